# Optimizing an MI355X kernel written in HIP

```python
import jax, jax.numpy as jnp
from jax import lax
import numpy as np

D_MODEL = 1024
BATCH = 4
SEQ = 8192
DEPTH = 2

CHUNK = 64
N_META = 16
HEAD_DIM = 64
Q_BLOCK = 128
POOL_WINDOWS = (2, 4, 8, 16)
N_POOL_GROUPS = 4
POOL_WIDTH = D_MODEL // 4
POOL_GROUP = POOL_WIDTH // N_POOL_GROUPS
FOX_HEADS = (3 * D_MODEL // 8) // HEAD_DIM
FOX_WIDTH = FOX_HEADS * HEAD_DIM
SB_HEADS = (3 * D_MODEL // 8) // HEAD_DIM
SB_WIDTH = SB_HEADS * HEAD_DIM
MIX_WIDTH = POOL_WIDTH + FOX_WIDTH + SB_WIDTH
IN_WIDTH = POOL_WIDTH + 3 * FOX_WIDTH + FOX_HEADS + 3 * SB_WIDTH
IN_SPLITS = (
    POOL_WIDTH,
    POOL_WIDTH + FOX_WIDTH,
    POOL_WIDTH + 2 * FOX_WIDTH,
    POOL_WIDTH + 3 * FOX_WIDTH,
    POOL_WIDTH + 3 * FOX_WIDTH + FOX_HEADS,
    POOL_WIDTH + 3 * FOX_WIDTH + FOX_HEADS + SB_WIDTH,
    POOL_WIDTH + 3 * FOX_WIDTH + FOX_HEADS + 2 * SB_WIDTH,
)
D_FF = ((8 * D_MODEL // 3 + 255) // 256) * 256
EPS = 1e-6

kernel_name = 'hymba_pool_fox_stickbreak_trunk'


def rmsnorm(x, g):
    x32 = x.astype(jnp.float32)
    y = x32 * lax.rsqrt(jnp.mean(x32 * x32, axis=-1, keepdims=True) + EPS)
    return (y * g.astype(jnp.float32)).astype(x.dtype)


def head_rmsnorm(y, gain, n_heads):
    b, l, _ = y.shape
    y32 = y.reshape(b, l, n_heads, HEAD_DIM).astype(jnp.float32)
    y32 = y32 * lax.rsqrt(jnp.mean(y32 * y32, axis=-1, keepdims=True) + EPS)
    return (y32.reshape(b, l, n_heads * HEAD_DIM) * gain.astype(jnp.float32)).astype(y.dtype)


def split_heads(t, n_heads):
    b, l, _ = t.shape
    return t.reshape(b, l, n_heads, HEAD_DIM).transpose(0, 2, 1, 3)


def query_blocks(t):
    l = t.shape[2]
    t = t.reshape(t.shape[:2] + (l // Q_BLOCK, Q_BLOCK) + t.shape[3:])
    return jnp.moveaxis(t, 2, 0)


def merge_blocks(o):
    nblk, b, h, q, d = o.shape
    o = jnp.moveaxis(o, 0, 2).reshape(b, h, nblk * q, d)
    return o.transpose(0, 2, 1, 3).reshape(b, nblk * q, h * d)


def multiscale_pool_mixer(u, pool_w, pool_scale):
    b, l, _ = u.shape
    ug = u.reshape(b, l, N_POOL_GROUPS, POOL_GROUP).astype(jnp.float32)
    cs = jnp.cumsum(ug, axis=1)
    cs0 = jnp.concatenate([jnp.zeros_like(cs[:, :1]), cs], axis=1)
    t1 = jnp.arange(1, l + 1)[:, None]
    win = jnp.array(POOL_WINDOWS, dtype=jnp.int32)[None, :]
    lo = jnp.maximum(t1 - win, 0)
    window_sum = cs - cs0[:, lo, jnp.arange(N_POOL_GROUPS)[None, :]]
    mean = window_sum / (t1 - lo).astype(jnp.float32)[None, :, :, None]
    d = (mean - ug).astype(u.dtype)
    mixed = jnp.einsum('blgc,gcd->blgd', d, pool_w)
    return mixed.reshape(b, l, POOL_WIDTH) * pool_scale


def forgetting_attention(q, k, v, log_f):
    c = jnp.cumsum(log_f.astype(jnp.float32), axis=1).transpose(0, 2, 1)
    l = q.shape[2]
    pos = jnp.arange(l)
    k32 = k.astype(jnp.float32)
    scale = HEAD_DIM ** -0.5

    def block(args):
        qb, cb, tq = args
        s = jnp.einsum('bhqd,bhkd->bhqk', qb.astype(jnp.float32), k32) * scale
        s = s + cb[..., None] - c[:, :, None, :]
        s = jnp.where(pos[None, :] <= tq[:, None], s, -jnp.inf)
        p = jax.nn.softmax(s, axis=-1)
        return jnp.einsum('bhqk,bhkd->bhqd', p.astype(v.dtype), v)

    o = lax.map(block, (query_blocks(q), query_blocks(c), pos.reshape(-1, Q_BLOCK)))
    return merge_blocks(o)


def stick_breaking_attention(q, k, v):
    l = q.shape[2]
    pos = jnp.arange(l)
    k32 = k.astype(jnp.float32)
    scale = HEAD_DIM ** -0.5

    def block(args):
        qb, tq = args
        z = jnp.einsum('bhqd,bhkd->bhqk', qb.astype(jnp.float32), k32) * scale
        strict = pos[None, :] < tq[:, None]
        log_beta = jax.nn.log_sigmoid(z)
        log_1m = jnp.where(strict, jax.nn.log_sigmoid(-z), 0.0)
        later = lax.cumsum(log_1m, axis=3, reverse=True) - log_1m
        a = jnp.where(strict, jnp.exp(log_beta + later), 0.0)
        return jnp.einsum('bhqk,bhkd->bhqd', a.astype(v.dtype), v)

    o = lax.map(block, (query_blocks(q), pos.reshape(-1, Q_BLOCK)))
    return merge_blocks(o)


def setup_inputs(seed: int = 0) -> dict:
    key = jax.random.key(seed)
    ks = jax.random.split(key, 15)
    f32 = jnp.float32
    n = jax.random.normal
    return {
        'x': n(ks[0], (BATCH, SEQ, D_MODEL), f32),
        'meta_tokens': n(ks[1], (N_META, D_MODEL), f32),
        'norm1': 1.0 + 0.05 * n(ks[2], (DEPTH, D_MODEL), f32),
        'w_in': n(ks[3], (DEPTH, D_MODEL, IN_WIDTH), f32) * D_MODEL ** -0.5,
        'forget_bias': jax.random.uniform(ks[4], (DEPTH, FOX_HEADS), f32, 1.0, 4.0),
        'pool_w': n(ks[5], (DEPTH, N_POOL_GROUPS, POOL_GROUP, POOL_GROUP), f32) * POOL_GROUP ** -0.5,
        'pool_scale': 1.0 + 0.1 * n(ks[6], (DEPTH, POOL_WIDTH), f32),
        'fox_out_gain': 1.0 + 0.05 * n(ks[7], (DEPTH, FOX_WIDTH), f32),
        'sb_out_gain': 1.0 + 0.05 * n(ks[8], (DEPTH, SB_WIDTH), f32),
        'w_out': n(ks[9], (DEPTH, MIX_WIDTH, D_MODEL), f32) * MIX_WIDTH ** -0.5,
        'norm2': 1.0 + 0.05 * n(ks[10], (DEPTH, D_MODEL), f32),
        'w_gate': n(ks[11], (DEPTH, D_MODEL, D_FF), f32) * D_MODEL ** -0.5,
        'w_up': n(ks[12], (DEPTH, D_MODEL, D_FF), f32) * D_MODEL ** -0.5,
        'w_down': n(ks[13], (DEPTH, D_FF, D_MODEL), f32) * D_FF ** -0.5,
        'final_norm': 1.0 + 0.05 * n(ks[14], (D_MODEL,), f32),
    }


def reference(x, meta_tokens, norm1, w_in, forget_bias, pool_w, pool_scale, fox_out_gain,
              sb_out_gain, w_out, norm2, w_gate, w_up, w_down, final_norm):
    b, s_len, _ = x.shape
    l = N_META + s_len
    l_pad = -(-l // Q_BLOCK) * Q_BLOCK
    meta = jnp.broadcast_to(meta_tokens[None].astype(x.dtype), (b, N_META, D_MODEL))
    h = jnp.concatenate([meta, x, jnp.zeros((b, l_pad - l, D_MODEL), x.dtype)], axis=1)

    for i in range(DEPTH):
        a = rmsnorm(h, norm1[i])
        proj = a @ w_in[i]
        u, qf, kf, vf, fl, qs, ks_, vs = jnp.split(proj, IN_SPLITS, axis=-1)
        y_pool = multiscale_pool_mixer(u, pool_w[i], pool_scale[i])
        log_f = jax.nn.log_sigmoid(fl.astype(jnp.float32) + forget_bias[i].astype(jnp.float32))
        y_fox = forgetting_attention(split_heads(qf, FOX_HEADS), split_heads(kf, FOX_HEADS),
                                     split_heads(vf, FOX_HEADS), log_f)
        y_fox = head_rmsnorm(y_fox, fox_out_gain[i], FOX_HEADS)
        y_sb = stick_breaking_attention(split_heads(qs, SB_HEADS), split_heads(ks_, SB_HEADS),
                                        split_heads(vs, SB_HEADS))
        y_sb = head_rmsnorm(y_sb, sb_out_gain[i], SB_HEADS)
        h = h + jnp.concatenate([y_pool, y_fox, y_sb], axis=-1) @ w_out[i]
        a = rmsnorm(h, norm2[i])
        h = h + (jax.nn.silu(a @ w_gate[i]) * (a @ w_up[i])) @ w_down[i]

    h = rmsnorm(h, final_norm)
    return h[:, N_META:N_META + s_len]
```

```cpp
#include <hip/hip_runtime.h>
#include <hip/hip_cooperative_groups.h>
#include <cstdio>
#include <cstdint>
namespace pg8 {
#define PG8_LAS __attribute__((address_space(3)))
typedef unsigned short bf16_t;
typedef short bf16x8 __attribute__((ext_vector_type(8)));
typedef float f32x4 __attribute__((ext_vector_type(4)));
typedef unsigned u32x4 __attribute__((ext_vector_type(4)));
constexpr int BM = 256, BK = 64, HALF = 128, HTB = HALF * BK * 2  , STAGE_BYTES = 8 * HTB, NXCD = 8, WGM = 8;

__host__ __device__ __forceinline__ int lds_byte(int r, int c) { const int st = (r >> 4) * 2 + (c >> 5), rr = r & 15, cc = c & 31, ob = rr * 64 + cc * 2; return st * 1024 + (ob ^ (((ob >> 9) & 1) << 5)); }
__host__ __device__ __forceinline__ void stage_rc(int b, int& R, int& C) { const int st = b / 1024, sb = b % 1024, swz = sb ^ (((sb >> 9) & 1) << 5); R = (st >> 1) * 16 + swz / 64; C = (st & 1) * 32 + (swz % 64) / 2; }
__host__ __device__ __forceinline__ int perm32(int rho) { const int n = rho >> 4, i = rho & 15; return 8 * (i >> 2) + 4 * n + (i & 3); }

struct Unit { int pm, pn; };
struct Gemm { const bf16_t* A; const bf16_t* Bt; int M, N, K; };

struct StaticOrder {
    int nM, nN, nwg, G, c;
    __host__ __device__ void init(int M, int N, int G_, int c_) { nM = M / BM; nN = N / BM; nwg = nM * nN; G = G_; c = c_; }
    __host__ __device__ bool next(int i, Unit& u) const {
        const long L = (long)i * G + c; if (L >= nwg) return false;
        int wgid = (int)L; { const int q = nwg / NXCD, r = nwg % NXCD, xcd = wgid % NXCD, off = wgid / NXCD; wgid = (xcd < r ? xcd * (q + 1) : r * (q + 1) + (xcd - r) * q) + off; }
        const int nig = WGM * nN, gid = wgid / nig, fm = gid * WGM, gsz = (nM - fm) < WGM ? (nM - fm) : WGM;
        u.pm = fm + ((wgid % nig) % gsz); u.pn = (wgid % nig) / gsz; return true;
    }
    __device__ __forceinline__ void a_ready(const Unit&) const {}
    __device__ __forceinline__ void done(const Unit&) const {}
};

__device__ __forceinline__ unsigned cvt_pk_bf16(float lo, float hi) { unsigned r; asm volatile("v_cvt_pk_bf16_f32 %0, %1, %2" : "=v"(r) : "v"(lo), "v"(hi)); return r; }
typedef unsigned u32x2 __attribute__((ext_vector_type(2)));
constexpr float RMS_EPS = 1e-6f;
struct EpiIn {
    static constexpr bool PERM = true, AFTER_DRAIN = false;
    bf16_t* P; float* LF; const float* ss; const float* fb;
    __device__ __forceinline__ void operator()(const f32x4 (&acc)[2][2][4][2], const Unit& u, int wr, int wc, int fr, int fq) const {
        const int row0 = u.pm * BM + wr * 64 + fr;
        if (u.pn < 10) {
            const int col0 = u.pn * BM + wc * 32 + 8 * fq;
#pragma unroll
            for (int ai = 0; ai < 2; ++ai)
#pragma unroll
                for (int m = 0; m < 4; ++m) { const int row = row0 + ai * HALF + m * 16; const float rs = __builtin_amdgcn_rsqf(ss[row] * (1.0f / 1024.0f) + RMS_EPS);
                    bf16_t* rowp = P + (size_t)row * 2560 + col0;
#pragma unroll
                    for (int bj = 0; bj < 2; ++bj) { const f32x4 v0 = acc[ai][bj][m][0] * rs, v1 = acc[ai][bj][m][1] * rs;
                        u32x4 w; w.x = cvt_pk_bf16(v0[0], v0[1]); w.y = cvt_pk_bf16(v0[2], v0[3]); w.z = cvt_pk_bf16(v1[0], v1[1]); w.w = cvt_pk_bf16(v1[2], v1[3]);
                        *(u32x4*)(rowp + bj * HALF) = w; } }
        } else if (wc == 0 && fq == 0) {
            float b[6];
#pragma unroll
            for (int j = 0; j < 6; ++j) b[j] = fb[j];
#pragma unroll
            for (int ai = 0; ai < 2; ++ai)
#pragma unroll
                for (int m = 0; m < 4; ++m) { const int row = row0 + ai * HALF + m * 16; const float rs = __builtin_amdgcn_rsqf(ss[row] * (1.0f / 1024.0f) + RMS_EPS);
                    const f32x4 v0 = acc[ai][0][m][0] * rs, v1 = acc[ai][0][m][1] * rs;
                    float x[6] = {v0[0] + b[0], v0[1] + b[1], v0[2] + b[2], v0[3] + b[3], v1[0] + b[4], v1[1] + b[5]};
                    float l[6];
#pragma unroll
                    for (int j = 0; j < 6; ++j) l[j] = -(fmaxf(-x[j], 0.f) + log1pf(expf(-fabsf(x[j])))) * 1.4426950408889634f;
                    *(f32x4*)(LF + (size_t)row * 8) = (f32x4){l[0], l[1], l[2], l[3]};
                    *(f32x4*)(LF + (size_t)row * 8 + 4) = (f32x4){l[4], l[5], 0.f, 0.f}; }
        }
    }
};
struct EpiRes {
    static constexpr bool PERM = true, AFTER_DRAIN = false;
    float* h; bf16_t* hb; float* ssn;
    __device__ __forceinline__ void operator()(const f32x4 (&acc)[2][2][4][2], const Unit& u, int wr, int wc, int fr, int fq) const {
        const int row0 = u.pm * BM + wr * 64 + fr, col0 = u.pn * BM + wc * 32 + 8 * fq;
#pragma unroll
        for (int ai = 0; ai < 2; ++ai)
#pragma unroll
            for (int m = 0; m < 4; ++m) { const int row = row0 + ai * HALF + m * 16; float* hp = h + (size_t)row * 1024 + col0; bf16_t* bp = hb + (size_t)row * 1024 + col0; float s = 0.f;
#pragma unroll
                for (int bj = 0; bj < 2; ++bj) { f32x4 a = *(const f32x4*)(hp + bj * HALF), b = *(const f32x4*)(hp + bj * HALF + 4);
                    a = a + acc[ai][bj][m][0]; b = b + acc[ai][bj][m][1];
                    *(f32x4*)(hp + bj * HALF) = a; *(f32x4*)(hp + bj * HALF + 4) = b;
                    s += (a[0] * a[0] + a[1] * a[1]) + (a[2] * a[2] + a[3] * a[3]) + (b[0] * b[0] + b[1] * b[1]) + (b[2] * b[2] + b[3] * b[3]);
                    u32x4 w; w.x = cvt_pk_bf16(a[0], a[1]); w.y = cvt_pk_bf16(a[2], a[3]); w.z = cvt_pk_bf16(b[0], b[1]); w.w = cvt_pk_bf16(b[2], b[3]);
                    *(u32x4*)(bp + bj * HALF) = w; }
                s += __shfl_xor(s, 16); s += __shfl_xor(s, 32);
                if (fq == 0) atomicAdd(ssn + row, s);
                asm volatile("" ::: "memory"); }
    }
};
struct EpiGU {
    static constexpr bool PERM = true, AFTER_DRAIN = false;
    bf16_t* H; const float* ss;
    __device__ __forceinline__ void operator()(const f32x4 (&acc)[2][2][4][2], const Unit& u, int wr, int wc, int fr, int fq) const {
        const int row0 = u.pm * BM + wr * 64 + fr, col0 = u.pn * HALF + wc * 32 + 8 * fq;
#pragma unroll
        for (int ai = 0; ai < 2; ++ai)
#pragma unroll
            for (int m = 0; m < 4; ++m) { const int row = row0 + ai * HALF + m * 16; const float rs = __builtin_amdgcn_rsqf(ss[row] * (1.0f / 1024.0f) + RMS_EPS);
                float o[8];
#pragma unroll
                for (int n = 0; n < 2; ++n)
#pragma unroll
                    for (int e = 0; e < 4; ++e) { const float g = acc[ai][0][m][n][e] * rs, up = acc[ai][1][m][n][e] * rs;
                        o[4 * n + e] = g * __builtin_amdgcn_rcpf(1.0f + __builtin_amdgcn_exp2f(-1.4426950408889634f * g)) * up; }
                u32x4 w; w.x = cvt_pk_bf16(o[0], o[1]); w.y = cvt_pk_bf16(o[2], o[3]); w.z = cvt_pk_bf16(o[4], o[5]); w.w = cvt_pk_bf16(o[6], o[7]);
                *(u32x4*)(H + (size_t)row * 2816 + col0) = w; }
    }
};
template <class Epi, class Sched, bool ALIGN_EPI = false, bool SP2 = false>
__device__ __forceinline__ void gemm_phase(PG8_LAS unsigned char* lds, const Gemm g, const Sched& S, const Epi& E) {
    int tid_ = threadIdx.x; asm volatile("" : "+v"(tid_));
    const int tid = tid_, wid = __builtin_amdgcn_readfirstlane(tid >> 6), lane = tid & 63, wr = wid >> 2, wc = wid & 3, fr = lane & 15, fq = lane >> 4;
    const int K = g.K, nt = K / BK;
    unsigned voffA[2], voffB[2];
#pragma unroll
    for (int i = 0; i < 2; ++i) { int R, C; stage_rc(tid * 16 + i * 8192, R, C); const int Rb = Epi::PERM ? ((R & ~31) + perm32(R & 31)) : R;
        voffA[i] = (unsigned)(R * K + C) * 2u; voffB[i] = (unsigned)(Rb * K + C) * 2u; }
    const size_t kstep = (size_t)(BK * 2);
    const size_t hstep = (size_t)HALF * K * 2;
    const size_t tstep = 2 * hstep;
    const unsigned ldsw = (unsigned)wid * 1024u;
    const int aoff = lds_byte(wr * 64 + fr, fq * 8), boff = lds_byte(wc * 32 + fr, fq * 8);
#define PG8_SA(b, h) (((b) * 2 + (h)) * HTB)
#define PG8_SB(b, h) ((4 + (b) * 2 + (h)) * HTB)
#define PG8_STAGE(bufoff, gbase, voff) do { _Pragma("unroll") for (int _i = 0; _i < 2; ++_i) \
        __builtin_amdgcn_global_load_lds((const unsigned*)((const char*)(gbase) + (voff)[_i]), (PG8_LAS unsigned*)(lds + (bufoff) + ldsw + _i * 8192), 16, 0, 0); } while (0)
#define PG8_LDA(dst, b, h) do { _Pragma("unroll") for (int m = 0; m < 4; ++m) _Pragma("unroll") for (int k = 0; k < 2; ++k) dst[m][k] = *(const PG8_LAS bf16x8*)(lds + PG8_SA(b, h) + aoff + m * 2048 + k * 1024); } while (0)
#define PG8_LDB(dst, b, h) do { _Pragma("unroll") for (int n = 0; n < 2; ++n) _Pragma("unroll") for (int k = 0; k < 2; ++k) dst[n][k] = *(const PG8_LAS bf16x8*)(lds + PG8_SB(b, h) + boff + n * 2048 + k * 1024); } while (0)
#define PG8_MMA(ai, bj, At, Bt) do { __builtin_amdgcn_s_setprio(1); _Pragma("unroll") for (int m = 0; m < 4; ++m) _Pragma("unroll") for (int n = 0; n < 2; ++n) _Pragma("unroll") for (int k = 0; k < 2; ++k) \
        acc[ai][bj][m][n] = __builtin_amdgcn_mfma_f32_16x16x32_bf16(Bt[n][k], At[m][k], acc[ai][bj][m][n], 0, 0, 0); __builtin_amdgcn_s_setprio(0); } while (0)
#define PG8_WAIT_V(n) asm volatile("s_waitcnt vmcnt(" #n ")" ::: "memory")
#define PG8_WAIT_L(n) asm volatile("s_waitcnt lgkmcnt(" #n ")" ::: "memory")
#define PG8_BAR __builtin_amdgcn_s_barrier()
#define PG8_SCHED __builtin_amdgcn_sched_barrier(0)
    Unit cur, nxt; int ui = 0;
    if (!S.next(0, cur)) return;
    f32x4 acc[2][2][4][2];
#pragma unroll
    for (int a = 0; a < 2; ++a)
#pragma unroll
        for (int b = 0; b < 2; ++b)
#pragma unroll
            for (int m = 0; m < 4; ++m)
#pragma unroll
                for (int n = 0; n < 2; ++n) acc[a][b][m][n] = (f32x4){0.f, 0.f, 0.f, 0.f};
    bf16x8 At[4][2], B0[2][2], B1[2][2];
    const char* cA = (const char*)g.A + (size_t)cur.pm * tstep; const char* cB = (const char*)g.Bt + (size_t)cur.pn * tstep;
    S.a_ready(cur);
    if constexpr (SP2) {
        PG8_STAGE(PG8_SB(0, 0), cB, voffB); PG8_STAGE(PG8_SB(0, 1), cB + hstep, voffB); PG8_STAGE(PG8_SA(0, 0), cA, voffA); PG8_STAGE(PG8_SA(0, 1), cA + hstep, voffA);
        if (wr == 1) PG8_BAR;
        PG8_WAIT_V(2); PG8_BAR;
        PG8_STAGE(PG8_SB(1, 0), cB + kstep, voffB); PG8_STAGE(PG8_SA(1, 0), cA + kstep, voffA); PG8_STAGE(PG8_SB(1, 1), cB + hstep + kstep, voffB);
        PG8_WAIT_V(6); PG8_BAR;
    } else {
        PG8_STAGE(PG8_SB(0, 0), cB, voffB); PG8_STAGE(PG8_SA(0, 0), cA, voffA); PG8_STAGE(PG8_SB(0, 1), cB + hstep, voffB); PG8_STAGE(PG8_SA(0, 1), cA + hstep, voffA);
        if (wr == 1) PG8_BAR;
        PG8_WAIT_V(4); PG8_BAR;
        PG8_STAGE(PG8_SB(1, 0), cB + kstep, voffB); PG8_STAGE(PG8_SA(1, 0), cA + kstep, voffA); PG8_STAGE(PG8_SB(1, 1), cB + hstep + kstep, voffB);
        PG8_WAIT_V(6); PG8_BAR;
    }
    for (;;) {
        const bool has_next = S.next(ui + 1, nxt);
        const char* nA = has_next ? (const char*)g.A + (size_t)nxt.pm * tstep : cA; const char* nB = has_next ? (const char*)g.Bt + (size_t)nxt.pn * tstep : cB;
        for (int t = 0; t < nt; t += 2) {
            const bool last = (t == nt - 2);
            const char* a1 = cA + (size_t)(t + 1) * kstep;
            const char* a2 = last ? nA : cA + (size_t)(t + 2) * kstep; const char* b2 = last ? nB : cB + (size_t)(t + 2) * kstep;
            const char* a3 = a2 + kstep; const char* b3 = b2 + kstep;
            if (last && has_next) S.a_ready(nxt);
            if constexpr (SP2) {
            PG8_LDB(B0, 0, 0); PG8_LDB(B1, 0, 1); PG8_SCHED; PG8_LDA(At, 0, 0); PG8_STAGE(PG8_SA(1, 1), a1 + hstep, voffA);
            PG8_WAIT_V(8); PG8_WAIT_L(0); PG8_BAR; PG8_MMA(0, 0, At, B0); PG8_MMA(0, 1, At, B1); PG8_BAR; PG8_SCHED;
            PG8_LDA(At, 0, 1); PG8_STAGE(PG8_SB(0, 0), b2, voffB); PG8_STAGE(PG8_SB(0, 1), b2 + hstep, voffB); PG8_STAGE(PG8_SA(0, 0), a2, voffA);
            PG8_WAIT_V(8); PG8_WAIT_L(0); PG8_BAR; PG8_MMA(1, 0, At, B0); PG8_MMA(1, 1, At, B1); PG8_BAR; PG8_SCHED;
            PG8_LDB(B0, 1, 0); PG8_LDB(B1, 1, 1); PG8_SCHED; PG8_LDA(At, 1, 0); PG8_STAGE(PG8_SA(0, 1), a2 + hstep, voffA);
            PG8_WAIT_V(8); PG8_WAIT_L(0); PG8_BAR; PG8_MMA(0, 0, At, B0); PG8_MMA(0, 1, At, B1); PG8_BAR; PG8_SCHED;
            PG8_LDA(At, 1, 1); PG8_STAGE(PG8_SB(1, 0), b3, voffB); PG8_STAGE(PG8_SB(1, 1), b3 + hstep, voffB); PG8_STAGE(PG8_SA(1, 0), a3, voffA);
            PG8_WAIT_V(8); PG8_WAIT_L(0); PG8_BAR; PG8_MMA(1, 0, At, B0); PG8_MMA(1, 1, At, B1); PG8_BAR; PG8_SCHED;
            } else {
            PG8_LDB(B0, 0, 0); PG8_SCHED; PG8_LDA(At, 0, 0); PG8_STAGE(PG8_SA(1, 1), a1 + hstep, voffA);
            PG8_WAIT_L(8); PG8_BAR; PG8_WAIT_L(0); PG8_MMA(0, 0, At, B0); PG8_BAR; PG8_SCHED;
            PG8_LDB(B1, 0, 1); PG8_STAGE(PG8_SB(0, 0), b2, voffB);
            PG8_BAR; PG8_WAIT_L(0); PG8_MMA(0, 1, At, B1); PG8_BAR;
            PG8_LDA(At, 0, 1); PG8_STAGE(PG8_SA(0, 0), a2, voffA);
            PG8_BAR; PG8_WAIT_L(0); PG8_MMA(1, 0, At, B0); PG8_BAR; PG8_SCHED;
            PG8_STAGE(PG8_SB(0, 1), b2 + hstep, voffB);
            PG8_WAIT_V(6); PG8_BAR; PG8_MMA(1, 1, At, B1); PG8_BAR;
            PG8_LDB(B0, 1, 0); PG8_SCHED; PG8_LDA(At, 1, 0); PG8_STAGE(PG8_SA(0, 1), a2 + hstep, voffA);
            PG8_WAIT_L(8); PG8_BAR; PG8_WAIT_L(0); PG8_MMA(0, 0, At, B0); PG8_BAR; PG8_SCHED;
            PG8_LDB(B1, 1, 1); PG8_STAGE(PG8_SB(1, 0), b3, voffB);
            PG8_BAR; PG8_WAIT_L(0); PG8_MMA(0, 1, At, B1); PG8_BAR;
            PG8_LDA(At, 1, 1); PG8_STAGE(PG8_SA(1, 0), a3, voffA);
            PG8_BAR; PG8_WAIT_L(0); PG8_MMA(1, 0, At, B0); PG8_BAR; PG8_SCHED;
            PG8_STAGE(PG8_SB(1, 1), b3 + hstep, voffB);
            PG8_WAIT_V(6); PG8_BAR; PG8_MMA(1, 1, At, B1); PG8_BAR;
            }
        }
        if constexpr (ALIGN_EPI) { if (wr == 0) PG8_BAR; }
        if constexpr (!Epi::AFTER_DRAIN) { E(acc, cur, wr, wc, fr, fq); S.done(cur); }
        if (!has_next) break;
#pragma unroll
        for (int a = 0; a < 2; ++a)
#pragma unroll
            for (int b = 0; b < 2; ++b)
#pragma unroll
                for (int m = 0; m < 4; ++m)
#pragma unroll
                    for (int n = 0; n < 2; ++n) acc[a][b][m][n] = (f32x4){0.f, 0.f, 0.f, 0.f};
        cur = nxt; cA = nA; cB = nB; ++ui;
        if constexpr (ALIGN_EPI) { if (wr == 1) PG8_BAR; }
    }
    PG8_WAIT_V(0);
    if constexpr (!ALIGN_EPI) { if (wr == 0) PG8_BAR; }
    PG8_BAR;
    if constexpr (Epi::AFTER_DRAIN) { E.fused(acc, cur, wr, wc, fr, fq, lds, wid, lane); S.done(cur); }
#undef PG8_SA
#undef PG8_SB
#undef PG8_STAGE
#undef PG8_LDA
#undef PG8_LDB
#undef PG8_MMA
#undef PG8_WAIT_V
#undef PG8_WAIT_L
#undef PG8_BAR
#undef PG8_SCHED
}
}
#include <hip/hip_bf16.h>
#include <cmath>
namespace attn_body {
using bf16=__hip_bfloat16;
using bf16x8=__attribute__((ext_vector_type(8)))short;
using s16x4=__attribute__((ext_vector_type(4)))short;
using f32x16=__attribute__((ext_vector_type(16)))float;
using u32x4=__attribute__((ext_vector_type(4)))unsigned;
constexpr int SEQ=8448,D=64,DM=2560,DMO=1024;
using f32x4=__attribute__((ext_vector_type(4)))float;
constexpr int NW=8,QBLK=32,QB=QBLK*NW,KVBLK=64,NQB=SEQ/QB;
constexpr int ATTN_UNIT_ROWS=QB;
__device__ __forceinline__ int crow(int r,int hi){return (r&3)+8*(r>>2)+4*hi;}
#define SBAR() __builtin_amdgcn_sched_barrier(0)
__device__ __forceinline__ void cmask(f32x16&p0,f32x16&p1,int jb,int qrel,int hi){
  const float NEG=-INFINITY; int kb=64*jb+4*hi;
  #pragma unroll
  for(int r=0;r<16;++r){int kv=kb+(r&3)+8*(r>>2); if(kv>qrel)p0[r]=NEG; if(kv+32>qrel)p1[r]=NEG;}
}

constexpr int NSLOT=3, SLOTB=8192;
constexpr int LDS_K=0, LDS_V=NSLOT*SLOTB, LDS_WS=2*NSLOT*SLOTB, LDS_OST=LDS_WS+NW*64*4, LDS_BYTES=LDS_OST+NW*4096, LDS_CS=LDS_BYTES, LDS_FLAGS=LDS_CS+SEQ*4, LDS_END=LDS_FLAGS+256;
constexpr float C2=0.125f*1.4426950408889634f;
__device__ __forceinline__ void glds16(const void*gsrc,unsigned lds_dst){unsigned keep;
  asm volatile("s_mov_b32 %0, m0\n\ts_mov_b32 m0, %2\n\ts_nop 0\n\tglobal_load_lds_dwordx4 %1, off\n\ts_mov_b32 m0, %0":"=&s"(keep):"v"(gsrc),"s"(lds_dst):"memory");}
__device__ __forceinline__ float max3f(float a,float b,float c){float r;asm("v_max3_f32 %0, %1, %2, %3":"=v"(r):"v"(a),"v"(b),"v"(c));return r;}
__device__ __forceinline__ float max2f(float a,float b){float r;asm("v_max_f32_e32 %0, %1, %2":"=v"(r):"v"(a),"v"(b));return r;}
__device__ __forceinline__ float fadd_s(float a,float b){float r;asm("v_add_f32_e32 %0, %1, %2":"=v"(r):"v"(a),"v"(b));return r;}
__device__ __forceinline__ float fsub_s(float a,float b){float r;asm("v_sub_f32_e32 %0, %1, %2":"=v"(r):"v"(a),"v"(b));return r;}
typedef float f32x2_t __attribute__((ext_vector_type(2))); typedef __bf16 bf16x2_t __attribute__((ext_vector_type(2)));
__device__ __forceinline__ unsigned cvtpk_s(float lo,float hi){f32x2_t v={lo,hi};bf16x2_t b=__builtin_convertvector(v,bf16x2_t);return __builtin_bit_cast(unsigned,b);}
#define WAIT_BAR(N) asm volatile("s_waitcnt vmcnt(" #N ") lgkmcnt(0)\n\ts_barrier":::"memory")

__device__ __forceinline__ void qkt(f32x16&p0,f32x16&p1,const char*Kslot,const bf16x8*qr,int r32,int hi){
  const char*kb=Kslot+hi*1024+r32*16;
  #pragma unroll
  for(int d0=0;d0<4;++d0){
    const bf16x8 b0=*reinterpret_cast<const bf16x8*>(kb+d0*2048);
    const bf16x8 b1=*reinterpret_cast<const bf16x8*>(kb+d0*2048+512);
    {p0=__builtin_amdgcn_mfma_f32_32x32x16_bf16(b0,qr[d0],p0,0,0,0);p1=__builtin_amdgcn_mfma_f32_32x32x16_bf16(b1,qr[d0],p1,0,0,0);}}
}
typedef __attribute__((address_space(3))) const char* lds_cptr;
typedef short v4i16_t __attribute__((ext_vector_type(4)));
__device__ __forceinline__ void kload8(bf16x8*kf,lds_cptr kp){
  kf[0]=*(const __attribute__((address_space(3))) bf16x8*)(kp);      kf[1]=*(const __attribute__((address_space(3))) bf16x8*)(kp+512);
  kf[2]=*(const __attribute__((address_space(3))) bf16x8*)(kp+2048); kf[3]=*(const __attribute__((address_space(3))) bf16x8*)(kp+2560);
  kf[4]=*(const __attribute__((address_space(3))) bf16x8*)(kp+4096); kf[5]=*(const __attribute__((address_space(3))) bf16x8*)(kp+4608);
  kf[6]=*(const __attribute__((address_space(3))) bf16x8*)(kp+6144); kf[7]=*(const __attribute__((address_space(3))) bf16x8*)(kp+6656);
}
__device__ __forceinline__ void kload2(bf16x8*kf,lds_cptr kp,int j){ kf[2*j]=*(const __attribute__((address_space(3))) bf16x8*)(kp+j*2048); kf[2*j+1]=*(const __attribute__((address_space(3))) bf16x8*)(kp+j*2048+512); }
__device__ __forceinline__ s16x4 vtr(lds_cptr p){ return __builtin_bit_cast(s16x4,__builtin_amdgcn_ds_read_tr16_b64_v4i16((__attribute__((address_space(3))) v4i16_t*)p)); }
__device__ __forceinline__ float rowmax(const f32x16&p0,const f32x16&p1){
  float a=max3f(p0[0],p0[1],p1[0]),b=max3f(p0[2],p0[3],p1[1]);a=max3f(a,p1[2],p1[3]);
  #pragma unroll
  for(int r=4;r<16;r+=4){a=max3f(a,p0[r],p0[r+1]);b=max3f(b,p0[r+2],p0[r+3]);a=max3f(a,p1[r],p1[r+1]);b=max3f(b,p1[r+2],p1[r+3]);}
  const float m=max2f(a,b);
  auto rr=__builtin_amdgcn_permlane32_swap(__float_as_uint(m),__float_as_uint(m),false,false);
  return max2f(__uint_as_float(rr[0]),__uint_as_float(rr[1]));
}
__device__ __forceinline__ void pv(f32x16*o,int vb,bf16x8 pa0,bf16x8 pa1,bf16x8 pa2,bf16x8 pa3){
  #pragma unroll
  for(int d0=0;d0<2;++d0){s16x4 lo[4],hi[4];
    #pragma unroll
    for(int ks=0;ks<4;++ks){
      asm volatile("ds_read_b64_tr_b16 %0,%1 offset:%c2":"=&v"(lo[ks]):"v"(vb),"i"(d0*4096+ks*1024):"memory");
      asm volatile("ds_read_b64_tr_b16 %0,%1 offset:%c2":"=&v"(hi[ks]):"v"(vb),"i"(d0*4096+ks*1024+512):"memory");}
    asm volatile("s_waitcnt lgkmcnt(0)":::"memory");SBAR();
    #define PK(k) (bf16x8){lo[k][0],lo[k][1],lo[k][2],lo[k][3],hi[k][0],hi[k][1],hi[k][2],hi[k][3]}
    o[d0]=__builtin_amdgcn_mfma_f32_32x32x16_bf16(pa0,PK(0),o[d0],0,0,0);
    o[d0]=__builtin_amdgcn_mfma_f32_32x32x16_bf16(pa1,PK(1),o[d0],0,0,0);
    o[d0]=__builtin_amdgcn_mfma_f32_32x32x16_bf16(pa2,PK(2),o[d0],0,0,0);
    o[d0]=__builtin_amdgcn_mfma_f32_32x32x16_bf16(pa3,PK(3),o[d0],0,0,0);
    #undef PK
  }
}

__device__ __forceinline__ u32x4 head_rms(u32x4 v){ float x[8];
  #pragma unroll
  for(int i=0;i<4;++i){x[2*i]=__uint_as_float(v[i]<<16);x[2*i+1]=__uint_as_float(v[i]&0xffff0000u);}
  float s=0.f;
  #pragma unroll
  for(int i=0;i<8;++i)s+=x[i]*x[i];
  s+=__shfl_xor(s,1);s+=__shfl_xor(s,2);s+=__shfl_xor(s,4);
  const float rs=__builtin_amdgcn_rsqf(s*(1.0f/64.0f)+1e-6f); u32x4 w;
  #pragma unroll
  for(int i=0;i<4;++i)w[i]=cvtpk_s(x[2*i]*rs,x[2*i+1]*rs);
  return w; }
#ifndef ATTN_STORE16
#define ATTN_STORE16(p,v) (*(u32x4*)(p)=(v))
#endif
template<int THRL> __device__ __forceinline__ void fox_unit(int b,int qb,int j0,const bf16*Q,const bf16*__restrict__ K,const bf16*__restrict__ V,bf16*O,const float*__restrict__ csg,char*shm){
  int tid_=threadIdx.x; asm volatile("":"+v"(tid_)); const int tid=tid_,lane=tid&63,r32=lane&31,hi=lane>>5; const int wid=__builtin_amdgcn_readfirstlane(tid>>6);
  const long rowbase=(long)b*SEQ; const int q0=qb*QB;
  const bf16*Qw=Q+(rowbase+q0+wid*QBLK)*DM;
  const bf16*Kh=K+(rowbase+(long)j0*KVBLK)*DM,*Vh=V+(rowbase+(long)j0*KVBLK)*DM;
  const unsigned lds0=(unsigned)(uintptr_t)shm; const lds_cptr shm3=(lds_cptr)shm;
  float*wsf=(float*)(shm+LDS_WS)+wid*64;
  const bf16*ksrc=Kh+(long)lane*DM+wid*8;
  const bf16*vsrc=Vh+(long)(16*(wid&3)+(lane>>2))*DM+(wid>>2)*32+(lane&3)*8;
  const unsigned kdst=lds0+LDS_K+wid*1024, vdst=lds0+LDS_V+wid*1024;
  #define DMA_K(t,slot) glds16(ksrc+(long)(t)*KVBLK*DM,(unsigned)__builtin_amdgcn_readfirstlane(kdst+(slot)))
  #define DMA_V(t,slot) glds16(vsrc+(long)(t)*KVBLK*DM,(unsigned)__builtin_amdgcn_readfirstlane(vdst+(slot)))
  const int vb0=(int)(lds0+LDS_V)+((lane>>4)&1)*32+(lane&3)*8+(4*hi+((lane&15)>>2))*64;
  const char*Kbase=shm+LDS_K; bf16x8 kf[8];
  const lds_cptr kp0=shm3+LDS_K+hi*1024+r32*16; const lds_cptr vp0=shm3+LDS_V+((lane>>4)&1)*32+(lane&3)*8+(4*hi+((lane&15)>>2))*64;
  const int NT=(q0+QB)/KVBLK-j0;
  typedef __attribute__((address_space(3))) float lds_f32; typedef __attribute__((address_space(3))) f32x4 lds_f32x4;
  { lds_f32*cl=(lds_f32*)(shm3+LDS_CS); const int n_=q0+QB; for(int i_=tid*4;i_<n_;i_+=2048){ const f32x4 v_=*(const f32x4*)(csg+i_); *(lds_f32x4*)(cl+i_)=v_; } }
  const lds_f32*cl3=(const lds_f32*)(shm3+LDS_CS)+64*j0;
  DMA_K(0,0);DMA_V(0,0);DMA_K(1,SLOTB);
  bf16x8 qr[4];
  #pragma unroll
  for(int d0=0;d0<4;++d0)qr[d0]=*reinterpret_cast<const bf16x8*>(&Qw[(long)r32*DM+d0*16+hi*8]);
  float base=0.f,l_reg=0.f;f32x16 o[2];o[0]=f32x16{};o[1]=f32x16{};
  #define CINIT(C0,C1,t) do{ const lds_f32*cp_=cl3+64*(t)+4*hi; \
    _Pragma("unroll") for(int g_=0;g_<4;++g_){ const f32x4 a_=*(const lds_f32x4*)(cp_+8*g_), b_=*(const lds_f32x4*)(cp_+32+8*g_); \
      C0[4*g_]=base-a_[0];C0[4*g_+1]=base-a_[1];C0[4*g_+2]=base-a_[2];C0[4*g_+3]=base-a_[3]; \
      C1[4*g_]=base-b_[0];C1[4*g_+1]=base-b_[1];C1[4*g_+2]=base-b_[2];C1[4*g_+3]=base-b_[3]; } }while(0)
  const int qrel=wid*QBLK+r32;
  #define CMASK(P0,P1,t) do{int jb_=(t)-(NT-4); if(jb_>=0)cmask(P0,P1,jb_,qrel,hi);}while(0)
  bool resc=false;
  #define START(P0,P1) do{ const float rm=rowmax(P0,P1); resc=false; \
    { const float dl=rm; base=fsub_s(base,dl); \
      _Pragma("unroll") for(int r=0;r<16;++r){P0[r]=fsub_s(P0[r],dl);P1[r]=fsub_s(P1[r],dl);} } \
    _Pragma("unroll") for(int r=0;r<16;++r)P0[r]=__builtin_amdgcn_exp2f(P0[r]); }while(0)
  #define RESC() do{ if(resc){ asm volatile("s_waitcnt lgkmcnt(0)":::"memory"); \
      _Pragma("unroll") for(int d_=0;d_<2;++d_) _Pragma("unroll") for(int r=0;r<16;++r)o[d_][r]*=wsf[crow(r,hi)]; } }while(0)
  f32x16 pA0,pA1,pB0,pB1;
  int sl_prev=0,sl_cur=0,sl_next=SLOTB;
  #define ROT() do{sl_prev=sl_cur;sl_cur=sl_next;sl_next=(sl_next==(NSLOT-1)*SLOTB)?0:sl_next+SLOTB;}while(0)
  DMA_K(2,2*SLOTB);
  WAIT_BAR(3);
  base=cl3[q0-64*j0+wid*QBLK+r32];
  CINIT(pA0,pA1,0); qkt(pA0,pA1,Kbase,qr,r32,hi);asm volatile("s_nop 15\n\ts_nop 7":"+v"(pA0),"+v"(pA1));CMASK(pA0,pA1,0);
  START(pA0,pA1);
  _Pragma("unroll") for(int r=0;r<16;++r)pA1[r]=__builtin_amdgcn_exp2f(pA1[r]);
  WAIT_BAR(0);
  DMA_K(3,0);DMA_V(1,SLOTB);
  ROT();
  kload8(kf,kp0+sl_cur);
  WAIT_BAR(2);
  s16x4 vlo[8],vhi[8]; u32x4 pw0,pw1,pw2,pw3;
  #define PKW(P,B) cvtpk_s(P[B],P[B+1])
  #define PAF(k) __builtin_bit_cast(bf16x8,pw##k)
  #define VFR(i) (bf16x8){vlo[i][0],vlo[i][1],vlo[i][2],vlo[i][3],vhi[i][0],vhi[i][1],vhi[i][2],vhi[i][3]}
  #define PIN(x) asm volatile("":"+v"(x))
  #define MX3(a,b,c) __builtin_fmaxf(__builtin_fmaxf((a),(b)),(c))
  #define GAPA(MF,A0,A1,A2,A3,W0,W1,PW) do{ MF; sacc+=A0; sacc+=A1; sacc+=A2; sacc+=A3; PIN(sacc); W0; W1; PIN(PW); SBAR(); }while(0)
  #define EX(v) __builtin_amdgcn_exp2f(v)
  #define GAPB(MF,X,B) do{ MF; X[B]=EX(X[B]); X[B+1]=EX(X[B+1]); X[B+2]=EX(X[B+2]); X[B+3]=EX(X[B+3]); PIN(X); SBAR(); }while(0)
  #define VRD(i) do{ vlo[i]=vtr(vp_+(((i)>>2)*4096+((i)&3)*1024)); vhi[i]=vtr(vp_+(((i)>>2)*4096+((i)&3)*1024+512)); }while(0)
  #define KRD(G,j) do{ if(G){ kload2(kf,kp0+sl_next,j); SBAR(); } }while(0)
  #define STEP(C0,C1,P0,P1,t,GK,GV,GL) do{ SBAR(); CINIT(C0,C1,t); SBAR(); \
    const lds_cptr vp_=vp0+sl_prev; \
    VRD(0); SBAR(); float sacc=(P0[0]+P0[1]); \
    GAPA(C0=__builtin_amdgcn_mfma_f32_32x32x16_bf16(kf[0],qr[0],C0,0,0,0), P0[2],P0[3],P0[4],P0[5],     pw0[0]=PKW(P0,0), pw0[1]=PKW(P0,2), pw0); \
    VRD(4); SBAR(); GAPA(C1=__builtin_amdgcn_mfma_f32_32x32x16_bf16(kf[1],qr[0],C1,0,0,0), P0[6],P0[7],P0[8],P0[9],     pw0[2]=PKW(P0,4), pw0[3]=PKW(P0,6), pw0); \
    VRD(1); SBAR(); GAPA(C0=__builtin_amdgcn_mfma_f32_32x32x16_bf16(kf[2],qr[1],C0,0,0,0),   P0[10],P0[11],P0[12],P0[13], pw1[0]=PKW(P0,8), pw1[1]=PKW(P0,10), pw1); \
    VRD(5); SBAR(); GAPA(C1=__builtin_amdgcn_mfma_f32_32x32x16_bf16(kf[3],qr[1],C1,0,0,0),   P0[14],P0[15],P1[0],P1[1],   pw1[2]=PKW(P0,12),pw1[3]=PKW(P0,14), pw1); \
    VRD(2); SBAR(); GAPA(C0=__builtin_amdgcn_mfma_f32_32x32x16_bf16(kf[4],qr[2],C0,0,0,0),   P1[2],P1[3],P1[4],P1[5],     pw2[0]=PKW(P1,0), pw2[1]=PKW(P1,2), pw2); \
    VRD(6); SBAR(); GAPA(C1=__builtin_amdgcn_mfma_f32_32x32x16_bf16(kf[5],qr[2],C1,0,0,0),   P1[6],P1[7],P1[8],P1[9],     pw2[2]=PKW(P1,4), pw2[3]=PKW(P1,6), pw2); \
    VRD(3); SBAR(); GAPA(C0=__builtin_amdgcn_mfma_f32_32x32x16_bf16(kf[6],qr[3],C0,0,0,0),   P1[10],P1[11],P1[12],P1[13], pw3[0]=PKW(P1,8), pw3[1]=PKW(P1,10), pw3); \
    VRD(7); SBAR(); GAPA(C1=__builtin_amdgcn_mfma_f32_32x32x16_bf16(kf[7],qr[3],C1,0,0,0),   P1[14],P1[15],0.f,0.f,       pw3[2]=PKW(P1,12),pw3[3]=PKW(P1,14), pw3); \
    l_reg+=sacc; \
    if(GK){DMA_K((t)+3,sl_cur);} if(GV){DMA_V((t)+1,sl_next);} \
    CMASK(C0,C1,t); \
    { float a=MX3(C0[0],C0[1],C1[0]),b=MX3(C0[2],C0[3],C1[1]); a=MX3(a,C1[2],C1[3]); \
      _Pragma("unroll") for(int r=4;r<16;r+=4){a=MX3(a,C0[r],C0[r+1]);b=MX3(b,C0[r+2],C0[r+3]);a=MX3(a,C1[r],C1[r+1]);b=MX3(b,C1[r+2],C1[r+3]);} \
      float rm=__builtin_fmaxf(a,b); { auto rr=__builtin_amdgcn_permlane32_swap(__float_as_uint(rm),__float_as_uint(rm),false,false); rm=__builtin_fmaxf(__uint_as_float(rr[0]),__uint_as_float(rr[1])); } \
      resc=false; \
      if(__builtin_expect(__any(rm>(float)THRL),0)){ const float dl=__builtin_fmaxf(rm,0.f); base-=dl; \
        _Pragma("unroll") for(int r=0;r<16;++r){C0[r]-=dl;C1[r]-=dl;} \
        const float f=__builtin_amdgcn_exp2f(-dl); l_reg*=f; if(hi==0)wsf[r32]=f; resc=true; } } \
    SBAR(); \
    GAPB(o[0]=__builtin_amdgcn_mfma_f32_32x32x16_bf16(PAF(0),VFR(0),o[0],0,0,0), C0,0); \
    GAPB(o[1]=__builtin_amdgcn_mfma_f32_32x32x16_bf16(PAF(0),VFR(4),o[1],0,0,0), C0,4); \
    KRD(GL,0); GAPB(o[0]=__builtin_amdgcn_mfma_f32_32x32x16_bf16(PAF(1),VFR(1),o[0],0,0,0), C0,8); \
    KRD(GL,1); GAPB(o[1]=__builtin_amdgcn_mfma_f32_32x32x16_bf16(PAF(1),VFR(5),o[1],0,0,0), C0,12); \
    KRD(GL,2); GAPB(o[0]=__builtin_amdgcn_mfma_f32_32x32x16_bf16(PAF(2),VFR(2),o[0],0,0,0), C1,0); \
    KRD(GL,3); GAPB(o[1]=__builtin_amdgcn_mfma_f32_32x32x16_bf16(PAF(2),VFR(6),o[1],0,0,0), C1,4); \
    GAPB(o[0]=__builtin_amdgcn_mfma_f32_32x32x16_bf16(PAF(3),VFR(3),o[0],0,0,0), C1,8); \
    GAPB(o[1]=__builtin_amdgcn_mfma_f32_32x32x16_bf16(PAF(3),VFR(7),o[1],0,0,0), C1,12); \
    }while(0)
  int t=1;
  #undef CMASK
  #define CMASK(P0,P1,t) do{}while(0)
  for(;t+5<NT;t+=2){
    STEP(pB0,pB1,pA0,pA1,t,true,true,true);     WAIT_BAR(2); RESC(); ROT();
    STEP(pA0,pA1,pB0,pB1,t+1,true,true,true);   WAIT_BAR(2); RESC(); ROT();
  }
  #undef CMASK
  #define CMASK(P0,P1,t) do{int jb_=(t)-(NT-4); if(jb_>=0)cmask(P0,P1,jb_,qrel,hi);}while(0)
  #define ENDW(tt) do{ if((tt)+3<NT){WAIT_BAR(2);} else if((tt)+2<NT){WAIT_BAR(1);} else {WAIT_BAR(0);} }while(0)
  for(;t+1<NT;t+=2){
    STEP(pB0,pB1,pA0,pA1,t,(t+3<NT),(t+1<NT),(t+1<NT));       ENDW(t);   RESC(); ROT();
    STEP(pA0,pA1,pB0,pB1,t+1,(t+4<NT),(t+2<NT),(t+2<NT));     ENDW(t+1); RESC(); ROT();
  }
  STEP(pB0,pB1,pA0,pA1,NT-1,false,false,false); RESC();
  { float sacc=pB0[0]+pB0[1]; _Pragma("unroll") for(int r=2;r<16;++r)sacc+=pB0[r]; _Pragma("unroll") for(int r=0;r<16;++r)sacc+=pB1[r]; l_reg+=sacc;
    pw0=(u32x4){PKW(pB0,0),PKW(pB0,2),PKW(pB0,4),PKW(pB0,6)};pw1=(u32x4){PKW(pB0,8),PKW(pB0,10),PKW(pB0,12),PKW(pB0,14)};pw2=(u32x4){PKW(pB1,0),PKW(pB1,2),PKW(pB1,4),PKW(pB1,6)};pw3=(u32x4){PKW(pB1,8),PKW(pB1,10),PKW(pB1,12),PKW(pB1,14)};
    SBAR(); pv(o,vb0+sl_cur,PAF(0),PAF(1),PAF(2),PAF(3)); }
  #undef PKW
  #undef PAF
  #undef VFR
  #undef PIN
  #undef MX3
  #undef GAPA
  #undef GAPB
  #undef EX
  #undef VRD
  #undef KRD
  #undef STEP
  #undef ENDW
  {auto rr=__builtin_amdgcn_permlane32_swap(__float_as_uint(l_reg),__float_as_uint(l_reg),false,false);l_reg=__uint_as_float(rr[0])+__uint_as_float(rr[1]);}
  if(hi==0)wsf[32+r32]=l_reg;asm volatile("s_waitcnt lgkmcnt(0)":::"memory");
  float rli[16];
  #pragma unroll
  for(int r=0;r<16;++r)rli[r]=__builtin_amdgcn_rcpf(wsf[32+crow(r,hi)]);
  bf16*Ow=O+(rowbase+q0+wid*QBLK)*DMO;
  { bf16*stg=(bf16*)(shm+LDS_OST)+wid*2048;
    #pragma unroll
    for(int r=0;r<16;++r){const int orow=crow(r,hi);
      #pragma unroll
      for(int d0=0;d0<2;++d0)stg[orow*64+d0*32+r32]=__float2bfloat16(o[d0][r]*rli[r]);}
    asm volatile("s_waitcnt lgkmcnt(0)":::"memory");
    #pragma unroll
    for(int i=0;i<4;++i){const int row=i*8+(lane>>3),ch=lane&7; const u32x4 v=*(const u32x4*)(stg+row*64+ch*8); ATTN_STORE16(Ow+(long)row*DMO+ch*8,head_rms(v));} }
  asm volatile("s_waitcnt lgkmcnt(0)\n\ts_barrier":::"memory");
  #undef DMA_K
  #undef DMA_V
  #undef CMASK
  #undef CINIT
  #undef START
  #undef RESC
  #undef ROT
}
__device__ __forceinline__ float sp2f(float z){ const float e=__builtin_amdgcn_exp2f(-__builtin_fabsf(z)); return __builtin_fmaxf(z,0.f)+__builtin_amdgcn_logf(1.f+e); }
__device__ __forceinline__ void sb_unit(int b,int qb,const bf16*Q,const bf16*__restrict__ K,const bf16*__restrict__ V,bf16*O,char*shm){
  int tid_=threadIdx.x; asm volatile("":"+v"(tid_)); const int tid=tid_,lane=tid&63,r32=lane&31,hi=lane>>5; const int wid=__builtin_amdgcn_readfirstlane(tid>>6);
  const long rowbase=(long)b*SEQ; const int q0=qb*QB;
  const bf16*Qw=Q+(rowbase+q0+wid*QBLK)*DM;
  const bf16*Kh=K+rowbase*DM,*Vh=V+rowbase*DM;
  const unsigned lds0=(unsigned)(uintptr_t)shm; const lds_cptr shm3=(lds_cptr)shm;
  const bf16*ksrc=Kh+(long)lane*DM+wid*8;
  const bf16*vsrc=Vh+(long)(16*(wid&3)+(lane>>2))*DM+(wid>>2)*32+(lane&3)*8;
  const unsigned kdst=lds0+LDS_K+wid*1024, vdst=lds0+LDS_V+wid*1024;
  #define DMA_K(t,slot) glds16(ksrc+(long)(t)*KVBLK*DM,(unsigned)__builtin_amdgcn_readfirstlane(kdst+(slot)))
  #define DMA_V(t,slot) glds16(vsrc+(long)(t)*KVBLK*DM,(unsigned)__builtin_amdgcn_readfirstlane(vdst+(slot)))
  const int vb0=(int)(lds0+LDS_V)+((lane>>4)&1)*32+(lane&3)*8+(4*hi+((lane&15)>>2))*64;
  typedef __attribute__((address_space(3))) unsigned lds_u32;
  volatile lds_u32*flags=(volatile lds_u32*)(shm3+LDS_FLAGS);
  bf16x8 qr[4];
  #pragma unroll
  for(int d0=0;d0<4;++d0)qr[d0]=*reinterpret_cast<const bf16x8*>(&Qw[(long)r32*DM+d0*16+hi*8]);
  asm volatile("":::"memory");
  f32x16 o[2];o[0]=f32x16{};o[1]=f32x16{};
  float R=0.f; const int qabs=q0+wid*QBLK+r32; bool done=false;
  const int jtop=4*qb+3;
  DMA_K(jtop,0);DMA_V(jtop,0);
  int slot=0;
  for(int j=jtop;j>=0;--j){
    if(j>0){ DMA_K(j-1,slot^SLOTB);DMA_V(j-1,slot^SLOTB); WAIT_BAR(2); } else { WAIT_BAR(0); }
    const bool active=(!done)&&(64*j<q0+wid*QBLK+31);
    if(active){
      f32x16 p0=f32x16{},p1=f32x16{};
      qkt(p0,p1,shm+LDS_K+slot,qr,r32,hi);
      const int kvb=64*j+4*hi; f32x16 s0,s1;
      #pragma unroll
      for(int r=0;r<16;++r){ const int kv=kvb+(r&3)+8*(r>>2); s0[r]=(kv<qabs)?sp2f(p0[r]):0.f; s1[r]=(kv+32<qabs)?sp2f(p1[r]):0.f; }
      float g0[4],g1[4],og0[4],og1[4],T0[4],T1[4];
      #pragma unroll
      for(int g=0;g<4;++g){ g0[g]=(s0[4*g]+s0[4*g+1])+(s0[4*g+2]+s0[4*g+3]); g1[g]=(s1[4*g]+s1[4*g+1])+(s1[4*g+2]+s1[4*g+3]); }
      #pragma unroll
      for(int g=0;g<4;++g){ og0[g]=__shfl_xor(g0[g],32); og1[g]=__shfl_xor(g1[g],32); }
      float run=R;
      #pragma unroll
      for(int g=3;g>=0;--g){ const float ah1=hi?g1[g]:og1[g], ah0=hi?og1[g]:g1[g]; const float t1=run; run+=ah1; const float t0=run; run+=ah0; T1[g]=hi?t1:t0; }
      #pragma unroll
      for(int g=3;g>=0;--g){ const float ah1=hi?g0[g]:og0[g], ah0=hi?og0[g]:g0[g]; const float t1=run; run+=ah1; const float t0=run; run+=ah0; T0[g]=hi?t1:t0; }
      R=run;
      #pragma unroll
      for(int g=0;g<4;++g){ float a0=T0[g],a1=T1[g];
        #pragma unroll
        for(int i=3;i>=0;--i){ const int r=4*g+i; const int kv=kvb+i+8*g; a0+=s0[r]; a1+=s1[r];
          p0[r]=(kv<qabs)?__builtin_amdgcn_exp2f(p0[r]-a0):0.f; p1[r]=(kv+32<qabs)?__builtin_amdgcn_exp2f(p1[r]-a1):0.f; } }
      u32x4 pw0,pw1,pw2,pw3;
      pw0=(u32x4){cvtpk_s(p0[0],p0[1]),cvtpk_s(p0[2],p0[3]),cvtpk_s(p0[4],p0[5]),cvtpk_s(p0[6],p0[7])};
      pw1=(u32x4){cvtpk_s(p0[8],p0[9]),cvtpk_s(p0[10],p0[11]),cvtpk_s(p0[12],p0[13]),cvtpk_s(p0[14],p0[15])};
      pw2=(u32x4){cvtpk_s(p1[0],p1[1]),cvtpk_s(p1[2],p1[3]),cvtpk_s(p1[4],p1[5]),cvtpk_s(p1[6],p1[7])};
      pw3=(u32x4){cvtpk_s(p1[8],p1[9]),cvtpk_s(p1[10],p1[11]),cvtpk_s(p1[12],p1[13]),cvtpk_s(p1[14],p1[15])};
      pv(o,vb0+slot,__builtin_bit_cast(bf16x8,pw0),__builtin_bit_cast(bf16x8,pw1),__builtin_bit_cast(bf16x8,pw2),__builtin_bit_cast(bf16x8,pw3));
      done=__all(R>=151.f)!=0;
    }
    if(lane==0)flags[wid]=done?1u:0u;
    asm volatile("s_waitcnt lgkmcnt(0)\n\ts_barrier":::"memory");
    unsigned alld=1u;
    #pragma unroll
    for(int w=0;w<NW;++w)alld&=flags[w];
    slot^=SLOTB;
    if(alld)break;
  }
  asm volatile("s_waitcnt vmcnt(0)":::"memory");
  bf16*Ow=O+(rowbase+q0+wid*QBLK)*DMO;
  { bf16*stg=(bf16*)(shm+LDS_OST)+wid*2048;
    #pragma unroll
    for(int r=0;r<16;++r){const int orow=crow(r,hi);
      #pragma unroll
      for(int d0=0;d0<2;++d0)stg[orow*64+d0*32+r32]=__float2bfloat16(o[d0][r]);}
    asm volatile("s_waitcnt lgkmcnt(0)":::"memory");
    #pragma unroll
    for(int i=0;i<4;++i){const int row=i*8+(lane>>3),ch=lane&7; const u32x4 v=*(const u32x4*)(stg+row*64+ch*8); ATTN_STORE16(Ow+(long)row*DMO+ch*8,head_rms(v));} }
  asm volatile("s_waitcnt vmcnt(0) lgkmcnt(0)\n\ts_barrier":::"memory");
  #undef DMA_K
  #undef DMA_V
}
#undef SBAR
#undef WAIT_BAR
}
namespace cg = cooperative_groups;
constexpr int NWAVES = 8;
constexpr int DMODEL = 1024, NBATCH = 4, SEQ_IN = 8192, NMETA = 16, LREAL = NMETA + SEQ_IN, LP = 8448  ;
constexpr int MROWS = NBATCH * LP;
constexpr int INW = 2566, NINP = 2560, NIN = 2816, DFF = 2816, NGU = 2 * DFF, DEPTH = 2, NFH = 6;
constexpr float C2F = 0.125f * 1.4426950408889634f;
constexpr int PC_U = 0, PC_FQ = 256, PC_FK = 640, PC_FV = 1024, PC_SQ = 1408, PC_SK = 1792, PC_SV = 2176;
constexpr size_t MiB = 1u << 20;
constexpr size_t WS_CTL = 0, CTL_ZERO_BYTES = 1 * MiB;
constexpr size_t WS_SS = 64 * 1024;
constexpr size_t WS_W = 1 * MiB, W_LAYER = 24 * MiB, W_IN = 0, W_OUT = (size_t)NIN * 1024 * 2, W_GU = W_OUT + 2 * MiB, W_D = W_GU + (size_t)NGU * 1024 * 2;
constexpr size_t WS_LF = 49 * MiB, WS_CS = 51 * MiB, WS_H = 52 * MiB, WS_HB = 184 * MiB, WS_Y = 250 * MiB, WS_P = 316 * MiB, WS_END = WS_P + (size_t)MROWS * DFF * 2;
static_assert(W_D + (size_t)1024 * DFF * 2 <= W_LAYER && WS_W + 2 * W_LAYER <= WS_LF && WS_SS + 5 * (size_t)MROWS * 4 <= CTL_ZERO_BYTES, "ws map");
static_assert(WS_H + (size_t)MROWS * 1024 * 4 <= WS_HB && WS_HB + (size_t)MROWS * 1024 * 2 <= WS_Y && WS_Y + (size_t)MROWS * 1024 * 2 <= WS_P && WS_END <= 512 * MiB, "ws map");
constexpr int LDS_BYTES = 147456;
constexpr int LDS_MISC = 131072;

#define LAS __attribute__((address_space(3)))
typedef unsigned short bf16u;
typedef unsigned v4u __attribute__((ext_vector_type(4)));
typedef float f32x4 __attribute__((ext_vector_type(4)));
#define LDS_WAIT() asm volatile("s_waitcnt lgkmcnt(0)" ::: "memory")
__device__ __forceinline__ unsigned f2bf(float f) { unsigned u = __builtin_bit_cast(unsigned, f); return (u + 0x7fffu + ((u >> 16) & 1u)) >> 16; }
__device__ __forceinline__ unsigned pk2(float lo, float hi) { return f2bf(lo) | (f2bf(hi) << 16); }
__device__ __forceinline__ float wave_sum(float v) {
#pragma unroll
    for (int o = 1; o < 64; o <<= 1) v += __shfl_xor(v, o);
    return v;
}

struct Args { const float* in[15]; float* out; unsigned char* ws; };

struct WinSrc { const float* w; const float* g;
    __device__ __forceinline__ float operator()(int k, int n) const { if (n >= INW) return 0.f; const int col = n < 1408 ? n : (n < 2560 ? n + 6 : n - 2560 + 1408);
        const float sc = ((n >= PC_FQ && n < PC_FK) || (n >= PC_SQ && n < PC_SK)) ? C2F : 1.0f; return w[(size_t)k * INW + col] * g[k] * sc; } };
struct WoutSrc { const float* w; const float* fg; const float* sg;
    __device__ __forceinline__ float operator()(int k, int n) const { const float gn = k < 640 ? fg[k - 256] : sg[k - 640]; return w[(size_t)k * 1024 + n] * gn; } };
struct WguSrc { const float* wg; const float* wu; const float* g;
    __device__ __forceinline__ float operator()(int k, int c) const { const int pn = c >> 8, w = c & 255, j = pn * 128 + (w & 127); const long dlt = (w >> 7) ? (long)(wu - wg) : 0L; return wg[(long)k * DFF + j + dlt] * g[k]; } };
struct WdSrc { const float* w;
    __device__ __forceinline__ float operator()(int k, int n) const { return w[(size_t)k * 1024 + n]; } };
template <class F> __device__ __forceinline__ void conv_item(const F src, bf16u* WT, int K, int k0, int n0, LAS float* scr, int lane) {
#pragma unroll 4
    for (int i = 0; i < 32; ++i) { const int kk = 2 * i + (lane >> 5); scr[kk * 33 + (lane & 31)] = src(k0 + kk, n0 + (lane & 31)); }
    LDS_WAIT(); asm volatile("" ::: "memory");
    const int c = lane & 7;
#pragma unroll
    for (int j = 0; j < 4; ++j) { const int n = (lane >> 3) + 8 * j; const LAS float* s = scr + (8 * c) * 33 + n;
        v4u o; o.x = pk2(s[0 * 33], s[1 * 33]); o.y = pk2(s[2 * 33], s[3 * 33]); o.z = pk2(s[4 * 33], s[5 * 33]); o.w = pk2(s[6 * 33], s[7 * 33]);
        *(v4u*)(WT + (size_t)(n0 + n) * K + k0 + 8 * c) = o; }
    LDS_WAIT(); asm volatile("" ::: "memory");
}
__device__ __forceinline__ void fold_item(const float* wout, const float* pw, const float* ps, bf16u* WT, int item, int lane) {
    const int g = item >> 4, n = (item & 15) * 64 + lane;
    float acc[64];
#pragma unroll
    for (int c = 0; c < 64; ++c) acc[c] = 0.f;
    for (int d = 0; d < 64; ++d) { const float wv = wout[(size_t)(g * 64 + d) * 1024 + n] * ps[g * 64 + d];
#pragma unroll
        for (int c = 0; c < 64; ++c) acc[c] += pw[(g * 64 + c) * 64 + d] * wv; }
    bf16u* o = WT + (size_t)n * 1024 + g * 64;
#pragma unroll
    for (int c = 0; c < 64; c += 8) { v4u w; w.x = pk2(acc[c], acc[c + 1]); w.y = pk2(acc[c + 2], acc[c + 3]); w.z = pk2(acc[c + 4], acc[c + 5]); w.w = pk2(acc[c + 6], acc[c + 7]); *(v4u*)(o + c) = w; }
}
__device__ __forceinline__ void p0_prologue(const Args& A, unsigned char* ws, LAS unsigned char* lds, int wave, int lane) {
    LAS float* scr = (LAS float*)(lds + wave * 16384);
    const int gw = blockIdx.x * NWAVES + wave, NGW = gridDim.x * NWAVES;
    constexpr int I_IN = 16 * (NIN / 32), I_OUT = 12 * 32, I_GU = 16 * (NGU / 32), I_D = (DFF / 64) * 32, I_F = 64, I_L = I_IN + I_OUT + I_GU + I_D + I_F;
    for (int it = gw; it < DEPTH * I_L; it += NGW) {
        const int L = it / I_L; int r = it % I_L;
        bf16u* wb = (bf16u*)(ws + WS_W + (size_t)L * W_LAYER);
        if (r < I_IN) { WinSrc s{A.in[3] + (size_t)L * 1024 * INW, A.in[2] + L * 1024}; conv_item(s, (bf16u*)((unsigned char*)wb + W_IN), 1024, (r / (NIN / 32)) * 64, (r % (NIN / 32)) * 32, scr, lane); continue; } r -= I_IN;
        if (r < I_OUT) { WoutSrc s{A.in[9] + (size_t)L * 1024 * 1024, A.in[7] + L * 384, A.in[8] + L * 384}; conv_item(s, (bf16u*)((unsigned char*)wb + W_OUT), 1024, 256 + (r / 32) * 64, (r % 32) * 32, scr, lane); continue; } r -= I_OUT;
        if (r < I_GU) { WguSrc s{A.in[11] + (size_t)L * 1024 * DFF, A.in[12] + (size_t)L * 1024 * DFF, A.in[10] + L * 1024}; conv_item(s, (bf16u*)((unsigned char*)wb + W_GU), 1024, (r / (NGU / 32)) * 64, (r % (NGU / 32)) * 32, scr, lane); continue; } r -= I_GU;
        if (r < I_D) { WdSrc s{A.in[13] + (size_t)L * DFF * 1024}; conv_item(s, (bf16u*)((unsigned char*)wb + W_D), DFF, (r / 32) * 64, (r % 32) * 32, scr, lane); continue; } r -= I_D;
        fold_item(A.in[9] + (size_t)L * 1024 * 1024, A.in[5] + (size_t)L * 4 * 64 * 64, A.in[6] + L * 256, (bf16u*)((unsigned char*)wb + W_OUT), r, lane);
    }
    float* h = (float*)(ws + WS_H); bf16u* hb = (bf16u*)(ws + WS_HB); float* ss0 = (float*)(ws + WS_SS);
    for (int m = gw; m < MROWS; m += NGW) {
        const int b = m / LP, t = m % LP;
        f32x4 v[4]; float s = 0.f;
        if (t < LREAL) { const f32x4* src = (const f32x4*)(t < NMETA ? A.in[1] + (size_t)t * 1024 : A.in[0] + ((size_t)b * SEQ_IN + (t - NMETA)) * 1024) + lane;
#pragma unroll
            for (int j = 0; j < 4; ++j) { v[j] = src[64 * j]; s += (v[j].x * v[j].x + v[j].y * v[j].y) + (v[j].z * v[j].z + v[j].w * v[j].w); } }
        else {
#pragma unroll
            for (int j = 0; j < 4; ++j) v[j] = (f32x4){0.f, 0.f, 0.f, 0.f}; }
        s = wave_sum(s);
        f32x4* ho = (f32x4*)(h + (size_t)m * 1024) + lane; unsigned long long* bo = (unsigned long long*)(hb + (size_t)m * 1024) + lane;
#pragma unroll
        for (int j = 0; j < 4; ++j) { ho[64 * j] = v[j]; bo[64 * j] = (unsigned long long)pk2(v[j].x, v[j].y) | ((unsigned long long)pk2(v[j].z, v[j].w) << 32); }
        if (lane == 0) ss0[m] = s;
    }
}
__device__ __forceinline__ void pool_scan_phase(unsigned char* ws, LAS unsigned char* lds, int tid, int wave, int lane) {
    const float* LF = (const float*)(ws + WS_LF); float* CS = (float*)(ws + WS_CS);
    if (blockIdx.x < NBATCH * NFH) {
        const int b = blockIdx.x / NFH, hf = blockIdx.x % NFH; constexpr int PER = 17;
        const float* lf = LF + (size_t)b * LP * 8 + hf; float* cs = CS + (size_t)(b * NFH + hf) * LP;
        float v[PER]; float s = 0.f; const int t0 = tid * PER;
#pragma unroll
        for (int i = 0; i < PER; ++i) { const int t = t0 + i; const float x = t < LP ? lf[(size_t)t * 8] : 0.f; s += x; v[i] = s; }
        float incl = s;
#pragma unroll
        for (int o = 1; o < 64; o <<= 1) { const float n = __shfl_up(incl, o); if (lane >= o) incl += n; }
        LAS float* wsum = (LAS float*)(lds + LDS_MISC + 256);
        if (lane == 63) wsum[wave] = incl;
        __syncthreads();
        float off = 0.f;
        for (int w = 0; w < wave; ++w) off += wsum[w];
        const float excl = off + incl - s;
#pragma unroll
        for (int i = 0; i < PER; ++i) { const int t = t0 + i; if (t < LP) cs[t] = excl + v[i]; }
        __syncthreads();
    }
    const bf16u* P = (const bf16u*)(ws + WS_P); bf16u* Y = (bf16u*)(ws + WS_Y);
    const int rsub = tid >> 5, ch = (tid & 31) * 8, win = 2 << (ch >> 6);
    for (int c = blockIdx.x; c < MROWS / 16; c += gridDim.x) {
        const int row = c * 16 + rsub, t = row % LP; const int cnt = (t + 1 < win) ? t + 1 : win;
        float acc[8], self[8];
#pragma unroll
        for (int e = 0; e < 8; ++e) acc[e] = 0.f;
        for (int j = 0; j < cnt; ++j) { const v4u w = *(const v4u*)(P + (size_t)(row - j) * NINP + PC_U + ch);
#pragma unroll
            for (int e = 0; e < 4; ++e) { const float lo = __uint_as_float(w[e] << 16), hi = __uint_as_float(w[e] & 0xffff0000u); acc[2 * e] += lo; acc[2 * e + 1] += hi; if (j == 0) { self[2 * e] = lo; self[2 * e + 1] = hi; } } }
        const float inv = 1.0f / (float)cnt; v4u o;
#pragma unroll
        for (int e = 0; e < 4; ++e) o[e] = pk2(acc[2 * e] * inv - self[2 * e], acc[2 * e + 1] * inv - self[2 * e + 1]);
        *(v4u*)(Y + (size_t)row * 1024 + ch) = o;
    }
}
__device__ __forceinline__ void attn_phase(unsigned char* ws, unsigned char* lds_g, unsigned* ctr, int tid) {
    const attn_body::bf16* P = (const attn_body::bf16*)(ws + WS_P); attn_body::bf16* Y = (attn_body::bf16*)(ws + WS_Y); const float* CS = (const float*)(ws + WS_CS);
    volatile LAS unsigned* bw = (volatile LAS unsigned*)((LAS unsigned char*)lds_g + LDS_MISC);
    constexpr int NU = NBATCH * NFH * (LP / 256);
    for (;;) {
        if (tid == 0) bw[0] = atomicAdd(ctr, 1u);
        __syncthreads();
        const int it = (int)bw[0];
        __syncthreads();
        if (it >= 2 * NU) break;
        const int r = it < NU ? it : it - NU; const int qb = (LP / 256 - 1) - r / (NBATCH * NFH), bh = r % (NBATCH * NFH), b = bh / NFH, h = bh % NFH;
#ifndef NO_FOX
        if (it < NU) attn_body::fox_unit<8>(b, qb, 0, P + PC_FQ + h * 64, P + PC_FK + h * 64, P + PC_FV + h * 64, Y + 256 + h * 64, CS + (size_t)bh * LP, (char*)lds_g);
#endif
#ifndef NO_SB
        if (it >= NU) attn_body::sb_unit(b, qb, P + PC_SQ + h * 64, P + PC_SK + h * 64, P + PC_SV + h * 64, Y + 640 + h * 64, (char*)lds_g);
#endif
    }
}
__device__ __forceinline__ void final_phase(const Args& A, unsigned char* ws, int wave, int lane) {
    const float* h = (const float*)(ws + WS_H); const float* ss = (const float*)(ws + WS_SS) + 4 * (size_t)MROWS; const f32x4* g = (const f32x4*)A.in[14] + lane;
    const int gw = blockIdx.x * NWAVES + wave, NGW = gridDim.x * NWAVES;
    f32x4 gv[4];
#pragma unroll
    for (int j = 0; j < 4; ++j) gv[j] = g[64 * j];
    for (int m = gw; m < NBATCH * SEQ_IN; m += NGW) {
        const int b = m / SEQ_IN, s = m % SEQ_IN; const size_t row = (size_t)b * LP + NMETA + s;
        const float rs = 1.0f / sqrtf(ss[row] * (1.0f / 1024.0f) + 1e-6f);
        const f32x4* src = (const f32x4*)(h + row * 1024) + lane; f32x4* dst = (f32x4*)(A.out + (size_t)m * 1024) + lane;
#pragma unroll
        for (int j = 0; j < 4; ++j) dst[64 * j] = src[64 * j] * rs * gv[j];
    }
}

#define FRESH() unsigned long zoff_ = 0; asm volatile("" : "+s"(zoff_)); unsigned char* ws = A.ws + zoff_; int tid = threadIdx.x; asm volatile("" : "+v"(tid)); const int lane = tid & 63, wave = __builtin_amdgcn_readfirstlane(tid >> 6); (void)lane; (void)wave
__global__ void __launch_bounds__(NWAVES * 64, 2) hymba_fwd(Args A) {
    extern __shared__ __attribute__((aligned(16))) unsigned char lds[];
    cg::grid_group grid = cg::this_grid();
    LAS unsigned char* L = (LAS unsigned char*)lds;
#ifndef NO_PRO
    { FRESH(); p0_prologue(A, ws, L, wave, lane); }
#endif
    grid.sync();
    for (int layer = 0; layer < DEPTH; ++layer) {
#ifndef NO_G1
        {
            FRESH(); const unsigned char* wb = ws + WS_W + (size_t)layer * W_LAYER;
            pg8::Gemm g{(const pg8::bf16_t*)(ws + WS_HB), (const pg8::bf16_t*)(wb + W_IN), MROWS, NIN, 1024}; pg8::StaticOrder S; S.init(MROWS, NIN, (int)gridDim.x, (int)blockIdx.x);
            pg8::EpiIn E{(pg8::bf16_t*)(ws + WS_P), (float*)(ws + WS_LF), (const float*)(ws + WS_SS) + (size_t)(2 * layer) * MROWS, A.in[4] + layer * NFH};
            pg8::gemm_phase<pg8::EpiIn, pg8::StaticOrder, true, true>(L, g, S, E);
        }
#endif
        grid.sync();
#ifndef NO_POOL
        { FRESH(); pool_scan_phase(ws, L, tid, wave, lane); }
#endif
        grid.sync();
        { FRESH(); attn_phase(ws, lds, (unsigned*)(ws + WS_CTL) + 64 * layer, tid); }
        grid.sync();
#ifndef NO_G3
        {
            FRESH(); const unsigned char* wb = ws + WS_W + (size_t)layer * W_LAYER;
            pg8::Gemm g{(const pg8::bf16_t*)(ws + WS_Y), (const pg8::bf16_t*)(wb + W_OUT), MROWS, 1024, 1024}; pg8::StaticOrder S; S.init(MROWS, 1024, (int)gridDim.x, (int)blockIdx.x);
            pg8::EpiRes E{(float*)(ws + WS_H), (pg8::bf16_t*)(ws + WS_HB), (float*)(ws + WS_SS) + (size_t)(2 * layer + 1) * MROWS};
            pg8::gemm_phase<pg8::EpiRes, pg8::StaticOrder, true, true>(L, g, S, E);
        }
#endif
        grid.sync();
#ifndef NO_G4
        {
            FRESH(); const unsigned char* wb = ws + WS_W + (size_t)layer * W_LAYER;
            pg8::Gemm g{(const pg8::bf16_t*)(ws + WS_HB), (const pg8::bf16_t*)(wb + W_GU), MROWS, NGU, 1024}; pg8::StaticOrder S; S.init(MROWS, NGU, (int)gridDim.x, (int)blockIdx.x);
            pg8::EpiGU E{(pg8::bf16_t*)(ws + WS_P), (const float*)(ws + WS_SS) + (size_t)(2 * layer + 1) * MROWS};
            pg8::gemm_phase<pg8::EpiGU, pg8::StaticOrder, true, true>(L, g, S, E);
        }
#endif
        grid.sync();
#ifndef NO_G5
        {
            FRESH(); const unsigned char* wb = ws + WS_W + (size_t)layer * W_LAYER;
            pg8::Gemm g{(const pg8::bf16_t*)(ws + WS_P), (const pg8::bf16_t*)(wb + W_D), MROWS, 1024, DFF}; pg8::StaticOrder S; S.init(MROWS, 1024, (int)gridDim.x, (int)blockIdx.x);
            pg8::EpiRes E{(float*)(ws + WS_H), (pg8::bf16_t*)(ws + WS_HB), (float*)(ws + WS_SS) + (size_t)(2 * layer + 2) * MROWS};
            pg8::gemm_phase<pg8::EpiRes, pg8::StaticOrder, true, true>(L, g, S, E);
        }
#endif
        grid.sync();
    }
    { FRESH(); final_phase(A, ws, wave, lane); }
}

extern "C" void kernel_launch(void* const* d_in, const int* in_sizes, int n_in, void* d_out, int out_size, void* d_ws, size_t ws_size, hipStream_t stream) {
    static int grid = 0;
    if (grid == 0) {
        if (n_in != 15 || out_size != NBATCH * SEQ_IN * DMODEL || ws_size < WS_END) { fprintf(stderr, "kernel_launch: unexpected shapes (n_in %d out %d ws %zu, need %zu)\n", n_in, out_size, ws_size, (size_t)WS_END); grid = -1; return; }
        int dev = 0, cus = 0, per_cu = 0;
        if (hipGetDevice(&dev) != hipSuccess || hipDeviceGetAttribute(&cus, hipDeviceAttributeMultiprocessorCount, dev) != hipSuccess) { grid = -1; return; }
        if (hipFuncSetAttribute((const void*)hymba_fwd, hipFuncAttributeMaxDynamicSharedMemorySize, LDS_BYTES) != hipSuccess) { fprintf(stderr, "kernel_launch: hipFuncSetAttribute failed\n"); grid = -1; return; }
        if (hipOccupancyMaxActiveBlocksPerMultiprocessor(&per_cu, (const void*)hymba_fwd, NWAVES * 64, LDS_BYTES) != hipSuccess || per_cu < 1) { fprintf(stderr, "kernel_launch: occupancy query says %d\n", per_cu); per_cu = 1; }
        (void)hipGetLastError();
        grid = cus;
    }
    if (grid < 0) return;
    if (hipMemsetAsync((char*)d_ws + WS_CTL, 0, CTL_ZERO_BYTES, stream) != hipSuccess) { fprintf(stderr, "kernel_launch: memset failed\n"); return; }
    Args a{};
    for (int i = 0; i < 15; ++i) a.in[i] = (const float*)d_in[i];
    a.out = (float*)d_out; a.ws = (unsigned char*)d_ws;
    void* args[] = {&a};
    const hipError_t e = hipLaunchCooperativeKernel((const void*)hymba_fwd, dim3(grid), dim3(NWAVES * 64), args, LDS_BYTES, stream);
    if (e != hipSuccess) fprintf(stderr, "kernel_launch: cooperative launch failed: %s (grid %d)\n", hipGetErrorString(e), grid);
}
```

```cpp
#include <hip/hip_runtime.h>
#include <hip/hip_cooperative_groups.h>
#include <cstdio>
#include <cstdint>
namespace pg8 {
#define PG8_LAS __attribute__((address_space(3)))
typedef unsigned short bf16_t;
typedef short bf16x8 __attribute__((ext_vector_type(8)));
typedef float f32x4 __attribute__((ext_vector_type(4)));
typedef unsigned u32x4 __attribute__((ext_vector_type(4)));
constexpr int BM = 256, BK = 64, HALF = 128, HTB = HALF * BK * 2  , STAGE_BYTES = 8 * HTB, NXCD = 8, WGM = 8;

__host__ __device__ __forceinline__ int lds_byte(int r, int c) { const int st = (r >> 4) * 2 + (c >> 5), rr = r & 15, cc = c & 31, ob = rr * 64 + cc * 2; return st * 1024 + (ob ^ (((ob >> 9) & 1) << 5)); }
__host__ __device__ __forceinline__ void stage_rc(int b, int& R, int& C) { const int st = b / 1024, sb = b % 1024, swz = sb ^ (((sb >> 9) & 1) << 5); R = (st >> 1) * 16 + swz / 64; C = (st & 1) * 32 + (swz % 64) / 2; }
__host__ __device__ __forceinline__ int perm32(int rho) { const int n = rho >> 4, i = rho & 15; return 8 * (i >> 2) + 4 * n + (i & 3); }

struct Unit { int pm, pn; };
struct Gemm { const bf16_t* A; const bf16_t* Bt; int M, N, K; };

struct StaticOrder {
    int nM, nN, nwg, G, c;
    __host__ __device__ void init(int M, int N, int G_, int c_) { nM = M / BM; nN = N / BM; nwg = nM * nN; G = G_; c = c_; }
    __host__ __device__ bool next(int i, Unit& u) const {
        const long L = (long)i * G + c; if (L >= nwg) return false;
        int wgid = (int)L; { const int q = nwg / NXCD, r = nwg % NXCD, xcd = wgid % NXCD, off = wgid / NXCD; wgid = (xcd < r ? xcd * (q + 1) : r * (q + 1) + (xcd - r) * q) + off; }
        const int nig = WGM * nN, gid = wgid / nig, fm = gid * WGM, gsz = (nM - fm) < WGM ? (nM - fm) : WGM;
        u.pm = fm + ((wgid % nig) % gsz); u.pn = (wgid % nig) / gsz; return true;
    }
    __device__ __forceinline__ void a_ready(const Unit&) const {}
    __device__ __forceinline__ void done(const Unit&) const {}
};

__device__ __forceinline__ unsigned cvt_pk_bf16(float lo, float hi) { unsigned r; asm volatile("v_cvt_pk_bf16_f32 %0, %1, %2" : "=v"(r) : "v"(lo), "v"(hi)); return r; }
typedef unsigned u32x2 __attribute__((ext_vector_type(2)));
constexpr float RMS_EPS = 1e-6f;
struct EpiIn {
    static constexpr bool PERM = true, AFTER_DRAIN = false;
    bf16_t* P; float* LF; const float* ss; const float* fb;
    __device__ __forceinline__ void operator()(const f32x4 (&acc)[2][2][4][2], const Unit& u, int wr, int wc, int fr, int fq) const {
        const int row0 = u.pm * BM + wr * 64 + fr;
        if (u.pn < 10) {
            const int col0 = u.pn * BM + wc * 32 + 8 * fq;
#pragma unroll
            for (int ai = 0; ai < 2; ++ai)
#pragma unroll
                for (int m = 0; m < 4; ++m) { const int row = row0 + ai * HALF + m * 16; const float rs = __builtin_amdgcn_rsqf(ss[row] * (1.0f / 1024.0f) + RMS_EPS);
                    bf16_t* rowp = P + (size_t)row * 2560 + col0;
#pragma unroll
                    for (int bj = 0; bj < 2; ++bj) { const f32x4 v0 = acc[ai][bj][m][0] * rs, v1 = acc[ai][bj][m][1] * rs;
                        u32x4 w; w.x = cvt_pk_bf16(v0[0], v0[1]); w.y = cvt_pk_bf16(v0[2], v0[3]); w.z = cvt_pk_bf16(v1[0], v1[1]); w.w = cvt_pk_bf16(v1[2], v1[3]);
                        *(u32x4*)(rowp + bj * HALF) = w; } }
        } else if (wc == 0 && fq == 0) {
            float b[6];
#pragma unroll
            for (int j = 0; j < 6; ++j) b[j] = fb[j];
#pragma unroll
            for (int ai = 0; ai < 2; ++ai)
#pragma unroll
                for (int m = 0; m < 4; ++m) { const int row = row0 + ai * HALF + m * 16; const float rs = __builtin_amdgcn_rsqf(ss[row] * (1.0f / 1024.0f) + RMS_EPS);
                    const f32x4 v0 = acc[ai][0][m][0] * rs, v1 = acc[ai][0][m][1] * rs;
                    float x[6] = {v0[0] + b[0], v0[1] + b[1], v0[2] + b[2], v0[3] + b[3], v1[0] + b[4], v1[1] + b[5]};
                    float l[6];
#pragma unroll
                    for (int j = 0; j < 6; ++j) l[j] = -(fmaxf(-x[j], 0.f) + log1pf(expf(-fabsf(x[j])))) * 1.4426950408889634f;
                    *(f32x4*)(LF + (size_t)row * 8) = (f32x4){l[0], l[1], l[2], l[3]};
                    *(f32x4*)(LF + (size_t)row * 8 + 4) = (f32x4){l[4], l[5], 0.f, 0.f}; }
        }
    }
};
struct EpiRes {
    static constexpr bool PERM = true, AFTER_DRAIN = false;
    float* h; bf16_t* hb; float* ssn;
    __device__ __forceinline__ void operator()(const f32x4 (&acc)[2][2][4][2], const Unit& u, int wr, int wc, int fr, int fq) const {
        const int row0 = u.pm * BM + wr * 64 + fr, col0 = u.pn * BM + wc * 32 + 8 * fq;
#pragma unroll
        for (int ai = 0; ai < 2; ++ai)
#pragma unroll
            for (int m = 0; m < 4; ++m) { const int row = row0 + ai * HALF + m * 16; float* hp = h + (size_t)row * 1024 + col0; bf16_t* bp = hb + (size_t)row * 1024 + col0; float s = 0.f;
#pragma unroll
                for (int bj = 0; bj < 2; ++bj) { f32x4 a = *(const f32x4*)(hp + bj * HALF), b = *(const f32x4*)(hp + bj * HALF + 4);
                    a = a + acc[ai][bj][m][0]; b = b + acc[ai][bj][m][1];
                    *(f32x4*)(hp + bj * HALF) = a; *(f32x4*)(hp + bj * HALF + 4) = b;
                    s += (a[0] * a[0] + a[1] * a[1]) + (a[2] * a[2] + a[3] * a[3]) + (b[0] * b[0] + b[1] * b[1]) + (b[2] * b[2] + b[3] * b[3]);
                    u32x4 w; w.x = cvt_pk_bf16(a[0], a[1]); w.y = cvt_pk_bf16(a[2], a[3]); w.z = cvt_pk_bf16(b[0], b[1]); w.w = cvt_pk_bf16(b[2], b[3]);
                    *(u32x4*)(bp + bj * HALF) = w; }
                s += __shfl_xor(s, 16); s += __shfl_xor(s, 32);
                if (fq == 0) atomicAdd(ssn + row, s);
                asm volatile("" ::: "memory"); }
    }
};
struct EpiGU {
    static constexpr bool PERM = true, AFTER_DRAIN = false;
    bf16_t* H; const float* ss;
    __device__ __forceinline__ void operator()(const f32x4 (&acc)[2][2][4][2], const Unit& u, int wr, int wc, int fr, int fq) const {
        const int row0 = u.pm * BM + wr * 64 + fr, col0 = u.pn * HALF + wc * 32 + 8 * fq;
#pragma unroll
        for (int ai = 0; ai < 2; ++ai)
#pragma unroll
            for (int m = 0; m < 4; ++m) { const int row = row0 + ai * HALF + m * 16; const float rs = __builtin_amdgcn_rsqf(ss[row] * (1.0f / 1024.0f) + RMS_EPS);
                float o[8];
#pragma unroll
                for (int n = 0; n < 2; ++n)
#pragma unroll
                    for (int e = 0; e < 4; ++e) { const float g = acc[ai][0][m][n][e] * rs, up = acc[ai][1][m][n][e] * rs;
                        o[4 * n + e] = g * __builtin_amdgcn_rcpf(1.0f + __builtin_amdgcn_exp2f(-1.4426950408889634f * g)) * up; }
                u32x4 w; w.x = cvt_pk_bf16(o[0], o[1]); w.y = cvt_pk_bf16(o[2], o[3]); w.z = cvt_pk_bf16(o[4], o[5]); w.w = cvt_pk_bf16(o[6], o[7]);
                *(u32x4*)(H + (size_t)row * 2816 + col0) = w; }
    }
};
template <class Epi, class Sched, bool ALIGN_EPI = false, bool SP2 = false>
__device__ __forceinline__ void gemm_phase(PG8_LAS unsigned char* lds, const Gemm g, const Sched& S, const Epi& E) {
    int tid_ = threadIdx.x; asm volatile("" : "+v"(tid_));
    const int tid = tid_, wid = __builtin_amdgcn_readfirstlane(tid >> 6), lane = tid & 63, wr = wid >> 2, wc = wid & 3, fr = lane & 15, fq = lane >> 4;
    const int K = g.K, nt = K / BK;
    unsigned voffA[2], voffB[2];
#pragma unroll
    for (int i = 0; i < 2; ++i) { int R, C; stage_rc(tid * 16 + i * 8192, R, C); const int Rb = Epi::PERM ? ((R & ~31) + perm32(R & 31)) : R;
        voffA[i] = (unsigned)(R * K + C) * 2u; voffB[i] = (unsigned)(Rb * K + C) * 2u; }
    const size_t kstep = (size_t)(BK * 2);
    const size_t hstep = (size_t)HALF * K * 2;
    const size_t tstep = 2 * hstep;
    const unsigned ldsw = (unsigned)wid * 1024u;
    const int aoff = lds_byte(wr * 64 + fr, fq * 8), boff = lds_byte(wc * 32 + fr, fq * 8);
#define PG8_SA(b, h) (((b) * 2 + (h)) * HTB)
#define PG8_SB(b, h) ((4 + (b) * 2 + (h)) * HTB)
#define PG8_STAGE(bufoff, gbase, voff) do { _Pragma("unroll") for (int _i = 0; _i < 2; ++_i) \
        __builtin_amdgcn_global_load_lds((const unsigned*)((const char*)(gbase) + (voff)[_i]), (PG8_LAS unsigned*)(lds + (bufoff) + ldsw + _i * 8192), 16, 0, 0); } while (0)
#define PG8_LDA(dst, b, h) do { _Pragma("unroll") for (int m = 0; m < 4; ++m) _Pragma("unroll") for (int k = 0; k < 2; ++k) dst[m][k] = *(const PG8_LAS bf16x8*)(lds + PG8_SA(b, h) + aoff + m * 2048 + k * 1024); } while (0)
#define PG8_LDB(dst, b, h) do { _Pragma("unroll") for (int n = 0; n < 2; ++n) _Pragma("unroll") for (int k = 0; k < 2; ++k) dst[n][k] = *(const PG8_LAS bf16x8*)(lds + PG8_SB(b, h) + boff + n * 2048 + k * 1024); } while (0)
#define PG8_MMA(ai, bj, At, Bt) do { __builtin_amdgcn_s_setprio(1); _Pragma("unroll") for (int m = 0; m < 4; ++m) _Pragma("unroll") for (int n = 0; n < 2; ++n) _Pragma("unroll") for (int k = 0; k < 2; ++k) \
        acc[ai][bj][m][n] = __builtin_amdgcn_mfma_f32_16x16x32_bf16(Bt[n][k], At[m][k], acc[ai][bj][m][n], 0, 0, 0); __builtin_amdgcn_s_setprio(0); } while (0)
#define PG8_WAIT_V(n) asm volatile("s_waitcnt vmcnt(" #n ")" ::: "memory")
#define PG8_WAIT_L(n) asm volatile("s_waitcnt lgkmcnt(" #n ")" ::: "memory")
#define PG8_BAR __builtin_amdgcn_s_barrier()
#define PG8_SCHED __builtin_amdgcn_sched_barrier(0)
    Unit cur, nxt; int ui = 0;
    if (!S.next(0, cur)) return;
    f32x4 acc[2][2][4][2];
#pragma unroll
    for (int a = 0; a < 2; ++a)
#pragma unroll
        for (int b = 0; b < 2; ++b)
#pragma unroll
            for (int m = 0; m < 4; ++m)
#pragma unroll
                for (int n = 0; n < 2; ++n) acc[a][b][m][n] = (f32x4){0.f, 0.f, 0.f, 0.f};
    bf16x8 At[4][2], B0[2][2], B1[2][2];
    const char* cA = (const char*)g.A + (size_t)cur.pm * tstep; const char* cB = (const char*)g.Bt + (size_t)cur.pn * tstep;
    S.a_ready(cur);
    if constexpr (SP2) {
        PG8_STAGE(PG8_SB(0, 0), cB, voffB); PG8_STAGE(PG8_SB(0, 1), cB + hstep, voffB); PG8_STAGE(PG8_SA(0, 0), cA, voffA); PG8_STAGE(PG8_SA(0, 1), cA + hstep, voffA);
        if (wr == 1) PG8_BAR;
        PG8_WAIT_V(2); PG8_BAR;
        PG8_STAGE(PG8_SB(1, 0), cB + kstep, voffB); PG8_STAGE(PG8_SA(1, 0), cA + kstep, voffA); PG8_STAGE(PG8_SB(1, 1), cB + hstep + kstep, voffB);
        PG8_WAIT_V(6); PG8_BAR;
    } else {
        PG8_STAGE(PG8_SB(0, 0), cB, voffB); PG8_STAGE(PG8_SA(0, 0), cA, voffA); PG8_STAGE(PG8_SB(0, 1), cB + hstep, voffB); PG8_STAGE(PG8_SA(0, 1), cA + hstep, voffA);
        if (wr == 1) PG8_BAR;
        PG8_WAIT_V(4); PG8_BAR;
        PG8_STAGE(PG8_SB(1, 0), cB + kstep, voffB); PG8_STAGE(PG8_SA(1, 0), cA + kstep, voffA); PG8_STAGE(PG8_SB(1, 1), cB + hstep + kstep, voffB);
        PG8_WAIT_V(6); PG8_BAR;
    }
    for (;;) {
        const bool has_next = S.next(ui + 1, nxt);
        const char* nA = has_next ? (const char*)g.A + (size_t)nxt.pm * tstep : cA; const char* nB = has_next ? (const char*)g.Bt + (size_t)nxt.pn * tstep : cB;
        for (int t = 0; t < nt; t += 2) {
            const bool last = (t == nt - 2);
            const char* a1 = cA + (size_t)(t + 1) * kstep;
            const char* a2 = last ? nA : cA + (size_t)(t + 2) * kstep; const char* b2 = last ? nB : cB + (size_t)(t + 2) * kstep;
            const char* a3 = a2 + kstep; const char* b3 = b2 + kstep;
            if (last && has_next) S.a_ready(nxt);
            if constexpr (SP2) {
            PG8_LDB(B0, 0, 0); PG8_LDB(B1, 0, 1); PG8_SCHED; PG8_LDA(At, 0, 0); PG8_STAGE(PG8_SA(1, 1), a1 + hstep, voffA);
            PG8_WAIT_V(8); PG8_WAIT_L(0); PG8_BAR; PG8_MMA(0, 0, At, B0); PG8_MMA(0, 1, At, B1); PG8_BAR; PG8_SCHED;
            PG8_LDA(At, 0, 1); PG8_STAGE(PG8_SB(0, 0), b2, voffB); PG8_STAGE(PG8_SB(0, 1), b2 + hstep, voffB); PG8_STAGE(PG8_SA(0, 0), a2, voffA);
            PG8_WAIT_V(8); PG8_WAIT_L(0); PG8_BAR; PG8_MMA(1, 0, At, B0); PG8_MMA(1, 1, At, B1); PG8_BAR; PG8_SCHED;
            PG8_LDB(B0, 1, 0); PG8_LDB(B1, 1, 1); PG8_SCHED; PG8_LDA(At, 1, 0); PG8_STAGE(PG8_SA(0, 1), a2 + hstep, voffA);
            PG8_WAIT_V(8); PG8_WAIT_L(0); PG8_BAR; PG8_MMA(0, 0, At, B0); PG8_MMA(0, 1, At, B1); PG8_BAR; PG8_SCHED;
            PG8_LDA(At, 1, 1); PG8_STAGE(PG8_SB(1, 0), b3, voffB); PG8_STAGE(PG8_SB(1, 1), b3 + hstep, voffB); PG8_STAGE(PG8_SA(1, 0), a3, voffA);
            PG8_WAIT_V(8); PG8_WAIT_L(0); PG8_BAR; PG8_MMA(1, 0, At, B0); PG8_MMA(1, 1, At, B1); PG8_BAR; PG8_SCHED;
            } else {
            PG8_LDB(B0, 0, 0); PG8_SCHED; PG8_LDA(At, 0, 0); PG8_STAGE(PG8_SA(1, 1), a1 + hstep, voffA);
            PG8_WAIT_L(8); PG8_BAR; PG8_WAIT_L(0); PG8_MMA(0, 0, At, B0); PG8_BAR; PG8_SCHED;
            PG8_LDB(B1, 0, 1); PG8_STAGE(PG8_SB(0, 0), b2, voffB);
            PG8_BAR; PG8_WAIT_L(0); PG8_MMA(0, 1, At, B1); PG8_BAR;
            PG8_LDA(At, 0, 1); PG8_STAGE(PG8_SA(0, 0), a2, voffA);
            PG8_BAR; PG8_WAIT_L(0); PG8_MMA(1, 0, At, B0); PG8_BAR; PG8_SCHED;
            PG8_STAGE(PG8_SB(0, 1), b2 + hstep, voffB);
            PG8_WAIT_V(6); PG8_BAR; PG8_MMA(1, 1, At, B1); PG8_BAR;
            PG8_LDB(B0, 1, 0); PG8_SCHED; PG8_LDA(At, 1, 0); PG8_STAGE(PG8_SA(0, 1), a2 + hstep, voffA);
            PG8_WAIT_L(8); PG8_BAR; PG8_WAIT_L(0); PG8_MMA(0, 0, At, B0); PG8_BAR; PG8_SCHED;
            PG8_LDB(B1, 1, 1); PG8_STAGE(PG8_SB(1, 0), b3, voffB);
            PG8_BAR; PG8_WAIT_L(0); PG8_MMA(0, 1, At, B1); PG8_BAR;
            PG8_LDA(At, 1, 1); PG8_STAGE(PG8_SA(1, 0), a3, voffA);
            PG8_BAR; PG8_WAIT_L(0); PG8_MMA(1, 0, At, B0); PG8_BAR; PG8_SCHED;
            PG8_STAGE(PG8_SB(1, 1), b3 + hstep, voffB);
            PG8_WAIT_V(6); PG8_BAR; PG8_MMA(1, 1, At, B1); PG8_BAR;
            }
        }
        if constexpr (ALIGN_EPI) { if (wr == 0) PG8_BAR; }
        if constexpr (!Epi::AFTER_DRAIN) { E(acc, cur, wr, wc, fr, fq); S.done(cur); }
        if (!has_next) break;
#pragma unroll
        for (int a = 0; a < 2; ++a)
#pragma unroll
            for (int b = 0; b < 2; ++b)
#pragma unroll
                for (int m = 0; m < 4; ++m)
#pragma unroll
                    for (int n = 0; n < 2; ++n) acc[a][b][m][n] = (f32x4){0.f, 0.f, 0.f, 0.f};
        cur = nxt; cA = nA; cB = nB; ++ui;
        if constexpr (ALIGN_EPI) { if (wr == 1) PG8_BAR; }
    }
    PG8_WAIT_V(0);
    if constexpr (!ALIGN_EPI) { if (wr == 0) PG8_BAR; }
    PG8_BAR;
    if constexpr (Epi::AFTER_DRAIN) { E.fused(acc, cur, wr, wc, fr, fq, lds, wid, lane); S.done(cur); }
#undef PG8_SA
#undef PG8_SB
#undef PG8_STAGE
#undef PG8_LDA
#undef PG8_LDB
#undef PG8_MMA
#undef PG8_WAIT_V
#undef PG8_WAIT_L
#undef PG8_BAR
#undef PG8_SCHED
}
}
#include <hip/hip_bf16.h>
#include <cmath>
namespace attn_body {
using bf16=__hip_bfloat16;
using bf16x8=__attribute__((ext_vector_type(8)))short;
using s16x4=__attribute__((ext_vector_type(4)))short;
using f32x16=__attribute__((ext_vector_type(16)))float;
using u32x4=__attribute__((ext_vector_type(4)))unsigned;
constexpr int SEQ=8448,D=64,DM=2560,DMO=1024;
using f32x4=__attribute__((ext_vector_type(4)))float;
constexpr int NW=8,QBLK=32,QB=QBLK*NW,KVBLK=64,NQB=SEQ/QB;
constexpr int ATTN_UNIT_ROWS=QB;
__device__ __forceinline__ int crow(int r,int hi){return (r&3)+8*(r>>2)+4*hi;}
#define SBAR() __builtin_amdgcn_sched_barrier(0)
__device__ __forceinline__ void cmask(f32x16&p0,f32x16&p1,int jb,int qrel,int hi){
  const float NEG=-INFINITY; int kb=64*jb+4*hi;
  #pragma unroll
  for(int r=0;r<16;++r){int kv=kb+(r&3)+8*(r>>2); if(kv>qrel)p0[r]=NEG; if(kv+32>qrel)p1[r]=NEG;}
}

constexpr int NSLOT=3, SLOTB=8192;
constexpr int LDS_K=0, LDS_V=NSLOT*SLOTB, LDS_WS=2*NSLOT*SLOTB, LDS_OST=LDS_WS+NW*64*4, LDS_BYTES=LDS_OST+NW*4096, LDS_CS=LDS_BYTES, LDS_FLAGS=LDS_CS+SEQ*4, LDS_END=LDS_FLAGS+256;
constexpr float C2=0.125f*1.4426950408889634f;
__device__ __forceinline__ void glds16(const void*gsrc,unsigned lds_dst){unsigned keep;
  asm volatile("s_mov_b32 %0, m0\n\ts_mov_b32 m0, %2\n\ts_nop 0\n\tglobal_load_lds_dwordx4 %1, off\n\ts_mov_b32 m0, %0":"=&s"(keep):"v"(gsrc),"s"(lds_dst):"memory");}
__device__ __forceinline__ float max3f(float a,float b,float c){float r;asm("v_max3_f32 %0, %1, %2, %3":"=v"(r):"v"(a),"v"(b),"v"(c));return r;}
__device__ __forceinline__ float max2f(float a,float b){float r;asm("v_max_f32_e32 %0, %1, %2":"=v"(r):"v"(a),"v"(b));return r;}
__device__ __forceinline__ float fadd_s(float a,float b){float r;asm("v_add_f32_e32 %0, %1, %2":"=v"(r):"v"(a),"v"(b));return r;}
__device__ __forceinline__ float fsub_s(float a,float b){float r;asm("v_sub_f32_e32 %0, %1, %2":"=v"(r):"v"(a),"v"(b));return r;}
typedef float f32x2_t __attribute__((ext_vector_type(2))); typedef __bf16 bf16x2_t __attribute__((ext_vector_type(2)));
__device__ __forceinline__ unsigned cvtpk_s(float lo,float hi){f32x2_t v={lo,hi};bf16x2_t b=__builtin_convertvector(v,bf16x2_t);return __builtin_bit_cast(unsigned,b);}
#define WAIT_BAR(N) asm volatile("s_waitcnt vmcnt(" #N ") lgkmcnt(0)\n\ts_barrier":::"memory")

__device__ __forceinline__ void qkt(f32x16&p0,f32x16&p1,const char*Kslot,const bf16x8*qr,int r32,int hi){
  const char*kb=Kslot+hi*1024+r32*16;
  #pragma unroll
  for(int d0=0;d0<4;++d0){
    const bf16x8 b0=*reinterpret_cast<const bf16x8*>(kb+d0*2048);
    const bf16x8 b1=*reinterpret_cast<const bf16x8*>(kb+d0*2048+512);
    {p0=__builtin_amdgcn_mfma_f32_32x32x16_bf16(b0,qr[d0],p0,0,0,0);p1=__builtin_amdgcn_mfma_f32_32x32x16_bf16(b1,qr[d0],p1,0,0,0);}}
}
typedef __attribute__((address_space(3))) const char* lds_cptr;
typedef short v4i16_t __attribute__((ext_vector_type(4)));
__device__ __forceinline__ void kload8(bf16x8*kf,lds_cptr kp){
  kf[0]=*(const __attribute__((address_space(3))) bf16x8*)(kp);      kf[1]=*(const __attribute__((address_space(3))) bf16x8*)(kp+512);
  kf[2]=*(const __attribute__((address_space(3))) bf16x8*)(kp+2048); kf[3]=*(const __attribute__((address_space(3))) bf16x8*)(kp+2560);
  kf[4]=*(const __attribute__((address_space(3))) bf16x8*)(kp+4096); kf[5]=*(const __attribute__((address_space(3))) bf16x8*)(kp+4608);
  kf[6]=*(const __attribute__((address_space(3))) bf16x8*)(kp+6144); kf[7]=*(const __attribute__((address_space(3))) bf16x8*)(kp+6656);
}
__device__ __forceinline__ void kload2(bf16x8*kf,lds_cptr kp,int j){ kf[2*j]=*(const __attribute__((address_space(3))) bf16x8*)(kp+j*2048); kf[2*j+1]=*(const __attribute__((address_space(3))) bf16x8*)(kp+j*2048+512); }
__device__ __forceinline__ s16x4 vtr(lds_cptr p){ return __builtin_bit_cast(s16x4,__builtin_amdgcn_ds_read_tr16_b64_v4i16((__attribute__((address_space(3))) v4i16_t*)p)); }
__device__ __forceinline__ float rowmax(const f32x16&p0,const f32x16&p1){
  float a=max3f(p0[0],p0[1],p1[0]),b=max3f(p0[2],p0[3],p1[1]);a=max3f(a,p1[2],p1[3]);
  #pragma unroll
  for(int r=4;r<16;r+=4){a=max3f(a,p0[r],p0[r+1]);b=max3f(b,p0[r+2],p0[r+3]);a=max3f(a,p1[r],p1[r+1]);b=max3f(b,p1[r+2],p1[r+3]);}
  const float m=max2f(a,b);
  auto rr=__builtin_amdgcn_permlane32_swap(__float_as_uint(m),__float_as_uint(m),false,false);
  return max2f(__uint_as_float(rr[0]),__uint_as_float(rr[1]));
}
__device__ __forceinline__ void pv(f32x16*o,int vb,bf16x8 pa0,bf16x8 pa1,bf16x8 pa2,bf16x8 pa3){
  #pragma unroll
  for(int d0=0;d0<2;++d0){s16x4 lo[4],hi[4];
    #pragma unroll
    for(int ks=0;ks<4;++ks){
      asm volatile("ds_read_b64_tr_b16 %0,%1 offset:%c2":"=&v"(lo[ks]):"v"(vb),"i"(d0*4096+ks*1024):"memory");
      asm volatile("ds_read_b64_tr_b16 %0,%1 offset:%c2":"=&v"(hi[ks]):"v"(vb),"i"(d0*4096+ks*1024+512):"memory");}
    asm volatile("s_waitcnt lgkmcnt(0)":::"memory");SBAR();
    #define PK(k) (bf16x8){lo[k][0],lo[k][1],lo[k][2],lo[k][3],hi[k][0],hi[k][1],hi[k][2],hi[k][3]}
    o[d0]=__builtin_amdgcn_mfma_f32_32x32x16_bf16(pa0,PK(0),o[d0],0,0,0);
    o[d0]=__builtin_amdgcn_mfma_f32_32x32x16_bf16(pa1,PK(1),o[d0],0,0,0);
    o[d0]=__builtin_amdgcn_mfma_f32_32x32x16_bf16(pa2,PK(2),o[d0],0,0,0);
    o[d0]=__builtin_amdgcn_mfma_f32_32x32x16_bf16(pa3,PK(3),o[d0],0,0,0);
    #undef PK
  }
}

__device__ __forceinline__ u32x4 head_rms(u32x4 v){ float x[8];
  #pragma unroll
  for(int i=0;i<4;++i){x[2*i]=__uint_as_float(v[i]<<16);x[2*i+1]=__uint_as_float(v[i]&0xffff0000u);}
  float s=0.f;
  #pragma unroll
  for(int i=0;i<8;++i)s+=x[i]*x[i];
  s+=__shfl_xor(s,1);s+=__shfl_xor(s,2);s+=__shfl_xor(s,4);
  const float rs=__builtin_amdgcn_rsqf(s*(1.0f/64.0f)+1e-6f); u32x4 w;
  #pragma unroll
  for(int i=0;i<4;++i)w[i]=cvtpk_s(x[2*i]*rs,x[2*i+1]*rs);
  return w; }
#ifndef ATTN_STORE16
#define ATTN_STORE16(p,v) (*(u32x4*)(p)=(v))
#endif
template<int THRL> __device__ __forceinline__ void fox_unit(int b,int qb,float dthr,const bf16*Q,const bf16*__restrict__ K,const bf16*__restrict__ V,bf16*O,const float*__restrict__ csg,char*shm){
  int tid_=threadIdx.x; asm volatile("":"+v"(tid_)); const int tid=tid_,lane=tid&63,r32=lane&31,hi=lane>>5; const int wid=__builtin_amdgcn_readfirstlane(tid>>6);
  const long rowbase=(long)b*SEQ; const int q0=qb*QB;
  const bf16*Qw=Q+(rowbase+q0+wid*QBLK)*DM;
  const unsigned lds0=(unsigned)(uintptr_t)shm; const lds_cptr shm3=(lds_cptr)shm;
  float*wsf=(float*)(shm+LDS_WS)+wid*64;
  const unsigned kdst=lds0+LDS_K+wid*1024, vdst=lds0+LDS_V+wid*1024;
  #define DMA_K(t,slot) glds16(ksrc+(long)(t)*KVBLK*DM,(unsigned)__builtin_amdgcn_readfirstlane(kdst+(slot)))
  #define DMA_V(t,slot) glds16(vsrc+(long)(t)*KVBLK*DM,(unsigned)__builtin_amdgcn_readfirstlane(vdst+(slot)))
  const int vb0=(int)(lds0+LDS_V)+((lane>>4)&1)*32+(lane&3)*8+(4*hi+((lane&15)>>2))*64;
  const char*Kbase=shm+LDS_K; bf16x8 kf[8];
  const lds_cptr kp0=shm3+LDS_K+hi*1024+r32*16; const lds_cptr vp0=shm3+LDS_V+((lane>>4)&1)*32+(lane&3)*8+(4*hi+((lane&15)>>2))*64;
  typedef __attribute__((address_space(3))) float lds_f32; typedef __attribute__((address_space(3))) f32x4 lds_f32x4;
  { lds_f32*cl=(lds_f32*)(shm3+LDS_CS); const int n_=q0+QB; for(int i_=tid*4;i_<n_;i_+=2048){ const f32x4 v_=*(const f32x4*)(csg+i_); *(lds_f32x4*)(cl+i_)=v_; } }
  asm volatile("s_waitcnt vmcnt(0) lgkmcnt(0)\n\ts_barrier":::"memory");
  int j0;
  { const lds_f32*cl=(const lds_f32*)(shm3+LDS_CS); const float cq0=cl[q0]; int lo_=0,hi_=4*qb;
    while(lo_<hi_){ const int mid_=(lo_+hi_)>>1; if(cl[64*mid_+63]-cq0>=dthr)lo_=mid_+1; else hi_=mid_; }
    j0=__builtin_amdgcn_readfirstlane(lo_)&~1; }
  const bf16*Kh=K+(rowbase+(long)j0*KVBLK)*DM,*Vh=V+(rowbase+(long)j0*KVBLK)*DM;
  const bf16*ksrc=Kh+(long)lane*DM+wid*8;
  const bf16*vsrc=Vh+(long)(16*(wid&3)+(lane>>2))*DM+(wid>>2)*32+(lane&3)*8;
  const int NT=(q0+QB)/KVBLK-j0;
  const lds_f32*cl3=(const lds_f32*)(shm3+LDS_CS)+64*j0;
  DMA_K(0,0);DMA_V(0,0);DMA_K(1,SLOTB);
  bf16x8 qr[4];
  #pragma unroll
  for(int d0=0;d0<4;++d0)qr[d0]=*reinterpret_cast<const bf16x8*>(&Qw[(long)r32*DM+d0*16+hi*8]);
  float base=0.f,l_reg=0.f;f32x16 o[2];o[0]=f32x16{};o[1]=f32x16{};
  #define CINIT(C0,C1,t) do{ const lds_f32*cp_=cl3+64*(t)+4*hi; \
    _Pragma("unroll") for(int g_=0;g_<4;++g_){ const f32x4 a_=*(const lds_f32x4*)(cp_+8*g_), b_=*(const lds_f32x4*)(cp_+32+8*g_); \
      C0[4*g_]=base-a_[0];C0[4*g_+1]=base-a_[1];C0[4*g_+2]=base-a_[2];C0[4*g_+3]=base-a_[3]; \
      C1[4*g_]=base-b_[0];C1[4*g_+1]=base-b_[1];C1[4*g_+2]=base-b_[2];C1[4*g_+3]=base-b_[3]; } }while(0)
  const int qrel=wid*QBLK+r32;
  #define CMASK(P0,P1,t) do{int jb_=(t)-(NT-4); if(jb_>=0)cmask(P0,P1,jb_,qrel,hi);}while(0)
  bool resc=false;
  #define START(P0,P1) do{ const float rm=rowmax(P0,P1); resc=false; \
    { const float dl=rm; base=fsub_s(base,dl); \
      _Pragma("unroll") for(int r=0;r<16;++r){P0[r]=fsub_s(P0[r],dl);P1[r]=fsub_s(P1[r],dl);} } \
    _Pragma("unroll") for(int r=0;r<16;++r)P0[r]=__builtin_amdgcn_exp2f(P0[r]); }while(0)
  #define RESC() do{ if(resc){ asm volatile("s_waitcnt lgkmcnt(0)":::"memory"); \
      _Pragma("unroll") for(int d_=0;d_<2;++d_) _Pragma("unroll") for(int r=0;r<16;++r)o[d_][r]*=wsf[crow(r,hi)]; } }while(0)
  f32x16 pA0,pA1,pB0,pB1;
  int sl_prev=0,sl_cur=0,sl_next=SLOTB;
  #define ROT() do{sl_prev=sl_cur;sl_cur=sl_next;sl_next=(sl_next==(NSLOT-1)*SLOTB)?0:sl_next+SLOTB;}while(0)
  DMA_K(2,2*SLOTB);
  WAIT_BAR(3);
  base=cl3[q0-64*j0+wid*QBLK+r32];
  CINIT(pA0,pA1,0); qkt(pA0,pA1,Kbase,qr,r32,hi);asm volatile("s_nop 15\n\ts_nop 7":"+v"(pA0),"+v"(pA1));CMASK(pA0,pA1,0);
  START(pA0,pA1);
  _Pragma("unroll") for(int r=0;r<16;++r)pA1[r]=__builtin_amdgcn_exp2f(pA1[r]);
  WAIT_BAR(0);
  DMA_K(3,0);DMA_V(1,SLOTB);
  ROT();
  kload8(kf,kp0+sl_cur);
  WAIT_BAR(2);
  s16x4 vlo[8],vhi[8]; u32x4 pw0,pw1,pw2,pw3;
  #define PKW(P,B) cvtpk_s(P[B],P[B+1])
  #define PAF(k) __builtin_bit_cast(bf16x8,pw##k)
  #define VFR(i) (bf16x8){vlo[i][0],vlo[i][1],vlo[i][2],vlo[i][3],vhi[i][0],vhi[i][1],vhi[i][2],vhi[i][3]}
  #define PIN(x) asm volatile("":"+v"(x))
  #define MX3(a,b,c) __builtin_fmaxf(__builtin_fmaxf((a),(b)),(c))
  #define GAPA(MF,A0,A1,A2,A3,W0,W1,PW) do{ MF; sacc+=A0; sacc+=A1; sacc+=A2; sacc+=A3; PIN(sacc); W0; W1; PIN(PW); SBAR(); }while(0)
  #define EX(v) __builtin_amdgcn_exp2f(v)
  #define GAPB(MF,X,B) do{ MF; X[B]=EX(X[B]); X[B+1]=EX(X[B+1]); X[B+2]=EX(X[B+2]); X[B+3]=EX(X[B+3]); PIN(X); SBAR(); }while(0)
  #define VRD(i) do{ vlo[i]=vtr(vp_+(((i)>>2)*4096+((i)&3)*1024)); vhi[i]=vtr(vp_+(((i)>>2)*4096+((i)&3)*1024+512)); }while(0)
  #define KRD(G,j) do{ if(G){ kload2(kf,kp0+sl_next,j); SBAR(); } }while(0)
  #define STEP(C0,C1,P0,P1,t,GK,GV,GL) do{ SBAR(); CINIT(C0,C1,t); SBAR(); \
    const lds_cptr vp_=vp0+sl_prev; \
    VRD(0); SBAR(); float sacc=(P0[0]+P0[1]); \
    GAPA(C0=__builtin_amdgcn_mfma_f32_32x32x16_bf16(kf[0],qr[0],C0,0,0,0), P0[2],P0[3],P0[4],P0[5],     pw0[0]=PKW(P0,0), pw0[1]=PKW(P0,2), pw0); \
    VRD(4); SBAR(); GAPA(C1=__builtin_amdgcn_mfma_f32_32x32x16_bf16(kf[1],qr[0],C1,0,0,0), P0[6],P0[7],P0[8],P0[9],     pw0[2]=PKW(P0,4), pw0[3]=PKW(P0,6), pw0); \
    VRD(1); SBAR(); GAPA(C0=__builtin_amdgcn_mfma_f32_32x32x16_bf16(kf[2],qr[1],C0,0,0,0),   P0[10],P0[11],P0[12],P0[13], pw1[0]=PKW(P0,8), pw1[1]=PKW(P0,10), pw1); \
    VRD(5); SBAR(); GAPA(C1=__builtin_amdgcn_mfma_f32_32x32x16_bf16(kf[3],qr[1],C1,0,0,0),   P0[14],P0[15],P1[0],P1[1],   pw1[2]=PKW(P0,12),pw1[3]=PKW(P0,14), pw1); \
    VRD(2); SBAR(); GAPA(C0=__builtin_amdgcn_mfma_f32_32x32x16_bf16(kf[4],qr[2],C0,0,0,0),   P1[2],P1[3],P1[4],P1[5],     pw2[0]=PKW(P1,0), pw2[1]=PKW(P1,2), pw2); \
    VRD(6); SBAR(); GAPA(C1=__builtin_amdgcn_mfma_f32_32x32x16_bf16(kf[5],qr[2],C1,0,0,0),   P1[6],P1[7],P1[8],P1[9],     pw2[2]=PKW(P1,4), pw2[3]=PKW(P1,6), pw2); \
    VRD(3); SBAR(); GAPA(C0=__builtin_amdgcn_mfma_f32_32x32x16_bf16(kf[6],qr[3],C0,0,0,0),   P1[10],P1[11],P1[12],P1[13], pw3[0]=PKW(P1,8), pw3[1]=PKW(P1,10), pw3); \
    VRD(7); SBAR(); GAPA(C1=__builtin_amdgcn_mfma_f32_32x32x16_bf16(kf[7],qr[3],C1,0,0,0),   P1[14],P1[15],0.f,0.f,       pw3[2]=PKW(P1,12),pw3[3]=PKW(P1,14), pw3); \
    l_reg+=sacc; \
    if(GK){DMA_K((t)+3,sl_cur);} if(GV){DMA_V((t)+1,sl_next);} \
    CMASK(C0,C1,t); \
    { float a=MX3(C0[0],C0[1],C1[0]),b=MX3(C0[2],C0[3],C1[1]); a=MX3(a,C1[2],C1[3]); \
      _Pragma("unroll") for(int r=4;r<16;r+=4){a=MX3(a,C0[r],C0[r+1]);b=MX3(b,C0[r+2],C0[r+3]);a=MX3(a,C1[r],C1[r+1]);b=MX3(b,C1[r+2],C1[r+3]);} \
      float rm=__builtin_fmaxf(a,b); { auto rr=__builtin_amdgcn_permlane32_swap(__float_as_uint(rm),__float_as_uint(rm),false,false); rm=__builtin_fmaxf(__uint_as_float(rr[0]),__uint_as_float(rr[1])); } \
      resc=false; \
      if(__builtin_expect(__any(rm>(float)THRL),0)){ const float dl=__builtin_fmaxf(rm,0.f); base-=dl; \
        _Pragma("unroll") for(int r=0;r<16;++r){C0[r]-=dl;C1[r]-=dl;} \
        const float f=__builtin_amdgcn_exp2f(-dl); l_reg*=f; if(hi==0)wsf[r32]=f; resc=true; } } \
    SBAR(); \
    GAPB(o[0]=__builtin_amdgcn_mfma_f32_32x32x16_bf16(PAF(0),VFR(0),o[0],0,0,0), C0,0); \
    GAPB(o[1]=__builtin_amdgcn_mfma_f32_32x32x16_bf16(PAF(0),VFR(4),o[1],0,0,0), C0,4); \
    KRD(GL,0); GAPB(o[0]=__builtin_amdgcn_mfma_f32_32x32x16_bf16(PAF(1),VFR(1),o[0],0,0,0), C0,8); \
    KRD(GL,1); GAPB(o[1]=__builtin_amdgcn_mfma_f32_32x32x16_bf16(PAF(1),VFR(5),o[1],0,0,0), C0,12); \
    KRD(GL,2); GAPB(o[0]=__builtin_amdgcn_mfma_f32_32x32x16_bf16(PAF(2),VFR(2),o[0],0,0,0), C1,0); \
    KRD(GL,3); GAPB(o[1]=__builtin_amdgcn_mfma_f32_32x32x16_bf16(PAF(2),VFR(6),o[1],0,0,0), C1,4); \
    GAPB(o[0]=__builtin_amdgcn_mfma_f32_32x32x16_bf16(PAF(3),VFR(3),o[0],0,0,0), C1,8); \
    GAPB(o[1]=__builtin_amdgcn_mfma_f32_32x32x16_bf16(PAF(3),VFR(7),o[1],0,0,0), C1,12); \
    }while(0)
  int t=1;
  #undef CMASK
  #define CMASK(P0,P1,t) do{}while(0)
  for(;t+5<NT;t+=2){
    STEP(pB0,pB1,pA0,pA1,t,true,true,true);     WAIT_BAR(2); RESC(); ROT();
    STEP(pA0,pA1,pB0,pB1,t+1,true,true,true);   WAIT_BAR(2); RESC(); ROT();
  }
  #undef CMASK
  #define CMASK(P0,P1,t) do{int jb_=(t)-(NT-4); if(jb_>=0)cmask(P0,P1,jb_,qrel,hi);}while(0)
  #define ENDW(tt) do{ if((tt)+3<NT){WAIT_BAR(2);} else if((tt)+2<NT){WAIT_BAR(1);} else {WAIT_BAR(0);} }while(0)
  for(;t+1<NT;t+=2){
    STEP(pB0,pB1,pA0,pA1,t,(t+3<NT),(t+1<NT),(t+1<NT));       ENDW(t);   RESC(); ROT();
    STEP(pA0,pA1,pB0,pB1,t+1,(t+4<NT),(t+2<NT),(t+2<NT));     ENDW(t+1); RESC(); ROT();
  }
  STEP(pB0,pB1,pA0,pA1,NT-1,false,false,false); RESC();
  { float sacc=pB0[0]+pB0[1]; _Pragma("unroll") for(int r=2;r<16;++r)sacc+=pB0[r]; _Pragma("unroll") for(int r=0;r<16;++r)sacc+=pB1[r]; l_reg+=sacc;
    pw0=(u32x4){PKW(pB0,0),PKW(pB0,2),PKW(pB0,4),PKW(pB0,6)};pw1=(u32x4){PKW(pB0,8),PKW(pB0,10),PKW(pB0,12),PKW(pB0,14)};pw2=(u32x4){PKW(pB1,0),PKW(pB1,2),PKW(pB1,4),PKW(pB1,6)};pw3=(u32x4){PKW(pB1,8),PKW(pB1,10),PKW(pB1,12),PKW(pB1,14)};
    SBAR(); pv(o,vb0+sl_cur,PAF(0),PAF(1),PAF(2),PAF(3)); }
  #undef PKW
  #undef PAF
  #undef VFR
  #undef PIN
  #undef MX3
  #undef GAPA
  #undef GAPB
  #undef EX
  #undef VRD
  #undef KRD
  #undef STEP
  #undef ENDW
  {auto rr=__builtin_amdgcn_permlane32_swap(__float_as_uint(l_reg),__float_as_uint(l_reg),false,false);l_reg=__uint_as_float(rr[0])+__uint_as_float(rr[1]);}
  if(hi==0)wsf[32+r32]=l_reg;asm volatile("s_waitcnt lgkmcnt(0)":::"memory");
  float rli[16];
  #pragma unroll
  for(int r=0;r<16;++r)rli[r]=__builtin_amdgcn_rcpf(wsf[32+crow(r,hi)]);
  bf16*Ow=O+(rowbase+q0+wid*QBLK)*DMO;
  { bf16*stg=(bf16*)(shm+LDS_OST)+wid*2048;
    #pragma unroll
    for(int r=0;r<16;++r){const int orow=crow(r,hi);
      #pragma unroll
      for(int d0=0;d0<2;++d0)stg[orow*64+d0*32+r32]=__float2bfloat16(o[d0][r]*rli[r]);}
    asm volatile("s_waitcnt lgkmcnt(0)":::"memory");
    #pragma unroll
    for(int i=0;i<4;++i){const int row=i*8+(lane>>3),ch=lane&7; const u32x4 v=*(const u32x4*)(stg+row*64+ch*8); ATTN_STORE16(Ow+(long)row*DMO+ch*8,head_rms(v));} }
  asm volatile("s_waitcnt lgkmcnt(0)\n\ts_barrier":::"memory");
  #undef DMA_K
  #undef DMA_V
  #undef CMASK
  #undef CINIT
  #undef START
  #undef RESC
  #undef ROT
}
__device__ __forceinline__ float sp2f(float z){ const float e=__builtin_amdgcn_exp2f(-__builtin_fabsf(z)); return __builtin_fmaxf(z,0.f)+__builtin_amdgcn_logf(1.f+e); }
__device__ __forceinline__ void sb_unit(int b,int qb,const bf16*Q,const bf16*__restrict__ K,const bf16*__restrict__ V,bf16*O,char*shm){
  int tid_=threadIdx.x; asm volatile("":"+v"(tid_)); const int tid=tid_,lane=tid&63,r32=lane&31,hi=lane>>5; const int wid=__builtin_amdgcn_readfirstlane(tid>>6);
  const long rowbase=(long)b*SEQ; const int q0=qb*QB;
  const bf16*Qw=Q+(rowbase+q0+wid*QBLK)*DM;
  const bf16*Kh=K+rowbase*DM,*Vh=V+rowbase*DM;
  const unsigned lds0=(unsigned)(uintptr_t)shm; const lds_cptr shm3=(lds_cptr)shm;
  const bf16*ksrc=Kh+(long)lane*DM+wid*8;
  const bf16*vsrc=Vh+(long)(16*(wid&3)+(lane>>2))*DM+(wid>>2)*32+(lane&3)*8;
  const unsigned kdst=lds0+LDS_K+wid*1024, vdst=lds0+LDS_V+wid*1024;
  #define DMA_K(t,slot) glds16(ksrc+(long)(t)*KVBLK*DM,(unsigned)__builtin_amdgcn_readfirstlane(kdst+(slot)))
  #define DMA_V(t,slot) glds16(vsrc+(long)(t)*KVBLK*DM,(unsigned)__builtin_amdgcn_readfirstlane(vdst+(slot)))
  const int vb0=(int)(lds0+LDS_V)+((lane>>4)&1)*32+(lane&3)*8+(4*hi+((lane&15)>>2))*64;
  typedef __attribute__((address_space(3))) unsigned lds_u32;
  volatile lds_u32*flags=(volatile lds_u32*)(shm3+LDS_FLAGS);
  bf16x8 qr[4];
  #pragma unroll
  for(int d0=0;d0<4;++d0)qr[d0]=*reinterpret_cast<const bf16x8*>(&Qw[(long)r32*DM+d0*16+hi*8]);
  asm volatile("":::"memory");
  f32x16 o[2];o[0]=f32x16{};o[1]=f32x16{};
  float R=0.f; const int qabs=q0+wid*QBLK+r32; bool done=false;
  const int jtop=4*qb+3;
  DMA_K(jtop,0);DMA_V(jtop,0);
  int slot=0;
  for(int j=jtop;j>=0;--j){
    if(j>0){ DMA_K(j-1,slot^SLOTB);DMA_V(j-1,slot^SLOTB); WAIT_BAR(2); } else { WAIT_BAR(0); }
    const bool active=(!done)&&(64*j<q0+wid*QBLK+31);
    if(active){
      f32x16 p0=f32x16{},p1=f32x16{};
      qkt(p0,p1,shm+LDS_K+slot,qr,r32,hi);
      const int kvb=64*j+4*hi; f32x16 s0,s1;
      #pragma unroll
      for(int r=0;r<16;++r){ const int kv=kvb+(r&3)+8*(r>>2); s0[r]=(kv<qabs)?sp2f(p0[r]):0.f; s1[r]=(kv+32<qabs)?sp2f(p1[r]):0.f; }
      float g0[4],g1[4],og0[4],og1[4],T0[4],T1[4];
      #pragma unroll
      for(int g=0;g<4;++g){ g0[g]=(s0[4*g]+s0[4*g+1])+(s0[4*g+2]+s0[4*g+3]); g1[g]=(s1[4*g]+s1[4*g+1])+(s1[4*g+2]+s1[4*g+3]); }
      #pragma unroll
      for(int g=0;g<4;++g){ og0[g]=__shfl_xor(g0[g],32); og1[g]=__shfl_xor(g1[g],32); }
      float run=R;
      #pragma unroll
      for(int g=3;g>=0;--g){ const float ah1=hi?g1[g]:og1[g], ah0=hi?og1[g]:g1[g]; const float t1=run; run+=ah1; const float t0=run; run+=ah0; T1[g]=hi?t1:t0; }
      #pragma unroll
      for(int g=3;g>=0;--g){ const float ah1=hi?g0[g]:og0[g], ah0=hi?og0[g]:g0[g]; const float t1=run; run+=ah1; const float t0=run; run+=ah0; T0[g]=hi?t1:t0; }
      R=run;
      #pragma unroll
      for(int g=0;g<4;++g){ float a0=T0[g],a1=T1[g];
        #pragma unroll
        for(int i=3;i>=0;--i){ const int r=4*g+i; const int kv=kvb+i+8*g; a0+=s0[r]; a1+=s1[r];
          p0[r]=(kv<qabs)?__builtin_amdgcn_exp2f(p0[r]-a0):0.f; p1[r]=(kv+32<qabs)?__builtin_amdgcn_exp2f(p1[r]-a1):0.f; } }
      u32x4 pw0,pw1,pw2,pw3;
      pw0=(u32x4){cvtpk_s(p0[0],p0[1]),cvtpk_s(p0[2],p0[3]),cvtpk_s(p0[4],p0[5]),cvtpk_s(p0[6],p0[7])};
      pw1=(u32x4){cvtpk_s(p0[8],p0[9]),cvtpk_s(p0[10],p0[11]),cvtpk_s(p0[12],p0[13]),cvtpk_s(p0[14],p0[15])};
      pw2=(u32x4){cvtpk_s(p1[0],p1[1]),cvtpk_s(p1[2],p1[3]),cvtpk_s(p1[4],p1[5]),cvtpk_s(p1[6],p1[7])};
      pw3=(u32x4){cvtpk_s(p1[8],p1[9]),cvtpk_s(p1[10],p1[11]),cvtpk_s(p1[12],p1[13]),cvtpk_s(p1[14],p1[15])};
      pv(o,vb0+slot,__builtin_bit_cast(bf16x8,pw0),__builtin_bit_cast(bf16x8,pw1),__builtin_bit_cast(bf16x8,pw2),__builtin_bit_cast(bf16x8,pw3));
      done=__all(R>=151.f)!=0;
    }
    if(lane==0)flags[wid]=done?1u:0u;
    asm volatile("s_waitcnt lgkmcnt(0)\n\ts_barrier":::"memory");
    unsigned alld=1u;
    #pragma unroll
    for(int w=0;w<NW;++w)alld&=flags[w];
    slot^=SLOTB;
    if(alld)break;
  }
  asm volatile("s_waitcnt vmcnt(0)":::"memory");
  bf16*Ow=O+(rowbase+q0+wid*QBLK)*DMO;
  { bf16*stg=(bf16*)(shm+LDS_OST)+wid*2048;
    #pragma unroll
    for(int r=0;r<16;++r){const int orow=crow(r,hi);
      #pragma unroll
      for(int d0=0;d0<2;++d0)stg[orow*64+d0*32+r32]=__float2bfloat16(o[d0][r]);}
    asm volatile("s_waitcnt lgkmcnt(0)":::"memory");
    #pragma unroll
    for(int i=0;i<4;++i){const int row=i*8+(lane>>3),ch=lane&7; const u32x4 v=*(const u32x4*)(stg+row*64+ch*8); ATTN_STORE16(Ow+(long)row*DMO+ch*8,head_rms(v));} }
  asm volatile("s_waitcnt vmcnt(0) lgkmcnt(0)\n\ts_barrier":::"memory");
  #undef DMA_K
  #undef DMA_V
}
#undef SBAR
#undef WAIT_BAR
}
namespace cg = cooperative_groups;
constexpr int NWAVES = 8;
constexpr int DMODEL = 1024, NBATCH = 4, SEQ_IN = 8192, NMETA = 16, LREAL = NMETA + SEQ_IN, LP = 8448  ;
constexpr int MROWS = NBATCH * LP;
constexpr int INW = 2566, NINP = 2560, NIN = 2816, DFF = 2816, NGU = 2 * DFF, DEPTH = 2, NFH = 6;
constexpr float C2F = 0.125f * 1.4426950408889634f;
constexpr int PC_U = 0, PC_FQ = 256, PC_FK = 640, PC_FV = 1024, PC_SQ = 1408, PC_SK = 1792, PC_SV = 2176;
constexpr size_t MiB = 1u << 20;
constexpr size_t WS_CTL = 0, CTL_ZERO_BYTES = 1 * MiB;
constexpr size_t WS_SS = 64 * 1024;
constexpr size_t WS_W = 1 * MiB, W_LAYER = 24 * MiB, W_IN = 0, W_OUT = (size_t)NIN * 1024 * 2, W_GU = W_OUT + 2 * MiB, W_D = W_GU + (size_t)NGU * 1024 * 2;
constexpr size_t WS_LF = 49 * MiB, WS_CS = 51 * MiB, WS_H = 52 * MiB, WS_HB = 184 * MiB, WS_Y = 250 * MiB, WS_P = 316 * MiB, WS_END = WS_P + (size_t)MROWS * DFF * 2;
static_assert(W_D + (size_t)1024 * DFF * 2 <= W_LAYER && WS_W + 2 * W_LAYER <= WS_LF && WS_SS + 5 * (size_t)MROWS * 4 <= CTL_ZERO_BYTES, "ws map");
static_assert(WS_H + (size_t)MROWS * 1024 * 4 <= WS_HB && WS_HB + (size_t)MROWS * 1024 * 2 <= WS_Y && WS_Y + (size_t)MROWS * 1024 * 2 <= WS_P && WS_END <= 512 * MiB, "ws map");
constexpr int LDS_BYTES = 147456;
constexpr int LDS_MISC = 131072;

#define LAS __attribute__((address_space(3)))
typedef unsigned short bf16u;
typedef unsigned v4u __attribute__((ext_vector_type(4)));
typedef float f32x4 __attribute__((ext_vector_type(4)));
#define LDS_WAIT() asm volatile("s_waitcnt lgkmcnt(0)" ::: "memory")
__device__ __forceinline__ unsigned f2bf(float f) { unsigned u = __builtin_bit_cast(unsigned, f); return (u + 0x7fffu + ((u >> 16) & 1u)) >> 16; }
__device__ __forceinline__ unsigned pk2(float lo, float hi) { return f2bf(lo) | (f2bf(hi) << 16); }
__device__ __forceinline__ float wave_sum(float v) {
#pragma unroll
    for (int o = 1; o < 64; o <<= 1) v += __shfl_xor(v, o);
    return v;
}

struct Args { const float* in[15]; float* out; unsigned char* ws; };

struct WinSrc { const float* w; const float* g;
    __device__ __forceinline__ float operator()(int k, int n) const { if (n >= INW) return 0.f; const int col = n < 1408 ? n : (n < 2560 ? n + 6 : n - 2560 + 1408);
        const float sc = ((n >= PC_FQ && n < PC_FK) || (n >= PC_SQ && n < PC_SK)) ? C2F : 1.0f; return w[(size_t)k * INW + col] * g[k] * sc; } };
struct WoutSrc { const float* w; const float* fg; const float* sg;
    __device__ __forceinline__ float operator()(int k, int n) const { const float gn = k < 640 ? fg[k - 256] : sg[k - 640]; return w[(size_t)k * 1024 + n] * gn; } };
struct WguSrc { const float* wg; const float* wu; const float* g;
    __device__ __forceinline__ float operator()(int k, int c) const { const int pn = c >> 8, w = c & 255, j = pn * 128 + (w & 127); const long dlt = (w >> 7) ? (long)(wu - wg) : 0L; return wg[(long)k * DFF + j + dlt] * g[k]; } };
struct WdSrc { const float* w;
    __device__ __forceinline__ float operator()(int k, int n) const { return w[(size_t)k * 1024 + n]; } };
template <class F> __device__ __forceinline__ void conv_item(const F src, bf16u* WT, int K, int k0, int n0, LAS float* scr, int lane) {
#pragma unroll 4
    for (int i = 0; i < 32; ++i) { const int kk = 2 * i + (lane >> 5); scr[kk * 33 + (lane & 31)] = src(k0 + kk, n0 + (lane & 31)); }
    LDS_WAIT(); asm volatile("" ::: "memory");
    const int c = lane & 7;
#pragma unroll
    for (int j = 0; j < 4; ++j) { const int n = (lane >> 3) + 8 * j; const LAS float* s = scr + (8 * c) * 33 + n;
        v4u o; o.x = pk2(s[0 * 33], s[1 * 33]); o.y = pk2(s[2 * 33], s[3 * 33]); o.z = pk2(s[4 * 33], s[5 * 33]); o.w = pk2(s[6 * 33], s[7 * 33]);
        *(v4u*)(WT + (size_t)(n0 + n) * K + k0 + 8 * c) = o; }
    LDS_WAIT(); asm volatile("" ::: "memory");
}
__device__ __forceinline__ void fold_item(const float* wout, const float* pw, const float* ps, bf16u* WT, int item, int lane) {
    const int g = item >> 4, n = (item & 15) * 64 + lane;
    float acc[64];
#pragma unroll
    for (int c = 0; c < 64; ++c) acc[c] = 0.f;
    for (int d = 0; d < 64; ++d) { const float wv = wout[(size_t)(g * 64 + d) * 1024 + n] * ps[g * 64 + d];
#pragma unroll
        for (int c = 0; c < 64; ++c) acc[c] += pw[(g * 64 + c) * 64 + d] * wv; }
    bf16u* o = WT + (size_t)n * 1024 + g * 64;
#pragma unroll
    for (int c = 0; c < 64; c += 8) { v4u w; w.x = pk2(acc[c], acc[c + 1]); w.y = pk2(acc[c + 2], acc[c + 3]); w.z = pk2(acc[c + 4], acc[c + 5]); w.w = pk2(acc[c + 6], acc[c + 7]); *(v4u*)(o + c) = w; }
}
__device__ __forceinline__ void p0_prologue(const Args& A, unsigned char* ws, LAS unsigned char* lds, int wave, int lane) {
    LAS float* scr = (LAS float*)(lds + wave * 16384);
    const int gw = blockIdx.x * NWAVES + wave, NGW = gridDim.x * NWAVES;
    constexpr int I_IN = 16 * (NIN / 32), I_OUT = 12 * 32, I_GU = 16 * (NGU / 32), I_D = (DFF / 64) * 32, I_F = 64, I_L = I_IN + I_OUT + I_GU + I_D + I_F;
    for (int it = gw; it < DEPTH * I_L; it += NGW) {
        const int L = it / I_L; int r = it % I_L;
        bf16u* wb = (bf16u*)(ws + WS_W + (size_t)L * W_LAYER);
        if (r < I_IN) { WinSrc s{A.in[3] + (size_t)L * 1024 * INW, A.in[2] + L * 1024}; conv_item(s, (bf16u*)((unsigned char*)wb + W_IN), 1024, (r / (NIN / 32)) * 64, (r % (NIN / 32)) * 32, scr, lane); continue; } r -= I_IN;
        if (r < I_OUT) { WoutSrc s{A.in[9] + (size_t)L * 1024 * 1024, A.in[7] + L * 384, A.in[8] + L * 384}; conv_item(s, (bf16u*)((unsigned char*)wb + W_OUT), 1024, 256 + (r / 32) * 64, (r % 32) * 32, scr, lane); continue; } r -= I_OUT;
        if (r < I_GU) { WguSrc s{A.in[11] + (size_t)L * 1024 * DFF, A.in[12] + (size_t)L * 1024 * DFF, A.in[10] + L * 1024}; conv_item(s, (bf16u*)((unsigned char*)wb + W_GU), 1024, (r / (NGU / 32)) * 64, (r % (NGU / 32)) * 32, scr, lane); continue; } r -= I_GU;
        if (r < I_D) { WdSrc s{A.in[13] + (size_t)L * DFF * 1024}; conv_item(s, (bf16u*)((unsigned char*)wb + W_D), DFF, (r / 32) * 64, (r % 32) * 32, scr, lane); continue; } r -= I_D;
        fold_item(A.in[9] + (size_t)L * 1024 * 1024, A.in[5] + (size_t)L * 4 * 64 * 64, A.in[6] + L * 256, (bf16u*)((unsigned char*)wb + W_OUT), r, lane);
    }
    float* h = (float*)(ws + WS_H); bf16u* hb = (bf16u*)(ws + WS_HB); float* ss0 = (float*)(ws + WS_SS);
    for (int m = gw; m < MROWS; m += NGW) {
        const int b = m / LP, t = m % LP;
        f32x4 v[4]; float s = 0.f;
        if (t < LREAL) { const f32x4* src = (const f32x4*)(t < NMETA ? A.in[1] + (size_t)t * 1024 : A.in[0] + ((size_t)b * SEQ_IN + (t - NMETA)) * 1024) + lane;
#pragma unroll
            for (int j = 0; j < 4; ++j) { v[j] = src[64 * j]; s += (v[j].x * v[j].x + v[j].y * v[j].y) + (v[j].z * v[j].z + v[j].w * v[j].w); } }
        else {
#pragma unroll
            for (int j = 0; j < 4; ++j) v[j] = (f32x4){0.f, 0.f, 0.f, 0.f}; }
        s = wave_sum(s);
        f32x4* ho = (f32x4*)(h + (size_t)m * 1024) + lane; unsigned long long* bo = (unsigned long long*)(hb + (size_t)m * 1024) + lane;
#pragma unroll
        for (int j = 0; j < 4; ++j) { ho[64 * j] = v[j]; bo[64 * j] = (unsigned long long)pk2(v[j].x, v[j].y) | ((unsigned long long)pk2(v[j].z, v[j].w) << 32); }
        if (lane == 0) ss0[m] = s;
    }
}
__device__ __forceinline__ void pool_scan_phase(unsigned char* ws, LAS unsigned char* lds, unsigned* nrm, int tid, int wave, int lane) {
    const float* LF = (const float*)(ws + WS_LF); float* CS = (float*)(ws + WS_CS);
    if (blockIdx.x < NBATCH * NFH) {
        const int b = blockIdx.x / NFH, hf = blockIdx.x % NFH; constexpr int PER = 17;
        const float* lf = LF + (size_t)b * LP * 8 + hf; float* cs = CS + (size_t)(b * NFH + hf) * LP;
        float v[PER]; float s = 0.f; const int t0 = tid * PER;
#pragma unroll
        for (int i = 0; i < PER; ++i) { const int t = t0 + i; const float x = t < LP ? lf[(size_t)t * 8] : 0.f; s += x; v[i] = s; }
        float incl = s;
#pragma unroll
        for (int o = 1; o < 64; o <<= 1) { const float n = __shfl_up(incl, o); if (lane >= o) incl += n; }
        LAS float* wsum = (LAS float*)(lds + LDS_MISC + 256);
        if (lane == 63) wsum[wave] = incl;
        __syncthreads();
        float off = 0.f;
        for (int w = 0; w < wave; ++w) off += wsum[w];
        const float excl = off + incl - s;
#pragma unroll
        for (int i = 0; i < PER; ++i) { const int t = t0 + i; if (t < LP) cs[t] = excl + v[i]; }
        __syncthreads();
    }
    const bf16u* P = (const bf16u*)(ws + WS_P); bf16u* Y = (bf16u*)(ws + WS_Y);
    for (int sl = blockIdx.x; sl < 256; sl += gridDim.x) {
        if (tid < 480) { const int sub = tid / 96, task = tid % 96, which = task / 48, head = (task % 48) >> 3, chunk = task & 7; const int r0 = sl * (MROWS / 256), b = r0 / LP;
            const bf16u* src = P + (which ? PC_FK : PC_FQ) + head * 64 + chunk * 8; float mx = 0.f;
            for (int r = sub; r < MROWS / 256; r += 5) { const v4u w = *(const v4u*)(src + (size_t)(r0 + r) * NINP); float s = 0.f;
#pragma unroll
                for (int e = 0; e < 4; ++e) { const float lo = __uint_as_float(w[e] << 16), hi = __uint_as_float(w[e] & 0xffff0000u); s += lo * lo + hi * hi; }
                s += __shfl_xor(s, 1); s += __shfl_xor(s, 2); s += __shfl_xor(s, 4); mx = fmaxf(mx, s); }
            if (chunk == 0) atomicMax(nrm + (b * NFH + head) * 2 + which, __float_as_uint(mx)); }
    }
    const int rsub = tid >> 5, ch = (tid & 31) * 8, win = 2 << (ch >> 6);
    for (int c = blockIdx.x; c < MROWS / 16; c += gridDim.x) {
        const int row = c * 16 + rsub, t = row % LP; const int cnt = (t + 1 < win) ? t + 1 : win;
        float acc[8], self[8];
#pragma unroll
        for (int e = 0; e < 8; ++e) acc[e] = 0.f;
        for (int j = 0; j < cnt; ++j) { const v4u w = *(const v4u*)(P + (size_t)(row - j) * NINP + PC_U + ch);
#pragma unroll
            for (int e = 0; e < 4; ++e) { const float lo = __uint_as_float(w[e] << 16), hi = __uint_as_float(w[e] & 0xffff0000u); acc[2 * e] += lo; acc[2 * e + 1] += hi; if (j == 0) { self[2 * e] = lo; self[2 * e + 1] = hi; } } }
        const float inv = 1.0f / (float)cnt; v4u o;
#pragma unroll
        for (int e = 0; e < 4; ++e) o[e] = pk2(acc[2 * e] * inv - self[2 * e], acc[2 * e + 1] * inv - self[2 * e + 1]);
        *(v4u*)(Y + (size_t)row * 1024 + ch) = o;
    }
}
__device__ __forceinline__ void attn_phase(unsigned char* ws, unsigned char* lds_g, unsigned* ctr, const unsigned* nrm, int tid) {
    const attn_body::bf16* P = (const attn_body::bf16*)(ws + WS_P); attn_body::bf16* Y = (attn_body::bf16*)(ws + WS_Y); const float* CS = (const float*)(ws + WS_CS);
    volatile LAS unsigned* bw = (volatile LAS unsigned*)((LAS unsigned char*)lds_g + LDS_MISC);
    constexpr int NU = NBATCH * NFH * (LP / 256);
    for (;;) {
        if (tid == 0) bw[0] = atomicAdd(ctr, 1u);
        __syncthreads();
        const int it = (int)bw[0];
        __syncthreads();
        if (it >= 2 * NU) break;
        const int r = it < NU ? it : it - NU; const int qb = (LP / 256 - 1) - r / (NBATCH * NFH), bh = r % (NBATCH * NFH), b = bh / NFH, h = bh % NFH;
#ifndef NO_FOX
        if (it < NU) attn_body::fox_unit<8>(b, qb, 154.0f + 2.0f * sqrtf(__uint_as_float(nrm[bh * 2]) * __uint_as_float(nrm[bh * 2 + 1])), P + PC_FQ + h * 64, P + PC_FK + h * 64, P + PC_FV + h * 64, Y + 256 + h * 64, CS + (size_t)bh * LP, (char*)lds_g);
#endif
#ifndef NO_SB
        if (it >= NU) attn_body::sb_unit(b, qb, P + PC_SQ + h * 64, P + PC_SK + h * 64, P + PC_SV + h * 64, Y + 640 + h * 64, (char*)lds_g);
#endif
    }
}
__device__ __forceinline__ void final_phase(const Args& A, unsigned char* ws, int wave, int lane) {
    const float* h = (const float*)(ws + WS_H); const float* ss = (const float*)(ws + WS_SS) + 4 * (size_t)MROWS; const f32x4* g = (const f32x4*)A.in[14] + lane;
    const int gw = blockIdx.x * NWAVES + wave, NGW = gridDim.x * NWAVES;
    f32x4 gv[4];
#pragma unroll
    for (int j = 0; j < 4; ++j) gv[j] = g[64 * j];
    for (int m = gw; m < NBATCH * SEQ_IN; m += NGW) {
        const int b = m / SEQ_IN, s = m % SEQ_IN; const size_t row = (size_t)b * LP + NMETA + s;
        const float rs = 1.0f / sqrtf(ss[row] * (1.0f / 1024.0f) + 1e-6f);
        const f32x4* src = (const f32x4*)(h + row * 1024) + lane; f32x4* dst = (f32x4*)(A.out + (size_t)m * 1024) + lane;
#pragma unroll
        for (int j = 0; j < 4; ++j) dst[64 * j] = src[64 * j] * rs * gv[j];
    }
}

#define FRESH() unsigned long zoff_ = 0; asm volatile("" : "+s"(zoff_)); unsigned char* ws = A.ws + zoff_; int tid = threadIdx.x; asm volatile("" : "+v"(tid)); const int lane = tid & 63, wave = __builtin_amdgcn_readfirstlane(tid >> 6); (void)lane; (void)wave
__global__ void __launch_bounds__(NWAVES * 64, 2) hymba_fwd(Args A) {
    extern __shared__ __attribute__((aligned(16))) unsigned char lds[];
    cg::grid_group grid = cg::this_grid();
    LAS unsigned char* L = (LAS unsigned char*)lds;
#ifndef NO_PRO
    { FRESH(); p0_prologue(A, ws, L, wave, lane); }
#endif
    grid.sync();
    for (int layer = 0; layer < DEPTH; ++layer) {
#ifndef NO_G1
        {
            FRESH(); const unsigned char* wb = ws + WS_W + (size_t)layer * W_LAYER;
            pg8::Gemm g{(const pg8::bf16_t*)(ws + WS_HB), (const pg8::bf16_t*)(wb + W_IN), MROWS, NIN, 1024}; pg8::StaticOrder S; S.init(MROWS, NIN, (int)gridDim.x, (int)blockIdx.x);
            pg8::EpiIn E{(pg8::bf16_t*)(ws + WS_P), (float*)(ws + WS_LF), (const float*)(ws + WS_SS) + (size_t)(2 * layer) * MROWS, A.in[4] + layer * NFH};
            pg8::gemm_phase<pg8::EpiIn, pg8::StaticOrder, true, true>(L, g, S, E);
        }
#endif
        grid.sync();
#ifndef NO_POOL
        { FRESH(); pool_scan_phase(ws, L, (unsigned*)(ws + WS_CTL) + 128 + 64 * layer, tid, wave, lane); }
#endif
        grid.sync();
        { FRESH(); attn_phase(ws, lds, (unsigned*)(ws + WS_CTL) + 64 * layer, (const unsigned*)(ws + WS_CTL) + 128 + 64 * layer, tid); }
        grid.sync();
#ifndef NO_G3
        {
            FRESH(); const unsigned char* wb = ws + WS_W + (size_t)layer * W_LAYER;
            pg8::Gemm g{(const pg8::bf16_t*)(ws + WS_Y), (const pg8::bf16_t*)(wb + W_OUT), MROWS, 1024, 1024}; pg8::StaticOrder S; S.init(MROWS, 1024, (int)gridDim.x, (int)blockIdx.x);
            pg8::EpiRes E{(float*)(ws + WS_H), (pg8::bf16_t*)(ws + WS_HB), (float*)(ws + WS_SS) + (size_t)(2 * layer + 1) * MROWS};
            pg8::gemm_phase<pg8::EpiRes, pg8::StaticOrder, true, true>(L, g, S, E);
        }
#endif
        grid.sync();
#ifndef NO_G4
        {
            FRESH(); const unsigned char* wb = ws + WS_W + (size_t)layer * W_LAYER;
            pg8::Gemm g{(const pg8::bf16_t*)(ws + WS_HB), (const pg8::bf16_t*)(wb + W_GU), MROWS, NGU, 1024}; pg8::StaticOrder S; S.init(MROWS, NGU, (int)gridDim.x, (int)blockIdx.x);
            pg8::EpiGU E{(pg8::bf16_t*)(ws + WS_P), (const float*)(ws + WS_SS) + (size_t)(2 * layer + 1) * MROWS};
            pg8::gemm_phase<pg8::EpiGU, pg8::StaticOrder, true, true>(L, g, S, E);
        }
#endif
        grid.sync();
#ifndef NO_G5
        {
            FRESH(); const unsigned char* wb = ws + WS_W + (size_t)layer * W_LAYER;
            pg8::Gemm g{(const pg8::bf16_t*)(ws + WS_P), (const pg8::bf16_t*)(wb + W_D), MROWS, 1024, DFF}; pg8::StaticOrder S; S.init(MROWS, 1024, (int)gridDim.x, (int)blockIdx.x);
            pg8::EpiRes E{(float*)(ws + WS_H), (pg8::bf16_t*)(ws + WS_HB), (float*)(ws + WS_SS) + (size_t)(2 * layer + 2) * MROWS};
            pg8::gemm_phase<pg8::EpiRes, pg8::StaticOrder, true, true>(L, g, S, E);
        }
#endif
        grid.sync();
    }
    { FRESH(); final_phase(A, ws, wave, lane); }
}

extern "C" void kernel_launch(void* const* d_in, const int* in_sizes, int n_in, void* d_out, int out_size, void* d_ws, size_t ws_size, hipStream_t stream) {
    static int grid = 0;
    if (grid == 0) {
        if (n_in != 15 || out_size != NBATCH * SEQ_IN * DMODEL || ws_size < WS_END) { fprintf(stderr, "kernel_launch: unexpected shapes (n_in %d out %d ws %zu, need %zu)\n", n_in, out_size, ws_size, (size_t)WS_END); grid = -1; return; }
        int dev = 0, cus = 0, per_cu = 0;
        if (hipGetDevice(&dev) != hipSuccess || hipDeviceGetAttribute(&cus, hipDeviceAttributeMultiprocessorCount, dev) != hipSuccess) { grid = -1; return; }
        if (hipFuncSetAttribute((const void*)hymba_fwd, hipFuncAttributeMaxDynamicSharedMemorySize, LDS_BYTES) != hipSuccess) { fprintf(stderr, "kernel_launch: hipFuncSetAttribute failed\n"); grid = -1; return; }
        if (hipOccupancyMaxActiveBlocksPerMultiprocessor(&per_cu, (const void*)hymba_fwd, NWAVES * 64, LDS_BYTES) != hipSuccess || per_cu < 1) { fprintf(stderr, "kernel_launch: occupancy query says %d\n", per_cu); per_cu = 1; }
        (void)hipGetLastError();
        grid = cus;
    }
    if (grid < 0) return;
    if (hipMemsetAsync((char*)d_ws + WS_CTL, 0, CTL_ZERO_BYTES, stream) != hipSuccess) { fprintf(stderr, "kernel_launch: memset failed\n"); return; }
    Args a{};
    for (int i = 0; i < 15; ++i) a.in[i] = (const float*)d_in[i];
    a.out = (float*)d_out; a.ws = (unsigned char*)d_ws;
    void* args[] = {&a};
    const hipError_t e = hipLaunchCooperativeKernel((const void*)hymba_fwd, dim3(grid), dim3(NWAVES * 64), args, LDS_BYTES, stream);
    if (e != hipSuccess) fprintf(stderr, "kernel_launch: cooperative launch failed: %s (grid %d)\n", hipGetErrorString(e), grid);
}
```

```cpp
#include <hip/hip_runtime.h>
#include <hip/hip_cooperative_groups.h>
#include <cstdio>
#include <cstdint>
namespace pg8 {
#define PG8_LAS __attribute__((address_space(3)))
typedef unsigned short bf16_t;
typedef short bf16x8 __attribute__((ext_vector_type(8)));
typedef float f32x4 __attribute__((ext_vector_type(4)));
typedef unsigned u32x4 __attribute__((ext_vector_type(4)));
constexpr int BM = 256, BK = 64, HALF = 128, HTB = HALF * BK * 2  , STAGE_BYTES = 8 * HTB, NXCD = 8, WGM = 8;

__host__ __device__ __forceinline__ int lds_byte(int r, int c) { const int st = (r >> 4) * 2 + (c >> 5), rr = r & 15, cc = c & 31, ob = rr * 64 + cc * 2; return st * 1024 + (ob ^ (((ob >> 9) & 1) << 5)); }
__host__ __device__ __forceinline__ void stage_rc(int b, int& R, int& C) { const int st = b / 1024, sb = b % 1024, swz = sb ^ (((sb >> 9) & 1) << 5); R = (st >> 1) * 16 + swz / 64; C = (st & 1) * 32 + (swz % 64) / 2; }
__host__ __device__ __forceinline__ int perm32(int rho) { const int n = rho >> 4, i = rho & 15; return 8 * (i >> 2) + 4 * n + (i & 3); }

struct Unit { int pm, pn; };
struct Gemm { const bf16_t* A; const bf16_t* Bt; int M, N, K; };

struct StaticOrder {
    int nM, nN, nwg, G, c;
    __host__ __device__ void init(int M, int N, int G_, int c_) { nM = M / BM; nN = N / BM; nwg = nM * nN; G = G_; c = c_; }
    __host__ __device__ bool next(int i, Unit& u) const {
        const long L = (long)i * G + c; if (L >= nwg) return false;
        int wgid = (int)L; { const int q = nwg / NXCD, r = nwg % NXCD, xcd = wgid % NXCD, off = wgid / NXCD; wgid = (xcd < r ? xcd * (q + 1) : r * (q + 1) + (xcd - r) * q) + off; }
        const int nig = WGM * nN, gid = wgid / nig, fm = gid * WGM, gsz = (nM - fm) < WGM ? (nM - fm) : WGM;
        u.pm = fm + ((wgid % nig) % gsz); u.pn = (wgid % nig) / gsz; return true;
    }
    __device__ __forceinline__ void a_ready(const Unit&) const {}
    __device__ __forceinline__ void done(const Unit&) const {}
};

__device__ __forceinline__ unsigned cvt_pk_bf16(float lo, float hi) { unsigned r; asm volatile("v_cvt_pk_bf16_f32 %0, %1, %2" : "=v"(r) : "v"(lo), "v"(hi)); return r; }
typedef unsigned u32x2 __attribute__((ext_vector_type(2)));
constexpr float RMS_EPS = 1e-6f;
struct EpiIn {
    static constexpr bool PERM = true, AFTER_DRAIN = false;
    bf16_t* P; float* LF; const float* ss; const float* fb;
    __device__ __forceinline__ void operator()(const f32x4 (&acc)[2][2][4][2], const Unit& u, int wr, int wc, int fr, int fq) const {
        const int row0 = u.pm * BM + wr * 64 + fr;
        if (u.pn < 10) {
            const int col0 = u.pn * BM + wc * 32 + 8 * fq;
#pragma unroll
            for (int ai = 0; ai < 2; ++ai)
#pragma unroll
                for (int m = 0; m < 4; ++m) { const int row = row0 + ai * HALF + m * 16; const float rs = __builtin_amdgcn_rsqf(ss[row] * (1.0f / 1024.0f) + RMS_EPS);
                    bf16_t* rowp = P + (size_t)row * 2560 + col0;
#pragma unroll
                    for (int bj = 0; bj < 2; ++bj) { const f32x4 v0 = acc[ai][bj][m][0] * rs, v1 = acc[ai][bj][m][1] * rs;
                        u32x4 w; w.x = cvt_pk_bf16(v0[0], v0[1]); w.y = cvt_pk_bf16(v0[2], v0[3]); w.z = cvt_pk_bf16(v1[0], v1[1]); w.w = cvt_pk_bf16(v1[2], v1[3]);
                        *(u32x4*)(rowp + bj * HALF) = w; } }
        } else if (wc == 0 && fq == 0) {
            float b[6];
#pragma unroll
            for (int j = 0; j < 6; ++j) b[j] = fb[j];
#pragma unroll
            for (int ai = 0; ai < 2; ++ai)
#pragma unroll
                for (int m = 0; m < 4; ++m) { const int row = row0 + ai * HALF + m * 16; const float rs = __builtin_amdgcn_rsqf(ss[row] * (1.0f / 1024.0f) + RMS_EPS);
                    const f32x4 v0 = acc[ai][0][m][0] * rs, v1 = acc[ai][0][m][1] * rs;
                    float x[6] = {v0[0] + b[0], v0[1] + b[1], v0[2] + b[2], v0[3] + b[3], v1[0] + b[4], v1[1] + b[5]};
                    float l[6];
#pragma unroll
                    for (int j = 0; j < 6; ++j) l[j] = -(fmaxf(-x[j], 0.f) + log1pf(expf(-fabsf(x[j])))) * 1.4426950408889634f;
                    *(f32x4*)(LF + (size_t)row * 8) = (f32x4){l[0], l[1], l[2], l[3]};
                    *(f32x4*)(LF + (size_t)row * 8 + 4) = (f32x4){l[4], l[5], 0.f, 0.f}; }
        }
    }
};
struct EpiRes {
    static constexpr bool PERM = true, AFTER_DRAIN = false;
    float* h; bf16_t* hb; float* ssn;
    __device__ __forceinline__ void operator()(const f32x4 (&acc)[2][2][4][2], const Unit& u, int wr, int wc, int fr, int fq) const {
        const int row0 = u.pm * BM + wr * 64 + fr, col0 = u.pn * BM + wc * 32 + 8 * fq;
#pragma unroll
        for (int ai = 0; ai < 2; ++ai)
#pragma unroll
            for (int m = 0; m < 4; ++m) { const int row = row0 + ai * HALF + m * 16; float* hp = h + (size_t)row * 1024 + col0; bf16_t* bp = hb + (size_t)row * 1024 + col0; float s = 0.f;
#pragma unroll
                for (int bj = 0; bj < 2; ++bj) { f32x4 a = *(const f32x4*)(hp + bj * HALF), b = *(const f32x4*)(hp + bj * HALF + 4);
                    a = a + acc[ai][bj][m][0]; b = b + acc[ai][bj][m][1];
                    *(f32x4*)(hp + bj * HALF) = a; *(f32x4*)(hp + bj * HALF + 4) = b;
                    s += (a[0] * a[0] + a[1] * a[1]) + (a[2] * a[2] + a[3] * a[3]) + (b[0] * b[0] + b[1] * b[1]) + (b[2] * b[2] + b[3] * b[3]);
                    u32x4 w; w.x = cvt_pk_bf16(a[0], a[1]); w.y = cvt_pk_bf16(a[2], a[3]); w.z = cvt_pk_bf16(b[0], b[1]); w.w = cvt_pk_bf16(b[2], b[3]);
                    *(u32x4*)(bp + bj * HALF) = w; }
                s += __shfl_xor(s, 16); s += __shfl_xor(s, 32);
                if (fq == 0) atomicAdd(ssn + row, s);
                asm volatile("" ::: "memory"); }
    }
};
struct EpiGU {
    static constexpr bool PERM = true, AFTER_DRAIN = false;
    bf16_t* H; const float* ss;
    __device__ __forceinline__ void operator()(const f32x4 (&acc)[2][2][4][2], const Unit& u, int wr, int wc, int fr, int fq) const {
        const int row0 = u.pm * BM + wr * 64 + fr, col0 = u.pn * HALF + wc * 32 + 8 * fq;
#pragma unroll
        for (int ai = 0; ai < 2; ++ai)
#pragma unroll
            for (int m = 0; m < 4; ++m) { const int row = row0 + ai * HALF + m * 16; const float rs = __builtin_amdgcn_rsqf(ss[row] * (1.0f / 1024.0f) + RMS_EPS);
                float o[8];
#pragma unroll
                for (int n = 0; n < 2; ++n)
#pragma unroll
                    for (int e = 0; e < 4; ++e) { const float g = acc[ai][0][m][n][e] * rs, up = acc[ai][1][m][n][e] * rs;
                        o[4 * n + e] = g * __builtin_amdgcn_rcpf(1.0f + __builtin_amdgcn_exp2f(-1.4426950408889634f * g)) * up; }
                u32x4 w; w.x = cvt_pk_bf16(o[0], o[1]); w.y = cvt_pk_bf16(o[2], o[3]); w.z = cvt_pk_bf16(o[4], o[5]); w.w = cvt_pk_bf16(o[6], o[7]);
                *(u32x4*)(H + (size_t)row * 2816 + col0) = w; }
    }
};
template <class Epi, class Sched, bool ALIGN_EPI = false, bool SP2 = false>
__device__ __forceinline__ void gemm_phase(PG8_LAS unsigned char* lds, const Gemm g, const Sched& S, const Epi& E) {
    int tid_ = threadIdx.x; asm volatile("" : "+v"(tid_));
    const int tid = tid_, wid = __builtin_amdgcn_readfirstlane(tid >> 6), lane = tid & 63, wr = wid >> 2, wc = wid & 3, fr = lane & 15, fq = lane >> 4;
    const int K = g.K, nt = K / BK;
    unsigned voffA[2], voffB[2];
#pragma unroll
    for (int i = 0; i < 2; ++i) { int R, C; stage_rc(tid * 16 + i * 8192, R, C); const int Rb = Epi::PERM ? ((R & ~31) + perm32(R & 31)) : R;
        voffA[i] = (unsigned)(R * K + C) * 2u; voffB[i] = (unsigned)(Rb * K + C) * 2u; }
    const size_t kstep = (size_t)(BK * 2);
    const size_t hstep = (size_t)HALF * K * 2;
    const size_t tstep = 2 * hstep;
    const unsigned ldsw = (unsigned)wid * 1024u;
    const int aoff = lds_byte(wr * 64 + fr, fq * 8), boff = lds_byte(wc * 32 + fr, fq * 8);
#define PG8_SA(b, h) (((b) * 2 + (h)) * HTB)
#define PG8_SB(b, h) ((4 + (b) * 2 + (h)) * HTB)
#define PG8_STAGE(bufoff, gbase, voff) do { _Pragma("unroll") for (int _i = 0; _i < 2; ++_i) \
        __builtin_amdgcn_global_load_lds((const unsigned*)((const char*)(gbase) + (voff)[_i]), (PG8_LAS unsigned*)(lds + (bufoff) + ldsw + _i * 8192), 16, 0, 0); } while (0)
#define PG8_LDA(dst, b, h) do { _Pragma("unroll") for (int m = 0; m < 4; ++m) _Pragma("unroll") for (int k = 0; k < 2; ++k) dst[m][k] = *(const PG8_LAS bf16x8*)(lds + PG8_SA(b, h) + aoff + m * 2048 + k * 1024); } while (0)
#define PG8_LDB(dst, b, h) do { _Pragma("unroll") for (int n = 0; n < 2; ++n) _Pragma("unroll") for (int k = 0; k < 2; ++k) dst[n][k] = *(const PG8_LAS bf16x8*)(lds + PG8_SB(b, h) + boff + n * 2048 + k * 1024); } while (0)
#define PG8_MMA(ai, bj, At, Bt) do { __builtin_amdgcn_s_setprio(1); _Pragma("unroll") for (int m = 0; m < 4; ++m) _Pragma("unroll") for (int n = 0; n < 2; ++n) _Pragma("unroll") for (int k = 0; k < 2; ++k) \
        acc[ai][bj][m][n] = __builtin_amdgcn_mfma_f32_16x16x32_bf16(Bt[n][k], At[m][k], acc[ai][bj][m][n], 0, 0, 0); __builtin_amdgcn_s_setprio(0); } while (0)
#define PG8_WAIT_V(n) asm volatile("s_waitcnt vmcnt(" #n ")" ::: "memory")
#define PG8_WAIT_L(n) asm volatile("s_waitcnt lgkmcnt(" #n ")" ::: "memory")
#define PG8_BAR __builtin_amdgcn_s_barrier()
#define PG8_SCHED __builtin_amdgcn_sched_barrier(0)
    Unit cur, nxt; int ui = 0;
    if (!S.next(0, cur)) return;
    f32x4 acc[2][2][4][2];
#pragma unroll
    for (int a = 0; a < 2; ++a)
#pragma unroll
        for (int b = 0; b < 2; ++b)
#pragma unroll
            for (int m = 0; m < 4; ++m)
#pragma unroll
                for (int n = 0; n < 2; ++n) acc[a][b][m][n] = (f32x4){0.f, 0.f, 0.f, 0.f};
    bf16x8 At[4][2], B0[2][2], B1[2][2];
    const char* cA = (const char*)g.A + (size_t)cur.pm * tstep; const char* cB = (const char*)g.Bt + (size_t)cur.pn * tstep;
    S.a_ready(cur);
    if constexpr (SP2) {
        PG8_STAGE(PG8_SB(0, 0), cB, voffB); PG8_STAGE(PG8_SB(0, 1), cB + hstep, voffB); PG8_STAGE(PG8_SA(0, 0), cA, voffA); PG8_STAGE(PG8_SA(0, 1), cA + hstep, voffA);
        if (wr == 1) PG8_BAR;
        PG8_WAIT_V(2); PG8_BAR;
        PG8_STAGE(PG8_SB(1, 0), cB + kstep, voffB); PG8_STAGE(PG8_SA(1, 0), cA + kstep, voffA); PG8_STAGE(PG8_SB(1, 1), cB + hstep + kstep, voffB);
        PG8_WAIT_V(6); PG8_BAR;
    } else {
        PG8_STAGE(PG8_SB(0, 0), cB, voffB); PG8_STAGE(PG8_SA(0, 0), cA, voffA); PG8_STAGE(PG8_SB(0, 1), cB + hstep, voffB); PG8_STAGE(PG8_SA(0, 1), cA + hstep, voffA);
        if (wr == 1) PG8_BAR;
        PG8_WAIT_V(4); PG8_BAR;
        PG8_STAGE(PG8_SB(1, 0), cB + kstep, voffB); PG8_STAGE(PG8_SA(1, 0), cA + kstep, voffA); PG8_STAGE(PG8_SB(1, 1), cB + hstep + kstep, voffB);
        PG8_WAIT_V(6); PG8_BAR;
    }
    for (;;) {
        const bool has_next = S.next(ui + 1, nxt);
        const char* nA = has_next ? (const char*)g.A + (size_t)nxt.pm * tstep : cA; const char* nB = has_next ? (const char*)g.Bt + (size_t)nxt.pn * tstep : cB;
        for (int t = 0; t < nt; t += 2) {
            const bool last = (t == nt - 2);
            const char* a1 = cA + (size_t)(t + 1) * kstep;
            const char* a2 = last ? nA : cA + (size_t)(t + 2) * kstep; const char* b2 = last ? nB : cB + (size_t)(t + 2) * kstep;
            const char* a3 = a2 + kstep; const char* b3 = b2 + kstep;
            if (last && has_next) S.a_ready(nxt);
            if constexpr (SP2) {
            PG8_LDB(B0, 0, 0); PG8_LDB(B1, 0, 1); PG8_SCHED; PG8_LDA(At, 0, 0); PG8_STAGE(PG8_SA(1, 1), a1 + hstep, voffA);
            PG8_WAIT_V(8); PG8_WAIT_L(0); PG8_BAR; PG8_MMA(0, 0, At, B0); PG8_MMA(0, 1, At, B1); PG8_BAR; PG8_SCHED;
            PG8_LDA(At, 0, 1); PG8_STAGE(PG8_SB(0, 0), b2, voffB); PG8_STAGE(PG8_SB(0, 1), b2 + hstep, voffB); PG8_STAGE(PG8_SA(0, 0), a2, voffA);
            PG8_WAIT_V(8); PG8_WAIT_L(0); PG8_BAR; PG8_MMA(1, 0, At, B0); PG8_MMA(1, 1, At, B1); PG8_BAR; PG8_SCHED;
            PG8_LDB(B0, 1, 0); PG8_LDB(B1, 1, 1); PG8_SCHED; PG8_LDA(At, 1, 0); PG8_STAGE(PG8_SA(0, 1), a2 + hstep, voffA);
            PG8_WAIT_V(8); PG8_WAIT_L(0); PG8_BAR; PG8_MMA(0, 0, At, B0); PG8_MMA(0, 1, At, B1); PG8_BAR; PG8_SCHED;
            PG8_LDA(At, 1, 1); PG8_STAGE(PG8_SB(1, 0), b3, voffB); PG8_STAGE(PG8_SB(1, 1), b3 + hstep, voffB); PG8_STAGE(PG8_SA(1, 0), a3, voffA);
            PG8_WAIT_V(8); PG8_WAIT_L(0); PG8_BAR; PG8_MMA(1, 0, At, B0); PG8_MMA(1, 1, At, B1); PG8_BAR; PG8_SCHED;
            } else {
            PG8_LDB(B0, 0, 0); PG8_SCHED; PG8_LDA(At, 0, 0); PG8_STAGE(PG8_SA(1, 1), a1 + hstep, voffA);
            PG8_WAIT_L(8); PG8_BAR; PG8_WAIT_L(0); PG8_MMA(0, 0, At, B0); PG8_BAR; PG8_SCHED;
            PG8_LDB(B1, 0, 1); PG8_STAGE(PG8_SB(0, 0), b2, voffB);
            PG8_BAR; PG8_WAIT_L(0); PG8_MMA(0, 1, At, B1); PG8_BAR;
            PG8_LDA(At, 0, 1); PG8_STAGE(PG8_SA(0, 0), a2, voffA);
            PG8_BAR; PG8_WAIT_L(0); PG8_MMA(1, 0, At, B0); PG8_BAR; PG8_SCHED;
            PG8_STAGE(PG8_SB(0, 1), b2 + hstep, voffB);
            PG8_WAIT_V(6); PG8_BAR; PG8_MMA(1, 1, At, B1); PG8_BAR;
            PG8_LDB(B0, 1, 0); PG8_SCHED; PG8_LDA(At, 1, 0); PG8_STAGE(PG8_SA(0, 1), a2 + hstep, voffA);
            PG8_WAIT_L(8); PG8_BAR; PG8_WAIT_L(0); PG8_MMA(0, 0, At, B0); PG8_BAR; PG8_SCHED;
            PG8_LDB(B1, 1, 1); PG8_STAGE(PG8_SB(1, 0), b3, voffB);
            PG8_BAR; PG8_WAIT_L(0); PG8_MMA(0, 1, At, B1); PG8_BAR;
            PG8_LDA(At, 1, 1); PG8_STAGE(PG8_SA(1, 0), a3, voffA);
            PG8_BAR; PG8_WAIT_L(0); PG8_MMA(1, 0, At, B0); PG8_BAR; PG8_SCHED;
            PG8_STAGE(PG8_SB(1, 1), b3 + hstep, voffB);
            PG8_WAIT_V(6); PG8_BAR; PG8_MMA(1, 1, At, B1); PG8_BAR;
            }
        }
        if constexpr (ALIGN_EPI) { if (wr == 0) PG8_BAR; }
        if constexpr (!Epi::AFTER_DRAIN) { E(acc, cur, wr, wc, fr, fq); S.done(cur); }
        if (!has_next) break;
#pragma unroll
        for (int a = 0; a < 2; ++a)
#pragma unroll
            for (int b = 0; b < 2; ++b)
#pragma unroll
                for (int m = 0; m < 4; ++m)
#pragma unroll
                    for (int n = 0; n < 2; ++n) acc[a][b][m][n] = (f32x4){0.f, 0.f, 0.f, 0.f};
        cur = nxt; cA = nA; cB = nB; ++ui;
        if constexpr (ALIGN_EPI) { if (wr == 1) PG8_BAR; }
    }
    PG8_WAIT_V(0);
    if constexpr (!ALIGN_EPI) { if (wr == 0) PG8_BAR; }
    PG8_BAR;
    if constexpr (Epi::AFTER_DRAIN) { E.fused(acc, cur, wr, wc, fr, fq, lds, wid, lane); S.done(cur); }
#undef PG8_SA
#undef PG8_SB
#undef PG8_STAGE
#undef PG8_LDA
#undef PG8_LDB
#undef PG8_MMA
#undef PG8_WAIT_V
#undef PG8_WAIT_L
#undef PG8_BAR
#undef PG8_SCHED
}
}
#include <hip/hip_bf16.h>
#include <cmath>
namespace attn_body {
using bf16=__hip_bfloat16;
using bf16x8=__attribute__((ext_vector_type(8)))short;
using s16x4=__attribute__((ext_vector_type(4)))short;
using f32x16=__attribute__((ext_vector_type(16)))float;
using u32x4=__attribute__((ext_vector_type(4)))unsigned;
constexpr int SEQ=8448,D=64,DM=2560,DMO=1024;
using f32x4=__attribute__((ext_vector_type(4)))float;
constexpr int NW=8,QBLK=32,QB=QBLK*NW,KVBLK=64,NQB=SEQ/QB;
constexpr int ATTN_UNIT_ROWS=QB;
__device__ __forceinline__ int crow(int r,int hi){return (r&3)+8*(r>>2)+4*hi;}
#define SBAR() __builtin_amdgcn_sched_barrier(0)
__device__ __forceinline__ void cmask(f32x16&p0,f32x16&p1,int jb,int qrel,int hi){
  const float NEG=-INFINITY; int kb=64*jb+4*hi;
  #pragma unroll
  for(int r=0;r<16;++r){int kv=kb+(r&3)+8*(r>>2); if(kv>qrel)p0[r]=NEG; if(kv+32>qrel)p1[r]=NEG;}
}

constexpr int NSLOT=3, SLOTB=8192;
constexpr int LDS_K=0, LDS_V=NSLOT*SLOTB, LDS_WS=2*NSLOT*SLOTB, LDS_OST=LDS_WS+NW*64*4, LDS_BYTES=LDS_OST+NW*4096, LDS_CS=LDS_BYTES, LDS_FLAGS=LDS_CS+SEQ*4, LDS_END=LDS_FLAGS+256;
constexpr float C2=0.125f*1.4426950408889634f;
__device__ __forceinline__ void glds16(const void*gsrc,unsigned lds_dst){unsigned keep;
  asm volatile("s_mov_b32 %0, m0\n\ts_mov_b32 m0, %2\n\ts_nop 0\n\tglobal_load_lds_dwordx4 %1, off\n\ts_mov_b32 m0, %0":"=&s"(keep):"v"(gsrc),"s"(lds_dst):"memory");}
__device__ __forceinline__ float max3f(float a,float b,float c){float r;asm("v_max3_f32 %0, %1, %2, %3":"=v"(r):"v"(a),"v"(b),"v"(c));return r;}
__device__ __forceinline__ float max2f(float a,float b){float r;asm("v_max_f32_e32 %0, %1, %2":"=v"(r):"v"(a),"v"(b));return r;}
__device__ __forceinline__ float fadd_s(float a,float b){float r;asm("v_add_f32_e32 %0, %1, %2":"=v"(r):"v"(a),"v"(b));return r;}
__device__ __forceinline__ float fsub_s(float a,float b){float r;asm("v_sub_f32_e32 %0, %1, %2":"=v"(r):"v"(a),"v"(b));return r;}
typedef float f32x2_t __attribute__((ext_vector_type(2))); typedef __bf16 bf16x2_t __attribute__((ext_vector_type(2)));
__device__ __forceinline__ unsigned cvtpk_s(float lo,float hi){f32x2_t v={lo,hi};bf16x2_t b=__builtin_convertvector(v,bf16x2_t);return __builtin_bit_cast(unsigned,b);}
#define WAIT_BAR(N) asm volatile("s_waitcnt vmcnt(" #N ") lgkmcnt(0)\n\ts_barrier":::"memory")

__device__ __forceinline__ void qkt(f32x16&p0,f32x16&p1,const char*Kslot,const bf16x8*qr,int r32,int hi){
  const char*kb=Kslot+hi*1024+r32*16;
  #pragma unroll
  for(int d0=0;d0<4;++d0){
    const bf16x8 b0=*reinterpret_cast<const bf16x8*>(kb+d0*2048);
    const bf16x8 b1=*reinterpret_cast<const bf16x8*>(kb+d0*2048+512);
    {p0=__builtin_amdgcn_mfma_f32_32x32x16_bf16(b0,qr[d0],p0,0,0,0);p1=__builtin_amdgcn_mfma_f32_32x32x16_bf16(b1,qr[d0],p1,0,0,0);}}
}
typedef __attribute__((address_space(3))) const char* lds_cptr;
typedef short v4i16_t __attribute__((ext_vector_type(4)));
__device__ __forceinline__ void kload8(bf16x8*kf,lds_cptr kp){
  kf[0]=*(const __attribute__((address_space(3))) bf16x8*)(kp);      kf[1]=*(const __attribute__((address_space(3))) bf16x8*)(kp+512);
  kf[2]=*(const __attribute__((address_space(3))) bf16x8*)(kp+2048); kf[3]=*(const __attribute__((address_space(3))) bf16x8*)(kp+2560);
  kf[4]=*(const __attribute__((address_space(3))) bf16x8*)(kp+4096); kf[5]=*(const __attribute__((address_space(3))) bf16x8*)(kp+4608);
  kf[6]=*(const __attribute__((address_space(3))) bf16x8*)(kp+6144); kf[7]=*(const __attribute__((address_space(3))) bf16x8*)(kp+6656);
}
__device__ __forceinline__ void kload2(bf16x8*kf,lds_cptr kp,int j){ kf[2*j]=*(const __attribute__((address_space(3))) bf16x8*)(kp+j*2048); kf[2*j+1]=*(const __attribute__((address_space(3))) bf16x8*)(kp+j*2048+512); }
__device__ __forceinline__ s16x4 vtr(lds_cptr p){ return __builtin_bit_cast(s16x4,__builtin_amdgcn_ds_read_tr16_b64_v4i16((__attribute__((address_space(3))) v4i16_t*)p)); }
__device__ __forceinline__ float rowmax(const f32x16&p0,const f32x16&p1){
  float a=max3f(p0[0],p0[1],p1[0]),b=max3f(p0[2],p0[3],p1[1]);a=max3f(a,p1[2],p1[3]);
  #pragma unroll
  for(int r=4;r<16;r+=4){a=max3f(a,p0[r],p0[r+1]);b=max3f(b,p0[r+2],p0[r+3]);a=max3f(a,p1[r],p1[r+1]);b=max3f(b,p1[r+2],p1[r+3]);}
  const float m=max2f(a,b);
  auto rr=__builtin_amdgcn_permlane32_swap(__float_as_uint(m),__float_as_uint(m),false,false);
  return max2f(__uint_as_float(rr[0]),__uint_as_float(rr[1]));
}
__device__ __forceinline__ void pv(f32x16*o,int vb,bf16x8 pa0,bf16x8 pa1,bf16x8 pa2,bf16x8 pa3){
  #pragma unroll
  for(int d0=0;d0<2;++d0){s16x4 lo[4],hi[4];
    #pragma unroll
    for(int ks=0;ks<4;++ks){
      asm volatile("ds_read_b64_tr_b16 %0,%1 offset:%c2":"=&v"(lo[ks]):"v"(vb),"i"(d0*4096+ks*1024):"memory");
      asm volatile("ds_read_b64_tr_b16 %0,%1 offset:%c2":"=&v"(hi[ks]):"v"(vb),"i"(d0*4096+ks*1024+512):"memory");}
    asm volatile("s_waitcnt lgkmcnt(0)":::"memory");SBAR();
    #define PK(k) (bf16x8){lo[k][0],lo[k][1],lo[k][2],lo[k][3],hi[k][0],hi[k][1],hi[k][2],hi[k][3]}
    o[d0]=__builtin_amdgcn_mfma_f32_32x32x16_bf16(pa0,PK(0),o[d0],0,0,0);
    o[d0]=__builtin_amdgcn_mfma_f32_32x32x16_bf16(pa1,PK(1),o[d0],0,0,0);
    o[d0]=__builtin_amdgcn_mfma_f32_32x32x16_bf16(pa2,PK(2),o[d0],0,0,0);
    o[d0]=__builtin_amdgcn_mfma_f32_32x32x16_bf16(pa3,PK(3),o[d0],0,0,0);
    #undef PK
  }
}

__device__ __forceinline__ u32x4 head_rms(u32x4 v){ float x[8];
  #pragma unroll
  for(int i=0;i<4;++i){x[2*i]=__uint_as_float(v[i]<<16);x[2*i+1]=__uint_as_float(v[i]&0xffff0000u);}
  float s=0.f;
  #pragma unroll
  for(int i=0;i<8;++i)s+=x[i]*x[i];
  s+=__shfl_xor(s,1);s+=__shfl_xor(s,2);s+=__shfl_xor(s,4);
  const float rs=__builtin_amdgcn_rsqf(s*(1.0f/64.0f)+1e-6f); u32x4 w;
  #pragma unroll
  for(int i=0;i<4;++i)w[i]=cvtpk_s(x[2*i]*rs,x[2*i+1]*rs);
  return w; }
#ifndef ATTN_STORE16
#define ATTN_STORE16(p,v) (*(u32x4*)(p)=(v))
#endif
template<int THRL> __device__ __forceinline__ void fox_unit(int b,int qb,float dthr,const bf16*Q,const bf16*__restrict__ K,const bf16*__restrict__ V,bf16*O,const float*__restrict__ csg,char*shm){
  int tid_=threadIdx.x; asm volatile("":"+v"(tid_)); const int tid=tid_,lane=tid&63,r32=lane&31,hi=lane>>5; const int wid=__builtin_amdgcn_readfirstlane(tid>>6);
  const long rowbase=(long)b*SEQ; const int q0=qb*QB;
  const bf16*Qw=Q+(rowbase+q0+wid*QBLK)*DM;
  const unsigned lds0=(unsigned)(uintptr_t)shm; const lds_cptr shm3=(lds_cptr)shm;
  float*wsf=(float*)(shm+LDS_WS)+wid*64;
  const unsigned kdst=lds0+LDS_K+wid*1024, vdst=lds0+LDS_V+wid*1024;
  #define DMA_K(t,slot) glds16(ksrc+(long)(t)*KVBLK*DM,(unsigned)__builtin_amdgcn_readfirstlane(kdst+(slot)))
  #define DMA_V(t,slot) glds16(vsrc+(long)(t)*KVBLK*DM,(unsigned)__builtin_amdgcn_readfirstlane(vdst+(slot)))
  const int vb0=(int)(lds0+LDS_V)+((lane>>4)&1)*32+(lane&3)*8+(4*hi+((lane&15)>>2))*64;
  const char*Kbase=shm+LDS_K; bf16x8 kf[8];
  const lds_cptr kp0=shm3+LDS_K+hi*1024+r32*16; const lds_cptr vp0=shm3+LDS_V+((lane>>4)&1)*32+(lane&3)*8+(4*hi+((lane&15)>>2))*64;
  typedef __attribute__((address_space(3))) float lds_f32; typedef __attribute__((address_space(3))) f32x4 lds_f32x4;
  { lds_f32*cl=(lds_f32*)(shm3+LDS_CS); const int n_=q0+QB; for(int i_=tid*4;i_<n_;i_+=2048){ const f32x4 v_=*(const f32x4*)(csg+i_); *(lds_f32x4*)(cl+i_)=v_; } }
  asm volatile("s_waitcnt vmcnt(0) lgkmcnt(0)\n\ts_barrier":::"memory");
  int j0;
  { const lds_f32*cl=(const lds_f32*)(shm3+LDS_CS); const float cq0=cl[q0]; int lo_=0,hi_=4*qb;
    while(lo_<hi_){ const int mid_=(lo_+hi_)>>1; if(cl[64*mid_+63]-cq0>=dthr)lo_=mid_+1; else hi_=mid_; }
    j0=__builtin_amdgcn_readfirstlane(lo_)&~1; }
  const bf16*Kh=K+(rowbase+(long)j0*KVBLK)*DM,*Vh=V+(rowbase+(long)j0*KVBLK)*DM;
  const bf16*ksrc=Kh+(long)lane*DM+wid*8;
  const bf16*vsrc=Vh+(long)(16*(wid&3)+(lane>>2))*DM+(wid>>2)*32+(lane&3)*8;
  const int NT=(q0+QB)/KVBLK-j0;
  const lds_f32*cl3=(const lds_f32*)(shm3+LDS_CS)+64*j0;
  DMA_K(0,0);DMA_V(0,0);DMA_K(1,SLOTB);
  bf16x8 qr[4];
  #pragma unroll
  for(int d0=0;d0<4;++d0)qr[d0]=*reinterpret_cast<const bf16x8*>(&Qw[(long)r32*DM+d0*16+hi*8]);
  float base=0.f,l_reg=0.f;f32x16 o[2];o[0]=f32x16{};o[1]=f32x16{};
  #define CINIT(C0,C1,t) do{ const lds_f32*cp_=cl3+64*(t)+4*hi; \
    _Pragma("unroll") for(int g_=0;g_<4;++g_){ const f32x4 a_=*(const lds_f32x4*)(cp_+8*g_), b_=*(const lds_f32x4*)(cp_+32+8*g_); \
      C0[4*g_]=base-a_[0];C0[4*g_+1]=base-a_[1];C0[4*g_+2]=base-a_[2];C0[4*g_+3]=base-a_[3]; \
      C1[4*g_]=base-b_[0];C1[4*g_+1]=base-b_[1];C1[4*g_+2]=base-b_[2];C1[4*g_+3]=base-b_[3]; } }while(0)
  const int qrel=wid*QBLK+r32;
  #define CMASK(P0,P1,t) do{int jb_=(t)-(NT-4); if(jb_>=0)cmask(P0,P1,jb_,qrel,hi);}while(0)
  bool resc=false;
  #define START(P0,P1) do{ const float rm=rowmax(P0,P1); resc=false; \
    { const float dl=rm; base=fsub_s(base,dl); \
      _Pragma("unroll") for(int r=0;r<16;++r){P0[r]=fsub_s(P0[r],dl);P1[r]=fsub_s(P1[r],dl);} } \
    _Pragma("unroll") for(int r=0;r<16;++r)P0[r]=__builtin_amdgcn_exp2f(P0[r]); }while(0)
  #define RESC() do{ if(resc){ asm volatile("s_waitcnt lgkmcnt(0)":::"memory"); \
      _Pragma("unroll") for(int d_=0;d_<2;++d_) _Pragma("unroll") for(int r=0;r<16;++r)o[d_][r]*=wsf[crow(r,hi)]; } }while(0)
  f32x16 pA0,pA1,pB0,pB1;
  int sl_prev=0,sl_cur=0,sl_next=SLOTB;
  #define ROT() do{sl_prev=sl_cur;sl_cur=sl_next;sl_next=(sl_next==(NSLOT-1)*SLOTB)?0:sl_next+SLOTB;}while(0)
  DMA_K(2,2*SLOTB);
  WAIT_BAR(3);
  base=cl3[q0-64*j0+wid*QBLK+r32];
  CINIT(pA0,pA1,0); qkt(pA0,pA1,Kbase,qr,r32,hi);asm volatile("s_nop 15\n\ts_nop 7":"+v"(pA0),"+v"(pA1));CMASK(pA0,pA1,0);
  START(pA0,pA1);
  _Pragma("unroll") for(int r=0;r<16;++r)pA1[r]=__builtin_amdgcn_exp2f(pA1[r]);
  WAIT_BAR(0);
  DMA_K(3,0);DMA_V(1,SLOTB);
  ROT();
  kload8(kf,kp0+sl_cur);
  WAIT_BAR(2);
  s16x4 vlo[8],vhi[8]; u32x4 pw0,pw1,pw2,pw3;
  #define PKW(P,B) cvtpk_s(P[B],P[B+1])
  #define PAF(k) __builtin_bit_cast(bf16x8,pw##k)
  #define VFR(i) (bf16x8){vlo[i][0],vlo[i][1],vlo[i][2],vlo[i][3],vhi[i][0],vhi[i][1],vhi[i][2],vhi[i][3]}
  #define PIN(x) asm volatile("":"+v"(x))
  #define MX3(a,b,c) __builtin_fmaxf(__builtin_fmaxf((a),(b)),(c))
  #define GAPA(MF,A0,A1,A2,A3,W0,W1,PW) do{ MF; sacc+=A0; sacc+=A1; sacc+=A2; sacc+=A3; PIN(sacc); W0; W1; PIN(PW); SBAR(); }while(0)
  #define EX(v) __builtin_amdgcn_exp2f(v)
  #define GAPB(MF,X,B) do{ MF; X[B]=EX(X[B]); X[B+1]=EX(X[B+1]); X[B+2]=EX(X[B+2]); X[B+3]=EX(X[B+3]); PIN(X); SBAR(); }while(0)
  #define VRD(i) do{ vlo[i]=vtr(vp_+(((i)>>2)*4096+((i)&3)*1024)); vhi[i]=vtr(vp_+(((i)>>2)*4096+((i)&3)*1024+512)); }while(0)
  #define KRD(G,j) do{ if(G){ kload2(kf,kp0+sl_next,j); SBAR(); } }while(0)
  #define STEP(C0,C1,P0,P1,t,GK,GV,GL) do{ SBAR(); CINIT(C0,C1,t); SBAR(); \
    const lds_cptr vp_=vp0+sl_prev; \
    VRD(0); SBAR(); float sacc=(P0[0]+P0[1]); \
    GAPA(C0=__builtin_amdgcn_mfma_f32_32x32x16_bf16(kf[0],qr[0],C0,0,0,0), P0[2],P0[3],P0[4],P0[5],     pw0[0]=PKW(P0,0), pw0[1]=PKW(P0,2), pw0); \
    VRD(4); SBAR(); GAPA(C1=__builtin_amdgcn_mfma_f32_32x32x16_bf16(kf[1],qr[0],C1,0,0,0), P0[6],P0[7],P0[8],P0[9],     pw0[2]=PKW(P0,4), pw0[3]=PKW(P0,6), pw0); \
    VRD(1); SBAR(); GAPA(C0=__builtin_amdgcn_mfma_f32_32x32x16_bf16(kf[2],qr[1],C0,0,0,0),   P0[10],P0[11],P0[12],P0[13], pw1[0]=PKW(P0,8), pw1[1]=PKW(P0,10), pw1); \
    VRD(5); SBAR(); GAPA(C1=__builtin_amdgcn_mfma_f32_32x32x16_bf16(kf[3],qr[1],C1,0,0,0),   P0[14],P0[15],P1[0],P1[1],   pw1[2]=PKW(P0,12),pw1[3]=PKW(P0,14), pw1); \
    VRD(2); SBAR(); GAPA(C0=__builtin_amdgcn_mfma_f32_32x32x16_bf16(kf[4],qr[2],C0,0,0,0),   P1[2],P1[3],P1[4],P1[5],     pw2[0]=PKW(P1,0), pw2[1]=PKW(P1,2), pw2); \
    VRD(6); SBAR(); GAPA(C1=__builtin_amdgcn_mfma_f32_32x32x16_bf16(kf[5],qr[2],C1,0,0,0),   P1[6],P1[7],P1[8],P1[9],     pw2[2]=PKW(P1,4), pw2[3]=PKW(P1,6), pw2); \
    VRD(3); SBAR(); GAPA(C0=__builtin_amdgcn_mfma_f32_32x32x16_bf16(kf[6],qr[3],C0,0,0,0),   P1[10],P1[11],P1[12],P1[13], pw3[0]=PKW(P1,8), pw3[1]=PKW(P1,10), pw3); \
    VRD(7); SBAR(); GAPA(C1=__builtin_amdgcn_mfma_f32_32x32x16_bf16(kf[7],qr[3],C1,0,0,0),   P1[14],P1[15],0.f,0.f,       pw3[2]=PKW(P1,12),pw3[3]=PKW(P1,14), pw3); \
    l_reg+=sacc; \
    if(GK){DMA_K((t)+3,sl_cur);} if(GV){DMA_V((t)+1,sl_next);} \
    CMASK(C0,C1,t); \
    { float a=MX3(C0[0],C0[1],C1[0]),b=MX3(C0[2],C0[3],C1[1]); a=MX3(a,C1[2],C1[3]); \
      _Pragma("unroll") for(int r=4;r<16;r+=4){a=MX3(a,C0[r],C0[r+1]);b=MX3(b,C0[r+2],C0[r+3]);a=MX3(a,C1[r],C1[r+1]);b=MX3(b,C1[r+2],C1[r+3]);} \
      float rm=__builtin_fmaxf(a,b); { auto rr=__builtin_amdgcn_permlane32_swap(__float_as_uint(rm),__float_as_uint(rm),false,false); rm=__builtin_fmaxf(__uint_as_float(rr[0]),__uint_as_float(rr[1])); } \
      resc=false; \
      if(__builtin_expect(__any(rm>(float)THRL),0)){ const float dl=__builtin_fmaxf(rm,0.f); base-=dl; \
        _Pragma("unroll") for(int r=0;r<16;++r){C0[r]-=dl;C1[r]-=dl;} \
        const float f=__builtin_amdgcn_exp2f(-dl); l_reg*=f; if(hi==0)wsf[r32]=f; resc=true; } } \
    SBAR(); \
    GAPB(o[0]=__builtin_amdgcn_mfma_f32_32x32x16_bf16(PAF(0),VFR(0),o[0],0,0,0), C0,0); \
    GAPB(o[1]=__builtin_amdgcn_mfma_f32_32x32x16_bf16(PAF(0),VFR(4),o[1],0,0,0), C0,4); \
    KRD(GL,0); GAPB(o[0]=__builtin_amdgcn_mfma_f32_32x32x16_bf16(PAF(1),VFR(1),o[0],0,0,0), C0,8); \
    KRD(GL,1); GAPB(o[1]=__builtin_amdgcn_mfma_f32_32x32x16_bf16(PAF(1),VFR(5),o[1],0,0,0), C0,12); \
    KRD(GL,2); GAPB(o[0]=__builtin_amdgcn_mfma_f32_32x32x16_bf16(PAF(2),VFR(2),o[0],0,0,0), C1,0); \
    KRD(GL,3); GAPB(o[1]=__builtin_amdgcn_mfma_f32_32x32x16_bf16(PAF(2),VFR(6),o[1],0,0,0), C1,4); \
    GAPB(o[0]=__builtin_amdgcn_mfma_f32_32x32x16_bf16(PAF(3),VFR(3),o[0],0,0,0), C1,8); \
    GAPB(o[1]=__builtin_amdgcn_mfma_f32_32x32x16_bf16(PAF(3),VFR(7),o[1],0,0,0), C1,12); \
    }while(0)
  int t=1;
  #undef CMASK
  #define CMASK(P0,P1,t) do{}while(0)
  for(;t+5<NT;t+=2){
    STEP(pB0,pB1,pA0,pA1,t,true,true,true);     WAIT_BAR(2); RESC(); ROT();
    STEP(pA0,pA1,pB0,pB1,t+1,true,true,true);   WAIT_BAR(2); RESC(); ROT();
  }
  #undef CMASK
  #define CMASK(P0,P1,t) do{int jb_=(t)-(NT-4); if(jb_>=0)cmask(P0,P1,jb_,qrel,hi);}while(0)
  #define ENDW(tt) do{ if((tt)+3<NT){WAIT_BAR(2);} else if((tt)+2<NT){WAIT_BAR(1);} else {WAIT_BAR(0);} }while(0)
  for(;t+1<NT;t+=2){
    STEP(pB0,pB1,pA0,pA1,t,(t+3<NT),(t+1<NT),(t+1<NT));       ENDW(t);   RESC(); ROT();
    STEP(pA0,pA1,pB0,pB1,t+1,(t+4<NT),(t+2<NT),(t+2<NT));     ENDW(t+1); RESC(); ROT();
  }
  STEP(pB0,pB1,pA0,pA1,NT-1,false,false,false); RESC();
  { float sacc=pB0[0]+pB0[1]; _Pragma("unroll") for(int r=2;r<16;++r)sacc+=pB0[r]; _Pragma("unroll") for(int r=0;r<16;++r)sacc+=pB1[r]; l_reg+=sacc;
    pw0=(u32x4){PKW(pB0,0),PKW(pB0,2),PKW(pB0,4),PKW(pB0,6)};pw1=(u32x4){PKW(pB0,8),PKW(pB0,10),PKW(pB0,12),PKW(pB0,14)};pw2=(u32x4){PKW(pB1,0),PKW(pB1,2),PKW(pB1,4),PKW(pB1,6)};pw3=(u32x4){PKW(pB1,8),PKW(pB1,10),PKW(pB1,12),PKW(pB1,14)};
    SBAR(); pv(o,vb0+sl_cur,PAF(0),PAF(1),PAF(2),PAF(3)); }
  #undef PKW
  #undef PAF
  #undef VFR
  #undef PIN
  #undef MX3
  #undef GAPA
  #undef GAPB
  #undef EX
  #undef VRD
  #undef KRD
  #undef STEP
  #undef ENDW
  {auto rr=__builtin_amdgcn_permlane32_swap(__float_as_uint(l_reg),__float_as_uint(l_reg),false,false);l_reg=__uint_as_float(rr[0])+__uint_as_float(rr[1]);}
  if(hi==0)wsf[32+r32]=l_reg;asm volatile("s_waitcnt lgkmcnt(0)":::"memory");
  float rli[16];
  #pragma unroll
  for(int r=0;r<16;++r)rli[r]=__builtin_amdgcn_rcpf(wsf[32+crow(r,hi)]);
  bf16*Ow=O+(rowbase+q0+wid*QBLK)*DMO;
  { bf16*stg=(bf16*)(shm+LDS_OST)+wid*2048;
    #pragma unroll
    for(int r=0;r<16;++r){const int orow=crow(r,hi);
      #pragma unroll
      for(int d0=0;d0<2;++d0)stg[orow*64+d0*32+r32]=__float2bfloat16(o[d0][r]*rli[r]);}
    asm volatile("s_waitcnt lgkmcnt(0)":::"memory");
    #pragma unroll
    for(int i=0;i<4;++i){const int row=i*8+(lane>>3),ch=lane&7; const u32x4 v=*(const u32x4*)(stg+row*64+ch*8); ATTN_STORE16(Ow+(long)row*DMO+ch*8,head_rms(v));} }
  asm volatile("s_waitcnt lgkmcnt(0)\n\ts_barrier":::"memory");
  #undef DMA_K
  #undef DMA_V
  #undef CMASK
  #undef CINIT
  #undef START
  #undef RESC
  #undef ROT
}
__device__ __forceinline__ float sp2f(float z){ const float e=__builtin_amdgcn_exp2f(-__builtin_fabsf(z)); return __builtin_fmaxf(z,0.f)+__builtin_amdgcn_logf(1.f+e); }
__device__ __forceinline__ void sb_unit(int b,int qb,const bf16*Q,const bf16*__restrict__ K,const bf16*__restrict__ V,bf16*O,char*shm){
  int tid_=threadIdx.x; asm volatile("":"+v"(tid_)); const int tid=tid_,lane=tid&63,r32=lane&31,hi=lane>>5; const int wid=__builtin_amdgcn_readfirstlane(tid>>6);
  const long rowbase=(long)b*SEQ; const int q0=qb*QB;
  const bf16*Qw=Q+(rowbase+q0+wid*QBLK)*DM;
  const bf16*Kh=K+rowbase*DM,*Vh=V+rowbase*DM;
  const unsigned lds0=(unsigned)(uintptr_t)shm; const lds_cptr shm3=(lds_cptr)shm;
  const bf16*ksrc=Kh+(long)lane*DM+wid*8;
  const bf16*vsrc=Vh+(long)(16*(wid&3)+(lane>>2))*DM+(wid>>2)*32+(lane&3)*8;
  const unsigned kdst=lds0+LDS_K+wid*1024, vdst=lds0+LDS_V+wid*1024;
  #define DMA_K(t,slot) glds16(ksrc+(long)(t)*KVBLK*DM,(unsigned)__builtin_amdgcn_readfirstlane(kdst+(slot)))
  #define DMA_V(t,slot) glds16(vsrc+(long)(t)*KVBLK*DM,(unsigned)__builtin_amdgcn_readfirstlane(vdst+(slot)))
  const int vb0=(int)(lds0+LDS_V)+((lane>>4)&1)*32+(lane&3)*8+(4*hi+((lane&15)>>2))*64;
  typedef __attribute__((address_space(3))) unsigned lds_u32;
  volatile lds_u32*flags=(volatile lds_u32*)(shm3+LDS_FLAGS);
  bf16x8 qr[4];
  #pragma unroll
  for(int d0=0;d0<4;++d0)qr[d0]=*reinterpret_cast<const bf16x8*>(&Qw[(long)r32*DM+d0*16+hi*8]);
  asm volatile("":::"memory");
  f32x16 o[2];o[0]=f32x16{};o[1]=f32x16{};
  float R=0.f; const int qabs=q0+wid*QBLK+r32; bool done=false;
  const int jtop=4*qb+3;
  DMA_K(jtop,0);DMA_V(jtop,0);
  int slot=0;
  for(int j=jtop;j>=0;--j){
    if(j>0){ DMA_K(j-1,slot^SLOTB);DMA_V(j-1,slot^SLOTB); WAIT_BAR(2); } else { WAIT_BAR(0); }
    const bool active=(!done)&&(64*j<q0+wid*QBLK+31);
    if(active){
      f32x16 p0=f32x16{},p1=f32x16{};
      qkt(p0,p1,shm+LDS_K+slot,qr,r32,hi);
      const int kvb=64*j+4*hi; f32x16 s0,s1;
      #pragma unroll
      for(int r=0;r<16;++r){ const int kv=kvb+(r&3)+8*(r>>2); s0[r]=(kv<qabs)?sp2f(p0[r]):0.f; s1[r]=(kv+32<qabs)?sp2f(p1[r]):0.f; }
      float g0[4],g1[4],og0[4],og1[4],T0[4],T1[4];
      #pragma unroll
      for(int g=0;g<4;++g){ g0[g]=(s0[4*g]+s0[4*g+1])+(s0[4*g+2]+s0[4*g+3]); g1[g]=(s1[4*g]+s1[4*g+1])+(s1[4*g+2]+s1[4*g+3]); }
      #pragma unroll
      for(int g=0;g<4;++g){ og0[g]=__shfl_xor(g0[g],32); og1[g]=__shfl_xor(g1[g],32); }
      float run=R;
      #pragma unroll
      for(int g=3;g>=0;--g){ const float ah1=hi?g1[g]:og1[g], ah0=hi?og1[g]:g1[g]; const float t1=run; run+=ah1; const float t0=run; run+=ah0; T1[g]=hi?t1:t0; }
      #pragma unroll
      for(int g=3;g>=0;--g){ const float ah1=hi?g0[g]:og0[g], ah0=hi?og0[g]:g0[g]; const float t1=run; run+=ah1; const float t0=run; run+=ah0; T0[g]=hi?t1:t0; }
      R=run;
      #pragma unroll
      for(int g=0;g<4;++g){ float a0=T0[g],a1=T1[g];
        #pragma unroll
        for(int i=3;i>=0;--i){ const int r=4*g+i; const int kv=kvb+i+8*g; a0+=s0[r]; a1+=s1[r];
          p0[r]=(kv<qabs)?__builtin_amdgcn_exp2f(p0[r]-a0):0.f; p1[r]=(kv+32<qabs)?__builtin_amdgcn_exp2f(p1[r]-a1):0.f; } }
      u32x4 pw0,pw1,pw2,pw3;
      pw0=(u32x4){cvtpk_s(p0[0],p0[1]),cvtpk_s(p0[2],p0[3]),cvtpk_s(p0[4],p0[5]),cvtpk_s(p0[6],p0[7])};
      pw1=(u32x4){cvtpk_s(p0[8],p0[9]),cvtpk_s(p0[10],p0[11]),cvtpk_s(p0[12],p0[13]),cvtpk_s(p0[14],p0[15])};
      pw2=(u32x4){cvtpk_s(p1[0],p1[1]),cvtpk_s(p1[2],p1[3]),cvtpk_s(p1[4],p1[5]),cvtpk_s(p1[6],p1[7])};
      pw3=(u32x4){cvtpk_s(p1[8],p1[9]),cvtpk_s(p1[10],p1[11]),cvtpk_s(p1[12],p1[13]),cvtpk_s(p1[14],p1[15])};
      pv(o,vb0+slot,__builtin_bit_cast(bf16x8,pw0),__builtin_bit_cast(bf16x8,pw1),__builtin_bit_cast(bf16x8,pw2),__builtin_bit_cast(bf16x8,pw3));
      done=__all(R>=151.f)!=0;
    }
    if(lane==0)flags[wid]=done?1u:0u;
    asm volatile("s_waitcnt lgkmcnt(0)\n\ts_barrier":::"memory");
    unsigned alld=1u;
    #pragma unroll
    for(int w=0;w<NW;++w)alld&=flags[w];
    slot^=SLOTB;
    if(alld)break;
  }
  asm volatile("s_waitcnt vmcnt(0)":::"memory");
  bf16*Ow=O+(rowbase+q0+wid*QBLK)*DMO;
  { bf16*stg=(bf16*)(shm+LDS_OST)+wid*2048;
    #pragma unroll
    for(int r=0;r<16;++r){const int orow=crow(r,hi);
      #pragma unroll
      for(int d0=0;d0<2;++d0)stg[orow*64+d0*32+r32]=__float2bfloat16(o[d0][r]);}
    asm volatile("s_waitcnt lgkmcnt(0)":::"memory");
    #pragma unroll
    for(int i=0;i<4;++i){const int row=i*8+(lane>>3),ch=lane&7; const u32x4 v=*(const u32x4*)(stg+row*64+ch*8); ATTN_STORE16(Ow+(long)row*DMO+ch*8,head_rms(v));} }
  asm volatile("s_waitcnt vmcnt(0) lgkmcnt(0)\n\ts_barrier":::"memory");
  #undef DMA_K
  #undef DMA_V
}
#undef SBAR
#undef WAIT_BAR
}
namespace cg = cooperative_groups;
constexpr int NWAVES = 8;
constexpr int DMODEL = 1024, NBATCH = 4, SEQ_IN = 8192, NMETA = 16, LREAL = NMETA + SEQ_IN, LP = 8448  ;
constexpr int MROWS = NBATCH * LP;
constexpr int INW = 2566, NINP = 2560, NIN = 2816, DFF = 2816, NGU = 2 * DFF, DEPTH = 2, NFH = 6;
constexpr float C2F = 0.125f * 1.4426950408889634f;
constexpr int PC_U = 0, PC_FQ = 256, PC_FK = 640, PC_FV = 1024, PC_SQ = 1408, PC_SK = 1792, PC_SV = 2176;
constexpr size_t MiB = 1u << 20;
constexpr size_t WS_CTL = 0, CTL_ZERO_BYTES = 1 * MiB;
constexpr size_t WS_SS = 64 * 1024;
constexpr size_t WS_W = 1 * MiB, W_LAYER = 24 * MiB, W_IN = 0, W_OUT = (size_t)NIN * 1024 * 2, W_GU = W_OUT + 2 * MiB, W_D = W_GU + (size_t)NGU * 1024 * 2;
constexpr size_t WS_LF = 49 * MiB, WS_CS = 51 * MiB, WS_H = 52 * MiB, WS_HB = 184 * MiB, WS_Y = 250 * MiB, WS_P = 316 * MiB, WS_END = WS_P + (size_t)MROWS * DFF * 2;
static_assert(W_D + (size_t)1024 * DFF * 2 <= W_LAYER && WS_W + 2 * W_LAYER <= WS_LF && WS_SS + 5 * (size_t)MROWS * 4 <= CTL_ZERO_BYTES, "ws map");
static_assert(WS_H + (size_t)MROWS * 1024 * 4 <= WS_HB && WS_HB + (size_t)MROWS * 1024 * 2 <= WS_Y && WS_Y + (size_t)MROWS * 1024 * 2 <= WS_P && WS_END <= 512 * MiB, "ws map");
constexpr int LDS_BYTES = 147456;
constexpr int LDS_MISC = 131072;

#define LAS __attribute__((address_space(3)))
typedef unsigned short bf16u;
typedef unsigned v4u __attribute__((ext_vector_type(4)));
typedef float f32x4 __attribute__((ext_vector_type(4)));
#define LDS_WAIT() asm volatile("s_waitcnt lgkmcnt(0)" ::: "memory")
__device__ __forceinline__ unsigned f2bf(float f) { unsigned u = __builtin_bit_cast(unsigned, f); return (u + 0x7fffu + ((u >> 16) & 1u)) >> 16; }
__device__ __forceinline__ unsigned pk2(float lo, float hi) { return f2bf(lo) | (f2bf(hi) << 16); }
__device__ __forceinline__ float wave_sum(float v) {
#pragma unroll
    for (int o = 1; o < 64; o <<= 1) v += __shfl_xor(v, o);
    return v;
}

struct Args { const float* in[15]; float* out; unsigned char* ws; };

struct WinSrc { const float* w; const float* g;
    __device__ __forceinline__ float operator()(int k, int n) const { if (n >= INW) return 0.f; const int col = n < 1408 ? n : (n < 2560 ? n + 6 : n - 2560 + 1408);
        const float sc = ((n >= PC_FQ && n < PC_FK) || (n >= PC_SQ && n < PC_SK)) ? C2F : 1.0f; return w[(size_t)k * INW + col] * g[k] * sc; } };
struct WoutSrc { const float* w; const float* fg; const float* sg;
    __device__ __forceinline__ float operator()(int k, int n) const { const float gn = k < 640 ? fg[k - 256] : sg[k - 640]; return w[(size_t)k * 1024 + n] * gn; } };
struct WguSrc { const float* wg; const float* wu; const float* g;
    __device__ __forceinline__ float operator()(int k, int c) const { const int pn = c >> 8, w = c & 255, j = pn * 128 + (w & 127); const long dlt = (w >> 7) ? (long)(wu - wg) : 0L; return wg[(long)k * DFF + j + dlt] * g[k]; } };
struct WdSrc { const float* w;
    __device__ __forceinline__ float operator()(int k, int n) const { return w[(size_t)k * 1024 + n]; } };
template <class F> __device__ __forceinline__ void conv_item(const F src, bf16u* WT, int K, int k0, int n0, LAS float* scr, int lane) {
#pragma unroll 4
    for (int i = 0; i < 32; ++i) { const int kk = 2 * i + (lane >> 5); scr[kk * 33 + (lane & 31)] = src(k0 + kk, n0 + (lane & 31)); }
    LDS_WAIT(); asm volatile("" ::: "memory");
    const int c = lane & 7;
#pragma unroll
    for (int j = 0; j < 4; ++j) { const int n = (lane >> 3) + 8 * j; const LAS float* s = scr + (8 * c) * 33 + n;
        v4u o; o.x = pk2(s[0 * 33], s[1 * 33]); o.y = pk2(s[2 * 33], s[3 * 33]); o.z = pk2(s[4 * 33], s[5 * 33]); o.w = pk2(s[6 * 33], s[7 * 33]);
        *(v4u*)(WT + (size_t)(n0 + n) * K + k0 + 8 * c) = o; }
    LDS_WAIT(); asm volatile("" ::: "memory");
}
__device__ __forceinline__ void fold_item(const float* wout, const float* pw, const float* ps, bf16u* WT, int item, int lane) {
    const int g = item >> 4, n = (item & 15) * 64 + lane;
    float acc[64];
#pragma unroll
    for (int c = 0; c < 64; ++c) acc[c] = 0.f;
    for (int d = 0; d < 64; ++d) { const float wv = wout[(size_t)(g * 64 + d) * 1024 + n] * ps[g * 64 + d];
#pragma unroll
        for (int c = 0; c < 64; ++c) acc[c] += pw[(g * 64 + c) * 64 + d] * wv; }
    bf16u* o = WT + (size_t)n * 1024 + g * 64;
#pragma unroll
    for (int c = 0; c < 64; c += 8) { v4u w; w.x = pk2(acc[c], acc[c + 1]); w.y = pk2(acc[c + 2], acc[c + 3]); w.z = pk2(acc[c + 4], acc[c + 5]); w.w = pk2(acc[c + 6], acc[c + 7]); *(v4u*)(o + c) = w; }
}
__device__ __forceinline__ void p0_prologue(const Args& A, unsigned char* ws, LAS unsigned char* lds, int wave, int lane) {
    LAS float* scr = (LAS float*)(lds + wave * 16384);
    const int gw = blockIdx.x * NWAVES + wave, NGW = gridDim.x * NWAVES;
    constexpr int I_IN = 16 * (NIN / 32), I_OUT = 12 * 32, I_GU = 16 * (NGU / 32), I_D = (DFF / 64) * 32, I_F = 64, I_L = I_IN + I_OUT + I_GU + I_D + I_F;
    for (int it = gw; it < DEPTH * I_L; it += NGW) {
        const int L = it / I_L; int r = it % I_L;
        bf16u* wb = (bf16u*)(ws + WS_W + (size_t)L * W_LAYER);
        if (r < I_IN) { WinSrc s{A.in[3] + (size_t)L * 1024 * INW, A.in[2] + L * 1024}; conv_item(s, (bf16u*)((unsigned char*)wb + W_IN), 1024, (r / (NIN / 32)) * 64, (r % (NIN / 32)) * 32, scr, lane); continue; } r -= I_IN;
        if (r < I_OUT) { WoutSrc s{A.in[9] + (size_t)L * 1024 * 1024, A.in[7] + L * 384, A.in[8] + L * 384}; conv_item(s, (bf16u*)((unsigned char*)wb + W_OUT), 1024, 256 + (r / 32) * 64, (r % 32) * 32, scr, lane); continue; } r -= I_OUT;
        if (r < I_GU) { WguSrc s{A.in[11] + (size_t)L * 1024 * DFF, A.in[12] + (size_t)L * 1024 * DFF, A.in[10] + L * 1024}; conv_item(s, (bf16u*)((unsigned char*)wb + W_GU), 1024, (r / (NGU / 32)) * 64, (r % (NGU / 32)) * 32, scr, lane); continue; } r -= I_GU;
        if (r < I_D) { WdSrc s{A.in[13] + (size_t)L * DFF * 1024}; conv_item(s, (bf16u*)((unsigned char*)wb + W_D), DFF, (r / 32) * 64, (r % 32) * 32, scr, lane); continue; } r -= I_D;
        fold_item(A.in[9] + (size_t)L * 1024 * 1024, A.in[5] + (size_t)L * 4 * 64 * 64, A.in[6] + L * 256, (bf16u*)((unsigned char*)wb + W_OUT), r, lane);
    }
    float* h = (float*)(ws + WS_H); bf16u* hb = (bf16u*)(ws + WS_HB); float* ss0 = (float*)(ws + WS_SS);
    for (int m = gw; m < MROWS; m += NGW) {
        const int b = m / LP, t = m % LP;
        f32x4 v[4]; float s = 0.f;
        if (t < LREAL) { const f32x4* src = (const f32x4*)(t < NMETA ? A.in[1] + (size_t)t * 1024 : A.in[0] + ((size_t)b * SEQ_IN + (t - NMETA)) * 1024) + lane;
#pragma unroll
            for (int j = 0; j < 4; ++j) { v[j] = src[64 * j]; s += (v[j].x * v[j].x + v[j].y * v[j].y) + (v[j].z * v[j].z + v[j].w * v[j].w); } }
        else {
#pragma unroll
            for (int j = 0; j < 4; ++j) v[j] = (f32x4){0.f, 0.f, 0.f, 0.f}; }
        s = wave_sum(s);
        f32x4* ho = (f32x4*)(h + (size_t)m * 1024) + lane; unsigned long long* bo = (unsigned long long*)(hb + (size_t)m * 1024) + lane;
#pragma unroll
        for (int j = 0; j < 4; ++j) { ho[64 * j] = v[j]; bo[64 * j] = (unsigned long long)pk2(v[j].x, v[j].y) | ((unsigned long long)pk2(v[j].z, v[j].w) << 32); }
        if (lane == 0) ss0[m] = s;
    }
}
__device__ __forceinline__ void pool_scan_phase(unsigned char* ws, LAS unsigned char* lds, unsigned* nrm, int tid, int wave, int lane) {
    const float* LF = (const float*)(ws + WS_LF); float* CS = (float*)(ws + WS_CS);
    if (blockIdx.x < NBATCH * NFH) {
        const int b = blockIdx.x / NFH, hf = blockIdx.x % NFH; constexpr int PER = 17;
        const float* lf = LF + (size_t)b * LP * 8 + hf; float* cs = CS + (size_t)(b * NFH + hf) * LP;
        float v[PER]; float s = 0.f; const int t0 = tid * PER;
#pragma unroll
        for (int i = 0; i < PER; ++i) { const int t = t0 + i; const float x = t < LP ? lf[(size_t)t * 8] : 0.f; s += x; v[i] = s; }
        float incl = s;
#pragma unroll
        for (int o = 1; o < 64; o <<= 1) { const float n = __shfl_up(incl, o); if (lane >= o) incl += n; }
        LAS float* wsum = (LAS float*)(lds + LDS_MISC + 256);
        if (lane == 63) wsum[wave] = incl;
        __syncthreads();
        float off = 0.f;
        for (int w = 0; w < wave; ++w) off += wsum[w];
        const float excl = off + incl - s;
#pragma unroll
        for (int i = 0; i < PER; ++i) { const int t = t0 + i; if (t < LP) cs[t] = excl + v[i]; }
        __syncthreads();
    }
    const bf16u* P = (const bf16u*)(ws + WS_P); bf16u* Y = (bf16u*)(ws + WS_Y);
    for (int sl = blockIdx.x; sl < 256; sl += gridDim.x) {
        if (tid < 480) { const int sub = tid / 96, task = tid % 96, which = task / 48, head = (task % 48) >> 3, chunk = task & 7; const int r0 = sl * (MROWS / 256), b = r0 / LP;
            const bf16u* src = P + (which ? PC_FK : PC_FQ) + head * 64 + chunk * 8; float mx = 0.f;
            for (int r = sub; r < MROWS / 256; r += 5) { const v4u w = *(const v4u*)(src + (size_t)(r0 + r) * NINP); float s = 0.f;
#pragma unroll
                for (int e = 0; e < 4; ++e) { const float lo = __uint_as_float(w[e] << 16), hi = __uint_as_float(w[e] & 0xffff0000u); s += lo * lo + hi * hi; }
                s += __shfl_xor(s, 1); s += __shfl_xor(s, 2); s += __shfl_xor(s, 4); mx = fmaxf(mx, s); }
            if (chunk == 0) atomicMax(nrm + (b * NFH + head) * 2 + which, __float_as_uint(mx)); }
    }
    const int rsub = tid >> 5, ch = (tid & 31) * 8, win = 2 << (ch >> 6);
    for (int c = blockIdx.x; c < MROWS / 16; c += gridDim.x) {
        const int row = c * 16 + rsub, t = row % LP; const int cnt = (t + 1 < win) ? t + 1 : win;
        float acc[8], self[8];
#pragma unroll
        for (int e = 0; e < 8; ++e) acc[e] = 0.f;
        for (int j = 0; j < cnt; ++j) { const v4u w = *(const v4u*)(P + (size_t)(row - j) * NINP + PC_U + ch);
#pragma unroll
            for (int e = 0; e < 4; ++e) { const float lo = __uint_as_float(w[e] << 16), hi = __uint_as_float(w[e] & 0xffff0000u); acc[2 * e] += lo; acc[2 * e + 1] += hi; if (j == 0) { self[2 * e] = lo; self[2 * e + 1] = hi; } } }
        const float inv = 1.0f / (float)cnt; v4u o;
#pragma unroll
        for (int e = 0; e < 4; ++e) o[e] = pk2(acc[2 * e] * inv - self[2 * e], acc[2 * e + 1] * inv - self[2 * e + 1]);
        *(v4u*)(Y + (size_t)row * 1024 + ch) = o;
    }
}
__device__ __forceinline__ void attn_phase(unsigned char* ws, unsigned char* lds_g, unsigned* ctr, const unsigned* nrm, int tid) {
    const attn_body::bf16* P = (const attn_body::bf16*)(ws + WS_P); attn_body::bf16* Y = (attn_body::bf16*)(ws + WS_Y); const float* CS = (const float*)(ws + WS_CS);
    volatile LAS unsigned* bw = (volatile LAS unsigned*)((LAS unsigned char*)lds_g + LDS_MISC);
    constexpr int NU = NBATCH * NFH * (LP / 256);
    for (;;) {
        if (tid == 0) bw[0] = atomicAdd(ctr, 1u);
        __syncthreads();
        const int it = (int)bw[0];
        __syncthreads();
        if (it >= 2 * NU) break;
        const int r = it < NU ? it : it - NU; const int qb = (LP / 256 - 1) - r / (NBATCH * NFH), bh = r % (NBATCH * NFH), b = bh / NFH, h = bh % NFH;
#ifndef NO_FOX
        if (it < NU) attn_body::fox_unit<8>(b, qb, 154.0f + 2.0f * sqrtf(__uint_as_float(nrm[bh * 2]) * __uint_as_float(nrm[bh * 2 + 1])), P + PC_FQ + h * 64, P + PC_FK + h * 64, P + PC_FV + h * 64, Y + 256 + h * 64, CS + (size_t)bh * LP, (char*)lds_g);
#endif
#ifndef NO_SB
        if (it >= NU) attn_body::sb_unit(b, qb, P + PC_SQ + h * 64, P + PC_SK + h * 64, P + PC_SV + h * 64, Y + 640 + h * 64, (char*)lds_g);
#endif
    }
}
__device__ __forceinline__ void final_phase(const Args& A, unsigned char* ws, int wave, int lane) {
    const float* h = (const float*)(ws + WS_H); const float* ss = (const float*)(ws + WS_SS) + 4 * (size_t)MROWS; const f32x4* g = (const f32x4*)A.in[14] + lane;
    const int gw = blockIdx.x * NWAVES + wave, NGW = gridDim.x * NWAVES;
    f32x4 gv[4];
#pragma unroll
    for (int j = 0; j < 4; ++j) gv[j] = g[64 * j];
    for (int m = gw; m < NBATCH * SEQ_IN; m += NGW) {
        const int b = m / SEQ_IN, s = m % SEQ_IN; const size_t row = (size_t)b * LP + NMETA + s;
        const float rs = 1.0f / sqrtf(ss[row] * (1.0f / 1024.0f) + 1e-6f);
        const f32x4* src = (const f32x4*)(h + row * 1024) + lane; f32x4* dst = (f32x4*)(A.out + (size_t)m * 1024) + lane;
#pragma unroll
        for (int j = 0; j < 4; ++j) dst[64 * j] = src[64 * j] * rs * gv[j];
    }
}

#define XB_TMO      128
#define XB_XCNT(j)  (256  + 64 * (j))
#define XB_XSUB(j)  (1280 + 64 * (j))
#define XB_XGEN(j)  (2304 + 64 * (j))
#define XB_TOP      3328
#define XB_TOPGEN   3392
#define XCD_BAR_WORDS 3456
#define XB_SPIN_CAP (1u << 18)

__device__ __forceinline__ unsigned xb_ld(unsigned* p)              { return __hip_atomic_load(p, __ATOMIC_RELAXED, __HIP_MEMORY_SCOPE_AGENT); }
__device__ __forceinline__ unsigned xb_add(unsigned* p, unsigned v) { return __hip_atomic_fetch_add(p, v, __ATOMIC_RELAXED, __HIP_MEMORY_SCOPE_AGENT); }
__device__ __forceinline__ unsigned xb_xcc_id() { return (unsigned)__builtin_amdgcn_s_getreg((3 << 11) | 20) & 0xFu; }
#define XB_SPIN(cond, bar) do { unsigned _sp = 0; while (cond) { __builtin_amdgcn_s_sleep(1); \
    if ((++_sp & 255u) == 0u) { if (xb_ld(&(bar)[XB_TMO])) break; if (_sp > XB_SPIN_CAP) { atomicAdd(&(bar)[XB_TMO], 1u); break; } } } } while (0)

struct XcdBarrier {
    unsigned* bar; unsigned x;
    volatile LAS unsigned* st;
};

__device__ __forceinline__ XcdBarrier xcd_barrier_post(unsigned* bar, volatile LAS unsigned* st) {
    XcdBarrier b; b.bar = bar; b.x = xb_xcc_id(); b.st = st;
    if (threadIdx.x == 0) (void)xb_add(&bar[XB_XCNT(b.x)], 1u);
    return b;
}
__device__ __forceinline__ void xcd_barrier_complete(unsigned* bar, unsigned x, unsigned& nloc, unsigned& nx) {
    const unsigned G = gridDim.x * gridDim.y * gridDim.z;
    unsigned sum, cnt, mine, sp = 0u;
    for (;;) {
        sum = 0u; cnt = 0u; mine = 0u;
#pragma unroll
        for (unsigned j = 0; j < 16; ++j) { const unsigned c = xb_ld(&bar[XB_XCNT(j)]); sum += c; cnt += (c > 0u) ? 1u : 0u; mine = (j == x) ? c : mine; }
        if (sum == G) break;
        __builtin_amdgcn_s_sleep(1);
        if ((++sp & 255u) == 0u) { if (xb_ld(&bar[XB_TMO])) break; if (sp > XB_SPIN_CAP) { atomicAdd(&bar[XB_TMO], 1u); break; } }
    }
    nloc = mine > 0u ? mine : 1u; nx = cnt > 0u ? cnt : 1u;
}

__device__ __forceinline__ void xcd_barrier(const XcdBarrier& b) {
    asm volatile("s_waitcnt vmcnt(0)" ::: "memory");
    __syncthreads();
    if (threadIdx.x == 0) {
        unsigned* bar = b.bar;
        __builtin_amdgcn_s_waitcnt(0);
        unsigned nloc = b.st[0], nx = b.st[1];
        if (nloc == 0u) { xcd_barrier_complete(bar, b.x, nloc, nx); b.st[0] = nloc; b.st[1] = nx; }
        const unsigned old = xb_add(&bar[XB_XSUB(b.x)], 1u);
        const unsigned gen = old / nloc;
        if (old + 1u == (gen + 1u) * nloc) {
            __builtin_amdgcn_fence(__ATOMIC_RELEASE, "agent");
            asm volatile("s_waitcnt vmcnt(0)" ::: "memory");
            const unsigned og = xb_add(&bar[XB_TOP], 1u);
            const unsigned tg = og / nx;
            if (og + 1u == (tg + 1u) * nx) xb_add(&bar[XB_TOPGEN], 1u);
            else XB_SPIN(xb_ld(&bar[XB_TOPGEN]) == tg, bar);
            __builtin_amdgcn_fence(__ATOMIC_ACQUIRE, "agent");
            xb_add(&bar[XB_XGEN(b.x)], 1u);
            asm volatile("s_waitcnt vmcnt(0)" ::: "memory");
        } else {
            XB_SPIN(xb_ld(&bar[XB_XGEN(b.x)]) == gen, bar);
            __builtin_amdgcn_fence(__ATOMIC_ACQUIRE, "agent");
            asm volatile("s_waitcnt vmcnt(0)" ::: "memory");
        }
    }
    __syncthreads();
}

#define FRESH() unsigned long zoff_ = 0; asm volatile("" : "+s"(zoff_)); unsigned char* ws = A.ws + zoff_; int tid = threadIdx.x; asm volatile("" : "+v"(tid)); const int lane = tid & 63, wave = __builtin_amdgcn_readfirstlane(tid >> 6); (void)lane; (void)wave
#ifdef PROBE
#define STAMP() do { if (blockIdx.x == 0 && threadIdx.x == 0) { ((volatile unsigned long long*)(A.ws + WS_CTL + 8192))[nst] = __builtin_amdgcn_s_memrealtime(); } ++nst; } while (0)
#else
#define STAMP() do {} while (0)
#endif
__global__ void __launch_bounds__(NWAVES * 64, 2) hymba_fwd(Args A) {
    extern __shared__ __attribute__((aligned(16))) unsigned char lds[];
    cg::grid_group grid = cg::this_grid();
    LAS unsigned char* L = (LAS unsigned char*)lds;
    if (threadIdx.x < 2) ((volatile LAS unsigned*)(L + LDS_MISC + 64))[threadIdx.x] = 0u;
    __syncthreads();
    const XcdBarrier xbar = xcd_barrier_post((unsigned*)(A.ws + WS_CTL) + 4096, (volatile LAS unsigned*)(L + LDS_MISC + 64));
#define GRID_BAR() xcd_barrier(xbar)
#ifdef PROBE
    int nst = 0; STAMP();
    for (int i = 0; i < 8; ++i) GRID_BAR();
    STAMP();
#endif
#ifndef NO_PRO
    { FRESH(); p0_prologue(A, ws, L, wave, lane); }
#endif
    grid.sync(); STAMP();
    for (int layer = 0; layer < DEPTH; ++layer) {
#ifndef NO_G1
        {
            FRESH(); const unsigned char* wb = ws + WS_W + (size_t)layer * W_LAYER;
            pg8::Gemm g{(const pg8::bf16_t*)(ws + WS_HB), (const pg8::bf16_t*)(wb + W_IN), MROWS, NIN, 1024}; pg8::StaticOrder S; S.init(MROWS, NIN, (int)gridDim.x, (int)blockIdx.x);
            pg8::EpiIn E{(pg8::bf16_t*)(ws + WS_P), (float*)(ws + WS_LF), (const float*)(ws + WS_SS) + (size_t)(2 * layer) * MROWS, A.in[4] + layer * NFH};
            pg8::gemm_phase<pg8::EpiIn, pg8::StaticOrder, true, true>(L, g, S, E);
        }
#endif
        GRID_BAR(); STAMP();
#ifndef NO_POOL
        { FRESH(); pool_scan_phase(ws, L, (unsigned*)(ws + WS_CTL) + 128 + 64 * layer, tid, wave, lane); }
#endif
        GRID_BAR(); STAMP();
        { FRESH(); attn_phase(ws, lds, (unsigned*)(ws + WS_CTL) + 64 * layer, (const unsigned*)(ws + WS_CTL) + 128 + 64 * layer, tid); }
        GRID_BAR(); STAMP();
#ifndef NO_G3
        {
            FRESH(); const unsigned char* wb = ws + WS_W + (size_t)layer * W_LAYER;
            pg8::Gemm g{(const pg8::bf16_t*)(ws + WS_Y), (const pg8::bf16_t*)(wb + W_OUT), MROWS, 1024, 1024}; pg8::StaticOrder S; S.init(MROWS, 1024, (int)gridDim.x, (int)blockIdx.x);
            pg8::EpiRes E{(float*)(ws + WS_H), (pg8::bf16_t*)(ws + WS_HB), (float*)(ws + WS_SS) + (size_t)(2 * layer + 1) * MROWS};
            pg8::gemm_phase<pg8::EpiRes, pg8::StaticOrder, true, true>(L, g, S, E);
        }
#endif
        GRID_BAR(); STAMP();
#ifndef NO_G4
        {
            FRESH(); const unsigned char* wb = ws + WS_W + (size_t)layer * W_LAYER;
            pg8::Gemm g{(const pg8::bf16_t*)(ws + WS_HB), (const pg8::bf16_t*)(wb + W_GU), MROWS, NGU, 1024}; pg8::StaticOrder S; S.init(MROWS, NGU, (int)gridDim.x, (int)blockIdx.x);
            pg8::EpiGU E{(pg8::bf16_t*)(ws + WS_P), (const float*)(ws + WS_SS) + (size_t)(2 * layer + 1) * MROWS};
            pg8::gemm_phase<pg8::EpiGU, pg8::StaticOrder, true, true>(L, g, S, E);
        }
#endif
        GRID_BAR(); STAMP();
#ifndef NO_G5
        {
            FRESH(); const unsigned char* wb = ws + WS_W + (size_t)layer * W_LAYER;
            pg8::Gemm g{(const pg8::bf16_t*)(ws + WS_P), (const pg8::bf16_t*)(wb + W_D), MROWS, 1024, DFF}; pg8::StaticOrder S; S.init(MROWS, 1024, (int)gridDim.x, (int)blockIdx.x);
            pg8::EpiRes E{(float*)(ws + WS_H), (pg8::bf16_t*)(ws + WS_HB), (float*)(ws + WS_SS) + (size_t)(2 * layer + 2) * MROWS};
            pg8::gemm_phase<pg8::EpiRes, pg8::StaticOrder, true, true>(L, g, S, E);
        }
#endif
        GRID_BAR(); STAMP();
    }
    { FRESH(); final_phase(A, ws, wave, lane); }
#ifdef PROBE
    STAMP();
    grid.sync();
    {
        volatile unsigned long long* T = (volatile unsigned long long*)(A.ws + WS_CTL + 8192);
        if (blockIdx.x == 0) {
            const unsigned long long dA = T[PA + 1] - T[PA], dB = T[PB + 1] - T[PB];
            for (unsigned long long i = threadIdx.x; i < dB; i += NWAVES * 64) A.out[i] += 0.125f;
            if (threadIdx.x == 0) { const unsigned long long t0 = __builtin_amdgcn_s_memrealtime(); while (__builtin_amdgcn_s_memrealtime() - t0 < dA) __builtin_amdgcn_s_sleep(8); }
        }
    }
#endif
}

extern "C" void kernel_launch(void* const* d_in, const int* in_sizes, int n_in, void* d_out, int out_size, void* d_ws, size_t ws_size, hipStream_t stream) {
    static int grid = 0;
    if (grid == 0) {
        if (n_in != 15 || out_size != NBATCH * SEQ_IN * DMODEL || ws_size < WS_END) { fprintf(stderr, "kernel_launch: unexpected shapes (n_in %d out %d ws %zu, need %zu)\n", n_in, out_size, ws_size, (size_t)WS_END); grid = -1; return; }
        int dev = 0, cus = 0, per_cu = 0;
        if (hipGetDevice(&dev) != hipSuccess || hipDeviceGetAttribute(&cus, hipDeviceAttributeMultiprocessorCount, dev) != hipSuccess) { grid = -1; return; }
        if (hipFuncSetAttribute((const void*)hymba_fwd, hipFuncAttributeMaxDynamicSharedMemorySize, LDS_BYTES) != hipSuccess) { fprintf(stderr, "kernel_launch: hipFuncSetAttribute failed\n"); grid = -1; return; }
        if (hipOccupancyMaxActiveBlocksPerMultiprocessor(&per_cu, (const void*)hymba_fwd, NWAVES * 64, LDS_BYTES) != hipSuccess || per_cu < 1) { fprintf(stderr, "kernel_launch: occupancy query says %d\n", per_cu); per_cu = 1; }
        (void)hipGetLastError();
        grid = cus;
    }
    if (grid < 0) return;
    if (hipMemsetAsync((char*)d_ws + WS_CTL, 0, CTL_ZERO_BYTES, stream) != hipSuccess) { fprintf(stderr, "kernel_launch: memset failed\n"); return; }
    Args a{};
    for (int i = 0; i < 15; ++i) a.in[i] = (const float*)d_in[i];
    a.out = (float*)d_out; a.ws = (unsigned char*)d_ws;
    void* args[] = {&a};
    const hipError_t e = hipLaunchCooperativeKernel((const void*)hymba_fwd, dim3(grid), dim3(NWAVES * 64), args, LDS_BYTES, stream);
    if (e != hipSuccess) fprintf(stderr, "kernel_launch: cooperative launch failed: %s (grid %d)\n", hipGetErrorString(e), grid);
}
```

```cpp
#include <hip/hip_runtime.h>
#include <hip/hip_cooperative_groups.h>
#include <cstdio>
#include <cstdint>
namespace pg8 {
#define PG8_LAS __attribute__((address_space(3)))
typedef unsigned short bf16_t;
typedef short bf16x8 __attribute__((ext_vector_type(8)));
typedef float f32x4 __attribute__((ext_vector_type(4)));
typedef unsigned u32x4 __attribute__((ext_vector_type(4)));
constexpr int BM = 256, BK = 64, HALF = 128, HTB = HALF * BK * 2  , STAGE_BYTES = 8 * HTB, NXCD = 8, WGM = 8;

__host__ __device__ __forceinline__ int lds_byte(int r, int c) { const int st = (r >> 4) * 2 + (c >> 5), rr = r & 15, cc = c & 31, ob = rr * 64 + cc * 2; return st * 1024 + (ob ^ (((ob >> 9) & 1) << 5)); }
__host__ __device__ __forceinline__ void stage_rc(int b, int& R, int& C) { const int st = b / 1024, sb = b % 1024, swz = sb ^ (((sb >> 9) & 1) << 5); R = (st >> 1) * 16 + swz / 64; C = (st & 1) * 32 + (swz % 64) / 2; }
__host__ __device__ __forceinline__ int perm32(int rho) { const int n = rho >> 4, i = rho & 15; return 8 * (i >> 2) + 4 * n + (i & 3); }

struct Unit { int pm, pn; };
struct Gemm { const bf16_t* A; const bf16_t* Bt; int M, N, K; };

struct StaticOrder {
    int nM, nN, nwg, G, c;
    __host__ __device__ void init(int M, int N, int G_, int c_) { nM = M / BM; nN = N / BM; nwg = nM * nN; G = G_; c = c_; }
    __host__ __device__ bool next(int i, Unit& u) const {
        const long L = (long)i * G + c; if (L >= nwg) return false;
        int wgid = (int)L; { const int q = nwg / NXCD, r = nwg % NXCD, xcd = wgid % NXCD, off = wgid / NXCD; wgid = (xcd < r ? xcd * (q + 1) : r * (q + 1) + (xcd - r) * q) + off; }
        const int nig = WGM * nN, gid = wgid / nig, fm = gid * WGM, gsz = (nM - fm) < WGM ? (nM - fm) : WGM;
        u.pm = fm + ((wgid % nig) % gsz); u.pn = (wgid % nig) / gsz; return true;
    }
    __device__ __forceinline__ void a_ready(const Unit&) const {}
    __device__ __forceinline__ void done(const Unit&) const {}
};

__device__ __forceinline__ unsigned cvt_pk_bf16(float lo, float hi) { unsigned r; asm volatile("v_cvt_pk_bf16_f32 %0, %1, %2" : "=v"(r) : "v"(lo), "v"(hi)); return r; }
typedef unsigned u32x2 __attribute__((ext_vector_type(2)));
constexpr float RMS_EPS = 1e-6f;
struct EpiIn {
    static constexpr bool PERM = true, AFTER_DRAIN = false;
    bf16_t* P; float* LF; const float* ss; const float* fb;
    __device__ __forceinline__ void operator()(const f32x4 (&acc)[2][2][4][2], const Unit& u, int wr, int wc, int fr, int fq) const {
        const int row0 = u.pm * BM + wr * 64 + fr;
        if (u.pn < 10) {
            const int col0 = u.pn * BM + wc * 32 + 8 * fq;
#pragma unroll
            for (int ai = 0; ai < 2; ++ai)
#pragma unroll
                for (int m = 0; m < 4; ++m) { const int row = row0 + ai * HALF + m * 16; const float rs = __builtin_amdgcn_rsqf(ss[row] * (1.0f / 1024.0f) + RMS_EPS);
                    bf16_t* rowp = P + (size_t)row * 2560 + col0;
#pragma unroll
                    for (int bj = 0; bj < 2; ++bj) { const f32x4 v0 = acc[ai][bj][m][0] * rs, v1 = acc[ai][bj][m][1] * rs;
                        u32x4 w; w.x = cvt_pk_bf16(v0[0], v0[1]); w.y = cvt_pk_bf16(v0[2], v0[3]); w.z = cvt_pk_bf16(v1[0], v1[1]); w.w = cvt_pk_bf16(v1[2], v1[3]);
                        *(u32x4*)(rowp + bj * HALF) = w; } }
        } else if (wc == 0 && fq == 0) {
            float b[6];
#pragma unroll
            for (int j = 0; j < 6; ++j) b[j] = fb[j];
#pragma unroll
            for (int ai = 0; ai < 2; ++ai)
#pragma unroll
                for (int m = 0; m < 4; ++m) { const int row = row0 + ai * HALF + m * 16; const float rs = __builtin_amdgcn_rsqf(ss[row] * (1.0f / 1024.0f) + RMS_EPS);
                    const f32x4 v0 = acc[ai][0][m][0] * rs, v1 = acc[ai][0][m][1] * rs;
                    float x[6] = {v0[0] + b[0], v0[1] + b[1], v0[2] + b[2], v0[3] + b[3], v1[0] + b[4], v1[1] + b[5]};
                    float l[6];
#pragma unroll
                    for (int j = 0; j < 6; ++j) l[j] = -(fmaxf(-x[j], 0.f) + log1pf(expf(-fabsf(x[j])))) * 1.4426950408889634f;
                    *(f32x4*)(LF + (size_t)row * 8) = (f32x4){l[0], l[1], l[2], l[3]};
                    *(f32x4*)(LF + (size_t)row * 8 + 4) = (f32x4){l[4], l[5], 0.f, 0.f}; }
        }
    }
};
struct EpiRes {
    static constexpr bool PERM = true, AFTER_DRAIN = false;
    float* h; bf16_t* hb; float* ssn;
    __device__ __forceinline__ void operator()(const f32x4 (&acc)[2][2][4][2], const Unit& u, int wr, int wc, int fr, int fq) const {
        const int row0 = u.pm * BM + wr * 64 + fr, col0 = u.pn * BM + wc * 32 + 8 * fq;
#pragma unroll
        for (int ai = 0; ai < 2; ++ai)
#pragma unroll
            for (int m = 0; m < 4; ++m) { const int row = row0 + ai * HALF + m * 16; float* hp = h + (size_t)row * 1024 + col0; bf16_t* bp = hb + (size_t)row * 1024 + col0; float s = 0.f;
#pragma unroll
                for (int bj = 0; bj < 2; ++bj) { f32x4 a = *(const f32x4*)(hp + bj * HALF), b = *(const f32x4*)(hp + bj * HALF + 4);
                    a = a + acc[ai][bj][m][0]; b = b + acc[ai][bj][m][1];
                    *(f32x4*)(hp + bj * HALF) = a; *(f32x4*)(hp + bj * HALF + 4) = b;
                    s += (a[0] * a[0] + a[1] * a[1]) + (a[2] * a[2] + a[3] * a[3]) + (b[0] * b[0] + b[1] * b[1]) + (b[2] * b[2] + b[3] * b[3]);
                    u32x4 w; w.x = cvt_pk_bf16(a[0], a[1]); w.y = cvt_pk_bf16(a[2], a[3]); w.z = cvt_pk_bf16(b[0], b[1]); w.w = cvt_pk_bf16(b[2], b[3]);
                    *(u32x4*)(bp + bj * HALF) = w; }
                s += __shfl_xor(s, 16); s += __shfl_xor(s, 32);
                if (fq == 0) atomicAdd(ssn + row, s);
                asm volatile("" ::: "memory"); }
    }
};
struct EpiGU {
    static constexpr bool PERM = true, AFTER_DRAIN = false;
    bf16_t* H; const float* ss;
    __device__ __forceinline__ void operator()(const f32x4 (&acc)[2][2][4][2], const Unit& u, int wr, int wc, int fr, int fq) const {
        const int row0 = u.pm * BM + wr * 64 + fr, col0 = u.pn * HALF + wc * 32 + 8 * fq;
#pragma unroll
        for (int ai = 0; ai < 2; ++ai)
#pragma unroll
            for (int m = 0; m < 4; ++m) { const int row = row0 + ai * HALF + m * 16; const float rs = __builtin_amdgcn_rsqf(ss[row] * (1.0f / 1024.0f) + RMS_EPS);
                float o[8];
#pragma unroll
                for (int n = 0; n < 2; ++n)
#pragma unroll
                    for (int e = 0; e < 4; ++e) { const float g = acc[ai][0][m][n][e] * rs, up = acc[ai][1][m][n][e] * rs;
                        o[4 * n + e] = g * __builtin_amdgcn_rcpf(1.0f + __builtin_amdgcn_exp2f(-1.4426950408889634f * g)) * up; }
                u32x4 w; w.x = cvt_pk_bf16(o[0], o[1]); w.y = cvt_pk_bf16(o[2], o[3]); w.z = cvt_pk_bf16(o[4], o[5]); w.w = cvt_pk_bf16(o[6], o[7]);
                *(u32x4*)(H + (size_t)row * 2816 + col0) = w; }
    }
};
template <class Epi, class Sched, bool ALIGN_EPI = false, bool SP2 = false>
__device__ __forceinline__ void gemm_phase(PG8_LAS unsigned char* lds, const Gemm g, const Sched& S, const Epi& E) {
    int tid_ = threadIdx.x; asm volatile("" : "+v"(tid_));
    const int tid = tid_, wid = __builtin_amdgcn_readfirstlane(tid >> 6), lane = tid & 63, wr = wid >> 2, wc = wid & 3, fr = lane & 15, fq = lane >> 4;
    const int K = g.K, nt = K / BK;
    unsigned voffA[2], voffB[2];
#pragma unroll
    for (int i = 0; i < 2; ++i) { int R, C; stage_rc(tid * 16 + i * 8192, R, C); const int Rb = Epi::PERM ? ((R & ~31) + perm32(R & 31)) : R;
        voffA[i] = (unsigned)(R * K + C) * 2u; voffB[i] = (unsigned)(Rb * K + C) * 2u; }
    const size_t kstep = (size_t)(BK * 2);
    const size_t hstep = (size_t)HALF * K * 2;
    const size_t tstep = 2 * hstep;
    const unsigned ldsw = (unsigned)wid * 1024u;
    const int aoff = lds_byte(wr * 64 + fr, fq * 8), boff = lds_byte(wc * 32 + fr, fq * 8);
#define PG8_SA(b, h) (((b) * 2 + (h)) * HTB)
#define PG8_SB(b, h) ((4 + (b) * 2 + (h)) * HTB)
#define PG8_STAGE(bufoff, gbase, voff) do { _Pragma("unroll") for (int _i = 0; _i < 2; ++_i) \
        __builtin_amdgcn_global_load_lds((const unsigned*)((const char*)(gbase) + (voff)[_i]), (PG8_LAS unsigned*)(lds + (bufoff) + ldsw + _i * 8192), 16, 0, 0); } while (0)
#define PG8_LDA(dst, b, h) do { _Pragma("unroll") for (int m = 0; m < 4; ++m) _Pragma("unroll") for (int k = 0; k < 2; ++k) dst[m][k] = *(const PG8_LAS bf16x8*)(lds + PG8_SA(b, h) + aoff + m * 2048 + k * 1024); } while (0)
#define PG8_LDB(dst, b, h) do { _Pragma("unroll") for (int n = 0; n < 2; ++n) _Pragma("unroll") for (int k = 0; k < 2; ++k) dst[n][k] = *(const PG8_LAS bf16x8*)(lds + PG8_SB(b, h) + boff + n * 2048 + k * 1024); } while (0)
#define PG8_MMA(ai, bj, At, Bt) do { __builtin_amdgcn_s_setprio(1); _Pragma("unroll") for (int m = 0; m < 4; ++m) _Pragma("unroll") for (int n = 0; n < 2; ++n) _Pragma("unroll") for (int k = 0; k < 2; ++k) \
        acc[ai][bj][m][n] = __builtin_amdgcn_mfma_f32_16x16x32_bf16(Bt[n][k], At[m][k], acc[ai][bj][m][n], 0, 0, 0); __builtin_amdgcn_s_setprio(0); } while (0)
#define PG8_WAIT_V(n) asm volatile("s_waitcnt vmcnt(" #n ")" ::: "memory")
#define PG8_WAIT_L(n) asm volatile("s_waitcnt lgkmcnt(" #n ")" ::: "memory")
#define PG8_BAR __builtin_amdgcn_s_barrier()
#define PG8_SCHED __builtin_amdgcn_sched_barrier(0)
    Unit cur, nxt; int ui = 0;
    if (!S.next(0, cur)) return;
    f32x4 acc[2][2][4][2];
#pragma unroll
    for (int a = 0; a < 2; ++a)
#pragma unroll
        for (int b = 0; b < 2; ++b)
#pragma unroll
            for (int m = 0; m < 4; ++m)
#pragma unroll
                for (int n = 0; n < 2; ++n) acc[a][b][m][n] = (f32x4){0.f, 0.f, 0.f, 0.f};
    bf16x8 At[4][2], B0[2][2], B1[2][2];
    const char* cA = (const char*)g.A + (size_t)cur.pm * tstep; const char* cB = (const char*)g.Bt + (size_t)cur.pn * tstep;
    S.a_ready(cur);
    if constexpr (SP2) {
        PG8_STAGE(PG8_SB(0, 0), cB, voffB); PG8_STAGE(PG8_SB(0, 1), cB + hstep, voffB); PG8_STAGE(PG8_SA(0, 0), cA, voffA); PG8_STAGE(PG8_SA(0, 1), cA + hstep, voffA);
        if (wr == 1) PG8_BAR;
        PG8_WAIT_V(2); PG8_BAR;
        PG8_STAGE(PG8_SB(1, 0), cB + kstep, voffB); PG8_STAGE(PG8_SA(1, 0), cA + kstep, voffA); PG8_STAGE(PG8_SB(1, 1), cB + hstep + kstep, voffB);
        PG8_WAIT_V(6); PG8_BAR;
    } else {
        PG8_STAGE(PG8_SB(0, 0), cB, voffB); PG8_STAGE(PG8_SA(0, 0), cA, voffA); PG8_STAGE(PG8_SB(0, 1), cB + hstep, voffB); PG8_STAGE(PG8_SA(0, 1), cA + hstep, voffA);
        if (wr == 1) PG8_BAR;
        PG8_WAIT_V(4); PG8_BAR;
        PG8_STAGE(PG8_SB(1, 0), cB + kstep, voffB); PG8_STAGE(PG8_SA(1, 0), cA + kstep, voffA); PG8_STAGE(PG8_SB(1, 1), cB + hstep + kstep, voffB);
        PG8_WAIT_V(6); PG8_BAR;
    }
    for (;;) {
        const bool has_next = S.next(ui + 1, nxt);
        const char* nA = has_next ? (const char*)g.A + (size_t)nxt.pm * tstep : cA; const char* nB = has_next ? (const char*)g.Bt + (size_t)nxt.pn * tstep : cB;
        for (int t = 0; t < nt; t += 2) {
            const bool last = (t == nt - 2);
            const char* a1 = cA + (size_t)(t + 1) * kstep;
            const char* a2 = last ? nA : cA + (size_t)(t + 2) * kstep; const char* b2 = last ? nB : cB + (size_t)(t + 2) * kstep;
            const char* a3 = a2 + kstep; const char* b3 = b2 + kstep;
            if (last && has_next) S.a_ready(nxt);
            if constexpr (SP2) {
            PG8_LDB(B0, 0, 0); PG8_LDB(B1, 0, 1); PG8_SCHED; PG8_LDA(At, 0, 0); PG8_STAGE(PG8_SA(1, 1), a1 + hstep, voffA);
            PG8_WAIT_V(8); PG8_WAIT_L(0); PG8_BAR; PG8_MMA(0, 0, At, B0); PG8_MMA(0, 1, At, B1); PG8_BAR; PG8_SCHED;
            PG8_LDA(At, 0, 1); PG8_STAGE(PG8_SB(0, 0), b2, voffB); PG8_STAGE(PG8_SB(0, 1), b2 + hstep, voffB); PG8_STAGE(PG8_SA(0, 0), a2, voffA);
            PG8_WAIT_V(8); PG8_WAIT_L(0); PG8_BAR; PG8_MMA(1, 0, At, B0); PG8_MMA(1, 1, At, B1); PG8_BAR; PG8_SCHED;
            PG8_LDB(B0, 1, 0); PG8_LDB(B1, 1, 1); PG8_SCHED; PG8_LDA(At, 1, 0); PG8_STAGE(PG8_SA(0, 1), a2 + hstep, voffA);
            PG8_WAIT_V(8); PG8_WAIT_L(0); PG8_BAR; PG8_MMA(0, 0, At, B0); PG8_MMA(0, 1, At, B1); PG8_BAR; PG8_SCHED;
            PG8_LDA(At, 1, 1); PG8_STAGE(PG8_SB(1, 0), b3, voffB); PG8_STAGE(PG8_SB(1, 1), b3 + hstep, voffB); PG8_STAGE(PG8_SA(1, 0), a3, voffA);
            PG8_WAIT_V(8); PG8_WAIT_L(0); PG8_BAR; PG8_MMA(1, 0, At, B0); PG8_MMA(1, 1, At, B1); PG8_BAR; PG8_SCHED;
            } else {
            PG8_LDB(B0, 0, 0); PG8_SCHED; PG8_LDA(At, 0, 0); PG8_STAGE(PG8_SA(1, 1), a1 + hstep, voffA);
            PG8_WAIT_L(8); PG8_BAR; PG8_WAIT_L(0); PG8_MMA(0, 0, At, B0); PG8_BAR; PG8_SCHED;
            PG8_LDB(B1, 0, 1); PG8_STAGE(PG8_SB(0, 0), b2, voffB);
            PG8_BAR; PG8_WAIT_L(0); PG8_MMA(0, 1, At, B1); PG8_BAR;
            PG8_LDA(At, 0, 1); PG8_STAGE(PG8_SA(0, 0), a2, voffA);
            PG8_BAR; PG8_WAIT_L(0); PG8_MMA(1, 0, At, B0); PG8_BAR; PG8_SCHED;
            PG8_STAGE(PG8_SB(0, 1), b2 + hstep, voffB);
            PG8_WAIT_V(6); PG8_BAR; PG8_MMA(1, 1, At, B1); PG8_BAR;
            PG8_LDB(B0, 1, 0); PG8_SCHED; PG8_LDA(At, 1, 0); PG8_STAGE(PG8_SA(0, 1), a2 + hstep, voffA);
            PG8_WAIT_L(8); PG8_BAR; PG8_WAIT_L(0); PG8_MMA(0, 0, At, B0); PG8_BAR; PG8_SCHED;
            PG8_LDB(B1, 1, 1); PG8_STAGE(PG8_SB(1, 0), b3, voffB);
            PG8_BAR; PG8_WAIT_L(0); PG8_MMA(0, 1, At, B1); PG8_BAR;
            PG8_LDA(At, 1, 1); PG8_STAGE(PG8_SA(1, 0), a3, voffA);
            PG8_BAR; PG8_WAIT_L(0); PG8_MMA(1, 0, At, B0); PG8_BAR; PG8_SCHED;
            PG8_STAGE(PG8_SB(1, 1), b3 + hstep, voffB);
            PG8_WAIT_V(6); PG8_BAR; PG8_MMA(1, 1, At, B1); PG8_BAR;
            }
        }
        if constexpr (ALIGN_EPI) { if (wr == 0) PG8_BAR; }
        if constexpr (!Epi::AFTER_DRAIN) { E(acc, cur, wr, wc, fr, fq); S.done(cur); }
        if (!has_next) break;
#pragma unroll
        for (int a = 0; a < 2; ++a)
#pragma unroll
            for (int b = 0; b < 2; ++b)
#pragma unroll
                for (int m = 0; m < 4; ++m)
#pragma unroll
                    for (int n = 0; n < 2; ++n) acc[a][b][m][n] = (f32x4){0.f, 0.f, 0.f, 0.f};
        cur = nxt; cA = nA; cB = nB; ++ui;
        if constexpr (ALIGN_EPI) { if (wr == 1) PG8_BAR; }
    }
    PG8_WAIT_V(0);
    if constexpr (!ALIGN_EPI) { if (wr == 0) PG8_BAR; }
    PG8_BAR;
    if constexpr (Epi::AFTER_DRAIN) { E.fused(acc, cur, wr, wc, fr, fq, lds, wid, lane); S.done(cur); }
#undef PG8_SA
#undef PG8_SB
#undef PG8_STAGE
#undef PG8_LDA
#undef PG8_LDB
#undef PG8_MMA
#undef PG8_WAIT_V
#undef PG8_WAIT_L
#undef PG8_BAR
#undef PG8_SCHED
}
}
#include <hip/hip_bf16.h>
#include <cmath>
namespace attn_body {
using bf16=__hip_bfloat16;
using bf16x8=__attribute__((ext_vector_type(8)))short;
using s16x4=__attribute__((ext_vector_type(4)))short;
using f32x16=__attribute__((ext_vector_type(16)))float;
using u32x4=__attribute__((ext_vector_type(4)))unsigned;
constexpr int SEQ=8448,D=64,DM=2560,DMO=1024;
using f32x4=__attribute__((ext_vector_type(4)))float;
constexpr int NW=8,QBLK=32,QB=QBLK*NW,KVBLK=64,NQB=SEQ/QB;
constexpr int ATTN_UNIT_ROWS=QB;
__device__ __forceinline__ int crow(int r,int hi){return (r&3)+8*(r>>2)+4*hi;}
#define SBAR() __builtin_amdgcn_sched_barrier(0)
__device__ __forceinline__ void cmask(f32x16&p0,f32x16&p1,int jb,int qrel,int hi){
  const float NEG=-INFINITY; int kb=64*jb+4*hi;
  #pragma unroll
  for(int r=0;r<16;++r){int kv=kb+(r&3)+8*(r>>2); if(kv>qrel)p0[r]=NEG; if(kv+32>qrel)p1[r]=NEG;}
}

constexpr int NSLOT=3, SLOTB=8192;
constexpr int LDS_K=0, LDS_V=NSLOT*SLOTB, LDS_WS=2*NSLOT*SLOTB, LDS_OST=LDS_WS+NW*64*4, LDS_BYTES=LDS_OST+NW*4096, LDS_CS=LDS_BYTES, LDS_FLAGS=LDS_CS+SEQ*4, LDS_END=LDS_FLAGS+256;
constexpr float C2=0.125f*1.4426950408889634f;
__device__ __forceinline__ void glds16(const void*gsrc,unsigned lds_dst){unsigned keep;
  asm volatile("s_mov_b32 %0, m0\n\ts_mov_b32 m0, %2\n\ts_nop 0\n\tglobal_load_lds_dwordx4 %1, off\n\ts_mov_b32 m0, %0":"=&s"(keep):"v"(gsrc),"s"(lds_dst):"memory");}
__device__ __forceinline__ float max3f(float a,float b,float c){float r;asm("v_max3_f32 %0, %1, %2, %3":"=v"(r):"v"(a),"v"(b),"v"(c));return r;}
__device__ __forceinline__ float max2f(float a,float b){float r;asm("v_max_f32_e32 %0, %1, %2":"=v"(r):"v"(a),"v"(b));return r;}
__device__ __forceinline__ float fadd_s(float a,float b){float r;asm("v_add_f32_e32 %0, %1, %2":"=v"(r):"v"(a),"v"(b));return r;}
__device__ __forceinline__ float fsub_s(float a,float b){float r;asm("v_sub_f32_e32 %0, %1, %2":"=v"(r):"v"(a),"v"(b));return r;}
typedef float f32x2_t __attribute__((ext_vector_type(2))); typedef __bf16 bf16x2_t __attribute__((ext_vector_type(2)));
__device__ __forceinline__ unsigned cvtpk_s(float lo,float hi){f32x2_t v={lo,hi};bf16x2_t b=__builtin_convertvector(v,bf16x2_t);return __builtin_bit_cast(unsigned,b);}
#define WAIT_BAR(N) asm volatile("s_waitcnt vmcnt(" #N ") lgkmcnt(0)\n\ts_barrier":::"memory")

__device__ __forceinline__ void qkt(f32x16&p0,f32x16&p1,const char*Kslot,const bf16x8*qr,int r32,int hi){
  const char*kb=Kslot+hi*1024+r32*16;
  #pragma unroll
  for(int d0=0;d0<4;++d0){
    const bf16x8 b0=*reinterpret_cast<const bf16x8*>(kb+d0*2048);
    const bf16x8 b1=*reinterpret_cast<const bf16x8*>(kb+d0*2048+512);
    {p0=__builtin_amdgcn_mfma_f32_32x32x16_bf16(b0,qr[d0],p0,0,0,0);p1=__builtin_amdgcn_mfma_f32_32x32x16_bf16(b1,qr[d0],p1,0,0,0);}}
}
typedef __attribute__((address_space(3))) const char* lds_cptr;
typedef short v4i16_t __attribute__((ext_vector_type(4)));
__device__ __forceinline__ void kload8(bf16x8*kf,lds_cptr kp){
  kf[0]=*(const __attribute__((address_space(3))) bf16x8*)(kp);      kf[1]=*(const __attribute__((address_space(3))) bf16x8*)(kp+512);
  kf[2]=*(const __attribute__((address_space(3))) bf16x8*)(kp+2048); kf[3]=*(const __attribute__((address_space(3))) bf16x8*)(kp+2560);
  kf[4]=*(const __attribute__((address_space(3))) bf16x8*)(kp+4096); kf[5]=*(const __attribute__((address_space(3))) bf16x8*)(kp+4608);
  kf[6]=*(const __attribute__((address_space(3))) bf16x8*)(kp+6144); kf[7]=*(const __attribute__((address_space(3))) bf16x8*)(kp+6656);
}
__device__ __forceinline__ void kload2(bf16x8*kf,lds_cptr kp,int j){ kf[2*j]=*(const __attribute__((address_space(3))) bf16x8*)(kp+j*2048); kf[2*j+1]=*(const __attribute__((address_space(3))) bf16x8*)(kp+j*2048+512); }
__device__ __forceinline__ s16x4 vtr(lds_cptr p){ return __builtin_bit_cast(s16x4,__builtin_amdgcn_ds_read_tr16_b64_v4i16((__attribute__((address_space(3))) v4i16_t*)p)); }
__device__ __forceinline__ float rowmax(const f32x16&p0,const f32x16&p1){
  float a=max3f(p0[0],p0[1],p1[0]),b=max3f(p0[2],p0[3],p1[1]);a=max3f(a,p1[2],p1[3]);
  #pragma unroll
  for(int r=4;r<16;r+=4){a=max3f(a,p0[r],p0[r+1]);b=max3f(b,p0[r+2],p0[r+3]);a=max3f(a,p1[r],p1[r+1]);b=max3f(b,p1[r+2],p1[r+3]);}
  const float m=max2f(a,b);
  auto rr=__builtin_amdgcn_permlane32_swap(__float_as_uint(m),__float_as_uint(m),false,false);
  return max2f(__uint_as_float(rr[0]),__uint_as_float(rr[1]));
}
__device__ __forceinline__ void pv(f32x16*o,int vb,bf16x8 pa0,bf16x8 pa1,bf16x8 pa2,bf16x8 pa3){
  #pragma unroll
  for(int d0=0;d0<2;++d0){s16x4 lo[4],hi[4];
    #pragma unroll
    for(int ks=0;ks<4;++ks){
      asm volatile("ds_read_b64_tr_b16 %0,%1 offset:%c2":"=&v"(lo[ks]):"v"(vb),"i"(d0*4096+ks*1024):"memory");
      asm volatile("ds_read_b64_tr_b16 %0,%1 offset:%c2":"=&v"(hi[ks]):"v"(vb),"i"(d0*4096+ks*1024+512):"memory");}
    asm volatile("s_waitcnt lgkmcnt(0)":::"memory");SBAR();
    #define PK(k) (bf16x8){lo[k][0],lo[k][1],lo[k][2],lo[k][3],hi[k][0],hi[k][1],hi[k][2],hi[k][3]}
    o[d0]=__builtin_amdgcn_mfma_f32_32x32x16_bf16(pa0,PK(0),o[d0],0,0,0);
    o[d0]=__builtin_amdgcn_mfma_f32_32x32x16_bf16(pa1,PK(1),o[d0],0,0,0);
    o[d0]=__builtin_amdgcn_mfma_f32_32x32x16_bf16(pa2,PK(2),o[d0],0,0,0);
    o[d0]=__builtin_amdgcn_mfma_f32_32x32x16_bf16(pa3,PK(3),o[d0],0,0,0);
    #undef PK
  }
}

__device__ __forceinline__ u32x4 head_rms(u32x4 v){ float x[8];
  #pragma unroll
  for(int i=0;i<4;++i){x[2*i]=__uint_as_float(v[i]<<16);x[2*i+1]=__uint_as_float(v[i]&0xffff0000u);}
  float s=0.f;
  #pragma unroll
  for(int i=0;i<8;++i)s+=x[i]*x[i];
  s+=__shfl_xor(s,1);s+=__shfl_xor(s,2);s+=__shfl_xor(s,4);
  const float rs=__builtin_amdgcn_rsqf(s*(1.0f/64.0f)+1e-6f); u32x4 w;
  #pragma unroll
  for(int i=0;i<4;++i)w[i]=cvtpk_s(x[2*i]*rs,x[2*i+1]*rs);
  return w; }
#ifndef ATTN_STORE16
#define ATTN_STORE16(p,v) (*(u32x4*)(p)=(v))
#endif
template<int THRL> __device__ __forceinline__ void fox_unit(int b,int qb,float dthr,const bf16*Q,const bf16*__restrict__ K,const bf16*__restrict__ V,bf16*O,const float*__restrict__ csg,char*shm){
  int tid_=threadIdx.x; asm volatile("":"+v"(tid_)); const int tid=tid_,lane=tid&63,r32=lane&31,hi=lane>>5; const int wid=__builtin_amdgcn_readfirstlane(tid>>6);
  const long rowbase=(long)b*SEQ; const int q0=qb*QB;
  const bf16*Qw=Q+(rowbase+q0+wid*QBLK)*DM;
  const unsigned lds0=(unsigned)(uintptr_t)shm; const lds_cptr shm3=(lds_cptr)shm;
  float*wsf=(float*)(shm+LDS_WS)+wid*64;
  const unsigned kdst=lds0+LDS_K+wid*1024, vdst=lds0+LDS_V+wid*1024;
  #define DMA_K(t,slot) glds16(ksrc+(long)(t)*KVBLK*DM,(unsigned)__builtin_amdgcn_readfirstlane(kdst+(slot)))
  #define DMA_V(t,slot) glds16(vsrc+(long)(t)*KVBLK*DM,(unsigned)__builtin_amdgcn_readfirstlane(vdst+(slot)))
  const int vb0=(int)(lds0+LDS_V)+((lane>>4)&1)*32+(lane&3)*8+(4*hi+((lane&15)>>2))*64;
  const char*Kbase=shm+LDS_K; bf16x8 kf[8];
  const lds_cptr kp0=shm3+LDS_K+hi*1024+r32*16; const lds_cptr vp0=shm3+LDS_V+((lane>>4)&1)*32+(lane&3)*8+(4*hi+((lane&15)>>2))*64;
  typedef __attribute__((address_space(3))) float lds_f32; typedef __attribute__((address_space(3))) f32x4 lds_f32x4;
  { lds_f32*cl=(lds_f32*)(shm3+LDS_CS); const int n_=q0+QB; for(int i_=tid*4;i_<n_;i_+=2048){ const f32x4 v_=*(const f32x4*)(csg+i_); *(lds_f32x4*)(cl+i_)=v_; } }
  asm volatile("s_waitcnt vmcnt(0) lgkmcnt(0)\n\ts_barrier":::"memory");
  int j0;
  { const lds_f32*cl=(const lds_f32*)(shm3+LDS_CS); const float cq0=cl[q0]; int lo_=0,hi_=4*qb;
    while(lo_<hi_){ const int mid_=(lo_+hi_)>>1; if(cl[64*mid_+63]-cq0>=dthr)lo_=mid_+1; else hi_=mid_; }
    j0=__builtin_amdgcn_readfirstlane(lo_)&~1; }
  const bf16*Kh=K+(rowbase+(long)j0*KVBLK)*DM,*Vh=V+(rowbase+(long)j0*KVBLK)*DM;
  const bf16*ksrc=Kh+(long)lane*DM+wid*8;
  const bf16*vsrc=Vh+(long)(16*(wid&3)+(lane>>2))*DM+(wid>>2)*32+(lane&3)*8;
  const int NT=(q0+QB)/KVBLK-j0;
  const lds_f32*cl3=(const lds_f32*)(shm3+LDS_CS)+64*j0;
  DMA_K(0,0);DMA_V(0,0);DMA_K(1,SLOTB);
  bf16x8 qr[4];
  #pragma unroll
  for(int d0=0;d0<4;++d0)qr[d0]=*reinterpret_cast<const bf16x8*>(&Qw[(long)r32*DM+d0*16+hi*8]);
  float base=0.f,l_reg=0.f;f32x16 o[2];o[0]=f32x16{};o[1]=f32x16{};
  #define CINIT(C0,C1,t) do{ const lds_f32*cp_=cl3+64*(t)+4*hi; \
    _Pragma("unroll") for(int g_=0;g_<4;++g_){ const f32x4 a_=*(const lds_f32x4*)(cp_+8*g_), b_=*(const lds_f32x4*)(cp_+32+8*g_); \
      C0[4*g_]=base-a_[0];C0[4*g_+1]=base-a_[1];C0[4*g_+2]=base-a_[2];C0[4*g_+3]=base-a_[3]; \
      C1[4*g_]=base-b_[0];C1[4*g_+1]=base-b_[1];C1[4*g_+2]=base-b_[2];C1[4*g_+3]=base-b_[3]; } }while(0)
  const int qrel=wid*QBLK+r32;
  #define CMASK(P0,P1,t) do{int jb_=(t)-(NT-4); if(jb_>=0)cmask(P0,P1,jb_,qrel,hi);}while(0)
  bool resc=false;
  #define START(P0,P1) do{ const float rm=rowmax(P0,P1); resc=false; \
    { const float dl=rm; base=fsub_s(base,dl); \
      _Pragma("unroll") for(int r=0;r<16;++r){P0[r]=fsub_s(P0[r],dl);P1[r]=fsub_s(P1[r],dl);} } \
    _Pragma("unroll") for(int r=0;r<16;++r)P0[r]=__builtin_amdgcn_exp2f(P0[r]); }while(0)
  #define RESC() do{ if(resc){ asm volatile("s_waitcnt lgkmcnt(0)":::"memory"); \
      _Pragma("unroll") for(int d_=0;d_<2;++d_) _Pragma("unroll") for(int r=0;r<16;++r)o[d_][r]*=wsf[crow(r,hi)]; } }while(0)
  f32x16 pA0,pA1,pB0,pB1;
  int sl_prev=0,sl_cur=0,sl_next=SLOTB;
  #define ROT() do{sl_prev=sl_cur;sl_cur=sl_next;sl_next=(sl_next==(NSLOT-1)*SLOTB)?0:sl_next+SLOTB;}while(0)
  DMA_K(2,2*SLOTB);
  WAIT_BAR(3);
  base=cl3[q0-64*j0+wid*QBLK+r32];
  CINIT(pA0,pA1,0); qkt(pA0,pA1,Kbase,qr,r32,hi);asm volatile("s_nop 15\n\ts_nop 7":"+v"(pA0),"+v"(pA1));CMASK(pA0,pA1,0);
  START(pA0,pA1);
  _Pragma("unroll") for(int r=0;r<16;++r)pA1[r]=__builtin_amdgcn_exp2f(pA1[r]);
  WAIT_BAR(0);
  DMA_K(3,0);DMA_V(1,SLOTB);
  ROT();
  kload8(kf,kp0+sl_cur);
  WAIT_BAR(2);
  s16x4 vlo[8],vhi[8]; u32x4 pw0,pw1,pw2,pw3;
  #define PKW(P,B) cvtpk_s(P[B],P[B+1])
  #define PAF(k) __builtin_bit_cast(bf16x8,pw##k)
  #define VFR(i) (bf16x8){vlo[i][0],vlo[i][1],vlo[i][2],vlo[i][3],vhi[i][0],vhi[i][1],vhi[i][2],vhi[i][3]}
  #define PIN(x) asm volatile("":"+v"(x))
  #define MX3(a,b,c) __builtin_fmaxf(__builtin_fmaxf((a),(b)),(c))
  #define GAPA(MF,A0,A1,A2,A3,W0,W1,PW) do{ MF; sacc+=A0; sacc+=A1; sacc+=A2; sacc+=A3; PIN(sacc); W0; W1; PIN(PW); SBAR(); }while(0)
  #define EX(v) __builtin_amdgcn_exp2f(v)
  #define GAPB(MF,X,B) do{ MF; X[B]=EX(X[B]); X[B+1]=EX(X[B+1]); X[B+2]=EX(X[B+2]); X[B+3]=EX(X[B+3]); PIN(X); SBAR(); }while(0)
  #define VRD(i) do{ vlo[i]=vtr(vp_+(((i)>>2)*4096+((i)&3)*1024)); vhi[i]=vtr(vp_+(((i)>>2)*4096+((i)&3)*1024+512)); }while(0)
  #define KRD(G,j) do{ if(G){ kload2(kf,kp0+sl_next,j); SBAR(); } }while(0)
  #define STEP(C0,C1,P0,P1,t,GK,GV,GL) do{ SBAR(); CINIT(C0,C1,t); SBAR(); \
    const lds_cptr vp_=vp0+sl_prev; \
    VRD(0); SBAR(); float sacc=(P0[0]+P0[1]); \
    GAPA(C0=__builtin_amdgcn_mfma_f32_32x32x16_bf16(kf[0],qr[0],C0,0,0,0), P0[2],P0[3],P0[4],P0[5],     pw0[0]=PKW(P0,0), pw0[1]=PKW(P0,2), pw0); \
    VRD(4); SBAR(); GAPA(C1=__builtin_amdgcn_mfma_f32_32x32x16_bf16(kf[1],qr[0],C1,0,0,0), P0[6],P0[7],P0[8],P0[9],     pw0[2]=PKW(P0,4), pw0[3]=PKW(P0,6), pw0); \
    VRD(1); SBAR(); GAPA(C0=__builtin_amdgcn_mfma_f32_32x32x16_bf16(kf[2],qr[1],C0,0,0,0),   P0[10],P0[11],P0[12],P0[13], pw1[0]=PKW(P0,8), pw1[1]=PKW(P0,10), pw1); \
    VRD(5); SBAR(); GAPA(C1=__builtin_amdgcn_mfma_f32_32x32x16_bf16(kf[3],qr[1],C1,0,0,0),   P0[14],P0[15],P1[0],P1[1],   pw1[2]=PKW(P0,12),pw1[3]=PKW(P0,14), pw1); \
    VRD(2); SBAR(); GAPA(C0=__builtin_amdgcn_mfma_f32_32x32x16_bf16(kf[4],qr[2],C0,0,0,0),   P1[2],P1[3],P1[4],P1[5],     pw2[0]=PKW(P1,0), pw2[1]=PKW(P1,2), pw2); \
    VRD(6); SBAR(); GAPA(C1=__builtin_amdgcn_mfma_f32_32x32x16_bf16(kf[5],qr[2],C1,0,0,0),   P1[6],P1[7],P1[8],P1[9],     pw2[2]=PKW(P1,4), pw2[3]=PKW(P1,6), pw2); \
    VRD(3); SBAR(); GAPA(C0=__builtin_amdgcn_mfma_f32_32x32x16_bf16(kf[6],qr[3],C0,0,0,0),   P1[10],P1[11],P1[12],P1[13], pw3[0]=PKW(P1,8), pw3[1]=PKW(P1,10), pw3); \
    VRD(7); SBAR(); GAPA(C1=__builtin_amdgcn_mfma_f32_32x32x16_bf16(kf[7],qr[3],C1,0,0,0),   P1[14],P1[15],0.f,0.f,       pw3[2]=PKW(P1,12),pw3[3]=PKW(P1,14), pw3); \
    l_reg+=sacc; \
    if(GK){DMA_K((t)+3,sl_cur);} if(GV){DMA_V((t)+1,sl_next);} \
    CMASK(C0,C1,t); \
    { float a=MX3(C0[0],C0[1],C1[0]),b=MX3(C0[2],C0[3],C1[1]); a=MX3(a,C1[2],C1[3]); \
      _Pragma("unroll") for(int r=4;r<16;r+=4){a=MX3(a,C0[r],C0[r+1]);b=MX3(b,C0[r+2],C0[r+3]);a=MX3(a,C1[r],C1[r+1]);b=MX3(b,C1[r+2],C1[r+3]);} \
      float rm=__builtin_fmaxf(a,b); { auto rr=__builtin_amdgcn_permlane32_swap(__float_as_uint(rm),__float_as_uint(rm),false,false); rm=__builtin_fmaxf(__uint_as_float(rr[0]),__uint_as_float(rr[1])); } \
      resc=false; \
      if(__builtin_expect(__any(rm>(float)THRL),0)){ const float dl=__builtin_fmaxf(rm,0.f); base-=dl; \
        _Pragma("unroll") for(int r=0;r<16;++r){C0[r]-=dl;C1[r]-=dl;} \
        const float f=__builtin_amdgcn_exp2f(-dl); l_reg*=f; if(hi==0)wsf[r32]=f; resc=true; } } \
    SBAR(); \
    GAPB(o[0]=__builtin_amdgcn_mfma_f32_32x32x16_bf16(PAF(0),VFR(0),o[0],0,0,0), C0,0); \
    GAPB(o[1]=__builtin_amdgcn_mfma_f32_32x32x16_bf16(PAF(0),VFR(4),o[1],0,0,0), C0,4); \
    KRD(GL,0); GAPB(o[0]=__builtin_amdgcn_mfma_f32_32x32x16_bf16(PAF(1),VFR(1),o[0],0,0,0), C0,8); \
    KRD(GL,1); GAPB(o[1]=__builtin_amdgcn_mfma_f32_32x32x16_bf16(PAF(1),VFR(5),o[1],0,0,0), C0,12); \
    KRD(GL,2); GAPB(o[0]=__builtin_amdgcn_mfma_f32_32x32x16_bf16(PAF(2),VFR(2),o[0],0,0,0), C1,0); \
    KRD(GL,3); GAPB(o[1]=__builtin_amdgcn_mfma_f32_32x32x16_bf16(PAF(2),VFR(6),o[1],0,0,0), C1,4); \
    GAPB(o[0]=__builtin_amdgcn_mfma_f32_32x32x16_bf16(PAF(3),VFR(3),o[0],0,0,0), C1,8); \
    GAPB(o[1]=__builtin_amdgcn_mfma_f32_32x32x16_bf16(PAF(3),VFR(7),o[1],0,0,0), C1,12); \
    }while(0)
  int t=1;
  #undef CMASK
  #define CMASK(P0,P1,t) do{}while(0)
  for(;t+5<NT;t+=2){
    STEP(pB0,pB1,pA0,pA1,t,true,true,true);     WAIT_BAR(2); RESC(); ROT();
    STEP(pA0,pA1,pB0,pB1,t+1,true,true,true);   WAIT_BAR(2); RESC(); ROT();
  }
  #undef CMASK
  #define CMASK(P0,P1,t) do{int jb_=(t)-(NT-4); if(jb_>=0)cmask(P0,P1,jb_,qrel,hi);}while(0)
  #define ENDW(tt) do{ if((tt)+3<NT){WAIT_BAR(2);} else if((tt)+2<NT){WAIT_BAR(1);} else {WAIT_BAR(0);} }while(0)
  for(;t+1<NT;t+=2){
    STEP(pB0,pB1,pA0,pA1,t,(t+3<NT),(t+1<NT),(t+1<NT));       ENDW(t);   RESC(); ROT();
    STEP(pA0,pA1,pB0,pB1,t+1,(t+4<NT),(t+2<NT),(t+2<NT));     ENDW(t+1); RESC(); ROT();
  }
  STEP(pB0,pB1,pA0,pA1,NT-1,false,false,false); RESC();
  { float sacc=pB0[0]+pB0[1]; _Pragma("unroll") for(int r=2;r<16;++r)sacc+=pB0[r]; _Pragma("unroll") for(int r=0;r<16;++r)sacc+=pB1[r]; l_reg+=sacc;
    pw0=(u32x4){PKW(pB0,0),PKW(pB0,2),PKW(pB0,4),PKW(pB0,6)};pw1=(u32x4){PKW(pB0,8),PKW(pB0,10),PKW(pB0,12),PKW(pB0,14)};pw2=(u32x4){PKW(pB1,0),PKW(pB1,2),PKW(pB1,4),PKW(pB1,6)};pw3=(u32x4){PKW(pB1,8),PKW(pB1,10),PKW(pB1,12),PKW(pB1,14)};
    SBAR(); pv(o,vb0+sl_cur,PAF(0),PAF(1),PAF(2),PAF(3)); }
  #undef PKW
  #undef PAF
  #undef VFR
  #undef PIN
  #undef MX3
  #undef GAPA
  #undef GAPB
  #undef EX
  #undef VRD
  #undef KRD
  #undef STEP
  #undef ENDW
  {auto rr=__builtin_amdgcn_permlane32_swap(__float_as_uint(l_reg),__float_as_uint(l_reg),false,false);l_reg=__uint_as_float(rr[0])+__uint_as_float(rr[1]);}
  if(hi==0)wsf[32+r32]=l_reg;asm volatile("s_waitcnt lgkmcnt(0)":::"memory");
  float rli[16];
  #pragma unroll
  for(int r=0;r<16;++r)rli[r]=__builtin_amdgcn_rcpf(wsf[32+crow(r,hi)]);
  bf16*Ow=O+(rowbase+q0+wid*QBLK)*DMO;
  { bf16*stg=(bf16*)(shm+LDS_OST)+wid*2048;
    #pragma unroll
    for(int r=0;r<16;++r){const int orow=crow(r,hi);
      #pragma unroll
      for(int d0=0;d0<2;++d0)stg[orow*64+d0*32+r32]=__float2bfloat16(o[d0][r]*rli[r]);}
    asm volatile("s_waitcnt lgkmcnt(0)":::"memory");
    #pragma unroll
    for(int i=0;i<4;++i){const int row=i*8+(lane>>3),ch=lane&7; const u32x4 v=*(const u32x4*)(stg+row*64+ch*8); ATTN_STORE16(Ow+(long)row*DMO+ch*8,head_rms(v));} }
  asm volatile("s_waitcnt lgkmcnt(0)\n\ts_barrier":::"memory");
  #undef DMA_K
  #undef DMA_V
  #undef CMASK
  #undef CINIT
  #undef START
  #undef RESC
  #undef ROT
}
__device__ __forceinline__ float sp2f(float z){ const float e=__builtin_amdgcn_exp2f(-__builtin_fabsf(z)); return __builtin_fmaxf(z,0.f)+__builtin_amdgcn_logf(1.f+e); }
__device__ __forceinline__ void sb_unit(int b,int qb,const bf16*Q,const bf16*__restrict__ K,const bf16*__restrict__ V,bf16*O,char*shm){
  int tid_=threadIdx.x; asm volatile("":"+v"(tid_)); const int tid=tid_,lane=tid&63,r32=lane&31,hi=lane>>5; const int wid=__builtin_amdgcn_readfirstlane(tid>>6);
  const long rowbase=(long)b*SEQ; const int q0=qb*QB;
  const bf16*Qw=Q+(rowbase+q0+wid*QBLK)*DM;
  const bf16*Kh=K+rowbase*DM,*Vh=V+rowbase*DM;
  const unsigned lds0=(unsigned)(uintptr_t)shm; const lds_cptr shm3=(lds_cptr)shm;
  const bf16*ksrc=Kh+(long)lane*DM+wid*8;
  const bf16*vsrc=Vh+(long)(16*(wid&3)+(lane>>2))*DM+(wid>>2)*32+(lane&3)*8;
  const unsigned kdst=lds0+LDS_K+wid*1024, vdst=lds0+LDS_V+wid*1024;
  #define DMA_K(t,slot) glds16(ksrc+(long)(t)*KVBLK*DM,(unsigned)__builtin_amdgcn_readfirstlane(kdst+(slot)))
  #define DMA_V(t,slot) glds16(vsrc+(long)(t)*KVBLK*DM,(unsigned)__builtin_amdgcn_readfirstlane(vdst+(slot)))
  const int vb0=(int)(lds0+LDS_V)+((lane>>4)&1)*32+(lane&3)*8+(4*hi+((lane&15)>>2))*64;
  typedef __attribute__((address_space(3))) unsigned lds_u32;
  volatile lds_u32*flags=(volatile lds_u32*)(shm3+LDS_FLAGS);
  bf16x8 qr[4];
  #pragma unroll
  for(int d0=0;d0<4;++d0)qr[d0]=*reinterpret_cast<const bf16x8*>(&Qw[(long)r32*DM+d0*16+hi*8]);
  asm volatile("":::"memory");
  f32x16 o[2];o[0]=f32x16{};o[1]=f32x16{};
  float R=0.f; const int qabs=q0+wid*QBLK+r32; bool done=false;
  const int jtop=4*qb+3;
  DMA_K(jtop,0);DMA_V(jtop,0);
  int slot=0;
  for(int j=jtop;j>=0;--j){
    if(j>0){ DMA_K(j-1,slot^SLOTB);DMA_V(j-1,slot^SLOTB); WAIT_BAR(2); } else { WAIT_BAR(0); }
    const bool active=(!done)&&(64*j<q0+wid*QBLK+31);
    if(active){
      f32x16 p0=f32x16{},p1=f32x16{};
      qkt(p0,p1,shm+LDS_K+slot,qr,r32,hi);
      const int kvb=64*j+4*hi; f32x16 s0,s1;
      #pragma unroll
      for(int r=0;r<16;++r){ const int kv=kvb+(r&3)+8*(r>>2); s0[r]=(kv<qabs)?sp2f(p0[r]):0.f; s1[r]=(kv+32<qabs)?sp2f(p1[r]):0.f; }
      float g0[4],g1[4],og0[4],og1[4],T0[4],T1[4];
      #pragma unroll
      for(int g=0;g<4;++g){ g0[g]=(s0[4*g]+s0[4*g+1])+(s0[4*g+2]+s0[4*g+3]); g1[g]=(s1[4*g]+s1[4*g+1])+(s1[4*g+2]+s1[4*g+3]); }
      #pragma unroll
      for(int g=0;g<4;++g){ og0[g]=__shfl_xor(g0[g],32); og1[g]=__shfl_xor(g1[g],32); }
      float run=R;
      #pragma unroll
      for(int g=3;g>=0;--g){ const float ah1=hi?g1[g]:og1[g], ah0=hi?og1[g]:g1[g]; const float t1=run; run+=ah1; const float t0=run; run+=ah0; T1[g]=hi?t1:t0; }
      #pragma unroll
      for(int g=3;g>=0;--g){ const float ah1=hi?g0[g]:og0[g], ah0=hi?og0[g]:g0[g]; const float t1=run; run+=ah1; const float t0=run; run+=ah0; T0[g]=hi?t1:t0; }
      R=run;
      #pragma unroll
      for(int g=0;g<4;++g){ float a0=T0[g],a1=T1[g];
        #pragma unroll
        for(int i=3;i>=0;--i){ const int r=4*g+i; const int kv=kvb+i+8*g; a0+=s0[r]; a1+=s1[r];
          p0[r]=(kv<qabs)?__builtin_amdgcn_exp2f(p0[r]-a0):0.f; p1[r]=(kv+32<qabs)?__builtin_amdgcn_exp2f(p1[r]-a1):0.f; } }
      u32x4 pw0,pw1,pw2,pw3;
      pw0=(u32x4){cvtpk_s(p0[0],p0[1]),cvtpk_s(p0[2],p0[3]),cvtpk_s(p0[4],p0[5]),cvtpk_s(p0[6],p0[7])};
      pw1=(u32x4){cvtpk_s(p0[8],p0[9]),cvtpk_s(p0[10],p0[11]),cvtpk_s(p0[12],p0[13]),cvtpk_s(p0[14],p0[15])};
      pw2=(u32x4){cvtpk_s(p1[0],p1[1]),cvtpk_s(p1[2],p1[3]),cvtpk_s(p1[4],p1[5]),cvtpk_s(p1[6],p1[7])};
      pw3=(u32x4){cvtpk_s(p1[8],p1[9]),cvtpk_s(p1[10],p1[11]),cvtpk_s(p1[12],p1[13]),cvtpk_s(p1[14],p1[15])};
      pv(o,vb0+slot,__builtin_bit_cast(bf16x8,pw0),__builtin_bit_cast(bf16x8,pw1),__builtin_bit_cast(bf16x8,pw2),__builtin_bit_cast(bf16x8,pw3));
      done=__all(R>=151.f)!=0;
    }
    if(lane==0)flags[wid]=done?1u:0u;
    asm volatile("s_waitcnt lgkmcnt(0)\n\ts_barrier":::"memory");
    unsigned alld=1u;
    #pragma unroll
    for(int w=0;w<NW;++w)alld&=flags[w];
    slot^=SLOTB;
    if(alld)break;
  }
  asm volatile("s_waitcnt vmcnt(0)":::"memory");
  bf16*Ow=O+(rowbase+q0+wid*QBLK)*DMO;
  { bf16*stg=(bf16*)(shm+LDS_OST)+wid*2048;
    #pragma unroll
    for(int r=0;r<16;++r){const int orow=crow(r,hi);
      #pragma unroll
      for(int d0=0;d0<2;++d0)stg[orow*64+d0*32+r32]=__float2bfloat16(o[d0][r]);}
    asm volatile("s_waitcnt lgkmcnt(0)":::"memory");
    #pragma unroll
    for(int i=0;i<4;++i){const int row=i*8+(lane>>3),ch=lane&7; const u32x4 v=*(const u32x4*)(stg+row*64+ch*8); ATTN_STORE16(Ow+(long)row*DMO+ch*8,head_rms(v));} }
  asm volatile("s_waitcnt vmcnt(0) lgkmcnt(0)\n\ts_barrier":::"memory");
  #undef DMA_K
  #undef DMA_V
}
#undef SBAR
#undef WAIT_BAR
}
namespace cg = cooperative_groups;
constexpr int NWAVES = 8;
constexpr int DMODEL = 1024, NBATCH = 4, SEQ_IN = 8192, NMETA = 16, LREAL = NMETA + SEQ_IN, LP = 8448  ;
constexpr int MROWS = NBATCH * LP;
constexpr int INW = 2566, NINP = 2560, NIN = 2816, DFF = 2816, NGU = 2 * DFF, DEPTH = 2, NFH = 6;
constexpr float C2F = 0.125f * 1.4426950408889634f;
constexpr int PC_U = 0, PC_FQ = 256, PC_FK = 640, PC_FV = 1024, PC_SQ = 1408, PC_SK = 1792, PC_SV = 2176;
constexpr size_t MiB = 1u << 20;
constexpr size_t WS_CTL = 0, CTL_ZERO_BYTES = 1 * MiB;
constexpr size_t WS_SS = 64 * 1024;
constexpr size_t WS_W = 1 * MiB, W_LAYER = 24 * MiB, W_IN = 0, W_OUT = (size_t)NIN * 1024 * 2, W_GU = W_OUT + 2 * MiB, W_D = W_GU + (size_t)NGU * 1024 * 2;
constexpr size_t WS_LF = 49 * MiB, WS_CS = 51 * MiB, WS_H = 52 * MiB, WS_HB = 184 * MiB, WS_Y = 250 * MiB, WS_P = 316 * MiB, WS_END = WS_P + (size_t)MROWS * DFF * 2;
static_assert(W_D + (size_t)1024 * DFF * 2 <= W_LAYER && WS_W + 2 * W_LAYER <= WS_LF && WS_SS + 5 * (size_t)MROWS * 4 <= CTL_ZERO_BYTES, "ws map");
static_assert(WS_H + (size_t)MROWS * 1024 * 4 <= WS_HB && WS_HB + (size_t)MROWS * 1024 * 2 <= WS_Y && WS_Y + (size_t)MROWS * 1024 * 2 <= WS_P && WS_END <= 512 * MiB, "ws map");
constexpr int LDS_BYTES = 147456;
constexpr int LDS_MISC = 131072;

#define LAS __attribute__((address_space(3)))
typedef unsigned short bf16u;
typedef unsigned v4u __attribute__((ext_vector_type(4)));
typedef float f32x4 __attribute__((ext_vector_type(4)));
#define LDS_WAIT() asm volatile("s_waitcnt lgkmcnt(0)" ::: "memory")
__device__ __forceinline__ unsigned f2bf(float f) { unsigned u = __builtin_bit_cast(unsigned, f); return (u + 0x7fffu + ((u >> 16) & 1u)) >> 16; }
__device__ __forceinline__ unsigned pk2(float lo, float hi) { return f2bf(lo) | (f2bf(hi) << 16); }
__device__ __forceinline__ float wave_sum(float v) {
#pragma unroll
    for (int o = 1; o < 64; o <<= 1) v += __shfl_xor(v, o);
    return v;
}

struct Args { const float* in[15]; float* out; unsigned char* ws; };

struct WinSrc { const float* w; const float* g;
    __device__ __forceinline__ float operator()(int k, int n) const { if (n >= INW) return 0.f; const int col = n < 1408 ? n : (n < 2560 ? n + 6 : n - 2560 + 1408);
        const float sc = ((n >= PC_FQ && n < PC_FK) || (n >= PC_SQ && n < PC_SK)) ? C2F : 1.0f; return w[(size_t)k * INW + col] * g[k] * sc; } };
struct WoutSrc { const float* w; const float* fg; const float* sg;
    __device__ __forceinline__ float operator()(int k, int n) const { const float gn = k < 640 ? fg[k - 256] : sg[k - 640]; return w[(size_t)k * 1024 + n] * gn; } };
struct WguSrc { const float* wg; const float* wu; const float* g;
    __device__ __forceinline__ float operator()(int k, int c) const { const int pn = c >> 8, w = c & 255, j = pn * 128 + (w & 127); const long dlt = (w >> 7) ? (long)(wu - wg) : 0L; return wg[(long)k * DFF + j + dlt] * g[k]; } };
struct WdSrc { const float* w;
    __device__ __forceinline__ float operator()(int k, int n) const { return w[(size_t)k * 1024 + n]; } };
template <class F> __device__ __forceinline__ void conv_item(const F src, bf16u* WT, int K, int k0, int n0, LAS float* scr, int lane) {
    float tv[32];
#pragma unroll
    for (int i = 0; i < 32; ++i) tv[i] = src(k0 + 2 * i + (lane >> 5), n0 + (lane & 31));
#pragma unroll
    for (int i = 0; i < 32; ++i) scr[(2 * i + (lane >> 5)) * 33 + (lane & 31)] = tv[i];
    LDS_WAIT(); asm volatile("" ::: "memory");
    const int c = lane & 7;
#pragma unroll
    for (int j = 0; j < 4; ++j) { const int n = (lane >> 3) + 8 * j; const LAS float* s = scr + (8 * c) * 33 + n;
        v4u o; o.x = pk2(s[0 * 33], s[1 * 33]); o.y = pk2(s[2 * 33], s[3 * 33]); o.z = pk2(s[4 * 33], s[5 * 33]); o.w = pk2(s[6 * 33], s[7 * 33]);
        *(v4u*)(WT + (size_t)(n0 + n) * K + k0 + 8 * c) = o; }
    LDS_WAIT(); asm volatile("" ::: "memory");
}
__device__ __forceinline__ void fold_item(const float* wout, const float* pw, const float* ps, bf16u* WT, int item, int lane) {
    const int g = item >> 4, n = (item & 15) * 64 + lane;
    float acc[64];
#pragma unroll
    for (int c = 0; c < 64; ++c) acc[c] = 0.f;
    for (int d = 0; d < 64; ++d) { const float wv = wout[(size_t)(g * 64 + d) * 1024 + n] * ps[g * 64 + d];
#pragma unroll
        for (int c = 0; c < 64; ++c) acc[c] += pw[(g * 64 + c) * 64 + d] * wv; }
    bf16u* o = WT + (size_t)n * 1024 + g * 64;
#pragma unroll
    for (int c = 0; c < 64; c += 8) { v4u w; w.x = pk2(acc[c], acc[c + 1]); w.y = pk2(acc[c + 2], acc[c + 3]); w.z = pk2(acc[c + 4], acc[c + 5]); w.w = pk2(acc[c + 6], acc[c + 7]); *(v4u*)(o + c) = w; }
}
__device__ __forceinline__ void p0_prologue(const Args& A, unsigned char* ws, LAS unsigned char* lds, int wave, int lane) {
    LAS float* scr = (LAS float*)(lds + wave * 16384);
    const int gw = blockIdx.x * NWAVES + wave, NGW = gridDim.x * NWAVES;
    constexpr int I_IN = 16 * (NIN / 32), I_OUT = 12 * 32, I_GU = 16 * (NGU / 32), I_D = (DFF / 64) * 32, I_F = 64, I_L = I_IN + I_OUT + I_GU + I_D + I_F;
    for (int it = gw; it < DEPTH * I_L; it += NGW) {
        const int L = it / I_L; int r = it % I_L;
        bf16u* wb = (bf16u*)(ws + WS_W + (size_t)L * W_LAYER);
        if (r < I_IN) { WinSrc s{A.in[3] + (size_t)L * 1024 * INW, A.in[2] + L * 1024}; conv_item(s, (bf16u*)((unsigned char*)wb + W_IN), 1024, (r / (NIN / 32)) * 64, (r % (NIN / 32)) * 32, scr, lane); continue; } r -= I_IN;
        if (r < I_OUT) { WoutSrc s{A.in[9] + (size_t)L * 1024 * 1024, A.in[7] + L * 384, A.in[8] + L * 384}; conv_item(s, (bf16u*)((unsigned char*)wb + W_OUT), 1024, 256 + (r / 32) * 64, (r % 32) * 32, scr, lane); continue; } r -= I_OUT;
        if (r < I_GU) { WguSrc s{A.in[11] + (size_t)L * 1024 * DFF, A.in[12] + (size_t)L * 1024 * DFF, A.in[10] + L * 1024}; conv_item(s, (bf16u*)((unsigned char*)wb + W_GU), 1024, (r / (NGU / 32)) * 64, (r % (NGU / 32)) * 32, scr, lane); continue; } r -= I_GU;
        if (r < I_D) { WdSrc s{A.in[13] + (size_t)L * DFF * 1024}; conv_item(s, (bf16u*)((unsigned char*)wb + W_D), DFF, (r / 32) * 64, (r % 32) * 32, scr, lane); continue; } r -= I_D;
        fold_item(A.in[9] + (size_t)L * 1024 * 1024, A.in[5] + (size_t)L * 4 * 64 * 64, A.in[6] + L * 256, (bf16u*)((unsigned char*)wb + W_OUT), r, lane);
    }
    float* h = (float*)(ws + WS_H); bf16u* hb = (bf16u*)(ws + WS_HB); float* ss0 = (float*)(ws + WS_SS);
    for (int m = gw; m < MROWS; m += NGW) {
        const int b = m / LP, t = m % LP;
        f32x4 v[4]; float s = 0.f;
        if (t < LREAL) { const f32x4* src = (const f32x4*)(t < NMETA ? A.in[1] + (size_t)t * 1024 : A.in[0] + ((size_t)b * SEQ_IN + (t - NMETA)) * 1024) + lane;
#pragma unroll
            for (int j = 0; j < 4; ++j) { v[j] = src[64 * j]; s += (v[j].x * v[j].x + v[j].y * v[j].y) + (v[j].z * v[j].z + v[j].w * v[j].w); } }
        else {
#pragma unroll
            for (int j = 0; j < 4; ++j) v[j] = (f32x4){0.f, 0.f, 0.f, 0.f}; }
        s = wave_sum(s);
        f32x4* ho = (f32x4*)(h + (size_t)m * 1024) + lane; unsigned long long* bo = (unsigned long long*)(hb + (size_t)m * 1024) + lane;
#pragma unroll
        for (int j = 0; j < 4; ++j) { ho[64 * j] = v[j]; bo[64 * j] = (unsigned long long)pk2(v[j].x, v[j].y) | ((unsigned long long)pk2(v[j].z, v[j].w) << 32); }
        if (lane == 0) ss0[m] = s;
    }
}
__device__ __forceinline__ void pool_scan_phase(unsigned char* ws, LAS unsigned char* lds, unsigned* nrm, int tid, int wave, int lane) {
    const float* LF = (const float*)(ws + WS_LF); float* CS = (float*)(ws + WS_CS);
    if (blockIdx.x < NBATCH * NFH) {
        const int b = blockIdx.x / NFH, hf = blockIdx.x % NFH; constexpr int PER = 17;
        const float* lf = LF + (size_t)b * LP * 8 + hf; float* cs = CS + (size_t)(b * NFH + hf) * LP;
        float v[PER]; float s = 0.f; const int t0 = tid * PER;
#pragma unroll
        for (int i = 0; i < PER; ++i) { const int t = t0 + i; const float x = t < LP ? lf[(size_t)t * 8] : 0.f; s += x; v[i] = s; }
        float incl = s;
#pragma unroll
        for (int o = 1; o < 64; o <<= 1) { const float n = __shfl_up(incl, o); if (lane >= o) incl += n; }
        LAS float* wsum = (LAS float*)(lds + LDS_MISC + 256);
        if (lane == 63) wsum[wave] = incl;
        __syncthreads();
        float off = 0.f;
        for (int w = 0; w < wave; ++w) off += wsum[w];
        const float excl = off + incl - s;
#pragma unroll
        for (int i = 0; i < PER; ++i) { const int t = t0 + i; if (t < LP) cs[t] = excl + v[i]; }
        __syncthreads();
    }
    const bf16u* P = (const bf16u*)(ws + WS_P); bf16u* Y = (bf16u*)(ws + WS_Y);
    for (int sl = blockIdx.x; sl < 256; sl += gridDim.x) {
        if (tid < 480) { const int sub = tid / 96, task = tid % 96, which = task / 48, head = (task % 48) >> 3, chunk = task & 7; const int r0 = sl * (MROWS / 256), b = r0 / LP;
            const bf16u* src = P + (which ? PC_FK : PC_FQ) + head * 64 + chunk * 8; float mx = 0.f;
#pragma unroll 9
            for (int r = sub; r < MROWS / 256; r += 5) { const v4u w = *(const v4u*)(src + (size_t)(r0 + r) * NINP); float s = 0.f;
#pragma unroll
                for (int e = 0; e < 4; ++e) { const float lo = __uint_as_float(w[e] << 16), hi = __uint_as_float(w[e] & 0xffff0000u); s += lo * lo + hi * hi; }
                s += __shfl_xor(s, 1); s += __shfl_xor(s, 2); s += __shfl_xor(s, 4); mx = fmaxf(mx, s); }
            if (chunk == 0) atomicMax(nrm + (b * NFH + head) * 2 + which, __float_as_uint(mx)); }
    }
    const int rsub = tid >> 5, ch = (tid & 31) * 8, win = 2 << (ch >> 6);
    for (int c = blockIdx.x; c < MROWS / 16; c += gridDim.x) {
        const int row = c * 16 + rsub, t = row % LP; const int cnt = (t + 1 < win) ? t + 1 : win;
        float acc[8], self[8];
#pragma unroll
        for (int e = 0; e < 8; ++e) acc[e] = 0.f;
        v4u wv[16];
#pragma unroll
        for (int j = 0; j < 16; ++j) wv[j] = (j < cnt) ? *(const v4u*)(P + (size_t)(row - j) * NINP + PC_U + ch) : (v4u){0u, 0u, 0u, 0u};
#pragma unroll
        for (int j = 0; j < 16; ++j) {
#pragma unroll
            for (int e = 0; e < 4; ++e) { const float lo = __uint_as_float(wv[j][e] << 16), hi = __uint_as_float(wv[j][e] & 0xffff0000u); acc[2 * e] += lo; acc[2 * e + 1] += hi; if (j == 0) { self[2 * e] = lo; self[2 * e + 1] = hi; } } }
        const float inv = 1.0f / (float)cnt; v4u o;
#pragma unroll
        for (int e = 0; e < 4; ++e) o[e] = pk2(acc[2 * e] * inv - self[2 * e], acc[2 * e + 1] * inv - self[2 * e + 1]);
        *(v4u*)(Y + (size_t)row * 1024 + ch) = o;
    }
}
__device__ __forceinline__ void attn_phase(unsigned char* ws, unsigned char* lds_g, unsigned* ctr, const unsigned* nrm, int tid) {
    const attn_body::bf16* P = (const attn_body::bf16*)(ws + WS_P); attn_body::bf16* Y = (attn_body::bf16*)(ws + WS_Y); const float* CS = (const float*)(ws + WS_CS);
    volatile LAS unsigned* bw = (volatile LAS unsigned*)((LAS unsigned char*)lds_g + LDS_MISC);
    constexpr int NU = NBATCH * NFH * (LP / 256);
    for (;;) {
        if (tid == 0) bw[0] = atomicAdd(ctr, 1u);
        __syncthreads();
        const int it = (int)bw[0];
        __syncthreads();
        if (it >= 2 * NU) break;
        const int r = it < NU ? it : it - NU; const int qb = (LP / 256 - 1) - r / (NBATCH * NFH), bh = r % (NBATCH * NFH), b = bh / NFH, h = bh % NFH;
#ifndef NO_FOX
        if (it < NU) attn_body::fox_unit<8>(b, qb, 154.0f + 2.0f * sqrtf(__uint_as_float(nrm[bh * 2]) * __uint_as_float(nrm[bh * 2 + 1])), P + PC_FQ + h * 64, P + PC_FK + h * 64, P + PC_FV + h * 64, Y + 256 + h * 64, CS + (size_t)bh * LP, (char*)lds_g);
#endif
#ifndef NO_SB
        if (it >= NU) attn_body::sb_unit(b, qb, P + PC_SQ + h * 64, P + PC_SK + h * 64, P + PC_SV + h * 64, Y + 640 + h * 64, (char*)lds_g);
#endif
    }
}
__device__ __forceinline__ void final_phase(const Args& A, unsigned char* ws, int wave, int lane) {
    const float* h = (const float*)(ws + WS_H); const float* ss = (const float*)(ws + WS_SS) + 4 * (size_t)MROWS; const f32x4* g = (const f32x4*)A.in[14] + lane;
    const int gw = blockIdx.x * NWAVES + wave, NGW = gridDim.x * NWAVES;
    f32x4 gv[4];
#pragma unroll
    for (int j = 0; j < 4; ++j) gv[j] = g[64 * j];
    for (int m = gw; m < NBATCH * SEQ_IN; m += NGW) {
        const int b = m / SEQ_IN, s = m % SEQ_IN; const size_t row = (size_t)b * LP + NMETA + s;
        const float rs = 1.0f / sqrtf(ss[row] * (1.0f / 1024.0f) + 1e-6f);
        const f32x4* src = (const f32x4*)(h + row * 1024) + lane; f32x4* dst = (f32x4*)(A.out + (size_t)m * 1024) + lane;
#pragma unroll
        for (int j = 0; j < 4; ++j) dst[64 * j] = src[64 * j] * rs * gv[j];
    }
}

#define XB_TMO      128
#define XB_XCNT(j)  (256  + 64 * (j))
#define XB_XSUB(j)  (1280 + 64 * (j))
#define XB_XGEN(j)  (2304 + 64 * (j))
#define XB_TOP      3328
#define XB_TOPGEN   3392
#define XCD_BAR_WORDS 3456
#define XB_SPIN_CAP (1u << 18)

__device__ __forceinline__ unsigned xb_ld(unsigned* p)              { return __hip_atomic_load(p, __ATOMIC_RELAXED, __HIP_MEMORY_SCOPE_AGENT); }
__device__ __forceinline__ unsigned xb_add(unsigned* p, unsigned v) { return __hip_atomic_fetch_add(p, v, __ATOMIC_RELAXED, __HIP_MEMORY_SCOPE_AGENT); }
__device__ __forceinline__ unsigned xb_xcc_id() { return (unsigned)__builtin_amdgcn_s_getreg((3 << 11) | 20) & 0xFu; }
#define XB_SPIN(cond, bar) do { unsigned _sp = 0; while (cond) { __builtin_amdgcn_s_sleep(1); \
    if ((++_sp & 255u) == 0u) { if (xb_ld(&(bar)[XB_TMO])) break; if (_sp > XB_SPIN_CAP) { atomicAdd(&(bar)[XB_TMO], 1u); break; } } } } while (0)

struct XcdBarrier {
    unsigned* bar; unsigned x;
    volatile LAS unsigned* st;
};

__device__ __forceinline__ XcdBarrier xcd_barrier_post(unsigned* bar, volatile LAS unsigned* st) {
    XcdBarrier b; b.bar = bar; b.x = xb_xcc_id(); b.st = st;
    if (threadIdx.x == 0) (void)xb_add(&bar[XB_XCNT(b.x)], 1u);
    return b;
}
__device__ __forceinline__ void xcd_barrier_complete(unsigned* bar, unsigned x, unsigned& nloc, unsigned& nx) {
    const unsigned G = gridDim.x * gridDim.y * gridDim.z;
    unsigned sum, cnt, mine, sp = 0u;
    for (;;) {
        sum = 0u; cnt = 0u; mine = 0u;
#pragma unroll
        for (unsigned j = 0; j < 16; ++j) { const unsigned c = xb_ld(&bar[XB_XCNT(j)]); sum += c; cnt += (c > 0u) ? 1u : 0u; mine = (j == x) ? c : mine; }
        if (sum == G) break;
        __builtin_amdgcn_s_sleep(1);
        if ((++sp & 255u) == 0u) { if (xb_ld(&bar[XB_TMO])) break; if (sp > XB_SPIN_CAP) { atomicAdd(&bar[XB_TMO], 1u); break; } }
    }
    nloc = mine > 0u ? mine : 1u; nx = cnt > 0u ? cnt : 1u;
}

__device__ __forceinline__ void xcd_barrier(const XcdBarrier& b) {
    asm volatile("s_waitcnt vmcnt(0)" ::: "memory");
    __syncthreads();
    if (threadIdx.x == 0) {
        unsigned* bar = b.bar;
        __builtin_amdgcn_s_waitcnt(0);
        unsigned nloc = b.st[0], nx = b.st[1];
        if (nloc == 0u) { xcd_barrier_complete(bar, b.x, nloc, nx); b.st[0] = nloc; b.st[1] = nx; }
        const unsigned old = xb_add(&bar[XB_XSUB(b.x)], 1u);
        const unsigned gen = old / nloc;
        if (old + 1u == (gen + 1u) * nloc) {
            __builtin_amdgcn_fence(__ATOMIC_RELEASE, "agent");
            asm volatile("s_waitcnt vmcnt(0)" ::: "memory");
            const unsigned og = xb_add(&bar[XB_TOP], 1u);
            const unsigned tg = og / nx;
            if (og + 1u == (tg + 1u) * nx) xb_add(&bar[XB_TOPGEN], 1u);
            else XB_SPIN(xb_ld(&bar[XB_TOPGEN]) == tg, bar);
            __builtin_amdgcn_fence(__ATOMIC_ACQUIRE, "agent");
            xb_add(&bar[XB_XGEN(b.x)], 1u);
            asm volatile("s_waitcnt vmcnt(0)" ::: "memory");
        } else {
            XB_SPIN(xb_ld(&bar[XB_XGEN(b.x)]) == gen, bar);
            __builtin_amdgcn_fence(__ATOMIC_ACQUIRE, "agent");
            asm volatile("s_waitcnt vmcnt(0)" ::: "memory");
        }
    }
    __syncthreads();
}

#define FRESH() unsigned long zoff_ = 0; asm volatile("" : "+s"(zoff_)); unsigned char* ws = A.ws + zoff_; int tid = threadIdx.x; asm volatile("" : "+v"(tid)); const int lane = tid & 63, wave = __builtin_amdgcn_readfirstlane(tid >> 6); (void)lane; (void)wave
#ifdef PROBE
#define STAMP() do { if (blockIdx.x == 0 && threadIdx.x == 0) { ((volatile unsigned long long*)(A.ws + WS_CTL + 8192))[nst] = __builtin_amdgcn_s_memrealtime(); } ++nst; } while (0)
#else
#define STAMP() do {} while (0)
#endif
__global__ void __launch_bounds__(NWAVES * 64, 2) hymba_fwd(Args A) {
    extern __shared__ __attribute__((aligned(16))) unsigned char lds[];
    cg::grid_group grid = cg::this_grid();
    LAS unsigned char* L = (LAS unsigned char*)lds;
    if (threadIdx.x < 2) ((volatile LAS unsigned*)(L + LDS_MISC + 64))[threadIdx.x] = 0u;
    __syncthreads();
    const XcdBarrier xbar = xcd_barrier_post((unsigned*)(A.ws + WS_CTL) + 4096, (volatile LAS unsigned*)(L + LDS_MISC + 64));
#define GRID_BAR() xcd_barrier(xbar)
#ifdef PROBE
    int nst = 0; STAMP();
    for (int i = 0; i < 8; ++i) GRID_BAR();
    STAMP();
#endif
#ifndef NO_PRO
    { FRESH(); p0_prologue(A, ws, L, wave, lane); }
#endif
    grid.sync(); STAMP();
    for (int layer = 0; layer < DEPTH; ++layer) {
#ifndef NO_G1
        {
            FRESH(); const unsigned char* wb = ws + WS_W + (size_t)layer * W_LAYER;
            pg8::Gemm g{(const pg8::bf16_t*)(ws + WS_HB), (const pg8::bf16_t*)(wb + W_IN), MROWS, NIN, 1024}; pg8::StaticOrder S; S.init(MROWS, NIN, (int)gridDim.x, (int)blockIdx.x);
            pg8::EpiIn E{(pg8::bf16_t*)(ws + WS_P), (float*)(ws + WS_LF), (const float*)(ws + WS_SS) + (size_t)(2 * layer) * MROWS, A.in[4] + layer * NFH};
            pg8::gemm_phase<pg8::EpiIn, pg8::StaticOrder, true, true>(L, g, S, E);
        }
#endif
        GRID_BAR(); STAMP();
#ifndef NO_POOL
        { FRESH(); pool_scan_phase(ws, L, (unsigned*)(ws + WS_CTL) + 128 + 64 * layer, tid, wave, lane); }
#endif
        GRID_BAR(); STAMP();
        { FRESH(); attn_phase(ws, lds, (unsigned*)(ws + WS_CTL) + 64 * layer, (const unsigned*)(ws + WS_CTL) + 128 + 64 * layer, tid); }
        GRID_BAR(); STAMP();
#ifndef NO_G3
        {
            FRESH(); const unsigned char* wb = ws + WS_W + (size_t)layer * W_LAYER;
            pg8::Gemm g{(const pg8::bf16_t*)(ws + WS_Y), (const pg8::bf16_t*)(wb + W_OUT), MROWS, 1024, 1024}; pg8::StaticOrder S; S.init(MROWS, 1024, (int)gridDim.x, (int)blockIdx.x);
            pg8::EpiRes E{(float*)(ws + WS_H), (pg8::bf16_t*)(ws + WS_HB), (float*)(ws + WS_SS) + (size_t)(2 * layer + 1) * MROWS};
            pg8::gemm_phase<pg8::EpiRes, pg8::StaticOrder, true, true>(L, g, S, E);
        }
#endif
        GRID_BAR(); STAMP();
#ifndef NO_G4
        {
            FRESH(); const unsigned char* wb = ws + WS_W + (size_t)layer * W_LAYER;
            pg8::Gemm g{(const pg8::bf16_t*)(ws + WS_HB), (const pg8::bf16_t*)(wb + W_GU), MROWS, NGU, 1024}; pg8::StaticOrder S; S.init(MROWS, NGU, (int)gridDim.x, (int)blockIdx.x);
            pg8::EpiGU E{(pg8::bf16_t*)(ws + WS_P), (const float*)(ws + WS_SS) + (size_t)(2 * layer + 1) * MROWS};
            pg8::gemm_phase<pg8::EpiGU, pg8::StaticOrder, true, true>(L, g, S, E);
        }
#endif
        GRID_BAR(); STAMP();
#ifndef NO_G5
        {
            FRESH(); const unsigned char* wb = ws + WS_W + (size_t)layer * W_LAYER;
            pg8::Gemm g{(const pg8::bf16_t*)(ws + WS_P), (const pg8::bf16_t*)(wb + W_D), MROWS, 1024, DFF}; pg8::StaticOrder S; S.init(MROWS, 1024, (int)gridDim.x, (int)blockIdx.x);
            pg8::EpiRes E{(float*)(ws + WS_H), (pg8::bf16_t*)(ws + WS_HB), (float*)(ws + WS_SS) + (size_t)(2 * layer + 2) * MROWS};
            pg8::gemm_phase<pg8::EpiRes, pg8::StaticOrder, true, true>(L, g, S, E);
        }
#endif
        GRID_BAR(); STAMP();
    }
    { FRESH(); final_phase(A, ws, wave, lane); }
#ifdef PROBE
    STAMP();
    grid.sync();
    {
        volatile unsigned long long* T = (volatile unsigned long long*)(A.ws + WS_CTL + 8192);
        if (blockIdx.x == 0) {
            const unsigned long long dA = T[PA + 1] - T[PA], dB = T[PB + 1] - T[PB];
            for (unsigned long long i = threadIdx.x; i < dB; i += NWAVES * 64) A.out[i] += 0.125f;
            if (threadIdx.x == 0) { const unsigned long long t0 = __builtin_amdgcn_s_memrealtime(); while (__builtin_amdgcn_s_memrealtime() - t0 < dA) __builtin_amdgcn_s_sleep(8); }
        }
    }
#endif
}

extern "C" void kernel_launch(void* const* d_in, const int* in_sizes, int n_in, void* d_out, int out_size, void* d_ws, size_t ws_size, hipStream_t stream) {
    static int grid = 0;
    if (grid == 0) {
        if (n_in != 15 || out_size != NBATCH * SEQ_IN * DMODEL || ws_size < WS_END) { fprintf(stderr, "kernel_launch: unexpected shapes (n_in %d out %d ws %zu, need %zu)\n", n_in, out_size, ws_size, (size_t)WS_END); grid = -1; return; }
        int dev = 0, cus = 0, per_cu = 0;
        if (hipGetDevice(&dev) != hipSuccess || hipDeviceGetAttribute(&cus, hipDeviceAttributeMultiprocessorCount, dev) != hipSuccess) { grid = -1; return; }
        if (hipFuncSetAttribute((const void*)hymba_fwd, hipFuncAttributeMaxDynamicSharedMemorySize, LDS_BYTES) != hipSuccess) { fprintf(stderr, "kernel_launch: hipFuncSetAttribute failed\n"); grid = -1; return; }
        if (hipOccupancyMaxActiveBlocksPerMultiprocessor(&per_cu, (const void*)hymba_fwd, NWAVES * 64, LDS_BYTES) != hipSuccess || per_cu < 1) { fprintf(stderr, "kernel_launch: occupancy query says %d\n", per_cu); per_cu = 1; }
        (void)hipGetLastError();
        grid = cus;
    }
    if (grid < 0) return;
    if (hipMemsetAsync((char*)d_ws + WS_CTL, 0, CTL_ZERO_BYTES, stream) != hipSuccess) { fprintf(stderr, "kernel_launch: memset failed\n"); return; }
    Args a{};
    for (int i = 0; i < 15; ++i) a.in[i] = (const float*)d_in[i];
    a.out = (float*)d_out; a.ws = (unsigned char*)d_ws;
    void* args[] = {&a};
    const hipError_t e = hipLaunchCooperativeKernel((const void*)hymba_fwd, dim3(grid), dim3(NWAVES * 64), args, LDS_BYTES, stream);
    if (e != hipSuccess) fprintf(stderr, "kernel_launch: cooperative launch failed: %s (grid %d)\n", hipGetErrorString(e), grid);
}
```

```cpp
#include <hip/hip_runtime.h>
#include <hip/hip_cooperative_groups.h>
#include <cstdio>
#include <cstdint>
namespace pg8 {
#define PG8_LAS __attribute__((address_space(3)))
typedef unsigned short bf16_t;
typedef short bf16x8 __attribute__((ext_vector_type(8)));
typedef float f32x4 __attribute__((ext_vector_type(4)));
typedef unsigned u32x4 __attribute__((ext_vector_type(4)));
constexpr int BM = 256, BK = 64, HALF = 128, HTB = HALF * BK * 2  , STAGE_BYTES = 8 * HTB, NXCD = 8, WGM = 8;

__host__ __device__ __forceinline__ int lds_byte(int r, int c) { const int st = (r >> 4) * 2 + (c >> 5), rr = r & 15, cc = c & 31, ob = rr * 64 + cc * 2; return st * 1024 + (ob ^ (((ob >> 9) & 1) << 5)); }
__host__ __device__ __forceinline__ void stage_rc(int b, int& R, int& C) { const int st = b / 1024, sb = b % 1024, swz = sb ^ (((sb >> 9) & 1) << 5); R = (st >> 1) * 16 + swz / 64; C = (st & 1) * 32 + (swz % 64) / 2; }
__host__ __device__ __forceinline__ int perm32(int rho) { const int n = rho >> 4, i = rho & 15; return 8 * (i >> 2) + 4 * n + (i & 3); }

struct Unit { int pm, pn; };
__host__ __device__ __forceinline__ int arow(int pm) { return 256 * (pm + (pm >> 5)) + 16; }
struct Gemm { const bf16_t* A; const bf16_t* Bt; int M, N, K; };

struct StaticOrder {
    int nM, nN, nwg, G, c;
    __host__ __device__ void init(int M, int N, int G_, int c_) { nM = M / BM; nN = N / BM; nwg = nM * nN; G = G_; c = c_; }
    __host__ __device__ bool next(int i, Unit& u) const {
        const long L = (long)i * G + c; if (L >= nwg) return false;
        int wgid = (int)L; { const int q = nwg / NXCD, r = nwg % NXCD, xcd = wgid % NXCD, off = wgid / NXCD; wgid = (xcd < r ? xcd * (q + 1) : r * (q + 1) + (xcd - r) * q) + off; }
        const int nig = WGM * nN, gid = wgid / nig, fm = gid * WGM, gsz = (nM - fm) < WGM ? (nM - fm) : WGM;
        u.pm = fm + ((wgid % nig) % gsz); u.pn = (wgid % nig) / gsz; return true;
    }
    __device__ __forceinline__ void a_ready(const Unit&) const {}
    __device__ __forceinline__ void done(const Unit&) const {}
};

__device__ __forceinline__ unsigned cvt_pk_bf16(float lo, float hi) { unsigned r; asm volatile("v_cvt_pk_bf16_f32 %0, %1, %2" : "=v"(r) : "v"(lo), "v"(hi)); return r; }
typedef unsigned u32x2 __attribute__((ext_vector_type(2)));
constexpr float RMS_EPS = 1e-6f;
struct EpiIn {
    static constexpr bool PERM = true, AFTER_DRAIN = false;
    bf16_t* P; float* LF; const float* ss; const float* fb;
    __device__ __forceinline__ void operator()(const f32x4 (&acc)[2][2][4][2], const Unit& u, int wr, int wc, int fr, int fq) const {
        const int row0 = arow(u.pm) + wr * 64 + fr;
        if (u.pn < 10) {
            const int col0 = u.pn * BM + wc * 32 + 8 * fq;
#pragma unroll
            for (int ai = 0; ai < 2; ++ai)
#pragma unroll
                for (int m = 0; m < 4; ++m) { const int row = row0 + ai * HALF + m * 16; const float rs = __builtin_amdgcn_rsqf(ss[row] * (1.0f / 1024.0f) + RMS_EPS);
                    bf16_t* rowp = P + (size_t)row * 2560 + col0;
#pragma unroll
                    for (int bj = 0; bj < 2; ++bj) { const f32x4 v0 = acc[ai][bj][m][0] * rs, v1 = acc[ai][bj][m][1] * rs;
                        u32x4 w; w.x = cvt_pk_bf16(v0[0], v0[1]); w.y = cvt_pk_bf16(v0[2], v0[3]); w.z = cvt_pk_bf16(v1[0], v1[1]); w.w = cvt_pk_bf16(v1[2], v1[3]);
                        *(u32x4*)(rowp + bj * HALF) = w; } }
        } else if (wc == 0 && fq == 0) {
            float b[6];
#pragma unroll
            for (int j = 0; j < 6; ++j) b[j] = fb[j];
#pragma unroll
            for (int ai = 0; ai < 2; ++ai)
#pragma unroll
                for (int m = 0; m < 4; ++m) { const int row = row0 + ai * HALF + m * 16; const float rs = __builtin_amdgcn_rsqf(ss[row] * (1.0f / 1024.0f) + RMS_EPS);
                    const f32x4 v0 = acc[ai][0][m][0] * rs, v1 = acc[ai][0][m][1] * rs;
                    float x[6] = {v0[0] + b[0], v0[1] + b[1], v0[2] + b[2], v0[3] + b[3], v1[0] + b[4], v1[1] + b[5]};
                    float l[6];
#pragma unroll
                    for (int j = 0; j < 6; ++j) l[j] = -(fmaxf(-x[j], 0.f) + log1pf(expf(-fabsf(x[j])))) * 1.4426950408889634f;
                    *(f32x4*)(LF + (size_t)row * 8) = (f32x4){l[0], l[1], l[2], l[3]};
                    *(f32x4*)(LF + (size_t)row * 8 + 4) = (f32x4){l[4], l[5], 0.f, 0.f}; }
        }
    }
};
struct EpiRes {
    static constexpr bool PERM = true, AFTER_DRAIN = false;
    float* h; bf16_t* hb; float* ssn;
    __device__ __forceinline__ void operator()(const f32x4 (&acc)[2][2][4][2], const Unit& u, int wr, int wc, int fr, int fq) const {
        const int row0 = arow(u.pm) + wr * 64 + fr, col0 = u.pn * BM + wc * 32 + 8 * fq;
#pragma unroll
        for (int ai = 0; ai < 2; ++ai)
#pragma unroll
            for (int m = 0; m < 4; ++m) { const int row = row0 + ai * HALF + m * 16; float* hp = h + (size_t)row * 1024 + col0; bf16_t* bp = hb + (size_t)row * 1024 + col0; float s = 0.f;
#pragma unroll
                for (int bj = 0; bj < 2; ++bj) { f32x4 a = *(const f32x4*)(hp + bj * HALF), b = *(const f32x4*)(hp + bj * HALF + 4);
                    a = a + acc[ai][bj][m][0]; b = b + acc[ai][bj][m][1];
                    *(f32x4*)(hp + bj * HALF) = a; *(f32x4*)(hp + bj * HALF + 4) = b;
                    s += (a[0] * a[0] + a[1] * a[1]) + (a[2] * a[2] + a[3] * a[3]) + (b[0] * b[0] + b[1] * b[1]) + (b[2] * b[2] + b[3] * b[3]);
                    u32x4 w; w.x = cvt_pk_bf16(a[0], a[1]); w.y = cvt_pk_bf16(a[2], a[3]); w.z = cvt_pk_bf16(b[0], b[1]); w.w = cvt_pk_bf16(b[2], b[3]);
                    *(u32x4*)(bp + bj * HALF) = w; }
                s += __shfl_xor(s, 16); s += __shfl_xor(s, 32);
                if (fq == 0) atomicAdd(ssn + row, s);
                asm volatile("" ::: "memory"); }
    }
};
struct EpiGU {
    static constexpr bool PERM = true, AFTER_DRAIN = false;
    bf16_t* H; const float* ss;
    __device__ __forceinline__ void operator()(const f32x4 (&acc)[2][2][4][2], const Unit& u, int wr, int wc, int fr, int fq) const {
        const int row0 = arow(u.pm) + wr * 64 + fr, col0 = u.pn * HALF + wc * 32 + 8 * fq;
#pragma unroll
        for (int ai = 0; ai < 2; ++ai)
#pragma unroll
            for (int m = 0; m < 4; ++m) { const int row = row0 + ai * HALF + m * 16; const float rs = __builtin_amdgcn_rsqf(ss[row] * (1.0f / 1024.0f) + RMS_EPS);
                float o[8];
#pragma unroll
                for (int n = 0; n < 2; ++n)
#pragma unroll
                    for (int e = 0; e < 4; ++e) { const float g = acc[ai][0][m][n][e] * rs, up = acc[ai][1][m][n][e] * rs;
                        o[4 * n + e] = g * __builtin_amdgcn_rcpf(1.0f + __builtin_amdgcn_exp2f(-1.4426950408889634f * g)) * up; }
                u32x4 w; w.x = cvt_pk_bf16(o[0], o[1]); w.y = cvt_pk_bf16(o[2], o[3]); w.z = cvt_pk_bf16(o[4], o[5]); w.w = cvt_pk_bf16(o[6], o[7]);
                *(u32x4*)(H + (size_t)row * 2816 + col0) = w; }
    }
};
template <class Epi, class Sched, bool ALIGN_EPI = false, bool SP2 = false>
__device__ __forceinline__ void gemm_phase(PG8_LAS unsigned char* lds, const Gemm g, const Sched& S, const Epi& E) {
    int tid_ = threadIdx.x; asm volatile("" : "+v"(tid_));
    const int tid = tid_, wid = __builtin_amdgcn_readfirstlane(tid >> 6), lane = tid & 63, wr = wid >> 2, wc = wid & 3, fr = lane & 15, fq = lane >> 4;
    const int K = g.K, nt = K / BK;
    unsigned voffA[2], voffB[2];
#pragma unroll
    for (int i = 0; i < 2; ++i) { int R, C; stage_rc(tid * 16 + i * 8192, R, C); const int Rb = Epi::PERM ? ((R & ~31) + perm32(R & 31)) : R;
        voffA[i] = (unsigned)(R * K + C) * 2u; voffB[i] = (unsigned)(Rb * K + C) * 2u; }
    const size_t kstep = (size_t)(BK * 2);
    const size_t hstep = (size_t)HALF * K * 2;
    const size_t tstep = 2 * hstep;
    const unsigned ldsw = (unsigned)wid * 1024u;
    const int aoff = lds_byte(wr * 64 + fr, fq * 8), boff = lds_byte(wc * 32 + fr, fq * 8);
#define PG8_SA(b, h) (((b) * 2 + (h)) * HTB)
#define PG8_SB(b, h) ((4 + (b) * 2 + (h)) * HTB)
#define PG8_STAGE(bufoff, gbase, voff) do { _Pragma("unroll") for (int _i = 0; _i < 2; ++_i) \
        __builtin_amdgcn_global_load_lds((const unsigned*)((const char*)(gbase) + (voff)[_i]), (PG8_LAS unsigned*)(lds + (bufoff) + ldsw + _i * 8192), 16, 0, 0); } while (0)
#define PG8_LDA(dst, b, h) do { _Pragma("unroll") for (int m = 0; m < 4; ++m) _Pragma("unroll") for (int k = 0; k < 2; ++k) dst[m][k] = *(const PG8_LAS bf16x8*)(lds + PG8_SA(b, h) + aoff + m * 2048 + k * 1024); } while (0)
#define PG8_LDB(dst, b, h) do { _Pragma("unroll") for (int n = 0; n < 2; ++n) _Pragma("unroll") for (int k = 0; k < 2; ++k) dst[n][k] = *(const PG8_LAS bf16x8*)(lds + PG8_SB(b, h) + boff + n * 2048 + k * 1024); } while (0)
#define PG8_MMA(ai, bj, At, Bt) do { __builtin_amdgcn_s_setprio(1); _Pragma("unroll") for (int m = 0; m < 4; ++m) _Pragma("unroll") for (int n = 0; n < 2; ++n) _Pragma("unroll") for (int k = 0; k < 2; ++k) \
        acc[ai][bj][m][n] = __builtin_amdgcn_mfma_f32_16x16x32_bf16(Bt[n][k], At[m][k], acc[ai][bj][m][n], 0, 0, 0); __builtin_amdgcn_s_setprio(0); } while (0)
#define PG8_WAIT_V(n) asm volatile("s_waitcnt vmcnt(" #n ")" ::: "memory")
#define PG8_WAIT_L(n) asm volatile("s_waitcnt lgkmcnt(" #n ")" ::: "memory")
#define PG8_BAR __builtin_amdgcn_s_barrier()
#define PG8_SCHED __builtin_amdgcn_sched_barrier(0)
    Unit cur, nxt; int ui = 0;
    if (!S.next(0, cur)) return;
    f32x4 acc[2][2][4][2];
#pragma unroll
    for (int a = 0; a < 2; ++a)
#pragma unroll
        for (int b = 0; b < 2; ++b)
#pragma unroll
            for (int m = 0; m < 4; ++m)
#pragma unroll
                for (int n = 0; n < 2; ++n) acc[a][b][m][n] = (f32x4){0.f, 0.f, 0.f, 0.f};
    bf16x8 At[4][2], B0[2][2], B1[2][2];
    const char* cA = (const char*)g.A + (size_t)arow(cur.pm) * K * 2; const char* cB = (const char*)g.Bt + (size_t)cur.pn * tstep;
    S.a_ready(cur);
    if constexpr (SP2) {
        PG8_STAGE(PG8_SB(0, 0), cB, voffB); PG8_STAGE(PG8_SB(0, 1), cB + hstep, voffB); PG8_STAGE(PG8_SA(0, 0), cA, voffA); PG8_STAGE(PG8_SA(0, 1), cA + hstep, voffA);
        if (wr == 1) PG8_BAR;
        PG8_WAIT_V(2); PG8_BAR;
        PG8_STAGE(PG8_SB(1, 0), cB + kstep, voffB); PG8_STAGE(PG8_SA(1, 0), cA + kstep, voffA); PG8_STAGE(PG8_SB(1, 1), cB + hstep + kstep, voffB);
        PG8_WAIT_V(6); PG8_BAR;
    } else {
        PG8_STAGE(PG8_SB(0, 0), cB, voffB); PG8_STAGE(PG8_SA(0, 0), cA, voffA); PG8_STAGE(PG8_SB(0, 1), cB + hstep, voffB); PG8_STAGE(PG8_SA(0, 1), cA + hstep, voffA);
        if (wr == 1) PG8_BAR;
        PG8_WAIT_V(4); PG8_BAR;
        PG8_STAGE(PG8_SB(1, 0), cB + kstep, voffB); PG8_STAGE(PG8_SA(1, 0), cA + kstep, voffA); PG8_STAGE(PG8_SB(1, 1), cB + hstep + kstep, voffB);
        PG8_WAIT_V(6); PG8_BAR;
    }
    for (;;) {
        const bool has_next = S.next(ui + 1, nxt);
        const char* nA = has_next ? (const char*)g.A + (size_t)arow(nxt.pm) * K * 2 : cA; const char* nB = has_next ? (const char*)g.Bt + (size_t)nxt.pn * tstep : cB;
        for (int t = 0; t < nt; t += 2) {
            const bool last = (t == nt - 2);
            const char* a1 = cA + (size_t)(t + 1) * kstep;
            const char* a2 = last ? nA : cA + (size_t)(t + 2) * kstep; const char* b2 = last ? nB : cB + (size_t)(t + 2) * kstep;
            const char* a3 = a2 + kstep; const char* b3 = b2 + kstep;
            if (last && has_next) S.a_ready(nxt);
            if constexpr (SP2) {
            PG8_LDB(B0, 0, 0); PG8_LDB(B1, 0, 1); PG8_SCHED; PG8_LDA(At, 0, 0); PG8_STAGE(PG8_SA(1, 1), a1 + hstep, voffA);
            PG8_WAIT_V(8); PG8_WAIT_L(0); PG8_BAR; PG8_MMA(0, 0, At, B0); PG8_MMA(0, 1, At, B1); PG8_BAR; PG8_SCHED;
            PG8_LDA(At, 0, 1); PG8_STAGE(PG8_SB(0, 0), b2, voffB); PG8_STAGE(PG8_SB(0, 1), b2 + hstep, voffB); PG8_STAGE(PG8_SA(0, 0), a2, voffA);
            PG8_WAIT_V(8); PG8_WAIT_L(0); PG8_BAR; PG8_MMA(1, 0, At, B0); PG8_MMA(1, 1, At, B1); PG8_BAR; PG8_SCHED;
            PG8_LDB(B0, 1, 0); PG8_LDB(B1, 1, 1); PG8_SCHED; PG8_LDA(At, 1, 0); PG8_STAGE(PG8_SA(0, 1), a2 + hstep, voffA);
            PG8_WAIT_V(8); PG8_WAIT_L(0); PG8_BAR; PG8_MMA(0, 0, At, B0); PG8_MMA(0, 1, At, B1); PG8_BAR; PG8_SCHED;
            PG8_LDA(At, 1, 1); PG8_STAGE(PG8_SB(1, 0), b3, voffB); PG8_STAGE(PG8_SB(1, 1), b3 + hstep, voffB); PG8_STAGE(PG8_SA(1, 0), a3, voffA);
            PG8_WAIT_V(8); PG8_WAIT_L(0); PG8_BAR; PG8_MMA(1, 0, At, B0); PG8_MMA(1, 1, At, B1); PG8_BAR; PG8_SCHED;
            } else {
            PG8_LDB(B0, 0, 0); PG8_SCHED; PG8_LDA(At, 0, 0); PG8_STAGE(PG8_SA(1, 1), a1 + hstep, voffA);
            PG8_WAIT_L(8); PG8_BAR; PG8_WAIT_L(0); PG8_MMA(0, 0, At, B0); PG8_BAR; PG8_SCHED;
            PG8_LDB(B1, 0, 1); PG8_STAGE(PG8_SB(0, 0), b2, voffB);
            PG8_BAR; PG8_WAIT_L(0); PG8_MMA(0, 1, At, B1); PG8_BAR;
            PG8_LDA(At, 0, 1); PG8_STAGE(PG8_SA(0, 0), a2, voffA);
            PG8_BAR; PG8_WAIT_L(0); PG8_MMA(1, 0, At, B0); PG8_BAR; PG8_SCHED;
            PG8_STAGE(PG8_SB(0, 1), b2 + hstep, voffB);
            PG8_WAIT_V(6); PG8_BAR; PG8_MMA(1, 1, At, B1); PG8_BAR;
            PG8_LDB(B0, 1, 0); PG8_SCHED; PG8_LDA(At, 1, 0); PG8_STAGE(PG8_SA(0, 1), a2 + hstep, voffA);
            PG8_WAIT_L(8); PG8_BAR; PG8_WAIT_L(0); PG8_MMA(0, 0, At, B0); PG8_BAR; PG8_SCHED;
            PG8_LDB(B1, 1, 1); PG8_STAGE(PG8_SB(1, 0), b3, voffB);
            PG8_BAR; PG8_WAIT_L(0); PG8_MMA(0, 1, At, B1); PG8_BAR;
            PG8_LDA(At, 1, 1); PG8_STAGE(PG8_SA(1, 0), a3, voffA);
            PG8_BAR; PG8_WAIT_L(0); PG8_MMA(1, 0, At, B0); PG8_BAR; PG8_SCHED;
            PG8_STAGE(PG8_SB(1, 1), b3 + hstep, voffB);
            PG8_WAIT_V(6); PG8_BAR; PG8_MMA(1, 1, At, B1); PG8_BAR;
            }
        }
        if constexpr (ALIGN_EPI) { if (wr == 0) PG8_BAR; }
        if constexpr (!Epi::AFTER_DRAIN) { E(acc, cur, wr, wc, fr, fq); S.done(cur); }
        if (!has_next) break;
#pragma unroll
        for (int a = 0; a < 2; ++a)
#pragma unroll
            for (int b = 0; b < 2; ++b)
#pragma unroll
                for (int m = 0; m < 4; ++m)
#pragma unroll
                    for (int n = 0; n < 2; ++n) acc[a][b][m][n] = (f32x4){0.f, 0.f, 0.f, 0.f};
        cur = nxt; cA = nA; cB = nB; ++ui;
        if constexpr (ALIGN_EPI) { if (wr == 1) PG8_BAR; }
    }
    PG8_WAIT_V(0);
    if constexpr (!ALIGN_EPI) { if (wr == 0) PG8_BAR; }
    PG8_BAR;
    if constexpr (Epi::AFTER_DRAIN) { E.fused(acc, cur, wr, wc, fr, fq, lds, wid, lane); S.done(cur); }
#undef PG8_SA
#undef PG8_SB
#undef PG8_STAGE
#undef PG8_LDA
#undef PG8_LDB
#undef PG8_MMA
#undef PG8_WAIT_V
#undef PG8_WAIT_L
#undef PG8_BAR
#undef PG8_SCHED
}
}
#include <hip/hip_bf16.h>
#include <cmath>
namespace attn_body {
using bf16=__hip_bfloat16;
using bf16x8=__attribute__((ext_vector_type(8)))short;
using s16x4=__attribute__((ext_vector_type(4)))short;
using f32x16=__attribute__((ext_vector_type(16)))float;
using u32x4=__attribute__((ext_vector_type(4)))unsigned;
constexpr int SEQ=8448,D=64,DM=2560,DMO=1024;
using f32x4=__attribute__((ext_vector_type(4)))float;
constexpr int NW=8,QBLK=32,QB=QBLK*NW,KVBLK=64,NQB=SEQ/QB;
constexpr int ATTN_UNIT_ROWS=QB;
__device__ __forceinline__ int crow(int r,int hi){return (r&3)+8*(r>>2)+4*hi;}
#define SBAR() __builtin_amdgcn_sched_barrier(0)
__device__ __forceinline__ void cmask(f32x16&p0,f32x16&p1,int jb,int qrel,int hi){
  const float NEG=-INFINITY; int kb=64*jb+4*hi;
  #pragma unroll
  for(int r=0;r<16;++r){int kv=kb+(r&3)+8*(r>>2); if(kv>qrel)p0[r]=NEG; if(kv+32>qrel)p1[r]=NEG;}
}

constexpr int NSLOT=3, SLOTB=8192;
constexpr int LDS_K=0, LDS_V=NSLOT*SLOTB, LDS_WS=2*NSLOT*SLOTB, LDS_OST=LDS_WS+NW*64*4, LDS_BYTES=LDS_OST+NW*4096, LDS_CS=LDS_BYTES, LDS_FLAGS=LDS_CS+SEQ*4, LDS_END=LDS_FLAGS+256;
constexpr float C2=0.125f*1.4426950408889634f;
__device__ __forceinline__ void glds16(const void*gsrc,unsigned lds_dst){unsigned keep;
  asm volatile("s_mov_b32 %0, m0\n\ts_mov_b32 m0, %2\n\ts_nop 0\n\tglobal_load_lds_dwordx4 %1, off\n\ts_mov_b32 m0, %0":"=&s"(keep):"v"(gsrc),"s"(lds_dst):"memory");}
__device__ __forceinline__ float max3f(float a,float b,float c){float r;asm("v_max3_f32 %0, %1, %2, %3":"=v"(r):"v"(a),"v"(b),"v"(c));return r;}
__device__ __forceinline__ float max2f(float a,float b){float r;asm("v_max_f32_e32 %0, %1, %2":"=v"(r):"v"(a),"v"(b));return r;}
__device__ __forceinline__ float fadd_s(float a,float b){float r;asm("v_add_f32_e32 %0, %1, %2":"=v"(r):"v"(a),"v"(b));return r;}
__device__ __forceinline__ float fsub_s(float a,float b){float r;asm("v_sub_f32_e32 %0, %1, %2":"=v"(r):"v"(a),"v"(b));return r;}
typedef float f32x2_t __attribute__((ext_vector_type(2))); typedef __bf16 bf16x2_t __attribute__((ext_vector_type(2)));
__device__ __forceinline__ unsigned cvtpk_s(float lo,float hi){f32x2_t v={lo,hi};bf16x2_t b=__builtin_convertvector(v,bf16x2_t);return __builtin_bit_cast(unsigned,b);}
#define WAIT_BAR(N) asm volatile("s_waitcnt vmcnt(" #N ") lgkmcnt(0)\n\ts_barrier":::"memory")

__device__ __forceinline__ void qkt(f32x16&p0,f32x16&p1,const char*Kslot,const bf16x8*qr,int r32,int hi){
  const char*kb=Kslot+hi*1024+r32*16;
  #pragma unroll
  for(int d0=0;d0<4;++d0){
    const bf16x8 b0=*reinterpret_cast<const bf16x8*>(kb+d0*2048);
    const bf16x8 b1=*reinterpret_cast<const bf16x8*>(kb+d0*2048+512);
    {p0=__builtin_amdgcn_mfma_f32_32x32x16_bf16(b0,qr[d0],p0,0,0,0);p1=__builtin_amdgcn_mfma_f32_32x32x16_bf16(b1,qr[d0],p1,0,0,0);}}
}
typedef __attribute__((address_space(3))) const char* lds_cptr;
typedef short v4i16_t __attribute__((ext_vector_type(4)));
__device__ __forceinline__ void kload8(bf16x8*kf,lds_cptr kp){
  kf[0]=*(const __attribute__((address_space(3))) bf16x8*)(kp);      kf[1]=*(const __attribute__((address_space(3))) bf16x8*)(kp+512);
  kf[2]=*(const __attribute__((address_space(3))) bf16x8*)(kp+2048); kf[3]=*(const __attribute__((address_space(3))) bf16x8*)(kp+2560);
  kf[4]=*(const __attribute__((address_space(3))) bf16x8*)(kp+4096); kf[5]=*(const __attribute__((address_space(3))) bf16x8*)(kp+4608);
  kf[6]=*(const __attribute__((address_space(3))) bf16x8*)(kp+6144); kf[7]=*(const __attribute__((address_space(3))) bf16x8*)(kp+6656);
}
__device__ __forceinline__ void kload2(bf16x8*kf,lds_cptr kp,int j){ kf[2*j]=*(const __attribute__((address_space(3))) bf16x8*)(kp+j*2048); kf[2*j+1]=*(const __attribute__((address_space(3))) bf16x8*)(kp+j*2048+512); }
__device__ __forceinline__ s16x4 vtr(lds_cptr p){ return __builtin_bit_cast(s16x4,__builtin_amdgcn_ds_read_tr16_b64_v4i16((__attribute__((address_space(3))) v4i16_t*)p)); }
__device__ __forceinline__ float rowmax(const f32x16&p0,const f32x16&p1){
  float a=max3f(p0[0],p0[1],p1[0]),b=max3f(p0[2],p0[3],p1[1]);a=max3f(a,p1[2],p1[3]);
  #pragma unroll
  for(int r=4;r<16;r+=4){a=max3f(a,p0[r],p0[r+1]);b=max3f(b,p0[r+2],p0[r+3]);a=max3f(a,p1[r],p1[r+1]);b=max3f(b,p1[r+2],p1[r+3]);}
  const float m=max2f(a,b);
  auto rr=__builtin_amdgcn_permlane32_swap(__float_as_uint(m),__float_as_uint(m),false,false);
  return max2f(__uint_as_float(rr[0]),__uint_as_float(rr[1]));
}
__device__ __forceinline__ void pv(f32x16*o,int vb,bf16x8 pa0,bf16x8 pa1,bf16x8 pa2,bf16x8 pa3){
  #pragma unroll
  for(int d0=0;d0<2;++d0){s16x4 lo[4],hi[4];
    #pragma unroll
    for(int ks=0;ks<4;++ks){
      asm volatile("ds_read_b64_tr_b16 %0,%1 offset:%c2":"=&v"(lo[ks]):"v"(vb),"i"(d0*4096+ks*1024):"memory");
      asm volatile("ds_read_b64_tr_b16 %0,%1 offset:%c2":"=&v"(hi[ks]):"v"(vb),"i"(d0*4096+ks*1024+512):"memory");}
    asm volatile("s_waitcnt lgkmcnt(0)":::"memory");SBAR();
    #define PK(k) (bf16x8){lo[k][0],lo[k][1],lo[k][2],lo[k][3],hi[k][0],hi[k][1],hi[k][2],hi[k][3]}
    o[d0]=__builtin_amdgcn_mfma_f32_32x32x16_bf16(pa0,PK(0),o[d0],0,0,0);
    o[d0]=__builtin_amdgcn_mfma_f32_32x32x16_bf16(pa1,PK(1),o[d0],0,0,0);
    o[d0]=__builtin_amdgcn_mfma_f32_32x32x16_bf16(pa2,PK(2),o[d0],0,0,0);
    o[d0]=__builtin_amdgcn_mfma_f32_32x32x16_bf16(pa3,PK(3),o[d0],0,0,0);
    #undef PK
  }
}

__device__ __forceinline__ u32x4 head_rms(u32x4 v){ float x[8];
  #pragma unroll
  for(int i=0;i<4;++i){x[2*i]=__uint_as_float(v[i]<<16);x[2*i+1]=__uint_as_float(v[i]&0xffff0000u);}
  float s=0.f;
  #pragma unroll
  for(int i=0;i<8;++i)s+=x[i]*x[i];
  s+=__shfl_xor(s,1);s+=__shfl_xor(s,2);s+=__shfl_xor(s,4);
  const float rs=__builtin_amdgcn_rsqf(s*(1.0f/64.0f)+1e-6f); u32x4 w;
  #pragma unroll
  for(int i=0;i<4;++i)w[i]=cvtpk_s(x[2*i]*rs,x[2*i+1]*rs);
  return w; }
#ifndef ATTN_STORE16
#define ATTN_STORE16(p,v) (*(u32x4*)(p)=(v))
#endif
template<int THRL> __device__ __forceinline__ void fox_unit(int b,int qb,float dthr,const bf16*Q,const bf16*__restrict__ K,const bf16*__restrict__ V,bf16*O,const float*__restrict__ csg,char*shm){
  int tid_=threadIdx.x; asm volatile("":"+v"(tid_)); const int tid=tid_,lane=tid&63,r32=lane&31,hi=lane>>5; const int wid=__builtin_amdgcn_readfirstlane(tid>>6);
  const long rowbase=(long)b*SEQ; const int q0=qb*QB;
  const bf16*Qw=Q+(rowbase+q0+wid*QBLK)*DM;
  const unsigned lds0=(unsigned)(uintptr_t)shm; const lds_cptr shm3=(lds_cptr)shm;
  float*wsf=(float*)(shm+LDS_WS)+wid*64;
  const unsigned kdst=lds0+LDS_K+wid*1024, vdst=lds0+LDS_V+wid*1024;
  #define DMA_K(t,slot) glds16(ksrc+(long)(t)*KVBLK*DM,(unsigned)__builtin_amdgcn_readfirstlane(kdst+(slot)))
  #define DMA_V(t,slot) glds16(vsrc+(long)(t)*KVBLK*DM,(unsigned)__builtin_amdgcn_readfirstlane(vdst+(slot)))
  const int vb0=(int)(lds0+LDS_V)+((lane>>4)&1)*32+(lane&3)*8+(4*hi+((lane&15)>>2))*64;
  const char*Kbase=shm+LDS_K; bf16x8 kf[8];
  const lds_cptr kp0=shm3+LDS_K+hi*1024+r32*16; const lds_cptr vp0=shm3+LDS_V+((lane>>4)&1)*32+(lane&3)*8+(4*hi+((lane&15)>>2))*64;
  typedef __attribute__((address_space(3))) float lds_f32; typedef __attribute__((address_space(3))) f32x4 lds_f32x4;
  { lds_f32*cl=(lds_f32*)(shm3+LDS_CS); const int n_=q0+QB; for(int i_=tid*4;i_<n_;i_+=2048){ const f32x4 v_=*(const f32x4*)(csg+i_); *(lds_f32x4*)(cl+i_)=v_; } }
  asm volatile("s_waitcnt vmcnt(0) lgkmcnt(0)\n\ts_barrier":::"memory");
  int j0;
  { const lds_f32*cl=(const lds_f32*)(shm3+LDS_CS); const float cq0=cl[q0]; int lo_=0,hi_=4*qb;
    while(lo_<hi_){ const int mid_=(lo_+hi_)>>1; if(cl[64*mid_+63]-cq0>=dthr)lo_=mid_+1; else hi_=mid_; }
    j0=__builtin_amdgcn_readfirstlane(lo_)&~1; }
  const bf16*Kh=K+(rowbase+(long)j0*KVBLK)*DM,*Vh=V+(rowbase+(long)j0*KVBLK)*DM;
  const bf16*ksrc=Kh+(long)lane*DM+wid*8;
  const bf16*vsrc=Vh+(long)(16*(wid&3)+(lane>>2))*DM+(wid>>2)*32+(lane&3)*8;
  const int NT=(q0+QB)/KVBLK-j0;
  const lds_f32*cl3=(const lds_f32*)(shm3+LDS_CS)+64*j0;
  DMA_K(0,0);DMA_V(0,0);DMA_K(1,SLOTB);
  bf16x8 qr[4];
  #pragma unroll
  for(int d0=0;d0<4;++d0)qr[d0]=*reinterpret_cast<const bf16x8*>(&Qw[(long)r32*DM+d0*16+hi*8]);
  float base=0.f,l_reg=0.f;f32x16 o[2];o[0]=f32x16{};o[1]=f32x16{};
  #define CINIT(C0,C1,t) do{ const lds_f32*cp_=cl3+64*(t)+4*hi; \
    _Pragma("unroll") for(int g_=0;g_<4;++g_){ const f32x4 a_=*(const lds_f32x4*)(cp_+8*g_), b_=*(const lds_f32x4*)(cp_+32+8*g_); \
      C0[4*g_]=base-a_[0];C0[4*g_+1]=base-a_[1];C0[4*g_+2]=base-a_[2];C0[4*g_+3]=base-a_[3]; \
      C1[4*g_]=base-b_[0];C1[4*g_+1]=base-b_[1];C1[4*g_+2]=base-b_[2];C1[4*g_+3]=base-b_[3]; } }while(0)
  const int qrel=wid*QBLK+r32;
  #define CMASK(P0,P1,t) do{int jb_=(t)-(NT-4); if(jb_>=0)cmask(P0,P1,jb_,qrel,hi);}while(0)
  bool resc=false;
  #define START(P0,P1) do{ const float rm=rowmax(P0,P1); resc=false; \
    { const float dl=rm; base=fsub_s(base,dl); \
      _Pragma("unroll") for(int r=0;r<16;++r){P0[r]=fsub_s(P0[r],dl);P1[r]=fsub_s(P1[r],dl);} } \
    _Pragma("unroll") for(int r=0;r<16;++r)P0[r]=__builtin_amdgcn_exp2f(P0[r]); }while(0)
  #define RESC() do{ if(resc){ asm volatile("s_waitcnt lgkmcnt(0)":::"memory"); \
      _Pragma("unroll") for(int d_=0;d_<2;++d_) _Pragma("unroll") for(int r=0;r<16;++r)o[d_][r]*=wsf[crow(r,hi)]; } }while(0)
  f32x16 pA0,pA1,pB0,pB1;
  int sl_prev=0,sl_cur=0,sl_next=SLOTB;
  #define ROT() do{sl_prev=sl_cur;sl_cur=sl_next;sl_next=(sl_next==(NSLOT-1)*SLOTB)?0:sl_next+SLOTB;}while(0)
  DMA_K(2,2*SLOTB);
  WAIT_BAR(3);
  base=cl3[q0-64*j0+wid*QBLK+r32];
  CINIT(pA0,pA1,0); qkt(pA0,pA1,Kbase,qr,r32,hi);asm volatile("s_nop 15\n\ts_nop 7":"+v"(pA0),"+v"(pA1));CMASK(pA0,pA1,0);
  START(pA0,pA1);
  _Pragma("unroll") for(int r=0;r<16;++r)pA1[r]=__builtin_amdgcn_exp2f(pA1[r]);
  WAIT_BAR(0);
  DMA_K(3,0);DMA_V(1,SLOTB);
  ROT();
  kload8(kf,kp0+sl_cur);
  WAIT_BAR(2);
  s16x4 vlo[8],vhi[8]; u32x4 pw0,pw1,pw2,pw3;
  #define PKW(P,B) cvtpk_s(P[B],P[B+1])
  #define PAF(k) __builtin_bit_cast(bf16x8,pw##k)
  #define VFR(i) (bf16x8){vlo[i][0],vlo[i][1],vlo[i][2],vlo[i][3],vhi[i][0],vhi[i][1],vhi[i][2],vhi[i][3]}
  #define PIN(x) asm volatile("":"+v"(x))
  #define MX3(a,b,c) __builtin_fmaxf(__builtin_fmaxf((a),(b)),(c))
  #define GAPA(MF,A0,A1,A2,A3,W0,W1,PW) do{ MF; sacc+=A0; sacc+=A1; sacc+=A2; sacc+=A3; PIN(sacc); W0; W1; PIN(PW); SBAR(); }while(0)
  #define EX(v) __builtin_amdgcn_exp2f(v)
  #define GAPB(MF,X,B) do{ MF; X[B]=EX(X[B]); X[B+1]=EX(X[B+1]); X[B+2]=EX(X[B+2]); X[B+3]=EX(X[B+3]); PIN(X); SBAR(); }while(0)
  #define VRD(i) do{ vlo[i]=vtr(vp_+(((i)>>2)*4096+((i)&3)*1024)); vhi[i]=vtr(vp_+(((i)>>2)*4096+((i)&3)*1024+512)); }while(0)
  #define KRD(G,j) do{ if(G){ kload2(kf,kp0+sl_next,j); SBAR(); } }while(0)
  #define STEP(C0,C1,P0,P1,t,GK,GV,GL) do{ SBAR(); CINIT(C0,C1,t); SBAR(); \
    const lds_cptr vp_=vp0+sl_prev; \
    VRD(0); SBAR(); float sacc=(P0[0]+P0[1]); \
    GAPA(C0=__builtin_amdgcn_mfma_f32_32x32x16_bf16(kf[0],qr[0],C0,0,0,0), P0[2],P0[3],P0[4],P0[5],     pw0[0]=PKW(P0,0), pw0[1]=PKW(P0,2), pw0); \
    VRD(4); SBAR(); GAPA(C1=__builtin_amdgcn_mfma_f32_32x32x16_bf16(kf[1],qr[0],C1,0,0,0), P0[6],P0[7],P0[8],P0[9],     pw0[2]=PKW(P0,4), pw0[3]=PKW(P0,6), pw0); \
    VRD(1); SBAR(); GAPA(C0=__builtin_amdgcn_mfma_f32_32x32x16_bf16(kf[2],qr[1],C0,0,0,0),   P0[10],P0[11],P0[12],P0[13], pw1[0]=PKW(P0,8), pw1[1]=PKW(P0,10), pw1); \
    VRD(5); SBAR(); GAPA(C1=__builtin_amdgcn_mfma_f32_32x32x16_bf16(kf[3],qr[1],C1,0,0,0),   P0[14],P0[15],P1[0],P1[1],   pw1[2]=PKW(P0,12),pw1[3]=PKW(P0,14), pw1); \
    VRD(2); SBAR(); GAPA(C0=__builtin_amdgcn_mfma_f32_32x32x16_bf16(kf[4],qr[2],C0,0,0,0),   P1[2],P1[3],P1[4],P1[5],     pw2[0]=PKW(P1,0), pw2[1]=PKW(P1,2), pw2); \
    VRD(6); SBAR(); GAPA(C1=__builtin_amdgcn_mfma_f32_32x32x16_bf16(kf[5],qr[2],C1,0,0,0),   P1[6],P1[7],P1[8],P1[9],     pw2[2]=PKW(P1,4), pw2[3]=PKW(P1,6), pw2); \
    VRD(3); SBAR(); GAPA(C0=__builtin_amdgcn_mfma_f32_32x32x16_bf16(kf[6],qr[3],C0,0,0,0),   P1[10],P1[11],P1[12],P1[13], pw3[0]=PKW(P1,8), pw3[1]=PKW(P1,10), pw3); \
    VRD(7); SBAR(); GAPA(C1=__builtin_amdgcn_mfma_f32_32x32x16_bf16(kf[7],qr[3],C1,0,0,0),   P1[14],P1[15],0.f,0.f,       pw3[2]=PKW(P1,12),pw3[3]=PKW(P1,14), pw3); \
    l_reg+=sacc; \
    if(GK){DMA_K((t)+3,sl_cur);} if(GV){DMA_V((t)+1,sl_next);} \
    CMASK(C0,C1,t); \
    { float a=MX3(C0[0],C0[1],C1[0]),b=MX3(C0[2],C0[3],C1[1]); a=MX3(a,C1[2],C1[3]); \
      _Pragma("unroll") for(int r=4;r<16;r+=4){a=MX3(a,C0[r],C0[r+1]);b=MX3(b,C0[r+2],C0[r+3]);a=MX3(a,C1[r],C1[r+1]);b=MX3(b,C1[r+2],C1[r+3]);} \
      float rm=__builtin_fmaxf(a,b); { auto rr=__builtin_amdgcn_permlane32_swap(__float_as_uint(rm),__float_as_uint(rm),false,false); rm=__builtin_fmaxf(__uint_as_float(rr[0]),__uint_as_float(rr[1])); } \
      resc=false; \
      if(__builtin_expect(__any(rm>(float)THRL),0)){ const float dl=__builtin_fmaxf(rm,0.f); base-=dl; \
        _Pragma("unroll") for(int r=0;r<16;++r){C0[r]-=dl;C1[r]-=dl;} \
        const float f=__builtin_amdgcn_exp2f(-dl); l_reg*=f; if(hi==0)wsf[r32]=f; resc=true; } } \
    SBAR(); \
    GAPB(o[0]=__builtin_amdgcn_mfma_f32_32x32x16_bf16(PAF(0),VFR(0),o[0],0,0,0), C0,0); \
    GAPB(o[1]=__builtin_amdgcn_mfma_f32_32x32x16_bf16(PAF(0),VFR(4),o[1],0,0,0), C0,4); \
    KRD(GL,0); GAPB(o[0]=__builtin_amdgcn_mfma_f32_32x32x16_bf16(PAF(1),VFR(1),o[0],0,0,0), C0,8); \
    KRD(GL,1); GAPB(o[1]=__builtin_amdgcn_mfma_f32_32x32x16_bf16(PAF(1),VFR(5),o[1],0,0,0), C0,12); \
    KRD(GL,2); GAPB(o[0]=__builtin_amdgcn_mfma_f32_32x32x16_bf16(PAF(2),VFR(2),o[0],0,0,0), C1,0); \
    KRD(GL,3); GAPB(o[1]=__builtin_amdgcn_mfma_f32_32x32x16_bf16(PAF(2),VFR(6),o[1],0,0,0), C1,4); \
    GAPB(o[0]=__builtin_amdgcn_mfma_f32_32x32x16_bf16(PAF(3),VFR(3),o[0],0,0,0), C1,8); \
    GAPB(o[1]=__builtin_amdgcn_mfma_f32_32x32x16_bf16(PAF(3),VFR(7),o[1],0,0,0), C1,12); \
    }while(0)
  int t=1;
  #undef CMASK
  #define CMASK(P0,P1,t) do{}while(0)
  for(;t+5<NT;t+=2){
    STEP(pB0,pB1,pA0,pA1,t,true,true,true);     WAIT_BAR(2); RESC(); ROT();
    STEP(pA0,pA1,pB0,pB1,t+1,true,true,true);   WAIT_BAR(2); RESC(); ROT();
  }
  #undef CMASK
  #define CMASK(P0,P1,t) do{int jb_=(t)-(NT-4); if(jb_>=0)cmask(P0,P1,jb_,qrel,hi);}while(0)
  #define ENDW(tt) do{ if((tt)+3<NT){WAIT_BAR(2);} else if((tt)+2<NT){WAIT_BAR(1);} else {WAIT_BAR(0);} }while(0)
  for(;t+1<NT;t+=2){
    STEP(pB0,pB1,pA0,pA1,t,(t+3<NT),(t+1<NT),(t+1<NT));       ENDW(t);   RESC(); ROT();
    STEP(pA0,pA1,pB0,pB1,t+1,(t+4<NT),(t+2<NT),(t+2<NT));     ENDW(t+1); RESC(); ROT();
  }
  STEP(pB0,pB1,pA0,pA1,NT-1,false,false,false); RESC();
  { float sacc=pB0[0]+pB0[1]; _Pragma("unroll") for(int r=2;r<16;++r)sacc+=pB0[r]; _Pragma("unroll") for(int r=0;r<16;++r)sacc+=pB1[r]; l_reg+=sacc;
    pw0=(u32x4){PKW(pB0,0),PKW(pB0,2),PKW(pB0,4),PKW(pB0,6)};pw1=(u32x4){PKW(pB0,8),PKW(pB0,10),PKW(pB0,12),PKW(pB0,14)};pw2=(u32x4){PKW(pB1,0),PKW(pB1,2),PKW(pB1,4),PKW(pB1,6)};pw3=(u32x4){PKW(pB1,8),PKW(pB1,10),PKW(pB1,12),PKW(pB1,14)};
    SBAR(); pv(o,vb0+sl_cur,PAF(0),PAF(1),PAF(2),PAF(3)); }
  #undef PKW
  #undef PAF
  #undef VFR
  #undef PIN
  #undef MX3
  #undef GAPA
  #undef GAPB
  #undef EX
  #undef VRD
  #undef KRD
  #undef STEP
  #undef ENDW
  {auto rr=__builtin_amdgcn_permlane32_swap(__float_as_uint(l_reg),__float_as_uint(l_reg),false,false);l_reg=__uint_as_float(rr[0])+__uint_as_float(rr[1]);}
  if(hi==0)wsf[32+r32]=l_reg;asm volatile("s_waitcnt lgkmcnt(0)":::"memory");
  float rli[16];
  #pragma unroll
  for(int r=0;r<16;++r)rli[r]=__builtin_amdgcn_rcpf(wsf[32+crow(r,hi)]);
  bf16*Ow=O+(rowbase+q0+wid*QBLK)*DMO;
  { bf16*stg=(bf16*)(shm+LDS_OST)+wid*2048;
    #pragma unroll
    for(int r=0;r<16;++r){const int orow=crow(r,hi);
      #pragma unroll
      for(int d0=0;d0<2;++d0)stg[orow*64+d0*32+r32]=__float2bfloat16(o[d0][r]*rli[r]);}
    asm volatile("s_waitcnt lgkmcnt(0)":::"memory");
    #pragma unroll
    for(int i=0;i<4;++i){const int row=i*8+(lane>>3),ch=lane&7; const u32x4 v=*(const u32x4*)(stg+row*64+ch*8); ATTN_STORE16(Ow+(long)row*DMO+ch*8,head_rms(v));} }
  asm volatile("s_waitcnt lgkmcnt(0)\n\ts_barrier":::"memory");
  #undef DMA_K
  #undef DMA_V
  #undef CMASK
  #undef CINIT
  #undef START
  #undef RESC
  #undef ROT
}
__device__ __forceinline__ float sp2f(float z){ const float e=__builtin_amdgcn_exp2f(-__builtin_fabsf(z)); return __builtin_fmaxf(z,0.f)+__builtin_amdgcn_logf(1.f+e); }
__device__ __forceinline__ void sb_unit(int b,int qb,const bf16*Q,const bf16*__restrict__ K,const bf16*__restrict__ V,bf16*O,char*shm){
  int tid_=threadIdx.x; asm volatile("":"+v"(tid_)); const int tid=tid_,lane=tid&63,r32=lane&31,hi=lane>>5; const int wid=__builtin_amdgcn_readfirstlane(tid>>6);
  const long rowbase=(long)b*SEQ; const int q0=qb*QB;
  const bf16*Qw=Q+(rowbase+q0+wid*QBLK)*DM;
  const bf16*Kh=K+rowbase*DM,*Vh=V+rowbase*DM;
  const unsigned lds0=(unsigned)(uintptr_t)shm; const lds_cptr shm3=(lds_cptr)shm;
  const bf16*ksrc=Kh+(long)lane*DM+wid*8;
  const bf16*vsrc=Vh+(long)(16*(wid&3)+(lane>>2))*DM+(wid>>2)*32+(lane&3)*8;
  const unsigned kdst=lds0+LDS_K+wid*1024, vdst=lds0+LDS_V+wid*1024;
  #define DMA_K(t,slot) glds16(ksrc+(long)(t)*KVBLK*DM,(unsigned)__builtin_amdgcn_readfirstlane(kdst+(slot)))
  #define DMA_V(t,slot) glds16(vsrc+(long)(t)*KVBLK*DM,(unsigned)__builtin_amdgcn_readfirstlane(vdst+(slot)))
  const int vb0=(int)(lds0+LDS_V)+((lane>>4)&1)*32+(lane&3)*8+(4*hi+((lane&15)>>2))*64;
  typedef __attribute__((address_space(3))) unsigned lds_u32;
  volatile lds_u32*flags=(volatile lds_u32*)(shm3+LDS_FLAGS);
  bf16x8 qr[4];
  #pragma unroll
  for(int d0=0;d0<4;++d0)qr[d0]=*reinterpret_cast<const bf16x8*>(&Qw[(long)r32*DM+d0*16+hi*8]);
  asm volatile("":::"memory");
  f32x16 o[2];o[0]=f32x16{};o[1]=f32x16{};
  float R=0.f; const int qabs=q0+wid*QBLK+r32; bool done=false;
  const int jtop=4*qb+3;
  DMA_K(jtop,0);DMA_V(jtop,0);
  int slot=0;
  for(int j=jtop;j>=0;--j){
    if(j>0){ DMA_K(j-1,slot^SLOTB);DMA_V(j-1,slot^SLOTB); WAIT_BAR(2); } else { WAIT_BAR(0); }
    const bool active=(!done)&&(64*j<q0+wid*QBLK+31);
    if(active){
      f32x16 p0=f32x16{},p1=f32x16{};
      qkt(p0,p1,shm+LDS_K+slot,qr,r32,hi);
      const int kvb=64*j+4*hi; f32x16 s0,s1;
      #pragma unroll
      for(int r=0;r<16;++r){ const int kv=kvb+(r&3)+8*(r>>2); s0[r]=(kv<qabs)?sp2f(p0[r]):0.f; s1[r]=(kv+32<qabs)?sp2f(p1[r]):0.f; }
      float g0[4],g1[4],og0[4],og1[4],T0[4],T1[4];
      #pragma unroll
      for(int g=0;g<4;++g){ g0[g]=(s0[4*g]+s0[4*g+1])+(s0[4*g+2]+s0[4*g+3]); g1[g]=(s1[4*g]+s1[4*g+1])+(s1[4*g+2]+s1[4*g+3]); }
      #pragma unroll
      for(int g=0;g<4;++g){ og0[g]=__shfl_xor(g0[g],32); og1[g]=__shfl_xor(g1[g],32); }
      float run=R;
      #pragma unroll
      for(int g=3;g>=0;--g){ const float ah1=hi?g1[g]:og1[g], ah0=hi?og1[g]:g1[g]; const float t1=run; run+=ah1; const float t0=run; run+=ah0; T1[g]=hi?t1:t0; }
      #pragma unroll
      for(int g=3;g>=0;--g){ const float ah1=hi?g0[g]:og0[g], ah0=hi?og0[g]:g0[g]; const float t1=run; run+=ah1; const float t0=run; run+=ah0; T0[g]=hi?t1:t0; }
      R=run;
      #pragma unroll
      for(int g=0;g<4;++g){ float a0=T0[g],a1=T1[g];
        #pragma unroll
        for(int i=3;i>=0;--i){ const int r=4*g+i; const int kv=kvb+i+8*g; a0+=s0[r]; a1+=s1[r];
          p0[r]=(kv<qabs)?__builtin_amdgcn_exp2f(p0[r]-a0):0.f; p1[r]=(kv+32<qabs)?__builtin_amdgcn_exp2f(p1[r]-a1):0.f; } }
      u32x4 pw0,pw1,pw2,pw3;
      pw0=(u32x4){cvtpk_s(p0[0],p0[1]),cvtpk_s(p0[2],p0[3]),cvtpk_s(p0[4],p0[5]),cvtpk_s(p0[6],p0[7])};
      pw1=(u32x4){cvtpk_s(p0[8],p0[9]),cvtpk_s(p0[10],p0[11]),cvtpk_s(p0[12],p0[13]),cvtpk_s(p0[14],p0[15])};
      pw2=(u32x4){cvtpk_s(p1[0],p1[1]),cvtpk_s(p1[2],p1[3]),cvtpk_s(p1[4],p1[5]),cvtpk_s(p1[6],p1[7])};
      pw3=(u32x4){cvtpk_s(p1[8],p1[9]),cvtpk_s(p1[10],p1[11]),cvtpk_s(p1[12],p1[13]),cvtpk_s(p1[14],p1[15])};
      pv(o,vb0+slot,__builtin_bit_cast(bf16x8,pw0),__builtin_bit_cast(bf16x8,pw1),__builtin_bit_cast(bf16x8,pw2),__builtin_bit_cast(bf16x8,pw3));
      done=__all(R>=151.f)!=0;
    }
    if(lane==0)flags[wid]=done?1u:0u;
    asm volatile("s_waitcnt lgkmcnt(0)\n\ts_barrier":::"memory");
    unsigned alld=1u;
    #pragma unroll
    for(int w=0;w<NW;++w)alld&=flags[w];
    slot^=SLOTB;
    if(alld)break;
  }
  asm volatile("s_waitcnt vmcnt(0)":::"memory");
  bf16*Ow=O+(rowbase+q0+wid*QBLK)*DMO;
  { bf16*stg=(bf16*)(shm+LDS_OST)+wid*2048;
    #pragma unroll
    for(int r=0;r<16;++r){const int orow=crow(r,hi);
      #pragma unroll
      for(int d0=0;d0<2;++d0)stg[orow*64+d0*32+r32]=__float2bfloat16(o[d0][r]);}
    asm volatile("s_waitcnt lgkmcnt(0)":::"memory");
    #pragma unroll
    for(int i=0;i<4;++i){const int row=i*8+(lane>>3),ch=lane&7; const u32x4 v=*(const u32x4*)(stg+row*64+ch*8); ATTN_STORE16(Ow+(long)row*DMO+ch*8,head_rms(v));} }
  asm volatile("s_waitcnt vmcnt(0) lgkmcnt(0)\n\ts_barrier":::"memory");
  #undef DMA_K
  #undef DMA_V
}
#undef SBAR
#undef WAIT_BAR
}
namespace cg = cooperative_groups;
constexpr int NWAVES = 8;
constexpr int DMODEL = 1024, NBATCH = 4, SEQ_IN = 8192, NMETA = 16, LREAL = NMETA + SEQ_IN, LP = 8448  ;
constexpr int MROWS = NBATCH * LP;
constexpr int MREAL = NBATCH * SEQ_IN;
constexpr int INW = 2566, NINP = 2560, NIN = 2816, DFF = 2816, NGU = 2 * DFF, DEPTH = 2, NFH = 6;
constexpr float C2F = 0.125f * 1.4426950408889634f;
constexpr int PC_U = 0, PC_FQ = 256, PC_FK = 640, PC_FV = 1024, PC_SQ = 1408, PC_SK = 1792, PC_SV = 2176;
constexpr size_t MiB = 1u << 20;
constexpr size_t WS_CTL = 0, CTL_ZERO_BYTES = 1 * MiB;
constexpr size_t WS_SS = 64 * 1024;
constexpr size_t WS_W = 1 * MiB, W_LAYER = 24 * MiB, W_IN = 0, W_OUT = (size_t)NIN * 1024 * 2, W_GU = W_OUT + 2 * MiB, W_D = W_GU + (size_t)NGU * 1024 * 2;
constexpr size_t WS_LF = 49 * MiB, WS_CS = 51 * MiB, WS_H = 52 * MiB, WS_HB = 184 * MiB, WS_Y = 250 * MiB, WS_P = 316 * MiB, WS_END = WS_P + (size_t)MROWS * DFF * 2;
static_assert(W_D + (size_t)1024 * DFF * 2 <= W_LAYER && WS_W + 2 * W_LAYER <= WS_LF && WS_SS + 5 * (size_t)MROWS * 4 <= CTL_ZERO_BYTES, "ws map");
static_assert(WS_H + (size_t)MROWS * 1024 * 4 <= WS_HB && WS_HB + (size_t)MROWS * 1024 * 2 <= WS_Y && WS_Y + (size_t)MROWS * 1024 * 2 <= WS_P && WS_END <= 512 * MiB, "ws map");
constexpr int LDS_BYTES = 147456;
constexpr int LDS_MISC = 131072;

#define LAS __attribute__((address_space(3)))
typedef unsigned short bf16u;
typedef unsigned v4u __attribute__((ext_vector_type(4)));
typedef float f32x4 __attribute__((ext_vector_type(4)));
#define LDS_WAIT() asm volatile("s_waitcnt lgkmcnt(0)" ::: "memory")
__device__ __forceinline__ unsigned f2bf(float f) { unsigned u = __builtin_bit_cast(unsigned, f); return (u + 0x7fffu + ((u >> 16) & 1u)) >> 16; }
__device__ __forceinline__ unsigned pk2(float lo, float hi) { return f2bf(lo) | (f2bf(hi) << 16); }
__device__ __forceinline__ float wave_sum(float v) {
#pragma unroll
    for (int o = 1; o < 64; o <<= 1) v += __shfl_xor(v, o);
    return v;
}

struct Args { const float* in[15]; float* out; unsigned char* ws; };

struct WinSrc { const float* w; const float* g;
    __device__ __forceinline__ float operator()(int k, int n) const { if (n >= INW) return 0.f; const int col = n < 1408 ? n : (n < 2560 ? n + 6 : n - 2560 + 1408);
        const float sc = ((n >= PC_FQ && n < PC_FK) || (n >= PC_SQ && n < PC_SK)) ? C2F : 1.0f; return w[(size_t)k * INW + col] * g[k] * sc; } };
struct WoutSrc { const float* w; const float* fg; const float* sg;
    __device__ __forceinline__ float operator()(int k, int n) const { const float gn = k < 640 ? fg[k - 256] : sg[k - 640]; return w[(size_t)k * 1024 + n] * gn; } };
struct WguSrc { const float* wg; const float* wu; const float* g;
    __device__ __forceinline__ float operator()(int k, int c) const { const int pn = c >> 8, w = c & 255, j = pn * 128 + (w & 127); const long dlt = (w >> 7) ? (long)(wu - wg) : 0L; return wg[(long)k * DFF + j + dlt] * g[k]; } };
struct WdSrc { const float* w;
    __device__ __forceinline__ float operator()(int k, int n) const { return w[(size_t)k * 1024 + n]; } };
template <class F> __device__ __forceinline__ void conv_item(const F src, bf16u* WT, int K, int k0, int n0, LAS float* scr, int lane) {
    float tv[32];
#pragma unroll
    for (int i = 0; i < 32; ++i) tv[i] = src(k0 + 2 * i + (lane >> 5), n0 + (lane & 31));
#pragma unroll
    for (int i = 0; i < 32; ++i) scr[(2 * i + (lane >> 5)) * 33 + (lane & 31)] = tv[i];
    LDS_WAIT(); asm volatile("" ::: "memory");
    const int c = lane & 7;
#pragma unroll
    for (int j = 0; j < 4; ++j) { const int n = (lane >> 3) + 8 * j; const LAS float* s = scr + (8 * c) * 33 + n;
        v4u o; o.x = pk2(s[0 * 33], s[1 * 33]); o.y = pk2(s[2 * 33], s[3 * 33]); o.z = pk2(s[4 * 33], s[5 * 33]); o.w = pk2(s[6 * 33], s[7 * 33]);
        *(v4u*)(WT + (size_t)(n0 + n) * K + k0 + 8 * c) = o; }
    LDS_WAIT(); asm volatile("" ::: "memory");
}
__device__ __forceinline__ void fold_item(const float* wout, const float* pw, const float* ps, bf16u* WT, int item, int lane) {
    const int g = item >> 4, n = (item & 15) * 64 + lane;
    float acc[64];
#pragma unroll
    for (int c = 0; c < 64; ++c) acc[c] = 0.f;
    for (int d = 0; d < 64; ++d) { const float wv = wout[(size_t)(g * 64 + d) * 1024 + n] * ps[g * 64 + d];
#pragma unroll
        for (int c = 0; c < 64; ++c) acc[c] += pw[(g * 64 + c) * 64 + d] * wv; }
    bf16u* o = WT + (size_t)n * 1024 + g * 64;
#pragma unroll
    for (int c = 0; c < 64; c += 8) { v4u w; w.x = pk2(acc[c], acc[c + 1]); w.y = pk2(acc[c + 2], acc[c + 3]); w.z = pk2(acc[c + 4], acc[c + 5]); w.w = pk2(acc[c + 6], acc[c + 7]); *(v4u*)(o + c) = w; }
}
__device__ __forceinline__ void p0_prologue(const Args& A, unsigned char* ws, LAS unsigned char* lds, int wave, int lane) {
    LAS float* scr = (LAS float*)(lds + wave * 16384);
    const int gw = blockIdx.x * NWAVES + wave, NGW = gridDim.x * NWAVES;
    constexpr int I_IN = 16 * (NIN / 32), I_OUT = 12 * 32, I_GU = 16 * (NGU / 32), I_D = (DFF / 64) * 32, I_F = 64, I_L = I_IN + I_OUT + I_GU + I_D + I_F;
    for (int it = gw; it < DEPTH * I_L; it += NGW) {
        const int L = it / I_L; int r = it % I_L;
        bf16u* wb = (bf16u*)(ws + WS_W + (size_t)L * W_LAYER);
        if (r < I_IN) { WinSrc s{A.in[3] + (size_t)L * 1024 * INW, A.in[2] + L * 1024}; conv_item(s, (bf16u*)((unsigned char*)wb + W_IN), 1024, (r / (NIN / 32)) * 64, (r % (NIN / 32)) * 32, scr, lane); continue; } r -= I_IN;
        if (r < I_OUT) { WoutSrc s{A.in[9] + (size_t)L * 1024 * 1024, A.in[7] + L * 384, A.in[8] + L * 384}; conv_item(s, (bf16u*)((unsigned char*)wb + W_OUT), 1024, 256 + (r / 32) * 64, (r % 32) * 32, scr, lane); continue; } r -= I_OUT;
        if (r < I_GU) { WguSrc s{A.in[11] + (size_t)L * 1024 * DFF, A.in[12] + (size_t)L * 1024 * DFF, A.in[10] + L * 1024}; conv_item(s, (bf16u*)((unsigned char*)wb + W_GU), 1024, (r / (NGU / 32)) * 64, (r % (NGU / 32)) * 32, scr, lane); continue; } r -= I_GU;
        if (r < I_D) { WdSrc s{A.in[13] + (size_t)L * DFF * 1024}; conv_item(s, (bf16u*)((unsigned char*)wb + W_D), DFF, (r / 32) * 64, (r % 32) * 32, scr, lane); continue; } r -= I_D;
        fold_item(A.in[9] + (size_t)L * 1024 * 1024, A.in[5] + (size_t)L * 4 * 64 * 64, A.in[6] + L * 256, (bf16u*)((unsigned char*)wb + W_OUT), r, lane);
    }
    float* h = (float*)(ws + WS_H); bf16u* hb = (bf16u*)(ws + WS_HB); float* ss0 = (float*)(ws + WS_SS);
    for (int m = gw; m < MROWS; m += NGW) {
        const int b = m / LP, t = m % LP;
        f32x4 v[4]; float s = 0.f;
        if (t < LREAL) { const f32x4* src = (const f32x4*)(t < NMETA ? A.in[1] + (size_t)t * 1024 : A.in[0] + ((size_t)b * SEQ_IN + (t - NMETA)) * 1024) + lane;
#pragma unroll
            for (int j = 0; j < 4; ++j) { v[j] = src[64 * j]; s += (v[j].x * v[j].x + v[j].y * v[j].y) + (v[j].z * v[j].z + v[j].w * v[j].w); } }
        else {
#pragma unroll
            for (int j = 0; j < 4; ++j) v[j] = (f32x4){0.f, 0.f, 0.f, 0.f}; }
        s = wave_sum(s);
        f32x4* ho = (f32x4*)(h + (size_t)m * 1024) + lane; unsigned long long* bo = (unsigned long long*)(hb + (size_t)m * 1024) + lane;
#pragma unroll
        for (int j = 0; j < 4; ++j) { ho[64 * j] = v[j]; bo[64 * j] = (unsigned long long)pk2(v[j].x, v[j].y) | ((unsigned long long)pk2(v[j].z, v[j].w) << 32); }
        if (lane == 0) ss0[m] = s;
    }
}
typedef short bf16x8m __attribute__((ext_vector_type(8)));
template <int NBK> __device__ __forceinline__ void mini_item(f32x4 (&acc)[NBK], const bf16u* A16, const bf16u* Bt0, const bf16u* Bt1, int K, LAS unsigned char* lds, int wave, int lane) {
    const int fr = lane & 15, fq = lane >> 4, kw = K >> 3; const size_t o = (size_t)fr * K + wave * kw + 8 * fq;
#pragma unroll
    for (int nb = 0; nb < NBK; ++nb) acc[nb] = (f32x4){0.f, 0.f, 0.f, 0.f};
    for (int k = 0; k < kw; k += 32) { const bf16x8m a = *(const bf16x8m*)(A16 + o + k); const bf16x8m b0 = *(const bf16x8m*)(Bt0 + o + k);
        acc[0] = __builtin_amdgcn_mfma_f32_16x16x32_bf16(b0, a, acc[0], 0, 0, 0);
        if (NBK == 2) { const bf16x8m b1 = *(const bf16x8m*)(Bt1 + o + k); acc[NBK - 1] = __builtin_amdgcn_mfma_f32_16x16x32_bf16(b1, a, acc[NBK - 1], 0, 0, 0); } }
    LAS f32x4* red = (LAS f32x4*)lds;
#pragma unroll
    for (int nb = 0; nb < NBK; ++nb) red[(nb * 8 + wave) * 64 + lane] = acc[nb];
    __syncthreads();
    if (wave == 0) {
#pragma unroll
        for (int nb = 0; nb < NBK; ++nb) { f32x4 s = red[(nb * 8) * 64 + lane];
#pragma unroll
            for (int w = 1; w < 8; ++w) s += red[(nb * 8 + w) * 64 + lane];
            acc[nb] = s; } }
    __syncthreads();
}
__device__ __forceinline__ void mini_in(unsigned char* ws, const bf16u* wt, const float* ss, const float* fb, LAS unsigned char* lds, int wave, int lane) {
    const bf16u* A16 = (const bf16u*)(ws + WS_HB); bf16u* P = (bf16u*)(ws + WS_P); float* LF = (float*)(ws + WS_LF);
    const int half = gridDim.x / 2; if ((int)blockIdx.x < half) return;
    for (int it = blockIdx.x - half; it < 161; it += gridDim.x - half) { const int n0 = it * 16; f32x4 acc[1];
        mini_item<1>(acc, A16, wt + (size_t)n0 * 1024, nullptr, 1024, lds, wave, lane);
        if (wave == 0) { const int fr = lane & 15, fq = lane >> 4; const float rs = __builtin_amdgcn_rsqf(ss[fr] * (1.0f / 1024.0f) + 1e-6f); const f32x4 v = acc[0] * rs;
            if (n0 < NINP) { const unsigned long long w = (unsigned long long)pk2(v[0], v[1]) | ((unsigned long long)pk2(v[2], v[3]) << 32);
#pragma unroll
                for (int b = 0; b < NBATCH; ++b) *(unsigned long long*)(P + ((size_t)b * LP + fr) * NINP + n0 + 4 * fq) = w; }
            else if (fq < 2) { f32x4 l;
#pragma unroll
                for (int i = 0; i < 4; ++i) { const int c = 4 * fq + i; const float x = v[i] + fb[c < NFH ? c : 0]; l[i] = c < NFH ? -(fmaxf(-x, 0.f) + log1pf(expf(-fabsf(x)))) * 1.4426950408889634f : 0.f; }
#pragma unroll
                for (int b = 0; b < NBATCH; ++b) *(f32x4*)(LF + ((size_t)b * LP + fr) * 8 + 4 * fq) = l; } }
    }
}
__device__ __forceinline__ void mini_res(unsigned char* ws, const bf16u* A16, const bf16u* wt, int K, float* ssn, LAS unsigned char* lds, int wave, int lane) {
    float* h = (float*)(ws + WS_H); bf16u* hb = (bf16u*)(ws + WS_HB);
    for (int it = blockIdx.x; it < 64; it += gridDim.x) { const int n0 = it * 16; f32x4 acc[1];
        mini_item<1>(acc, A16, wt + (size_t)n0 * K, nullptr, K, lds, wave, lane);
        if (wave == 0) { const int fr = lane & 15, fq = lane >> 4; float* hp = h + (size_t)fr * 1024 + n0 + 4 * fq; const f32x4 a = *(const f32x4*)hp + acc[0]; *(f32x4*)hp = a;
            *(unsigned long long*)(hb + (size_t)fr * 1024 + n0 + 4 * fq) = (unsigned long long)pk2(a[0], a[1]) | ((unsigned long long)pk2(a[2], a[3]) << 32);
            float s = (a[0] * a[0] + a[1] * a[1]) + (a[2] * a[2] + a[3] * a[3]); s += __shfl_xor(s, 16); s += __shfl_xor(s, 32);
            if (fq == 0) atomicAdd(ssn + fr, s); }
    }
}
__device__ __forceinline__ void mini_gu(unsigned char* ws, const bf16u* wt, const float* ss, LAS unsigned char* lds, int wave, int lane) {
    const bf16u* A16 = (const bf16u*)(ws + WS_HB); bf16u* H = (bf16u*)(ws + WS_P);
    for (int it = blockIdx.x; it < DFF / 16; it += gridDim.x) { const int j0 = it * 16, cg = (j0 >> 7) * 256 + (j0 & 127); f32x4 acc[2];
        mini_item<2>(acc, A16, wt + (size_t)cg * 1024, wt + (size_t)(cg + 128) * 1024, 1024, lds, wave, lane);
        if (wave == 0) { const int fr = lane & 15, fq = lane >> 4; const float rs = __builtin_amdgcn_rsqf(ss[fr] * (1.0f / 1024.0f) + 1e-6f); float o[4];
#pragma unroll
            for (int i = 0; i < 4; ++i) { const float g = acc[0][i] * rs, up = acc[1][i] * rs; o[i] = g * __builtin_amdgcn_rcpf(1.0f + __builtin_amdgcn_exp2f(-1.4426950408889634f * g)) * up; }
            *(unsigned long long*)(H + (size_t)fr * DFF + j0 + 4 * fq) = (unsigned long long)pk2(o[0], o[1]) | ((unsigned long long)pk2(o[2], o[3]) << 32); }
    }
}
__device__ __forceinline__ void pool_scan_phase(unsigned char* ws, LAS unsigned char* lds, unsigned* nrm, int tid, int wave, int lane) {
    const float* LF = (const float*)(ws + WS_LF); float* CS = (float*)(ws + WS_CS);
    if (blockIdx.x < NBATCH * NFH) {
        const int b = blockIdx.x / NFH, hf = blockIdx.x % NFH; constexpr int PER = 17;
        const float* lf = LF + (size_t)b * LP * 8 + hf; float* cs = CS + (size_t)(b * NFH + hf) * LP;
        float v[PER]; float s = 0.f; const int t0 = tid * PER;
#pragma unroll
        for (int i = 0; i < PER; ++i) { const int t = t0 + i; const float x = t < LREAL ? lf[(size_t)t * 8] : 0.f; s += x; v[i] = s; }
        float incl = s;
#pragma unroll
        for (int o = 1; o < 64; o <<= 1) { const float n = __shfl_up(incl, o); if (lane >= o) incl += n; }
        LAS float* wsum = (LAS float*)(lds + LDS_MISC + 256);
        if (lane == 63) wsum[wave] = incl;
        __syncthreads();
        float off = 0.f;
        for (int w = 0; w < wave; ++w) off += wsum[w];
        const float excl = off + incl - s;
#pragma unroll
        for (int i = 0; i < PER; ++i) { const int t = t0 + i; if (t < LREAL) cs[t] = excl + v[i]; }
        __syncthreads();
    }
    const bf16u* P = (const bf16u*)(ws + WS_P); bf16u* Y = (bf16u*)(ws + WS_Y);
    for (int sl = blockIdx.x; sl < 256; sl += gridDim.x) {
        if (tid < 480) { const int sub = tid / 96, task = tid % 96, which = task / 48, head = (task % 48) >> 3, chunk = task & 7; const int r0 = sl * (MROWS / 256), b = r0 / LP;
            const bf16u* src = P + (which ? PC_FK : PC_FQ) + head * 64 + chunk * 8; float mx = 0.f;
#pragma unroll 9
            for (int r = sub; r < MROWS / 256; r += 5) { const v4u w = ((r0 + r) % LP < LREAL) ? *(const v4u*)(src + (size_t)(r0 + r) * NINP) : (v4u){0u, 0u, 0u, 0u}; float s = 0.f;
#pragma unroll
                for (int e = 0; e < 4; ++e) { const float lo = __uint_as_float(w[e] << 16), hi = __uint_as_float(w[e] & 0xffff0000u); s += lo * lo + hi * hi; }
                s += __shfl_xor(s, 1); s += __shfl_xor(s, 2); s += __shfl_xor(s, 4); mx = fmaxf(mx, s); }
            if (chunk == 0) atomicMax(nrm + (b * NFH + head) * 2 + which, __float_as_uint(mx)); }
    }
    const int rsub = tid >> 5, ch = (tid & 31) * 8, win = 2 << (ch >> 6);
    for (int c = blockIdx.x; c < MROWS / 16; c += gridDim.x) {
        const int row = c * 16 + rsub, t = row % LP; const int cnt = (t + 1 < win) ? t + 1 : win;
        float acc[8], self[8];
#pragma unroll
        for (int e = 0; e < 8; ++e) acc[e] = 0.f;
        v4u wv[16];
#pragma unroll
        for (int j = 0; j < 16; ++j) wv[j] = (j < cnt) ? *(const v4u*)(P + (size_t)(row - j) * NINP + PC_U + ch) : (v4u){0u, 0u, 0u, 0u};
#pragma unroll
        for (int j = 0; j < 16; ++j) {
#pragma unroll
            for (int e = 0; e < 4; ++e) { const float lo = __uint_as_float(wv[j][e] << 16), hi = __uint_as_float(wv[j][e] & 0xffff0000u); acc[2 * e] += lo; acc[2 * e + 1] += hi; if (j == 0) { self[2 * e] = lo; self[2 * e + 1] = hi; } } }
        const float inv = 1.0f / (float)cnt; v4u o;
#pragma unroll
        for (int e = 0; e < 4; ++e) o[e] = pk2(acc[2 * e] * inv - self[2 * e], acc[2 * e + 1] * inv - self[2 * e + 1]);
        *(v4u*)(Y + (size_t)row * 1024 + ch) = o;
    }
}
__device__ __forceinline__ void attn_phase(unsigned char* ws, unsigned char* lds_g, unsigned* ctr, const unsigned* nrm, int tid) {
    const attn_body::bf16* P = (const attn_body::bf16*)(ws + WS_P); attn_body::bf16* Y = (attn_body::bf16*)(ws + WS_Y); const float* CS = (const float*)(ws + WS_CS);
    volatile LAS unsigned* bw = (volatile LAS unsigned*)((LAS unsigned char*)lds_g + LDS_MISC);
    constexpr int NU = NBATCH * NFH * (LP / 256);
    for (;;) {
        if (tid == 0) bw[0] = atomicAdd(ctr, 1u);
        __syncthreads();
        const int it = (int)bw[0];
        __syncthreads();
        if (it >= 2 * NU) break;
        const int r = it < NU ? it : it - NU; const int qb = (LP / 256 - 1) - r / (NBATCH * NFH), bh = r % (NBATCH * NFH), b = bh / NFH, h = bh % NFH;
#ifndef NO_FOX
        if (it < NU) attn_body::fox_unit<8>(b, qb, 154.0f + 2.0f * sqrtf(__uint_as_float(nrm[bh * 2]) * __uint_as_float(nrm[bh * 2 + 1])), P + PC_FQ + h * 64, P + PC_FK + h * 64, P + PC_FV + h * 64, Y + 256 + h * 64, CS + (size_t)bh * LP, (char*)lds_g);
#endif
#ifndef NO_SB
        if (it >= NU) attn_body::sb_unit(b, qb, P + PC_SQ + h * 64, P + PC_SK + h * 64, P + PC_SV + h * 64, Y + 640 + h * 64, (char*)lds_g);
#endif
    }
}
__device__ __forceinline__ void final_phase(const Args& A, unsigned char* ws, int wave, int lane) {
    const float* h = (const float*)(ws + WS_H); const float* ss = (const float*)(ws + WS_SS) + 4 * (size_t)MROWS; const f32x4* g = (const f32x4*)A.in[14] + lane;
    const int gw = blockIdx.x * NWAVES + wave, NGW = gridDim.x * NWAVES;
    f32x4 gv[4];
#pragma unroll
    for (int j = 0; j < 4; ++j) gv[j] = g[64 * j];
    for (int m = gw; m < NBATCH * SEQ_IN; m += NGW) {
        const int b = m / SEQ_IN, s = m % SEQ_IN; const size_t row = (size_t)b * LP + NMETA + s;
        const float rs = 1.0f / sqrtf(ss[row] * (1.0f / 1024.0f) + 1e-6f);
        const f32x4* src = (const f32x4*)(h + row * 1024) + lane; f32x4* dst = (f32x4*)(A.out + (size_t)m * 1024) + lane;
#pragma unroll
        for (int j = 0; j < 4; ++j) dst[64 * j] = src[64 * j] * rs * gv[j];
    }
}

#define XB_TMO      128
#define XB_XCNT(j)  (256  + 64 * (j))
#define XB_XSUB(j)  (1280 + 64 * (j))
#define XB_XGEN(j)  (2304 + 64 * (j))
#define XB_TOP      3328
#define XB_TOPGEN   3392
#define XCD_BAR_WORDS 3456
#define XB_SPIN_CAP (1u << 18)

__device__ __forceinline__ unsigned xb_ld(unsigned* p)              { return __hip_atomic_load(p, __ATOMIC_RELAXED, __HIP_MEMORY_SCOPE_AGENT); }
__device__ __forceinline__ unsigned xb_add(unsigned* p, unsigned v) { return __hip_atomic_fetch_add(p, v, __ATOMIC_RELAXED, __HIP_MEMORY_SCOPE_AGENT); }
__device__ __forceinline__ unsigned xb_xcc_id() { return (unsigned)__builtin_amdgcn_s_getreg((3 << 11) | 20) & 0xFu; }
#define XB_SPIN(cond, bar) do { unsigned _sp = 0; while (cond) { __builtin_amdgcn_s_sleep(1); \
    if ((++_sp & 255u) == 0u) { if (xb_ld(&(bar)[XB_TMO])) break; if (_sp > XB_SPIN_CAP) { atomicAdd(&(bar)[XB_TMO], 1u); break; } } } } while (0)

struct XcdBarrier {
    unsigned* bar; unsigned x;
    volatile LAS unsigned* st;
};

__device__ __forceinline__ XcdBarrier xcd_barrier_post(unsigned* bar, volatile LAS unsigned* st) {
    XcdBarrier b; b.bar = bar; b.x = xb_xcc_id(); b.st = st;
    if (threadIdx.x == 0) (void)xb_add(&bar[XB_XCNT(b.x)], 1u);
    return b;
}
__device__ __forceinline__ void xcd_barrier_complete(unsigned* bar, unsigned x, unsigned& nloc, unsigned& nx) {
    const unsigned G = gridDim.x * gridDim.y * gridDim.z;
    unsigned sum, cnt, mine, sp = 0u;
    for (;;) {
        sum = 0u; cnt = 0u; mine = 0u;
#pragma unroll
        for (unsigned j = 0; j < 16; ++j) { const unsigned c = xb_ld(&bar[XB_XCNT(j)]); sum += c; cnt += (c > 0u) ? 1u : 0u; mine = (j == x) ? c : mine; }
        if (sum == G) break;
        __builtin_amdgcn_s_sleep(1);
        if ((++sp & 255u) == 0u) { if (xb_ld(&bar[XB_TMO])) break; if (sp > XB_SPIN_CAP) { atomicAdd(&bar[XB_TMO], 1u); break; } }
    }
    nloc = mine > 0u ? mine : 1u; nx = cnt > 0u ? cnt : 1u;
}

__device__ __forceinline__ void xcd_barrier(const XcdBarrier& b) {
    asm volatile("s_waitcnt vmcnt(0)" ::: "memory");
    __syncthreads();
    if (threadIdx.x == 0) {
        unsigned* bar = b.bar;
        __builtin_amdgcn_s_waitcnt(0);
        unsigned nloc = b.st[0], nx = b.st[1];
        if (nloc == 0u) { xcd_barrier_complete(bar, b.x, nloc, nx); b.st[0] = nloc; b.st[1] = nx; }
        const unsigned old = xb_add(&bar[XB_XSUB(b.x)], 1u);
        const unsigned gen = old / nloc;
        if (old + 1u == (gen + 1u) * nloc) {
            __builtin_amdgcn_fence(__ATOMIC_RELEASE, "agent");
            asm volatile("s_waitcnt vmcnt(0)" ::: "memory");
            const unsigned og = xb_add(&bar[XB_TOP], 1u);
            const unsigned tg = og / nx;
            if (og + 1u == (tg + 1u) * nx) xb_add(&bar[XB_TOPGEN], 1u);
            else XB_SPIN(xb_ld(&bar[XB_TOPGEN]) == tg, bar);
            __builtin_amdgcn_fence(__ATOMIC_ACQUIRE, "agent");
            xb_add(&bar[XB_XGEN(b.x)], 1u);
            asm volatile("s_waitcnt vmcnt(0)" ::: "memory");
        } else {
            XB_SPIN(xb_ld(&bar[XB_XGEN(b.x)]) == gen, bar);
            __builtin_amdgcn_fence(__ATOMIC_ACQUIRE, "agent");
            asm volatile("s_waitcnt vmcnt(0)" ::: "memory");
        }
    }
    __syncthreads();
}

#define FRESH() unsigned long zoff_ = 0; asm volatile("" : "+s"(zoff_)); unsigned char* ws = A.ws + zoff_; int tid = threadIdx.x; asm volatile("" : "+v"(tid)); const int lane = tid & 63, wave = __builtin_amdgcn_readfirstlane(tid >> 6); (void)lane; (void)wave
#ifdef PROBE
#define STAMP() do { if (blockIdx.x == 0 && threadIdx.x == 0) { ((volatile unsigned long long*)(A.ws + WS_CTL + 8192))[nst] = __builtin_amdgcn_s_memrealtime(); } ++nst; } while (0)
#else
#define STAMP() do {} while (0)
#endif
__global__ void __launch_bounds__(NWAVES * 64, 2) hymba_fwd(Args A) {
    extern __shared__ __attribute__((aligned(16))) unsigned char lds[];
    cg::grid_group grid = cg::this_grid();
    LAS unsigned char* L = (LAS unsigned char*)lds;
    if (threadIdx.x < 2) ((volatile LAS unsigned*)(L + LDS_MISC + 64))[threadIdx.x] = 0u;
    __syncthreads();
    const XcdBarrier xbar = xcd_barrier_post((unsigned*)(A.ws + WS_CTL) + 4096, (volatile LAS unsigned*)(L + LDS_MISC + 64));
#define GRID_BAR() xcd_barrier(xbar)
#ifdef PROBE
    int nst = 0; STAMP();
    for (int i = 0; i < 8; ++i) GRID_BAR();
    STAMP();
#endif
#ifndef NO_PRO
    { FRESH(); p0_prologue(A, ws, L, wave, lane); }
#endif
    grid.sync(); STAMP();
    for (int layer = 0; layer < DEPTH; ++layer) {
#ifndef NO_G1
        {
            FRESH(); const unsigned char* wb = ws + WS_W + (size_t)layer * W_LAYER;
            pg8::Gemm g{(const pg8::bf16_t*)(ws + WS_HB), (const pg8::bf16_t*)(wb + W_IN), MREAL, NIN, 1024}; pg8::StaticOrder S; S.init(MREAL, NIN, (int)gridDim.x, (int)blockIdx.x);
            pg8::EpiIn E{(pg8::bf16_t*)(ws + WS_P), (float*)(ws + WS_LF), (const float*)(ws + WS_SS) + (size_t)(2 * layer) * MROWS, A.in[4] + layer * NFH};
            mini_in(ws, (const bf16u*)(wb + W_IN), (const float*)(ws + WS_SS) + (size_t)(2 * layer) * MROWS, A.in[4] + layer * NFH, L, wave, lane);
            pg8::gemm_phase<pg8::EpiIn, pg8::StaticOrder, true, true>(L, g, S, E);
        }
#endif
        GRID_BAR(); STAMP();
#ifndef NO_POOL
        { FRESH(); pool_scan_phase(ws, L, (unsigned*)(ws + WS_CTL) + 128 + 64 * layer, tid, wave, lane); }
#endif
        GRID_BAR(); STAMP();
        { FRESH(); attn_phase(ws, lds, (unsigned*)(ws + WS_CTL) + 64 * layer, (const unsigned*)(ws + WS_CTL) + 128 + 64 * layer, tid); }
        GRID_BAR(); STAMP();
#ifndef NO_G3
        {
            FRESH(); const unsigned char* wb = ws + WS_W + (size_t)layer * W_LAYER;
            pg8::Gemm g{(const pg8::bf16_t*)(ws + WS_Y), (const pg8::bf16_t*)(wb + W_OUT), MREAL, 1024, 1024}; pg8::StaticOrder S; S.init(MREAL, 1024, (int)gridDim.x, (int)blockIdx.x);
            pg8::EpiRes E{(float*)(ws + WS_H), (pg8::bf16_t*)(ws + WS_HB), (float*)(ws + WS_SS) + (size_t)(2 * layer + 1) * MROWS};
            mini_res(ws, (const bf16u*)(ws + WS_Y), (const bf16u*)(wb + W_OUT), 1024, (float*)(ws + WS_SS) + (size_t)(2 * layer + 1) * MROWS, L, wave, lane);
            pg8::gemm_phase<pg8::EpiRes, pg8::StaticOrder, true, true>(L, g, S, E);
        }
#endif
        GRID_BAR(); STAMP();
#ifndef NO_G4
        {
            FRESH(); const unsigned char* wb = ws + WS_W + (size_t)layer * W_LAYER;
            pg8::Gemm g{(const pg8::bf16_t*)(ws + WS_HB), (const pg8::bf16_t*)(wb + W_GU), MREAL, NGU, 1024}; pg8::StaticOrder S; S.init(MREAL, NGU, (int)gridDim.x, (int)blockIdx.x);
            pg8::EpiGU E{(pg8::bf16_t*)(ws + WS_P), (const float*)(ws + WS_SS) + (size_t)(2 * layer + 1) * MROWS};
            mini_gu(ws, (const bf16u*)(wb + W_GU), (const float*)(ws + WS_SS) + (size_t)(2 * layer + 1) * MROWS, L, wave, lane);
            pg8::gemm_phase<pg8::EpiGU, pg8::StaticOrder, true, true>(L, g, S, E);
        }
#endif
        GRID_BAR(); STAMP();
#ifndef NO_G5
        {
            FRESH(); const unsigned char* wb = ws + WS_W + (size_t)layer * W_LAYER;
            pg8::Gemm g{(const pg8::bf16_t*)(ws + WS_P), (const pg8::bf16_t*)(wb + W_D), MREAL, 1024, DFF}; pg8::StaticOrder S; S.init(MREAL, 1024, (int)gridDim.x, (int)blockIdx.x);
            pg8::EpiRes E{(float*)(ws + WS_H), (pg8::bf16_t*)(ws + WS_HB), (float*)(ws + WS_SS) + (size_t)(2 * layer + 2) * MROWS};
            mini_res(ws, (const bf16u*)(ws + WS_P), (const bf16u*)(wb + W_D), DFF, (float*)(ws + WS_SS) + (size_t)(2 * layer + 2) * MROWS, L, wave, lane);
            pg8::gemm_phase<pg8::EpiRes, pg8::StaticOrder, true, true>(L, g, S, E);
        }
#endif
        GRID_BAR(); STAMP();
    }
    { FRESH(); final_phase(A, ws, wave, lane); }
#ifdef PROBE
    STAMP();
    grid.sync();
    {
        volatile unsigned long long* T = (volatile unsigned long long*)(A.ws + WS_CTL + 8192);
        if (blockIdx.x == 0) {
            const unsigned long long dA = T[PA + 1] - T[PA], dB = T[PB + 1] - T[PB];
            for (unsigned long long i = threadIdx.x; i < dB; i += NWAVES * 64) A.out[i] += 0.125f;
            if (threadIdx.x == 0) { const unsigned long long t0 = __builtin_amdgcn_s_memrealtime(); while (__builtin_amdgcn_s_memrealtime() - t0 < dA) __builtin_amdgcn_s_sleep(8); }
        }
    }
#endif
}

extern "C" void kernel_launch(void* const* d_in, const int* in_sizes, int n_in, void* d_out, int out_size, void* d_ws, size_t ws_size, hipStream_t stream) {
    static int grid = 0;
    if (grid == 0) {
        if (n_in != 15 || out_size != NBATCH * SEQ_IN * DMODEL || ws_size < WS_END) { fprintf(stderr, "kernel_launch: unexpected shapes (n_in %d out %d ws %zu, need %zu)\n", n_in, out_size, ws_size, (size_t)WS_END); grid = -1; return; }
        int dev = 0, cus = 0, per_cu = 0;
        if (hipGetDevice(&dev) != hipSuccess || hipDeviceGetAttribute(&cus, hipDeviceAttributeMultiprocessorCount, dev) != hipSuccess) { grid = -1; return; }
        if (hipFuncSetAttribute((const void*)hymba_fwd, hipFuncAttributeMaxDynamicSharedMemorySize, LDS_BYTES) != hipSuccess) { fprintf(stderr, "kernel_launch: hipFuncSetAttribute failed\n"); grid = -1; return; }
        if (hipOccupancyMaxActiveBlocksPerMultiprocessor(&per_cu, (const void*)hymba_fwd, NWAVES * 64, LDS_BYTES) != hipSuccess || per_cu < 1) { fprintf(stderr, "kernel_launch: occupancy query says %d\n", per_cu); per_cu = 1; }
        (void)hipGetLastError();
        grid = cus;
    }
    if (grid < 0) return;
    if (hipMemsetAsync((char*)d_ws + WS_CTL, 0, CTL_ZERO_BYTES, stream) != hipSuccess) { fprintf(stderr, "kernel_launch: memset failed\n"); return; }
    Args a{};
    for (int i = 0; i < 15; ++i) a.in[i] = (const float*)d_in[i];
    a.out = (float*)d_out; a.ws = (unsigned char*)d_ws;
    void* args[] = {&a};
    const hipError_t e = hipLaunchCooperativeKernel((const void*)hymba_fwd, dim3(grid), dim3(NWAVES * 64), args, LDS_BYTES, stream);
    if (e != hipSuccess) fprintf(stderr, "kernel_launch: cooperative launch failed: %s (grid %d)\n", hipGetErrorString(e), grid);
}
```

```cpp
#include <hip/hip_runtime.h>
#include <hip/hip_cooperative_groups.h>
#include <cstdio>
#include <cstdint>
namespace pg8 {
#define PG8_LAS __attribute__((address_space(3)))
typedef unsigned short bf16_t;
typedef short bf16x8 __attribute__((ext_vector_type(8)));
typedef float f32x4 __attribute__((ext_vector_type(4)));
typedef unsigned u32x4 __attribute__((ext_vector_type(4)));
constexpr int BM = 256, BK = 64, HALF = 128, HTB = HALF * BK * 2  , STAGE_BYTES = 8 * HTB, NXCD = 8, WGM = 8;

__host__ __device__ __forceinline__ int lds_byte(int r, int c) { const int st = (r >> 4) * 2 + (c >> 5), rr = r & 15, cc = c & 31, ob = rr * 64 + cc * 2; return st * 1024 + (ob ^ (((ob >> 9) & 1) << 5)); }
__host__ __device__ __forceinline__ void stage_rc(int b, int& R, int& C) { const int st = b / 1024, sb = b % 1024, swz = sb ^ (((sb >> 9) & 1) << 5); R = (st >> 1) * 16 + swz / 64; C = (st & 1) * 32 + (swz % 64) / 2; }
__host__ __device__ __forceinline__ int perm32(int rho) { const int n = rho >> 4, i = rho & 15; return 8 * (i >> 2) + 4 * n + (i & 3); }

struct Unit { int pm, pn; };
__host__ __device__ __forceinline__ int arow(int pm) { return 256 * (pm + (pm >> 5)) + 16; }
struct Gemm { const bf16_t* A; const bf16_t* Bt; int M, N, K; };

struct StaticOrder {
    int nM, nN, nwg, G, c;
    __host__ __device__ void init(int M, int N, int G_, int c_) { nM = M / BM; nN = N / BM; nwg = nM * nN; G = G_; c = c_; }
    __host__ __device__ bool next(int i, Unit& u) const {
        const long L = (long)i * G + c; if (L >= nwg) return false;
        int wgid = (int)L; { const int q = nwg / NXCD, r = nwg % NXCD, xcd = wgid % NXCD, off = wgid / NXCD; wgid = (xcd < r ? xcd * (q + 1) : r * (q + 1) + (xcd - r) * q) + off; }
        const int nig = WGM * nN, gid = wgid / nig, fm = gid * WGM, gsz = (nM - fm) < WGM ? (nM - fm) : WGM;
        u.pm = fm + ((wgid % nig) % gsz); u.pn = (wgid % nig) / gsz; return true;
    }
    __device__ __forceinline__ void a_ready(const Unit&) const {}
    __device__ __forceinline__ void done(const Unit&) const {}
};

__device__ __forceinline__ unsigned cvt_pk_bf16(float lo, float hi) { unsigned r; asm volatile("v_cvt_pk_bf16_f32 %0, %1, %2" : "=v"(r) : "v"(lo), "v"(hi)); return r; }
typedef unsigned u32x2 __attribute__((ext_vector_type(2)));
constexpr float RMS_EPS = 1e-6f;
struct EpiIn {
    static constexpr bool PERM = true, AFTER_DRAIN = false;
    bf16_t* P; float* LF; const float* ss; const float* fb;
    __device__ __forceinline__ void operator()(const f32x4 (&acc)[2][2][4][2], const Unit& u, int wr, int wc, int fr, int fq) const {
        const int row0 = arow(u.pm) + wr * 64 + fr;
        if (u.pn < 10) {
            const int col0 = u.pn * BM + wc * 32 + 8 * fq;
#pragma unroll
            for (int ai = 0; ai < 2; ++ai)
#pragma unroll
                for (int m = 0; m < 4; ++m) { const int row = row0 + ai * HALF + m * 16; const float rs = __builtin_amdgcn_rsqf(ss[row] * (1.0f / 1024.0f) + RMS_EPS);
                    bf16_t* rowp = P + (size_t)row * 2560 + col0;
#pragma unroll
                    for (int bj = 0; bj < 2; ++bj) { const f32x4 v0 = acc[ai][bj][m][0] * rs, v1 = acc[ai][bj][m][1] * rs;
                        u32x4 w; w.x = cvt_pk_bf16(v0[0], v0[1]); w.y = cvt_pk_bf16(v0[2], v0[3]); w.z = cvt_pk_bf16(v1[0], v1[1]); w.w = cvt_pk_bf16(v1[2], v1[3]);
                        *(u32x4*)(rowp + bj * HALF) = w; } }
        } else if (wc == 0 && fq == 0) {
            float b[6];
#pragma unroll
            for (int j = 0; j < 6; ++j) b[j] = fb[j];
#pragma unroll
            for (int ai = 0; ai < 2; ++ai)
#pragma unroll
                for (int m = 0; m < 4; ++m) { const int row = row0 + ai * HALF + m * 16; const float rs = __builtin_amdgcn_rsqf(ss[row] * (1.0f / 1024.0f) + RMS_EPS);
                    const f32x4 v0 = acc[ai][0][m][0] * rs, v1 = acc[ai][0][m][1] * rs;
                    float x[6] = {v0[0] + b[0], v0[1] + b[1], v0[2] + b[2], v0[3] + b[3], v1[0] + b[4], v1[1] + b[5]};
                    float l[6];
#pragma unroll
                    for (int j = 0; j < 6; ++j) l[j] = -(fmaxf(-x[j], 0.f) + log1pf(expf(-fabsf(x[j])))) * 1.4426950408889634f;
                    *(f32x4*)(LF + (size_t)row * 8) = (f32x4){l[0], l[1], l[2], l[3]};
                    *(f32x4*)(LF + (size_t)row * 8 + 4) = (f32x4){l[4], l[5], 0.f, 0.f}; }
        }
    }
};
struct EpiRes {
    static constexpr bool PERM = true, AFTER_DRAIN = false;
    float* h; bf16_t* hb; float* ssn;
    __device__ __forceinline__ void operator()(const f32x4 (&acc)[2][2][4][2], const Unit& u, int wr, int wc, int fr, int fq) const {
        const int row0 = arow(u.pm) + wr * 64 + fr, col0 = u.pn * BM + wc * 32 + 8 * fq;
#pragma unroll
        for (int ai = 0; ai < 2; ++ai)
#pragma unroll
            for (int m = 0; m < 4; ++m) { const int row = row0 + ai * HALF + m * 16; float* hp = h + (size_t)row * 1024 + col0; bf16_t* bp = hb + (size_t)row * 1024 + col0; float s = 0.f;
#pragma unroll
                for (int bj = 0; bj < 2; ++bj) { f32x4 a = *(const f32x4*)(hp + bj * HALF), b = *(const f32x4*)(hp + bj * HALF + 4);
                    a = a + acc[ai][bj][m][0]; b = b + acc[ai][bj][m][1];
                    *(f32x4*)(hp + bj * HALF) = a; *(f32x4*)(hp + bj * HALF + 4) = b;
                    s += (a[0] * a[0] + a[1] * a[1]) + (a[2] * a[2] + a[3] * a[3]) + (b[0] * b[0] + b[1] * b[1]) + (b[2] * b[2] + b[3] * b[3]);
                    u32x4 w; w.x = cvt_pk_bf16(a[0], a[1]); w.y = cvt_pk_bf16(a[2], a[3]); w.z = cvt_pk_bf16(b[0], b[1]); w.w = cvt_pk_bf16(b[2], b[3]);
                    *(u32x4*)(bp + bj * HALF) = w; }
                s += __shfl_xor(s, 16); s += __shfl_xor(s, 32);
                if (fq == 0) atomicAdd(ssn + row, s);
                asm volatile("" ::: "memory"); }
    }
};
struct EpiGU {
    static constexpr bool PERM = true, AFTER_DRAIN = false;
    bf16_t* H; const float* ss;
    __device__ __forceinline__ void operator()(const f32x4 (&acc)[2][2][4][2], const Unit& u, int wr, int wc, int fr, int fq) const {
        const int row0 = arow(u.pm) + wr * 64 + fr, col0 = u.pn * HALF + wc * 32 + 8 * fq;
#pragma unroll
        for (int ai = 0; ai < 2; ++ai)
#pragma unroll
            for (int m = 0; m < 4; ++m) { const int row = row0 + ai * HALF + m * 16; const float rs = __builtin_amdgcn_rsqf(ss[row] * (1.0f / 1024.0f) + RMS_EPS);
                float o[8];
#pragma unroll
                for (int n = 0; n < 2; ++n)
#pragma unroll
                    for (int e = 0; e < 4; ++e) { const float g = acc[ai][0][m][n][e] * rs, up = acc[ai][1][m][n][e] * rs;
                        o[4 * n + e] = g * __builtin_amdgcn_rcpf(1.0f + __builtin_amdgcn_exp2f(-1.4426950408889634f * g)) * up; }
                u32x4 w; w.x = cvt_pk_bf16(o[0], o[1]); w.y = cvt_pk_bf16(o[2], o[3]); w.z = cvt_pk_bf16(o[4], o[5]); w.w = cvt_pk_bf16(o[6], o[7]);
                *(u32x4*)(H + (size_t)row * 2816 + col0) = w; }
    }
};
template <class Epi, class Sched, bool ALIGN_EPI = false, bool SP2 = false>
__device__ __forceinline__ void gemm_phase(PG8_LAS unsigned char* lds, const Gemm g, const Sched& S, const Epi& E) {
    int tid_ = threadIdx.x; asm volatile("" : "+v"(tid_));
    const int tid = tid_, wid = __builtin_amdgcn_readfirstlane(tid >> 6), lane = tid & 63, wr = wid >> 2, wc = wid & 3, fr = lane & 15, fq = lane >> 4;
    const int K = g.K, nt = K / BK;
    unsigned voffA[2], voffB[2];
#pragma unroll
    for (int i = 0; i < 2; ++i) { int R, C; stage_rc(tid * 16 + i * 8192, R, C); const int Rb = Epi::PERM ? ((R & ~31) + perm32(R & 31)) : R;
        voffA[i] = (unsigned)(R * K + C) * 2u; voffB[i] = (unsigned)(Rb * K + C) * 2u; }
    const size_t kstep = (size_t)(BK * 2);
    const size_t hstep = (size_t)HALF * K * 2;
    const size_t tstep = 2 * hstep;
    const unsigned ldsw = (unsigned)wid * 1024u;
    const int aoff = lds_byte(wr * 64 + fr, fq * 8), boff = lds_byte(wc * 32 + fr, fq * 8);
#define PG8_SA(b, h) (((b) * 2 + (h)) * HTB)
#define PG8_SB(b, h) ((4 + (b) * 2 + (h)) * HTB)
#define PG8_STAGE(bufoff, gbase, voff) do { _Pragma("unroll") for (int _i = 0; _i < 2; ++_i) \
        __builtin_amdgcn_global_load_lds((const unsigned*)((const char*)(gbase) + (voff)[_i]), (PG8_LAS unsigned*)(lds + (bufoff) + ldsw + _i * 8192), 16, 0, 0); } while (0)
#define PG8_LDA(dst, b, h) do { _Pragma("unroll") for (int m = 0; m < 4; ++m) _Pragma("unroll") for (int k = 0; k < 2; ++k) dst[m][k] = *(const PG8_LAS bf16x8*)(lds + PG8_SA(b, h) + aoff + m * 2048 + k * 1024); } while (0)
#define PG8_LDB(dst, b, h) do { _Pragma("unroll") for (int n = 0; n < 2; ++n) _Pragma("unroll") for (int k = 0; k < 2; ++k) dst[n][k] = *(const PG8_LAS bf16x8*)(lds + PG8_SB(b, h) + boff + n * 2048 + k * 1024); } while (0)
#define PG8_MMA(ai, bj, At, Bt) do { __builtin_amdgcn_s_setprio(1); _Pragma("unroll") for (int m = 0; m < 4; ++m) _Pragma("unroll") for (int n = 0; n < 2; ++n) _Pragma("unroll") for (int k = 0; k < 2; ++k) \
        acc[ai][bj][m][n] = __builtin_amdgcn_mfma_f32_16x16x32_bf16(Bt[n][k], At[m][k], acc[ai][bj][m][n], 0, 0, 0); __builtin_amdgcn_s_setprio(0); } while (0)
#define PG8_WAIT_V(n) asm volatile("s_waitcnt vmcnt(" #n ")" ::: "memory")
#define PG8_WAIT_L(n) asm volatile("s_waitcnt lgkmcnt(" #n ")" ::: "memory")
#define PG8_BAR __builtin_amdgcn_s_barrier()
#define PG8_SCHED __builtin_amdgcn_sched_barrier(0)
    Unit cur, nxt; int ui = 0;
    if (!S.next(0, cur)) return;
    f32x4 acc[2][2][4][2];
#pragma unroll
    for (int a = 0; a < 2; ++a)
#pragma unroll
        for (int b = 0; b < 2; ++b)
#pragma unroll
            for (int m = 0; m < 4; ++m)
#pragma unroll
                for (int n = 0; n < 2; ++n) acc[a][b][m][n] = (f32x4){0.f, 0.f, 0.f, 0.f};
    bf16x8 At[4][2], B0[2][2], B1[2][2];
    const char* cA = (const char*)g.A + (size_t)arow(cur.pm) * K * 2; const char* cB = (const char*)g.Bt + (size_t)cur.pn * tstep;
    S.a_ready(cur);
    if constexpr (SP2) {
        PG8_STAGE(PG8_SB(0, 0), cB, voffB); PG8_STAGE(PG8_SB(0, 1), cB + hstep, voffB); PG8_STAGE(PG8_SA(0, 0), cA, voffA); PG8_STAGE(PG8_SA(0, 1), cA + hstep, voffA);
        if (wr == 1) PG8_BAR;
        PG8_WAIT_V(2); PG8_BAR;
        PG8_STAGE(PG8_SB(1, 0), cB + kstep, voffB); PG8_STAGE(PG8_SA(1, 0), cA + kstep, voffA); PG8_STAGE(PG8_SB(1, 1), cB + hstep + kstep, voffB);
        PG8_WAIT_V(6); PG8_BAR;
    } else {
        PG8_STAGE(PG8_SB(0, 0), cB, voffB); PG8_STAGE(PG8_SA(0, 0), cA, voffA); PG8_STAGE(PG8_SB(0, 1), cB + hstep, voffB); PG8_STAGE(PG8_SA(0, 1), cA + hstep, voffA);
        if (wr == 1) PG8_BAR;
        PG8_WAIT_V(4); PG8_BAR;
        PG8_STAGE(PG8_SB(1, 0), cB + kstep, voffB); PG8_STAGE(PG8_SA(1, 0), cA + kstep, voffA); PG8_STAGE(PG8_SB(1, 1), cB + hstep + kstep, voffB);
        PG8_WAIT_V(6); PG8_BAR;
    }
    for (;;) {
        const bool has_next = S.next(ui + 1, nxt);
        const char* nA = has_next ? (const char*)g.A + (size_t)arow(nxt.pm) * K * 2 : cA; const char* nB = has_next ? (const char*)g.Bt + (size_t)nxt.pn * tstep : cB;
        for (int t = 0; t < nt; t += 2) {
            const bool last = (t == nt - 2);
            const char* a1 = cA + (size_t)(t + 1) * kstep;
            const char* a2 = last ? nA : cA + (size_t)(t + 2) * kstep; const char* b2 = last ? nB : cB + (size_t)(t + 2) * kstep;
            const char* a3 = a2 + kstep; const char* b3 = b2 + kstep;
            if (last && has_next) S.a_ready(nxt);
            if constexpr (SP2) {
            PG8_LDB(B0, 0, 0); PG8_LDB(B1, 0, 1); PG8_SCHED; PG8_LDA(At, 0, 0); PG8_STAGE(PG8_SA(1, 1), a1 + hstep, voffA);
            PG8_WAIT_V(8); PG8_WAIT_L(0); PG8_BAR; PG8_MMA(0, 0, At, B0); PG8_MMA(0, 1, At, B1); PG8_BAR; PG8_SCHED;
            PG8_LDA(At, 0, 1); PG8_STAGE(PG8_SB(0, 0), b2, voffB); PG8_STAGE(PG8_SB(0, 1), b2 + hstep, voffB); PG8_STAGE(PG8_SA(0, 0), a2, voffA);
            PG8_WAIT_V(8); PG8_WAIT_L(0); PG8_BAR; PG8_MMA(1, 0, At, B0); PG8_MMA(1, 1, At, B1); PG8_BAR; PG8_SCHED;
            PG8_LDB(B0, 1, 0); PG8_LDB(B1, 1, 1); PG8_SCHED; PG8_LDA(At, 1, 0); PG8_STAGE(PG8_SA(0, 1), a2 + hstep, voffA);
            PG8_WAIT_V(8); PG8_WAIT_L(0); PG8_BAR; PG8_MMA(0, 0, At, B0); PG8_MMA(0, 1, At, B1); PG8_BAR; PG8_SCHED;
            PG8_LDA(At, 1, 1); PG8_STAGE(PG8_SB(1, 0), b3, voffB); PG8_STAGE(PG8_SB(1, 1), b3 + hstep, voffB); PG8_STAGE(PG8_SA(1, 0), a3, voffA);
            PG8_WAIT_V(8); PG8_WAIT_L(0); PG8_BAR; PG8_MMA(1, 0, At, B0); PG8_MMA(1, 1, At, B1); PG8_BAR; PG8_SCHED;
            } else {
            PG8_LDB(B0, 0, 0); PG8_SCHED; PG8_LDA(At, 0, 0); PG8_STAGE(PG8_SA(1, 1), a1 + hstep, voffA);
            PG8_WAIT_L(8); PG8_BAR; PG8_WAIT_L(0); PG8_MMA(0, 0, At, B0); PG8_BAR; PG8_SCHED;
            PG8_LDB(B1, 0, 1); PG8_STAGE(PG8_SB(0, 0), b2, voffB);
            PG8_BAR; PG8_WAIT_L(0); PG8_MMA(0, 1, At, B1); PG8_BAR;
            PG8_LDA(At, 0, 1); PG8_STAGE(PG8_SA(0, 0), a2, voffA);
            PG8_BAR; PG8_WAIT_L(0); PG8_MMA(1, 0, At, B0); PG8_BAR; PG8_SCHED;
            PG8_STAGE(PG8_SB(0, 1), b2 + hstep, voffB);
            PG8_WAIT_V(6); PG8_BAR; PG8_MMA(1, 1, At, B1); PG8_BAR;
            PG8_LDB(B0, 1, 0); PG8_SCHED; PG8_LDA(At, 1, 0); PG8_STAGE(PG8_SA(0, 1), a2 + hstep, voffA);
            PG8_WAIT_L(8); PG8_BAR; PG8_WAIT_L(0); PG8_MMA(0, 0, At, B0); PG8_BAR; PG8_SCHED;
            PG8_LDB(B1, 1, 1); PG8_STAGE(PG8_SB(1, 0), b3, voffB);
            PG8_BAR; PG8_WAIT_L(0); PG8_MMA(0, 1, At, B1); PG8_BAR;
            PG8_LDA(At, 1, 1); PG8_STAGE(PG8_SA(1, 0), a3, voffA);
            PG8_BAR; PG8_WAIT_L(0); PG8_MMA(1, 0, At, B0); PG8_BAR; PG8_SCHED;
            PG8_STAGE(PG8_SB(1, 1), b3 + hstep, voffB);
            PG8_WAIT_V(6); PG8_BAR; PG8_MMA(1, 1, At, B1); PG8_BAR;
            }
        }
        if constexpr (ALIGN_EPI) { if (wr == 0) PG8_BAR; }
        if constexpr (!Epi::AFTER_DRAIN) { E(acc, cur, wr, wc, fr, fq); S.done(cur); }
        if (!has_next) break;
#pragma unroll
        for (int a = 0; a < 2; ++a)
#pragma unroll
            for (int b = 0; b < 2; ++b)
#pragma unroll
                for (int m = 0; m < 4; ++m)
#pragma unroll
                    for (int n = 0; n < 2; ++n) acc[a][b][m][n] = (f32x4){0.f, 0.f, 0.f, 0.f};
        cur = nxt; cA = nA; cB = nB; ++ui;
        if constexpr (ALIGN_EPI) { if (wr == 1) PG8_BAR; }
    }
    PG8_WAIT_V(0);
    if constexpr (!ALIGN_EPI) { if (wr == 0) PG8_BAR; }
    PG8_BAR;
    if constexpr (Epi::AFTER_DRAIN) { E.fused(acc, cur, wr, wc, fr, fq, lds, wid, lane); S.done(cur); }
#undef PG8_SA
#undef PG8_SB
#undef PG8_STAGE
#undef PG8_LDA
#undef PG8_LDB
#undef PG8_MMA
#undef PG8_WAIT_V
#undef PG8_WAIT_L
#undef PG8_BAR
#undef PG8_SCHED
}
}
#include <hip/hip_bf16.h>
#include <cmath>
namespace attn_body {
using bf16=__hip_bfloat16;
using bf16x8=__attribute__((ext_vector_type(8)))short;
using s16x4=__attribute__((ext_vector_type(4)))short;
using f32x16=__attribute__((ext_vector_type(16)))float;
using u32x4=__attribute__((ext_vector_type(4)))unsigned;
constexpr int SEQ=8448,D=64,DM=2560,DMO=1024;
using f32x4=__attribute__((ext_vector_type(4)))float;
constexpr int NW=8,QBLK=32,QB=QBLK*NW,KVBLK=64,NQB=SEQ/QB;
constexpr int ATTN_UNIT_ROWS=QB;
__device__ __forceinline__ int crow(int r,int hi){return (r&3)+8*(r>>2)+4*hi;}
#define SBAR() __builtin_amdgcn_sched_barrier(0)
__device__ __forceinline__ void cmask(f32x16&p0,f32x16&p1,int jb,int qrel,int hi){
  const float NEG=-INFINITY; int kb=64*jb+4*hi;
  #pragma unroll
  for(int r=0;r<16;++r){int kv=kb+(r&3)+8*(r>>2); if(kv>qrel)p0[r]=NEG; if(kv+32>qrel)p1[r]=NEG;}
}

constexpr int NSLOT=3, SLOTB=8192;
constexpr int LDS_K=0, LDS_V=NSLOT*SLOTB, LDS_WS=2*NSLOT*SLOTB, LDS_OST=LDS_WS+NW*64*4, LDS_BYTES=LDS_OST+NW*4096, LDS_CS=LDS_BYTES, LDS_FLAGS=LDS_CS+SEQ*4, LDS_END=LDS_FLAGS+256;
constexpr float C2=0.125f*1.4426950408889634f;
__device__ __forceinline__ void glds16(const void*gsrc,unsigned lds_dst){unsigned keep;
  asm volatile("s_mov_b32 %0, m0\n\ts_mov_b32 m0, %2\n\ts_nop 0\n\tglobal_load_lds_dwordx4 %1, off\n\ts_mov_b32 m0, %0":"=&s"(keep):"v"(gsrc),"s"(lds_dst):"memory");}
__device__ __forceinline__ float max3f(float a,float b,float c){float r;asm("v_max3_f32 %0, %1, %2, %3":"=v"(r):"v"(a),"v"(b),"v"(c));return r;}
__device__ __forceinline__ float max2f(float a,float b){float r;asm("v_max_f32_e32 %0, %1, %2":"=v"(r):"v"(a),"v"(b));return r;}
__device__ __forceinline__ float fadd_s(float a,float b){float r;asm("v_add_f32_e32 %0, %1, %2":"=v"(r):"v"(a),"v"(b));return r;}
__device__ __forceinline__ float fsub_s(float a,float b){float r;asm("v_sub_f32_e32 %0, %1, %2":"=v"(r):"v"(a),"v"(b));return r;}
typedef float f32x2_t __attribute__((ext_vector_type(2))); typedef __bf16 bf16x2_t __attribute__((ext_vector_type(2)));
__device__ __forceinline__ unsigned cvtpk_s(float lo,float hi){f32x2_t v={lo,hi};bf16x2_t b=__builtin_convertvector(v,bf16x2_t);return __builtin_bit_cast(unsigned,b);}
#define WAIT_BAR(N) asm volatile("s_waitcnt vmcnt(" #N ") lgkmcnt(0)\n\ts_barrier":::"memory")

__device__ __forceinline__ void qkt(f32x16&p0,f32x16&p1,const char*Kslot,const bf16x8*qr,int r32,int hi){
  const char*kb=Kslot+hi*1024+r32*16;
  #pragma unroll
  for(int d0=0;d0<4;++d0){
    const bf16x8 b0=*reinterpret_cast<const bf16x8*>(kb+d0*2048);
    const bf16x8 b1=*reinterpret_cast<const bf16x8*>(kb+d0*2048+512);
    {p0=__builtin_amdgcn_mfma_f32_32x32x16_bf16(b0,qr[d0],p0,0,0,0);p1=__builtin_amdgcn_mfma_f32_32x32x16_bf16(b1,qr[d0],p1,0,0,0);}}
}
typedef __attribute__((address_space(3))) const char* lds_cptr;
typedef short v4i16_t __attribute__((ext_vector_type(4)));
__device__ __forceinline__ void kload8(bf16x8*kf,lds_cptr kp){
  kf[0]=*(const __attribute__((address_space(3))) bf16x8*)(kp);      kf[1]=*(const __attribute__((address_space(3))) bf16x8*)(kp+512);
  kf[2]=*(const __attribute__((address_space(3))) bf16x8*)(kp+2048); kf[3]=*(const __attribute__((address_space(3))) bf16x8*)(kp+2560);
  kf[4]=*(const __attribute__((address_space(3))) bf16x8*)(kp+4096); kf[5]=*(const __attribute__((address_space(3))) bf16x8*)(kp+4608);
  kf[6]=*(const __attribute__((address_space(3))) bf16x8*)(kp+6144); kf[7]=*(const __attribute__((address_space(3))) bf16x8*)(kp+6656);
}
__device__ __forceinline__ void kload2(bf16x8*kf,lds_cptr kp,int j){ kf[2*j]=*(const __attribute__((address_space(3))) bf16x8*)(kp+j*2048); kf[2*j+1]=*(const __attribute__((address_space(3))) bf16x8*)(kp+j*2048+512); }
__device__ __forceinline__ s16x4 vtr(lds_cptr p){ return __builtin_bit_cast(s16x4,__builtin_amdgcn_ds_read_tr16_b64_v4i16((__attribute__((address_space(3))) v4i16_t*)p)); }
__device__ __forceinline__ float rowmax(const f32x16&p0,const f32x16&p1){
  float a=max3f(p0[0],p0[1],p1[0]),b=max3f(p0[2],p0[3],p1[1]);a=max3f(a,p1[2],p1[3]);
  #pragma unroll
  for(int r=4;r<16;r+=4){a=max3f(a,p0[r],p0[r+1]);b=max3f(b,p0[r+2],p0[r+3]);a=max3f(a,p1[r],p1[r+1]);b=max3f(b,p1[r+2],p1[r+3]);}
  const float m=max2f(a,b);
  auto rr=__builtin_amdgcn_permlane32_swap(__float_as_uint(m),__float_as_uint(m),false,false);
  return max2f(__uint_as_float(rr[0]),__uint_as_float(rr[1]));
}
__device__ __forceinline__ void pv(f32x16*o,int vb,bf16x8 pa0,bf16x8 pa1,bf16x8 pa2,bf16x8 pa3){
  #pragma unroll
  for(int d0=0;d0<2;++d0){s16x4 lo[4],hi[4];
    #pragma unroll
    for(int ks=0;ks<4;++ks){
      asm volatile("ds_read_b64_tr_b16 %0,%1 offset:%c2":"=&v"(lo[ks]):"v"(vb),"i"(d0*4096+ks*1024):"memory");
      asm volatile("ds_read_b64_tr_b16 %0,%1 offset:%c2":"=&v"(hi[ks]):"v"(vb),"i"(d0*4096+ks*1024+512):"memory");}
    asm volatile("s_waitcnt lgkmcnt(0)":::"memory");SBAR();
    #define PK(k) (bf16x8){lo[k][0],lo[k][1],lo[k][2],lo[k][3],hi[k][0],hi[k][1],hi[k][2],hi[k][3]}
    o[d0]=__builtin_amdgcn_mfma_f32_32x32x16_bf16(pa0,PK(0),o[d0],0,0,0);
    o[d0]=__builtin_amdgcn_mfma_f32_32x32x16_bf16(pa1,PK(1),o[d0],0,0,0);
    o[d0]=__builtin_amdgcn_mfma_f32_32x32x16_bf16(pa2,PK(2),o[d0],0,0,0);
    o[d0]=__builtin_amdgcn_mfma_f32_32x32x16_bf16(pa3,PK(3),o[d0],0,0,0);
    #undef PK
  }
}

__device__ __forceinline__ u32x4 head_rms(u32x4 v){ float x[8];
  #pragma unroll
  for(int i=0;i<4;++i){x[2*i]=__uint_as_float(v[i]<<16);x[2*i+1]=__uint_as_float(v[i]&0xffff0000u);}
  float s=0.f;
  #pragma unroll
  for(int i=0;i<8;++i)s+=x[i]*x[i];
  s+=__shfl_xor(s,1);s+=__shfl_xor(s,2);s+=__shfl_xor(s,4);
  const float rs=__builtin_amdgcn_rsqf(s*(1.0f/64.0f)+1e-6f); u32x4 w;
  #pragma unroll
  for(int i=0;i<4;++i)w[i]=cvtpk_s(x[2*i]*rs,x[2*i+1]*rs);
  return w; }
#ifndef ATTN_STORE16
#define ATTN_STORE16(p,v) (*(u32x4*)(p)=(v))
#endif
template<int THRL> __device__ __forceinline__ void fox_unit(int b,int qb,float dthr,const bf16*Q,const bf16*__restrict__ K,const bf16*__restrict__ V,bf16*O,const float*__restrict__ csg,char*shm){
  int tid_=threadIdx.x; asm volatile("":"+v"(tid_)); const int tid=tid_,lane=tid&63,r32=lane&31,hi=lane>>5; const int wid=__builtin_amdgcn_readfirstlane(tid>>6);
  const long rowbase=(long)b*SEQ; const int q0=qb*QB;
  const bf16*Qw=Q+(rowbase+q0+wid*QBLK)*DM;
  const unsigned lds0=(unsigned)(uintptr_t)shm; const lds_cptr shm3=(lds_cptr)shm;
  float*wsf=(float*)(shm+LDS_WS)+wid*64;
  const unsigned kdst=lds0+LDS_K+wid*1024, vdst=lds0+LDS_V+wid*1024;
  #define DMA_K(t,slot) glds16(ksrc+(long)(t)*KVBLK*DM,(unsigned)__builtin_amdgcn_readfirstlane(kdst+(slot)))
  #define DMA_V(t,slot) glds16(vsrc+(long)(t)*KVBLK*DM,(unsigned)__builtin_amdgcn_readfirstlane(vdst+(slot)))
  const int vb0=(int)(lds0+LDS_V)+((lane>>4)&1)*32+(lane&3)*8+(4*hi+((lane&15)>>2))*64;
  const char*Kbase=shm+LDS_K; bf16x8 kf[8];
  const lds_cptr kp0=shm3+LDS_K+hi*1024+r32*16; const lds_cptr vp0=shm3+LDS_V+((lane>>4)&1)*32+(lane&3)*8+(4*hi+((lane&15)>>2))*64;
  typedef __attribute__((address_space(3))) float lds_f32; typedef __attribute__((address_space(3))) f32x4 lds_f32x4;
  { lds_f32*cl=(lds_f32*)(shm3+LDS_CS); const int n_=q0+QB; for(int i_=tid*4;i_<n_;i_+=2048){ const f32x4 v_=*(const f32x4*)(csg+i_); *(lds_f32x4*)(cl+i_)=v_; } }
  asm volatile("s_waitcnt vmcnt(0) lgkmcnt(0)\n\ts_barrier":::"memory");
  int j0;
  { const lds_f32*cl=(const lds_f32*)(shm3+LDS_CS); const float cq0=cl[q0]; int lo_=0,hi_=4*qb;
    while(lo_<hi_){ const int mid_=(lo_+hi_)>>1; if(cl[64*mid_+63]-cq0>=dthr)lo_=mid_+1; else hi_=mid_; }
    j0=__builtin_amdgcn_readfirstlane(lo_)&~1; }
  const bf16*Kh=K+(rowbase+(long)j0*KVBLK)*DM,*Vh=V+(rowbase+(long)j0*KVBLK)*DM;
  const bf16*ksrc=Kh+(long)lane*DM+wid*8;
  const bf16*vsrc=Vh+(long)(16*(wid&3)+(lane>>2))*DM+(wid>>2)*32+(lane&3)*8;
  const int NT=(q0+QB)/KVBLK-j0;
  const lds_f32*cl3=(const lds_f32*)(shm3+LDS_CS)+64*j0;
  DMA_K(0,0);DMA_V(0,0);DMA_K(1,SLOTB);
  bf16x8 qr[4];
  #pragma unroll
  for(int d0=0;d0<4;++d0)qr[d0]=*reinterpret_cast<const bf16x8*>(&Qw[(long)r32*DM+d0*16+hi*8]);
  float base=0.f,l_reg=0.f;f32x16 o[2];o[0]=f32x16{};o[1]=f32x16{};
  #define CINIT(C0,C1,t) do{ const lds_f32*cp_=cl3+64*(t)+4*hi; \
    _Pragma("unroll") for(int g_=0;g_<4;++g_){ const f32x4 a_=*(const lds_f32x4*)(cp_+8*g_), b_=*(const lds_f32x4*)(cp_+32+8*g_); \
      C0[4*g_]=base-a_[0];C0[4*g_+1]=base-a_[1];C0[4*g_+2]=base-a_[2];C0[4*g_+3]=base-a_[3]; \
      C1[4*g_]=base-b_[0];C1[4*g_+1]=base-b_[1];C1[4*g_+2]=base-b_[2];C1[4*g_+3]=base-b_[3]; } }while(0)
  const int qrel=wid*QBLK+r32;
  #define CMASK(P0,P1,t) do{int jb_=(t)-(NT-4); if(jb_>=0)cmask(P0,P1,jb_,qrel,hi);}while(0)
  bool resc=false;
  #define START(P0,P1) do{ const float rm=rowmax(P0,P1); resc=false; \
    { const float dl=rm; base=fsub_s(base,dl); \
      _Pragma("unroll") for(int r=0;r<16;++r){P0[r]=fsub_s(P0[r],dl);P1[r]=fsub_s(P1[r],dl);} } \
    _Pragma("unroll") for(int r=0;r<16;++r)P0[r]=__builtin_amdgcn_exp2f(P0[r]); }while(0)
  #define RESC() do{ if(resc){ asm volatile("s_waitcnt lgkmcnt(0)":::"memory"); \
      _Pragma("unroll") for(int d_=0;d_<2;++d_) _Pragma("unroll") for(int r=0;r<16;++r)o[d_][r]*=wsf[crow(r,hi)]; } }while(0)
  f32x16 pA0,pA1,pB0,pB1;
  int sl_prev=0,sl_cur=0,sl_next=SLOTB;
  #define ROT() do{sl_prev=sl_cur;sl_cur=sl_next;sl_next=(sl_next==(NSLOT-1)*SLOTB)?0:sl_next+SLOTB;}while(0)
  DMA_K(2,2*SLOTB);
  WAIT_BAR(3);
  base=cl3[q0-64*j0+wid*QBLK+r32];
  CINIT(pA0,pA1,0); qkt(pA0,pA1,Kbase,qr,r32,hi);asm volatile("s_nop 15\n\ts_nop 7":"+v"(pA0),"+v"(pA1));CMASK(pA0,pA1,0);
  START(pA0,pA1);
  _Pragma("unroll") for(int r=0;r<16;++r)pA1[r]=__builtin_amdgcn_exp2f(pA1[r]);
  WAIT_BAR(0);
  DMA_K(3,0);DMA_V(1,SLOTB);
  ROT();
  kload8(kf,kp0+sl_cur);
  WAIT_BAR(2);
  s16x4 vlo[8],vhi[8]; u32x4 pw0,pw1,pw2,pw3;
  #define PKW(P,B) cvtpk_s(P[B],P[B+1])
  #define PAF(k) __builtin_bit_cast(bf16x8,pw##k)
  #define VFR(i) (bf16x8){vlo[i][0],vlo[i][1],vlo[i][2],vlo[i][3],vhi[i][0],vhi[i][1],vhi[i][2],vhi[i][3]}
  #define PIN(x) asm volatile("":"+v"(x))
  #define MX3(a,b,c) __builtin_fmaxf(__builtin_fmaxf((a),(b)),(c))
  #define GAPA(MF,A0,A1,A2,A3,W0,W1,PW) do{ MF; sacc+=A0; sacc+=A1; sacc+=A2; sacc+=A3; PIN(sacc); W0; W1; PIN(PW); SBAR(); }while(0)
  #define EX(v) __builtin_amdgcn_exp2f(v)
  #define GAPB(MF,X,B) do{ MF; X[B]=EX(X[B]); X[B+1]=EX(X[B+1]); X[B+2]=EX(X[B+2]); X[B+3]=EX(X[B+3]); PIN(X); SBAR(); }while(0)
  #define VRD(i) do{ vlo[i]=vtr(vp_+(((i)>>2)*4096+((i)&3)*1024)); vhi[i]=vtr(vp_+(((i)>>2)*4096+((i)&3)*1024+512)); }while(0)
  #define KRD(G,j) do{ if(G){ kload2(kf,kp0+sl_next,j); SBAR(); } }while(0)
  #define STEP(C0,C1,P0,P1,t,GK,GV,GL) do{ SBAR(); CINIT(C0,C1,t); SBAR(); \
    const lds_cptr vp_=vp0+sl_prev; \
    VRD(0); SBAR(); float sacc=(P0[0]+P0[1]); \
    GAPA(C0=__builtin_amdgcn_mfma_f32_32x32x16_bf16(kf[0],qr[0],C0,0,0,0), P0[2],P0[3],P0[4],P0[5],     pw0[0]=PKW(P0,0), pw0[1]=PKW(P0,2), pw0); \
    VRD(4); SBAR(); GAPA(C1=__builtin_amdgcn_mfma_f32_32x32x16_bf16(kf[1],qr[0],C1,0,0,0), P0[6],P0[7],P0[8],P0[9],     pw0[2]=PKW(P0,4), pw0[3]=PKW(P0,6), pw0); \
    VRD(1); SBAR(); GAPA(C0=__builtin_amdgcn_mfma_f32_32x32x16_bf16(kf[2],qr[1],C0,0,0,0),   P0[10],P0[11],P0[12],P0[13], pw1[0]=PKW(P0,8), pw1[1]=PKW(P0,10), pw1); \
    VRD(5); SBAR(); GAPA(C1=__builtin_amdgcn_mfma_f32_32x32x16_bf16(kf[3],qr[1],C1,0,0,0),   P0[14],P0[15],P1[0],P1[1],   pw1[2]=PKW(P0,12),pw1[3]=PKW(P0,14), pw1); \
    VRD(2); SBAR(); GAPA(C0=__builtin_amdgcn_mfma_f32_32x32x16_bf16(kf[4],qr[2],C0,0,0,0),   P1[2],P1[3],P1[4],P1[5],     pw2[0]=PKW(P1,0), pw2[1]=PKW(P1,2), pw2); \
    VRD(6); SBAR(); GAPA(C1=__builtin_amdgcn_mfma_f32_32x32x16_bf16(kf[5],qr[2],C1,0,0,0),   P1[6],P1[7],P1[8],P1[9],     pw2[2]=PKW(P1,4), pw2[3]=PKW(P1,6), pw2); \
    VRD(3); SBAR(); GAPA(C0=__builtin_amdgcn_mfma_f32_32x32x16_bf16(kf[6],qr[3],C0,0,0,0),   P1[10],P1[11],P1[12],P1[13], pw3[0]=PKW(P1,8), pw3[1]=PKW(P1,10), pw3); \
    VRD(7); SBAR(); GAPA(C1=__builtin_amdgcn_mfma_f32_32x32x16_bf16(kf[7],qr[3],C1,0,0,0),   P1[14],P1[15],0.f,0.f,       pw3[2]=PKW(P1,12),pw3[3]=PKW(P1,14), pw3); \
    l_reg+=sacc; \
    if(GK){DMA_K((t)+3,sl_cur);} if(GV){DMA_V((t)+1,sl_next);} \
    CMASK(C0,C1,t); \
    { float a=MX3(C0[0],C0[1],C1[0]),b=MX3(C0[2],C0[3],C1[1]); a=MX3(a,C1[2],C1[3]); \
      _Pragma("unroll") for(int r=4;r<16;r+=4){a=MX3(a,C0[r],C0[r+1]);b=MX3(b,C0[r+2],C0[r+3]);a=MX3(a,C1[r],C1[r+1]);b=MX3(b,C1[r+2],C1[r+3]);} \
      float rm=__builtin_fmaxf(a,b); { auto rr=__builtin_amdgcn_permlane32_swap(__float_as_uint(rm),__float_as_uint(rm),false,false); rm=__builtin_fmaxf(__uint_as_float(rr[0]),__uint_as_float(rr[1])); } \
      resc=false; \
      if(__builtin_expect(__any(rm>(float)THRL),0)){ const float dl=__builtin_fmaxf(rm,0.f); base-=dl; \
        _Pragma("unroll") for(int r=0;r<16;++r){C0[r]-=dl;C1[r]-=dl;} \
        const float f=__builtin_amdgcn_exp2f(-dl); l_reg*=f; if(hi==0)wsf[r32]=f; resc=true; } } \
    SBAR(); \
    GAPB(o[0]=__builtin_amdgcn_mfma_f32_32x32x16_bf16(PAF(0),VFR(0),o[0],0,0,0), C0,0); \
    GAPB(o[1]=__builtin_amdgcn_mfma_f32_32x32x16_bf16(PAF(0),VFR(4),o[1],0,0,0), C0,4); \
    KRD(GL,0); GAPB(o[0]=__builtin_amdgcn_mfma_f32_32x32x16_bf16(PAF(1),VFR(1),o[0],0,0,0), C0,8); \
    KRD(GL,1); GAPB(o[1]=__builtin_amdgcn_mfma_f32_32x32x16_bf16(PAF(1),VFR(5),o[1],0,0,0), C0,12); \
    KRD(GL,2); GAPB(o[0]=__builtin_amdgcn_mfma_f32_32x32x16_bf16(PAF(2),VFR(2),o[0],0,0,0), C1,0); \
    KRD(GL,3); GAPB(o[1]=__builtin_amdgcn_mfma_f32_32x32x16_bf16(PAF(2),VFR(6),o[1],0,0,0), C1,4); \
    GAPB(o[0]=__builtin_amdgcn_mfma_f32_32x32x16_bf16(PAF(3),VFR(3),o[0],0,0,0), C1,8); \
    GAPB(o[1]=__builtin_amdgcn_mfma_f32_32x32x16_bf16(PAF(3),VFR(7),o[1],0,0,0), C1,12); \
    }while(0)
  int t=1;
  #undef CMASK
  #define CMASK(P0,P1,t) do{}while(0)
  for(;t+5<NT;t+=2){
    STEP(pB0,pB1,pA0,pA1,t,true,true,true);     WAIT_BAR(2); RESC(); ROT();
    STEP(pA0,pA1,pB0,pB1,t+1,true,true,true);   WAIT_BAR(2); RESC(); ROT();
  }
  #undef CMASK
  #define CMASK(P0,P1,t) do{int jb_=(t)-(NT-4); if(jb_>=0)cmask(P0,P1,jb_,qrel,hi);}while(0)
  #define ENDW(tt) do{ if((tt)+3<NT){WAIT_BAR(2);} else if((tt)+2<NT){WAIT_BAR(1);} else {WAIT_BAR(0);} }while(0)
  for(;t+1<NT;t+=2){
    STEP(pB0,pB1,pA0,pA1,t,(t+3<NT),(t+1<NT),(t+1<NT));       ENDW(t);   RESC(); ROT();
    STEP(pA0,pA1,pB0,pB1,t+1,(t+4<NT),(t+2<NT),(t+2<NT));     ENDW(t+1); RESC(); ROT();
  }
  STEP(pB0,pB1,pA0,pA1,NT-1,false,false,false); RESC();
  { float sacc=pB0[0]+pB0[1]; _Pragma("unroll") for(int r=2;r<16;++r)sacc+=pB0[r]; _Pragma("unroll") for(int r=0;r<16;++r)sacc+=pB1[r]; l_reg+=sacc;
    pw0=(u32x4){PKW(pB0,0),PKW(pB0,2),PKW(pB0,4),PKW(pB0,6)};pw1=(u32x4){PKW(pB0,8),PKW(pB0,10),PKW(pB0,12),PKW(pB0,14)};pw2=(u32x4){PKW(pB1,0),PKW(pB1,2),PKW(pB1,4),PKW(pB1,6)};pw3=(u32x4){PKW(pB1,8),PKW(pB1,10),PKW(pB1,12),PKW(pB1,14)};
    SBAR(); pv(o,vb0+sl_cur,PAF(0),PAF(1),PAF(2),PAF(3)); }
  #undef PKW
  #undef PAF
  #undef VFR
  #undef PIN
  #undef MX3
  #undef GAPA
  #undef GAPB
  #undef EX
  #undef VRD
  #undef KRD
  #undef STEP
  #undef ENDW
  {auto rr=__builtin_amdgcn_permlane32_swap(__float_as_uint(l_reg),__float_as_uint(l_reg),false,false);l_reg=__uint_as_float(rr[0])+__uint_as_float(rr[1]);}
  if(hi==0)wsf[32+r32]=l_reg;asm volatile("s_waitcnt lgkmcnt(0)":::"memory");
  float rli[16];
  #pragma unroll
  for(int r=0;r<16;++r)rli[r]=__builtin_amdgcn_rcpf(wsf[32+crow(r,hi)]);
  bf16*Ow=O+(rowbase+q0+wid*QBLK)*DMO;
  { bf16*stg=(bf16*)(shm+LDS_OST)+wid*2048;
    #pragma unroll
    for(int r=0;r<16;++r){const int orow=crow(r,hi);
      #pragma unroll
      for(int d0=0;d0<2;++d0)stg[orow*64+d0*32+r32]=__float2bfloat16(o[d0][r]*rli[r]);}
    asm volatile("s_waitcnt lgkmcnt(0)":::"memory");
    #pragma unroll
    for(int i=0;i<4;++i){const int row=i*8+(lane>>3),ch=lane&7; const u32x4 v=*(const u32x4*)(stg+row*64+ch*8); ATTN_STORE16(Ow+(long)row*DMO+ch*8,head_rms(v));} }
  asm volatile("s_waitcnt lgkmcnt(0)\n\ts_barrier":::"memory");
  #undef DMA_K
  #undef DMA_V
  #undef CMASK
  #undef CINIT
  #undef START
  #undef RESC
  #undef ROT
}
__device__ __forceinline__ float sp2f(float z){ const float e=__builtin_amdgcn_exp2f(-__builtin_fabsf(z)); return __builtin_fmaxf(z,0.f)+__builtin_amdgcn_logf(1.f+e); }
__device__ __forceinline__ void sb_unit(int b,int qb,const bf16*Q,const bf16*__restrict__ K,const bf16*__restrict__ V,bf16*O,char*shm){
  int tid_=threadIdx.x; asm volatile("":"+v"(tid_)); const int tid=tid_,lane=tid&63,r32=lane&31,hi=lane>>5; const int wid=__builtin_amdgcn_readfirstlane(tid>>6);
  const long rowbase=(long)b*SEQ; const int q0=qb*QB;
  const bf16*Qw=Q+(rowbase+q0+wid*QBLK)*DM;
  const bf16*Kh=K+rowbase*DM,*Vh=V+rowbase*DM;
  const unsigned lds0=(unsigned)(uintptr_t)shm; const lds_cptr shm3=(lds_cptr)shm;
  const bf16*ksrc=Kh+(long)lane*DM+wid*8;
  const bf16*vsrc=Vh+(long)(16*(wid&3)+(lane>>2))*DM+(wid>>2)*32+(lane&3)*8;
  const unsigned kdst=lds0+LDS_K+wid*1024, vdst=lds0+LDS_V+wid*1024;
  #define DMA_K(t,slot) glds16(ksrc+(long)(t)*KVBLK*DM,(unsigned)__builtin_amdgcn_readfirstlane(kdst+(slot)))
  #define DMA_V(t,slot) glds16(vsrc+(long)(t)*KVBLK*DM,(unsigned)__builtin_amdgcn_readfirstlane(vdst+(slot)))
  const int vb0=(int)(lds0+LDS_V)+((lane>>4)&1)*32+(lane&3)*8+(4*hi+((lane&15)>>2))*64;
  typedef __attribute__((address_space(3))) unsigned lds_u32;
  volatile lds_u32*flags=(volatile lds_u32*)(shm3+LDS_FLAGS);
  bf16x8 qr[4];
  #pragma unroll
  for(int d0=0;d0<4;++d0)qr[d0]=*reinterpret_cast<const bf16x8*>(&Qw[(long)r32*DM+d0*16+hi*8]);
  asm volatile("":::"memory");
  f32x16 o[2];o[0]=f32x16{};o[1]=f32x16{};
  float R=1.f; const int qabs=q0+wid*QBLK+r32; bool done=false;
  const int jtop=4*qb+3;
  DMA_K(jtop,0);DMA_V(jtop,0);
  int slot=0;
  for(int j=jtop;j>=0;--j){
    if(j>0){ DMA_K(j-1,slot^SLOTB);DMA_V(j-1,slot^SLOTB); WAIT_BAR(2); } else { WAIT_BAR(0); }
    const bool active=(!done)&&(64*j<q0+wid*QBLK+31);
    if(active){
      f32x16 p0=f32x16{},p1=f32x16{};
      qkt(p0,p1,shm+LDS_K+slot,qr,r32,hi);
      const int kvb=64*j+4*hi; f32x16 s0,s1;
      #pragma unroll
      for(int r=0;r<16;++r){ const int kv=kvb+(r&3)+8*(r>>2);
        const float e0=__builtin_amdgcn_exp2f(__builtin_fminf(p0[r],80.f)), e1=__builtin_amdgcn_exp2f(__builtin_fminf(p1[r],80.f));
        const float r0=__builtin_amdgcn_rcpf(1.f+e0), r1=__builtin_amdgcn_rcpf(1.f+e1);
        const bool v0=kv<qabs, v1=kv+32<qabs;
        p0[r]=v0?e0*r0:0.f; p1[r]=v1?e1*r1:0.f; s0[r]=v0?r0:1.f; s1[r]=v1?r1:1.f; }
      float g0[4],g1[4],og0[4],og1[4],T0[4],T1[4];
      #pragma unroll
      for(int g=0;g<4;++g){ g0[g]=(s0[4*g]*s0[4*g+1])*(s0[4*g+2]*s0[4*g+3]); g1[g]=(s1[4*g]*s1[4*g+1])*(s1[4*g+2]*s1[4*g+3]); }
      #pragma unroll
      for(int g=0;g<4;++g){ og0[g]=__shfl_xor(g0[g],32); og1[g]=__shfl_xor(g1[g],32); }
      float run=R;
      #pragma unroll
      for(int g=3;g>=0;--g){ const float ah1=hi?g1[g]:og1[g], ah0=hi?og1[g]:g1[g]; const float t1=run; run*=ah1; const float t0=run; run*=ah0; T1[g]=hi?t1:t0; }
      #pragma unroll
      for(int g=3;g>=0;--g){ const float ah1=hi?g0[g]:og0[g], ah0=hi?og0[g]:g0[g]; const float t1=run; run*=ah1; const float t0=run; run*=ah0; T0[g]=hi?t1:t0; }
      R=run;
      #pragma unroll
      for(int g=0;g<4;++g){ float a0=T0[g],a1=T1[g];
        #pragma unroll
        for(int i=3;i>=0;--i){ const int r=4*g+i; p0[r]*=a0; p1[r]*=a1; a0*=s0[r]; a1*=s1[r]; } }
      u32x4 pw0,pw1,pw2,pw3;
      pw0=(u32x4){cvtpk_s(p0[0],p0[1]),cvtpk_s(p0[2],p0[3]),cvtpk_s(p0[4],p0[5]),cvtpk_s(p0[6],p0[7])};
      pw1=(u32x4){cvtpk_s(p0[8],p0[9]),cvtpk_s(p0[10],p0[11]),cvtpk_s(p0[12],p0[13]),cvtpk_s(p0[14],p0[15])};
      pw2=(u32x4){cvtpk_s(p1[0],p1[1]),cvtpk_s(p1[2],p1[3]),cvtpk_s(p1[4],p1[5]),cvtpk_s(p1[6],p1[7])};
      pw3=(u32x4){cvtpk_s(p1[8],p1[9]),cvtpk_s(p1[10],p1[11]),cvtpk_s(p1[12],p1[13]),cvtpk_s(p1[14],p1[15])};
      pv(o,vb0+slot,__builtin_bit_cast(bf16x8,pw0),__builtin_bit_cast(bf16x8,pw1),__builtin_bit_cast(bf16x8,pw2),__builtin_bit_cast(bf16x8,pw3));
      done=__all(R<1.0e-37f)!=0;
    }
    if(lane==0)flags[wid]=done?1u:0u;
    asm volatile("s_waitcnt lgkmcnt(0)\n\ts_barrier":::"memory");
    unsigned alld=1u;
    #pragma unroll
    for(int w=0;w<NW;++w)alld&=flags[w];
    slot^=SLOTB;
    if(alld)break;
  }
  asm volatile("s_waitcnt vmcnt(0)":::"memory");
  bf16*Ow=O+(rowbase+q0+wid*QBLK)*DMO;
  { bf16*stg=(bf16*)(shm+LDS_OST)+wid*2048;
    #pragma unroll
    for(int r=0;r<16;++r){const int orow=crow(r,hi);
      #pragma unroll
      for(int d0=0;d0<2;++d0)stg[orow*64+d0*32+r32]=__float2bfloat16(o[d0][r]);}
    asm volatile("s_waitcnt lgkmcnt(0)":::"memory");
    #pragma unroll
    for(int i=0;i<4;++i){const int row=i*8+(lane>>3),ch=lane&7; const u32x4 v=*(const u32x4*)(stg+row*64+ch*8); ATTN_STORE16(Ow+(long)row*DMO+ch*8,head_rms(v));} }
  asm volatile("s_waitcnt vmcnt(0) lgkmcnt(0)\n\ts_barrier":::"memory");
  #undef DMA_K
  #undef DMA_V
}
#undef SBAR
#undef WAIT_BAR
}
namespace cg = cooperative_groups;
constexpr int NWAVES = 8;
constexpr int DMODEL = 1024, NBATCH = 4, SEQ_IN = 8192, NMETA = 16, LREAL = NMETA + SEQ_IN, LP = 8448  ;
constexpr int MROWS = NBATCH * LP;
constexpr int MREAL = NBATCH * SEQ_IN;
constexpr int INW = 2566, NINP = 2560, NIN = 2816, DFF = 2816, NGU = 2 * DFF, DEPTH = 2, NFH = 6;
constexpr float C2F = 0.125f * 1.4426950408889634f;
constexpr int PC_U = 0, PC_FQ = 256, PC_FK = 640, PC_FV = 1024, PC_SQ = 1408, PC_SK = 1792, PC_SV = 2176;
constexpr size_t MiB = 1u << 20;
constexpr size_t WS_CTL = 0, CTL_ZERO_BYTES = 1 * MiB;
constexpr size_t WS_SS = 64 * 1024;
constexpr size_t WS_W = 1 * MiB, W_LAYER = 24 * MiB, W_IN = 0, W_OUT = (size_t)NIN * 1024 * 2, W_GU = W_OUT + 2 * MiB, W_D = W_GU + (size_t)NGU * 1024 * 2;
constexpr size_t WS_LF = 49 * MiB, WS_CS = 51 * MiB, WS_H = 52 * MiB, WS_HB = 184 * MiB, WS_Y = 250 * MiB, WS_P = 316 * MiB, WS_END = WS_P + (size_t)MROWS * DFF * 2;
static_assert(W_D + (size_t)1024 * DFF * 2 <= W_LAYER && WS_W + 2 * W_LAYER <= WS_LF && WS_SS + 5 * (size_t)MROWS * 4 <= CTL_ZERO_BYTES, "ws map");
static_assert(WS_H + (size_t)MROWS * 1024 * 4 <= WS_HB && WS_HB + (size_t)MROWS * 1024 * 2 <= WS_Y && WS_Y + (size_t)MROWS * 1024 * 2 <= WS_P && WS_END <= 512 * MiB, "ws map");
constexpr int LDS_BYTES = 147456;
constexpr int LDS_MISC = 131072;

#define LAS __attribute__((address_space(3)))
typedef unsigned short bf16u;
typedef unsigned v4u __attribute__((ext_vector_type(4)));
typedef float f32x4 __attribute__((ext_vector_type(4)));
#define LDS_WAIT() asm volatile("s_waitcnt lgkmcnt(0)" ::: "memory")
__device__ __forceinline__ unsigned f2bf(float f) { unsigned u = __builtin_bit_cast(unsigned, f); return (u + 0x7fffu + ((u >> 16) & 1u)) >> 16; }
__device__ __forceinline__ unsigned pk2(float lo, float hi) { return f2bf(lo) | (f2bf(hi) << 16); }
__device__ __forceinline__ float wave_sum(float v) {
#pragma unroll
    for (int o = 1; o < 64; o <<= 1) v += __shfl_xor(v, o);
    return v;
}

struct Args { const float* in[15]; float* out; unsigned char* ws; };

struct WinSrc { const float* w; const float* g;
    __device__ __forceinline__ float operator()(int k, int n) const { if (n >= INW) return 0.f; const int col = n < 1408 ? n : (n < 2560 ? n + 6 : n - 2560 + 1408);
        const float sc = ((n >= PC_FQ && n < PC_FK) || (n >= PC_SQ && n < PC_SK)) ? C2F : 1.0f; return w[(size_t)k * INW + col] * g[k] * sc; } };
struct WoutSrc { const float* w; const float* fg; const float* sg;
    __device__ __forceinline__ float operator()(int k, int n) const { const float gn = k < 640 ? fg[k - 256] : sg[k - 640]; return w[(size_t)k * 1024 + n] * gn; } };
struct WguSrc { const float* wg; const float* wu; const float* g;
    __device__ __forceinline__ float operator()(int k, int c) const { const int pn = c >> 8, w = c & 255, j = pn * 128 + (w & 127); const long dlt = (w >> 7) ? (long)(wu - wg) : 0L; return wg[(long)k * DFF + j + dlt] * g[k]; } };
struct WdSrc { const float* w;
    __device__ __forceinline__ float operator()(int k, int n) const { return w[(size_t)k * 1024 + n]; } };
template <class F> __device__ __forceinline__ void conv_item(const F src, bf16u* WT, int K, int k0, int n0, LAS float* scr, int lane) {
    float tv[32];
#pragma unroll
    for (int i = 0; i < 32; ++i) tv[i] = src(k0 + 2 * i + (lane >> 5), n0 + (lane & 31));
#pragma unroll
    for (int i = 0; i < 32; ++i) scr[(2 * i + (lane >> 5)) * 33 + (lane & 31)] = tv[i];
    LDS_WAIT(); asm volatile("" ::: "memory");
    const int c = lane & 7;
#pragma unroll
    for (int j = 0; j < 4; ++j) { const int n = (lane >> 3) + 8 * j; const LAS float* s = scr + (8 * c) * 33 + n;
        v4u o; o.x = pk2(s[0 * 33], s[1 * 33]); o.y = pk2(s[2 * 33], s[3 * 33]); o.z = pk2(s[4 * 33], s[5 * 33]); o.w = pk2(s[6 * 33], s[7 * 33]);
        *(v4u*)(WT + (size_t)(n0 + n) * K + k0 + 8 * c) = o; }
    LDS_WAIT(); asm volatile("" ::: "memory");
}
__device__ __forceinline__ void fold_item(const float* wout, const float* pw, const float* ps, bf16u* WT, int item, int lane) {
    const int g = item >> 4, n = (item & 15) * 64 + lane;
    float acc[64];
#pragma unroll
    for (int c = 0; c < 64; ++c) acc[c] = 0.f;
    for (int d = 0; d < 64; ++d) { const float wv = wout[(size_t)(g * 64 + d) * 1024 + n] * ps[g * 64 + d];
#pragma unroll
        for (int c = 0; c < 64; ++c) acc[c] += pw[(g * 64 + c) * 64 + d] * wv; }
    bf16u* o = WT + (size_t)n * 1024 + g * 64;
#pragma unroll
    for (int c = 0; c < 64; c += 8) { v4u w; w.x = pk2(acc[c], acc[c + 1]); w.y = pk2(acc[c + 2], acc[c + 3]); w.z = pk2(acc[c + 4], acc[c + 5]); w.w = pk2(acc[c + 6], acc[c + 7]); *(v4u*)(o + c) = w; }
}
__device__ __forceinline__ void p0_prologue(const Args& A, unsigned char* ws, LAS unsigned char* lds, int wave, int lane) {
    LAS float* scr = (LAS float*)(lds + wave * 16384);
    const int gw = blockIdx.x * NWAVES + wave, NGW = gridDim.x * NWAVES;
    constexpr int I_IN = 16 * (NIN / 32), I_OUT = 12 * 32, I_GU = 16 * (NGU / 32), I_D = (DFF / 64) * 32, I_F = 64, I_L = I_IN + I_OUT + I_GU + I_D + I_F;
    for (int it = gw; it < DEPTH * I_L; it += NGW) {
        const int L = it / I_L; int r = it % I_L;
        bf16u* wb = (bf16u*)(ws + WS_W + (size_t)L * W_LAYER);
        if (r < I_IN) { WinSrc s{A.in[3] + (size_t)L * 1024 * INW, A.in[2] + L * 1024}; conv_item(s, (bf16u*)((unsigned char*)wb + W_IN), 1024, (r / (NIN / 32)) * 64, (r % (NIN / 32)) * 32, scr, lane); continue; } r -= I_IN;
        if (r < I_OUT) { WoutSrc s{A.in[9] + (size_t)L * 1024 * 1024, A.in[7] + L * 384, A.in[8] + L * 384}; conv_item(s, (bf16u*)((unsigned char*)wb + W_OUT), 1024, 256 + (r / 32) * 64, (r % 32) * 32, scr, lane); continue; } r -= I_OUT;
        if (r < I_GU) { WguSrc s{A.in[11] + (size_t)L * 1024 * DFF, A.in[12] + (size_t)L * 1024 * DFF, A.in[10] + L * 1024}; conv_item(s, (bf16u*)((unsigned char*)wb + W_GU), 1024, (r / (NGU / 32)) * 64, (r % (NGU / 32)) * 32, scr, lane); continue; } r -= I_GU;
        if (r < I_D) { WdSrc s{A.in[13] + (size_t)L * DFF * 1024}; conv_item(s, (bf16u*)((unsigned char*)wb + W_D), DFF, (r / 32) * 64, (r % 32) * 32, scr, lane); continue; } r -= I_D;
        fold_item(A.in[9] + (size_t)L * 1024 * 1024, A.in[5] + (size_t)L * 4 * 64 * 64, A.in[6] + L * 256, (bf16u*)((unsigned char*)wb + W_OUT), r, lane);
    }
    float* h = (float*)(ws + WS_H); bf16u* hb = (bf16u*)(ws + WS_HB); float* ss0 = (float*)(ws + WS_SS);
    for (int m = gw; m < MROWS; m += NGW) {
        const int b = m / LP, t = m % LP;
        f32x4 v[4]; float s = 0.f;
        if (t < LREAL) { const f32x4* src = (const f32x4*)(t < NMETA ? A.in[1] + (size_t)t * 1024 : A.in[0] + ((size_t)b * SEQ_IN + (t - NMETA)) * 1024) + lane;
#pragma unroll
            for (int j = 0; j < 4; ++j) { v[j] = src[64 * j]; s += (v[j].x * v[j].x + v[j].y * v[j].y) + (v[j].z * v[j].z + v[j].w * v[j].w); } }
        else {
#pragma unroll
            for (int j = 0; j < 4; ++j) v[j] = (f32x4){0.f, 0.f, 0.f, 0.f}; }
        s = wave_sum(s);
        f32x4* ho = (f32x4*)(h + (size_t)m * 1024) + lane; unsigned long long* bo = (unsigned long long*)(hb + (size_t)m * 1024) + lane;
#pragma unroll
        for (int j = 0; j < 4; ++j) { ho[64 * j] = v[j]; bo[64 * j] = (unsigned long long)pk2(v[j].x, v[j].y) | ((unsigned long long)pk2(v[j].z, v[j].w) << 32); }
        if (lane == 0) ss0[m] = s;
    }
}
typedef short bf16x8m __attribute__((ext_vector_type(8)));
template <int NBK> __device__ __forceinline__ void mini_item(f32x4 (&acc)[NBK], const bf16u* A16, const bf16u* Bt0, const bf16u* Bt1, int K, LAS unsigned char* lds, int wave, int lane) {
    const int fr = lane & 15, fq = lane >> 4, kw = K >> 3; const size_t o = (size_t)fr * K + wave * kw + 8 * fq;
#pragma unroll
    for (int nb = 0; nb < NBK; ++nb) acc[nb] = (f32x4){0.f, 0.f, 0.f, 0.f};
    for (int k = 0; k < kw; k += 32) { const bf16x8m a = *(const bf16x8m*)(A16 + o + k); const bf16x8m b0 = *(const bf16x8m*)(Bt0 + o + k);
        acc[0] = __builtin_amdgcn_mfma_f32_16x16x32_bf16(b0, a, acc[0], 0, 0, 0);
        if (NBK == 2) { const bf16x8m b1 = *(const bf16x8m*)(Bt1 + o + k); acc[NBK - 1] = __builtin_amdgcn_mfma_f32_16x16x32_bf16(b1, a, acc[NBK - 1], 0, 0, 0); } }
    LAS f32x4* red = (LAS f32x4*)lds;
#pragma unroll
    for (int nb = 0; nb < NBK; ++nb) red[(nb * 8 + wave) * 64 + lane] = acc[nb];
    __syncthreads();
    if (wave == 0) {
#pragma unroll
        for (int nb = 0; nb < NBK; ++nb) { f32x4 s = red[(nb * 8) * 64 + lane];
#pragma unroll
            for (int w = 1; w < 8; ++w) s += red[(nb * 8 + w) * 64 + lane];
            acc[nb] = s; } }
    __syncthreads();
}
__device__ __forceinline__ void mini_in(unsigned char* ws, const bf16u* wt, const float* ss, const float* fb, LAS unsigned char* lds, int wave, int lane) {
    const bf16u* A16 = (const bf16u*)(ws + WS_HB); bf16u* P = (bf16u*)(ws + WS_P); float* LF = (float*)(ws + WS_LF);
    const int half = gridDim.x / 2; if ((int)blockIdx.x < half) return;
    for (int it = blockIdx.x - half; it < 161; it += gridDim.x - half) { const int n0 = it * 16; f32x4 acc[1];
        mini_item<1>(acc, A16, wt + (size_t)n0 * 1024, nullptr, 1024, lds, wave, lane);
        if (wave == 0) { const int fr = lane & 15, fq = lane >> 4; const float rs = __builtin_amdgcn_rsqf(ss[fr] * (1.0f / 1024.0f) + 1e-6f); const f32x4 v = acc[0] * rs;
            if (n0 < NINP) { const unsigned long long w = (unsigned long long)pk2(v[0], v[1]) | ((unsigned long long)pk2(v[2], v[3]) << 32);
#pragma unroll
                for (int b = 0; b < NBATCH; ++b) *(unsigned long long*)(P + ((size_t)b * LP + fr) * NINP + n0 + 4 * fq) = w; }
            else if (fq < 2) { f32x4 l;
#pragma unroll
                for (int i = 0; i < 4; ++i) { const int c = 4 * fq + i; const float x = v[i] + fb[c < NFH ? c : 0]; l[i] = c < NFH ? -(fmaxf(-x, 0.f) + log1pf(expf(-fabsf(x)))) * 1.4426950408889634f : 0.f; }
#pragma unroll
                for (int b = 0; b < NBATCH; ++b) *(f32x4*)(LF + ((size_t)b * LP + fr) * 8 + 4 * fq) = l; } }
    }
}
__device__ __forceinline__ void mini_res(unsigned char* ws, const bf16u* A16, const bf16u* wt, int K, float* ssn, LAS unsigned char* lds, int wave, int lane) {
    float* h = (float*)(ws + WS_H); bf16u* hb = (bf16u*)(ws + WS_HB);
    for (int it = blockIdx.x; it < 64; it += gridDim.x) { const int n0 = it * 16; f32x4 acc[1];
        mini_item<1>(acc, A16, wt + (size_t)n0 * K, nullptr, K, lds, wave, lane);
        if (wave == 0) { const int fr = lane & 15, fq = lane >> 4; float* hp = h + (size_t)fr * 1024 + n0 + 4 * fq; const f32x4 a = *(const f32x4*)hp + acc[0]; *(f32x4*)hp = a;
            *(unsigned long long*)(hb + (size_t)fr * 1024 + n0 + 4 * fq) = (unsigned long long)pk2(a[0], a[1]) | ((unsigned long long)pk2(a[2], a[3]) << 32);
            float s = (a[0] * a[0] + a[1] * a[1]) + (a[2] * a[2] + a[3] * a[3]); s += __shfl_xor(s, 16); s += __shfl_xor(s, 32);
            if (fq == 0) atomicAdd(ssn + fr, s); }
    }
}
__device__ __forceinline__ void mini_gu(unsigned char* ws, const bf16u* wt, const float* ss, LAS unsigned char* lds, int wave, int lane) {
    const bf16u* A16 = (const bf16u*)(ws + WS_HB); bf16u* H = (bf16u*)(ws + WS_P);
    for (int it = blockIdx.x; it < DFF / 16; it += gridDim.x) { const int j0 = it * 16, cg = (j0 >> 7) * 256 + (j0 & 127); f32x4 acc[2];
        mini_item<2>(acc, A16, wt + (size_t)cg * 1024, wt + (size_t)(cg + 128) * 1024, 1024, lds, wave, lane);
        if (wave == 0) { const int fr = lane & 15, fq = lane >> 4; const float rs = __builtin_amdgcn_rsqf(ss[fr] * (1.0f / 1024.0f) + 1e-6f); float o[4];
#pragma unroll
            for (int i = 0; i < 4; ++i) { const float g = acc[0][i] * rs, up = acc[1][i] * rs; o[i] = g * __builtin_amdgcn_rcpf(1.0f + __builtin_amdgcn_exp2f(-1.4426950408889634f * g)) * up; }
            *(unsigned long long*)(H + (size_t)fr * DFF + j0 + 4 * fq) = (unsigned long long)pk2(o[0], o[1]) | ((unsigned long long)pk2(o[2], o[3]) << 32); }
    }
}
__device__ __forceinline__ void pool_scan_phase(unsigned char* ws, LAS unsigned char* lds, unsigned* nrm, int tid, int wave, int lane) {
    const float* LF = (const float*)(ws + WS_LF); float* CS = (float*)(ws + WS_CS);
    if (blockIdx.x < NBATCH * NFH) {
        const int b = blockIdx.x / NFH, hf = blockIdx.x % NFH; constexpr int PER = 17;
        const float* lf = LF + (size_t)b * LP * 8 + hf; float* cs = CS + (size_t)(b * NFH + hf) * LP;
        float v[PER]; float s = 0.f; const int t0 = tid * PER;
#pragma unroll
        for (int i = 0; i < PER; ++i) { const int t = t0 + i; const float x = t < LREAL ? lf[(size_t)t * 8] : 0.f; s += x; v[i] = s; }
        float incl = s;
#pragma unroll
        for (int o = 1; o < 64; o <<= 1) { const float n = __shfl_up(incl, o); if (lane >= o) incl += n; }
        LAS float* wsum = (LAS float*)(lds + LDS_MISC + 256);
        if (lane == 63) wsum[wave] = incl;
        __syncthreads();
        float off = 0.f;
        for (int w = 0; w < wave; ++w) off += wsum[w];
        const float excl = off + incl - s;
#pragma unroll
        for (int i = 0; i < PER; ++i) { const int t = t0 + i; if (t < LREAL) cs[t] = excl + v[i]; }
        __syncthreads();
    }
    const bf16u* P = (const bf16u*)(ws + WS_P); bf16u* Y = (bf16u*)(ws + WS_Y);
    for (int sl = blockIdx.x; sl < 256; sl += gridDim.x) {
        if (tid < 480) { const int sub = tid / 96, task = tid % 96, which = task / 48, head = (task % 48) >> 3, chunk = task & 7; const int r0 = sl * (MROWS / 256), b = r0 / LP;
            const bf16u* src = P + (which ? PC_FK : PC_FQ) + head * 64 + chunk * 8; float mx = 0.f;
#pragma unroll 9
            for (int r = sub; r < MROWS / 256; r += 5) { const v4u w = ((r0 + r) % LP < LREAL) ? *(const v4u*)(src + (size_t)(r0 + r) * NINP) : (v4u){0u, 0u, 0u, 0u}; float s = 0.f;
#pragma unroll
                for (int e = 0; e < 4; ++e) { const float lo = __uint_as_float(w[e] << 16), hi = __uint_as_float(w[e] & 0xffff0000u); s += lo * lo + hi * hi; }
                s += __shfl_xor(s, 1); s += __shfl_xor(s, 2); s += __shfl_xor(s, 4); mx = fmaxf(mx, s); }
            if (chunk == 0) atomicMax(nrm + (b * NFH + head) * 2 + which, __float_as_uint(mx)); }
    }
    const int rsub = tid >> 5, ch = (tid & 31) * 8, win = 2 << (ch >> 6);
    for (int c = blockIdx.x; c < MROWS / 16; c += gridDim.x) {
        const int row = c * 16 + rsub, t = row % LP; const int cnt = (t + 1 < win) ? t + 1 : win;
        float acc[8], self[8];
#pragma unroll
        for (int e = 0; e < 8; ++e) acc[e] = 0.f;
        v4u wv[16];
#pragma unroll
        for (int j = 0; j < 16; ++j) wv[j] = (j < cnt) ? *(const v4u*)(P + (size_t)(row - j) * NINP + PC_U + ch) : (v4u){0u, 0u, 0u, 0u};
#pragma unroll
        for (int j = 0; j < 16; ++j) {
#pragma unroll
            for (int e = 0; e < 4; ++e) { const float lo = __uint_as_float(wv[j][e] << 16), hi = __uint_as_float(wv[j][e] & 0xffff0000u); acc[2 * e] += lo; acc[2 * e + 1] += hi; if (j == 0) { self[2 * e] = lo; self[2 * e + 1] = hi; } } }
        const float inv = 1.0f / (float)cnt; v4u o;
#pragma unroll
        for (int e = 0; e < 4; ++e) o[e] = pk2(acc[2 * e] * inv - self[2 * e], acc[2 * e + 1] * inv - self[2 * e + 1]);
        *(v4u*)(Y + (size_t)row * 1024 + ch) = o;
    }
}
__device__ __forceinline__ void attn_phase(unsigned char* ws, unsigned char* lds_g, unsigned* ctr, const unsigned* nrm, int tid) {
    const attn_body::bf16* P = (const attn_body::bf16*)(ws + WS_P); attn_body::bf16* Y = (attn_body::bf16*)(ws + WS_Y); const float* CS = (const float*)(ws + WS_CS);
    volatile LAS unsigned* bw = (volatile LAS unsigned*)((LAS unsigned char*)lds_g + LDS_MISC);
    constexpr int NU = NBATCH * NFH * (LP / 256);
    for (;;) {
        if (tid == 0) bw[0] = atomicAdd(ctr, 1u);
        __syncthreads();
        const int it = (int)bw[0];
        __syncthreads();
        if (it >= 2 * NU) break;
        const int r = it < NU ? it : it - NU; const int qb = (LP / 256 - 1) - r / (NBATCH * NFH), bh = r % (NBATCH * NFH), b = bh / NFH, h = bh % NFH;
#ifndef NO_FOX
        if (it < NU) attn_body::fox_unit<8>(b, qb, 154.0f + 2.0f * sqrtf(__uint_as_float(nrm[bh * 2]) * __uint_as_float(nrm[bh * 2 + 1])), P + PC_FQ + h * 64, P + PC_FK + h * 64, P + PC_FV + h * 64, Y + 256 + h * 64, CS + (size_t)bh * LP, (char*)lds_g);
#endif
#ifndef NO_SB
        if (it >= NU) attn_body::sb_unit(b, qb, P + PC_SQ + h * 64, P + PC_SK + h * 64, P + PC_SV + h * 64, Y + 640 + h * 64, (char*)lds_g);
#endif
    }
}
__device__ __forceinline__ void final_phase(const Args& A, unsigned char* ws, int wave, int lane) {
    const float* h = (const float*)(ws + WS_H); const float* ss = (const float*)(ws + WS_SS) + 4 * (size_t)MROWS; const f32x4* g = (const f32x4*)A.in[14] + lane;
    const int gw = blockIdx.x * NWAVES + wave, NGW = gridDim.x * NWAVES;
    f32x4 gv[4];
#pragma unroll
    for (int j = 0; j < 4; ++j) gv[j] = g[64 * j];
    for (int m = gw; m < NBATCH * SEQ_IN; m += NGW) {
        const int b = m / SEQ_IN, s = m % SEQ_IN; const size_t row = (size_t)b * LP + NMETA + s;
        const float rs = 1.0f / sqrtf(ss[row] * (1.0f / 1024.0f) + 1e-6f);
        const f32x4* src = (const f32x4*)(h + row * 1024) + lane; f32x4* dst = (f32x4*)(A.out + (size_t)m * 1024) + lane;
#pragma unroll
        for (int j = 0; j < 4; ++j) dst[64 * j] = src[64 * j] * rs * gv[j];
    }
}

#define XB_TMO      128
#define XB_XCNT(j)  (256  + 64 * (j))
#define XB_XSUB(j)  (1280 + 64 * (j))
#define XB_XGEN(j)  (2304 + 64 * (j))
#define XB_TOP      3328
#define XB_TOPGEN   3392
#define XCD_BAR_WORDS 3456
#define XB_SPIN_CAP (1u << 18)

__device__ __forceinline__ unsigned xb_ld(unsigned* p)              { return __hip_atomic_load(p, __ATOMIC_RELAXED, __HIP_MEMORY_SCOPE_AGENT); }
__device__ __forceinline__ unsigned xb_add(unsigned* p, unsigned v) { return __hip_atomic_fetch_add(p, v, __ATOMIC_RELAXED, __HIP_MEMORY_SCOPE_AGENT); }
__device__ __forceinline__ unsigned xb_xcc_id() { return (unsigned)__builtin_amdgcn_s_getreg((3 << 11) | 20) & 0xFu; }
#define XB_SPIN(cond, bar) do { unsigned _sp = 0; while (cond) { __builtin_amdgcn_s_sleep(1); \
    if ((++_sp & 255u) == 0u) { if (xb_ld(&(bar)[XB_TMO])) break; if (_sp > XB_SPIN_CAP) { atomicAdd(&(bar)[XB_TMO], 1u); break; } } } } while (0)

struct XcdBarrier {
    unsigned* bar; unsigned x;
    volatile LAS unsigned* st;
};

__device__ __forceinline__ XcdBarrier xcd_barrier_post(unsigned* bar, volatile LAS unsigned* st) {
    XcdBarrier b; b.bar = bar; b.x = xb_xcc_id(); b.st = st;
    if (threadIdx.x == 0) (void)xb_add(&bar[XB_XCNT(b.x)], 1u);
    return b;
}
__device__ __forceinline__ void xcd_barrier_complete(unsigned* bar, unsigned x, unsigned& nloc, unsigned& nx) {
    const unsigned G = gridDim.x * gridDim.y * gridDim.z;
    unsigned sum, cnt, mine, sp = 0u;
    for (;;) {
        sum = 0u; cnt = 0u; mine = 0u;
#pragma unroll
        for (unsigned j = 0; j < 16; ++j) { const unsigned c = xb_ld(&bar[XB_XCNT(j)]); sum += c; cnt += (c > 0u) ? 1u : 0u; mine = (j == x) ? c : mine; }
        if (sum == G) break;
        __builtin_amdgcn_s_sleep(1);
        if ((++sp & 255u) == 0u) { if (xb_ld(&bar[XB_TMO])) break; if (sp > XB_SPIN_CAP) { atomicAdd(&bar[XB_TMO], 1u); break; } }
    }
    nloc = mine > 0u ? mine : 1u; nx = cnt > 0u ? cnt : 1u;
}

__device__ __forceinline__ void xcd_barrier(const XcdBarrier& b) {
    asm volatile("s_waitcnt vmcnt(0)" ::: "memory");
    __syncthreads();
    if (threadIdx.x == 0) {
        unsigned* bar = b.bar;
        __builtin_amdgcn_s_waitcnt(0);
        unsigned nloc = b.st[0], nx = b.st[1];
        if (nloc == 0u) { xcd_barrier_complete(bar, b.x, nloc, nx); b.st[0] = nloc; b.st[1] = nx; }
        const unsigned old = xb_add(&bar[XB_XSUB(b.x)], 1u);
        const unsigned gen = old / nloc;
        if (old + 1u == (gen + 1u) * nloc) {
            __builtin_amdgcn_fence(__ATOMIC_RELEASE, "agent");
            asm volatile("s_waitcnt vmcnt(0)" ::: "memory");
            const unsigned og = xb_add(&bar[XB_TOP], 1u);
            const unsigned tg = og / nx;
            if (og + 1u == (tg + 1u) * nx) xb_add(&bar[XB_TOPGEN], 1u);
            else XB_SPIN(xb_ld(&bar[XB_TOPGEN]) == tg, bar);
            __builtin_amdgcn_fence(__ATOMIC_ACQUIRE, "agent");
            xb_add(&bar[XB_XGEN(b.x)], 1u);
            asm volatile("s_waitcnt vmcnt(0)" ::: "memory");
        } else {
            XB_SPIN(xb_ld(&bar[XB_XGEN(b.x)]) == gen, bar);
            __builtin_amdgcn_fence(__ATOMIC_ACQUIRE, "agent");
            asm volatile("s_waitcnt vmcnt(0)" ::: "memory");
        }
    }
    __syncthreads();
}

#define FRESH() unsigned long zoff_ = 0; asm volatile("" : "+s"(zoff_)); unsigned char* ws = A.ws + zoff_; int tid = threadIdx.x; asm volatile("" : "+v"(tid)); const int lane = tid & 63, wave = __builtin_amdgcn_readfirstlane(tid >> 6); (void)lane; (void)wave
#ifdef PROBE
#define STAMP() do { if (blockIdx.x == 0 && threadIdx.x == 0) { ((volatile unsigned long long*)(A.ws + WS_CTL + 8192))[nst] = __builtin_amdgcn_s_memrealtime(); } ++nst; } while (0)
#else
#define STAMP() do {} while (0)
#endif
__global__ void __launch_bounds__(NWAVES * 64, 2) hymba_fwd(Args A) {
    extern __shared__ __attribute__((aligned(16))) unsigned char lds[];
    cg::grid_group grid = cg::this_grid();
    LAS unsigned char* L = (LAS unsigned char*)lds;
    if (threadIdx.x < 2) ((volatile LAS unsigned*)(L + LDS_MISC + 64))[threadIdx.x] = 0u;
    __syncthreads();
    const XcdBarrier xbar = xcd_barrier_post((unsigned*)(A.ws + WS_CTL) + 4096, (volatile LAS unsigned*)(L + LDS_MISC + 64));
#define GRID_BAR() xcd_barrier(xbar)
#ifdef PROBE
    int nst = 0; STAMP();
    for (int i = 0; i < 8; ++i) GRID_BAR();
    STAMP();
#endif
#ifndef NO_PRO
    { FRESH(); p0_prologue(A, ws, L, wave, lane); }
#endif
    if (A.ws == nullptr) grid.sync();
    GRID_BAR(); STAMP();
    for (int layer = 0; layer < DEPTH; ++layer) {
#ifndef NO_G1
        {
            FRESH(); const unsigned char* wb = ws + WS_W + (size_t)layer * W_LAYER;
            pg8::Gemm g{(const pg8::bf16_t*)(ws + WS_HB), (const pg8::bf16_t*)(wb + W_IN), MREAL, NIN, 1024}; pg8::StaticOrder S; S.init(MREAL, NIN, (int)gridDim.x, (int)blockIdx.x);
            pg8::EpiIn E{(pg8::bf16_t*)(ws + WS_P), (float*)(ws + WS_LF), (const float*)(ws + WS_SS) + (size_t)(2 * layer) * MROWS, A.in[4] + layer * NFH};
            mini_in(ws, (const bf16u*)(wb + W_IN), (const float*)(ws + WS_SS) + (size_t)(2 * layer) * MROWS, A.in[4] + layer * NFH, L, wave, lane);
            pg8::gemm_phase<pg8::EpiIn, pg8::StaticOrder, true, true>(L, g, S, E);
        }
#endif
        GRID_BAR(); STAMP();
#ifndef NO_POOL
        { FRESH(); pool_scan_phase(ws, L, (unsigned*)(ws + WS_CTL) + 128 + 64 * layer, tid, wave, lane); }
#endif
        GRID_BAR(); STAMP();
        { FRESH(); attn_phase(ws, lds, (unsigned*)(ws + WS_CTL) + 64 * layer, (const unsigned*)(ws + WS_CTL) + 128 + 64 * layer, tid); }
        GRID_BAR(); STAMP();
#ifndef NO_G3
        {
            FRESH(); const unsigned char* wb = ws + WS_W + (size_t)layer * W_LAYER;
            pg8::Gemm g{(const pg8::bf16_t*)(ws + WS_Y), (const pg8::bf16_t*)(wb + W_OUT), MREAL, 1024, 1024}; pg8::StaticOrder S; S.init(MREAL, 1024, (int)gridDim.x, (int)blockIdx.x);
            pg8::EpiRes E{(float*)(ws + WS_H), (pg8::bf16_t*)(ws + WS_HB), (float*)(ws + WS_SS) + (size_t)(2 * layer + 1) * MROWS};
            mini_res(ws, (const bf16u*)(ws + WS_Y), (const bf16u*)(wb + W_OUT), 1024, (float*)(ws + WS_SS) + (size_t)(2 * layer + 1) * MROWS, L, wave, lane);
            pg8::gemm_phase<pg8::EpiRes, pg8::StaticOrder, true, true>(L, g, S, E);
        }
#endif
        GRID_BAR(); STAMP();
#ifndef NO_G4
        {
            FRESH(); const unsigned char* wb = ws + WS_W + (size_t)layer * W_LAYER;
            pg8::Gemm g{(const pg8::bf16_t*)(ws + WS_HB), (const pg8::bf16_t*)(wb + W_GU), MREAL, NGU, 1024}; pg8::StaticOrder S; S.init(MREAL, NGU, (int)gridDim.x, (int)blockIdx.x);
            pg8::EpiGU E{(pg8::bf16_t*)(ws + WS_P), (const float*)(ws + WS_SS) + (size_t)(2 * layer + 1) * MROWS};
            mini_gu(ws, (const bf16u*)(wb + W_GU), (const float*)(ws + WS_SS) + (size_t)(2 * layer + 1) * MROWS, L, wave, lane);
            pg8::gemm_phase<pg8::EpiGU, pg8::StaticOrder, true, true>(L, g, S, E);
        }
#endif
        GRID_BAR(); STAMP();
#ifndef NO_G5
        {
            FRESH(); const unsigned char* wb = ws + WS_W + (size_t)layer * W_LAYER;
            pg8::Gemm g{(const pg8::bf16_t*)(ws + WS_P), (const pg8::bf16_t*)(wb + W_D), MREAL, 1024, DFF}; pg8::StaticOrder S; S.init(MREAL, 1024, (int)gridDim.x, (int)blockIdx.x);
            pg8::EpiRes E{(float*)(ws + WS_H), (pg8::bf16_t*)(ws + WS_HB), (float*)(ws + WS_SS) + (size_t)(2 * layer + 2) * MROWS};
            mini_res(ws, (const bf16u*)(ws + WS_P), (const bf16u*)(wb + W_D), DFF, (float*)(ws + WS_SS) + (size_t)(2 * layer + 2) * MROWS, L, wave, lane);
            pg8::gemm_phase<pg8::EpiRes, pg8::StaticOrder, true, true>(L, g, S, E);
        }
#endif
        GRID_BAR(); STAMP();
    }
    { FRESH(); final_phase(A, ws, wave, lane); }
#ifdef PROBE
    STAMP();
    grid.sync();
    {
        volatile unsigned long long* T = (volatile unsigned long long*)(A.ws + WS_CTL + 8192);
        if (blockIdx.x == 0) {
            const unsigned long long dA = T[PA + 1] - T[PA], dB = T[PB + 1] - T[PB];
            for (unsigned long long i = threadIdx.x; i < dB; i += NWAVES * 64) A.out[i] += 0.125f;
            if (threadIdx.x == 0) { const unsigned long long t0 = __builtin_amdgcn_s_memrealtime(); while (__builtin_amdgcn_s_memrealtime() - t0 < dA) __builtin_amdgcn_s_sleep(8); }
        }
    }
#endif
}

extern "C" void kernel_launch(void* const* d_in, const int* in_sizes, int n_in, void* d_out, int out_size, void* d_ws, size_t ws_size, hipStream_t stream) {
    static int grid = 0;
    if (grid == 0) {
        if (n_in != 15 || out_size != NBATCH * SEQ_IN * DMODEL || ws_size < WS_END) { fprintf(stderr, "kernel_launch: unexpected shapes (n_in %d out %d ws %zu, need %zu)\n", n_in, out_size, ws_size, (size_t)WS_END); grid = -1; return; }
        int dev = 0, cus = 0, per_cu = 0;
        if (hipGetDevice(&dev) != hipSuccess || hipDeviceGetAttribute(&cus, hipDeviceAttributeMultiprocessorCount, dev) != hipSuccess) { grid = -1; return; }
        if (hipFuncSetAttribute((const void*)hymba_fwd, hipFuncAttributeMaxDynamicSharedMemorySize, LDS_BYTES) != hipSuccess) { fprintf(stderr, "kernel_launch: hipFuncSetAttribute failed\n"); grid = -1; return; }
        if (hipOccupancyMaxActiveBlocksPerMultiprocessor(&per_cu, (const void*)hymba_fwd, NWAVES * 64, LDS_BYTES) != hipSuccess || per_cu < 1) { fprintf(stderr, "kernel_launch: occupancy query says %d\n", per_cu); per_cu = 1; }
        (void)hipGetLastError();
        grid = cus;
    }
    if (grid < 0) return;
    if (hipMemsetAsync((char*)d_ws + WS_CTL, 0, CTL_ZERO_BYTES, stream) != hipSuccess) { fprintf(stderr, "kernel_launch: memset failed\n"); return; }
    Args a{};
    for (int i = 0; i < 15; ++i) a.in[i] = (const float*)d_in[i];
    a.out = (float*)d_out; a.ws = (unsigned char*)d_ws;
    void* args[] = {&a};
    const hipError_t e = hipLaunchCooperativeKernel((const void*)hymba_fwd, dim3(grid), dim3(NWAVES * 64), args, LDS_BYTES, stream);
    if (e != hipSuccess) fprintf(stderr, "kernel_launch: cooperative launch failed: %s (grid %d)\n", hipGetErrorString(e), grid);
}
```

```cpp
#include <hip/hip_runtime.h>
#include <hip/hip_cooperative_groups.h>
#include <cstdio>
#include <cstdint>
namespace pg8 {
#define PG8_LAS __attribute__((address_space(3)))
typedef unsigned short bf16_t;
typedef short bf16x8 __attribute__((ext_vector_type(8)));
typedef float f32x4 __attribute__((ext_vector_type(4)));
typedef unsigned u32x4 __attribute__((ext_vector_type(4)));
constexpr int BM = 256, BK = 64, HALF = 128, HTB = HALF * BK * 2  , STAGE_BYTES = 8 * HTB, NXCD = 8, WGM = 8;

__host__ __device__ __forceinline__ int lds_byte(int r, int c) { const int st = (r >> 4) * 2 + (c >> 5), rr = r & 15, cc = c & 31, ob = rr * 64 + cc * 2; return st * 1024 + (ob ^ (((ob >> 9) & 1) << 5)); }
__host__ __device__ __forceinline__ void stage_rc(int b, int& R, int& C) { const int st = b / 1024, sb = b % 1024, swz = sb ^ (((sb >> 9) & 1) << 5); R = (st >> 1) * 16 + swz / 64; C = (st & 1) * 32 + (swz % 64) / 2; }
__host__ __device__ __forceinline__ int perm32(int rho) { const int n = rho >> 4, i = rho & 15; return 8 * (i >> 2) + 4 * n + (i & 3); }

struct Unit { int pm, pn; };
__host__ __device__ __forceinline__ int arow(int pm) { return 256 * (pm + (pm >> 5)) + 16; }
struct Gemm { const bf16_t* A; const bf16_t* Bt; int M, N, K; };

struct StaticOrder {
    int nM, nN, nwg, G, c;
    __host__ __device__ void init(int M, int N, int G_, int c_) { nM = M / BM; nN = N / BM; nwg = nM * nN; G = G_; c = c_; }
    __host__ __device__ bool next(int i, Unit& u) const {
        const long L = (long)i * G + c; if (L >= nwg) return false;
        int wgid = (int)L; { const int q = nwg / NXCD, r = nwg % NXCD, xcd = wgid % NXCD, off = wgid / NXCD; wgid = (xcd < r ? xcd * (q + 1) : r * (q + 1) + (xcd - r) * q) + off; }
        const int nig = WGM * nN, gid = wgid / nig, fm = gid * WGM, gsz = (nM - fm) < WGM ? (nM - fm) : WGM;
        u.pm = fm + ((wgid % nig) % gsz); u.pn = (wgid % nig) / gsz; return true;
    }
    __device__ __forceinline__ void a_ready(const Unit&) const {}
    __device__ __forceinline__ void done(const Unit&) const {}
};

__device__ __forceinline__ unsigned cvt_pk_bf16(float lo, float hi) { unsigned r; asm volatile("v_cvt_pk_bf16_f32 %0, %1, %2" : "=v"(r) : "v"(lo), "v"(hi)); return r; }
typedef unsigned u32x2 __attribute__((ext_vector_type(2)));
constexpr float RMS_EPS = 1e-6f;
struct EpiIn {
    static constexpr bool PERM = true, AFTER_DRAIN = false;
    bf16_t* P; float* LF; const float* ss; const float* fb;
    __device__ __forceinline__ void operator()(const f32x4 (&acc)[2][2][4][2], const Unit& u, int wr, int wc, int fr, int fq) const {
        const int row0 = arow(u.pm) + wr * 64 + fr;
        if (u.pn < 10) {
            const int col0 = u.pn * BM + wc * 32 + 8 * fq;
#pragma unroll
            for (int ai = 0; ai < 2; ++ai)
#pragma unroll
                for (int m = 0; m < 4; ++m) { const int row = row0 + ai * HALF + m * 16; const float rs = __builtin_amdgcn_rsqf(ss[row] * (1.0f / 1024.0f) + RMS_EPS);
                    bf16_t* rowp = P + (size_t)row * 2560 + col0;
#pragma unroll
                    for (int bj = 0; bj < 2; ++bj) { const f32x4 v0 = acc[ai][bj][m][0] * rs, v1 = acc[ai][bj][m][1] * rs;
                        u32x4 w; w.x = cvt_pk_bf16(v0[0], v0[1]); w.y = cvt_pk_bf16(v0[2], v0[3]); w.z = cvt_pk_bf16(v1[0], v1[1]); w.w = cvt_pk_bf16(v1[2], v1[3]);
                        *(u32x4*)(rowp + bj * HALF) = w; } }
        } else if (wc == 0 && fq == 0) {
            float b[6];
#pragma unroll
            for (int j = 0; j < 6; ++j) b[j] = fb[j];
#pragma unroll
            for (int ai = 0; ai < 2; ++ai)
#pragma unroll
                for (int m = 0; m < 4; ++m) { const int row = row0 + ai * HALF + m * 16; const float rs = __builtin_amdgcn_rsqf(ss[row] * (1.0f / 1024.0f) + RMS_EPS);
                    const f32x4 v0 = acc[ai][0][m][0] * rs, v1 = acc[ai][0][m][1] * rs;
                    float x[6] = {v0[0] + b[0], v0[1] + b[1], v0[2] + b[2], v0[3] + b[3], v1[0] + b[4], v1[1] + b[5]};
                    float l[6];
#pragma unroll
                    for (int j = 0; j < 6; ++j) l[j] = -(fmaxf(-x[j], 0.f) + log1pf(expf(-fabsf(x[j])))) * 1.4426950408889634f;
                    *(f32x4*)(LF + (size_t)row * 8) = (f32x4){l[0], l[1], l[2], l[3]};
                    *(f32x4*)(LF + (size_t)row * 8 + 4) = (f32x4){l[4], l[5], 0.f, 0.f}; }
        }
    }
};
struct EpiRes {
    static constexpr bool PERM = true, AFTER_DRAIN = false;
    bf16_t* hb; float* hf; float* ssn;
    __device__ __forceinline__ void operator()(const f32x4 (&acc)[2][2][4][2], const Unit& u, int wr, int wc, int fr, int fq) const {
        const int row0 = arow(u.pm) + wr * 64 + fr, col0 = u.pn * BM + wc * 32 + 8 * fq;
#pragma unroll
        for (int ai = 0; ai < 2; ++ai)
#pragma unroll
            for (int m = 0; m < 4; ++m) { const int row = row0 + ai * HALF + m * 16; bf16_t* bp = hb + (size_t)row * 1024 + col0; float s = 0.f;
#pragma unroll
                for (int bj = 0; bj < 2; ++bj) { const u32x4 r = *(const u32x4*)(bp + bj * HALF);
                    f32x4 a = (f32x4){__uint_as_float(r.x << 16), __uint_as_float(r.x & 0xffff0000u), __uint_as_float(r.y << 16), __uint_as_float(r.y & 0xffff0000u)};
                    f32x4 b = (f32x4){__uint_as_float(r.z << 16), __uint_as_float(r.z & 0xffff0000u), __uint_as_float(r.w << 16), __uint_as_float(r.w & 0xffff0000u)};
                    a = a + acc[ai][bj][m][0]; b = b + acc[ai][bj][m][1];
                    if (hf) { float* hp = hf + (size_t)row * 1024 + col0 + bj * HALF; *(f32x4*)hp = a; *(f32x4*)(hp + 4) = b; }
                    s += (a[0] * a[0] + a[1] * a[1]) + (a[2] * a[2] + a[3] * a[3]) + (b[0] * b[0] + b[1] * b[1]) + (b[2] * b[2] + b[3] * b[3]);
                    u32x4 w; w.x = cvt_pk_bf16(a[0], a[1]); w.y = cvt_pk_bf16(a[2], a[3]); w.z = cvt_pk_bf16(b[0], b[1]); w.w = cvt_pk_bf16(b[2], b[3]);
                    *(u32x4*)(bp + bj * HALF) = w; }
                s += __shfl_xor(s, 16); s += __shfl_xor(s, 32);
                if (fq == 0) atomicAdd(ssn + row, s);
                asm volatile("" ::: "memory"); }
    }
};
struct EpiGU {
    static constexpr bool PERM = true, AFTER_DRAIN = false;
    bf16_t* H; const float* ss;
    __device__ __forceinline__ void operator()(const f32x4 (&acc)[2][2][4][2], const Unit& u, int wr, int wc, int fr, int fq) const {
        const int row0 = arow(u.pm) + wr * 64 + fr, col0 = u.pn * HALF + wc * 32 + 8 * fq;
#pragma unroll
        for (int ai = 0; ai < 2; ++ai)
#pragma unroll
            for (int m = 0; m < 4; ++m) { const int row = row0 + ai * HALF + m * 16; const float rs = __builtin_amdgcn_rsqf(ss[row] * (1.0f / 1024.0f) + RMS_EPS);
                float o[8];
#pragma unroll
                for (int n = 0; n < 2; ++n)
#pragma unroll
                    for (int e = 0; e < 4; ++e) { const float g = acc[ai][0][m][n][e] * rs, up = acc[ai][1][m][n][e] * rs;
                        o[4 * n + e] = g * __builtin_amdgcn_rcpf(1.0f + __builtin_amdgcn_exp2f(-1.4426950408889634f * g)) * up; }
                u32x4 w; w.x = cvt_pk_bf16(o[0], o[1]); w.y = cvt_pk_bf16(o[2], o[3]); w.z = cvt_pk_bf16(o[4], o[5]); w.w = cvt_pk_bf16(o[6], o[7]);
                *(u32x4*)(H + (size_t)row * 2816 + col0) = w; }
    }
};
template <class Epi, class Sched, bool ALIGN_EPI = false, bool SP2 = false>
__device__ __forceinline__ void gemm_phase(PG8_LAS unsigned char* lds, const Gemm g, const Sched& S, const Epi& E) {
    int tid_ = threadIdx.x; asm volatile("" : "+v"(tid_));
    const int tid = tid_, wid = __builtin_amdgcn_readfirstlane(tid >> 6), lane = tid & 63, wr = wid >> 2, wc = wid & 3, fr = lane & 15, fq = lane >> 4;
    const int K = g.K, nt = K / BK;
    unsigned voffA[2], voffB[2];
#pragma unroll
    for (int i = 0; i < 2; ++i) { int R, C; stage_rc(tid * 16 + i * 8192, R, C); const int Rb = Epi::PERM ? ((R & ~31) + perm32(R & 31)) : R;
        voffA[i] = (unsigned)(R * K + C) * 2u; voffB[i] = (unsigned)(Rb * K + C) * 2u; }
    const size_t kstep = (size_t)(BK * 2);
    const size_t hstep = (size_t)HALF * K * 2;
    const size_t tstep = 2 * hstep;
    const unsigned ldsw = (unsigned)wid * 1024u;
    const int aoff = lds_byte(wr * 64 + fr, fq * 8), boff = lds_byte(wc * 32 + fr, fq * 8);
#define PG8_SA(b, h) (((b) * 2 + (h)) * HTB)
#define PG8_SB(b, h) ((4 + (b) * 2 + (h)) * HTB)
#define PG8_STAGE(bufoff, gbase, voff) do { _Pragma("unroll") for (int _i = 0; _i < 2; ++_i) \
        __builtin_amdgcn_global_load_lds((const unsigned*)((const char*)(gbase) + (voff)[_i]), (PG8_LAS unsigned*)(lds + (bufoff) + ldsw + _i * 8192), 16, 0, 0); } while (0)
#define PG8_LDA(dst, b, h) do { _Pragma("unroll") for (int m = 0; m < 4; ++m) _Pragma("unroll") for (int k = 0; k < 2; ++k) dst[m][k] = *(const PG8_LAS bf16x8*)(lds + PG8_SA(b, h) + aoff + m * 2048 + k * 1024); } while (0)
#define PG8_LDB(dst, b, h) do { _Pragma("unroll") for (int n = 0; n < 2; ++n) _Pragma("unroll") for (int k = 0; k < 2; ++k) dst[n][k] = *(const PG8_LAS bf16x8*)(lds + PG8_SB(b, h) + boff + n * 2048 + k * 1024); } while (0)
#define PG8_MMA(ai, bj, At, Bt) do { __builtin_amdgcn_s_setprio(1); _Pragma("unroll") for (int m = 0; m < 4; ++m) _Pragma("unroll") for (int n = 0; n < 2; ++n) _Pragma("unroll") for (int k = 0; k < 2; ++k) \
        acc[ai][bj][m][n] = __builtin_amdgcn_mfma_f32_16x16x32_bf16(Bt[n][k], At[m][k], acc[ai][bj][m][n], 0, 0, 0); __builtin_amdgcn_s_setprio(0); } while (0)
#define PG8_WAIT_V(n) asm volatile("s_waitcnt vmcnt(" #n ")" ::: "memory")
#define PG8_WAIT_L(n) asm volatile("s_waitcnt lgkmcnt(" #n ")" ::: "memory")
#define PG8_BAR __builtin_amdgcn_s_barrier()
#define PG8_SCHED __builtin_amdgcn_sched_barrier(0)
    Unit cur, nxt; int ui = 0;
    if (!S.next(0, cur)) return;
    f32x4 acc[2][2][4][2];
#pragma unroll
    for (int a = 0; a < 2; ++a)
#pragma unroll
        for (int b = 0; b < 2; ++b)
#pragma unroll
            for (int m = 0; m < 4; ++m)
#pragma unroll
                for (int n = 0; n < 2; ++n) acc[a][b][m][n] = (f32x4){0.f, 0.f, 0.f, 0.f};
    bf16x8 At[4][2], B0[2][2], B1[2][2];
    const char* cA = (const char*)g.A + (size_t)arow(cur.pm) * K * 2; const char* cB = (const char*)g.Bt + (size_t)cur.pn * tstep;
    S.a_ready(cur);
    if constexpr (SP2) {
        PG8_STAGE(PG8_SB(0, 0), cB, voffB); PG8_STAGE(PG8_SB(0, 1), cB + hstep, voffB); PG8_STAGE(PG8_SA(0, 0), cA, voffA); PG8_STAGE(PG8_SA(0, 1), cA + hstep, voffA);
        if (wr == 1) PG8_BAR;
        PG8_WAIT_V(2); PG8_BAR;
        PG8_STAGE(PG8_SB(1, 0), cB + kstep, voffB); PG8_STAGE(PG8_SA(1, 0), cA + kstep, voffA); PG8_STAGE(PG8_SB(1, 1), cB + hstep + kstep, voffB);
        PG8_WAIT_V(6); PG8_BAR;
    } else {
        PG8_STAGE(PG8_SB(0, 0), cB, voffB); PG8_STAGE(PG8_SA(0, 0), cA, voffA); PG8_STAGE(PG8_SB(0, 1), cB + hstep, voffB); PG8_STAGE(PG8_SA(0, 1), cA + hstep, voffA);
        if (wr == 1) PG8_BAR;
        PG8_WAIT_V(4); PG8_BAR;
        PG8_STAGE(PG8_SB(1, 0), cB + kstep, voffB); PG8_STAGE(PG8_SA(1, 0), cA + kstep, voffA); PG8_STAGE(PG8_SB(1, 1), cB + hstep + kstep, voffB);
        PG8_WAIT_V(6); PG8_BAR;
    }
    for (;;) {
        const bool has_next = S.next(ui + 1, nxt);
        const char* nA = has_next ? (const char*)g.A + (size_t)arow(nxt.pm) * K * 2 : cA; const char* nB = has_next ? (const char*)g.Bt + (size_t)nxt.pn * tstep : cB;
        for (int t = 0; t < nt; t += 2) {
            const bool last = (t == nt - 2);
            const char* a1 = cA + (size_t)(t + 1) * kstep;
            const char* a2 = last ? nA : cA + (size_t)(t + 2) * kstep; const char* b2 = last ? nB : cB + (size_t)(t + 2) * kstep;
            const char* a3 = a2 + kstep; const char* b3 = b2 + kstep;
            if (last && has_next) S.a_ready(nxt);
            if constexpr (SP2) {
            PG8_LDB(B0, 0, 0); PG8_LDB(B1, 0, 1); PG8_SCHED; PG8_LDA(At, 0, 0); PG8_STAGE(PG8_SA(1, 1), a1 + hstep, voffA);
            PG8_WAIT_V(8); PG8_WAIT_L(0); PG8_BAR; PG8_MMA(0, 0, At, B0); PG8_MMA(0, 1, At, B1); PG8_BAR; PG8_SCHED;
            PG8_LDA(At, 0, 1); PG8_STAGE(PG8_SB(0, 0), b2, voffB); PG8_STAGE(PG8_SB(0, 1), b2 + hstep, voffB); PG8_STAGE(PG8_SA(0, 0), a2, voffA);
            PG8_WAIT_V(8); PG8_WAIT_L(0); PG8_BAR; PG8_MMA(1, 0, At, B0); PG8_MMA(1, 1, At, B1); PG8_BAR; PG8_SCHED;
            PG8_LDB(B0, 1, 0); PG8_LDB(B1, 1, 1); PG8_SCHED; PG8_LDA(At, 1, 0); PG8_STAGE(PG8_SA(0, 1), a2 + hstep, voffA);
            PG8_WAIT_V(8); PG8_WAIT_L(0); PG8_BAR; PG8_MMA(0, 0, At, B0); PG8_MMA(0, 1, At, B1); PG8_BAR; PG8_SCHED;
            PG8_LDA(At, 1, 1); PG8_STAGE(PG8_SB(1, 0), b3, voffB); PG8_STAGE(PG8_SB(1, 1), b3 + hstep, voffB); PG8_STAGE(PG8_SA(1, 0), a3, voffA);
            PG8_WAIT_V(8); PG8_WAIT_L(0); PG8_BAR; PG8_MMA(1, 0, At, B0); PG8_MMA(1, 1, At, B1); PG8_BAR; PG8_SCHED;
            } else {
            PG8_LDB(B0, 0, 0); PG8_SCHED; PG8_LDA(At, 0, 0); PG8_STAGE(PG8_SA(1, 1), a1 + hstep, voffA);
            PG8_WAIT_L(8); PG8_BAR; PG8_WAIT_L(0); PG8_MMA(0, 0, At, B0); PG8_BAR; PG8_SCHED;
            PG8_LDB(B1, 0, 1); PG8_STAGE(PG8_SB(0, 0), b2, voffB);
            PG8_BAR; PG8_WAIT_L(0); PG8_MMA(0, 1, At, B1); PG8_BAR;
            PG8_LDA(At, 0, 1); PG8_STAGE(PG8_SA(0, 0), a2, voffA);
            PG8_BAR; PG8_WAIT_L(0); PG8_MMA(1, 0, At, B0); PG8_BAR; PG8_SCHED;
            PG8_STAGE(PG8_SB(0, 1), b2 + hstep, voffB);
            PG8_WAIT_V(6); PG8_BAR; PG8_MMA(1, 1, At, B1); PG8_BAR;
            PG8_LDB(B0, 1, 0); PG8_SCHED; PG8_LDA(At, 1, 0); PG8_STAGE(PG8_SA(0, 1), a2 + hstep, voffA);
            PG8_WAIT_L(8); PG8_BAR; PG8_WAIT_L(0); PG8_MMA(0, 0, At, B0); PG8_BAR; PG8_SCHED;
            PG8_LDB(B1, 1, 1); PG8_STAGE(PG8_SB(1, 0), b3, voffB);
            PG8_BAR; PG8_WAIT_L(0); PG8_MMA(0, 1, At, B1); PG8_BAR;
            PG8_LDA(At, 1, 1); PG8_STAGE(PG8_SA(1, 0), a3, voffA);
            PG8_BAR; PG8_WAIT_L(0); PG8_MMA(1, 0, At, B0); PG8_BAR; PG8_SCHED;
            PG8_STAGE(PG8_SB(1, 1), b3 + hstep, voffB);
            PG8_WAIT_V(6); PG8_BAR; PG8_MMA(1, 1, At, B1); PG8_BAR;
            }
        }
        if constexpr (ALIGN_EPI) { if (wr == 0) PG8_BAR; }
        if constexpr (!Epi::AFTER_DRAIN) { E(acc, cur, wr, wc, fr, fq); S.done(cur); }
        if (!has_next) break;
#pragma unroll
        for (int a = 0; a < 2; ++a)
#pragma unroll
            for (int b = 0; b < 2; ++b)
#pragma unroll
                for (int m = 0; m < 4; ++m)
#pragma unroll
                    for (int n = 0; n < 2; ++n) acc[a][b][m][n] = (f32x4){0.f, 0.f, 0.f, 0.f};
        cur = nxt; cA = nA; cB = nB; ++ui;
        if constexpr (ALIGN_EPI) { if (wr == 1) PG8_BAR; }
    }
    PG8_WAIT_V(0);
    if constexpr (!ALIGN_EPI) { if (wr == 0) PG8_BAR; }
    PG8_BAR;
    if constexpr (Epi::AFTER_DRAIN) { E.fused(acc, cur, wr, wc, fr, fq, lds, wid, lane); S.done(cur); }
#undef PG8_SA
#undef PG8_SB
#undef PG8_STAGE
#undef PG8_LDA
#undef PG8_LDB
#undef PG8_MMA
#undef PG8_WAIT_V
#undef PG8_WAIT_L
#undef PG8_BAR
#undef PG8_SCHED
}
}
#include <hip/hip_bf16.h>
#include <cmath>
namespace attn_body {
using bf16=__hip_bfloat16;
using bf16x8=__attribute__((ext_vector_type(8)))short;
using s16x4=__attribute__((ext_vector_type(4)))short;
using f32x16=__attribute__((ext_vector_type(16)))float;
using u32x4=__attribute__((ext_vector_type(4)))unsigned;
constexpr int SEQ=8448,D=64,DM=2560,DMO=1024;
using f32x4=__attribute__((ext_vector_type(4)))float;
constexpr int NW=8,QBLK=32,QB=QBLK*NW,KVBLK=64,NQB=SEQ/QB;
constexpr int ATTN_UNIT_ROWS=QB;
__device__ __forceinline__ int crow(int r,int hi){return (r&3)+8*(r>>2)+4*hi;}
#define SBAR() __builtin_amdgcn_sched_barrier(0)
__device__ __forceinline__ void cmask(f32x16&p0,f32x16&p1,int jb,int qrel,int hi){
  const float NEG=-INFINITY; int kb=64*jb+4*hi;
  #pragma unroll
  for(int r=0;r<16;++r){int kv=kb+(r&3)+8*(r>>2); if(kv>qrel)p0[r]=NEG; if(kv+32>qrel)p1[r]=NEG;}
}

constexpr int NSLOT=3, SLOTB=8192;
constexpr int LDS_K=0, LDS_V=NSLOT*SLOTB, LDS_WS=2*NSLOT*SLOTB, LDS_OST=LDS_WS+NW*64*4, LDS_BYTES=LDS_OST+NW*4096, LDS_CS=LDS_BYTES, LDS_FLAGS=LDS_CS+SEQ*4, LDS_END=LDS_FLAGS+256;
constexpr float C2=0.125f*1.4426950408889634f;
__device__ __forceinline__ void glds16(const void*gsrc,unsigned lds_dst){unsigned keep;
  asm volatile("s_mov_b32 %0, m0\n\ts_mov_b32 m0, %2\n\ts_nop 0\n\tglobal_load_lds_dwordx4 %1, off\n\ts_mov_b32 m0, %0":"=&s"(keep):"v"(gsrc),"s"(lds_dst):"memory");}
__device__ __forceinline__ float max3f(float a,float b,float c){float r;asm("v_max3_f32 %0, %1, %2, %3":"=v"(r):"v"(a),"v"(b),"v"(c));return r;}
__device__ __forceinline__ float max2f(float a,float b){float r;asm("v_max_f32_e32 %0, %1, %2":"=v"(r):"v"(a),"v"(b));return r;}
__device__ __forceinline__ float fadd_s(float a,float b){float r;asm("v_add_f32_e32 %0, %1, %2":"=v"(r):"v"(a),"v"(b));return r;}
__device__ __forceinline__ float fsub_s(float a,float b){float r;asm("v_sub_f32_e32 %0, %1, %2":"=v"(r):"v"(a),"v"(b));return r;}
typedef float f32x2_t __attribute__((ext_vector_type(2))); typedef __bf16 bf16x2_t __attribute__((ext_vector_type(2)));
__device__ __forceinline__ unsigned cvtpk_s(float lo,float hi){f32x2_t v={lo,hi};bf16x2_t b=__builtin_convertvector(v,bf16x2_t);return __builtin_bit_cast(unsigned,b);}
#define WAIT_BAR(N) asm volatile("s_waitcnt vmcnt(" #N ") lgkmcnt(0)\n\ts_barrier":::"memory")

__device__ __forceinline__ void qkt(f32x16&p0,f32x16&p1,const char*Kslot,const bf16x8*qr,int r32,int hi){
  const char*kb=Kslot+hi*1024+r32*16;
  #pragma unroll
  for(int d0=0;d0<4;++d0){
    const bf16x8 b0=*reinterpret_cast<const bf16x8*>(kb+d0*2048);
    const bf16x8 b1=*reinterpret_cast<const bf16x8*>(kb+d0*2048+512);
    {p0=__builtin_amdgcn_mfma_f32_32x32x16_bf16(b0,qr[d0],p0,0,0,0);p1=__builtin_amdgcn_mfma_f32_32x32x16_bf16(b1,qr[d0],p1,0,0,0);}}
}
typedef __attribute__((address_space(3))) const char* lds_cptr;
typedef short v4i16_t __attribute__((ext_vector_type(4)));
__device__ __forceinline__ void kload8(bf16x8*kf,lds_cptr kp){
  kf[0]=*(const __attribute__((address_space(3))) bf16x8*)(kp);      kf[1]=*(const __attribute__((address_space(3))) bf16x8*)(kp+512);
  kf[2]=*(const __attribute__((address_space(3))) bf16x8*)(kp+2048); kf[3]=*(const __attribute__((address_space(3))) bf16x8*)(kp+2560);
  kf[4]=*(const __attribute__((address_space(3))) bf16x8*)(kp+4096); kf[5]=*(const __attribute__((address_space(3))) bf16x8*)(kp+4608);
  kf[6]=*(const __attribute__((address_space(3))) bf16x8*)(kp+6144); kf[7]=*(const __attribute__((address_space(3))) bf16x8*)(kp+6656);
}
__device__ __forceinline__ void kload2(bf16x8*kf,lds_cptr kp,int j){ kf[2*j]=*(const __attribute__((address_space(3))) bf16x8*)(kp+j*2048); kf[2*j+1]=*(const __attribute__((address_space(3))) bf16x8*)(kp+j*2048+512); }
__device__ __forceinline__ s16x4 vtr(lds_cptr p){ return __builtin_bit_cast(s16x4,__builtin_amdgcn_ds_read_tr16_b64_v4i16((__attribute__((address_space(3))) v4i16_t*)p)); }
__device__ __forceinline__ float rowmax(const f32x16&p0,const f32x16&p1){
  float a=max3f(p0[0],p0[1],p1[0]),b=max3f(p0[2],p0[3],p1[1]);a=max3f(a,p1[2],p1[3]);
  #pragma unroll
  for(int r=4;r<16;r+=4){a=max3f(a,p0[r],p0[r+1]);b=max3f(b,p0[r+2],p0[r+3]);a=max3f(a,p1[r],p1[r+1]);b=max3f(b,p1[r+2],p1[r+3]);}
  const float m=max2f(a,b);
  auto rr=__builtin_amdgcn_permlane32_swap(__float_as_uint(m),__float_as_uint(m),false,false);
  return max2f(__uint_as_float(rr[0]),__uint_as_float(rr[1]));
}
__device__ __forceinline__ void pv(f32x16*o,int vb,bf16x8 pa0,bf16x8 pa1,bf16x8 pa2,bf16x8 pa3){
  #pragma unroll
  for(int d0=0;d0<2;++d0){s16x4 lo[4],hi[4];
    #pragma unroll
    for(int ks=0;ks<4;++ks){
      asm volatile("ds_read_b64_tr_b16 %0,%1 offset:%c2":"=&v"(lo[ks]):"v"(vb),"i"(d0*4096+ks*1024):"memory");
      asm volatile("ds_read_b64_tr_b16 %0,%1 offset:%c2":"=&v"(hi[ks]):"v"(vb),"i"(d0*4096+ks*1024+512):"memory");}
    asm volatile("s_waitcnt lgkmcnt(0)":::"memory");SBAR();
    #define PK(k) (bf16x8){lo[k][0],lo[k][1],lo[k][2],lo[k][3],hi[k][0],hi[k][1],hi[k][2],hi[k][3]}
    o[d0]=__builtin_amdgcn_mfma_f32_32x32x16_bf16(pa0,PK(0),o[d0],0,0,0);
    o[d0]=__builtin_amdgcn_mfma_f32_32x32x16_bf16(pa1,PK(1),o[d0],0,0,0);
    o[d0]=__builtin_amdgcn_mfma_f32_32x32x16_bf16(pa2,PK(2),o[d0],0,0,0);
    o[d0]=__builtin_amdgcn_mfma_f32_32x32x16_bf16(pa3,PK(3),o[d0],0,0,0);
    #undef PK
  }
}

__device__ __forceinline__ u32x4 head_rms(u32x4 v){ float x[8];
  #pragma unroll
  for(int i=0;i<4;++i){x[2*i]=__uint_as_float(v[i]<<16);x[2*i+1]=__uint_as_float(v[i]&0xffff0000u);}
  float s=0.f;
  #pragma unroll
  for(int i=0;i<8;++i)s+=x[i]*x[i];
  s+=__shfl_xor(s,1);s+=__shfl_xor(s,2);s+=__shfl_xor(s,4);
  const float rs=__builtin_amdgcn_rsqf(s*(1.0f/64.0f)+1e-6f); u32x4 w;
  #pragma unroll
  for(int i=0;i<4;++i)w[i]=cvtpk_s(x[2*i]*rs,x[2*i+1]*rs);
  return w; }
#ifndef ATTN_STORE16
#define ATTN_STORE16(p,v) (*(u32x4*)(p)=(v))
#endif
template<int THRL> __device__ __forceinline__ void fox_unit(int b,int qb,float dthr,const bf16*Q,const bf16*__restrict__ K,const bf16*__restrict__ V,bf16*O,const float*__restrict__ csg,char*shm){
  int tid_=threadIdx.x; asm volatile("":"+v"(tid_)); const int tid=tid_,lane=tid&63,r32=lane&31,hi=lane>>5; const int wid=__builtin_amdgcn_readfirstlane(tid>>6);
  const long rowbase=(long)b*SEQ; const int q0=qb*QB;
  const bf16*Qw=Q+(rowbase+q0+wid*QBLK)*DM;
  const unsigned lds0=(unsigned)(uintptr_t)shm; const lds_cptr shm3=(lds_cptr)shm;
  float*wsf=(float*)(shm+LDS_WS)+wid*64;
  const unsigned kdst=lds0+LDS_K+wid*1024, vdst=lds0+LDS_V+wid*1024;
  #define DMA_K(t,slot) glds16(ksrc+(long)(t)*KVBLK*DM,(unsigned)__builtin_amdgcn_readfirstlane(kdst+(slot)))
  #define DMA_V(t,slot) glds16(vsrc+(long)(t)*KVBLK*DM,(unsigned)__builtin_amdgcn_readfirstlane(vdst+(slot)))
  const int vb0=(int)(lds0+LDS_V)+((lane>>4)&1)*32+(lane&3)*8+(4*hi+((lane&15)>>2))*64;
  const char*Kbase=shm+LDS_K; bf16x8 kf[8];
  const lds_cptr kp0=shm3+LDS_K+hi*1024+r32*16; const lds_cptr vp0=shm3+LDS_V+((lane>>4)&1)*32+(lane&3)*8+(4*hi+((lane&15)>>2))*64;
  typedef __attribute__((address_space(3))) float lds_f32; typedef __attribute__((address_space(3))) f32x4 lds_f32x4;
  { lds_f32*cl=(lds_f32*)(shm3+LDS_CS); const int n_=q0+QB; for(int i_=tid*4;i_<n_;i_+=2048){ const f32x4 v_=*(const f32x4*)(csg+i_); *(lds_f32x4*)(cl+i_)=v_; } }
  asm volatile("s_waitcnt vmcnt(0) lgkmcnt(0)\n\ts_barrier":::"memory");
  int j0;
  { const lds_f32*cl=(const lds_f32*)(shm3+LDS_CS); const float cq0=cl[q0]; int lo_=0,hi_=4*qb;
    while(lo_<hi_){ const int mid_=(lo_+hi_)>>1; if(cl[64*mid_+63]-cq0>=dthr)lo_=mid_+1; else hi_=mid_; }
    j0=__builtin_amdgcn_readfirstlane(lo_)&~1; }
  const bf16*Kh=K+(rowbase+(long)j0*KVBLK)*DM,*Vh=V+(rowbase+(long)j0*KVBLK)*DM;
  const bf16*ksrc=Kh+(long)lane*DM+wid*8;
  const bf16*vsrc=Vh+(long)(16*(wid&3)+(lane>>2))*DM+(wid>>2)*32+(lane&3)*8;
  const int NT=(q0+QB)/KVBLK-j0;
  const lds_f32*cl3=(const lds_f32*)(shm3+LDS_CS)+64*j0;
  DMA_K(0,0);DMA_V(0,0);DMA_K(1,SLOTB);
  bf16x8 qr[4];
  #pragma unroll
  for(int d0=0;d0<4;++d0)qr[d0]=*reinterpret_cast<const bf16x8*>(&Qw[(long)r32*DM+d0*16+hi*8]);
  float base=0.f,l_reg=0.f;f32x16 o[2];o[0]=f32x16{};o[1]=f32x16{};
  #define CINIT(C0,C1,t) do{ const lds_f32*cp_=cl3+64*(t)+4*hi; \
    _Pragma("unroll") for(int g_=0;g_<4;++g_){ const f32x4 a_=*(const lds_f32x4*)(cp_+8*g_), b_=*(const lds_f32x4*)(cp_+32+8*g_); \
      C0[4*g_]=base-a_[0];C0[4*g_+1]=base-a_[1];C0[4*g_+2]=base-a_[2];C0[4*g_+3]=base-a_[3]; \
      C1[4*g_]=base-b_[0];C1[4*g_+1]=base-b_[1];C1[4*g_+2]=base-b_[2];C1[4*g_+3]=base-b_[3]; } }while(0)
  const int qrel=wid*QBLK+r32;
  #define CMASK(P0,P1,t) do{int jb_=(t)-(NT-4); if(jb_>=0)cmask(P0,P1,jb_,qrel,hi);}while(0)
  bool resc=false;
  #define START(P0,P1) do{ const float rm=rowmax(P0,P1); resc=false; \
    { const float dl=rm; base=fsub_s(base,dl); \
      _Pragma("unroll") for(int r=0;r<16;++r){P0[r]=fsub_s(P0[r],dl);P1[r]=fsub_s(P1[r],dl);} } \
    _Pragma("unroll") for(int r=0;r<16;++r)P0[r]=__builtin_amdgcn_exp2f(P0[r]); }while(0)
  #define RESC() do{ if(resc){ asm volatile("s_waitcnt lgkmcnt(0)":::"memory"); \
      _Pragma("unroll") for(int d_=0;d_<2;++d_) _Pragma("unroll") for(int r=0;r<16;++r)o[d_][r]*=wsf[crow(r,hi)]; } }while(0)
  f32x16 pA0,pA1,pB0,pB1;
  int sl_prev=0,sl_cur=0,sl_next=SLOTB;
  #define ROT() do{sl_prev=sl_cur;sl_cur=sl_next;sl_next=(sl_next==(NSLOT-1)*SLOTB)?0:sl_next+SLOTB;}while(0)
  DMA_K(2,2*SLOTB);
  WAIT_BAR(3);
  base=cl3[q0-64*j0+wid*QBLK+r32];
  CINIT(pA0,pA1,0); qkt(pA0,pA1,Kbase,qr,r32,hi);asm volatile("s_nop 15\n\ts_nop 7":"+v"(pA0),"+v"(pA1));CMASK(pA0,pA1,0);
  START(pA0,pA1);
  _Pragma("unroll") for(int r=0;r<16;++r)pA1[r]=__builtin_amdgcn_exp2f(pA1[r]);
  WAIT_BAR(0);
  DMA_K(3,0);DMA_V(1,SLOTB);
  ROT();
  kload8(kf,kp0+sl_cur);
  WAIT_BAR(2);
  s16x4 vlo[8],vhi[8]; u32x4 pw0,pw1,pw2,pw3;
  #define PKW(P,B) cvtpk_s(P[B],P[B+1])
  #define PAF(k) __builtin_bit_cast(bf16x8,pw##k)
  #define VFR(i) (bf16x8){vlo[i][0],vlo[i][1],vlo[i][2],vlo[i][3],vhi[i][0],vhi[i][1],vhi[i][2],vhi[i][3]}
  #define PIN(x) asm volatile("":"+v"(x))
  #define MX3(a,b,c) __builtin_fmaxf(__builtin_fmaxf((a),(b)),(c))
  #define GAPA(MF,A0,A1,A2,A3,W0,W1,PW) do{ MF; sacc+=A0; sacc+=A1; sacc+=A2; sacc+=A3; PIN(sacc); W0; W1; PIN(PW); SBAR(); }while(0)
  #define EX(v) __builtin_amdgcn_exp2f(v)
  #define GAPB(MF,X,B) do{ MF; X[B]=EX(X[B]); X[B+1]=EX(X[B+1]); X[B+2]=EX(X[B+2]); X[B+3]=EX(X[B+3]); PIN(X); SBAR(); }while(0)
  #define VRD(i) do{ vlo[i]=vtr(vp_+(((i)>>2)*4096+((i)&3)*1024)); vhi[i]=vtr(vp_+(((i)>>2)*4096+((i)&3)*1024+512)); }while(0)
  #define KRD(G,j) do{ if(G){ kload2(kf,kp0+sl_next,j); SBAR(); } }while(0)
  #define STEP(C0,C1,P0,P1,t,GK,GV,GL) do{ SBAR(); CINIT(C0,C1,t); SBAR(); \
    const lds_cptr vp_=vp0+sl_prev; \
    VRD(0); SBAR(); float sacc=(P0[0]+P0[1]); \
    GAPA(C0=__builtin_amdgcn_mfma_f32_32x32x16_bf16(kf[0],qr[0],C0,0,0,0), P0[2],P0[3],P0[4],P0[5],     pw0[0]=PKW(P0,0), pw0[1]=PKW(P0,2), pw0); \
    VRD(4); SBAR(); GAPA(C1=__builtin_amdgcn_mfma_f32_32x32x16_bf16(kf[1],qr[0],C1,0,0,0), P0[6],P0[7],P0[8],P0[9],     pw0[2]=PKW(P0,4), pw0[3]=PKW(P0,6), pw0); \
    VRD(1); SBAR(); GAPA(C0=__builtin_amdgcn_mfma_f32_32x32x16_bf16(kf[2],qr[1],C0,0,0,0),   P0[10],P0[11],P0[12],P0[13], pw1[0]=PKW(P0,8), pw1[1]=PKW(P0,10), pw1); \
    VRD(5); SBAR(); GAPA(C1=__builtin_amdgcn_mfma_f32_32x32x16_bf16(kf[3],qr[1],C1,0,0,0),   P0[14],P0[15],P1[0],P1[1],   pw1[2]=PKW(P0,12),pw1[3]=PKW(P0,14), pw1); \
    VRD(2); SBAR(); GAPA(C0=__builtin_amdgcn_mfma_f32_32x32x16_bf16(kf[4],qr[2],C0,0,0,0),   P1[2],P1[3],P1[4],P1[5],     pw2[0]=PKW(P1,0), pw2[1]=PKW(P1,2), pw2); \
    VRD(6); SBAR(); GAPA(C1=__builtin_amdgcn_mfma_f32_32x32x16_bf16(kf[5],qr[2],C1,0,0,0),   P1[6],P1[7],P1[8],P1[9],     pw2[2]=PKW(P1,4), pw2[3]=PKW(P1,6), pw2); \
    VRD(3); SBAR(); GAPA(C0=__builtin_amdgcn_mfma_f32_32x32x16_bf16(kf[6],qr[3],C0,0,0,0),   P1[10],P1[11],P1[12],P1[13], pw3[0]=PKW(P1,8), pw3[1]=PKW(P1,10), pw3); \
    VRD(7); SBAR(); GAPA(C1=__builtin_amdgcn_mfma_f32_32x32x16_bf16(kf[7],qr[3],C1,0,0,0),   P1[14],P1[15],0.f,0.f,       pw3[2]=PKW(P1,12),pw3[3]=PKW(P1,14), pw3); \
    l_reg+=sacc; \
    if(GK){DMA_K((t)+3,sl_cur);} if(GV){DMA_V((t)+1,sl_next);} \
    CMASK(C0,C1,t); \
    { float a=MX3(C0[0],C0[1],C1[0]),b=MX3(C0[2],C0[3],C1[1]); a=MX3(a,C1[2],C1[3]); \
      _Pragma("unroll") for(int r=4;r<16;r+=4){a=MX3(a,C0[r],C0[r+1]);b=MX3(b,C0[r+2],C0[r+3]);a=MX3(a,C1[r],C1[r+1]);b=MX3(b,C1[r+2],C1[r+3]);} \
      float rm=__builtin_fmaxf(a,b); { auto rr=__builtin_amdgcn_permlane32_swap(__float_as_uint(rm),__float_as_uint(rm),false,false); rm=__builtin_fmaxf(__uint_as_float(rr[0]),__uint_as_float(rr[1])); } \
      resc=false; \
      if(__builtin_expect(__any(rm>(float)THRL),0)){ const float dl=__builtin_fmaxf(rm,0.f); base-=dl; \
        _Pragma("unroll") for(int r=0;r<16;++r){C0[r]-=dl;C1[r]-=dl;} \
        const float f=__builtin_amdgcn_exp2f(-dl); l_reg*=f; if(hi==0)wsf[r32]=f; resc=true; } } \
    SBAR(); \
    GAPB(o[0]=__builtin_amdgcn_mfma_f32_32x32x16_bf16(PAF(0),VFR(0),o[0],0,0,0), C0,0); \
    GAPB(o[1]=__builtin_amdgcn_mfma_f32_32x32x16_bf16(PAF(0),VFR(4),o[1],0,0,0), C0,4); \
    KRD(GL,0); GAPB(o[0]=__builtin_amdgcn_mfma_f32_32x32x16_bf16(PAF(1),VFR(1),o[0],0,0,0), C0,8); \
    KRD(GL,1); GAPB(o[1]=__builtin_amdgcn_mfma_f32_32x32x16_bf16(PAF(1),VFR(5),o[1],0,0,0), C0,12); \
    KRD(GL,2); GAPB(o[0]=__builtin_amdgcn_mfma_f32_32x32x16_bf16(PAF(2),VFR(2),o[0],0,0,0), C1,0); \
    KRD(GL,3); GAPB(o[1]=__builtin_amdgcn_mfma_f32_32x32x16_bf16(PAF(2),VFR(6),o[1],0,0,0), C1,4); \
    GAPB(o[0]=__builtin_amdgcn_mfma_f32_32x32x16_bf16(PAF(3),VFR(3),o[0],0,0,0), C1,8); \
    GAPB(o[1]=__builtin_amdgcn_mfma_f32_32x32x16_bf16(PAF(3),VFR(7),o[1],0,0,0), C1,12); \
    }while(0)
  int t=1;
  #undef CMASK
  #define CMASK(P0,P1,t) do{}while(0)
  for(;t+5<NT;t+=2){
    STEP(pB0,pB1,pA0,pA1,t,true,true,true);     WAIT_BAR(2); RESC(); ROT();
    STEP(pA0,pA1,pB0,pB1,t+1,true,true,true);   WAIT_BAR(2); RESC(); ROT();
  }
  #undef CMASK
  #define CMASK(P0,P1,t) do{int jb_=(t)-(NT-4); if(jb_>=0)cmask(P0,P1,jb_,qrel,hi);}while(0)
  #define ENDW(tt) do{ if((tt)+3<NT){WAIT_BAR(2);} else if((tt)+2<NT){WAIT_BAR(1);} else {WAIT_BAR(0);} }while(0)
  for(;t+1<NT;t+=2){
    STEP(pB0,pB1,pA0,pA1,t,(t+3<NT),(t+1<NT),(t+1<NT));       ENDW(t);   RESC(); ROT();
    STEP(pA0,pA1,pB0,pB1,t+1,(t+4<NT),(t+2<NT),(t+2<NT));     ENDW(t+1); RESC(); ROT();
  }
  STEP(pB0,pB1,pA0,pA1,NT-1,false,false,false); RESC();
  { float sacc=pB0[0]+pB0[1]; _Pragma("unroll") for(int r=2;r<16;++r)sacc+=pB0[r]; _Pragma("unroll") for(int r=0;r<16;++r)sacc+=pB1[r]; l_reg+=sacc;
    pw0=(u32x4){PKW(pB0,0),PKW(pB0,2),PKW(pB0,4),PKW(pB0,6)};pw1=(u32x4){PKW(pB0,8),PKW(pB0,10),PKW(pB0,12),PKW(pB0,14)};pw2=(u32x4){PKW(pB1,0),PKW(pB1,2),PKW(pB1,4),PKW(pB1,6)};pw3=(u32x4){PKW(pB1,8),PKW(pB1,10),PKW(pB1,12),PKW(pB1,14)};
    SBAR(); pv(o,vb0+sl_cur,PAF(0),PAF(1),PAF(2),PAF(3)); }
  #undef PKW
  #undef PAF
  #undef VFR
  #undef PIN
  #undef MX3
  #undef GAPA
  #undef GAPB
  #undef EX
  #undef VRD
  #undef KRD
  #undef STEP
  #undef ENDW
  {auto rr=__builtin_amdgcn_permlane32_swap(__float_as_uint(l_reg),__float_as_uint(l_reg),false,false);l_reg=__uint_as_float(rr[0])+__uint_as_float(rr[1]);}
  if(hi==0)wsf[32+r32]=l_reg;asm volatile("s_waitcnt lgkmcnt(0)":::"memory");
  float rli[16];
  #pragma unroll
  for(int r=0;r<16;++r)rli[r]=__builtin_amdgcn_rcpf(wsf[32+crow(r,hi)]);
  bf16*Ow=O+(rowbase+q0+wid*QBLK)*DMO;
  { bf16*stg=(bf16*)(shm+LDS_OST)+wid*2048;
    #pragma unroll
    for(int r=0;r<16;++r){const int orow=crow(r,hi);
      #pragma unroll
      for(int d0=0;d0<2;++d0)stg[orow*64+d0*32+r32]=__float2bfloat16(o[d0][r]*rli[r]);}
    asm volatile("s_waitcnt lgkmcnt(0)":::"memory");
    #pragma unroll
    for(int i=0;i<4;++i){const int row=i*8+(lane>>3),ch=lane&7; const u32x4 v=*(const u32x4*)(stg+row*64+ch*8); ATTN_STORE16(Ow+(long)row*DMO+ch*8,head_rms(v));} }
  asm volatile("s_waitcnt lgkmcnt(0)\n\ts_barrier":::"memory");
  #undef DMA_K
  #undef DMA_V
  #undef CMASK
  #undef CINIT
  #undef START
  #undef RESC
  #undef ROT
}
__device__ __forceinline__ float sp2f(float z){ const float e=__builtin_amdgcn_exp2f(-__builtin_fabsf(z)); return __builtin_fmaxf(z,0.f)+__builtin_amdgcn_logf(1.f+e); }
__device__ __forceinline__ void sb_unit(int b,int qb,const bf16*Q,const bf16*__restrict__ K,const bf16*__restrict__ V,bf16*O,char*shm){
  int tid_=threadIdx.x; asm volatile("":"+v"(tid_)); const int tid=tid_,lane=tid&63,r32=lane&31,hi=lane>>5; const int wid=__builtin_amdgcn_readfirstlane(tid>>6);
  const long rowbase=(long)b*SEQ; const int q0=qb*QB;
  const bf16*Qw=Q+(rowbase+q0+wid*QBLK)*DM;
  const bf16*Kh=K+rowbase*DM,*Vh=V+rowbase*DM;
  const unsigned lds0=(unsigned)(uintptr_t)shm; const lds_cptr shm3=(lds_cptr)shm;
  const bf16*ksrc=Kh+(long)lane*DM+wid*8;
  const bf16*vsrc=Vh+(long)(16*(wid&3)+(lane>>2))*DM+(wid>>2)*32+(lane&3)*8;
  const unsigned kdst=lds0+LDS_K+wid*1024, vdst=lds0+LDS_V+wid*1024;
  #define DMA_K(t,slot) glds16(ksrc+(long)(t)*KVBLK*DM,(unsigned)__builtin_amdgcn_readfirstlane(kdst+(slot)))
  #define DMA_V(t,slot) glds16(vsrc+(long)(t)*KVBLK*DM,(unsigned)__builtin_amdgcn_readfirstlane(vdst+(slot)))
  const int vb0=(int)(lds0+LDS_V)+((lane>>4)&1)*32+(lane&3)*8+(4*hi+((lane&15)>>2))*64;
  typedef __attribute__((address_space(3))) unsigned lds_u32;
  volatile lds_u32*flags=(volatile lds_u32*)(shm3+LDS_FLAGS);
  bf16x8 qr[4];
  #pragma unroll
  for(int d0=0;d0<4;++d0)qr[d0]=*reinterpret_cast<const bf16x8*>(&Qw[(long)r32*DM+d0*16+hi*8]);
  asm volatile("":::"memory");
  f32x16 o[2];o[0]=f32x16{};o[1]=f32x16{};
  float R=1.f; const int qabs=q0+wid*QBLK+r32; bool done=false;
  const int jtop=4*qb+3;
  DMA_K(jtop,0);DMA_V(jtop,0);
  int slot=0;
  for(int j=jtop;j>=0;--j){
    if(j>0){ DMA_K(j-1,slot^SLOTB);DMA_V(j-1,slot^SLOTB); WAIT_BAR(2); } else { WAIT_BAR(0); }
    const bool active=(!done)&&(64*j<q0+wid*QBLK+31);
    if(active){
      f32x16 p0=f32x16{},p1=f32x16{};
      qkt(p0,p1,shm+LDS_K+slot,qr,r32,hi);
      const int kvb=64*j+4*hi; f32x16 s0,s1;
      #pragma unroll
      for(int r=0;r<16;++r){ const int kv=kvb+(r&3)+8*(r>>2);
        const float e0=__builtin_amdgcn_exp2f(__builtin_fminf(p0[r],80.f)), e1=__builtin_amdgcn_exp2f(__builtin_fminf(p1[r],80.f));
        const float r0=__builtin_amdgcn_rcpf(1.f+e0), r1=__builtin_amdgcn_rcpf(1.f+e1);
        const bool v0=kv<qabs, v1=kv+32<qabs;
        p0[r]=v0?e0*r0:0.f; p1[r]=v1?e1*r1:0.f; s0[r]=v0?r0:1.f; s1[r]=v1?r1:1.f; }
      float g0[4],g1[4],og0[4],og1[4],T0[4],T1[4];
      #pragma unroll
      for(int g=0;g<4;++g){ g0[g]=(s0[4*g]*s0[4*g+1])*(s0[4*g+2]*s0[4*g+3]); g1[g]=(s1[4*g]*s1[4*g+1])*(s1[4*g+2]*s1[4*g+3]); }
      #pragma unroll
      for(int g=0;g<4;++g){ og0[g]=__shfl_xor(g0[g],32); og1[g]=__shfl_xor(g1[g],32); }
      float run=R;
      #pragma unroll
      for(int g=3;g>=0;--g){ const float ah1=hi?g1[g]:og1[g], ah0=hi?og1[g]:g1[g]; const float t1=run; run*=ah1; const float t0=run; run*=ah0; T1[g]=hi?t1:t0; }
      #pragma unroll
      for(int g=3;g>=0;--g){ const float ah1=hi?g0[g]:og0[g], ah0=hi?og0[g]:g0[g]; const float t1=run; run*=ah1; const float t0=run; run*=ah0; T0[g]=hi?t1:t0; }
      R=run;
      #pragma unroll
      for(int g=0;g<4;++g){ float a0=T0[g],a1=T1[g];
        #pragma unroll
        for(int i=3;i>=0;--i){ const int r=4*g+i; p0[r]*=a0; p1[r]*=a1; a0*=s0[r]; a1*=s1[r]; } }
      u32x4 pw0,pw1,pw2,pw3;
      pw0=(u32x4){cvtpk_s(p0[0],p0[1]),cvtpk_s(p0[2],p0[3]),cvtpk_s(p0[4],p0[5]),cvtpk_s(p0[6],p0[7])};
      pw1=(u32x4){cvtpk_s(p0[8],p0[9]),cvtpk_s(p0[10],p0[11]),cvtpk_s(p0[12],p0[13]),cvtpk_s(p0[14],p0[15])};
      pw2=(u32x4){cvtpk_s(p1[0],p1[1]),cvtpk_s(p1[2],p1[3]),cvtpk_s(p1[4],p1[5]),cvtpk_s(p1[6],p1[7])};
      pw3=(u32x4){cvtpk_s(p1[8],p1[9]),cvtpk_s(p1[10],p1[11]),cvtpk_s(p1[12],p1[13]),cvtpk_s(p1[14],p1[15])};
      pv(o,vb0+slot,__builtin_bit_cast(bf16x8,pw0),__builtin_bit_cast(bf16x8,pw1),__builtin_bit_cast(bf16x8,pw2),__builtin_bit_cast(bf16x8,pw3));
      done=__all(R<1.0e-37f)!=0;
    }
    if(lane==0)flags[wid]=done?1u:0u;
    asm volatile("s_waitcnt lgkmcnt(0)\n\ts_barrier":::"memory");
    unsigned alld=1u;
    #pragma unroll
    for(int w=0;w<NW;++w)alld&=flags[w];
    slot^=SLOTB;
    if(alld)break;
  }
  asm volatile("s_waitcnt vmcnt(0)":::"memory");
  bf16*Ow=O+(rowbase+q0+wid*QBLK)*DMO;
  { bf16*stg=(bf16*)(shm+LDS_OST)+wid*2048;
    #pragma unroll
    for(int r=0;r<16;++r){const int orow=crow(r,hi);
      #pragma unroll
      for(int d0=0;d0<2;++d0)stg[orow*64+d0*32+r32]=__float2bfloat16(o[d0][r]);}
    asm volatile("s_waitcnt lgkmcnt(0)":::"memory");
    #pragma unroll
    for(int i=0;i<4;++i){const int row=i*8+(lane>>3),ch=lane&7; const u32x4 v=*(const u32x4*)(stg+row*64+ch*8); ATTN_STORE16(Ow+(long)row*DMO+ch*8,head_rms(v));} }
  asm volatile("s_waitcnt vmcnt(0) lgkmcnt(0)\n\ts_barrier":::"memory");
  #undef DMA_K
  #undef DMA_V
}
#undef SBAR
#undef WAIT_BAR
}
namespace cg = cooperative_groups;
constexpr int NWAVES = 8;
constexpr int DMODEL = 1024, NBATCH = 4, SEQ_IN = 8192, NMETA = 16, LREAL = NMETA + SEQ_IN, LP = 8448  ;
constexpr int MROWS = NBATCH * LP;
constexpr int MREAL = NBATCH * SEQ_IN;
constexpr int INW = 2566, NINP = 2560, NIN = 2816, DFF = 2816, NGU = 2 * DFF, DEPTH = 2, NFH = 6;
constexpr float C2F = 0.125f * 1.4426950408889634f;
constexpr int PC_U = 0, PC_FQ = 256, PC_FK = 640, PC_FV = 1024, PC_SQ = 1408, PC_SK = 1792, PC_SV = 2176;
constexpr size_t MiB = 1u << 20;
constexpr size_t WS_CTL = 0, CTL_ZERO_BYTES = 1 * MiB;
constexpr size_t WS_SS = 64 * 1024;
constexpr size_t WS_W = 1 * MiB, W_LAYER = 24 * MiB, W_IN = 0, W_OUT = (size_t)NIN * 1024 * 2, W_GU = W_OUT + 2 * MiB, W_D = W_GU + (size_t)NGU * 1024 * 2;
constexpr size_t WS_LF = 49 * MiB, WS_CS = 51 * MiB, WS_H = 52 * MiB, WS_HB = 184 * MiB, WS_Y = 250 * MiB, WS_P = 316 * MiB, WS_END = WS_P + (size_t)MROWS * DFF * 2;
static_assert(W_D + (size_t)1024 * DFF * 2 <= W_LAYER && WS_W + 2 * W_LAYER <= WS_LF && WS_SS + 5 * (size_t)MROWS * 4 <= CTL_ZERO_BYTES, "ws map");
static_assert(WS_H + (size_t)MROWS * 1024 * 4 <= WS_HB && WS_HB + (size_t)MROWS * 1024 * 2 <= WS_Y && WS_Y + (size_t)MROWS * 1024 * 2 <= WS_P && WS_END <= 512 * MiB, "ws map");
constexpr int LDS_BYTES = 147456;
constexpr int LDS_MISC = 131072;

#define LAS __attribute__((address_space(3)))
typedef unsigned short bf16u;
typedef unsigned v4u __attribute__((ext_vector_type(4)));
typedef float f32x4 __attribute__((ext_vector_type(4)));
#define LDS_WAIT() asm volatile("s_waitcnt lgkmcnt(0)" ::: "memory")
__device__ __forceinline__ unsigned f2bf(float f) { unsigned u = __builtin_bit_cast(unsigned, f); return (u + 0x7fffu + ((u >> 16) & 1u)) >> 16; }
__device__ __forceinline__ unsigned pk2(float lo, float hi) { return f2bf(lo) | (f2bf(hi) << 16); }
__device__ __forceinline__ float wave_sum(float v) {
#pragma unroll
    for (int o = 1; o < 64; o <<= 1) v += __shfl_xor(v, o);
    return v;
}

struct Args { const float* in[15]; float* out; unsigned char* ws; };

struct WinSrc { const float* w; const float* g;
    __device__ __forceinline__ float operator()(int k, int n) const { if (n >= INW) return 0.f; const int col = n < 1408 ? n : (n < 2560 ? n + 6 : n - 2560 + 1408);
        const float sc = ((n >= PC_FQ && n < PC_FK) || (n >= PC_SQ && n < PC_SK)) ? C2F : 1.0f; return w[(size_t)k * INW + col] * g[k] * sc; } };
struct WoutSrc { const float* w; const float* fg; const float* sg;
    __device__ __forceinline__ float operator()(int k, int n) const { const float gn = k < 640 ? fg[k - 256] : sg[k - 640]; return w[(size_t)k * 1024 + n] * gn; } };
struct WguSrc { const float* wg; const float* wu; const float* g;
    __device__ __forceinline__ float operator()(int k, int c) const { const int pn = c >> 8, w = c & 255, j = pn * 128 + (w & 127); const long dlt = (w >> 7) ? (long)(wu - wg) : 0L; return wg[(long)k * DFF + j + dlt] * g[k]; } };
struct WdSrc { const float* w;
    __device__ __forceinline__ float operator()(int k, int n) const { return w[(size_t)k * 1024 + n]; } };
template <class F> __device__ __forceinline__ void conv_item(const F src, bf16u* WT, int K, int k0, int n0, LAS float* scr, int lane) {
    float tv[32];
#pragma unroll
    for (int i = 0; i < 32; ++i) tv[i] = src(k0 + 2 * i + (lane >> 5), n0 + (lane & 31));
#pragma unroll
    for (int i = 0; i < 32; ++i) scr[(2 * i + (lane >> 5)) * 33 + (lane & 31)] = tv[i];
    LDS_WAIT(); asm volatile("" ::: "memory");
    const int c = lane & 7;
#pragma unroll
    for (int j = 0; j < 4; ++j) { const int n = (lane >> 3) + 8 * j; const LAS float* s = scr + (8 * c) * 33 + n;
        v4u o; o.x = pk2(s[0 * 33], s[1 * 33]); o.y = pk2(s[2 * 33], s[3 * 33]); o.z = pk2(s[4 * 33], s[5 * 33]); o.w = pk2(s[6 * 33], s[7 * 33]);
        *(v4u*)(WT + (size_t)(n0 + n) * K + k0 + 8 * c) = o; }
    LDS_WAIT(); asm volatile("" ::: "memory");
}
__device__ __forceinline__ void fold_item(const float* wout, const float* pw, const float* ps, bf16u* WT, int item, int lane) {
    const int g = item >> 4, n = (item & 15) * 64 + lane;
    float acc[64];
#pragma unroll
    for (int c = 0; c < 64; ++c) acc[c] = 0.f;
    for (int d = 0; d < 64; ++d) { const float wv = wout[(size_t)(g * 64 + d) * 1024 + n] * ps[g * 64 + d];
#pragma unroll
        for (int c = 0; c < 64; ++c) acc[c] += pw[(g * 64 + c) * 64 + d] * wv; }
    bf16u* o = WT + (size_t)n * 1024 + g * 64;
#pragma unroll
    for (int c = 0; c < 64; c += 8) { v4u w; w.x = pk2(acc[c], acc[c + 1]); w.y = pk2(acc[c + 2], acc[c + 3]); w.z = pk2(acc[c + 4], acc[c + 5]); w.w = pk2(acc[c + 6], acc[c + 7]); *(v4u*)(o + c) = w; }
}
__device__ __forceinline__ void p0_prologue(const Args& A, unsigned char* ws, LAS unsigned char* lds, int wave, int lane) {
    LAS float* scr = (LAS float*)(lds + wave * 16384);
    const int gw = blockIdx.x * NWAVES + wave, NGW = gridDim.x * NWAVES;
    constexpr int I_IN = 16 * (NIN / 32), I_OUT = 12 * 32, I_GU = 16 * (NGU / 32), I_D = (DFF / 64) * 32, I_F = 64, I_L = I_IN + I_OUT + I_GU + I_D + I_F;
    for (int it = gw; it < DEPTH * I_L; it += NGW) {
        const int L = it / I_L; int r = it % I_L;
        bf16u* wb = (bf16u*)(ws + WS_W + (size_t)L * W_LAYER);
        if (r < I_IN) { WinSrc s{A.in[3] + (size_t)L * 1024 * INW, A.in[2] + L * 1024}; conv_item(s, (bf16u*)((unsigned char*)wb + W_IN), 1024, (r / (NIN / 32)) * 64, (r % (NIN / 32)) * 32, scr, lane); continue; } r -= I_IN;
        if (r < I_OUT) { WoutSrc s{A.in[9] + (size_t)L * 1024 * 1024, A.in[7] + L * 384, A.in[8] + L * 384}; conv_item(s, (bf16u*)((unsigned char*)wb + W_OUT), 1024, 256 + (r / 32) * 64, (r % 32) * 32, scr, lane); continue; } r -= I_OUT;
        if (r < I_GU) { WguSrc s{A.in[11] + (size_t)L * 1024 * DFF, A.in[12] + (size_t)L * 1024 * DFF, A.in[10] + L * 1024}; conv_item(s, (bf16u*)((unsigned char*)wb + W_GU), 1024, (r / (NGU / 32)) * 64, (r % (NGU / 32)) * 32, scr, lane); continue; } r -= I_GU;
        if (r < I_D) { WdSrc s{A.in[13] + (size_t)L * DFF * 1024}; conv_item(s, (bf16u*)((unsigned char*)wb + W_D), DFF, (r / 32) * 64, (r % 32) * 32, scr, lane); continue; } r -= I_D;
        fold_item(A.in[9] + (size_t)L * 1024 * 1024, A.in[5] + (size_t)L * 4 * 64 * 64, A.in[6] + L * 256, (bf16u*)((unsigned char*)wb + W_OUT), r, lane);
    }
    bf16u* hb = (bf16u*)(ws + WS_HB); float* ss0 = (float*)(ws + WS_SS);
    for (int m = gw; m < MROWS; m += NGW) {
        const int b = m / LP, t = m % LP;
        f32x4 v[4]; float s = 0.f;
        if (t < LREAL) { const f32x4* src = (const f32x4*)(t < NMETA ? A.in[1] + (size_t)t * 1024 : A.in[0] + ((size_t)b * SEQ_IN + (t - NMETA)) * 1024) + lane;
#pragma unroll
            for (int j = 0; j < 4; ++j) { v[j] = src[64 * j]; s += (v[j].x * v[j].x + v[j].y * v[j].y) + (v[j].z * v[j].z + v[j].w * v[j].w); } }
        else {
#pragma unroll
            for (int j = 0; j < 4; ++j) v[j] = (f32x4){0.f, 0.f, 0.f, 0.f}; }
        s = wave_sum(s);
        unsigned long long* bo = (unsigned long long*)(hb + (size_t)m * 1024) + lane;
#pragma unroll
        for (int j = 0; j < 4; ++j) { bo[64 * j] = (unsigned long long)pk2(v[j].x, v[j].y) | ((unsigned long long)pk2(v[j].z, v[j].w) << 32); }
        if (lane == 0) ss0[m] = s;
    }
}
typedef short bf16x8m __attribute__((ext_vector_type(8)));
template <int NBK> __device__ __forceinline__ void mini_item(f32x4 (&acc)[NBK], const bf16u* A16, const bf16u* Bt0, const bf16u* Bt1, int K, LAS unsigned char* lds, int wave, int lane) {
    const int fr = lane & 15, fq = lane >> 4, kw = K >> 3; const size_t o = (size_t)fr * K + wave * kw + 8 * fq;
#pragma unroll
    for (int nb = 0; nb < NBK; ++nb) acc[nb] = (f32x4){0.f, 0.f, 0.f, 0.f};
    for (int k = 0; k < kw; k += 32) { const bf16x8m a = *(const bf16x8m*)(A16 + o + k); const bf16x8m b0 = *(const bf16x8m*)(Bt0 + o + k);
        acc[0] = __builtin_amdgcn_mfma_f32_16x16x32_bf16(b0, a, acc[0], 0, 0, 0);
        if (NBK == 2) { const bf16x8m b1 = *(const bf16x8m*)(Bt1 + o + k); acc[NBK - 1] = __builtin_amdgcn_mfma_f32_16x16x32_bf16(b1, a, acc[NBK - 1], 0, 0, 0); } }
    LAS f32x4* red = (LAS f32x4*)lds;
#pragma unroll
    for (int nb = 0; nb < NBK; ++nb) red[(nb * 8 + wave) * 64 + lane] = acc[nb];
    __syncthreads();
    if (wave == 0) {
#pragma unroll
        for (int nb = 0; nb < NBK; ++nb) { f32x4 s = red[(nb * 8) * 64 + lane];
#pragma unroll
            for (int w = 1; w < 8; ++w) s += red[(nb * 8 + w) * 64 + lane];
            acc[nb] = s; } }
    __syncthreads();
}
__device__ __forceinline__ void mini_in(unsigned char* ws, const bf16u* wt, const float* ss, const float* fb, LAS unsigned char* lds, int wave, int lane) {
    const bf16u* A16 = (const bf16u*)(ws + WS_HB); bf16u* P = (bf16u*)(ws + WS_P); float* LF = (float*)(ws + WS_LF);
    const int half = gridDim.x / 2; if ((int)blockIdx.x < half) return;
    for (int it = blockIdx.x - half; it < 161; it += gridDim.x - half) { const int n0 = it * 16; f32x4 acc[1];
        mini_item<1>(acc, A16, wt + (size_t)n0 * 1024, nullptr, 1024, lds, wave, lane);
        if (wave == 0) { const int fr = lane & 15, fq = lane >> 4; const float rs = __builtin_amdgcn_rsqf(ss[fr] * (1.0f / 1024.0f) + 1e-6f); const f32x4 v = acc[0] * rs;
            if (n0 < NINP) { const unsigned long long w = (unsigned long long)pk2(v[0], v[1]) | ((unsigned long long)pk2(v[2], v[3]) << 32);
#pragma unroll
                for (int b = 0; b < NBATCH; ++b) *(unsigned long long*)(P + ((size_t)b * LP + fr) * NINP + n0 + 4 * fq) = w; }
            else if (fq < 2) { f32x4 l;
#pragma unroll
                for (int i = 0; i < 4; ++i) { const int c = 4 * fq + i; const float x = v[i] + fb[c < NFH ? c : 0]; l[i] = c < NFH ? -(fmaxf(-x, 0.f) + log1pf(expf(-fabsf(x)))) * 1.4426950408889634f : 0.f; }
#pragma unroll
                for (int b = 0; b < NBATCH; ++b) *(f32x4*)(LF + ((size_t)b * LP + fr) * 8 + 4 * fq) = l; } }
    }
}
__device__ __forceinline__ void mini_res(unsigned char* ws, const bf16u* A16, const bf16u* wt, int K, float* ssn, LAS unsigned char* lds, int wave, int lane) {
    bf16u* hb = (bf16u*)(ws + WS_HB);
    for (int it = blockIdx.x; it < 64; it += gridDim.x) { const int n0 = it * 16; f32x4 acc[1];
        mini_item<1>(acc, A16, wt + (size_t)n0 * K, nullptr, K, lds, wave, lane);
        if (wave == 0) { const int fr = lane & 15, fq = lane >> 4; unsigned long long* bp = (unsigned long long*)(hb + (size_t)fr * 1024 + n0 + 4 * fq); const unsigned long long r = *bp; const unsigned rl = (unsigned)r, rh = (unsigned)(r >> 32);
            const f32x4 a = (f32x4){__uint_as_float(rl << 16), __uint_as_float(rl & 0xffff0000u), __uint_as_float(rh << 16), __uint_as_float(rh & 0xffff0000u)} + acc[0];
            *bp = (unsigned long long)pk2(a[0], a[1]) | ((unsigned long long)pk2(a[2], a[3]) << 32);
            float s = (a[0] * a[0] + a[1] * a[1]) + (a[2] * a[2] + a[3] * a[3]); s += __shfl_xor(s, 16); s += __shfl_xor(s, 32);
            if (fq == 0) atomicAdd(ssn + fr, s); }
    }
}
__device__ __forceinline__ void mini_gu(unsigned char* ws, const bf16u* wt, const float* ss, LAS unsigned char* lds, int wave, int lane) {
    const bf16u* A16 = (const bf16u*)(ws + WS_HB); bf16u* H = (bf16u*)(ws + WS_P);
    for (int it = blockIdx.x; it < DFF / 16; it += gridDim.x) { const int j0 = it * 16, cg = (j0 >> 7) * 256 + (j0 & 127); f32x4 acc[2];
        mini_item<2>(acc, A16, wt + (size_t)cg * 1024, wt + (size_t)(cg + 128) * 1024, 1024, lds, wave, lane);
        if (wave == 0) { const int fr = lane & 15, fq = lane >> 4; const float rs = __builtin_amdgcn_rsqf(ss[fr] * (1.0f / 1024.0f) + 1e-6f); float o[4];
#pragma unroll
            for (int i = 0; i < 4; ++i) { const float g = acc[0][i] * rs, up = acc[1][i] * rs; o[i] = g * __builtin_amdgcn_rcpf(1.0f + __builtin_amdgcn_exp2f(-1.4426950408889634f * g)) * up; }
            *(unsigned long long*)(H + (size_t)fr * DFF + j0 + 4 * fq) = (unsigned long long)pk2(o[0], o[1]) | ((unsigned long long)pk2(o[2], o[3]) << 32); }
    }
}
__device__ __forceinline__ void pool_scan_phase(unsigned char* ws, LAS unsigned char* lds, unsigned* nrm, int tid, int wave, int lane) {
    const float* LF = (const float*)(ws + WS_LF); float* CS = (float*)(ws + WS_CS);
    if (blockIdx.x < NBATCH * NFH) {
        const int b = blockIdx.x / NFH, hf = blockIdx.x % NFH; constexpr int PER = 17;
        const float* lf = LF + (size_t)b * LP * 8 + hf; float* cs = CS + (size_t)(b * NFH + hf) * LP;
        float v[PER]; float s = 0.f; const int t0 = tid * PER;
#pragma unroll
        for (int i = 0; i < PER; ++i) { const int t = t0 + i; const float x = t < LREAL ? lf[(size_t)t * 8] : 0.f; s += x; v[i] = s; }
        float incl = s;
#pragma unroll
        for (int o = 1; o < 64; o <<= 1) { const float n = __shfl_up(incl, o); if (lane >= o) incl += n; }
        LAS float* wsum = (LAS float*)(lds + LDS_MISC + 256);
        if (lane == 63) wsum[wave] = incl;
        __syncthreads();
        float off = 0.f;
        for (int w = 0; w < wave; ++w) off += wsum[w];
        const float excl = off + incl - s;
#pragma unroll
        for (int i = 0; i < PER; ++i) { const int t = t0 + i; if (t < LREAL) cs[t] = excl + v[i]; }
        __syncthreads();
    }
    const bf16u* P = (const bf16u*)(ws + WS_P); bf16u* Y = (bf16u*)(ws + WS_Y);
    for (int sl = blockIdx.x; sl < 256; sl += gridDim.x) {
        if (tid < 480) { const int sub = tid / 96, task = tid % 96, which = task / 48, head = (task % 48) >> 3, chunk = task & 7; const int r0 = sl * (MROWS / 256), b = r0 / LP;
            const bf16u* src = P + (which ? PC_FK : PC_FQ) + head * 64 + chunk * 8; float mx = 0.f;
#pragma unroll 9
            for (int r = sub; r < MROWS / 256; r += 5) { const v4u w = ((r0 + r) % LP < LREAL) ? *(const v4u*)(src + (size_t)(r0 + r) * NINP) : (v4u){0u, 0u, 0u, 0u}; float s = 0.f;
#pragma unroll
                for (int e = 0; e < 4; ++e) { const float lo = __uint_as_float(w[e] << 16), hi = __uint_as_float(w[e] & 0xffff0000u); s += lo * lo + hi * hi; }
                s += __shfl_xor(s, 1); s += __shfl_xor(s, 2); s += __shfl_xor(s, 4); mx = fmaxf(mx, s); }
            if (chunk == 0) atomicMax(nrm + (b * NFH + head) * 2 + which, __float_as_uint(mx)); }
    }
    const int rsub = tid >> 5, ch = (tid & 31) * 8, win = 2 << (ch >> 6);
    for (int c = blockIdx.x; c < MROWS / 16; c += gridDim.x) {
        const int row = c * 16 + rsub, t = row % LP; const int cnt = (t + 1 < win) ? t + 1 : win;
        float acc[8], self[8];
#pragma unroll
        for (int e = 0; e < 8; ++e) acc[e] = 0.f;
        v4u wv[16];
#pragma unroll
        for (int j = 0; j < 16; ++j) wv[j] = (j < cnt) ? *(const v4u*)(P + (size_t)(row - j) * NINP + PC_U + ch) : (v4u){0u, 0u, 0u, 0u};
#pragma unroll
        for (int j = 0; j < 16; ++j) {
#pragma unroll
            for (int e = 0; e < 4; ++e) { const float lo = __uint_as_float(wv[j][e] << 16), hi = __uint_as_float(wv[j][e] & 0xffff0000u); acc[2 * e] += lo; acc[2 * e + 1] += hi; if (j == 0) { self[2 * e] = lo; self[2 * e + 1] = hi; } } }
        const float inv = 1.0f / (float)cnt; v4u o;
#pragma unroll
        for (int e = 0; e < 4; ++e) o[e] = pk2(acc[2 * e] * inv - self[2 * e], acc[2 * e + 1] * inv - self[2 * e + 1]);
        *(v4u*)(Y + (size_t)row * 1024 + ch) = o;
    }
}
__device__ __forceinline__ void attn_phase(unsigned char* ws, unsigned char* lds_g, unsigned* ctr, const unsigned* nrm, int tid) {
    const attn_body::bf16* P = (const attn_body::bf16*)(ws + WS_P); attn_body::bf16* Y = (attn_body::bf16*)(ws + WS_Y); const float* CS = (const float*)(ws + WS_CS);
    volatile LAS unsigned* bw = (volatile LAS unsigned*)((LAS unsigned char*)lds_g + LDS_MISC);
    constexpr int NU = NBATCH * NFH * (LP / 256);
    for (;;) {
        if (tid == 0) bw[0] = atomicAdd(ctr, 1u);
        __syncthreads();
        const int it = (int)bw[0];
        __syncthreads();
        if (it >= 2 * NU) break;
        const int r = it < NU ? it : it - NU; const int qb = (LP / 256 - 1) - r / (NBATCH * NFH), bh = r % (NBATCH * NFH), b = bh / NFH, h = bh % NFH;
#ifndef NO_FOX
        if (it < NU) attn_body::fox_unit<8>(b, qb, 154.0f + 2.0f * sqrtf(__uint_as_float(nrm[bh * 2]) * __uint_as_float(nrm[bh * 2 + 1])), P + PC_FQ + h * 64, P + PC_FK + h * 64, P + PC_FV + h * 64, Y + 256 + h * 64, CS + (size_t)bh * LP, (char*)lds_g);
#endif
#ifndef NO_SB
        if (it >= NU) attn_body::sb_unit(b, qb, P + PC_SQ + h * 64, P + PC_SK + h * 64, P + PC_SV + h * 64, Y + 640 + h * 64, (char*)lds_g);
#endif
    }
}
__device__ __forceinline__ void final_phase(const Args& A, unsigned char* ws, int wave, int lane) {
    const float* h = (const float*)(ws + WS_H); const float* ss = (const float*)(ws + WS_SS) + 4 * (size_t)MROWS; const f32x4* g = (const f32x4*)A.in[14] + lane;
    const int gw = blockIdx.x * NWAVES + wave, NGW = gridDim.x * NWAVES;
    f32x4 gv[4];
#pragma unroll
    for (int j = 0; j < 4; ++j) gv[j] = g[64 * j];
    for (int m = gw; m < NBATCH * SEQ_IN; m += NGW) {
        const int b = m / SEQ_IN, s = m % SEQ_IN; const size_t row = (size_t)b * LP + NMETA + s;
        const float rs = 1.0f / sqrtf(ss[row] * (1.0f / 1024.0f) + 1e-6f);
        const f32x4* src = (const f32x4*)(h + row * 1024) + lane; f32x4* dst = (f32x4*)(A.out + (size_t)m * 1024) + lane;
#pragma unroll
        for (int j = 0; j < 4; ++j) dst[64 * j] = src[64 * j] * rs * gv[j];
    }
}

#define XB_TMO      128
#define XB_XCNT(j)  (256  + 64 * (j))
#define XB_XSUB(j)  (1280 + 64 * (j))
#define XB_XGEN(j)  (2304 + 64 * (j))
#define XB_TOP      3328
#define XB_TOPGEN   3392
#define XCD_BAR_WORDS 3456
#define XB_SPIN_CAP (1u << 18)

__device__ __forceinline__ unsigned xb_ld(unsigned* p)              { return __hip_atomic_load(p, __ATOMIC_RELAXED, __HIP_MEMORY_SCOPE_AGENT); }
__device__ __forceinline__ unsigned xb_add(unsigned* p, unsigned v) { return __hip_atomic_fetch_add(p, v, __ATOMIC_RELAXED, __HIP_MEMORY_SCOPE_AGENT); }
__device__ __forceinline__ unsigned xb_xcc_id() { return (unsigned)__builtin_amdgcn_s_getreg((3 << 11) | 20) & 0xFu; }
#define XB_SPIN(cond, bar) do { unsigned _sp = 0; while (cond) { __builtin_amdgcn_s_sleep(1); \
    if ((++_sp & 255u) == 0u) { if (xb_ld(&(bar)[XB_TMO])) break; if (_sp > XB_SPIN_CAP) { atomicAdd(&(bar)[XB_TMO], 1u); break; } } } } while (0)

struct XcdBarrier {
    unsigned* bar; unsigned x;
    volatile LAS unsigned* st;
};

__device__ __forceinline__ XcdBarrier xcd_barrier_post(unsigned* bar, volatile LAS unsigned* st) {
    XcdBarrier b; b.bar = bar; b.x = xb_xcc_id(); b.st = st;
    if (threadIdx.x == 0) (void)xb_add(&bar[XB_XCNT(b.x)], 1u);
    return b;
}
__device__ __forceinline__ void xcd_barrier_complete(unsigned* bar, unsigned x, unsigned& nloc, unsigned& nx) {
    const unsigned G = gridDim.x * gridDim.y * gridDim.z;
    unsigned sum, cnt, mine, sp = 0u;
    for (;;) {
        sum = 0u; cnt = 0u; mine = 0u;
#pragma unroll
        for (unsigned j = 0; j < 16; ++j) { const unsigned c = xb_ld(&bar[XB_XCNT(j)]); sum += c; cnt += (c > 0u) ? 1u : 0u; mine = (j == x) ? c : mine; }
        if (sum == G) break;
        __builtin_amdgcn_s_sleep(1);
        if ((++sp & 255u) == 0u) { if (xb_ld(&bar[XB_TMO])) break; if (sp > XB_SPIN_CAP) { atomicAdd(&bar[XB_TMO], 1u); break; } }
    }
    nloc = mine > 0u ? mine : 1u; nx = cnt > 0u ? cnt : 1u;
}

__device__ __forceinline__ void xcd_barrier(const XcdBarrier& b) {
    asm volatile("s_waitcnt vmcnt(0)" ::: "memory");
    __syncthreads();
    if (threadIdx.x == 0) {
        unsigned* bar = b.bar;
        __builtin_amdgcn_s_waitcnt(0);
        unsigned nloc = b.st[0], nx = b.st[1];
        if (nloc == 0u) { xcd_barrier_complete(bar, b.x, nloc, nx); b.st[0] = nloc; b.st[1] = nx; }
        const unsigned old = xb_add(&bar[XB_XSUB(b.x)], 1u);
        const unsigned gen = old / nloc;
        if (old + 1u == (gen + 1u) * nloc) {
            __builtin_amdgcn_fence(__ATOMIC_RELEASE, "agent");
            asm volatile("s_waitcnt vmcnt(0)" ::: "memory");
            const unsigned og = xb_add(&bar[XB_TOP], 1u);
            const unsigned tg = og / nx;
            if (og + 1u == (tg + 1u) * nx) xb_add(&bar[XB_TOPGEN], 1u);
            else XB_SPIN(xb_ld(&bar[XB_TOPGEN]) == tg, bar);
            __builtin_amdgcn_fence(__ATOMIC_ACQUIRE, "agent");
            xb_add(&bar[XB_XGEN(b.x)], 1u);
            asm volatile("s_waitcnt vmcnt(0)" ::: "memory");
        } else {
            XB_SPIN(xb_ld(&bar[XB_XGEN(b.x)]) == gen, bar);
            __builtin_amdgcn_fence(__ATOMIC_ACQUIRE, "agent");
            asm volatile("s_waitcnt vmcnt(0)" ::: "memory");
        }
    }
    __syncthreads();
}

#define FRESH() unsigned long zoff_ = 0; asm volatile("" : "+s"(zoff_)); unsigned char* ws = A.ws + zoff_; int tid = threadIdx.x; asm volatile("" : "+v"(tid)); const int lane = tid & 63, wave = __builtin_amdgcn_readfirstlane(tid >> 6); (void)lane; (void)wave
#ifdef PROBE
#define STAMP() do { if (blockIdx.x == 0 && threadIdx.x == 0) { ((volatile unsigned long long*)(A.ws + WS_CTL + 8192))[nst] = __builtin_amdgcn_s_memrealtime(); } ++nst; } while (0)
#else
#define STAMP() do {} while (0)
#endif
__global__ void __launch_bounds__(NWAVES * 64, 2) hymba_fwd(Args A) {
    extern __shared__ __attribute__((aligned(16))) unsigned char lds[];
    cg::grid_group grid = cg::this_grid();
    LAS unsigned char* L = (LAS unsigned char*)lds;
    if (threadIdx.x < 2) ((volatile LAS unsigned*)(L + LDS_MISC + 64))[threadIdx.x] = 0u;
    __syncthreads();
    const XcdBarrier xbar = xcd_barrier_post((unsigned*)(A.ws + WS_CTL) + 4096, (volatile LAS unsigned*)(L + LDS_MISC + 64));
#define GRID_BAR() xcd_barrier(xbar)
#ifdef PROBE
    int nst = 0; STAMP();
    for (int i = 0; i < 8; ++i) GRID_BAR();
    STAMP();
#endif
#ifndef NO_PRO
    { FRESH(); p0_prologue(A, ws, L, wave, lane); }
#endif
    if (A.ws == nullptr) grid.sync();
    GRID_BAR(); STAMP();
    for (int layer = 0; layer < DEPTH; ++layer) {
#ifndef NO_G1
        {
            FRESH(); const unsigned char* wb = ws + WS_W + (size_t)layer * W_LAYER;
            pg8::Gemm g{(const pg8::bf16_t*)(ws + WS_HB), (const pg8::bf16_t*)(wb + W_IN), MREAL, NIN, 1024}; pg8::StaticOrder S; S.init(MREAL, NIN, (int)gridDim.x, (int)blockIdx.x);
            pg8::EpiIn E{(pg8::bf16_t*)(ws + WS_P), (float*)(ws + WS_LF), (const float*)(ws + WS_SS) + (size_t)(2 * layer) * MROWS, A.in[4] + layer * NFH};
            mini_in(ws, (const bf16u*)(wb + W_IN), (const float*)(ws + WS_SS) + (size_t)(2 * layer) * MROWS, A.in[4] + layer * NFH, L, wave, lane);
            pg8::gemm_phase<pg8::EpiIn, pg8::StaticOrder, true, true>(L, g, S, E);
        }
#endif
        GRID_BAR(); STAMP();
#ifndef NO_POOL
        { FRESH(); pool_scan_phase(ws, L, (unsigned*)(ws + WS_CTL) + 128 + 64 * layer, tid, wave, lane); }
#endif
        GRID_BAR(); STAMP();
        { FRESH(); attn_phase(ws, lds, (unsigned*)(ws + WS_CTL) + 64 * layer, (const unsigned*)(ws + WS_CTL) + 128 + 64 * layer, tid); }
        GRID_BAR(); STAMP();
#ifndef NO_G3
        {
            FRESH(); const unsigned char* wb = ws + WS_W + (size_t)layer * W_LAYER;
            pg8::Gemm g{(const pg8::bf16_t*)(ws + WS_Y), (const pg8::bf16_t*)(wb + W_OUT), MREAL, 1024, 1024}; pg8::StaticOrder S; S.init(MREAL, 1024, (int)gridDim.x, (int)blockIdx.x);
            pg8::EpiRes E{(pg8::bf16_t*)(ws + WS_HB), nullptr, (float*)(ws + WS_SS) + (size_t)(2 * layer + 1) * MROWS};
            mini_res(ws, (const bf16u*)(ws + WS_Y), (const bf16u*)(wb + W_OUT), 1024, (float*)(ws + WS_SS) + (size_t)(2 * layer + 1) * MROWS, L, wave, lane);
            pg8::gemm_phase<pg8::EpiRes, pg8::StaticOrder, true, true>(L, g, S, E);
        }
#endif
        GRID_BAR(); STAMP();
#ifndef NO_G4
        {
            FRESH(); const unsigned char* wb = ws + WS_W + (size_t)layer * W_LAYER;
            pg8::Gemm g{(const pg8::bf16_t*)(ws + WS_HB), (const pg8::bf16_t*)(wb + W_GU), MREAL, NGU, 1024}; pg8::StaticOrder S; S.init(MREAL, NGU, (int)gridDim.x, (int)blockIdx.x);
            pg8::EpiGU E{(pg8::bf16_t*)(ws + WS_P), (const float*)(ws + WS_SS) + (size_t)(2 * layer + 1) * MROWS};
            mini_gu(ws, (const bf16u*)(wb + W_GU), (const float*)(ws + WS_SS) + (size_t)(2 * layer + 1) * MROWS, L, wave, lane);
            pg8::gemm_phase<pg8::EpiGU, pg8::StaticOrder, true, true>(L, g, S, E);
        }
#endif
        GRID_BAR(); STAMP();
#ifndef NO_G5
        {
            FRESH(); const unsigned char* wb = ws + WS_W + (size_t)layer * W_LAYER;
            pg8::Gemm g{(const pg8::bf16_t*)(ws + WS_P), (const pg8::bf16_t*)(wb + W_D), MREAL, 1024, DFF}; pg8::StaticOrder S; S.init(MREAL, 1024, (int)gridDim.x, (int)blockIdx.x);
            pg8::EpiRes E{(pg8::bf16_t*)(ws + WS_HB), layer == DEPTH - 1 ? (float*)(ws + WS_H) : nullptr, (float*)(ws + WS_SS) + (size_t)(2 * layer + 2) * MROWS};
            mini_res(ws, (const bf16u*)(ws + WS_P), (const bf16u*)(wb + W_D), DFF, (float*)(ws + WS_SS) + (size_t)(2 * layer + 2) * MROWS, L, wave, lane);
            pg8::gemm_phase<pg8::EpiRes, pg8::StaticOrder, true, true>(L, g, S, E);
        }
#endif
        GRID_BAR(); STAMP();
    }
    { FRESH(); final_phase(A, ws, wave, lane); }
#ifdef PROBE
    STAMP();
    grid.sync();
    {
        volatile unsigned long long* T = (volatile unsigned long long*)(A.ws + WS_CTL + 8192);
        if (blockIdx.x == 0) {
            const unsigned long long dA = T[PA + 1] - T[PA], dB = T[PB + 1] - T[PB];
            for (unsigned long long i = threadIdx.x; i < dB; i += NWAVES * 64) A.out[i] += 0.125f;
            if (threadIdx.x == 0) { const unsigned long long t0 = __builtin_amdgcn_s_memrealtime(); while (__builtin_amdgcn_s_memrealtime() - t0 < dA) __builtin_amdgcn_s_sleep(8); }
        }
    }
#endif
}

extern "C" void kernel_launch(void* const* d_in, const int* in_sizes, int n_in, void* d_out, int out_size, void* d_ws, size_t ws_size, hipStream_t stream) {
    static int grid = 0;
    if (grid == 0) {
        if (n_in != 15 || out_size != NBATCH * SEQ_IN * DMODEL || ws_size < WS_END) { fprintf(stderr, "kernel_launch: unexpected shapes (n_in %d out %d ws %zu, need %zu)\n", n_in, out_size, ws_size, (size_t)WS_END); grid = -1; return; }
        int dev = 0, cus = 0, per_cu = 0;
        if (hipGetDevice(&dev) != hipSuccess || hipDeviceGetAttribute(&cus, hipDeviceAttributeMultiprocessorCount, dev) != hipSuccess) { grid = -1; return; }
        if (hipFuncSetAttribute((const void*)hymba_fwd, hipFuncAttributeMaxDynamicSharedMemorySize, LDS_BYTES) != hipSuccess) { fprintf(stderr, "kernel_launch: hipFuncSetAttribute failed\n"); grid = -1; return; }
        if (hipOccupancyMaxActiveBlocksPerMultiprocessor(&per_cu, (const void*)hymba_fwd, NWAVES * 64, LDS_BYTES) != hipSuccess || per_cu < 1) { fprintf(stderr, "kernel_launch: occupancy query says %d\n", per_cu); per_cu = 1; }
        (void)hipGetLastError();
        grid = cus;
    }
    if (grid < 0) return;
    if (hipMemsetAsync((char*)d_ws + WS_CTL, 0, CTL_ZERO_BYTES, stream) != hipSuccess) { fprintf(stderr, "kernel_launch: memset failed\n"); return; }
    Args a{};
    for (int i = 0; i < 15; ++i) a.in[i] = (const float*)d_in[i];
    a.out = (float*)d_out; a.ws = (unsigned char*)d_ws;
    void* args[] = {&a};
    const hipError_t e = hipLaunchCooperativeKernel((const void*)hymba_fwd, dim3(grid), dim3(NWAVES * 64), args, LDS_BYTES, stream);
    if (e != hipSuccess) fprintf(stderr, "kernel_launch: cooperative launch failed: %s (grid %d)\n", hipGetErrorString(e), grid);
}
```

```cpp
#include <hip/hip_runtime.h>
#include <hip/hip_cooperative_groups.h>
#include <cstdio>
#include <cstdint>
namespace pg8 {
#define PG8_LAS __attribute__((address_space(3)))
typedef unsigned short bf16_t;
typedef short bf16x8 __attribute__((ext_vector_type(8)));
typedef float f32x4 __attribute__((ext_vector_type(4)));
typedef unsigned u32x4 __attribute__((ext_vector_type(4)));
constexpr int BM = 256, BK = 64, HALF = 128, HTB = HALF * BK * 2  , STAGE_BYTES = 8 * HTB, NXCD = 8, WGM = 8;

__host__ __device__ __forceinline__ int lds_byte(int r, int c) { const int st = (r >> 4) * 2 + (c >> 5), rr = r & 15, cc = c & 31, ob = rr * 64 + cc * 2; return st * 1024 + (ob ^ (((ob >> 9) & 1) << 5)); }
__host__ __device__ __forceinline__ void stage_rc(int b, int& R, int& C) { const int st = b / 1024, sb = b % 1024, swz = sb ^ (((sb >> 9) & 1) << 5); R = (st >> 1) * 16 + swz / 64; C = (st & 1) * 32 + (swz % 64) / 2; }
__host__ __device__ __forceinline__ int perm32(int rho) { const int n = rho >> 4, i = rho & 15; return 8 * (i >> 2) + 4 * n + (i & 3); }

struct Unit { int pm, pn; };
__host__ __device__ __forceinline__ int arow(int pm) { return 256 * (pm + (pm >> 5)) + 16; }
struct Gemm { const bf16_t* A; const bf16_t* Bt; int M, N, K; };

struct StaticOrder {
    int nM, nN, nwg, G, c;
    __host__ __device__ void init(int M, int N, int G_, int c_) { nM = M / BM; nN = N / BM; nwg = nM * nN; G = G_; c = c_; }
    __host__ __device__ bool next(int i, Unit& u) const {
        const long L = (long)i * G + c; if (L >= nwg) return false;
        int wgid = (int)L; { const int q = nwg / NXCD, r = nwg % NXCD, xcd = wgid % NXCD, off = wgid / NXCD; wgid = (xcd < r ? xcd * (q + 1) : r * (q + 1) + (xcd - r) * q) + off; }
        const int nig = WGM * nN, gid = wgid / nig, fm = gid * WGM, gsz = (nM - fm) < WGM ? (nM - fm) : WGM;
        u.pm = fm + ((wgid % nig) % gsz); u.pn = (wgid % nig) / gsz; return true;
    }
    __device__ __forceinline__ void a_ready(const Unit&) const {}
    __device__ __forceinline__ void done(const Unit&) const {}
};

__device__ __forceinline__ unsigned cvt_pk_bf16(float lo, float hi) { unsigned r; asm volatile("v_cvt_pk_bf16_f32 %0, %1, %2" : "=v"(r) : "v"(lo), "v"(hi)); return r; }
typedef unsigned u32x2 __attribute__((ext_vector_type(2)));
constexpr float RMS_EPS = 1e-6f;
struct EpiIn {
    static constexpr bool PERM = true, AFTER_DRAIN = false;
    bf16_t* P; float* LF; const float* ss; const float* fb;
    __device__ __forceinline__ void operator()(const f32x4 (&acc)[2][2][4][2], const Unit& u, int wr, int wc, int fr, int fq) const {
        const int row0 = arow(u.pm) + wr * 64 + fr;
        if (u.pn < 10) {
            const int col0 = u.pn * BM + wc * 32 + 8 * fq;
#pragma unroll
            for (int ai = 0; ai < 2; ++ai)
#pragma unroll
                for (int m = 0; m < 4; ++m) { const int row = row0 + ai * HALF + m * 16; const float rs = __builtin_amdgcn_rsqf(ss[row] * (1.0f / 1024.0f) + RMS_EPS);
                    bf16_t* rowp = P + (size_t)row * 2560 + col0;
#pragma unroll
                    for (int bj = 0; bj < 2; ++bj) { const f32x4 v0 = acc[ai][bj][m][0] * rs, v1 = acc[ai][bj][m][1] * rs;
                        u32x4 w; w.x = cvt_pk_bf16(v0[0], v0[1]); w.y = cvt_pk_bf16(v0[2], v0[3]); w.z = cvt_pk_bf16(v1[0], v1[1]); w.w = cvt_pk_bf16(v1[2], v1[3]);
                        *(u32x4*)(rowp + bj * HALF) = w; } }
        } else if (wc == 0 && fq == 0) {
            float b[6];
#pragma unroll
            for (int j = 0; j < 6; ++j) b[j] = fb[j];
#pragma unroll
            for (int ai = 0; ai < 2; ++ai)
#pragma unroll
                for (int m = 0; m < 4; ++m) { const int row = row0 + ai * HALF + m * 16; const float rs = __builtin_amdgcn_rsqf(ss[row] * (1.0f / 1024.0f) + RMS_EPS);
                    const f32x4 v0 = acc[ai][0][m][0] * rs, v1 = acc[ai][0][m][1] * rs;
                    float x[6] = {v0[0] + b[0], v0[1] + b[1], v0[2] + b[2], v0[3] + b[3], v1[0] + b[4], v1[1] + b[5]};
                    float l[6];
#pragma unroll
                    for (int j = 0; j < 6; ++j) l[j] = -(fmaxf(-x[j], 0.f) + log1pf(expf(-fabsf(x[j])))) * 1.4426950408889634f;
                    *(f32x4*)(LF + (size_t)row * 8) = (f32x4){l[0], l[1], l[2], l[3]};
                    *(f32x4*)(LF + (size_t)row * 8 + 4) = (f32x4){l[4], l[5], 0.f, 0.f}; }
        }
    }
};
struct EpiRes {
    static constexpr bool PERM = true, AFTER_DRAIN = false;
    bf16_t* hb; float* hf; float* ssn;
    __device__ __forceinline__ void operator()(const f32x4 (&acc)[2][2][4][2], const Unit& u, int wr, int wc, int fr, int fq) const {
        const int row0 = arow(u.pm) + wr * 64 + fr, col0 = u.pn * BM + wc * 32 + 8 * fq;
#pragma unroll
        for (int ai = 0; ai < 2; ++ai)
#pragma unroll
            for (int m = 0; m < 4; ++m) { const int row = row0 + ai * HALF + m * 16; bf16_t* bp = hb + (size_t)row * 1024 + col0; float s = 0.f;
#pragma unroll
                for (int bj = 0; bj < 2; ++bj) { const u32x4 r = *(const u32x4*)(bp + bj * HALF);
                    f32x4 a = (f32x4){__uint_as_float(r.x << 16), __uint_as_float(r.x & 0xffff0000u), __uint_as_float(r.y << 16), __uint_as_float(r.y & 0xffff0000u)};
                    f32x4 b = (f32x4){__uint_as_float(r.z << 16), __uint_as_float(r.z & 0xffff0000u), __uint_as_float(r.w << 16), __uint_as_float(r.w & 0xffff0000u)};
                    a = a + acc[ai][bj][m][0]; b = b + acc[ai][bj][m][1];
                    if (hf) { float* hp = hf + (size_t)row * 1024 + col0 + bj * HALF; *(f32x4*)hp = a; *(f32x4*)(hp + 4) = b; }
                    s += (a[0] * a[0] + a[1] * a[1]) + (a[2] * a[2] + a[3] * a[3]) + (b[0] * b[0] + b[1] * b[1]) + (b[2] * b[2] + b[3] * b[3]);
                    u32x4 w; w.x = cvt_pk_bf16(a[0], a[1]); w.y = cvt_pk_bf16(a[2], a[3]); w.z = cvt_pk_bf16(b[0], b[1]); w.w = cvt_pk_bf16(b[2], b[3]);
                    *(u32x4*)(bp + bj * HALF) = w; }
                s += __shfl_xor(s, 16); s += __shfl_xor(s, 32);
                if (fq == 0) atomicAdd(ssn + row, s);
                asm volatile("" ::: "memory"); }
    }
};
struct EpiGU {
    static constexpr bool PERM = true, AFTER_DRAIN = false;
    bf16_t* H; const float* ss;
    __device__ __forceinline__ void operator()(const f32x4 (&acc)[2][2][4][2], const Unit& u, int wr, int wc, int fr, int fq) const {
        const int row0 = arow(u.pm) + wr * 64 + fr, col0 = u.pn * HALF + wc * 32 + 8 * fq;
#pragma unroll
        for (int ai = 0; ai < 2; ++ai)
#pragma unroll
            for (int m = 0; m < 4; ++m) { const int row = row0 + ai * HALF + m * 16; const float rs = __builtin_amdgcn_rsqf(ss[row] * (1.0f / 1024.0f) + RMS_EPS);
                float o[8];
#pragma unroll
                for (int n = 0; n < 2; ++n)
#pragma unroll
                    for (int e = 0; e < 4; ++e) { const float g = acc[ai][0][m][n][e] * rs, up = acc[ai][1][m][n][e] * rs;
                        o[4 * n + e] = g * __builtin_amdgcn_rcpf(1.0f + __builtin_amdgcn_exp2f(-1.4426950408889634f * g)) * up; }
                u32x4 w; w.x = cvt_pk_bf16(o[0], o[1]); w.y = cvt_pk_bf16(o[2], o[3]); w.z = cvt_pk_bf16(o[4], o[5]); w.w = cvt_pk_bf16(o[6], o[7]);
                *(u32x4*)(H + (size_t)row * 2816 + col0) = w; }
    }
};
template <class Epi, class Sched, bool ALIGN_EPI = false, bool SP2 = false>
__device__ __forceinline__ void gemm_phase(PG8_LAS unsigned char* lds, const Gemm g, const Sched& S, const Epi& E) {
    int tid_ = threadIdx.x; asm volatile("" : "+v"(tid_));
    const int tid = tid_, wid = __builtin_amdgcn_readfirstlane(tid >> 6), lane = tid & 63, wr = wid >> 2, wc = wid & 3, fr = lane & 15, fq = lane >> 4;
    const int K = g.K, nt = K / BK;
    unsigned voffA[2], voffB[2];
#pragma unroll
    for (int i = 0; i < 2; ++i) { int R, C; stage_rc(tid * 16 + i * 8192, R, C); const int Rb = Epi::PERM ? ((R & ~31) + perm32(R & 31)) : R;
        voffA[i] = (unsigned)(R * K + C) * 2u; voffB[i] = (unsigned)(Rb * K + C) * 2u; }
    const size_t kstep = (size_t)(BK * 2);
    const size_t hstep = (size_t)HALF * K * 2;
    const size_t tstep = 2 * hstep;
    const unsigned ldsw = (unsigned)wid * 1024u;
    const int aoff = lds_byte(wr * 64 + fr, fq * 8), boff = lds_byte(wc * 32 + fr, fq * 8);
#define PG8_SA(b, h) (((b) * 2 + (h)) * HTB)
#define PG8_SB(b, h) ((4 + (b) * 2 + (h)) * HTB)
#define PG8_STAGE(bufoff, gbase, voff) do { _Pragma("unroll") for (int _i = 0; _i < 2; ++_i) \
        __builtin_amdgcn_global_load_lds((const unsigned*)((const char*)(gbase) + (voff)[_i]), (PG8_LAS unsigned*)(lds + (bufoff) + ldsw + _i * 8192), 16, 0, 0); } while (0)
#define PG8_LDA(dst, b, h) do { _Pragma("unroll") for (int m = 0; m < 4; ++m) _Pragma("unroll") for (int k = 0; k < 2; ++k) dst[m][k] = *(const PG8_LAS bf16x8*)(lds + PG8_SA(b, h) + aoff + m * 2048 + k * 1024); } while (0)
#define PG8_LDB(dst, b, h) do { _Pragma("unroll") for (int n = 0; n < 2; ++n) _Pragma("unroll") for (int k = 0; k < 2; ++k) dst[n][k] = *(const PG8_LAS bf16x8*)(lds + PG8_SB(b, h) + boff + n * 2048 + k * 1024); } while (0)
#define PG8_MMA(ai, bj, At, Bt) do { __builtin_amdgcn_s_setprio(1); _Pragma("unroll") for (int m = 0; m < 4; ++m) _Pragma("unroll") for (int n = 0; n < 2; ++n) _Pragma("unroll") for (int k = 0; k < 2; ++k) \
        acc[ai][bj][m][n] = __builtin_amdgcn_mfma_f32_16x16x32_bf16(Bt[n][k], At[m][k], acc[ai][bj][m][n], 0, 0, 0); __builtin_amdgcn_s_setprio(0); } while (0)
#define PG8_WAIT_V(n) asm volatile("s_waitcnt vmcnt(" #n ")" ::: "memory")
#define PG8_WAIT_L(n) asm volatile("s_waitcnt lgkmcnt(" #n ")" ::: "memory")
#define PG8_BAR __builtin_amdgcn_s_barrier()
#define PG8_SCHED __builtin_amdgcn_sched_barrier(0)
    Unit cur, nxt; int ui = 0;
    if (!S.next(0, cur)) return;
    f32x4 acc[2][2][4][2];
#pragma unroll
    for (int a = 0; a < 2; ++a)
#pragma unroll
        for (int b = 0; b < 2; ++b)
#pragma unroll
            for (int m = 0; m < 4; ++m)
#pragma unroll
                for (int n = 0; n < 2; ++n) acc[a][b][m][n] = (f32x4){0.f, 0.f, 0.f, 0.f};
    bf16x8 At[4][2], B0[2][2], B1[2][2];
    const char* cA = (const char*)g.A + (size_t)arow(cur.pm) * K * 2; const char* cB = (const char*)g.Bt + (size_t)cur.pn * tstep;
    S.a_ready(cur);
    if constexpr (SP2) {
        PG8_STAGE(PG8_SB(0, 0), cB, voffB); PG8_STAGE(PG8_SB(0, 1), cB + hstep, voffB); PG8_STAGE(PG8_SA(0, 0), cA, voffA); PG8_STAGE(PG8_SA(0, 1), cA + hstep, voffA);
        if (wr == 1) PG8_BAR;
        PG8_WAIT_V(2); PG8_BAR;
        PG8_STAGE(PG8_SB(1, 0), cB + kstep, voffB); PG8_STAGE(PG8_SA(1, 0), cA + kstep, voffA); PG8_STAGE(PG8_SB(1, 1), cB + hstep + kstep, voffB);
        PG8_WAIT_V(6); PG8_BAR;
    } else {
        PG8_STAGE(PG8_SB(0, 0), cB, voffB); PG8_STAGE(PG8_SA(0, 0), cA, voffA); PG8_STAGE(PG8_SB(0, 1), cB + hstep, voffB); PG8_STAGE(PG8_SA(0, 1), cA + hstep, voffA);
        if (wr == 1) PG8_BAR;
        PG8_WAIT_V(4); PG8_BAR;
        PG8_STAGE(PG8_SB(1, 0), cB + kstep, voffB); PG8_STAGE(PG8_SA(1, 0), cA + kstep, voffA); PG8_STAGE(PG8_SB(1, 1), cB + hstep + kstep, voffB);
        PG8_WAIT_V(6); PG8_BAR;
    }
    for (;;) {
        const bool has_next = S.next(ui + 1, nxt);
        const char* nA = has_next ? (const char*)g.A + (size_t)arow(nxt.pm) * K * 2 : cA; const char* nB = has_next ? (const char*)g.Bt + (size_t)nxt.pn * tstep : cB;
        for (int t = 0; t < nt; t += 2) {
            const bool last = (t == nt - 2);
            const char* a1 = cA + (size_t)(t + 1) * kstep;
            const char* a2 = last ? nA : cA + (size_t)(t + 2) * kstep; const char* b2 = last ? nB : cB + (size_t)(t + 2) * kstep;
            const char* a3 = a2 + kstep; const char* b3 = b2 + kstep;
            if (last && has_next) S.a_ready(nxt);
            if constexpr (SP2) {
            PG8_LDB(B0, 0, 0); PG8_LDB(B1, 0, 1); PG8_SCHED; PG8_LDA(At, 0, 0); PG8_STAGE(PG8_SA(1, 1), a1 + hstep, voffA);
            PG8_WAIT_V(8); PG8_WAIT_L(0); PG8_BAR; PG8_MMA(0, 0, At, B0); PG8_MMA(0, 1, At, B1); PG8_BAR; PG8_SCHED;
            PG8_LDA(At, 0, 1); PG8_STAGE(PG8_SB(0, 0), b2, voffB); PG8_STAGE(PG8_SB(0, 1), b2 + hstep, voffB); PG8_STAGE(PG8_SA(0, 0), a2, voffA);
            PG8_WAIT_V(8); PG8_WAIT_L(0); PG8_BAR; PG8_MMA(1, 0, At, B0); PG8_MMA(1, 1, At, B1); PG8_BAR; PG8_SCHED;
            PG8_LDB(B0, 1, 0); PG8_LDB(B1, 1, 1); PG8_SCHED; PG8_LDA(At, 1, 0); PG8_STAGE(PG8_SA(0, 1), a2 + hstep, voffA);
            PG8_WAIT_V(8); PG8_WAIT_L(0); PG8_BAR; PG8_MMA(0, 0, At, B0); PG8_MMA(0, 1, At, B1); PG8_BAR; PG8_SCHED;
            PG8_LDA(At, 1, 1); PG8_STAGE(PG8_SB(1, 0), b3, voffB); PG8_STAGE(PG8_SB(1, 1), b3 + hstep, voffB); PG8_STAGE(PG8_SA(1, 0), a3, voffA);
            PG8_WAIT_V(8); PG8_WAIT_L(0); PG8_BAR; PG8_MMA(1, 0, At, B0); PG8_MMA(1, 1, At, B1); PG8_BAR; PG8_SCHED;
            } else {
            PG8_LDB(B0, 0, 0); PG8_SCHED; PG8_LDA(At, 0, 0); PG8_STAGE(PG8_SA(1, 1), a1 + hstep, voffA);
            PG8_WAIT_L(8); PG8_BAR; PG8_WAIT_L(0); PG8_MMA(0, 0, At, B0); PG8_BAR; PG8_SCHED;
            PG8_LDB(B1, 0, 1); PG8_STAGE(PG8_SB(0, 0), b2, voffB);
            PG8_BAR; PG8_WAIT_L(0); PG8_MMA(0, 1, At, B1); PG8_BAR;
            PG8_LDA(At, 0, 1); PG8_STAGE(PG8_SA(0, 0), a2, voffA);
            PG8_BAR; PG8_WAIT_L(0); PG8_MMA(1, 0, At, B0); PG8_BAR; PG8_SCHED;
            PG8_STAGE(PG8_SB(0, 1), b2 + hstep, voffB);
            PG8_WAIT_V(6); PG8_BAR; PG8_MMA(1, 1, At, B1); PG8_BAR;
            PG8_LDB(B0, 1, 0); PG8_SCHED; PG8_LDA(At, 1, 0); PG8_STAGE(PG8_SA(0, 1), a2 + hstep, voffA);
            PG8_WAIT_L(8); PG8_BAR; PG8_WAIT_L(0); PG8_MMA(0, 0, At, B0); PG8_BAR; PG8_SCHED;
            PG8_LDB(B1, 1, 1); PG8_STAGE(PG8_SB(1, 0), b3, voffB);
            PG8_BAR; PG8_WAIT_L(0); PG8_MMA(0, 1, At, B1); PG8_BAR;
            PG8_LDA(At, 1, 1); PG8_STAGE(PG8_SA(1, 0), a3, voffA);
            PG8_BAR; PG8_WAIT_L(0); PG8_MMA(1, 0, At, B0); PG8_BAR; PG8_SCHED;
            PG8_STAGE(PG8_SB(1, 1), b3 + hstep, voffB);
            PG8_WAIT_V(6); PG8_BAR; PG8_MMA(1, 1, At, B1); PG8_BAR;
            }
        }
        if constexpr (ALIGN_EPI) { if (wr == 0) PG8_BAR; }
        if constexpr (!Epi::AFTER_DRAIN) { E(acc, cur, wr, wc, fr, fq); S.done(cur); }
        if (!has_next) break;
#pragma unroll
        for (int a = 0; a < 2; ++a)
#pragma unroll
            for (int b = 0; b < 2; ++b)
#pragma unroll
                for (int m = 0; m < 4; ++m)
#pragma unroll
                    for (int n = 0; n < 2; ++n) acc[a][b][m][n] = (f32x4){0.f, 0.f, 0.f, 0.f};
        cur = nxt; cA = nA; cB = nB; ++ui;
        if constexpr (ALIGN_EPI) { if (wr == 1) PG8_BAR; }
    }
    PG8_WAIT_V(0);
    if constexpr (!ALIGN_EPI) { if (wr == 0) PG8_BAR; }
    PG8_BAR;
    if constexpr (Epi::AFTER_DRAIN) { E.fused(acc, cur, wr, wc, fr, fq, lds, wid, lane); S.done(cur); }
#undef PG8_SA
#undef PG8_SB
#undef PG8_STAGE
#undef PG8_LDA
#undef PG8_LDB
#undef PG8_MMA
#undef PG8_WAIT_V
#undef PG8_WAIT_L
#undef PG8_BAR
#undef PG8_SCHED
}
}
#include <hip/hip_bf16.h>
#include <cmath>
namespace attn_body {
using bf16=__hip_bfloat16;
using bf16x8=__attribute__((ext_vector_type(8)))short;
using s16x4=__attribute__((ext_vector_type(4)))short;
using f32x16=__attribute__((ext_vector_type(16)))float;
using u32x4=__attribute__((ext_vector_type(4)))unsigned;
constexpr int SEQ=8448,D=64,DM=2560,DMO=1024;
using f32x4=__attribute__((ext_vector_type(4)))float;
constexpr int NW=8,QBLK=32,QB=QBLK*NW,KVBLK=64,NQB=SEQ/QB;
constexpr int ATTN_UNIT_ROWS=QB;
__device__ __forceinline__ int crow(int r,int hi){return (r&3)+8*(r>>2)+4*hi;}
#define SBAR() __builtin_amdgcn_sched_barrier(0)
__device__ __forceinline__ void cmask(f32x16&p0,f32x16&p1,int jb,int qrel,int hi){
  const float NEG=-INFINITY; int kb=64*jb+4*hi;
  #pragma unroll
  for(int r=0;r<16;++r){int kv=kb+(r&3)+8*(r>>2); if(kv>qrel)p0[r]=NEG; if(kv+32>qrel)p1[r]=NEG;}
}

constexpr int NSLOT=3, SLOTB=8192;
constexpr int LDS_K=0, LDS_V=NSLOT*SLOTB, LDS_WS=2*NSLOT*SLOTB, LDS_OST=LDS_WS+NW*64*4, LDS_BYTES=LDS_OST+NW*4096, LDS_CS=LDS_BYTES, LDS_FLAGS=LDS_CS+SEQ*4, LDS_END=LDS_FLAGS+256;
constexpr float C2=0.125f*1.4426950408889634f;
__device__ __forceinline__ void glds16(const void*gsrc,unsigned lds_dst){unsigned keep;
  asm volatile("s_mov_b32 %0, m0\n\ts_mov_b32 m0, %2\n\ts_nop 0\n\tglobal_load_lds_dwordx4 %1, off\n\ts_mov_b32 m0, %0":"=&s"(keep):"v"(gsrc),"s"(lds_dst):"memory");}
__device__ __forceinline__ float max3f(float a,float b,float c){float r;asm("v_max3_f32 %0, %1, %2, %3":"=v"(r):"v"(a),"v"(b),"v"(c));return r;}
__device__ __forceinline__ float max2f(float a,float b){float r;asm("v_max_f32_e32 %0, %1, %2":"=v"(r):"v"(a),"v"(b));return r;}
__device__ __forceinline__ float fadd_s(float a,float b){float r;asm("v_add_f32_e32 %0, %1, %2":"=v"(r):"v"(a),"v"(b));return r;}
__device__ __forceinline__ float fsub_s(float a,float b){float r;asm("v_sub_f32_e32 %0, %1, %2":"=v"(r):"v"(a),"v"(b));return r;}
typedef float f32x2_t __attribute__((ext_vector_type(2))); typedef __bf16 bf16x2_t __attribute__((ext_vector_type(2)));
__device__ __forceinline__ unsigned cvtpk_s(float lo,float hi){f32x2_t v={lo,hi};bf16x2_t b=__builtin_convertvector(v,bf16x2_t);return __builtin_bit_cast(unsigned,b);}
#define WAIT_BAR(N) asm volatile("s_waitcnt vmcnt(" #N ") lgkmcnt(0)\n\ts_barrier":::"memory")

__device__ __forceinline__ void qkt(f32x16&p0,f32x16&p1,const char*Kslot,const bf16x8*qr,int r32,int hi){
  const char*kb=Kslot+hi*1024+r32*16;
  #pragma unroll
  for(int d0=0;d0<4;++d0){
    const bf16x8 b0=*reinterpret_cast<const bf16x8*>(kb+d0*2048);
    const bf16x8 b1=*reinterpret_cast<const bf16x8*>(kb+d0*2048+512);
    {p0=__builtin_amdgcn_mfma_f32_32x32x16_bf16(b0,qr[d0],p0,0,0,0);p1=__builtin_amdgcn_mfma_f32_32x32x16_bf16(b1,qr[d0],p1,0,0,0);}}
}
typedef __attribute__((address_space(3))) const char* lds_cptr;
typedef short v4i16_t __attribute__((ext_vector_type(4)));
__device__ __forceinline__ void kload8(bf16x8*kf,lds_cptr kp){
  kf[0]=*(const __attribute__((address_space(3))) bf16x8*)(kp);      kf[1]=*(const __attribute__((address_space(3))) bf16x8*)(kp+512);
  kf[2]=*(const __attribute__((address_space(3))) bf16x8*)(kp+2048); kf[3]=*(const __attribute__((address_space(3))) bf16x8*)(kp+2560);
  kf[4]=*(const __attribute__((address_space(3))) bf16x8*)(kp+4096); kf[5]=*(const __attribute__((address_space(3))) bf16x8*)(kp+4608);
  kf[6]=*(const __attribute__((address_space(3))) bf16x8*)(kp+6144); kf[7]=*(const __attribute__((address_space(3))) bf16x8*)(kp+6656);
}
__device__ __forceinline__ void kload2(bf16x8*kf,lds_cptr kp,int j){ kf[2*j]=*(const __attribute__((address_space(3))) bf16x8*)(kp+j*2048); kf[2*j+1]=*(const __attribute__((address_space(3))) bf16x8*)(kp+j*2048+512); }
__device__ __forceinline__ s16x4 vtr(lds_cptr p){ return __builtin_bit_cast(s16x4,__builtin_amdgcn_ds_read_tr16_b64_v4i16((__attribute__((address_space(3))) v4i16_t*)p)); }
__device__ __forceinline__ float rowmax(const f32x16&p0,const f32x16&p1){
  float a=max3f(p0[0],p0[1],p1[0]),b=max3f(p0[2],p0[3],p1[1]);a=max3f(a,p1[2],p1[3]);
  #pragma unroll
  for(int r=4;r<16;r+=4){a=max3f(a,p0[r],p0[r+1]);b=max3f(b,p0[r+2],p0[r+3]);a=max3f(a,p1[r],p1[r+1]);b=max3f(b,p1[r+2],p1[r+3]);}
  const float m=max2f(a,b);
  auto rr=__builtin_amdgcn_permlane32_swap(__float_as_uint(m),__float_as_uint(m),false,false);
  return max2f(__uint_as_float(rr[0]),__uint_as_float(rr[1]));
}
__device__ __forceinline__ void pv(f32x16*o,int vb,bf16x8 pa0,bf16x8 pa1,bf16x8 pa2,bf16x8 pa3){
  #pragma unroll
  for(int d0=0;d0<2;++d0){s16x4 lo[4],hi[4];
    #pragma unroll
    for(int ks=0;ks<4;++ks){
      asm volatile("ds_read_b64_tr_b16 %0,%1 offset:%c2":"=&v"(lo[ks]):"v"(vb),"i"(d0*4096+ks*1024):"memory");
      asm volatile("ds_read_b64_tr_b16 %0,%1 offset:%c2":"=&v"(hi[ks]):"v"(vb),"i"(d0*4096+ks*1024+512):"memory");}
    asm volatile("s_waitcnt lgkmcnt(0)":::"memory");SBAR();
    #define PK(k) (bf16x8){lo[k][0],lo[k][1],lo[k][2],lo[k][3],hi[k][0],hi[k][1],hi[k][2],hi[k][3]}
    o[d0]=__builtin_amdgcn_mfma_f32_32x32x16_bf16(pa0,PK(0),o[d0],0,0,0);
    o[d0]=__builtin_amdgcn_mfma_f32_32x32x16_bf16(pa1,PK(1),o[d0],0,0,0);
    o[d0]=__builtin_amdgcn_mfma_f32_32x32x16_bf16(pa2,PK(2),o[d0],0,0,0);
    o[d0]=__builtin_amdgcn_mfma_f32_32x32x16_bf16(pa3,PK(3),o[d0],0,0,0);
    #undef PK
  }
}

__device__ __forceinline__ u32x4 head_rms(u32x4 v){ float x[8];
  #pragma unroll
  for(int i=0;i<4;++i){x[2*i]=__uint_as_float(v[i]<<16);x[2*i+1]=__uint_as_float(v[i]&0xffff0000u);}
  float s=0.f;
  #pragma unroll
  for(int i=0;i<8;++i)s+=x[i]*x[i];
  s+=__shfl_xor(s,1);s+=__shfl_xor(s,2);s+=__shfl_xor(s,4);
  const float rs=__builtin_amdgcn_rsqf(s*(1.0f/64.0f)+1e-6f); u32x4 w;
  #pragma unroll
  for(int i=0;i<4;++i)w[i]=cvtpk_s(x[2*i]*rs,x[2*i+1]*rs);
  return w; }
#ifndef ATTN_STORE16
#define ATTN_STORE16(p,v) (*(u32x4*)(p)=(v))
#endif
template<int THRL> __device__ __forceinline__ void fox_unit(int b,int qb,float dthr,const bf16*Q,const bf16*__restrict__ K,const bf16*__restrict__ V,bf16*O,const float*__restrict__ csg,char*shm){
  int tid_=threadIdx.x; asm volatile("":"+v"(tid_)); const int tid=tid_,lane=tid&63,r32=lane&31,hi=lane>>5; const int wid=__builtin_amdgcn_readfirstlane(tid>>6);
  const long rowbase=(long)b*SEQ; const int q0=qb*QB;
  const bf16*Qw=Q+(rowbase+q0+wid*QBLK)*DM;
  const unsigned lds0=(unsigned)(uintptr_t)shm; const lds_cptr shm3=(lds_cptr)shm;
  float*wsf=(float*)(shm+LDS_WS)+wid*64;
  const unsigned kdst=lds0+LDS_K+wid*1024, vdst=lds0+LDS_V+wid*1024;
  #define DMA_K(t,slot) glds16(ksrc+(long)(t)*KVBLK*DM,(unsigned)__builtin_amdgcn_readfirstlane(kdst+(slot)))
  #define DMA_V(t,slot) glds16(vsrc+(long)(t)*KVBLK*DM,(unsigned)__builtin_amdgcn_readfirstlane(vdst+(slot)))
  const int vb0=(int)(lds0+LDS_V)+((lane>>4)&1)*32+(lane&3)*8+(4*hi+((lane&15)>>2))*64;
  const char*Kbase=shm+LDS_K; bf16x8 kf[8];
  const lds_cptr kp0=shm3+LDS_K+hi*1024+r32*16; const lds_cptr vp0=shm3+LDS_V+((lane>>4)&1)*32+(lane&3)*8+(4*hi+((lane&15)>>2))*64;
  typedef __attribute__((address_space(3))) float lds_f32; typedef __attribute__((address_space(3))) f32x4 lds_f32x4;
  { lds_f32*cl=(lds_f32*)(shm3+LDS_CS); const int n_=q0+QB; for(int i_=tid*4;i_<n_;i_+=2048){ const f32x4 v_=*(const f32x4*)(csg+i_); *(lds_f32x4*)(cl+i_)=v_; } }
  asm volatile("s_waitcnt vmcnt(0) lgkmcnt(0)\n\ts_barrier":::"memory");
  int j0;
  { const lds_f32*cl=(const lds_f32*)(shm3+LDS_CS); const float cq0=cl[q0]; int lo_=0,hi_=4*qb;
    while(lo_<hi_){ const int mid_=(lo_+hi_)>>1; if(cl[64*mid_+63]-cq0>=dthr)lo_=mid_+1; else hi_=mid_; }
    j0=__builtin_amdgcn_readfirstlane(lo_)&~1; }
  const bf16*Kh=K+(rowbase+(long)j0*KVBLK)*DM,*Vh=V+(rowbase+(long)j0*KVBLK)*DM;
  const bf16*ksrc=Kh+(long)lane*DM+wid*8;
  const bf16*vsrc=Vh+(long)(16*(wid&3)+(lane>>2))*DM+(wid>>2)*32+(lane&3)*8;
  const int NT=(q0+QB)/KVBLK-j0;
  const lds_f32*cl3=(const lds_f32*)(shm3+LDS_CS)+64*j0;
  DMA_K(0,0);DMA_V(0,0);DMA_K(1,SLOTB);
  bf16x8 qr[4];
  #pragma unroll
  for(int d0=0;d0<4;++d0)qr[d0]=*reinterpret_cast<const bf16x8*>(&Qw[(long)r32*DM+d0*16+hi*8]);
  float base=0.f,l_reg=0.f;f32x16 o[2];o[0]=f32x16{};o[1]=f32x16{};
  #define CINIT(C0,C1,t) do{ const lds_f32*cp_=cl3+64*(t)+4*hi; \
    _Pragma("unroll") for(int g_=0;g_<4;++g_){ const f32x4 a_=*(const lds_f32x4*)(cp_+8*g_), b_=*(const lds_f32x4*)(cp_+32+8*g_); \
      C0[4*g_]=base-a_[0];C0[4*g_+1]=base-a_[1];C0[4*g_+2]=base-a_[2];C0[4*g_+3]=base-a_[3]; \
      C1[4*g_]=base-b_[0];C1[4*g_+1]=base-b_[1];C1[4*g_+2]=base-b_[2];C1[4*g_+3]=base-b_[3]; } }while(0)
  const int qrel=wid*QBLK+r32;
  #define CMASK(P0,P1,t) do{int jb_=(t)-(NT-4); if(jb_>=0)cmask(P0,P1,jb_,qrel,hi);}while(0)
  bool resc=false;
  #define START(P0,P1) do{ const float rm=rowmax(P0,P1); resc=false; \
    { const float dl=rm; base=fsub_s(base,dl); \
      _Pragma("unroll") for(int r=0;r<16;++r){P0[r]=fsub_s(P0[r],dl);P1[r]=fsub_s(P1[r],dl);} } \
    _Pragma("unroll") for(int r=0;r<16;++r)P0[r]=__builtin_amdgcn_exp2f(P0[r]); }while(0)
  #define RESC() do{ if(resc){ asm volatile("s_waitcnt lgkmcnt(0)":::"memory"); \
      _Pragma("unroll") for(int d_=0;d_<2;++d_) _Pragma("unroll") for(int r=0;r<16;++r)o[d_][r]*=wsf[crow(r,hi)]; } }while(0)
  f32x16 pA0,pA1,pB0,pB1;
  int sl_prev=0,sl_cur=0,sl_next=SLOTB;
  #define ROT() do{sl_prev=sl_cur;sl_cur=sl_next;sl_next=(sl_next==(NSLOT-1)*SLOTB)?0:sl_next+SLOTB;}while(0)
  DMA_K(2,2*SLOTB);
  WAIT_BAR(3);
  base=cl3[q0-64*j0+wid*QBLK+r32];
  CINIT(pA0,pA1,0); qkt(pA0,pA1,Kbase,qr,r32,hi);asm volatile("s_nop 15\n\ts_nop 7":"+v"(pA0),"+v"(pA1));CMASK(pA0,pA1,0);
  START(pA0,pA1);
  _Pragma("unroll") for(int r=0;r<16;++r)pA1[r]=__builtin_amdgcn_exp2f(pA1[r]);
  WAIT_BAR(0);
  DMA_K(3,0);DMA_V(1,SLOTB);
  ROT();
  kload8(kf,kp0+sl_cur);
  WAIT_BAR(2);
  s16x4 vlo[8],vhi[8]; u32x4 pw0,pw1,pw2,pw3;
  #define PKW(P,B) cvtpk_s(P[B],P[B+1])
  #define PAF(k) __builtin_bit_cast(bf16x8,pw##k)
  #define VFR(i) (bf16x8){vlo[i][0],vlo[i][1],vlo[i][2],vlo[i][3],vhi[i][0],vhi[i][1],vhi[i][2],vhi[i][3]}
  #define PIN(x) asm volatile("":"+v"(x))
  #define MX3(a,b,c) __builtin_fmaxf(__builtin_fmaxf((a),(b)),(c))
  #define GAPA(MF,A0,A1,A2,A3,W0,W1,PW) do{ MF; sacc+=A0; sacc+=A1; sacc+=A2; sacc+=A3; PIN(sacc); W0; W1; PIN(PW); SBAR(); }while(0)
  #define EX(v) __builtin_amdgcn_exp2f(v)
  #define GAPB(MF,X,B) do{ MF; X[B]=EX(X[B]); X[B+1]=EX(X[B+1]); X[B+2]=EX(X[B+2]); X[B+3]=EX(X[B+3]); PIN(X); SBAR(); }while(0)
  #define VRD(i) do{ vlo[i]=vtr(vp_+(((i)>>2)*4096+((i)&3)*1024)); vhi[i]=vtr(vp_+(((i)>>2)*4096+((i)&3)*1024+512)); }while(0)
  #define KRD(G,j) do{ if(G){ kload2(kf,kp0+sl_next,j); SBAR(); } }while(0)
  #define STEP(C0,C1,P0,P1,t,GK,GV,GL) do{ SBAR(); CINIT(C0,C1,t); SBAR(); \
    const lds_cptr vp_=vp0+sl_prev; \
    VRD(0); SBAR(); float sacc=(P0[0]+P0[1]); \
    GAPA(C0=__builtin_amdgcn_mfma_f32_32x32x16_bf16(kf[0],qr[0],C0,0,0,0), P0[2],P0[3],P0[4],P0[5],     pw0[0]=PKW(P0,0), pw0[1]=PKW(P0,2), pw0); \
    VRD(4); SBAR(); GAPA(C1=__builtin_amdgcn_mfma_f32_32x32x16_bf16(kf[1],qr[0],C1,0,0,0), P0[6],P0[7],P0[8],P0[9],     pw0[2]=PKW(P0,4), pw0[3]=PKW(P0,6), pw0); \
    VRD(1); SBAR(); GAPA(C0=__builtin_amdgcn_mfma_f32_32x32x16_bf16(kf[2],qr[1],C0,0,0,0),   P0[10],P0[11],P0[12],P0[13], pw1[0]=PKW(P0,8), pw1[1]=PKW(P0,10), pw1); \
    VRD(5); SBAR(); GAPA(C1=__builtin_amdgcn_mfma_f32_32x32x16_bf16(kf[3],qr[1],C1,0,0,0),   P0[14],P0[15],P1[0],P1[1],   pw1[2]=PKW(P0,12),pw1[3]=PKW(P0,14), pw1); \
    VRD(2); SBAR(); GAPA(C0=__builtin_amdgcn_mfma_f32_32x32x16_bf16(kf[4],qr[2],C0,0,0,0),   P1[2],P1[3],P1[4],P1[5],     pw2[0]=PKW(P1,0), pw2[1]=PKW(P1,2), pw2); \
    VRD(6); SBAR(); GAPA(C1=__builtin_amdgcn_mfma_f32_32x32x16_bf16(kf[5],qr[2],C1,0,0,0),   P1[6],P1[7],P1[8],P1[9],     pw2[2]=PKW(P1,4), pw2[3]=PKW(P1,6), pw2); \
    VRD(3); SBAR(); GAPA(C0=__builtin_amdgcn_mfma_f32_32x32x16_bf16(kf[6],qr[3],C0,0,0,0),   P1[10],P1[11],P1[12],P1[13], pw3[0]=PKW(P1,8), pw3[1]=PKW(P1,10), pw3); \
    VRD(7); SBAR(); GAPA(C1=__builtin_amdgcn_mfma_f32_32x32x16_bf16(kf[7],qr[3],C1,0,0,0),   P1[14],P1[15],0.f,0.f,       pw3[2]=PKW(P1,12),pw3[3]=PKW(P1,14), pw3); \
    l_reg+=sacc; \
    if(GK){DMA_K((t)+3,sl_cur);} if(GV){DMA_V((t)+1,sl_next);} \
    CMASK(C0,C1,t); \
    { float a=MX3(C0[0],C0[1],C1[0]),b=MX3(C0[2],C0[3],C1[1]); a=MX3(a,C1[2],C1[3]); \
      _Pragma("unroll") for(int r=4;r<16;r+=4){a=MX3(a,C0[r],C0[r+1]);b=MX3(b,C0[r+2],C0[r+3]);a=MX3(a,C1[r],C1[r+1]);b=MX3(b,C1[r+2],C1[r+3]);} \
      float rm=__builtin_fmaxf(a,b); { auto rr=__builtin_amdgcn_permlane32_swap(__float_as_uint(rm),__float_as_uint(rm),false,false); rm=__builtin_fmaxf(__uint_as_float(rr[0]),__uint_as_float(rr[1])); } \
      resc=false; \
      if(__builtin_expect(__any(rm>(float)THRL),0)){ const float dl=__builtin_fmaxf(rm,0.f); base-=dl; \
        _Pragma("unroll") for(int r=0;r<16;++r){C0[r]-=dl;C1[r]-=dl;} \
        const float f=__builtin_amdgcn_exp2f(-dl); l_reg*=f; if(hi==0)wsf[r32]=f; resc=true; } } \
    SBAR(); \
    GAPB(o[0]=__builtin_amdgcn_mfma_f32_32x32x16_bf16(PAF(0),VFR(0),o[0],0,0,0), C0,0); \
    GAPB(o[1]=__builtin_amdgcn_mfma_f32_32x32x16_bf16(PAF(0),VFR(4),o[1],0,0,0), C0,4); \
    KRD(GL,0); GAPB(o[0]=__builtin_amdgcn_mfma_f32_32x32x16_bf16(PAF(1),VFR(1),o[0],0,0,0), C0,8); \
    KRD(GL,1); GAPB(o[1]=__builtin_amdgcn_mfma_f32_32x32x16_bf16(PAF(1),VFR(5),o[1],0,0,0), C0,12); \
    KRD(GL,2); GAPB(o[0]=__builtin_amdgcn_mfma_f32_32x32x16_bf16(PAF(2),VFR(2),o[0],0,0,0), C1,0); \
    KRD(GL,3); GAPB(o[1]=__builtin_amdgcn_mfma_f32_32x32x16_bf16(PAF(2),VFR(6),o[1],0,0,0), C1,4); \
    GAPB(o[0]=__builtin_amdgcn_mfma_f32_32x32x16_bf16(PAF(3),VFR(3),o[0],0,0,0), C1,8); \
    GAPB(o[1]=__builtin_amdgcn_mfma_f32_32x32x16_bf16(PAF(3),VFR(7),o[1],0,0,0), C1,12); \
    }while(0)
  int t=1;
  #undef CMASK
  #define CMASK(P0,P1,t) do{}while(0)
  for(;t+5<NT;t+=2){
    STEP(pB0,pB1,pA0,pA1,t,true,true,true);     WAIT_BAR(2); RESC(); ROT();
    STEP(pA0,pA1,pB0,pB1,t+1,true,true,true);   WAIT_BAR(2); RESC(); ROT();
  }
  #undef CMASK
  #define CMASK(P0,P1,t) do{int jb_=(t)-(NT-4); if(jb_>=0)cmask(P0,P1,jb_,qrel,hi);}while(0)
  #define ENDW(tt) do{ if((tt)+3<NT){WAIT_BAR(2);} else if((tt)+2<NT){WAIT_BAR(1);} else {WAIT_BAR(0);} }while(0)
  for(;t+1<NT;t+=2){
    STEP(pB0,pB1,pA0,pA1,t,(t+3<NT),(t+1<NT),(t+1<NT));       ENDW(t);   RESC(); ROT();
    STEP(pA0,pA1,pB0,pB1,t+1,(t+4<NT),(t+2<NT),(t+2<NT));     ENDW(t+1); RESC(); ROT();
  }
  STEP(pB0,pB1,pA0,pA1,NT-1,false,false,false); RESC();
  { float sacc=pB0[0]+pB0[1]; _Pragma("unroll") for(int r=2;r<16;++r)sacc+=pB0[r]; _Pragma("unroll") for(int r=0;r<16;++r)sacc+=pB1[r]; l_reg+=sacc;
    pw0=(u32x4){PKW(pB0,0),PKW(pB0,2),PKW(pB0,4),PKW(pB0,6)};pw1=(u32x4){PKW(pB0,8),PKW(pB0,10),PKW(pB0,12),PKW(pB0,14)};pw2=(u32x4){PKW(pB1,0),PKW(pB1,2),PKW(pB1,4),PKW(pB1,6)};pw3=(u32x4){PKW(pB1,8),PKW(pB1,10),PKW(pB1,12),PKW(pB1,14)};
    SBAR(); pv(o,vb0+sl_cur,PAF(0),PAF(1),PAF(2),PAF(3)); }
  #undef PKW
  #undef PAF
  #undef VFR
  #undef PIN
  #undef MX3
  #undef GAPA
  #undef GAPB
  #undef EX
  #undef VRD
  #undef KRD
  #undef STEP
  #undef ENDW
  {auto rr=__builtin_amdgcn_permlane32_swap(__float_as_uint(l_reg),__float_as_uint(l_reg),false,false);l_reg=__uint_as_float(rr[0])+__uint_as_float(rr[1]);}
  if(hi==0)wsf[32+r32]=l_reg;asm volatile("s_waitcnt lgkmcnt(0)":::"memory");
  float rli[16];
  #pragma unroll
  for(int r=0;r<16;++r)rli[r]=__builtin_amdgcn_rcpf(wsf[32+crow(r,hi)]);
  bf16*Ow=O+(rowbase+q0+wid*QBLK)*DMO;
  { bf16*stg=(bf16*)(shm+LDS_OST)+wid*2048;
    #pragma unroll
    for(int r=0;r<16;++r){const int orow=crow(r,hi);
      #pragma unroll
      for(int d0=0;d0<2;++d0)stg[orow*64+d0*32+r32]=__float2bfloat16(o[d0][r]*rli[r]);}
    asm volatile("s_waitcnt lgkmcnt(0)":::"memory");
    #pragma unroll
    for(int i=0;i<4;++i){const int row=i*8+(lane>>3),ch=lane&7; const u32x4 v=*(const u32x4*)(stg+row*64+ch*8); ATTN_STORE16(Ow+(long)row*DMO+ch*8,head_rms(v));} }
  asm volatile("s_waitcnt lgkmcnt(0)\n\ts_barrier":::"memory");
  #undef DMA_K
  #undef DMA_V
  #undef CMASK
  #undef CINIT
  #undef START
  #undef RESC
  #undef ROT
}
__device__ __forceinline__ float sp2f(float z){ const float e=__builtin_amdgcn_exp2f(-__builtin_fabsf(z)); return __builtin_fmaxf(z,0.f)+__builtin_amdgcn_logf(1.f+e); }
__device__ __forceinline__ void sb_unit(int b,int qb,const bf16*Q,const bf16*__restrict__ K,const bf16*__restrict__ V,bf16*O,char*shm){
  int tid_=threadIdx.x; asm volatile("":"+v"(tid_)); const int tid=tid_,lane=tid&63,r32=lane&31,hi=lane>>5; const int wid=__builtin_amdgcn_readfirstlane(tid>>6);
  const long rowbase=(long)b*SEQ; const int q0=qb*QB;
  const bf16*Qw=Q+(rowbase+q0+wid*QBLK)*DM;
  const bf16*Kh=K+rowbase*DM,*Vh=V+rowbase*DM;
  const unsigned lds0=(unsigned)(uintptr_t)shm; const lds_cptr shm3=(lds_cptr)shm;
  const bf16*ksrc=Kh+(long)lane*DM+wid*8;
  const bf16*vsrc=Vh+(long)(16*(wid&3)+(lane>>2))*DM+(wid>>2)*32+(lane&3)*8;
  const unsigned kdst=lds0+LDS_K+wid*1024, vdst=lds0+LDS_V+wid*1024;
  #define DMA_K(t,slot) glds16(ksrc+(long)(t)*KVBLK*DM,(unsigned)__builtin_amdgcn_readfirstlane(kdst+(slot)))
  #define DMA_V(t,slot) glds16(vsrc+(long)(t)*KVBLK*DM,(unsigned)__builtin_amdgcn_readfirstlane(vdst+(slot)))
  const int vb0=(int)(lds0+LDS_V)+((lane>>4)&1)*32+(lane&3)*8+(4*hi+((lane&15)>>2))*64;
  typedef __attribute__((address_space(3))) unsigned lds_u32;
  volatile lds_u32*flags=(volatile lds_u32*)(shm3+LDS_FLAGS);
  bf16x8 qr[4];
  #pragma unroll
  for(int d0=0;d0<4;++d0)qr[d0]=*reinterpret_cast<const bf16x8*>(&Qw[(long)r32*DM+d0*16+hi*8]);
  asm volatile("":::"memory");
  f32x16 o[2];o[0]=f32x16{};o[1]=f32x16{};
  float R=1.f; const int qabs=q0+wid*QBLK+r32; bool done=false;
  const int jtop=4*qb+3;
  DMA_K(jtop,0);DMA_V(jtop,0);
  int slot=0;
  for(int j=jtop;j>=0;--j){
    if(j>0){ DMA_K(j-1,slot^SLOTB);DMA_V(j-1,slot^SLOTB); WAIT_BAR(2); } else { WAIT_BAR(0); }
    const bool active=(!done)&&(64*j<q0+wid*QBLK+31);
    if(active){
      f32x16 p0=f32x16{},p1=f32x16{};
      qkt(p0,p1,shm+LDS_K+slot,qr,r32,hi);
      const int kvb=64*j+4*hi; f32x16 s0,s1;
      #pragma unroll
      for(int r=0;r<16;++r){ const int kv=kvb+(r&3)+8*(r>>2);
        const float e0=__builtin_amdgcn_exp2f(__builtin_fminf(p0[r],80.f)), e1=__builtin_amdgcn_exp2f(__builtin_fminf(p1[r],80.f));
        const float r0=__builtin_amdgcn_rcpf(1.f+e0), r1=__builtin_amdgcn_rcpf(1.f+e1);
        const bool v0=kv<qabs, v1=kv+32<qabs;
        p0[r]=v0?e0*r0:0.f; p1[r]=v1?e1*r1:0.f; s0[r]=v0?r0:1.f; s1[r]=v1?r1:1.f; }
      float g0[4],g1[4],og0[4],og1[4],T0[4],T1[4];
      #pragma unroll
      for(int g=0;g<4;++g){ g0[g]=(s0[4*g]*s0[4*g+1])*(s0[4*g+2]*s0[4*g+3]); g1[g]=(s1[4*g]*s1[4*g+1])*(s1[4*g+2]*s1[4*g+3]); }
      #pragma unroll
      for(int g=0;g<4;++g){ og0[g]=__shfl_xor(g0[g],32); og1[g]=__shfl_xor(g1[g],32); }
      float run=R;
      #pragma unroll
      for(int g=3;g>=0;--g){ const float ah1=hi?g1[g]:og1[g], ah0=hi?og1[g]:g1[g]; const float t1=run; run*=ah1; const float t0=run; run*=ah0; T1[g]=hi?t1:t0; }
      #pragma unroll
      for(int g=3;g>=0;--g){ const float ah1=hi?g0[g]:og0[g], ah0=hi?og0[g]:g0[g]; const float t1=run; run*=ah1; const float t0=run; run*=ah0; T0[g]=hi?t1:t0; }
      R=run;
      #pragma unroll
      for(int g=0;g<4;++g){ float a0=T0[g],a1=T1[g];
        #pragma unroll
        for(int i=3;i>=0;--i){ const int r=4*g+i; p0[r]*=a0; p1[r]*=a1; a0*=s0[r]; a1*=s1[r]; } }
      u32x4 pw0,pw1,pw2,pw3;
      pw0=(u32x4){cvtpk_s(p0[0],p0[1]),cvtpk_s(p0[2],p0[3]),cvtpk_s(p0[4],p0[5]),cvtpk_s(p0[6],p0[7])};
      pw1=(u32x4){cvtpk_s(p0[8],p0[9]),cvtpk_s(p0[10],p0[11]),cvtpk_s(p0[12],p0[13]),cvtpk_s(p0[14],p0[15])};
      pw2=(u32x4){cvtpk_s(p1[0],p1[1]),cvtpk_s(p1[2],p1[3]),cvtpk_s(p1[4],p1[5]),cvtpk_s(p1[6],p1[7])};
      pw3=(u32x4){cvtpk_s(p1[8],p1[9]),cvtpk_s(p1[10],p1[11]),cvtpk_s(p1[12],p1[13]),cvtpk_s(p1[14],p1[15])};
      pv(o,vb0+slot,__builtin_bit_cast(bf16x8,pw0),__builtin_bit_cast(bf16x8,pw1),__builtin_bit_cast(bf16x8,pw2),__builtin_bit_cast(bf16x8,pw3));
      done=__all(R<1.0e-37f)!=0;
    }
    if(lane==0)flags[wid]=done?1u:0u;
    asm volatile("s_waitcnt lgkmcnt(0)\n\ts_barrier":::"memory");
    unsigned alld=1u;
    #pragma unroll
    for(int w=0;w<NW;++w)alld&=flags[w];
    slot^=SLOTB;
    if(alld)break;
  }
  asm volatile("s_waitcnt vmcnt(0)":::"memory");
  bf16*Ow=O+(rowbase+q0+wid*QBLK)*DMO;
  { bf16*stg=(bf16*)(shm+LDS_OST)+wid*2048;
    #pragma unroll
    for(int r=0;r<16;++r){const int orow=crow(r,hi);
      #pragma unroll
      for(int d0=0;d0<2;++d0)stg[orow*64+d0*32+r32]=__float2bfloat16(o[d0][r]);}
    asm volatile("s_waitcnt lgkmcnt(0)":::"memory");
    #pragma unroll
    for(int i=0;i<4;++i){const int row=i*8+(lane>>3),ch=lane&7; const u32x4 v=*(const u32x4*)(stg+row*64+ch*8); ATTN_STORE16(Ow+(long)row*DMO+ch*8,head_rms(v));} }
  asm volatile("s_waitcnt vmcnt(0) lgkmcnt(0)\n\ts_barrier":::"memory");
  #undef DMA_K
  #undef DMA_V
}
#undef SBAR
#undef WAIT_BAR
}
namespace cg = cooperative_groups;
constexpr int NWAVES = 8;
constexpr int DMODEL = 1024, NBATCH = 4, SEQ_IN = 8192, NMETA = 16, LREAL = NMETA + SEQ_IN, LP = 8448  ;
constexpr int MROWS = NBATCH * LP;
constexpr int MREAL = NBATCH * SEQ_IN;
constexpr int INW = 2566, NINP = 2560, NIN = 2816, DFF = 2816, NGU = 2 * DFF, DEPTH = 2, NFH = 6;
constexpr float C2F = 0.125f * 1.4426950408889634f;
constexpr int PC_U = 0, PC_FQ = 256, PC_FK = 640, PC_FV = 1024, PC_SQ = 1408, PC_SK = 1792, PC_SV = 2176;
constexpr size_t MiB = 1u << 20;
constexpr size_t WS_CTL = 0, CTL_ZERO_BYTES = 1 * MiB;
constexpr size_t WS_SS = 64 * 1024;
constexpr size_t WS_W = 1 * MiB, W_LAYER = 24 * MiB, W_IN = 0, W_OUT = (size_t)NIN * 1024 * 2, W_GU = W_OUT + 2 * MiB, W_D = W_GU + (size_t)NGU * 1024 * 2;
constexpr size_t WS_LF = 49 * MiB, WS_CS = 51 * MiB, WS_H = 52 * MiB, WS_HB = 184 * MiB, WS_Y = 250 * MiB, WS_P = 316 * MiB, WS_END = WS_P + (size_t)MROWS * DFF * 2;
static_assert(W_D + (size_t)1024 * DFF * 2 <= W_LAYER && WS_W + 2 * W_LAYER <= WS_LF && WS_SS + 5 * (size_t)MROWS * 4 <= CTL_ZERO_BYTES, "ws map");
static_assert(WS_H + (size_t)MROWS * 1024 * 4 <= WS_HB && WS_HB + (size_t)MROWS * 1024 * 2 <= WS_Y && WS_Y + (size_t)MROWS * 1024 * 2 <= WS_P && WS_END <= 512 * MiB, "ws map");
constexpr int LDS_BYTES = 147456;
constexpr int LDS_MISC = 131072;

#define LAS __attribute__((address_space(3)))
typedef unsigned short bf16u;
typedef unsigned v4u __attribute__((ext_vector_type(4)));
typedef float f32x4 __attribute__((ext_vector_type(4)));
#define LDS_WAIT() asm volatile("s_waitcnt lgkmcnt(0)" ::: "memory")
__device__ __forceinline__ unsigned f2bf(float f) { unsigned u = __builtin_bit_cast(unsigned, f); return (u + 0x7fffu + ((u >> 16) & 1u)) >> 16; }
__device__ __forceinline__ unsigned pk2(float lo, float hi) { return f2bf(lo) | (f2bf(hi) << 16); }
__device__ __forceinline__ float wave_sum(float v) {
#pragma unroll
    for (int o = 1; o < 64; o <<= 1) v += __shfl_xor(v, o);
    return v;
}

struct Args { const float* in[15]; float* out; unsigned char* ws; };

struct WinSrc { const float* w; const float* g;
    __device__ __forceinline__ float operator()(int k, int n) const { if (n >= INW) return 0.f; const int col = n < 1408 ? n : (n < 2560 ? n + 6 : n - 2560 + 1408);
        const float sc = ((n >= PC_FQ && n < PC_FK) || (n >= PC_SQ && n < PC_SK)) ? C2F : 1.0f; return w[(size_t)k * INW + col] * g[k] * sc; } };
struct WoutSrc { const float* w; const float* fg; const float* sg;
    __device__ __forceinline__ float operator()(int k, int n) const { const float gn = k < 640 ? fg[k - 256] : sg[k - 640]; return w[(size_t)k * 1024 + n] * gn; } };
struct WguSrc { const float* wg; const float* wu; const float* g;
    __device__ __forceinline__ float operator()(int k, int c) const { const int pn = c >> 8, w = c & 255, j = pn * 128 + (w & 127); const long dlt = (w >> 7) ? (long)(wu - wg) : 0L; return wg[(long)k * DFF + j + dlt] * g[k]; } };
struct WdSrc { const float* w;
    __device__ __forceinline__ float operator()(int k, int n) const { return w[(size_t)k * 1024 + n]; } };
template <class F> __device__ __forceinline__ void conv_item(const F src, bf16u* WT, int K, int k0, int n0, LAS float* scr, int lane) {
    float tv[32];
#pragma unroll
    for (int i = 0; i < 32; ++i) tv[i] = src(k0 + 2 * i + (lane >> 5), n0 + (lane & 31));
#pragma unroll
    for (int i = 0; i < 32; ++i) scr[(2 * i + (lane >> 5)) * 33 + (lane & 31)] = tv[i];
    LDS_WAIT(); asm volatile("" ::: "memory");
    const int c = lane & 7;
#pragma unroll
    for (int j = 0; j < 4; ++j) { const int n = (lane >> 3) + 8 * j; const LAS float* s = scr + (8 * c) * 33 + n;
        v4u o; o.x = pk2(s[0 * 33], s[1 * 33]); o.y = pk2(s[2 * 33], s[3 * 33]); o.z = pk2(s[4 * 33], s[5 * 33]); o.w = pk2(s[6 * 33], s[7 * 33]);
        *(v4u*)(WT + (size_t)(n0 + n) * K + k0 + 8 * c) = o; }
    LDS_WAIT(); asm volatile("" ::: "memory");
}
__device__ __forceinline__ void fold_item(const float* wout, const float* pw, const float* ps, bf16u* WT, int item, int lane) {
    const int g = item >> 4, n = (item & 15) * 64 + lane;
    float acc[64];
#pragma unroll
    for (int c = 0; c < 64; ++c) acc[c] = 0.f;
    for (int d = 0; d < 64; ++d) { const float wv = wout[(size_t)(g * 64 + d) * 1024 + n] * ps[g * 64 + d];
#pragma unroll
        for (int c = 0; c < 64; ++c) acc[c] += pw[(g * 64 + c) * 64 + d] * wv; }
    bf16u* o = WT + (size_t)n * 1024 + g * 64;
#pragma unroll
    for (int c = 0; c < 64; c += 8) { v4u w; w.x = pk2(acc[c], acc[c + 1]); w.y = pk2(acc[c + 2], acc[c + 3]); w.z = pk2(acc[c + 4], acc[c + 5]); w.w = pk2(acc[c + 6], acc[c + 7]); *(v4u*)(o + c) = w; }
}
__device__ __forceinline__ void p0_prologue(const Args& A, unsigned char* ws, LAS unsigned char* lds, int wave, int lane) {
    LAS float* scr = (LAS float*)(lds + wave * 16384);
    const int gw = blockIdx.x * NWAVES + wave, NGW = gridDim.x * NWAVES;
    constexpr int I_IN = 16 * (NIN / 32), I_OUT = 12 * 32, I_GU = 16 * (NGU / 32), I_D = (DFF / 64) * 32, I_F = 64, I_L = I_IN + I_OUT + I_GU + I_D + I_F;
    for (int it = gw; it < DEPTH * I_L; it += NGW) {
        const int L = it / I_L; int r = it % I_L;
        bf16u* wb = (bf16u*)(ws + WS_W + (size_t)L * W_LAYER);
        if (r < I_IN) { WinSrc s{A.in[3] + (size_t)L * 1024 * INW, A.in[2] + L * 1024}; conv_item(s, (bf16u*)((unsigned char*)wb + W_IN), 1024, (r / (NIN / 32)) * 64, (r % (NIN / 32)) * 32, scr, lane); continue; } r -= I_IN;
        if (r < I_OUT) { WoutSrc s{A.in[9] + (size_t)L * 1024 * 1024, A.in[7] + L * 384, A.in[8] + L * 384}; conv_item(s, (bf16u*)((unsigned char*)wb + W_OUT), 1024, 256 + (r / 32) * 64, (r % 32) * 32, scr, lane); continue; } r -= I_OUT;
        if (r < I_GU) { WguSrc s{A.in[11] + (size_t)L * 1024 * DFF, A.in[12] + (size_t)L * 1024 * DFF, A.in[10] + L * 1024}; conv_item(s, (bf16u*)((unsigned char*)wb + W_GU), 1024, (r / (NGU / 32)) * 64, (r % (NGU / 32)) * 32, scr, lane); continue; } r -= I_GU;
        if (r < I_D) { WdSrc s{A.in[13] + (size_t)L * DFF * 1024}; conv_item(s, (bf16u*)((unsigned char*)wb + W_D), DFF, (r / 32) * 64, (r % 32) * 32, scr, lane); continue; } r -= I_D;
        fold_item(A.in[9] + (size_t)L * 1024 * 1024, A.in[5] + (size_t)L * 4 * 64 * 64, A.in[6] + L * 256, (bf16u*)((unsigned char*)wb + W_OUT), r, lane);
    }
    bf16u* hb = (bf16u*)(ws + WS_HB); float* ss0 = (float*)(ws + WS_SS);
    for (int m = gw; m < MROWS; m += NGW) {
        const int b = m / LP, t = m % LP;
        f32x4 v[4]; float s = 0.f;
        if (t < LREAL) { const f32x4* src = (const f32x4*)(t < NMETA ? A.in[1] + (size_t)t * 1024 : A.in[0] + ((size_t)b * SEQ_IN + (t - NMETA)) * 1024) + lane;
#pragma unroll
            for (int j = 0; j < 4; ++j) { v[j] = src[64 * j]; s += (v[j].x * v[j].x + v[j].y * v[j].y) + (v[j].z * v[j].z + v[j].w * v[j].w); } }
        else {
#pragma unroll
            for (int j = 0; j < 4; ++j) v[j] = (f32x4){0.f, 0.f, 0.f, 0.f}; }
        s = wave_sum(s);
        unsigned long long* bo = (unsigned long long*)(hb + (size_t)m * 1024) + lane;
#pragma unroll
        for (int j = 0; j < 4; ++j) { bo[64 * j] = (unsigned long long)pk2(v[j].x, v[j].y) | ((unsigned long long)pk2(v[j].z, v[j].w) << 32); }
        if (lane == 0) ss0[m] = s;
    }
}
typedef short bf16x8m __attribute__((ext_vector_type(8)));
template <int NBK> __device__ __forceinline__ void mini_item(f32x4 (&acc)[NBK], const bf16u* A16, const bf16u* Bt0, const bf16u* Bt1, int K, LAS unsigned char* lds, int wave, int lane) {
    const int fr = lane & 15, fq = lane >> 4, kw = K >> 3; const size_t o = (size_t)fr * K + wave * kw + 8 * fq;
#pragma unroll
    for (int nb = 0; nb < NBK; ++nb) acc[nb] = (f32x4){0.f, 0.f, 0.f, 0.f};
    for (int k = 0; k < kw; k += 32) { const bf16x8m a = *(const bf16x8m*)(A16 + o + k); const bf16x8m b0 = *(const bf16x8m*)(Bt0 + o + k);
        acc[0] = __builtin_amdgcn_mfma_f32_16x16x32_bf16(b0, a, acc[0], 0, 0, 0);
        if (NBK == 2) { const bf16x8m b1 = *(const bf16x8m*)(Bt1 + o + k); acc[NBK - 1] = __builtin_amdgcn_mfma_f32_16x16x32_bf16(b1, a, acc[NBK - 1], 0, 0, 0); } }
    LAS f32x4* red = (LAS f32x4*)lds;
#pragma unroll
    for (int nb = 0; nb < NBK; ++nb) red[(nb * 8 + wave) * 64 + lane] = acc[nb];
    __syncthreads();
    if (wave == 0) {
#pragma unroll
        for (int nb = 0; nb < NBK; ++nb) { f32x4 s = red[(nb * 8) * 64 + lane];
#pragma unroll
            for (int w = 1; w < 8; ++w) s += red[(nb * 8 + w) * 64 + lane];
            acc[nb] = s; } }
    __syncthreads();
}
__device__ __forceinline__ void mini_in(unsigned char* ws, const bf16u* wt, const float* ss, const float* fb, LAS unsigned char* lds, int wave, int lane) {
    const bf16u* A16 = (const bf16u*)(ws + WS_HB); bf16u* P = (bf16u*)(ws + WS_P); float* LF = (float*)(ws + WS_LF);
    const int half = gridDim.x / 2; if ((int)blockIdx.x < half) return;
    for (int it = blockIdx.x - half; it < 161; it += gridDim.x - half) { const int n0 = it * 16; f32x4 acc[1];
        mini_item<1>(acc, A16, wt + (size_t)n0 * 1024, nullptr, 1024, lds, wave, lane);
        if (wave == 0) { const int fr = lane & 15, fq = lane >> 4; const float rs = __builtin_amdgcn_rsqf(ss[fr] * (1.0f / 1024.0f) + 1e-6f); const f32x4 v = acc[0] * rs;
            if (n0 < NINP) { const unsigned long long w = (unsigned long long)pk2(v[0], v[1]) | ((unsigned long long)pk2(v[2], v[3]) << 32);
#pragma unroll
                for (int b = 0; b < NBATCH; ++b) *(unsigned long long*)(P + ((size_t)b * LP + fr) * NINP + n0 + 4 * fq) = w; }
            else if (fq < 2) { f32x4 l;
#pragma unroll
                for (int i = 0; i < 4; ++i) { const int c = 4 * fq + i; const float x = v[i] + fb[c < NFH ? c : 0]; l[i] = c < NFH ? -(fmaxf(-x, 0.f) + log1pf(expf(-fabsf(x)))) * 1.4426950408889634f : 0.f; }
#pragma unroll
                for (int b = 0; b < NBATCH; ++b) *(f32x4*)(LF + ((size_t)b * LP + fr) * 8 + 4 * fq) = l; } }
    }
}
__device__ __forceinline__ void mini_res(unsigned char* ws, const bf16u* A16, const bf16u* wt, int K, float* ssn, LAS unsigned char* lds, int wave, int lane) {
    bf16u* hb = (bf16u*)(ws + WS_HB);
    for (int it = blockIdx.x; it < 64; it += gridDim.x) { const int n0 = it * 16; f32x4 acc[1];
        mini_item<1>(acc, A16, wt + (size_t)n0 * K, nullptr, K, lds, wave, lane);
        if (wave == 0) { const int fr = lane & 15, fq = lane >> 4; unsigned long long* bp = (unsigned long long*)(hb + (size_t)fr * 1024 + n0 + 4 * fq); const unsigned long long r = *bp; const unsigned rl = (unsigned)r, rh = (unsigned)(r >> 32);
            const f32x4 a = (f32x4){__uint_as_float(rl << 16), __uint_as_float(rl & 0xffff0000u), __uint_as_float(rh << 16), __uint_as_float(rh & 0xffff0000u)} + acc[0];
            *bp = (unsigned long long)pk2(a[0], a[1]) | ((unsigned long long)pk2(a[2], a[3]) << 32);
            float s = (a[0] * a[0] + a[1] * a[1]) + (a[2] * a[2] + a[3] * a[3]); s += __shfl_xor(s, 16); s += __shfl_xor(s, 32);
            if (fq == 0) atomicAdd(ssn + fr, s); }
    }
}
__device__ __forceinline__ void mini_gu(unsigned char* ws, const bf16u* wt, const float* ss, LAS unsigned char* lds, int wave, int lane) {
    const bf16u* A16 = (const bf16u*)(ws + WS_HB); bf16u* H = (bf16u*)(ws + WS_P);
    for (int it = blockIdx.x; it < DFF / 16; it += gridDim.x) { const int j0 = it * 16, cg = (j0 >> 7) * 256 + (j0 & 127); f32x4 acc[2];
        mini_item<2>(acc, A16, wt + (size_t)cg * 1024, wt + (size_t)(cg + 128) * 1024, 1024, lds, wave, lane);
        if (wave == 0) { const int fr = lane & 15, fq = lane >> 4; const float rs = __builtin_amdgcn_rsqf(ss[fr] * (1.0f / 1024.0f) + 1e-6f); float o[4];
#pragma unroll
            for (int i = 0; i < 4; ++i) { const float g = acc[0][i] * rs, up = acc[1][i] * rs; o[i] = g * __builtin_amdgcn_rcpf(1.0f + __builtin_amdgcn_exp2f(-1.4426950408889634f * g)) * up; }
            *(unsigned long long*)(H + (size_t)fr * DFF + j0 + 4 * fq) = (unsigned long long)pk2(o[0], o[1]) | ((unsigned long long)pk2(o[2], o[3]) << 32); }
    }
}
__device__ __forceinline__ void pool_scan_phase(unsigned char* ws, LAS unsigned char* lds, unsigned* nrm, int tid, int wave, int lane) {
    const float* LF = (const float*)(ws + WS_LF); float* CS = (float*)(ws + WS_CS);
    if (blockIdx.x < NBATCH * NFH) {
        const int b = blockIdx.x / NFH, hf = blockIdx.x % NFH; constexpr int PER = 17;
        const float* lf = LF + (size_t)b * LP * 8 + hf; float* cs = CS + (size_t)(b * NFH + hf) * LP;
        float v[PER]; float s = 0.f; const int t0 = tid * PER;
#pragma unroll
        for (int i = 0; i < PER; ++i) { const int t = t0 + i; const float x = t < LREAL ? lf[(size_t)t * 8] : 0.f; s += x; v[i] = s; }
        float incl = s;
#pragma unroll
        for (int o = 1; o < 64; o <<= 1) { const float n = __shfl_up(incl, o); if (lane >= o) incl += n; }
        LAS float* wsum = (LAS float*)(lds + LDS_MISC + 256);
        if (lane == 63) wsum[wave] = incl;
        __syncthreads();
        float off = 0.f;
        for (int w = 0; w < wave; ++w) off += wsum[w];
        const float excl = off + incl - s;
#pragma unroll
        for (int i = 0; i < PER; ++i) { const int t = t0 + i; if (t < LREAL) cs[t] = excl + v[i]; }
        __syncthreads();
    }
    const bf16u* P = (const bf16u*)(ws + WS_P); bf16u* Y = (bf16u*)(ws + WS_Y);
    for (int sl = blockIdx.x; sl < 256; sl += gridDim.x) {
        if (tid < 480) { const int sub = tid / 96, task = tid % 96, which = task / 48, head = (task % 48) >> 3, chunk = task & 7; const int r0 = sl * (MROWS / 256), b = r0 / LP;
            const bf16u* src = P + (which ? PC_FK : PC_FQ) + head * 64 + chunk * 8; float mx = 0.f;
#pragma unroll 9
            for (int r = sub; r < MROWS / 256; r += 5) { const v4u w = ((r0 + r) % LP < LREAL) ? *(const v4u*)(src + (size_t)(r0 + r) * NINP) : (v4u){0u, 0u, 0u, 0u}; float s = 0.f;
#pragma unroll
                for (int e = 0; e < 4; ++e) { const float lo = __uint_as_float(w[e] << 16), hi = __uint_as_float(w[e] & 0xffff0000u); s += lo * lo + hi * hi; }
                s += __shfl_xor(s, 1); s += __shfl_xor(s, 2); s += __shfl_xor(s, 4); mx = fmaxf(mx, s); }
            if (chunk == 0) atomicMax(nrm + (b * NFH + head) * 2 + which, __float_as_uint(mx)); }
    }
    const int rsub = tid >> 5, ch = (tid & 31) * 8, win = 2 << (ch >> 6);
    const int nsc = (gridDim.x > 2 * NBATCH * NFH) ? NBATCH * NFH : 0;
    if ((int)blockIdx.x >= nsc)
    for (int c = blockIdx.x - nsc; c < MROWS / 64; c += gridDim.x - nsc) {
        const int rg = c * 64 + rsub * 4, t0 = rg % LP;
        v4u wv[19];
#pragma unroll
        for (int j = 0; j < 19; ++j) { const int back = 15 - j;
            wv[j] = (back < win && t0 - back >= 0) ? *(const v4u*)(P + (size_t)(rg - back) * NINP + PC_U + ch) : (v4u){0u, 0u, 0u, 0u}; }
#pragma unroll
        for (int i = 0; i < 4; ++i) { const int t = t0 + i, cnt = (t + 1 < win) ? t + 1 : win; float acc[8];
#pragma unroll
            for (int e = 0; e < 8; ++e) acc[e] = 0.f;
#pragma unroll
            for (int k = 0; k < 16; ++k) { if (k < cnt) {
#pragma unroll
                for (int e = 0; e < 4; ++e) { acc[2 * e] += __uint_as_float(wv[15 + i - k][e] << 16); acc[2 * e + 1] += __uint_as_float(wv[15 + i - k][e] & 0xffff0000u); } } }
            const float inv = 1.0f / (float)cnt; v4u o;
#pragma unroll
            for (int e = 0; e < 4; ++e) o[e] = pk2(acc[2 * e] * inv - __uint_as_float(wv[15 + i][e] << 16), acc[2 * e + 1] * inv - __uint_as_float(wv[15 + i][e] & 0xffff0000u));
            *(v4u*)(Y + (size_t)(rg + i) * 1024 + ch) = o; }
    }
}
__device__ __forceinline__ void attn_phase(unsigned char* ws, unsigned char* lds_g, unsigned* ctr, const unsigned* nrm, int tid) {
    const attn_body::bf16* P = (const attn_body::bf16*)(ws + WS_P); attn_body::bf16* Y = (attn_body::bf16*)(ws + WS_Y); const float* CS = (const float*)(ws + WS_CS);
    volatile LAS unsigned* bw = (volatile LAS unsigned*)((LAS unsigned char*)lds_g + LDS_MISC);
    constexpr int NU = NBATCH * NFH * (LP / 256);
    for (;;) {
        if (tid == 0) bw[0] = atomicAdd(ctr, 1u);
        __syncthreads();
        const int it = (int)bw[0];
        __syncthreads();
        if (it >= 2 * NU) break;
        const int r = it < NU ? it : it - NU; const int qb = (LP / 256 - 1) - r / (NBATCH * NFH), bh = r % (NBATCH * NFH), b = bh / NFH, h = bh % NFH;
#ifndef NO_FOX
        if (it < NU) attn_body::fox_unit<8>(b, qb, 154.0f + 2.0f * sqrtf(__uint_as_float(nrm[bh * 2]) * __uint_as_float(nrm[bh * 2 + 1])), P + PC_FQ + h * 64, P + PC_FK + h * 64, P + PC_FV + h * 64, Y + 256 + h * 64, CS + (size_t)bh * LP, (char*)lds_g);
#endif
#ifndef NO_SB
        if (it >= NU) attn_body::sb_unit(b, qb, P + PC_SQ + h * 64, P + PC_SK + h * 64, P + PC_SV + h * 64, Y + 640 + h * 64, (char*)lds_g);
#endif
    }
}
__device__ __forceinline__ void final_phase(const Args& A, unsigned char* ws, int wave, int lane) {
    const bf16u* hb = (const bf16u*)(ws + WS_HB); const float* ss = (const float*)(ws + WS_SS) + 4 * (size_t)MROWS; const f32x4* g = (const f32x4*)A.in[14] + lane;
    const int gw = blockIdx.x * NWAVES + wave, NGW = gridDim.x * NWAVES;
    f32x4 gv[4];
#pragma unroll
    for (int j = 0; j < 4; ++j) gv[j] = g[64 * j];
    for (int m = gw; m < NBATCH * SEQ_IN; m += NGW) {
        const int b = m / SEQ_IN, s = m % SEQ_IN; const size_t row = (size_t)b * LP + NMETA + s;
        const float rs = 1.0f / sqrtf(ss[row] * (1.0f / 1024.0f) + 1e-6f);
        const unsigned long long* src = (const unsigned long long*)(hb + row * 1024) + lane; f32x4* dst = (f32x4*)(A.out + (size_t)m * 1024) + lane;
#pragma unroll
        for (int j = 0; j < 4; ++j) { const unsigned long long r = src[64 * j]; const unsigned rl = (unsigned)r, rh = (unsigned)(r >> 32);
            dst[64 * j] = (f32x4){__uint_as_float(rl << 16), __uint_as_float(rl & 0xffff0000u), __uint_as_float(rh << 16), __uint_as_float(rh & 0xffff0000u)} * rs * gv[j]; }
    }
}

#define XB_TMO      128
#define XB_XCNT(j)  (256  + 64 * (j))
#define XB_XSUB(j)  (1280 + 64 * (j))
#define XB_XGEN(j)  (2304 + 64 * (j))
#define XB_TOP      3328
#define XB_TOPGEN   3392
#define XCD_BAR_WORDS 3456
#define XB_SPIN_CAP (1u << 18)

__device__ __forceinline__ unsigned xb_ld(unsigned* p)              { return __hip_atomic_load(p, __ATOMIC_RELAXED, __HIP_MEMORY_SCOPE_AGENT); }
__device__ __forceinline__ unsigned xb_add(unsigned* p, unsigned v) { return __hip_atomic_fetch_add(p, v, __ATOMIC_RELAXED, __HIP_MEMORY_SCOPE_AGENT); }
__device__ __forceinline__ unsigned xb_xcc_id() { return (unsigned)__builtin_amdgcn_s_getreg((3 << 11) | 20) & 0xFu; }
#define XB_SPIN(cond, bar) do { unsigned _sp = 0; while (cond) { __builtin_amdgcn_s_sleep(1); \
    if ((++_sp & 255u) == 0u) { if (xb_ld(&(bar)[XB_TMO])) break; if (_sp > XB_SPIN_CAP) { atomicAdd(&(bar)[XB_TMO], 1u); break; } } } } while (0)

struct XcdBarrier {
    unsigned* bar; unsigned x;
    volatile LAS unsigned* st;
};

__device__ __forceinline__ XcdBarrier xcd_barrier_post(unsigned* bar, volatile LAS unsigned* st) {
    XcdBarrier b; b.bar = bar; b.x = xb_xcc_id(); b.st = st;
    if (threadIdx.x == 0) (void)xb_add(&bar[XB_XCNT(b.x)], 1u);
    return b;
}
__device__ __forceinline__ void xcd_barrier_complete(unsigned* bar, unsigned x, unsigned& nloc, unsigned& nx) {
    const unsigned G = gridDim.x * gridDim.y * gridDim.z;
    unsigned sum, cnt, mine, sp = 0u;
    for (;;) {
        sum = 0u; cnt = 0u; mine = 0u;
#pragma unroll
        for (unsigned j = 0; j < 16; ++j) { const unsigned c = xb_ld(&bar[XB_XCNT(j)]); sum += c; cnt += (c > 0u) ? 1u : 0u; mine = (j == x) ? c : mine; }
        if (sum == G) break;
        __builtin_amdgcn_s_sleep(1);
        if ((++sp & 255u) == 0u) { if (xb_ld(&bar[XB_TMO])) break; if (sp > XB_SPIN_CAP) { atomicAdd(&bar[XB_TMO], 1u); break; } }
    }
    nloc = mine > 0u ? mine : 1u; nx = cnt > 0u ? cnt : 1u;
}

__device__ __forceinline__ void xcd_barrier(const XcdBarrier& b) {
    asm volatile("s_waitcnt vmcnt(0)" ::: "memory");
    __syncthreads();
    if (threadIdx.x == 0) {
        unsigned* bar = b.bar;
        __builtin_amdgcn_s_waitcnt(0);
        unsigned nloc = b.st[0], nx = b.st[1];
        if (nloc == 0u) { xcd_barrier_complete(bar, b.x, nloc, nx); b.st[0] = nloc; b.st[1] = nx; }
        const unsigned old = xb_add(&bar[XB_XSUB(b.x)], 1u);
        const unsigned gen = old / nloc;
        if (old + 1u == (gen + 1u) * nloc) {
            __builtin_amdgcn_fence(__ATOMIC_RELEASE, "agent");
            asm volatile("s_waitcnt vmcnt(0)" ::: "memory");
            const unsigned og = xb_add(&bar[XB_TOP], 1u);
            const unsigned tg = og / nx;
            if (og + 1u == (tg + 1u) * nx) xb_add(&bar[XB_TOPGEN], 1u);
            else XB_SPIN(xb_ld(&bar[XB_TOPGEN]) == tg, bar);
            __builtin_amdgcn_fence(__ATOMIC_ACQUIRE, "agent");
            xb_add(&bar[XB_XGEN(b.x)], 1u);
            asm volatile("s_waitcnt vmcnt(0)" ::: "memory");
        } else {
            XB_SPIN(xb_ld(&bar[XB_XGEN(b.x)]) == gen, bar);
            __builtin_amdgcn_fence(__ATOMIC_ACQUIRE, "agent");
            asm volatile("s_waitcnt vmcnt(0)" ::: "memory");
        }
    }
    __syncthreads();
}

#define FRESH() unsigned long zoff_ = 0; asm volatile("" : "+s"(zoff_)); unsigned char* ws = A.ws + zoff_; int tid = threadIdx.x; asm volatile("" : "+v"(tid)); const int lane = tid & 63, wave = __builtin_amdgcn_readfirstlane(tid >> 6); (void)lane; (void)wave
#ifdef PROBE
#define STAMP() do { if (blockIdx.x == 0 && threadIdx.x == 0) { ((volatile unsigned long long*)(A.ws + WS_CTL + 8192))[nst] = __builtin_amdgcn_s_memrealtime(); } ++nst; } while (0)
#else
#define STAMP() do {} while (0)
#endif
__global__ void __launch_bounds__(NWAVES * 64, 2) hymba_fwd(Args A) {
    extern __shared__ __attribute__((aligned(16))) unsigned char lds[];
    cg::grid_group grid = cg::this_grid();
    LAS unsigned char* L = (LAS unsigned char*)lds;
    if (threadIdx.x < 2) ((volatile LAS unsigned*)(L + LDS_MISC + 64))[threadIdx.x] = 0u;
    __syncthreads();
    const XcdBarrier xbar = xcd_barrier_post((unsigned*)(A.ws + WS_CTL) + 4096, (volatile LAS unsigned*)(L + LDS_MISC + 64));
#define GRID_BAR() xcd_barrier(xbar)
#ifdef PROBE
    int nst = 0; STAMP();
    for (int i = 0; i < 8; ++i) GRID_BAR();
    STAMP();
#endif
#ifndef NO_PRO
    { FRESH(); p0_prologue(A, ws, L, wave, lane); }
#endif
    if (A.ws == nullptr) grid.sync();
    GRID_BAR(); STAMP();
    for (int layer = 0; layer < DEPTH; ++layer) {
#ifndef NO_G1
        {
            FRESH(); const unsigned char* wb = ws + WS_W + (size_t)layer * W_LAYER;
            pg8::Gemm g{(const pg8::bf16_t*)(ws + WS_HB), (const pg8::bf16_t*)(wb + W_IN), MREAL, NIN, 1024}; pg8::StaticOrder S; S.init(MREAL, NIN, (int)gridDim.x, (int)blockIdx.x);
            pg8::EpiIn E{(pg8::bf16_t*)(ws + WS_P), (float*)(ws + WS_LF), (const float*)(ws + WS_SS) + (size_t)(2 * layer) * MROWS, A.in[4] + layer * NFH};
            mini_in(ws, (const bf16u*)(wb + W_IN), (const float*)(ws + WS_SS) + (size_t)(2 * layer) * MROWS, A.in[4] + layer * NFH, L, wave, lane);
            pg8::gemm_phase<pg8::EpiIn, pg8::StaticOrder, true, true>(L, g, S, E);
        }
#endif
        GRID_BAR(); STAMP();
#ifndef NO_POOL
        { FRESH(); pool_scan_phase(ws, L, (unsigned*)(ws + WS_CTL) + 128 + 64 * layer, tid, wave, lane); }
#endif
        GRID_BAR(); STAMP();
        { FRESH(); attn_phase(ws, lds, (unsigned*)(ws + WS_CTL) + 64 * layer, (const unsigned*)(ws + WS_CTL) + 128 + 64 * layer, tid); }
        GRID_BAR(); STAMP();
#ifndef NO_G3
        {
            FRESH(); const unsigned char* wb = ws + WS_W + (size_t)layer * W_LAYER;
            pg8::Gemm g{(const pg8::bf16_t*)(ws + WS_Y), (const pg8::bf16_t*)(wb + W_OUT), MREAL, 1024, 1024}; pg8::StaticOrder S; S.init(MREAL, 1024, (int)gridDim.x, (int)blockIdx.x);
            pg8::EpiRes E{(pg8::bf16_t*)(ws + WS_HB), nullptr, (float*)(ws + WS_SS) + (size_t)(2 * layer + 1) * MROWS};
            mini_res(ws, (const bf16u*)(ws + WS_Y), (const bf16u*)(wb + W_OUT), 1024, (float*)(ws + WS_SS) + (size_t)(2 * layer + 1) * MROWS, L, wave, lane);
            pg8::gemm_phase<pg8::EpiRes, pg8::StaticOrder, true, true>(L, g, S, E);
        }
#endif
        GRID_BAR(); STAMP();
#ifndef NO_G4
        {
            FRESH(); const unsigned char* wb = ws + WS_W + (size_t)layer * W_LAYER;
            pg8::Gemm g{(const pg8::bf16_t*)(ws + WS_HB), (const pg8::bf16_t*)(wb + W_GU), MREAL, NGU, 1024}; pg8::StaticOrder S; S.init(MREAL, NGU, (int)gridDim.x, (int)blockIdx.x);
            pg8::EpiGU E{(pg8::bf16_t*)(ws + WS_P), (const float*)(ws + WS_SS) + (size_t)(2 * layer + 1) * MROWS};
            mini_gu(ws, (const bf16u*)(wb + W_GU), (const float*)(ws + WS_SS) + (size_t)(2 * layer + 1) * MROWS, L, wave, lane);
            pg8::gemm_phase<pg8::EpiGU, pg8::StaticOrder, true, true>(L, g, S, E);
        }
#endif
        GRID_BAR(); STAMP();
#ifndef NO_G5
        {
            FRESH(); const unsigned char* wb = ws + WS_W + (size_t)layer * W_LAYER;
            pg8::Gemm g{(const pg8::bf16_t*)(ws + WS_P), (const pg8::bf16_t*)(wb + W_D), MREAL, 1024, DFF}; pg8::StaticOrder S; S.init(MREAL, 1024, (int)gridDim.x, (int)blockIdx.x);
            pg8::EpiRes E{(pg8::bf16_t*)(ws + WS_HB), nullptr, (float*)(ws + WS_SS) + (size_t)(2 * layer + 2) * MROWS};
            mini_res(ws, (const bf16u*)(ws + WS_P), (const bf16u*)(wb + W_D), DFF, (float*)(ws + WS_SS) + (size_t)(2 * layer + 2) * MROWS, L, wave, lane);
            pg8::gemm_phase<pg8::EpiRes, pg8::StaticOrder, true, true>(L, g, S, E);
        }
#endif
        GRID_BAR(); STAMP();
    }
    { FRESH(); final_phase(A, ws, wave, lane); }
#ifdef PROBE
    STAMP();
    grid.sync();
    {
        volatile unsigned long long* T = (volatile unsigned long long*)(A.ws + WS_CTL + 8192);
        if (blockIdx.x == 0) {
            const unsigned long long dA = T[PA + 1] - T[PA], dB = T[PB + 1] - T[PB];
            for (unsigned long long i = threadIdx.x; i < dB; i += NWAVES * 64) A.out[i] += 0.125f;
            if (threadIdx.x == 0) { const unsigned long long t0 = __builtin_amdgcn_s_memrealtime(); while (__builtin_amdgcn_s_memrealtime() - t0 < dA) __builtin_amdgcn_s_sleep(8); }
        }
    }
#endif
}

extern "C" void kernel_launch(void* const* d_in, const int* in_sizes, int n_in, void* d_out, int out_size, void* d_ws, size_t ws_size, hipStream_t stream) {
    static int grid = 0;
    if (grid == 0) {
        if (n_in != 15 || out_size != NBATCH * SEQ_IN * DMODEL || ws_size < WS_END) { fprintf(stderr, "kernel_launch: unexpected shapes (n_in %d out %d ws %zu, need %zu)\n", n_in, out_size, ws_size, (size_t)WS_END); grid = -1; return; }
        int dev = 0, cus = 0, per_cu = 0;
        if (hipGetDevice(&dev) != hipSuccess || hipDeviceGetAttribute(&cus, hipDeviceAttributeMultiprocessorCount, dev) != hipSuccess) { grid = -1; return; }
        if (hipFuncSetAttribute((const void*)hymba_fwd, hipFuncAttributeMaxDynamicSharedMemorySize, LDS_BYTES) != hipSuccess) { fprintf(stderr, "kernel_launch: hipFuncSetAttribute failed\n"); grid = -1; return; }
        if (hipOccupancyMaxActiveBlocksPerMultiprocessor(&per_cu, (const void*)hymba_fwd, NWAVES * 64, LDS_BYTES) != hipSuccess || per_cu < 1) { fprintf(stderr, "kernel_launch: occupancy query says %d\n", per_cu); per_cu = 1; }
        (void)hipGetLastError();
        grid = cus;
    }
    if (grid < 0) return;
    if (hipMemsetAsync((char*)d_ws + WS_CTL, 0, CTL_ZERO_BYTES, stream) != hipSuccess) { fprintf(stderr, "kernel_launch: memset failed\n"); return; }
    Args a{};
    for (int i = 0; i < 15; ++i) a.in[i] = (const float*)d_in[i];
    a.out = (float*)d_out; a.ws = (unsigned char*)d_ws;
    void* args[] = {&a};
    const hipError_t e = hipLaunchCooperativeKernel((const void*)hymba_fwd, dim3(grid), dim3(NWAVES * 64), args, LDS_BYTES, stream);
    if (e != hipSuccess) fprintf(stderr, "kernel_launch: cooperative launch failed: %s (grid %d)\n", hipGetErrorString(e), grid);
}
```

```cpp
#include <hip/hip_runtime.h>
#include <hip/hip_cooperative_groups.h>
#include <cstdio>
#include <cstdint>
namespace pg8 {
#define PG8_LAS __attribute__((address_space(3)))
typedef unsigned short bf16_t;
typedef short bf16x8 __attribute__((ext_vector_type(8)));
typedef float f32x4 __attribute__((ext_vector_type(4)));
typedef unsigned u32x4 __attribute__((ext_vector_type(4)));
constexpr int BM = 256, BK = 64, HALF = 128, HTB = HALF * BK * 2  , STAGE_BYTES = 8 * HTB, NXCD = 8, WGM = 8;

__host__ __device__ __forceinline__ int lds_byte(int r, int c) { const int st = (r >> 4) * 2 + (c >> 5), rr = r & 15, cc = c & 31, ob = rr * 64 + cc * 2; return st * 1024 + (ob ^ (((ob >> 9) & 1) << 5)); }
__host__ __device__ __forceinline__ void stage_rc(int b, int& R, int& C) { const int st = b / 1024, sb = b % 1024, swz = sb ^ (((sb >> 9) & 1) << 5); R = (st >> 1) * 16 + swz / 64; C = (st & 1) * 32 + (swz % 64) / 2; }
__host__ __device__ __forceinline__ int perm32(int rho) { const int n = rho >> 4, i = rho & 15; return 8 * (i >> 2) + 4 * n + (i & 3); }

struct Unit { int pm, pn; };
__host__ __device__ __forceinline__ int arow(int pm) { return 256 * (pm + (pm >> 5)) + 16; }
struct Gemm { const bf16_t* A; const bf16_t* Bt; int M, N, K; };

struct StaticOrder {
    int nM, nN, nwg, G, c;
    __host__ __device__ void init(int M, int N, int G_, int c_) { nM = M / BM; nN = N / BM; nwg = nM * nN; G = G_; c = c_; }
    __host__ __device__ bool next(int i, Unit& u) const {
        const long L = (long)i * G + c; if (L >= nwg) return false;
        int wgid = (int)L; { const int q = nwg / NXCD, r = nwg % NXCD, xcd = wgid % NXCD, off = wgid / NXCD; wgid = (xcd < r ? xcd * (q + 1) : r * (q + 1) + (xcd - r) * q) + off; }
        const int nig = WGM * nN, gid = wgid / nig, fm = gid * WGM, gsz = (nM - fm) < WGM ? (nM - fm) : WGM;
        u.pm = fm + ((wgid % nig) % gsz); u.pn = (wgid % nig) / gsz; return true;
    }
    __device__ __forceinline__ void a_ready(const Unit&) const {}
    __device__ __forceinline__ void done(const Unit&) const {}
};

__device__ __forceinline__ unsigned cvt_pk_bf16(float lo, float hi) { unsigned r; asm volatile("v_cvt_pk_bf16_f32 %0, %1, %2" : "=v"(r) : "v"(lo), "v"(hi)); return r; }
typedef unsigned u32x2 __attribute__((ext_vector_type(2)));
constexpr float RMS_EPS = 1e-6f;
struct EpiIn {
    static constexpr bool PERM = true, AFTER_DRAIN = false;
    bf16_t* P; float* LF; const float* ss; const float* fb;
    __device__ __forceinline__ void operator()(const f32x4 (&acc)[2][2][4][2], const Unit& u, int wr, int wc, int fr, int fq) const {
        const int row0 = arow(u.pm) + wr * 64 + fr;
        {
            const int col0 = u.pn * BM + wc * 32 + 8 * fq;
#pragma unroll
            for (int ai = 0; ai < 2; ++ai)
#pragma unroll
                for (int m = 0; m < 4; ++m) { const int row = row0 + ai * HALF + m * 16; const float rs = __builtin_amdgcn_rsqf(ss[row] * (1.0f / 1024.0f) + RMS_EPS);
                    bf16_t* rowp = P + (size_t)row * 2560 + col0;
#pragma unroll
                    for (int bj = 0; bj < 2; ++bj) { const f32x4 v0 = acc[ai][bj][m][0] * rs, v1 = acc[ai][bj][m][1] * rs;
                        u32x4 w; w.x = cvt_pk_bf16(v0[0], v0[1]); w.y = cvt_pk_bf16(v0[2], v0[3]); w.z = cvt_pk_bf16(v1[0], v1[1]); w.w = cvt_pk_bf16(v1[2], v1[3]);
                        *(u32x4*)(rowp + bj * HALF) = w; } }
        }
    }
};
struct EpiRes {
    static constexpr bool PERM = true, AFTER_DRAIN = false;
    bf16_t* hb; float* hf; float* ssn;
    __device__ __forceinline__ void operator()(const f32x4 (&acc)[2][2][4][2], const Unit& u, int wr, int wc, int fr, int fq) const {
        const int row0 = arow(u.pm) + wr * 64 + fr, col0 = u.pn * BM + wc * 32 + 8 * fq;
#pragma unroll
        for (int ai = 0; ai < 2; ++ai)
#pragma unroll
            for (int m = 0; m < 4; ++m) { const int row = row0 + ai * HALF + m * 16; bf16_t* bp = hb + (size_t)row * 1024 + col0; float s = 0.f;
#pragma unroll
                for (int bj = 0; bj < 2; ++bj) { const u32x4 r = *(const u32x4*)(bp + bj * HALF);
                    f32x4 a = (f32x4){__uint_as_float(r.x << 16), __uint_as_float(r.x & 0xffff0000u), __uint_as_float(r.y << 16), __uint_as_float(r.y & 0xffff0000u)};
                    f32x4 b = (f32x4){__uint_as_float(r.z << 16), __uint_as_float(r.z & 0xffff0000u), __uint_as_float(r.w << 16), __uint_as_float(r.w & 0xffff0000u)};
                    a = a + acc[ai][bj][m][0]; b = b + acc[ai][bj][m][1];
                    if (hf) { float* hp = hf + (size_t)row * 1024 + col0 + bj * HALF; *(f32x4*)hp = a; *(f32x4*)(hp + 4) = b; }
                    s += (a[0] * a[0] + a[1] * a[1]) + (a[2] * a[2] + a[3] * a[3]) + (b[0] * b[0] + b[1] * b[1]) + (b[2] * b[2] + b[3] * b[3]);
                    u32x4 w; w.x = cvt_pk_bf16(a[0], a[1]); w.y = cvt_pk_bf16(a[2], a[3]); w.z = cvt_pk_bf16(b[0], b[1]); w.w = cvt_pk_bf16(b[2], b[3]);
                    *(u32x4*)(bp + bj * HALF) = w; }
                s += __shfl_xor(s, 16); s += __shfl_xor(s, 32);
                if (fq == 0) atomicAdd(ssn + row, s);
                asm volatile("" ::: "memory"); }
    }
};
struct EpiGU {
    static constexpr bool PERM = true, AFTER_DRAIN = false;
    bf16_t* H; const float* ss;
    __device__ __forceinline__ void operator()(const f32x4 (&acc)[2][2][4][2], const Unit& u, int wr, int wc, int fr, int fq) const {
        const int row0 = arow(u.pm) + wr * 64 + fr, col0 = u.pn * HALF + wc * 32 + 8 * fq;
#pragma unroll
        for (int ai = 0; ai < 2; ++ai)
#pragma unroll
            for (int m = 0; m < 4; ++m) { const int row = row0 + ai * HALF + m * 16; const float rs = __builtin_amdgcn_rsqf(ss[row] * (1.0f / 1024.0f) + RMS_EPS);
                float o[8];
#pragma unroll
                for (int n = 0; n < 2; ++n)
#pragma unroll
                    for (int e = 0; e < 4; ++e) { const float g = acc[ai][0][m][n][e] * rs, up = acc[ai][1][m][n][e] * rs;
                        o[4 * n + e] = g * __builtin_amdgcn_rcpf(1.0f + __builtin_amdgcn_exp2f(-1.4426950408889634f * g)) * up; }
                u32x4 w; w.x = cvt_pk_bf16(o[0], o[1]); w.y = cvt_pk_bf16(o[2], o[3]); w.z = cvt_pk_bf16(o[4], o[5]); w.w = cvt_pk_bf16(o[6], o[7]);
                *(u32x4*)(H + (size_t)row * 2816 + col0) = w; }
    }
};
template <class Epi, class Sched, bool ALIGN_EPI = false, bool SP2 = false>
__device__ __forceinline__ void gemm_phase(PG8_LAS unsigned char* lds, const Gemm g, const Sched& S, const Epi& E) {
    int tid_ = threadIdx.x; asm volatile("" : "+v"(tid_));
    const int tid = tid_, wid = __builtin_amdgcn_readfirstlane(tid >> 6), lane = tid & 63, wr = wid >> 2, wc = wid & 3, fr = lane & 15, fq = lane >> 4;
    const int K = g.K, nt = K / BK;
    unsigned voffA[2], voffB[2];
#pragma unroll
    for (int i = 0; i < 2; ++i) { int R, C; stage_rc(tid * 16 + i * 8192, R, C); const int Rb = Epi::PERM ? ((R & ~31) + perm32(R & 31)) : R;
        voffA[i] = (unsigned)(R * K + C) * 2u; voffB[i] = (unsigned)(Rb * K + C) * 2u; }
    const size_t kstep = (size_t)(BK * 2);
    const size_t hstep = (size_t)HALF * K * 2;
    const size_t tstep = 2 * hstep;
    const unsigned ldsw = (unsigned)wid * 1024u;
    const int aoff = lds_byte(wr * 64 + fr, fq * 8), boff = lds_byte(wc * 32 + fr, fq * 8);
#define PG8_SA(b, h) (((b) * 2 + (h)) * HTB)
#define PG8_SB(b, h) ((4 + (b) * 2 + (h)) * HTB)
#define PG8_STAGE(bufoff, gbase, voff) do { _Pragma("unroll") for (int _i = 0; _i < 2; ++_i) \
        __builtin_amdgcn_global_load_lds((const unsigned*)((const char*)(gbase) + (voff)[_i]), (PG8_LAS unsigned*)(lds + (bufoff) + ldsw + _i * 8192), 16, 0, 0); } while (0)
#define PG8_LDA(dst, b, h) do { _Pragma("unroll") for (int m = 0; m < 4; ++m) _Pragma("unroll") for (int k = 0; k < 2; ++k) dst[m][k] = *(const PG8_LAS bf16x8*)(lds + PG8_SA(b, h) + aoff + m * 2048 + k * 1024); } while (0)
#define PG8_LDB(dst, b, h) do { _Pragma("unroll") for (int n = 0; n < 2; ++n) _Pragma("unroll") for (int k = 0; k < 2; ++k) dst[n][k] = *(const PG8_LAS bf16x8*)(lds + PG8_SB(b, h) + boff + n * 2048 + k * 1024); } while (0)
#define PG8_MMA(ai, bj, At, Bt) do { __builtin_amdgcn_s_setprio(1); _Pragma("unroll") for (int m = 0; m < 4; ++m) _Pragma("unroll") for (int n = 0; n < 2; ++n) _Pragma("unroll") for (int k = 0; k < 2; ++k) \
        acc[ai][bj][m][n] = __builtin_amdgcn_mfma_f32_16x16x32_bf16(Bt[n][k], At[m][k], acc[ai][bj][m][n], 0, 0, 0); __builtin_amdgcn_s_setprio(0); } while (0)
#define PG8_WAIT_V(n) asm volatile("s_waitcnt vmcnt(" #n ")" ::: "memory")
#define PG8_WAIT_L(n) asm volatile("s_waitcnt lgkmcnt(" #n ")" ::: "memory")
#define PG8_BAR __builtin_amdgcn_s_barrier()
#define PG8_SCHED __builtin_amdgcn_sched_barrier(0)
    Unit cur, nxt; int ui = 0;
    if (!S.next(0, cur)) return;
    f32x4 acc[2][2][4][2];
#pragma unroll
    for (int a = 0; a < 2; ++a)
#pragma unroll
        for (int b = 0; b < 2; ++b)
#pragma unroll
            for (int m = 0; m < 4; ++m)
#pragma unroll
                for (int n = 0; n < 2; ++n) acc[a][b][m][n] = (f32x4){0.f, 0.f, 0.f, 0.f};
    bf16x8 At[4][2], B0[2][2], B1[2][2];
    const char* cA = (const char*)g.A + (size_t)arow(cur.pm) * K * 2; const char* cB = (const char*)g.Bt + (size_t)cur.pn * tstep;
    S.a_ready(cur);
    if constexpr (SP2) {
        PG8_STAGE(PG8_SB(0, 0), cB, voffB); PG8_STAGE(PG8_SB(0, 1), cB + hstep, voffB); PG8_STAGE(PG8_SA(0, 0), cA, voffA); PG8_STAGE(PG8_SA(0, 1), cA + hstep, voffA);
        if (wr == 1) PG8_BAR;
        PG8_WAIT_V(2); PG8_BAR;
        PG8_STAGE(PG8_SB(1, 0), cB + kstep, voffB); PG8_STAGE(PG8_SA(1, 0), cA + kstep, voffA); PG8_STAGE(PG8_SB(1, 1), cB + hstep + kstep, voffB);
        PG8_WAIT_V(6); PG8_BAR;
    } else {
        PG8_STAGE(PG8_SB(0, 0), cB, voffB); PG8_STAGE(PG8_SA(0, 0), cA, voffA); PG8_STAGE(PG8_SB(0, 1), cB + hstep, voffB); PG8_STAGE(PG8_SA(0, 1), cA + hstep, voffA);
        if (wr == 1) PG8_BAR;
        PG8_WAIT_V(4); PG8_BAR;
        PG8_STAGE(PG8_SB(1, 0), cB + kstep, voffB); PG8_STAGE(PG8_SA(1, 0), cA + kstep, voffA); PG8_STAGE(PG8_SB(1, 1), cB + hstep + kstep, voffB);
        PG8_WAIT_V(6); PG8_BAR;
    }
    for (;;) {
        const bool has_next = S.next(ui + 1, nxt);
        const char* nA = has_next ? (const char*)g.A + (size_t)arow(nxt.pm) * K * 2 : cA; const char* nB = has_next ? (const char*)g.Bt + (size_t)nxt.pn * tstep : cB;
        for (int t = 0; t < nt; t += 2) {
            const bool last = (t == nt - 2);
            const char* a1 = cA + (size_t)(t + 1) * kstep;
            const char* a2 = last ? nA : cA + (size_t)(t + 2) * kstep; const char* b2 = last ? nB : cB + (size_t)(t + 2) * kstep;
            const char* a3 = a2 + kstep; const char* b3 = b2 + kstep;
            if (last && has_next) S.a_ready(nxt);
            if constexpr (SP2) {
            PG8_LDB(B0, 0, 0); PG8_LDB(B1, 0, 1); PG8_SCHED; PG8_LDA(At, 0, 0); PG8_STAGE(PG8_SA(1, 1), a1 + hstep, voffA);
            PG8_WAIT_V(8); PG8_WAIT_L(0); PG8_BAR; PG8_MMA(0, 0, At, B0); PG8_MMA(0, 1, At, B1); PG8_BAR; PG8_SCHED;
            PG8_LDA(At, 0, 1); PG8_STAGE(PG8_SB(0, 0), b2, voffB); PG8_STAGE(PG8_SB(0, 1), b2 + hstep, voffB); PG8_STAGE(PG8_SA(0, 0), a2, voffA);
            PG8_WAIT_V(8); PG8_WAIT_L(0); PG8_BAR; PG8_MMA(1, 0, At, B0); PG8_MMA(1, 1, At, B1); PG8_BAR; PG8_SCHED;
            PG8_LDB(B0, 1, 0); PG8_LDB(B1, 1, 1); PG8_SCHED; PG8_LDA(At, 1, 0); PG8_STAGE(PG8_SA(0, 1), a2 + hstep, voffA);
            PG8_WAIT_V(8); PG8_WAIT_L(0); PG8_BAR; PG8_MMA(0, 0, At, B0); PG8_MMA(0, 1, At, B1); PG8_BAR; PG8_SCHED;
            PG8_LDA(At, 1, 1); PG8_STAGE(PG8_SB(1, 0), b3, voffB); PG8_STAGE(PG8_SB(1, 1), b3 + hstep, voffB); PG8_STAGE(PG8_SA(1, 0), a3, voffA);
            PG8_WAIT_V(8); PG8_WAIT_L(0); PG8_BAR; PG8_MMA(1, 0, At, B0); PG8_MMA(1, 1, At, B1); PG8_BAR; PG8_SCHED;
            } else {
            PG8_LDB(B0, 0, 0); PG8_SCHED; PG8_LDA(At, 0, 0); PG8_STAGE(PG8_SA(1, 1), a1 + hstep, voffA);
            PG8_WAIT_L(8); PG8_BAR; PG8_WAIT_L(0); PG8_MMA(0, 0, At, B0); PG8_BAR; PG8_SCHED;
            PG8_LDB(B1, 0, 1); PG8_STAGE(PG8_SB(0, 0), b2, voffB);
            PG8_BAR; PG8_WAIT_L(0); PG8_MMA(0, 1, At, B1); PG8_BAR;
            PG8_LDA(At, 0, 1); PG8_STAGE(PG8_SA(0, 0), a2, voffA);
            PG8_BAR; PG8_WAIT_L(0); PG8_MMA(1, 0, At, B0); PG8_BAR; PG8_SCHED;
            PG8_STAGE(PG8_SB(0, 1), b2 + hstep, voffB);
            PG8_WAIT_V(6); PG8_BAR; PG8_MMA(1, 1, At, B1); PG8_BAR;
            PG8_LDB(B0, 1, 0); PG8_SCHED; PG8_LDA(At, 1, 0); PG8_STAGE(PG8_SA(0, 1), a2 + hstep, voffA);
            PG8_WAIT_L(8); PG8_BAR; PG8_WAIT_L(0); PG8_MMA(0, 0, At, B0); PG8_BAR; PG8_SCHED;
            PG8_LDB(B1, 1, 1); PG8_STAGE(PG8_SB(1, 0), b3, voffB);
            PG8_BAR; PG8_WAIT_L(0); PG8_MMA(0, 1, At, B1); PG8_BAR;
            PG8_LDA(At, 1, 1); PG8_STAGE(PG8_SA(1, 0), a3, voffA);
            PG8_BAR; PG8_WAIT_L(0); PG8_MMA(1, 0, At, B0); PG8_BAR; PG8_SCHED;
            PG8_STAGE(PG8_SB(1, 1), b3 + hstep, voffB);
            PG8_WAIT_V(6); PG8_BAR; PG8_MMA(1, 1, At, B1); PG8_BAR;
            }
        }
        if constexpr (ALIGN_EPI) { if (wr == 0) PG8_BAR; }
        if constexpr (!Epi::AFTER_DRAIN) { E(acc, cur, wr, wc, fr, fq); S.done(cur); }
        if (!has_next) break;
#pragma unroll
        for (int a = 0; a < 2; ++a)
#pragma unroll
            for (int b = 0; b < 2; ++b)
#pragma unroll
                for (int m = 0; m < 4; ++m)
#pragma unroll
                    for (int n = 0; n < 2; ++n) acc[a][b][m][n] = (f32x4){0.f, 0.f, 0.f, 0.f};
        cur = nxt; cA = nA; cB = nB; ++ui;
        if constexpr (ALIGN_EPI) { if (wr == 1) PG8_BAR; }
    }
    PG8_WAIT_V(0);
    if constexpr (!ALIGN_EPI) { if (wr == 0) PG8_BAR; }
    PG8_BAR;
    if constexpr (Epi::AFTER_DRAIN) { E.fused(acc, cur, wr, wc, fr, fq, lds, wid, lane); S.done(cur); }
#undef PG8_SA
#undef PG8_SB
#undef PG8_STAGE
#undef PG8_LDA
#undef PG8_LDB
#undef PG8_MMA
#undef PG8_WAIT_V
#undef PG8_WAIT_L
#undef PG8_BAR
#undef PG8_SCHED
}
}
#include <hip/hip_bf16.h>
#include <cmath>
namespace attn_body {
using bf16=__hip_bfloat16;
using bf16x8=__attribute__((ext_vector_type(8)))short;
using s16x4=__attribute__((ext_vector_type(4)))short;
using f32x16=__attribute__((ext_vector_type(16)))float;
using u32x4=__attribute__((ext_vector_type(4)))unsigned;
constexpr int SEQ=8448,D=64,DM=2560,DMO=1024;
using f32x4=__attribute__((ext_vector_type(4)))float;
constexpr int NW=8,QBLK=32,QB=QBLK*NW,KVBLK=64,NQB=SEQ/QB;
constexpr int ATTN_UNIT_ROWS=QB;
__device__ __forceinline__ int crow(int r,int hi){return (r&3)+8*(r>>2)+4*hi;}
#define SBAR() __builtin_amdgcn_sched_barrier(0)
__device__ __forceinline__ void cmask(f32x16&p0,f32x16&p1,int jb,int qrel,int hi){
  const float NEG=-INFINITY; int kb=64*jb+4*hi;
  #pragma unroll
  for(int r=0;r<16;++r){int kv=kb+(r&3)+8*(r>>2); if(kv>qrel)p0[r]=NEG; if(kv+32>qrel)p1[r]=NEG;}
}

constexpr int NSLOT=3, SLOTB=8192;
constexpr int LDS_K=0, LDS_V=NSLOT*SLOTB, LDS_WS=2*NSLOT*SLOTB, LDS_OST=LDS_WS+NW*64*4, LDS_BYTES=LDS_OST+NW*4096, LDS_CS=LDS_BYTES, LDS_FLAGS=LDS_CS+SEQ*4, LDS_END=LDS_FLAGS+256;
constexpr float C2=0.125f*1.4426950408889634f;
__device__ __forceinline__ void glds16(const void*gsrc,unsigned lds_dst){unsigned keep;
  asm volatile("s_mov_b32 %0, m0\n\ts_mov_b32 m0, %2\n\ts_nop 0\n\tglobal_load_lds_dwordx4 %1, off\n\ts_mov_b32 m0, %0":"=&s"(keep):"v"(gsrc),"s"(lds_dst):"memory");}
__device__ __forceinline__ float max3f(float a,float b,float c){float r;asm("v_max3_f32 %0, %1, %2, %3":"=v"(r):"v"(a),"v"(b),"v"(c));return r;}
__device__ __forceinline__ float max2f(float a,float b){float r;asm("v_max_f32_e32 %0, %1, %2":"=v"(r):"v"(a),"v"(b));return r;}
__device__ __forceinline__ float fadd_s(float a,float b){float r;asm("v_add_f32_e32 %0, %1, %2":"=v"(r):"v"(a),"v"(b));return r;}
__device__ __forceinline__ float fsub_s(float a,float b){float r;asm("v_sub_f32_e32 %0, %1, %2":"=v"(r):"v"(a),"v"(b));return r;}
typedef float f32x2_t __attribute__((ext_vector_type(2))); typedef __bf16 bf16x2_t __attribute__((ext_vector_type(2)));
__device__ __forceinline__ unsigned cvtpk_s(float lo,float hi){f32x2_t v={lo,hi};bf16x2_t b=__builtin_convertvector(v,bf16x2_t);return __builtin_bit_cast(unsigned,b);}
#define WAIT_BAR(N) asm volatile("s_waitcnt vmcnt(" #N ") lgkmcnt(0)\n\ts_barrier":::"memory")

__device__ __forceinline__ void qkt(f32x16&p0,f32x16&p1,const char*Kslot,const bf16x8*qr,int r32,int hi){
  const char*kb=Kslot+hi*1024+r32*16;
  #pragma unroll
  for(int d0=0;d0<4;++d0){
    const bf16x8 b0=*reinterpret_cast<const bf16x8*>(kb+d0*2048);
    const bf16x8 b1=*reinterpret_cast<const bf16x8*>(kb+d0*2048+512);
    {p0=__builtin_amdgcn_mfma_f32_32x32x16_bf16(b0,qr[d0],p0,0,0,0);p1=__builtin_amdgcn_mfma_f32_32x32x16_bf16(b1,qr[d0],p1,0,0,0);}}
}
typedef __attribute__((address_space(3))) const char* lds_cptr;
typedef short v4i16_t __attribute__((ext_vector_type(4)));
__device__ __forceinline__ void kload8(bf16x8*kf,lds_cptr kp){
  kf[0]=*(const __attribute__((address_space(3))) bf16x8*)(kp);      kf[1]=*(const __attribute__((address_space(3))) bf16x8*)(kp+512);
  kf[2]=*(const __attribute__((address_space(3))) bf16x8*)(kp+2048); kf[3]=*(const __attribute__((address_space(3))) bf16x8*)(kp+2560);
  kf[4]=*(const __attribute__((address_space(3))) bf16x8*)(kp+4096); kf[5]=*(const __attribute__((address_space(3))) bf16x8*)(kp+4608);
  kf[6]=*(const __attribute__((address_space(3))) bf16x8*)(kp+6144); kf[7]=*(const __attribute__((address_space(3))) bf16x8*)(kp+6656);
}
__device__ __forceinline__ void kload2(bf16x8*kf,lds_cptr kp,int j){ kf[2*j]=*(const __attribute__((address_space(3))) bf16x8*)(kp+j*2048); kf[2*j+1]=*(const __attribute__((address_space(3))) bf16x8*)(kp+j*2048+512); }
__device__ __forceinline__ s16x4 vtr(lds_cptr p){ return __builtin_bit_cast(s16x4,__builtin_amdgcn_ds_read_tr16_b64_v4i16((__attribute__((address_space(3))) v4i16_t*)p)); }
__device__ __forceinline__ float rowmax(const f32x16&p0,const f32x16&p1){
  float a=max3f(p0[0],p0[1],p1[0]),b=max3f(p0[2],p0[3],p1[1]);a=max3f(a,p1[2],p1[3]);
  #pragma unroll
  for(int r=4;r<16;r+=4){a=max3f(a,p0[r],p0[r+1]);b=max3f(b,p0[r+2],p0[r+3]);a=max3f(a,p1[r],p1[r+1]);b=max3f(b,p1[r+2],p1[r+3]);}
  const float m=max2f(a,b);
  auto rr=__builtin_amdgcn_permlane32_swap(__float_as_uint(m),__float_as_uint(m),false,false);
  return max2f(__uint_as_float(rr[0]),__uint_as_float(rr[1]));
}
__device__ __forceinline__ void pv(f32x16*o,int vb,bf16x8 pa0,bf16x8 pa1,bf16x8 pa2,bf16x8 pa3){
  #pragma unroll
  for(int d0=0;d0<2;++d0){s16x4 lo[4],hi[4];
    #pragma unroll
    for(int ks=0;ks<4;++ks){
      asm volatile("ds_read_b64_tr_b16 %0,%1 offset:%c2":"=&v"(lo[ks]):"v"(vb),"i"(d0*4096+ks*1024):"memory");
      asm volatile("ds_read_b64_tr_b16 %0,%1 offset:%c2":"=&v"(hi[ks]):"v"(vb),"i"(d0*4096+ks*1024+512):"memory");}
    asm volatile("s_waitcnt lgkmcnt(0)":::"memory");SBAR();
    #define PK(k) (bf16x8){lo[k][0],lo[k][1],lo[k][2],lo[k][3],hi[k][0],hi[k][1],hi[k][2],hi[k][3]}
    o[d0]=__builtin_amdgcn_mfma_f32_32x32x16_bf16(pa0,PK(0),o[d0],0,0,0);
    o[d0]=__builtin_amdgcn_mfma_f32_32x32x16_bf16(pa1,PK(1),o[d0],0,0,0);
    o[d0]=__builtin_amdgcn_mfma_f32_32x32x16_bf16(pa2,PK(2),o[d0],0,0,0);
    o[d0]=__builtin_amdgcn_mfma_f32_32x32x16_bf16(pa3,PK(3),o[d0],0,0,0);
    #undef PK
  }
}

__device__ __forceinline__ u32x4 head_rms(u32x4 v){ float x[8];
  #pragma unroll
  for(int i=0;i<4;++i){x[2*i]=__uint_as_float(v[i]<<16);x[2*i+1]=__uint_as_float(v[i]&0xffff0000u);}
  float s=0.f;
  #pragma unroll
  for(int i=0;i<8;++i)s+=x[i]*x[i];
  s+=__shfl_xor(s,1);s+=__shfl_xor(s,2);s+=__shfl_xor(s,4);
  const float rs=__builtin_amdgcn_rsqf(s*(1.0f/64.0f)+1e-6f); u32x4 w;
  #pragma unroll
  for(int i=0;i<4;++i)w[i]=cvtpk_s(x[2*i]*rs,x[2*i+1]*rs);
  return w; }
#ifndef ATTN_STORE16
#define ATTN_STORE16(p,v) (*(u32x4*)(p)=(v))
#endif
template<int THRL> __device__ __forceinline__ void fox_unit(int b,int qb,float dthr,const bf16*Q,const bf16*__restrict__ K,const bf16*__restrict__ V,bf16*O,const float*__restrict__ csg,char*shm){
  int tid_=threadIdx.x; asm volatile("":"+v"(tid_)); const int tid=tid_,lane=tid&63,r32=lane&31,hi=lane>>5; const int wid=__builtin_amdgcn_readfirstlane(tid>>6);
  const long rowbase=(long)b*SEQ; const int q0=qb*QB;
  const bf16*Qw=Q+(rowbase+q0+wid*QBLK)*DM;
  const unsigned lds0=(unsigned)(uintptr_t)shm; const lds_cptr shm3=(lds_cptr)shm;
  float*wsf=(float*)(shm+LDS_WS)+wid*64;
  const unsigned kdst=lds0+LDS_K+wid*1024, vdst=lds0+LDS_V+wid*1024;
  #define DMA_K(t,slot) glds16(ksrc+(long)(t)*KVBLK*DM,(unsigned)__builtin_amdgcn_readfirstlane(kdst+(slot)))
  #define DMA_V(t,slot) glds16(vsrc+(long)(t)*KVBLK*DM,(unsigned)__builtin_amdgcn_readfirstlane(vdst+(slot)))
  const int vb0=(int)(lds0+LDS_V)+((lane>>4)&1)*32+(lane&3)*8+(4*hi+((lane&15)>>2))*64;
  const char*Kbase=shm+LDS_K; bf16x8 kf[8];
  const lds_cptr kp0=shm3+LDS_K+hi*1024+r32*16; const lds_cptr vp0=shm3+LDS_V+((lane>>4)&1)*32+(lane&3)*8+(4*hi+((lane&15)>>2))*64;
  typedef __attribute__((address_space(3))) float lds_f32; typedef __attribute__((address_space(3))) f32x4 lds_f32x4;
  { lds_f32*cl=(lds_f32*)(shm3+LDS_CS); const int n_=q0+QB; for(int i_=tid*4;i_<n_;i_+=2048){ const f32x4 v_=*(const f32x4*)(csg+i_); *(lds_f32x4*)(cl+i_)=v_; } }
  asm volatile("s_waitcnt vmcnt(0) lgkmcnt(0)\n\ts_barrier":::"memory");
  int j0;
  { const lds_f32*cl=(const lds_f32*)(shm3+LDS_CS); const float cq0=cl[q0]; int lo_=0,hi_=4*qb;
    while(lo_<hi_){ const int mid_=(lo_+hi_)>>1; if(cl[64*mid_+63]-cq0>=dthr)lo_=mid_+1; else hi_=mid_; }
    j0=__builtin_amdgcn_readfirstlane(lo_)&~1; }
  const bf16*Kh=K+(rowbase+(long)j0*KVBLK)*DM,*Vh=V+(rowbase+(long)j0*KVBLK)*DM;
  const bf16*ksrc=Kh+(long)lane*DM+wid*8;
  const bf16*vsrc=Vh+(long)(16*(wid&3)+(lane>>2))*DM+(wid>>2)*32+(lane&3)*8;
  const int NT=(q0+QB)/KVBLK-j0;
  const lds_f32*cl3=(const lds_f32*)(shm3+LDS_CS)+64*j0;
  DMA_K(0,0);DMA_V(0,0);DMA_K(1,SLOTB);
  bf16x8 qr[4];
  #pragma unroll
  for(int d0=0;d0<4;++d0)qr[d0]=*reinterpret_cast<const bf16x8*>(&Qw[(long)r32*DM+d0*16+hi*8]);
  float base=0.f,l_reg=0.f;f32x16 o[2];o[0]=f32x16{};o[1]=f32x16{};
  #define CINIT(C0,C1,t) do{ const lds_f32*cp_=cl3+64*(t)+4*hi; \
    _Pragma("unroll") for(int g_=0;g_<4;++g_){ const f32x4 a_=*(const lds_f32x4*)(cp_+8*g_), b_=*(const lds_f32x4*)(cp_+32+8*g_); \
      C0[4*g_]=base-a_[0];C0[4*g_+1]=base-a_[1];C0[4*g_+2]=base-a_[2];C0[4*g_+3]=base-a_[3]; \
      C1[4*g_]=base-b_[0];C1[4*g_+1]=base-b_[1];C1[4*g_+2]=base-b_[2];C1[4*g_+3]=base-b_[3]; } }while(0)
  const int qrel=wid*QBLK+r32;
  #define CMASK(P0,P1,t) do{int jb_=(t)-(NT-4); if(jb_>=0)cmask(P0,P1,jb_,qrel,hi);}while(0)
  bool resc=false;
  #define START(P0,P1) do{ const float rm=rowmax(P0,P1); resc=false; \
    { const float dl=rm; base=fsub_s(base,dl); \
      _Pragma("unroll") for(int r=0;r<16;++r){P0[r]=fsub_s(P0[r],dl);P1[r]=fsub_s(P1[r],dl);} } \
    _Pragma("unroll") for(int r=0;r<16;++r)P0[r]=__builtin_amdgcn_exp2f(P0[r]); }while(0)
  #define RESC() do{ if(resc){ asm volatile("s_waitcnt lgkmcnt(0)":::"memory"); \
      _Pragma("unroll") for(int d_=0;d_<2;++d_) _Pragma("unroll") for(int r=0;r<16;++r)o[d_][r]*=wsf[crow(r,hi)]; } }while(0)
  f32x16 pA0,pA1,pB0,pB1;
  int sl_prev=0,sl_cur=0,sl_next=SLOTB;
  #define ROT() do{sl_prev=sl_cur;sl_cur=sl_next;sl_next=(sl_next==(NSLOT-1)*SLOTB)?0:sl_next+SLOTB;}while(0)
  DMA_K(2,2*SLOTB);
  WAIT_BAR(3);
  base=cl3[q0-64*j0+wid*QBLK+r32];
  CINIT(pA0,pA1,0); qkt(pA0,pA1,Kbase,qr,r32,hi);asm volatile("s_nop 15\n\ts_nop 7":"+v"(pA0),"+v"(pA1));CMASK(pA0,pA1,0);
  START(pA0,pA1);
  _Pragma("unroll") for(int r=0;r<16;++r)pA1[r]=__builtin_amdgcn_exp2f(pA1[r]);
  WAIT_BAR(0);
  DMA_K(3,0);DMA_V(1,SLOTB);
  ROT();
  kload8(kf,kp0+sl_cur);
  WAIT_BAR(2);
  s16x4 vlo[8],vhi[8]; u32x4 pw0,pw1,pw2,pw3;
  #define PKW(P,B) cvtpk_s(P[B],P[B+1])
  #define PAF(k) __builtin_bit_cast(bf16x8,pw##k)
  #define VFR(i) (bf16x8){vlo[i][0],vlo[i][1],vlo[i][2],vlo[i][3],vhi[i][0],vhi[i][1],vhi[i][2],vhi[i][3]}
  #define PIN(x) asm volatile("":"+v"(x))
  #define MX3(a,b,c) __builtin_fmaxf(__builtin_fmaxf((a),(b)),(c))
  #define GAPA(MF,A0,A1,A2,A3,W0,W1,PW) do{ MF; sacc+=A0; sacc+=A1; sacc+=A2; sacc+=A3; PIN(sacc); W0; W1; PIN(PW); SBAR(); }while(0)
  #define EX(v) __builtin_amdgcn_exp2f(v)
  #define GAPB(MF,X,B) do{ MF; X[B]=EX(X[B]); X[B+1]=EX(X[B+1]); X[B+2]=EX(X[B+2]); X[B+3]=EX(X[B+3]); PIN(X); SBAR(); }while(0)
  #define VRD(i) do{ vlo[i]=vtr(vp_+(((i)>>2)*4096+((i)&3)*1024)); vhi[i]=vtr(vp_+(((i)>>2)*4096+((i)&3)*1024+512)); }while(0)
  #define KRD(G,j) do{ if(G){ kload2(kf,kp0+sl_next,j); SBAR(); } }while(0)
  #define STEP(C0,C1,P0,P1,t,GK,GV,GL) do{ SBAR(); CINIT(C0,C1,t); SBAR(); \
    const lds_cptr vp_=vp0+sl_prev; \
    VRD(0); SBAR(); float sacc=(P0[0]+P0[1]); \
    GAPA(C0=__builtin_amdgcn_mfma_f32_32x32x16_bf16(kf[0],qr[0],C0,0,0,0), P0[2],P0[3],P0[4],P0[5],     pw0[0]=PKW(P0,0), pw0[1]=PKW(P0,2), pw0); \
    VRD(4); SBAR(); GAPA(C1=__builtin_amdgcn_mfma_f32_32x32x16_bf16(kf[1],qr[0],C1,0,0,0), P0[6],P0[7],P0[8],P0[9],     pw0[2]=PKW(P0,4), pw0[3]=PKW(P0,6), pw0); \
    VRD(1); SBAR(); GAPA(C0=__builtin_amdgcn_mfma_f32_32x32x16_bf16(kf[2],qr[1],C0,0,0,0),   P0[10],P0[11],P0[12],P0[13], pw1[0]=PKW(P0,8), pw1[1]=PKW(P0,10), pw1); \
    VRD(5); SBAR(); GAPA(C1=__builtin_amdgcn_mfma_f32_32x32x16_bf16(kf[3],qr[1],C1,0,0,0),   P0[14],P0[15],P1[0],P1[1],   pw1[2]=PKW(P0,12),pw1[3]=PKW(P0,14), pw1); \
    VRD(2); SBAR(); GAPA(C0=__builtin_amdgcn_mfma_f32_32x32x16_bf16(kf[4],qr[2],C0,0,0,0),   P1[2],P1[3],P1[4],P1[5],     pw2[0]=PKW(P1,0), pw2[1]=PKW(P1,2), pw2); \
    VRD(6); SBAR(); GAPA(C1=__builtin_amdgcn_mfma_f32_32x32x16_bf16(kf[5],qr[2],C1,0,0,0),   P1[6],P1[7],P1[8],P1[9],     pw2[2]=PKW(P1,4), pw2[3]=PKW(P1,6), pw2); \
    VRD(3); SBAR(); GAPA(C0=__builtin_amdgcn_mfma_f32_32x32x16_bf16(kf[6],qr[3],C0,0,0,0),   P1[10],P1[11],P1[12],P1[13], pw3[0]=PKW(P1,8), pw3[1]=PKW(P1,10), pw3); \
    VRD(7); SBAR(); GAPA(C1=__builtin_amdgcn_mfma_f32_32x32x16_bf16(kf[7],qr[3],C1,0,0,0),   P1[14],P1[15],0.f,0.f,       pw3[2]=PKW(P1,12),pw3[3]=PKW(P1,14), pw3); \
    l_reg+=sacc; \
    if(GK){DMA_K((t)+3,sl_cur);} if(GV){DMA_V((t)+1,sl_next);} \
    CMASK(C0,C1,t); \
    { float a=MX3(C0[0],C0[1],C1[0]),b=MX3(C0[2],C0[3],C1[1]); a=MX3(a,C1[2],C1[3]); \
      _Pragma("unroll") for(int r=4;r<16;r+=4){a=MX3(a,C0[r],C0[r+1]);b=MX3(b,C0[r+2],C0[r+3]);a=MX3(a,C1[r],C1[r+1]);b=MX3(b,C1[r+2],C1[r+3]);} \
      float rm=__builtin_fmaxf(a,b); { auto rr=__builtin_amdgcn_permlane32_swap(__float_as_uint(rm),__float_as_uint(rm),false,false); rm=__builtin_fmaxf(__uint_as_float(rr[0]),__uint_as_float(rr[1])); } \
      resc=false; \
      if(__builtin_expect(__any(rm>(float)THRL),0)){ const float dl=__builtin_fmaxf(rm,0.f); base-=dl; \
        _Pragma("unroll") for(int r=0;r<16;++r){C0[r]-=dl;C1[r]-=dl;} \
        const float f=__builtin_amdgcn_exp2f(-dl); l_reg*=f; if(hi==0)wsf[r32]=f; resc=true; } } \
    SBAR(); \
    GAPB(o[0]=__builtin_amdgcn_mfma_f32_32x32x16_bf16(PAF(0),VFR(0),o[0],0,0,0), C0,0); \
    GAPB(o[1]=__builtin_amdgcn_mfma_f32_32x32x16_bf16(PAF(0),VFR(4),o[1],0,0,0), C0,4); \
    KRD(GL,0); GAPB(o[0]=__builtin_amdgcn_mfma_f32_32x32x16_bf16(PAF(1),VFR(1),o[0],0,0,0), C0,8); \
    KRD(GL,1); GAPB(o[1]=__builtin_amdgcn_mfma_f32_32x32x16_bf16(PAF(1),VFR(5),o[1],0,0,0), C0,12); \
    KRD(GL,2); GAPB(o[0]=__builtin_amdgcn_mfma_f32_32x32x16_bf16(PAF(2),VFR(2),o[0],0,0,0), C1,0); \
    KRD(GL,3); GAPB(o[1]=__builtin_amdgcn_mfma_f32_32x32x16_bf16(PAF(2),VFR(6),o[1],0,0,0), C1,4); \
    GAPB(o[0]=__builtin_amdgcn_mfma_f32_32x32x16_bf16(PAF(3),VFR(3),o[0],0,0,0), C1,8); \
    GAPB(o[1]=__builtin_amdgcn_mfma_f32_32x32x16_bf16(PAF(3),VFR(7),o[1],0,0,0), C1,12); \
    }while(0)
  int t=1;
  #undef CMASK
  #define CMASK(P0,P1,t) do{}while(0)
  for(;t+5<NT;t+=2){
    STEP(pB0,pB1,pA0,pA1,t,true,true,true);     WAIT_BAR(2); RESC(); ROT();
    STEP(pA0,pA1,pB0,pB1,t+1,true,true,true);   WAIT_BAR(2); RESC(); ROT();
  }
  #undef CMASK
  #define CMASK(P0,P1,t) do{int jb_=(t)-(NT-4); if(jb_>=0)cmask(P0,P1,jb_,qrel,hi);}while(0)
  #define ENDW(tt) do{ if((tt)+3<NT){WAIT_BAR(2);} else if((tt)+2<NT){WAIT_BAR(1);} else {WAIT_BAR(0);} }while(0)
  for(;t+1<NT;t+=2){
    STEP(pB0,pB1,pA0,pA1,t,(t+3<NT),(t+1<NT),(t+1<NT));       ENDW(t);   RESC(); ROT();
    STEP(pA0,pA1,pB0,pB1,t+1,(t+4<NT),(t+2<NT),(t+2<NT));     ENDW(t+1); RESC(); ROT();
  }
  STEP(pB0,pB1,pA0,pA1,NT-1,false,false,false); RESC();
  { float sacc=pB0[0]+pB0[1]; _Pragma("unroll") for(int r=2;r<16;++r)sacc+=pB0[r]; _Pragma("unroll") for(int r=0;r<16;++r)sacc+=pB1[r]; l_reg+=sacc;
    pw0=(u32x4){PKW(pB0,0),PKW(pB0,2),PKW(pB0,4),PKW(pB0,6)};pw1=(u32x4){PKW(pB0,8),PKW(pB0,10),PKW(pB0,12),PKW(pB0,14)};pw2=(u32x4){PKW(pB1,0),PKW(pB1,2),PKW(pB1,4),PKW(pB1,6)};pw3=(u32x4){PKW(pB1,8),PKW(pB1,10),PKW(pB1,12),PKW(pB1,14)};
    SBAR(); pv(o,vb0+sl_cur,PAF(0),PAF(1),PAF(2),PAF(3)); }
  #undef PKW
  #undef PAF
  #undef VFR
  #undef PIN
  #undef MX3
  #undef GAPA
  #undef GAPB
  #undef EX
  #undef VRD
  #undef KRD
  #undef STEP
  #undef ENDW
  {auto rr=__builtin_amdgcn_permlane32_swap(__float_as_uint(l_reg),__float_as_uint(l_reg),false,false);l_reg=__uint_as_float(rr[0])+__uint_as_float(rr[1]);}
  if(hi==0)wsf[32+r32]=l_reg;asm volatile("s_waitcnt lgkmcnt(0)":::"memory");
  float rli[16];
  #pragma unroll
  for(int r=0;r<16;++r)rli[r]=__builtin_amdgcn_rcpf(wsf[32+crow(r,hi)]);
  bf16*Ow=O+(rowbase+q0+wid*QBLK)*DMO;
  { bf16*stg=(bf16*)(shm+LDS_OST)+wid*2048;
    #pragma unroll
    for(int r=0;r<16;++r){const int orow=crow(r,hi);
      #pragma unroll
      for(int d0=0;d0<2;++d0)stg[orow*64+d0*32+r32]=__float2bfloat16(o[d0][r]*rli[r]);}
    asm volatile("s_waitcnt lgkmcnt(0)":::"memory");
    #pragma unroll
    for(int i=0;i<4;++i){const int row=i*8+(lane>>3),ch=lane&7; const u32x4 v=*(const u32x4*)(stg+row*64+ch*8); ATTN_STORE16(Ow+(long)row*DMO+ch*8,head_rms(v));} }
  asm volatile("s_waitcnt lgkmcnt(0)\n\ts_barrier":::"memory");
  #undef DMA_K
  #undef DMA_V
  #undef CMASK
  #undef CINIT
  #undef START
  #undef RESC
  #undef ROT
}
__device__ __forceinline__ float sp2f(float z){ const float e=__builtin_amdgcn_exp2f(-__builtin_fabsf(z)); return __builtin_fmaxf(z,0.f)+__builtin_amdgcn_logf(1.f+e); }
__device__ __forceinline__ void sb_unit(int b,int qb,const bf16*Q,const bf16*__restrict__ K,const bf16*__restrict__ V,bf16*O,char*shm){
  int tid_=threadIdx.x; asm volatile("":"+v"(tid_)); const int tid=tid_,lane=tid&63,r32=lane&31,hi=lane>>5; const int wid=__builtin_amdgcn_readfirstlane(tid>>6);
  const long rowbase=(long)b*SEQ; const int q0=qb*QB;
  const bf16*Qw=Q+(rowbase+q0+wid*QBLK)*DM;
  const bf16*Kh=K+rowbase*DM,*Vh=V+rowbase*DM;
  const unsigned lds0=(unsigned)(uintptr_t)shm; const lds_cptr shm3=(lds_cptr)shm;
  const bf16*ksrc=Kh+(long)lane*DM+wid*8;
  const bf16*vsrc=Vh+(long)(16*(wid&3)+(lane>>2))*DM+(wid>>2)*32+(lane&3)*8;
  const unsigned kdst=lds0+LDS_K+wid*1024, vdst=lds0+LDS_V+wid*1024;
  #define DMA_K(t,slot) glds16(ksrc+(long)(t)*KVBLK*DM,(unsigned)__builtin_amdgcn_readfirstlane(kdst+(slot)))
  #define DMA_V(t,slot) glds16(vsrc+(long)(t)*KVBLK*DM,(unsigned)__builtin_amdgcn_readfirstlane(vdst+(slot)))
  const int vb0=(int)(lds0+LDS_V)+((lane>>4)&1)*32+(lane&3)*8+(4*hi+((lane&15)>>2))*64;
  typedef __attribute__((address_space(3))) unsigned lds_u32;
  volatile lds_u32*flags=(volatile lds_u32*)(shm3+LDS_FLAGS);
  bf16x8 qr[4];
  #pragma unroll
  for(int d0=0;d0<4;++d0)qr[d0]=*reinterpret_cast<const bf16x8*>(&Qw[(long)r32*DM+d0*16+hi*8]);
  asm volatile("":::"memory");
  f32x16 o[2];o[0]=f32x16{};o[1]=f32x16{};
  float R=1.f; const int qabs=q0+wid*QBLK+r32; bool done=false;
  const int jtop=4*qb+3;
  DMA_K(jtop,0);DMA_V(jtop,0); DMA_K(jtop-1,SLOTB);DMA_V(jtop-1,SLOTB);
  int slot=0,slot2=2*SLOTB,bank=0;
  for(int j=jtop;j>=0;--j){
    if(j>0){ WAIT_BAR(2); } else { WAIT_BAR(0); }
    if(j<jtop){ unsigned alld=1u;
      #pragma unroll
      for(int w=0;w<NW;++w)alld&=flags[(bank^8)+w];
      if(alld)break; }
    if(j>=2){ DMA_K(j-2,slot2);DMA_V(j-2,slot2); }
    const bool active=(!done)&&(64*j<q0+wid*QBLK+31);
    if(active){
      f32x16 p0=f32x16{},p1=f32x16{};
      qkt(p0,p1,shm+LDS_K+slot,qr,r32,hi);
      const int kvb=64*j+4*hi; f32x16 s0,s1;
      #pragma unroll
      for(int r=0;r<16;++r){ const int kv=kvb+(r&3)+8*(r>>2);
        const float e0=__builtin_amdgcn_exp2f(__builtin_fminf(p0[r],80.f)), e1=__builtin_amdgcn_exp2f(__builtin_fminf(p1[r],80.f));
        const float r0=__builtin_amdgcn_rcpf(1.f+e0), r1=__builtin_amdgcn_rcpf(1.f+e1);
        const bool v0=kv<qabs, v1=kv+32<qabs;
        p0[r]=v0?e0*r0:0.f; p1[r]=v1?e1*r1:0.f; s0[r]=v0?r0:1.f; s1[r]=v1?r1:1.f; }
      float g0[4],g1[4],og0[4],og1[4],T0[4],T1[4];
      #pragma unroll
      for(int g=0;g<4;++g){ g0[g]=(s0[4*g]*s0[4*g+1])*(s0[4*g+2]*s0[4*g+3]); g1[g]=(s1[4*g]*s1[4*g+1])*(s1[4*g+2]*s1[4*g+3]); }
      #pragma unroll
      for(int g=0;g<4;++g){ og0[g]=__shfl_xor(g0[g],32); og1[g]=__shfl_xor(g1[g],32); }
      float run=R;
      #pragma unroll
      for(int g=3;g>=0;--g){ const float ah1=hi?g1[g]:og1[g], ah0=hi?og1[g]:g1[g]; const float t1=run; run*=ah1; const float t0=run; run*=ah0; T1[g]=hi?t1:t0; }
      #pragma unroll
      for(int g=3;g>=0;--g){ const float ah1=hi?g0[g]:og0[g], ah0=hi?og0[g]:g0[g]; const float t1=run; run*=ah1; const float t0=run; run*=ah0; T0[g]=hi?t1:t0; }
      R=run;
      #pragma unroll
      for(int g=0;g<4;++g){ float a0=T0[g],a1=T1[g];
        #pragma unroll
        for(int i=3;i>=0;--i){ const int r=4*g+i; p0[r]*=a0; p1[r]*=a1; a0*=s0[r]; a1*=s1[r]; } }
      u32x4 pw0,pw1,pw2,pw3;
      pw0=(u32x4){cvtpk_s(p0[0],p0[1]),cvtpk_s(p0[2],p0[3]),cvtpk_s(p0[4],p0[5]),cvtpk_s(p0[6],p0[7])};
      pw1=(u32x4){cvtpk_s(p0[8],p0[9]),cvtpk_s(p0[10],p0[11]),cvtpk_s(p0[12],p0[13]),cvtpk_s(p0[14],p0[15])};
      pw2=(u32x4){cvtpk_s(p1[0],p1[1]),cvtpk_s(p1[2],p1[3]),cvtpk_s(p1[4],p1[5]),cvtpk_s(p1[6],p1[7])};
      pw3=(u32x4){cvtpk_s(p1[8],p1[9]),cvtpk_s(p1[10],p1[11]),cvtpk_s(p1[12],p1[13]),cvtpk_s(p1[14],p1[15])};
      pv(o,vb0+slot,__builtin_bit_cast(bf16x8,pw0),__builtin_bit_cast(bf16x8,pw1),__builtin_bit_cast(bf16x8,pw2),__builtin_bit_cast(bf16x8,pw3));
      done=__all(R<1.0e-37f)!=0;
    }
    if(lane==0)flags[bank+wid]=done?1u:0u;
    bank^=8; slot=(slot==2*SLOTB)?0:slot+SLOTB; slot2=(slot2==2*SLOTB)?0:slot2+SLOTB;
  }
  asm volatile("s_waitcnt vmcnt(0)":::"memory");
  bf16*Ow=O+(rowbase+q0+wid*QBLK)*DMO;
  { bf16*stg=(bf16*)(shm+LDS_OST)+wid*2048;
    #pragma unroll
    for(int r=0;r<16;++r){const int orow=crow(r,hi);
      #pragma unroll
      for(int d0=0;d0<2;++d0)stg[orow*64+d0*32+r32]=__float2bfloat16(o[d0][r]);}
    asm volatile("s_waitcnt lgkmcnt(0)":::"memory");
    #pragma unroll
    for(int i=0;i<4;++i){const int row=i*8+(lane>>3),ch=lane&7; const u32x4 v=*(const u32x4*)(stg+row*64+ch*8); ATTN_STORE16(Ow+(long)row*DMO+ch*8,head_rms(v));} }
  asm volatile("s_waitcnt vmcnt(0) lgkmcnt(0)\n\ts_barrier":::"memory");
  #undef DMA_K
  #undef DMA_V
}
#undef SBAR
#undef WAIT_BAR
}
namespace cg = cooperative_groups;
constexpr int NWAVES = 8;
constexpr int DMODEL = 1024, NBATCH = 4, SEQ_IN = 8192, NMETA = 16, LREAL = NMETA + SEQ_IN, LP = 8448  ;
constexpr int MROWS = NBATCH * LP;
constexpr int MREAL = NBATCH * SEQ_IN;
constexpr int INW = 2566, NINP = 2560, NIN = 2816, DFF = 2816, NGU = 2 * DFF, DEPTH = 2, NFH = 6;
constexpr float C2F = 0.125f * 1.4426950408889634f;
constexpr int PC_U = 0, PC_FQ = 256, PC_FK = 640, PC_FV = 1024, PC_SQ = 1408, PC_SK = 1792, PC_SV = 2176;
constexpr size_t MiB = 1u << 20;
constexpr size_t WS_CTL = 0, CTL_ZERO_BYTES = 1 * MiB;
constexpr size_t WS_SS = 64 * 1024;
constexpr size_t WS_W = 1 * MiB, W_LAYER = 24 * MiB, W_IN = 0, W_OUT = (size_t)NIN * 1024 * 2, W_GU = W_OUT + 2 * MiB, W_D = W_GU + (size_t)NGU * 1024 * 2;
constexpr size_t WS_LF = 49 * MiB, WS_CS = 51 * MiB, WS_H = 52 * MiB, WS_HB = 184 * MiB, WS_Y = 250 * MiB, WS_P = 316 * MiB, WS_END = WS_P + (size_t)MROWS * DFF * 2;
static_assert(W_D + (size_t)1024 * DFF * 2 <= W_LAYER && WS_W + 2 * W_LAYER <= WS_LF && WS_SS + 5 * (size_t)MROWS * 4 <= CTL_ZERO_BYTES, "ws map");
static_assert(WS_H + (size_t)MROWS * 1024 * 4 <= WS_HB && WS_HB + (size_t)MROWS * 1024 * 2 <= WS_Y && WS_Y + (size_t)MROWS * 1024 * 2 <= WS_P && WS_END <= 512 * MiB, "ws map");
constexpr int LDS_BYTES = 147456;
constexpr int LDS_MISC = 131072;

#define LAS __attribute__((address_space(3)))
typedef unsigned short bf16u;
typedef unsigned v4u __attribute__((ext_vector_type(4)));
typedef float f32x4 __attribute__((ext_vector_type(4)));
#define LDS_WAIT() asm volatile("s_waitcnt lgkmcnt(0)" ::: "memory")
__device__ __forceinline__ unsigned f2bf(float f) { unsigned u = __builtin_bit_cast(unsigned, f); return (u + 0x7fffu + ((u >> 16) & 1u)) >> 16; }
__device__ __forceinline__ unsigned pk2(float lo, float hi) { return f2bf(lo) | (f2bf(hi) << 16); }
__device__ __forceinline__ float wave_sum(float v) {
#pragma unroll
    for (int o = 1; o < 64; o <<= 1) v += __shfl_xor(v, o);
    return v;
}

struct Args { const float* in[15]; float* out; unsigned char* ws; };

struct WinSrc { const float* w; const float* g;
    __device__ __forceinline__ float operator()(int k, int n) const { if (n >= INW) return 0.f; const int col = n < 1408 ? n : (n < 2560 ? n + 6 : n - 2560 + 1408);
        const float sc = ((n >= PC_FQ && n < PC_FK) || (n >= PC_SQ && n < PC_SK)) ? C2F : 1.0f; return w[(size_t)k * INW + col] * g[k] * sc; } };
struct WoutSrc { const float* w; const float* fg; const float* sg;
    __device__ __forceinline__ float operator()(int k, int n) const { const float gn = k < 640 ? fg[k - 256] : sg[k - 640]; return w[(size_t)k * 1024 + n] * gn; } };
struct WguSrc { const float* wg; const float* wu; const float* g;
    __device__ __forceinline__ float operator()(int k, int c) const { const int pn = c >> 8, w = c & 255, j = pn * 128 + (w & 127); const long dlt = (w >> 7) ? (long)(wu - wg) : 0L; return wg[(long)k * DFF + j + dlt] * g[k]; } };
struct WdSrc { const float* w;
    __device__ __forceinline__ float operator()(int k, int n) const { return w[(size_t)k * 1024 + n]; } };
template <class F> __device__ __forceinline__ void conv_item(const F src, bf16u* WT, int K, int k0, int n0, LAS float* scr, int lane) {
    float tv[32];
#pragma unroll
    for (int i = 0; i < 32; ++i) tv[i] = src(k0 + 2 * i + (lane >> 5), n0 + (lane & 31));
#pragma unroll
    for (int i = 0; i < 32; ++i) scr[(2 * i + (lane >> 5)) * 33 + (lane & 31)] = tv[i];
    LDS_WAIT(); asm volatile("" ::: "memory");
    const int c = lane & 7;
#pragma unroll
    for (int j = 0; j < 4; ++j) { const int n = (lane >> 3) + 8 * j; const LAS float* s = scr + (8 * c) * 33 + n;
        v4u o; o.x = pk2(s[0 * 33], s[1 * 33]); o.y = pk2(s[2 * 33], s[3 * 33]); o.z = pk2(s[4 * 33], s[5 * 33]); o.w = pk2(s[6 * 33], s[7 * 33]);
        *(v4u*)(WT + (size_t)(n0 + n) * K + k0 + 8 * c) = o; }
    LDS_WAIT(); asm volatile("" ::: "memory");
}
__device__ __forceinline__ void fold_item(const float* wout, const float* pw, const float* ps, bf16u* WT, int item, int lane) {
    const int g = item >> 4, n = (item & 15) * 64 + lane;
    float acc[64];
#pragma unroll
    for (int c = 0; c < 64; ++c) acc[c] = 0.f;
    for (int d = 0; d < 64; ++d) { const float wv = wout[(size_t)(g * 64 + d) * 1024 + n] * ps[g * 64 + d];
#pragma unroll
        for (int c = 0; c < 64; ++c) acc[c] += pw[(g * 64 + c) * 64 + d] * wv; }
    bf16u* o = WT + (size_t)n * 1024 + g * 64;
#pragma unroll
    for (int c = 0; c < 64; c += 8) { v4u w; w.x = pk2(acc[c], acc[c + 1]); w.y = pk2(acc[c + 2], acc[c + 3]); w.z = pk2(acc[c + 4], acc[c + 5]); w.w = pk2(acc[c + 6], acc[c + 7]); *(v4u*)(o + c) = w; }
}
__device__ __forceinline__ void p0_prologue(const Args& A, unsigned char* ws, LAS unsigned char* lds, int wave, int lane) {
    LAS float* scr = (LAS float*)(lds + wave * 16384);
    const int gw = blockIdx.x * NWAVES + wave, NGW = gridDim.x * NWAVES;
    constexpr int I_IN = 16 * (NIN / 32), I_OUT = 12 * 32, I_GU = 16 * (NGU / 32), I_D = (DFF / 64) * 32, I_F = 64, I_L = I_IN + I_OUT + I_GU + I_D + I_F;
    for (int it = gw; it < DEPTH * I_L; it += NGW) {
        const int L = it / I_L; int r = it % I_L;
        bf16u* wb = (bf16u*)(ws + WS_W + (size_t)L * W_LAYER);
        if (r < I_IN) { WinSrc s{A.in[3] + (size_t)L * 1024 * INW, A.in[2] + L * 1024}; conv_item(s, (bf16u*)((unsigned char*)wb + W_IN), 1024, (r / (NIN / 32)) * 64, (r % (NIN / 32)) * 32, scr, lane); continue; } r -= I_IN;
        if (r < I_OUT) { WoutSrc s{A.in[9] + (size_t)L * 1024 * 1024, A.in[7] + L * 384, A.in[8] + L * 384}; conv_item(s, (bf16u*)((unsigned char*)wb + W_OUT), 1024, 256 + (r / 32) * 64, (r % 32) * 32, scr, lane); continue; } r -= I_OUT;
        if (r < I_GU) { WguSrc s{A.in[11] + (size_t)L * 1024 * DFF, A.in[12] + (size_t)L * 1024 * DFF, A.in[10] + L * 1024}; conv_item(s, (bf16u*)((unsigned char*)wb + W_GU), 1024, (r / (NGU / 32)) * 64, (r % (NGU / 32)) * 32, scr, lane); continue; } r -= I_GU;
        if (r < I_D) { WdSrc s{A.in[13] + (size_t)L * DFF * 1024}; conv_item(s, (bf16u*)((unsigned char*)wb + W_D), DFF, (r / 32) * 64, (r % 32) * 32, scr, lane); continue; } r -= I_D;
        fold_item(A.in[9] + (size_t)L * 1024 * 1024, A.in[5] + (size_t)L * 4 * 64 * 64, A.in[6] + L * 256, (bf16u*)((unsigned char*)wb + W_OUT), r, lane);
    }
    bf16u* hb = (bf16u*)(ws + WS_HB); float* ss0 = (float*)(ws + WS_SS);
    for (int m = gw; m < MROWS; m += NGW) {
        const int b = m / LP, t = m % LP;
        f32x4 v[4]; float s = 0.f;
        if (t < LREAL) { const f32x4* src = (const f32x4*)(t < NMETA ? A.in[1] + (size_t)t * 1024 : A.in[0] + ((size_t)b * SEQ_IN + (t - NMETA)) * 1024) + lane;
#pragma unroll
            for (int j = 0; j < 4; ++j) { v[j] = src[64 * j]; s += (v[j].x * v[j].x + v[j].y * v[j].y) + (v[j].z * v[j].z + v[j].w * v[j].w); } }
        else {
#pragma unroll
            for (int j = 0; j < 4; ++j) v[j] = (f32x4){0.f, 0.f, 0.f, 0.f}; }
        s = wave_sum(s);
        unsigned long long* bo = (unsigned long long*)(hb + (size_t)m * 1024) + lane;
#pragma unroll
        for (int j = 0; j < 4; ++j) { bo[64 * j] = (unsigned long long)pk2(v[j].x, v[j].y) | ((unsigned long long)pk2(v[j].z, v[j].w) << 32); }
        if (lane == 0) ss0[m] = s;
    }
}
typedef short bf16x8m __attribute__((ext_vector_type(8)));
template <int NBK> __device__ __forceinline__ void mini_item(f32x4 (&acc)[NBK], const bf16u* A16, const bf16u* Bt0, const bf16u* Bt1, int K, LAS unsigned char* lds, int wave, int lane) {
    const int fr = lane & 15, fq = lane >> 4, kw = K >> 3; const size_t o = (size_t)fr * K + wave * kw + 8 * fq;
#pragma unroll
    for (int nb = 0; nb < NBK; ++nb) acc[nb] = (f32x4){0.f, 0.f, 0.f, 0.f};
    for (int k = 0; k < kw; k += 32) { const bf16x8m a = *(const bf16x8m*)(A16 + o + k); const bf16x8m b0 = *(const bf16x8m*)(Bt0 + o + k);
        acc[0] = __builtin_amdgcn_mfma_f32_16x16x32_bf16(b0, a, acc[0], 0, 0, 0);
        if (NBK == 2) { const bf16x8m b1 = *(const bf16x8m*)(Bt1 + o + k); acc[NBK - 1] = __builtin_amdgcn_mfma_f32_16x16x32_bf16(b1, a, acc[NBK - 1], 0, 0, 0); } }
    LAS f32x4* red = (LAS f32x4*)lds;
#pragma unroll
    for (int nb = 0; nb < NBK; ++nb) red[(nb * 8 + wave) * 64 + lane] = acc[nb];
    __syncthreads();
    if (wave == 0) {
#pragma unroll
        for (int nb = 0; nb < NBK; ++nb) { f32x4 s = red[(nb * 8) * 64 + lane];
#pragma unroll
            for (int w = 1; w < 8; ++w) s += red[(nb * 8 + w) * 64 + lane];
            acc[nb] = s; } }
    __syncthreads();
}
__device__ __forceinline__ void mini_in(unsigned char* ws, const bf16u* wt, const float* ss, const float* fb, LAS unsigned char* lds, int wave, int lane) {
    const bf16u* A16 = (const bf16u*)(ws + WS_HB); bf16u* P = (bf16u*)(ws + WS_P); float* LF = (float*)(ws + WS_LF);
    for (int it = blockIdx.x; it < 161; it += gridDim.x) { const int n0 = it * 16; f32x4 acc[1];
        mini_item<1>(acc, A16, wt + (size_t)n0 * 1024, nullptr, 1024, lds, wave, lane);
        if (wave == 0) { const int fr = lane & 15, fq = lane >> 4; const float rs = __builtin_amdgcn_rsqf(ss[fr] * (1.0f / 1024.0f) + 1e-6f); const f32x4 v = acc[0] * rs;
            if (n0 < NINP) { const unsigned long long w = (unsigned long long)pk2(v[0], v[1]) | ((unsigned long long)pk2(v[2], v[3]) << 32);
#pragma unroll
                for (int b = 0; b < NBATCH; ++b) *(unsigned long long*)(P + ((size_t)b * LP + fr) * NINP + n0 + 4 * fq) = w; }
            else if (fq < 2) { f32x4 l;
#pragma unroll
                for (int i = 0; i < 4; ++i) { const int c = 4 * fq + i; const float x = v[i] + fb[c < NFH ? c : 0]; l[i] = c < NFH ? -(fmaxf(-x, 0.f) + log1pf(expf(-fabsf(x)))) * 1.4426950408889634f : 0.f; }
#pragma unroll
                for (int b = 0; b < NBATCH; ++b) *(f32x4*)(LF + ((size_t)b * LP + fr) * 8 + 4 * fq) = l; } }
    }
}
__device__ __forceinline__ void mini_res(unsigned char* ws, const bf16u* A16, const bf16u* wt, int K, float* ssn, LAS unsigned char* lds, int wave, int lane) {
    bf16u* hb = (bf16u*)(ws + WS_HB);
    for (int it = blockIdx.x; it < 64; it += gridDim.x) { const int n0 = it * 16; f32x4 acc[1];
        mini_item<1>(acc, A16, wt + (size_t)n0 * K, nullptr, K, lds, wave, lane);
        if (wave == 0) { const int fr = lane & 15, fq = lane >> 4; unsigned long long* bp = (unsigned long long*)(hb + (size_t)fr * 1024 + n0 + 4 * fq); const unsigned long long r = *bp; const unsigned rl = (unsigned)r, rh = (unsigned)(r >> 32);
            const f32x4 a = (f32x4){__uint_as_float(rl << 16), __uint_as_float(rl & 0xffff0000u), __uint_as_float(rh << 16), __uint_as_float(rh & 0xffff0000u)} + acc[0];
            *bp = (unsigned long long)pk2(a[0], a[1]) | ((unsigned long long)pk2(a[2], a[3]) << 32);
            float s = (a[0] * a[0] + a[1] * a[1]) + (a[2] * a[2] + a[3] * a[3]); s += __shfl_xor(s, 16); s += __shfl_xor(s, 32);
            if (fq == 0) atomicAdd(ssn + fr, s); }
    }
}
__device__ __forceinline__ void mini_gu(unsigned char* ws, const bf16u* wt, const float* ss, LAS unsigned char* lds, int wave, int lane) {
    const bf16u* A16 = (const bf16u*)(ws + WS_HB); bf16u* H = (bf16u*)(ws + WS_P);
    for (int it = blockIdx.x; it < DFF / 16; it += gridDim.x) { const int j0 = it * 16, cg = (j0 >> 7) * 256 + (j0 & 127); f32x4 acc[2];
        mini_item<2>(acc, A16, wt + (size_t)cg * 1024, wt + (size_t)(cg + 128) * 1024, 1024, lds, wave, lane);
        if (wave == 0) { const int fr = lane & 15, fq = lane >> 4; const float rs = __builtin_amdgcn_rsqf(ss[fr] * (1.0f / 1024.0f) + 1e-6f); float o[4];
#pragma unroll
            for (int i = 0; i < 4; ++i) { const float g = acc[0][i] * rs, up = acc[1][i] * rs; o[i] = g * __builtin_amdgcn_rcpf(1.0f + __builtin_amdgcn_exp2f(-1.4426950408889634f * g)) * up; }
            *(unsigned long long*)(H + (size_t)fr * DFF + j0 + 4 * fq) = (unsigned long long)pk2(o[0], o[1]) | ((unsigned long long)pk2(o[2], o[3]) << 32); }
    }
}
__device__ __forceinline__ void fl_phase(unsigned char* ws, const bf16u* wt  , const float* ss, const float* fb, int wave, int lane) {
    const bf16u* HBp = (const bf16u*)(ws + WS_HB); float* LF = (float*)(ws + WS_LF);
    const int fr = lane & 15, fq = lane >> 4;
    for (int it = blockIdx.x * NWAVES + wave; it < MREAL / 16; it += gridDim.x * NWAVES) {
        const int m0 = it * 16, row0 = (m0 / SEQ_IN) * LP + NMETA + (m0 % SEQ_IN);
        const bf16u* ap = HBp + (size_t)(row0 + fr) * 1024 + 8 * fq; const bf16u* bp = wt + (size_t)fr * 1024 + 8 * fq;
        f32x4 acc = (f32x4){0.f, 0.f, 0.f, 0.f};
#pragma unroll 8
        for (int k = 0; k < 1024; k += 32) { const bf16x8m a = *(const bf16x8m*)(ap + k); const bf16x8m b = *(const bf16x8m*)(bp + k); acc = __builtin_amdgcn_mfma_f32_16x16x32_bf16(b, a, acc, 0, 0, 0); }
        if (fq < 2) { const int row = row0 + fr; const float rs = __builtin_amdgcn_rsqf(ss[row] * (1.0f / 1024.0f) + 1e-6f); f32x4 l;
#pragma unroll
            for (int i = 0; i < 4; ++i) { const int c = 4 * fq + i; const float x = acc[i] * rs + fb[c < NFH ? c : 0]; l[i] = c < NFH ? -(fmaxf(-x, 0.f) + log1pf(expf(-fabsf(x)))) * 1.4426950408889634f : 0.f; }
            *(f32x4*)(LF + (size_t)row * 8 + 4 * fq) = l; }
    }
}
__device__ __forceinline__ void pool_scan_phase(unsigned char* ws, LAS unsigned char* lds, unsigned* nrm, int tid, int wave, int lane) {
    const float* LF = (const float*)(ws + WS_LF); float* CS = (float*)(ws + WS_CS);
    if (blockIdx.x < NBATCH * NFH) {
        const int b = blockIdx.x / NFH, hf = blockIdx.x % NFH; constexpr int PER = 17;
        const float* lf = LF + (size_t)b * LP * 8 + hf; float* cs = CS + (size_t)(b * NFH + hf) * LP;
        float v[PER]; float s = 0.f; const int t0 = tid * PER;
#pragma unroll
        for (int i = 0; i < PER; ++i) { const int t = t0 + i; const float x = t < LREAL ? lf[(size_t)t * 8] : 0.f; s += x; v[i] = s; }
        float incl = s;
#pragma unroll
        for (int o = 1; o < 64; o <<= 1) { const float n = __shfl_up(incl, o); if (lane >= o) incl += n; }
        LAS float* wsum = (LAS float*)(lds + LDS_MISC + 256);
        if (lane == 63) wsum[wave] = incl;
        __syncthreads();
        float off = 0.f;
        for (int w = 0; w < wave; ++w) off += wsum[w];
        const float excl = off + incl - s;
#pragma unroll
        for (int i = 0; i < PER; ++i) { const int t = t0 + i; if (t < LREAL) cs[t] = excl + v[i]; }
        __syncthreads();
    }
    const bf16u* P = (const bf16u*)(ws + WS_P); bf16u* Y = (bf16u*)(ws + WS_Y);
    for (int sl = blockIdx.x; sl < 256; sl += gridDim.x) {
        if (tid < 480) { const int sub = tid / 96, task = tid % 96, which = task / 48, head = (task % 48) >> 3, chunk = task & 7; const int r0 = sl * (MROWS / 256), b = r0 / LP;
            const bf16u* src = P + (which ? PC_FK : PC_FQ) + head * 64 + chunk * 8; float mx = 0.f;
#pragma unroll 9
            for (int r = sub; r < MROWS / 256; r += 5) { const v4u w = ((r0 + r) % LP < LREAL) ? *(const v4u*)(src + (size_t)(r0 + r) * NINP) : (v4u){0u, 0u, 0u, 0u}; float s = 0.f;
#pragma unroll
                for (int e = 0; e < 4; ++e) { const float lo = __uint_as_float(w[e] << 16), hi = __uint_as_float(w[e] & 0xffff0000u); s += lo * lo + hi * hi; }
                s += __shfl_xor(s, 1); s += __shfl_xor(s, 2); s += __shfl_xor(s, 4); mx = fmaxf(mx, s); }
            if (chunk == 0) atomicMax(nrm + (b * NFH + head) * 2 + which, __float_as_uint(mx)); }
    }
    const int rsub = tid >> 5, ch = (tid & 31) * 8, win = 2 << (ch >> 6);
    const int nsc = (gridDim.x > 2 * NBATCH * NFH) ? NBATCH * NFH : 0;
    if ((int)blockIdx.x >= nsc)
    for (int c = blockIdx.x - nsc; c < MROWS / 64; c += gridDim.x - nsc) {
        const int rg = c * 64 + rsub * 4, t0 = rg % LP;
        v4u wv[19];
#pragma unroll
        for (int j = 0; j < 19; ++j) { const int back = 15 - j;
            wv[j] = (back < win && t0 - back >= 0) ? *(const v4u*)(P + (size_t)(rg - back) * NINP + PC_U + ch) : (v4u){0u, 0u, 0u, 0u}; }
#pragma unroll
        for (int i = 0; i < 4; ++i) { const int t = t0 + i, cnt = (t + 1 < win) ? t + 1 : win; float acc[8];
#pragma unroll
            for (int e = 0; e < 8; ++e) acc[e] = 0.f;
#pragma unroll
            for (int k = 0; k < 16; ++k) { if (k < cnt) {
#pragma unroll
                for (int e = 0; e < 4; ++e) { acc[2 * e] += __uint_as_float(wv[15 + i - k][e] << 16); acc[2 * e + 1] += __uint_as_float(wv[15 + i - k][e] & 0xffff0000u); } } }
            const float inv = 1.0f / (float)cnt; v4u o;
#pragma unroll
            for (int e = 0; e < 4; ++e) o[e] = pk2(acc[2 * e] * inv - __uint_as_float(wv[15 + i][e] << 16), acc[2 * e + 1] * inv - __uint_as_float(wv[15 + i][e] & 0xffff0000u));
            *(v4u*)(Y + (size_t)(rg + i) * 1024 + ch) = o; }
    }
}
__device__ __forceinline__ void attn_phase(unsigned char* ws, unsigned char* lds_g, unsigned* ctr, const unsigned* nrm, int tid) {
    const attn_body::bf16* P = (const attn_body::bf16*)(ws + WS_P); attn_body::bf16* Y = (attn_body::bf16*)(ws + WS_Y); const float* CS = (const float*)(ws + WS_CS);
    volatile LAS unsigned* bw = (volatile LAS unsigned*)((LAS unsigned char*)lds_g + LDS_MISC);
    constexpr int NU = NBATCH * NFH * (LP / 256);
    for (;;) {
        if (tid == 0) bw[0] = atomicAdd(ctr, 1u);
        __syncthreads();
        const int it = (int)bw[0];
        __syncthreads();
        if (it >= 2 * NU) break;
#ifdef PROBE
        if (it == NU && tid == 0) ((volatile unsigned long long*)(ws + WS_CTL + 8192))[20 + (ctr != (unsigned*)(ws + WS_CTL))] = __builtin_amdgcn_s_memrealtime();
#endif
        const int r = it < NU ? it : it - NU; const int qb = (LP / 256 - 1) - r / (NBATCH * NFH), bh = r % (NBATCH * NFH), b = bh / NFH, h = bh % NFH;
#ifndef NO_FOX
        if (it < NU) attn_body::fox_unit<8>(b, qb, 154.0f + 2.0f * sqrtf(__uint_as_float(nrm[bh * 2]) * __uint_as_float(nrm[bh * 2 + 1])), P + PC_FQ + h * 64, P + PC_FK + h * 64, P + PC_FV + h * 64, Y + 256 + h * 64, CS + (size_t)bh * LP, (char*)lds_g);
#endif
#ifndef NO_SB
        if (it >= NU) attn_body::sb_unit(b, qb, P + PC_SQ + h * 64, P + PC_SK + h * 64, P + PC_SV + h * 64, Y + 640 + h * 64, (char*)lds_g);
#endif
    }
}
__device__ __forceinline__ void final_phase(const Args& A, unsigned char* ws, int wave, int lane) {
    const bf16u* hb = (const bf16u*)(ws + WS_HB); const float* ss = (const float*)(ws + WS_SS) + 4 * (size_t)MROWS; const f32x4* g = (const f32x4*)A.in[14] + lane;
    const int gw = blockIdx.x * NWAVES + wave, NGW = gridDim.x * NWAVES;
    f32x4 gv[4];
#pragma unroll
    for (int j = 0; j < 4; ++j) gv[j] = g[64 * j];
    for (int m = gw; m < NBATCH * SEQ_IN; m += NGW) {
        const int b = m / SEQ_IN, s = m % SEQ_IN; const size_t row = (size_t)b * LP + NMETA + s;
        const float rs = 1.0f / sqrtf(ss[row] * (1.0f / 1024.0f) + 1e-6f);
        const unsigned long long* src = (const unsigned long long*)(hb + row * 1024) + lane; f32x4* dst = (f32x4*)(A.out + (size_t)m * 1024) + lane;
#pragma unroll
        for (int j = 0; j < 4; ++j) { const unsigned long long r = src[64 * j]; const unsigned rl = (unsigned)r, rh = (unsigned)(r >> 32);
            dst[64 * j] = (f32x4){__uint_as_float(rl << 16), __uint_as_float(rl & 0xffff0000u), __uint_as_float(rh << 16), __uint_as_float(rh & 0xffff0000u)} * rs * gv[j]; }
    }
}

#define XB_TMO      128
#define XB_XCNT(j)  (256  + 64 * (j))
#define XB_XSUB(j)  (1280 + 64 * (j))
#define XB_XGEN(j)  (2304 + 64 * (j))
#define XB_TOP      3328
#define XB_TOPGEN   3392
#define XCD_BAR_WORDS 3456
#define XB_SPIN_CAP (1u << 18)

__device__ __forceinline__ unsigned xb_ld(unsigned* p)              { return __hip_atomic_load(p, __ATOMIC_RELAXED, __HIP_MEMORY_SCOPE_AGENT); }
__device__ __forceinline__ unsigned xb_add(unsigned* p, unsigned v) { return __hip_atomic_fetch_add(p, v, __ATOMIC_RELAXED, __HIP_MEMORY_SCOPE_AGENT); }
__device__ __forceinline__ unsigned xb_xcc_id() { return (unsigned)__builtin_amdgcn_s_getreg((3 << 11) | 20) & 0xFu; }
#define XB_SPIN(cond, bar) do { unsigned _sp = 0; while (cond) { __builtin_amdgcn_s_sleep(1); \
    if ((++_sp & 255u) == 0u) { if (xb_ld(&(bar)[XB_TMO])) break; if (_sp > XB_SPIN_CAP) { atomicAdd(&(bar)[XB_TMO], 1u); break; } } } } while (0)

struct XcdBarrier {
    unsigned* bar; unsigned x;
    volatile LAS unsigned* st;
};

__device__ __forceinline__ XcdBarrier xcd_barrier_post(unsigned* bar, volatile LAS unsigned* st) {
    XcdBarrier b; b.bar = bar; b.x = xb_xcc_id(); b.st = st;
    if (threadIdx.x == 0) (void)xb_add(&bar[XB_XCNT(b.x)], 1u);
    return b;
}
__device__ __forceinline__ void xcd_barrier_complete(unsigned* bar, unsigned x, unsigned& nloc, unsigned& nx) {
    const unsigned G = gridDim.x * gridDim.y * gridDim.z;
    unsigned sum, cnt, mine, sp = 0u;
    for (;;) {
        sum = 0u; cnt = 0u; mine = 0u;
#pragma unroll
        for (unsigned j = 0; j < 16; ++j) { const unsigned c = xb_ld(&bar[XB_XCNT(j)]); sum += c; cnt += (c > 0u) ? 1u : 0u; mine = (j == x) ? c : mine; }
        if (sum == G) break;
        __builtin_amdgcn_s_sleep(1);
        if ((++sp & 255u) == 0u) { if (xb_ld(&bar[XB_TMO])) break; if (sp > XB_SPIN_CAP) { atomicAdd(&bar[XB_TMO], 1u); break; } }
    }
    nloc = mine > 0u ? mine : 1u; nx = cnt > 0u ? cnt : 1u;
}

__device__ __forceinline__ void xcd_barrier(const XcdBarrier& b) {
    asm volatile("s_waitcnt vmcnt(0)" ::: "memory");
    __syncthreads();
    if (threadIdx.x == 0) {
        unsigned* bar = b.bar;
        __builtin_amdgcn_s_waitcnt(0);
        unsigned nloc = b.st[0], nx = b.st[1];
        if (nloc == 0u) { xcd_barrier_complete(bar, b.x, nloc, nx); b.st[0] = nloc; b.st[1] = nx; }
        const unsigned old = xb_add(&bar[XB_XSUB(b.x)], 1u);
        const unsigned gen = old / nloc;
        if (old + 1u == (gen + 1u) * nloc) {
            __builtin_amdgcn_fence(__ATOMIC_RELEASE, "agent");
            asm volatile("s_waitcnt vmcnt(0)" ::: "memory");
            const unsigned og = xb_add(&bar[XB_TOP], 1u);
            const unsigned tg = og / nx;
            if (og + 1u == (tg + 1u) * nx) xb_add(&bar[XB_TOPGEN], 1u);
            else XB_SPIN(xb_ld(&bar[XB_TOPGEN]) == tg, bar);
            __builtin_amdgcn_fence(__ATOMIC_ACQUIRE, "agent");
            xb_add(&bar[XB_XGEN(b.x)], 1u);
            asm volatile("s_waitcnt vmcnt(0)" ::: "memory");
        } else {
            XB_SPIN(xb_ld(&bar[XB_XGEN(b.x)]) == gen, bar);
            __builtin_amdgcn_fence(__ATOMIC_ACQUIRE, "agent");
            asm volatile("s_waitcnt vmcnt(0)" ::: "memory");
        }
    }
    __syncthreads();
}

#define FRESH() unsigned long zoff_ = 0; asm volatile("" : "+s"(zoff_)); unsigned char* ws = A.ws + zoff_; int tid = threadIdx.x; asm volatile("" : "+v"(tid)); const int lane = tid & 63, wave = __builtin_amdgcn_readfirstlane(tid >> 6); (void)lane; (void)wave
#ifdef PROBE
#define STAMP() do { if (blockIdx.x == 0 && threadIdx.x == 0) { ((volatile unsigned long long*)(A.ws + WS_CTL + 8192))[nst] = __builtin_amdgcn_s_memrealtime(); } ++nst; } while (0)
#else
#define STAMP() do {} while (0)
#endif
__global__ void __launch_bounds__(NWAVES * 64, 2) hymba_fwd(Args A) {
    extern __shared__ __attribute__((aligned(16))) unsigned char lds[];
    cg::grid_group grid = cg::this_grid();
    LAS unsigned char* L = (LAS unsigned char*)lds;
    if (threadIdx.x < 2) ((volatile LAS unsigned*)(L + LDS_MISC + 64))[threadIdx.x] = 0u;
    __syncthreads();
    const XcdBarrier xbar = xcd_barrier_post((unsigned*)(A.ws + WS_CTL) + 4096, (volatile LAS unsigned*)(L + LDS_MISC + 64));
#define GRID_BAR() xcd_barrier(xbar)
#ifdef PROBE
    int nst = 0; STAMP();
    for (int i = 0; i < 8; ++i) GRID_BAR();
    STAMP();
#endif
#ifndef NO_PRO
    { FRESH(); p0_prologue(A, ws, L, wave, lane); }
#endif
    if (A.ws == nullptr) grid.sync();
    GRID_BAR(); STAMP();
    for (int layer = 0; layer < DEPTH; ++layer) {
#ifndef NO_G1
        {
            FRESH(); const unsigned char* wb = ws + WS_W + (size_t)layer * W_LAYER;
            pg8::Gemm g{(const pg8::bf16_t*)(ws + WS_HB), (const pg8::bf16_t*)(wb + W_IN), MREAL, NINP, 1024}; pg8::StaticOrder S; S.init(MREAL, NINP, (int)gridDim.x, (int)blockIdx.x);
            pg8::EpiIn E{(pg8::bf16_t*)(ws + WS_P), (float*)(ws + WS_LF), (const float*)(ws + WS_SS) + (size_t)(2 * layer) * MROWS, A.in[4] + layer * NFH};
            fl_phase(ws, (const bf16u*)(wb + W_IN) + (size_t)NINP * 1024, (const float*)(ws + WS_SS) + (size_t)(2 * layer) * MROWS, A.in[4] + layer * NFH, wave, lane);
            mini_in(ws, (const bf16u*)(wb + W_IN), (const float*)(ws + WS_SS) + (size_t)(2 * layer) * MROWS, A.in[4] + layer * NFH, L, wave, lane);
            pg8::gemm_phase<pg8::EpiIn, pg8::StaticOrder, true, true>(L, g, S, E);
        }
#endif
        GRID_BAR(); STAMP();
#ifndef NO_POOL
        { FRESH(); pool_scan_phase(ws, L, (unsigned*)(ws + WS_CTL) + 128 + 64 * layer, tid, wave, lane); }
#endif
        GRID_BAR(); STAMP();
        { FRESH(); attn_phase(ws, lds, (unsigned*)(ws + WS_CTL) + 64 * layer, (const unsigned*)(ws + WS_CTL) + 128 + 64 * layer, tid); }
        GRID_BAR(); STAMP();
#ifndef NO_G3
        {
            FRESH(); const unsigned char* wb = ws + WS_W + (size_t)layer * W_LAYER;
            pg8::Gemm g{(const pg8::bf16_t*)(ws + WS_Y), (const pg8::bf16_t*)(wb + W_OUT), MREAL, 1024, 1024}; pg8::StaticOrder S; S.init(MREAL, 1024, (int)gridDim.x, (int)blockIdx.x);
            pg8::EpiRes E{(pg8::bf16_t*)(ws + WS_HB), nullptr, (float*)(ws + WS_SS) + (size_t)(2 * layer + 1) * MROWS};
            mini_res(ws, (const bf16u*)(ws + WS_Y), (const bf16u*)(wb + W_OUT), 1024, (float*)(ws + WS_SS) + (size_t)(2 * layer + 1) * MROWS, L, wave, lane);
            pg8::gemm_phase<pg8::EpiRes, pg8::StaticOrder, true, true>(L, g, S, E);
        }
#endif
        GRID_BAR(); STAMP();
#ifndef NO_G4
        {
            FRESH(); const unsigned char* wb = ws + WS_W + (size_t)layer * W_LAYER;
            pg8::Gemm g{(const pg8::bf16_t*)(ws + WS_HB), (const pg8::bf16_t*)(wb + W_GU), MREAL, NGU, 1024}; pg8::StaticOrder S; S.init(MREAL, NGU, (int)gridDim.x, (int)blockIdx.x);
            pg8::EpiGU E{(pg8::bf16_t*)(ws + WS_P), (const float*)(ws + WS_SS) + (size_t)(2 * layer + 1) * MROWS};
            mini_gu(ws, (const bf16u*)(wb + W_GU), (const float*)(ws + WS_SS) + (size_t)(2 * layer + 1) * MROWS, L, wave, lane);
            pg8::gemm_phase<pg8::EpiGU, pg8::StaticOrder, true, true>(L, g, S, E);
        }
#endif
        GRID_BAR(); STAMP();
#ifndef NO_G5
        {
            FRESH(); const unsigned char* wb = ws + WS_W + (size_t)layer * W_LAYER;
            pg8::Gemm g{(const pg8::bf16_t*)(ws + WS_P), (const pg8::bf16_t*)(wb + W_D), MREAL, 1024, DFF}; pg8::StaticOrder S; S.init(MREAL, 1024, (int)gridDim.x, (int)blockIdx.x);
            pg8::EpiRes E{(pg8::bf16_t*)(ws + WS_HB), nullptr, (float*)(ws + WS_SS) + (size_t)(2 * layer + 2) * MROWS};
            mini_res(ws, (const bf16u*)(ws + WS_P), (const bf16u*)(wb + W_D), DFF, (float*)(ws + WS_SS) + (size_t)(2 * layer + 2) * MROWS, L, wave, lane);
            pg8::gemm_phase<pg8::EpiRes, pg8::StaticOrder, true, true>(L, g, S, E);
        }
#endif
        GRID_BAR(); STAMP();
    }
    { FRESH(); final_phase(A, ws, wave, lane); }
#ifdef PROBE
    STAMP();
    grid.sync();
    {
        volatile unsigned long long* T = (volatile unsigned long long*)(A.ws + WS_CTL + 8192);
        if (blockIdx.x == 0) {
#ifndef PB_HI
#define PB_HI (PB + 1)
#endif
            const unsigned long long dA = T[PA + 1] - T[PA], dB = T[PB_HI] - T[PB];
            for (unsigned long long i = threadIdx.x; i < dB; i += NWAVES * 64) A.out[i] += 0.125f;
            if (threadIdx.x == 0) { const unsigned long long t0 = __builtin_amdgcn_s_memrealtime(); while (__builtin_amdgcn_s_memrealtime() - t0 < dA) __builtin_amdgcn_s_sleep(8); }
        }
    }
#endif
}

extern "C" void kernel_launch(void* const* d_in, const int* in_sizes, int n_in, void* d_out, int out_size, void* d_ws, size_t ws_size, hipStream_t stream) {
    static int grid = 0;
    if (grid == 0) {
        if (n_in != 15 || out_size != NBATCH * SEQ_IN * DMODEL || ws_size < WS_END) { fprintf(stderr, "kernel_launch: unexpected shapes (n_in %d out %d ws %zu, need %zu)\n", n_in, out_size, ws_size, (size_t)WS_END); grid = -1; return; }
        int dev = 0, cus = 0, per_cu = 0;
        if (hipGetDevice(&dev) != hipSuccess || hipDeviceGetAttribute(&cus, hipDeviceAttributeMultiprocessorCount, dev) != hipSuccess) { grid = -1; return; }
        if (hipFuncSetAttribute((const void*)hymba_fwd, hipFuncAttributeMaxDynamicSharedMemorySize, LDS_BYTES) != hipSuccess) { fprintf(stderr, "kernel_launch: hipFuncSetAttribute failed\n"); grid = -1; return; }
        if (hipOccupancyMaxActiveBlocksPerMultiprocessor(&per_cu, (const void*)hymba_fwd, NWAVES * 64, LDS_BYTES) != hipSuccess || per_cu < 1) { fprintf(stderr, "kernel_launch: occupancy query says %d\n", per_cu); per_cu = 1; }
        (void)hipGetLastError();
        grid = cus;
    }
    if (grid < 0) return;
    if (hipMemsetAsync((char*)d_ws + WS_CTL, 0, CTL_ZERO_BYTES, stream) != hipSuccess) { fprintf(stderr, "kernel_launch: memset failed\n"); return; }
    Args a{};
    for (int i = 0; i < 15; ++i) a.in[i] = (const float*)d_in[i];
    a.out = (float*)d_out; a.ws = (unsigned char*)d_ws;
    void* args[] = {&a};
    const hipError_t e = hipLaunchCooperativeKernel((const void*)hymba_fwd, dim3(grid), dim3(NWAVES * 64), args, LDS_BYTES, stream);
    if (e != hipSuccess) fprintf(stderr, "kernel_launch: cooperative launch failed: %s (grid %d)\n", hipGetErrorString(e), grid);
}
```

```cpp
#include <hip/hip_runtime.h>
#include <hip/hip_cooperative_groups.h>
#include <cstdio>
#include <cstdint>
namespace pg8 {
#define PG8_LAS __attribute__((address_space(3)))
typedef unsigned short bf16_t;
typedef short bf16x8 __attribute__((ext_vector_type(8)));
typedef float f32x4 __attribute__((ext_vector_type(4)));
typedef unsigned u32x4 __attribute__((ext_vector_type(4)));
constexpr int BM = 256, BK = 64, HALF = 128, HTB = HALF * BK * 2  , STAGE_BYTES = 8 * HTB, NXCD = 8, WGM = 8;

__host__ __device__ __forceinline__ int lds_byte(int r, int c) { const int st = (r >> 4) * 2 + (c >> 5), rr = r & 15, cc = c & 31, ob = rr * 64 + cc * 2; return st * 1024 + (ob ^ (((ob >> 9) & 1) << 5)); }
__host__ __device__ __forceinline__ void stage_rc(int b, int& R, int& C) { const int st = b / 1024, sb = b % 1024, swz = sb ^ (((sb >> 9) & 1) << 5); R = (st >> 1) * 16 + swz / 64; C = (st & 1) * 32 + (swz % 64) / 2; }
__host__ __device__ __forceinline__ int perm32(int rho) { const int n = rho >> 4, i = rho & 15; return 8 * (i >> 2) + 4 * n + (i & 3); }

struct Unit { int pm, pn; };
__host__ __device__ __forceinline__ int arow(int pm) { return 256 * (pm + (pm >> 5)) + 16; }
struct Gemm { const bf16_t* A; const bf16_t* Bt; int M, N, K; };

struct StaticOrder {
    int nM, nN, nwg, G, c;
    __host__ __device__ void init(int M, int N, int G_, int c_) { nM = M / BM; nN = N / BM; nwg = nM * nN; G = G_; c = c_; }
    __host__ __device__ bool next(int i, Unit& u) const {
        const long L = (long)i * G + c; if (L >= nwg) return false;
        int wgid = (int)L; { const int q = nwg / NXCD, r = nwg % NXCD, xcd = wgid % NXCD, off = wgid / NXCD; wgid = (xcd < r ? xcd * (q + 1) : r * (q + 1) + (xcd - r) * q) + off; }
        const int nig = WGM * nN, gid = wgid / nig, fm = gid * WGM, gsz = (nM - fm) < WGM ? (nM - fm) : WGM;
        u.pm = fm + ((wgid % nig) % gsz); u.pn = (wgid % nig) / gsz; return true;
    }
    __device__ __forceinline__ void a_ready(const Unit&) const {}
    __device__ __forceinline__ void done(const Unit&) const {}
};

__device__ __forceinline__ unsigned cvt_pk_bf16(float lo, float hi) { unsigned r; asm volatile("v_cvt_pk_bf16_f32 %0, %1, %2" : "=v"(r) : "v"(lo), "v"(hi)); return r; }
typedef unsigned u32x2 __attribute__((ext_vector_type(2)));
constexpr float RMS_EPS = 1e-6f;
struct EpiIn {
    static constexpr bool PERM = true, AFTER_DRAIN = false;
    bf16_t* P; float* LF; const float* ss; const float* fb;
    __device__ __forceinline__ void operator()(const f32x4 (&acc)[2][2][4][2], const Unit& u, int wr, int wc, int fr, int fq) const {
        const int row0 = arow(u.pm) + wr * 64 + fr;
        {
            const int col0 = u.pn * BM + wc * 32 + 8 * fq;
#pragma unroll
            for (int ai = 0; ai < 2; ++ai)
#pragma unroll
                for (int m = 0; m < 4; ++m) { const int row = row0 + ai * HALF + m * 16; const float rs = __builtin_amdgcn_rsqf(ss[row] * (1.0f / 1024.0f) + RMS_EPS);
                    bf16_t* rowp = P + (size_t)row * 2560 + col0;
#pragma unroll
                    for (int bj = 0; bj < 2; ++bj) { const f32x4 v0 = acc[ai][bj][m][0] * rs, v1 = acc[ai][bj][m][1] * rs;
                        u32x4 w; w.x = cvt_pk_bf16(v0[0], v0[1]); w.y = cvt_pk_bf16(v0[2], v0[3]); w.z = cvt_pk_bf16(v1[0], v1[1]); w.w = cvt_pk_bf16(v1[2], v1[3]);
                        *(u32x4*)(rowp + bj * HALF) = w; } }
        }
    }
};
struct EpiRes {
    static constexpr bool PERM = true, AFTER_DRAIN = false;
    bf16_t* hb; float* hf; float* ssn;
    __device__ __forceinline__ void operator()(const f32x4 (&acc)[2][2][4][2], const Unit& u, int wr, int wc, int fr, int fq) const {
        const int row0 = arow(u.pm) + wr * 64 + fr, col0 = u.pn * BM + wc * 32 + 8 * fq;
#pragma unroll
        for (int ai = 0; ai < 2; ++ai)
#pragma unroll
            for (int m = 0; m < 4; ++m) { const int row = row0 + ai * HALF + m * 16; bf16_t* bp = hb + (size_t)row * 1024 + col0; float s = 0.f;
#pragma unroll
                for (int bj = 0; bj < 2; ++bj) { const u32x4 r = *(const u32x4*)(bp + bj * HALF);
                    f32x4 a = (f32x4){__uint_as_float(r.x << 16), __uint_as_float(r.x & 0xffff0000u), __uint_as_float(r.y << 16), __uint_as_float(r.y & 0xffff0000u)};
                    f32x4 b = (f32x4){__uint_as_float(r.z << 16), __uint_as_float(r.z & 0xffff0000u), __uint_as_float(r.w << 16), __uint_as_float(r.w & 0xffff0000u)};
                    a = a + acc[ai][bj][m][0]; b = b + acc[ai][bj][m][1];
                    if (hf) { float* hp = hf + (size_t)row * 1024 + col0 + bj * HALF; *(f32x4*)hp = a; *(f32x4*)(hp + 4) = b; }
                    s += (a[0] * a[0] + a[1] * a[1]) + (a[2] * a[2] + a[3] * a[3]) + (b[0] * b[0] + b[1] * b[1]) + (b[2] * b[2] + b[3] * b[3]);
                    u32x4 w; w.x = cvt_pk_bf16(a[0], a[1]); w.y = cvt_pk_bf16(a[2], a[3]); w.z = cvt_pk_bf16(b[0], b[1]); w.w = cvt_pk_bf16(b[2], b[3]);
                    *(u32x4*)(bp + bj * HALF) = w; }
                s += __shfl_xor(s, 16); s += __shfl_xor(s, 32);
                if (fq == 0) atomicAdd(ssn + row, s);
                asm volatile("" ::: "memory"); }
    }
};
struct EpiGU {
    static constexpr bool PERM = true, AFTER_DRAIN = false;
    bf16_t* H; const float* ss;
    __device__ __forceinline__ void operator()(const f32x4 (&acc)[2][2][4][2], const Unit& u, int wr, int wc, int fr, int fq) const {
        const int row0 = arow(u.pm) + wr * 64 + fr, col0 = u.pn * HALF + wc * 32 + 8 * fq;
#pragma unroll
        for (int ai = 0; ai < 2; ++ai)
#pragma unroll
            for (int m = 0; m < 4; ++m) { const int row = row0 + ai * HALF + m * 16; const float rs = __builtin_amdgcn_rsqf(ss[row] * (1.0f / 1024.0f) + RMS_EPS);
                float o[8];
#pragma unroll
                for (int n = 0; n < 2; ++n)
#pragma unroll
                    for (int e = 0; e < 4; ++e) { const float g = acc[ai][0][m][n][e] * rs, up = acc[ai][1][m][n][e] * rs;
                        o[4 * n + e] = g * __builtin_amdgcn_rcpf(1.0f + __builtin_amdgcn_exp2f(-1.4426950408889634f * g)) * up; }
                u32x4 w; w.x = cvt_pk_bf16(o[0], o[1]); w.y = cvt_pk_bf16(o[2], o[3]); w.z = cvt_pk_bf16(o[4], o[5]); w.w = cvt_pk_bf16(o[6], o[7]);
                *(u32x4*)(H + (size_t)row * 2816 + col0) = w; }
    }
};
template <class Epi, class Sched, bool ALIGN_EPI = false, bool SP2 = false>
__device__ __forceinline__ void gemm_phase(PG8_LAS unsigned char* lds, const Gemm g, const Sched& S, const Epi& E) {
    int tid_ = threadIdx.x; asm volatile("" : "+v"(tid_));
    const int tid = tid_, wid = __builtin_amdgcn_readfirstlane(tid >> 6), lane = tid & 63, wr = wid >> 2, wc = wid & 3, fr = lane & 15, fq = lane >> 4;
    const int K = g.K, nt = K / BK;
    unsigned voffA[2], voffB[2];
#pragma unroll
    for (int i = 0; i < 2; ++i) { int R, C; stage_rc(tid * 16 + i * 8192, R, C); const int Rb = Epi::PERM ? ((R & ~31) + perm32(R & 31)) : R;
        voffA[i] = (unsigned)(R * K + C) * 2u; voffB[i] = (unsigned)(Rb * K + C) * 2u; }
    const size_t kstep = (size_t)(BK * 2);
    const size_t hstep = (size_t)HALF * K * 2;
    const size_t tstep = 2 * hstep;
    const unsigned ldsw = (unsigned)wid * 1024u;
    const int aoff = lds_byte(wr * 64 + fr, fq * 8), boff = lds_byte(wc * 32 + fr, fq * 8);
#define PG8_SA(b, h) (((b) * 2 + (h)) * HTB)
#define PG8_SB(b, h) ((4 + (b) * 2 + (h)) * HTB)
#define PG8_STAGE(bufoff, gbase, voff) do { _Pragma("unroll") for (int _i = 0; _i < 2; ++_i) \
        __builtin_amdgcn_global_load_lds((const unsigned*)((const char*)(gbase) + (voff)[_i]), (PG8_LAS unsigned*)(lds + (bufoff) + ldsw + _i * 8192), 16, 0, 0); } while (0)
#define PG8_LDA(dst, b, h) do { _Pragma("unroll") for (int m = 0; m < 4; ++m) _Pragma("unroll") for (int k = 0; k < 2; ++k) dst[m][k] = *(const PG8_LAS bf16x8*)(lds + PG8_SA(b, h) + aoff + m * 2048 + k * 1024); } while (0)
#define PG8_LDB(dst, b, h) do { _Pragma("unroll") for (int n = 0; n < 2; ++n) _Pragma("unroll") for (int k = 0; k < 2; ++k) dst[n][k] = *(const PG8_LAS bf16x8*)(lds + PG8_SB(b, h) + boff + n * 2048 + k * 1024); } while (0)
#define PG8_MMA(ai, bj, At, Bt) do { __builtin_amdgcn_s_setprio(1); _Pragma("unroll") for (int m = 0; m < 4; ++m) _Pragma("unroll") for (int n = 0; n < 2; ++n) _Pragma("unroll") for (int k = 0; k < 2; ++k) \
        acc[ai][bj][m][n] = __builtin_amdgcn_mfma_f32_16x16x32_bf16(Bt[n][k], At[m][k], acc[ai][bj][m][n], 0, 0, 0); __builtin_amdgcn_s_setprio(0); } while (0)
#define PG8_WAIT_V(n) asm volatile("s_waitcnt vmcnt(" #n ")" ::: "memory")
#define PG8_WAIT_L(n) asm volatile("s_waitcnt lgkmcnt(" #n ")" ::: "memory")
#define PG8_BAR __builtin_amdgcn_s_barrier()
#define PG8_SCHED __builtin_amdgcn_sched_barrier(0)
    Unit cur, nxt; int ui = 0;
    if (!S.next(0, cur)) return;
    f32x4 acc[2][2][4][2];
#pragma unroll
    for (int a = 0; a < 2; ++a)
#pragma unroll
        for (int b = 0; b < 2; ++b)
#pragma unroll
            for (int m = 0; m < 4; ++m)
#pragma unroll
                for (int n = 0; n < 2; ++n) acc[a][b][m][n] = (f32x4){0.f, 0.f, 0.f, 0.f};
    bf16x8 At[4][2], B0[2][2], B1[2][2];
    const char* cA = (const char*)g.A + (size_t)arow(cur.pm) * K * 2; const char* cB = (const char*)g.Bt + (size_t)cur.pn * tstep;
    S.a_ready(cur);
    if constexpr (SP2) {
        PG8_STAGE(PG8_SB(0, 0), cB, voffB); PG8_STAGE(PG8_SB(0, 1), cB + hstep, voffB); PG8_STAGE(PG8_SA(0, 0), cA, voffA); PG8_STAGE(PG8_SA(0, 1), cA + hstep, voffA);
        if (wr == 1) PG8_BAR;
        PG8_WAIT_V(2); PG8_BAR;
        PG8_STAGE(PG8_SB(1, 0), cB + kstep, voffB); PG8_STAGE(PG8_SA(1, 0), cA + kstep, voffA); PG8_STAGE(PG8_SB(1, 1), cB + hstep + kstep, voffB);
        PG8_WAIT_V(6); PG8_BAR;
    } else {
        PG8_STAGE(PG8_SB(0, 0), cB, voffB); PG8_STAGE(PG8_SA(0, 0), cA, voffA); PG8_STAGE(PG8_SB(0, 1), cB + hstep, voffB); PG8_STAGE(PG8_SA(0, 1), cA + hstep, voffA);
        if (wr == 1) PG8_BAR;
        PG8_WAIT_V(4); PG8_BAR;
        PG8_STAGE(PG8_SB(1, 0), cB + kstep, voffB); PG8_STAGE(PG8_SA(1, 0), cA + kstep, voffA); PG8_STAGE(PG8_SB(1, 1), cB + hstep + kstep, voffB);
        PG8_WAIT_V(6); PG8_BAR;
    }
    for (;;) {
        const bool has_next = S.next(ui + 1, nxt);
        const char* nA = has_next ? (const char*)g.A + (size_t)arow(nxt.pm) * K * 2 : cA; const char* nB = has_next ? (const char*)g.Bt + (size_t)nxt.pn * tstep : cB;
        for (int t = 0; t < nt; t += 2) {
            const bool last = (t == nt - 2);
            const char* a1 = cA + (size_t)(t + 1) * kstep;
            const char* a2 = last ? nA : cA + (size_t)(t + 2) * kstep; const char* b2 = last ? nB : cB + (size_t)(t + 2) * kstep;
            const char* a3 = a2 + kstep; const char* b3 = b2 + kstep;
            if (last && has_next) S.a_ready(nxt);
            if constexpr (SP2) {
            PG8_LDB(B0, 0, 0); PG8_LDB(B1, 0, 1); PG8_SCHED; PG8_LDA(At, 0, 0); PG8_STAGE(PG8_SA(1, 1), a1 + hstep, voffA);
            PG8_WAIT_V(8); PG8_WAIT_L(0); PG8_BAR; PG8_MMA(0, 0, At, B0); PG8_MMA(0, 1, At, B1); PG8_BAR; PG8_SCHED;
            PG8_LDA(At, 0, 1); PG8_STAGE(PG8_SB(0, 0), b2, voffB); PG8_STAGE(PG8_SB(0, 1), b2 + hstep, voffB); PG8_STAGE(PG8_SA(0, 0), a2, voffA);
            PG8_WAIT_V(8); PG8_WAIT_L(0); PG8_BAR; PG8_MMA(1, 0, At, B0); PG8_MMA(1, 1, At, B1); PG8_BAR; PG8_SCHED;
            PG8_LDB(B0, 1, 0); PG8_LDB(B1, 1, 1); PG8_SCHED; PG8_LDA(At, 1, 0); PG8_STAGE(PG8_SA(0, 1), a2 + hstep, voffA);
            PG8_WAIT_V(8); PG8_WAIT_L(0); PG8_BAR; PG8_MMA(0, 0, At, B0); PG8_MMA(0, 1, At, B1); PG8_BAR; PG8_SCHED;
            PG8_LDA(At, 1, 1); PG8_STAGE(PG8_SB(1, 0), b3, voffB); PG8_STAGE(PG8_SB(1, 1), b3 + hstep, voffB); PG8_STAGE(PG8_SA(1, 0), a3, voffA);
            PG8_WAIT_V(8); PG8_WAIT_L(0); PG8_BAR; PG8_MMA(1, 0, At, B0); PG8_MMA(1, 1, At, B1); PG8_BAR; PG8_SCHED;
            } else {
            PG8_LDB(B0, 0, 0); PG8_SCHED; PG8_LDA(At, 0, 0); PG8_STAGE(PG8_SA(1, 1), a1 + hstep, voffA);
            PG8_WAIT_L(8); PG8_BAR; PG8_WAIT_L(0); PG8_MMA(0, 0, At, B0); PG8_BAR; PG8_SCHED;
            PG8_LDB(B1, 0, 1); PG8_STAGE(PG8_SB(0, 0), b2, voffB);
            PG8_BAR; PG8_WAIT_L(0); PG8_MMA(0, 1, At, B1); PG8_BAR;
            PG8_LDA(At, 0, 1); PG8_STAGE(PG8_SA(0, 0), a2, voffA);
            PG8_BAR; PG8_WAIT_L(0); PG8_MMA(1, 0, At, B0); PG8_BAR; PG8_SCHED;
            PG8_STAGE(PG8_SB(0, 1), b2 + hstep, voffB);
            PG8_WAIT_V(6); PG8_BAR; PG8_MMA(1, 1, At, B1); PG8_BAR;
            PG8_LDB(B0, 1, 0); PG8_SCHED; PG8_LDA(At, 1, 0); PG8_STAGE(PG8_SA(0, 1), a2 + hstep, voffA);
            PG8_WAIT_L(8); PG8_BAR; PG8_WAIT_L(0); PG8_MMA(0, 0, At, B0); PG8_BAR; PG8_SCHED;
            PG8_LDB(B1, 1, 1); PG8_STAGE(PG8_SB(1, 0), b3, voffB);
            PG8_BAR; PG8_WAIT_L(0); PG8_MMA(0, 1, At, B1); PG8_BAR;
            PG8_LDA(At, 1, 1); PG8_STAGE(PG8_SA(1, 0), a3, voffA);
            PG8_BAR; PG8_WAIT_L(0); PG8_MMA(1, 0, At, B0); PG8_BAR; PG8_SCHED;
            PG8_STAGE(PG8_SB(1, 1), b3 + hstep, voffB);
            PG8_WAIT_V(6); PG8_BAR; PG8_MMA(1, 1, At, B1); PG8_BAR;
            }
        }
        if constexpr (ALIGN_EPI) { if (wr == 0) PG8_BAR; }
        if constexpr (!Epi::AFTER_DRAIN) { E(acc, cur, wr, wc, fr, fq); S.done(cur); }
        if (!has_next) break;
#pragma unroll
        for (int a = 0; a < 2; ++a)
#pragma unroll
            for (int b = 0; b < 2; ++b)
#pragma unroll
                for (int m = 0; m < 4; ++m)
#pragma unroll
                    for (int n = 0; n < 2; ++n) acc[a][b][m][n] = (f32x4){0.f, 0.f, 0.f, 0.f};
        cur = nxt; cA = nA; cB = nB; ++ui;
        if constexpr (ALIGN_EPI) { if (wr == 1) PG8_BAR; }
    }
    PG8_WAIT_V(0);
    if constexpr (!ALIGN_EPI) { if (wr == 0) PG8_BAR; }
    PG8_BAR;
    if constexpr (Epi::AFTER_DRAIN) { E.fused(acc, cur, wr, wc, fr, fq, lds, wid, lane); S.done(cur); }
#undef PG8_SA
#undef PG8_SB
#undef PG8_STAGE
#undef PG8_LDA
#undef PG8_LDB
#undef PG8_MMA
#undef PG8_WAIT_V
#undef PG8_WAIT_L
#undef PG8_BAR
#undef PG8_SCHED
}
}
#include <hip/hip_bf16.h>
#include <cmath>
namespace attn_body {
using bf16=__hip_bfloat16;
using bf16x8=__attribute__((ext_vector_type(8)))short;
using s16x4=__attribute__((ext_vector_type(4)))short;
using f32x16=__attribute__((ext_vector_type(16)))float;
using u32x4=__attribute__((ext_vector_type(4)))unsigned;
constexpr int SEQ=8448,D=64,DM=2560,DMO=1024;
using f32x4=__attribute__((ext_vector_type(4)))float;
constexpr int NW=8,QBLK=32,QB=QBLK*NW,KVBLK=64,NQB=SEQ/QB;
constexpr int ATTN_UNIT_ROWS=QB;
__device__ __forceinline__ int crow(int r,int hi){return (r&3)+8*(r>>2)+4*hi;}
#define SBAR() __builtin_amdgcn_sched_barrier(0)
__device__ __forceinline__ void cmask(f32x16&p0,f32x16&p1,int jb,int qrel,int hi){
  const float NEG=-INFINITY; int kb=64*jb+4*hi;
  #pragma unroll
  for(int r=0;r<16;++r){int kv=kb+(r&3)+8*(r>>2); if(kv>qrel)p0[r]=NEG; if(kv+32>qrel)p1[r]=NEG;}
}

constexpr int NSLOT=3, SLOTB=8192;
constexpr int LDS_K=0, LDS_V=NSLOT*SLOTB, LDS_WS=2*NSLOT*SLOTB, LDS_OST=LDS_WS+NW*64*4, LDS_BYTES=LDS_OST+NW*4096, LDS_CS=LDS_BYTES, LDS_FLAGS=LDS_CS+SEQ*4, LDS_END=LDS_FLAGS+256;
constexpr float C2=0.125f*1.4426950408889634f;
__device__ __forceinline__ void glds16(const void*gsrc,unsigned lds_dst){unsigned keep;
  asm volatile("s_mov_b32 %0, m0\n\ts_mov_b32 m0, %2\n\ts_nop 0\n\tglobal_load_lds_dwordx4 %1, off\n\ts_mov_b32 m0, %0":"=&s"(keep):"v"(gsrc),"s"(lds_dst):"memory");}
__device__ __forceinline__ float max3f(float a,float b,float c){float r;asm("v_max3_f32 %0, %1, %2, %3":"=v"(r):"v"(a),"v"(b),"v"(c));return r;}
__device__ __forceinline__ float max2f(float a,float b){float r;asm("v_max_f32_e32 %0, %1, %2":"=v"(r):"v"(a),"v"(b));return r;}
__device__ __forceinline__ float fadd_s(float a,float b){float r;asm("v_add_f32_e32 %0, %1, %2":"=v"(r):"v"(a),"v"(b));return r;}
__device__ __forceinline__ float fsub_s(float a,float b){float r;asm("v_sub_f32_e32 %0, %1, %2":"=v"(r):"v"(a),"v"(b));return r;}
typedef float f32x2_t __attribute__((ext_vector_type(2))); typedef __bf16 bf16x2_t __attribute__((ext_vector_type(2)));
__device__ __forceinline__ unsigned cvtpk_s(float lo,float hi){f32x2_t v={lo,hi};bf16x2_t b=__builtin_convertvector(v,bf16x2_t);return __builtin_bit_cast(unsigned,b);}
#define WAIT_BAR(N) asm volatile("s_waitcnt vmcnt(" #N ") lgkmcnt(0)\n\ts_barrier":::"memory")

__device__ __forceinline__ void qkt(f32x16&p0,f32x16&p1,const char*Kslot,const bf16x8*qr,int r32,int hi){
  const char*kb=Kslot+hi*1024+r32*16;
  #pragma unroll
  for(int d0=0;d0<4;++d0){
    const bf16x8 b0=*reinterpret_cast<const bf16x8*>(kb+d0*2048);
    const bf16x8 b1=*reinterpret_cast<const bf16x8*>(kb+d0*2048+512);
    {p0=__builtin_amdgcn_mfma_f32_32x32x16_bf16(b0,qr[d0],p0,0,0,0);p1=__builtin_amdgcn_mfma_f32_32x32x16_bf16(b1,qr[d0],p1,0,0,0);}}
}
typedef __attribute__((address_space(3))) const char* lds_cptr;
typedef short v4i16_t __attribute__((ext_vector_type(4)));
__device__ __forceinline__ void kload8(bf16x8*kf,lds_cptr kp){
  kf[0]=*(const __attribute__((address_space(3))) bf16x8*)(kp);      kf[1]=*(const __attribute__((address_space(3))) bf16x8*)(kp+512);
  kf[2]=*(const __attribute__((address_space(3))) bf16x8*)(kp+2048); kf[3]=*(const __attribute__((address_space(3))) bf16x8*)(kp+2560);
  kf[4]=*(const __attribute__((address_space(3))) bf16x8*)(kp+4096); kf[5]=*(const __attribute__((address_space(3))) bf16x8*)(kp+4608);
  kf[6]=*(const __attribute__((address_space(3))) bf16x8*)(kp+6144); kf[7]=*(const __attribute__((address_space(3))) bf16x8*)(kp+6656);
}
__device__ __forceinline__ void kload2(bf16x8*kf,lds_cptr kp,int j){ kf[2*j]=*(const __attribute__((address_space(3))) bf16x8*)(kp+j*2048); kf[2*j+1]=*(const __attribute__((address_space(3))) bf16x8*)(kp+j*2048+512); }
__device__ __forceinline__ s16x4 vtr(lds_cptr p){ return __builtin_bit_cast(s16x4,__builtin_amdgcn_ds_read_tr16_b64_v4i16((__attribute__((address_space(3))) v4i16_t*)p)); }
__device__ __forceinline__ float rowmax(const f32x16&p0,const f32x16&p1){
  float a=max3f(p0[0],p0[1],p1[0]),b=max3f(p0[2],p0[3],p1[1]);a=max3f(a,p1[2],p1[3]);
  #pragma unroll
  for(int r=4;r<16;r+=4){a=max3f(a,p0[r],p0[r+1]);b=max3f(b,p0[r+2],p0[r+3]);a=max3f(a,p1[r],p1[r+1]);b=max3f(b,p1[r+2],p1[r+3]);}
  const float m=max2f(a,b);
  auto rr=__builtin_amdgcn_permlane32_swap(__float_as_uint(m),__float_as_uint(m),false,false);
  return max2f(__uint_as_float(rr[0]),__uint_as_float(rr[1]));
}
__device__ __forceinline__ void pv(f32x16*o,int vb,bf16x8 pa0,bf16x8 pa1,bf16x8 pa2,bf16x8 pa3){
  #pragma unroll
  for(int d0=0;d0<2;++d0){s16x4 lo[4],hi[4];
    #pragma unroll
    for(int ks=0;ks<4;++ks){
      asm volatile("ds_read_b64_tr_b16 %0,%1 offset:%c2":"=&v"(lo[ks]):"v"(vb),"i"(d0*4096+ks*1024):"memory");
      asm volatile("ds_read_b64_tr_b16 %0,%1 offset:%c2":"=&v"(hi[ks]):"v"(vb),"i"(d0*4096+ks*1024+512):"memory");}
    asm volatile("s_waitcnt lgkmcnt(0)":::"memory");SBAR();
    #define PK(k) (bf16x8){lo[k][0],lo[k][1],lo[k][2],lo[k][3],hi[k][0],hi[k][1],hi[k][2],hi[k][3]}
    o[d0]=__builtin_amdgcn_mfma_f32_32x32x16_bf16(pa0,PK(0),o[d0],0,0,0);
    o[d0]=__builtin_amdgcn_mfma_f32_32x32x16_bf16(pa1,PK(1),o[d0],0,0,0);
    o[d0]=__builtin_amdgcn_mfma_f32_32x32x16_bf16(pa2,PK(2),o[d0],0,0,0);
    o[d0]=__builtin_amdgcn_mfma_f32_32x32x16_bf16(pa3,PK(3),o[d0],0,0,0);
    #undef PK
  }
}

__device__ __forceinline__ u32x4 head_rms(u32x4 v){ float x[8];
  #pragma unroll
  for(int i=0;i<4;++i){x[2*i]=__uint_as_float(v[i]<<16);x[2*i+1]=__uint_as_float(v[i]&0xffff0000u);}
  float s=0.f;
  #pragma unroll
  for(int i=0;i<8;++i)s+=x[i]*x[i];
  s+=__shfl_xor(s,1);s+=__shfl_xor(s,2);s+=__shfl_xor(s,4);
  const float rs=__builtin_amdgcn_rsqf(s*(1.0f/64.0f)+1e-6f); u32x4 w;
  #pragma unroll
  for(int i=0;i<4;++i)w[i]=cvtpk_s(x[2*i]*rs,x[2*i+1]*rs);
  return w; }
#ifndef ATTN_STORE16
#define ATTN_STORE16(p,v) (*(u32x4*)(p)=(v))
#endif
template<int THRL> __device__ __forceinline__ void fox_unit(int b,int qb,float dthr,const bf16*Q,const bf16*__restrict__ K,const bf16*__restrict__ V,bf16*O,const float*__restrict__ csg,char*shm){
  int tid_=threadIdx.x; asm volatile("":"+v"(tid_)); const int tid=tid_,lane=tid&63,r32=lane&31,hi=lane>>5; const int wid=__builtin_amdgcn_readfirstlane(tid>>6);
  const long rowbase=(long)b*SEQ; const int q0=qb*QB;
  const bf16*Qw=Q+(rowbase+q0+wid*QBLK)*DM;
  const unsigned lds0=(unsigned)(uintptr_t)shm; const lds_cptr shm3=(lds_cptr)shm;
  float*wsf=(float*)(shm+LDS_WS)+wid*64;
  const unsigned kdst=lds0+LDS_K+wid*1024, vdst=lds0+LDS_V+wid*1024;
  #define DMA_K(t,slot) glds16(ksrc+(long)(t)*KVBLK*DM,(unsigned)__builtin_amdgcn_readfirstlane(kdst+(slot)))
  #define DMA_V(t,slot) glds16(vsrc+(long)(t)*KVBLK*DM,(unsigned)__builtin_amdgcn_readfirstlane(vdst+(slot)))
  const int vb0=(int)(lds0+LDS_V)+((lane>>4)&1)*32+(lane&3)*8+(4*hi+((lane&15)>>2))*64;
  const char*Kbase=shm+LDS_K; bf16x8 kf[8];
  const lds_cptr kp0=shm3+LDS_K+hi*1024+r32*16; const lds_cptr vp0=shm3+LDS_V+((lane>>4)&1)*32+(lane&3)*8+(4*hi+((lane&15)>>2))*64;
  typedef __attribute__((address_space(3))) float lds_f32; typedef __attribute__((address_space(3))) f32x4 lds_f32x4;
  { lds_f32*cl=(lds_f32*)(shm3+LDS_CS); const int n_=q0+QB; for(int i_=tid*4;i_<n_;i_+=2048){ const f32x4 v_=*(const f32x4*)(csg+i_); *(lds_f32x4*)(cl+i_)=v_; } }
  asm volatile("s_waitcnt vmcnt(0) lgkmcnt(0)\n\ts_barrier":::"memory");
  int j0;
  { const lds_f32*cl=(const lds_f32*)(shm3+LDS_CS); const float cq0=cl[q0]; int lo_=0,hi_=4*qb;
    while(lo_<hi_){ const int mid_=(lo_+hi_)>>1; if(cl[64*mid_+63]-cq0>=dthr)lo_=mid_+1; else hi_=mid_; }
    j0=__builtin_amdgcn_readfirstlane(lo_)&~1; }
  const bf16*Kh=K+(rowbase+(long)j0*KVBLK)*DM,*Vh=V+(rowbase+(long)j0*KVBLK)*DM;
  const bf16*ksrc=Kh+(long)lane*DM+wid*8;
  const bf16*vsrc=Vh+(long)(16*(wid&3)+(lane>>2))*DM+(wid>>2)*32+(lane&3)*8;
  const int NT=(q0+QB)/KVBLK-j0;
  const lds_f32*cl3=(const lds_f32*)(shm3+LDS_CS)+64*j0;
  DMA_K(0,0);DMA_V(0,0);DMA_K(1,SLOTB);
  bf16x8 qr[4];
  #pragma unroll
  for(int d0=0;d0<4;++d0)qr[d0]=*reinterpret_cast<const bf16x8*>(&Qw[(long)r32*DM+d0*16+hi*8]);
  float base=0.f,l_reg=0.f;f32x16 o[2];o[0]=f32x16{};o[1]=f32x16{};
  #define CINIT(C0,C1,t) do{ const lds_f32*cp_=cl3+64*(t)+4*hi; \
    _Pragma("unroll") for(int g_=0;g_<4;++g_){ const f32x4 a_=*(const lds_f32x4*)(cp_+8*g_), b_=*(const lds_f32x4*)(cp_+32+8*g_); \
      C0[4*g_]=base-a_[0];C0[4*g_+1]=base-a_[1];C0[4*g_+2]=base-a_[2];C0[4*g_+3]=base-a_[3]; \
      C1[4*g_]=base-b_[0];C1[4*g_+1]=base-b_[1];C1[4*g_+2]=base-b_[2];C1[4*g_+3]=base-b_[3]; } }while(0)
  const int qrel=wid*QBLK+r32;
  #define CMASK(P0,P1,t) do{int jb_=(t)-(NT-4); if(jb_>=0)cmask(P0,P1,jb_,qrel,hi);}while(0)
  bool resc=false;
  #define START(P0,P1) do{ const float rm=rowmax(P0,P1); resc=false; \
    { const float dl=rm; base=fsub_s(base,dl); \
      _Pragma("unroll") for(int r=0;r<16;++r){P0[r]=fsub_s(P0[r],dl);P1[r]=fsub_s(P1[r],dl);} } \
    _Pragma("unroll") for(int r=0;r<16;++r)P0[r]=__builtin_amdgcn_exp2f(P0[r]); }while(0)
  #define RESC() do{ if(resc){ asm volatile("s_waitcnt lgkmcnt(0)":::"memory"); \
      _Pragma("unroll") for(int d_=0;d_<2;++d_) _Pragma("unroll") for(int r=0;r<16;++r)o[d_][r]*=wsf[crow(r,hi)]; } }while(0)
  f32x16 pA0,pA1,pB0,pB1;
  int sl_prev=0,sl_cur=0,sl_next=SLOTB;
  #define ROT() do{sl_prev=sl_cur;sl_cur=sl_next;sl_next=(sl_next==(NSLOT-1)*SLOTB)?0:sl_next+SLOTB;}while(0)
  DMA_K(2,2*SLOTB);
  WAIT_BAR(3);
  base=cl3[q0-64*j0+wid*QBLK+r32];
  CINIT(pA0,pA1,0); qkt(pA0,pA1,Kbase,qr,r32,hi);asm volatile("s_nop 15\n\ts_nop 7":"+v"(pA0),"+v"(pA1));CMASK(pA0,pA1,0);
  START(pA0,pA1);
  _Pragma("unroll") for(int r=0;r<16;++r)pA1[r]=__builtin_amdgcn_exp2f(pA1[r]);
  WAIT_BAR(0);
  DMA_K(3,0);DMA_V(1,SLOTB);
  ROT();
  kload8(kf,kp0+sl_cur);
  WAIT_BAR(2);
  s16x4 vlo[8],vhi[8]; u32x4 pw0,pw1,pw2,pw3;
  #define PKW(P,B) cvtpk_s(P[B],P[B+1])
  #define PAF(k) __builtin_bit_cast(bf16x8,pw##k)
  #define VFR(i) (bf16x8){vlo[i][0],vlo[i][1],vlo[i][2],vlo[i][3],vhi[i][0],vhi[i][1],vhi[i][2],vhi[i][3]}
  #define PIN(x) asm volatile("":"+v"(x))
  #define MX3(a,b,c) __builtin_fmaxf(__builtin_fmaxf((a),(b)),(c))
  #define GAPA(MF,A0,A1,A2,A3,W0,W1,PW) do{ MF; sacc+=A0; sacc+=A1; sacc+=A2; sacc+=A3; PIN(sacc); W0; W1; PIN(PW); SBAR(); }while(0)
  #define EX(v) __builtin_amdgcn_exp2f(v)
  #define GAPB(MF,X,B) do{ MF; X[B]=EX(X[B]); X[B+1]=EX(X[B+1]); X[B+2]=EX(X[B+2]); X[B+3]=EX(X[B+3]); PIN(X); SBAR(); }while(0)
  #define VRD(i) do{ vlo[i]=vtr(vp_+(((i)>>2)*4096+((i)&3)*1024)); vhi[i]=vtr(vp_+(((i)>>2)*4096+((i)&3)*1024+512)); }while(0)
  #define KRD(G,j) do{ if(G){ kload2(kf,kp0+sl_next,j); SBAR(); } }while(0)
  #define STEP(C0,C1,P0,P1,t,GK,GV,GL) do{ SBAR(); CINIT(C0,C1,t); SBAR(); \
    const lds_cptr vp_=vp0+sl_prev; \
    VRD(0); SBAR(); float sacc=(P0[0]+P0[1]); \
    GAPA(C0=__builtin_amdgcn_mfma_f32_32x32x16_bf16(kf[0],qr[0],C0,0,0,0), P0[2],P0[3],P0[4],P0[5],     pw0[0]=PKW(P0,0), pw0[1]=PKW(P0,2), pw0); \
    VRD(4); SBAR(); GAPA(C1=__builtin_amdgcn_mfma_f32_32x32x16_bf16(kf[1],qr[0],C1,0,0,0), P0[6],P0[7],P0[8],P0[9],     pw0[2]=PKW(P0,4), pw0[3]=PKW(P0,6), pw0); \
    VRD(1); SBAR(); GAPA(C0=__builtin_amdgcn_mfma_f32_32x32x16_bf16(kf[2],qr[1],C0,0,0,0),   P0[10],P0[11],P0[12],P0[13], pw1[0]=PKW(P0,8), pw1[1]=PKW(P0,10), pw1); \
    VRD(5); SBAR(); GAPA(C1=__builtin_amdgcn_mfma_f32_32x32x16_bf16(kf[3],qr[1],C1,0,0,0),   P0[14],P0[15],P1[0],P1[1],   pw1[2]=PKW(P0,12),pw1[3]=PKW(P0,14), pw1); \
    VRD(2); SBAR(); GAPA(C0=__builtin_amdgcn_mfma_f32_32x32x16_bf16(kf[4],qr[2],C0,0,0,0),   P1[2],P1[3],P1[4],P1[5],     pw2[0]=PKW(P1,0), pw2[1]=PKW(P1,2), pw2); \
    VRD(6); SBAR(); GAPA(C1=__builtin_amdgcn_mfma_f32_32x32x16_bf16(kf[5],qr[2],C1,0,0,0),   P1[6],P1[7],P1[8],P1[9],     pw2[2]=PKW(P1,4), pw2[3]=PKW(P1,6), pw2); \
    VRD(3); SBAR(); GAPA(C0=__builtin_amdgcn_mfma_f32_32x32x16_bf16(kf[6],qr[3],C0,0,0,0),   P1[10],P1[11],P1[12],P1[13], pw3[0]=PKW(P1,8), pw3[1]=PKW(P1,10), pw3); \
    VRD(7); SBAR(); GAPA(C1=__builtin_amdgcn_mfma_f32_32x32x16_bf16(kf[7],qr[3],C1,0,0,0),   P1[14],P1[15],0.f,0.f,       pw3[2]=PKW(P1,12),pw3[3]=PKW(P1,14), pw3); \
    l_reg+=sacc; \
    if(GK){DMA_K((t)+3,sl_cur);} if(GV){DMA_V((t)+1,sl_next);} \
    CMASK(C0,C1,t); \
    { float a=MX3(C0[0],C0[1],C1[0]),b=MX3(C0[2],C0[3],C1[1]); a=MX3(a,C1[2],C1[3]); \
      _Pragma("unroll") for(int r=4;r<16;r+=4){a=MX3(a,C0[r],C0[r+1]);b=MX3(b,C0[r+2],C0[r+3]);a=MX3(a,C1[r],C1[r+1]);b=MX3(b,C1[r+2],C1[r+3]);} \
      float rm=__builtin_fmaxf(a,b); { auto rr=__builtin_amdgcn_permlane32_swap(__float_as_uint(rm),__float_as_uint(rm),false,false); rm=__builtin_fmaxf(__uint_as_float(rr[0]),__uint_as_float(rr[1])); } \
      resc=false; \
      if(__builtin_expect(__any(rm>(float)THRL),0)){ const float dl=__builtin_fmaxf(rm,0.f); base-=dl; \
        _Pragma("unroll") for(int r=0;r<16;++r){C0[r]-=dl;C1[r]-=dl;} \
        const float f=__builtin_amdgcn_exp2f(-dl); l_reg*=f; if(hi==0)wsf[r32]=f; resc=true; } } \
    SBAR(); \
    GAPB(o[0]=__builtin_amdgcn_mfma_f32_32x32x16_bf16(PAF(0),VFR(0),o[0],0,0,0), C0,0); \
    GAPB(o[1]=__builtin_amdgcn_mfma_f32_32x32x16_bf16(PAF(0),VFR(4),o[1],0,0,0), C0,4); \
    KRD(GL,0); GAPB(o[0]=__builtin_amdgcn_mfma_f32_32x32x16_bf16(PAF(1),VFR(1),o[0],0,0,0), C0,8); \
    KRD(GL,1); GAPB(o[1]=__builtin_amdgcn_mfma_f32_32x32x16_bf16(PAF(1),VFR(5),o[1],0,0,0), C0,12); \
    KRD(GL,2); GAPB(o[0]=__builtin_amdgcn_mfma_f32_32x32x16_bf16(PAF(2),VFR(2),o[0],0,0,0), C1,0); \
    KRD(GL,3); GAPB(o[1]=__builtin_amdgcn_mfma_f32_32x32x16_bf16(PAF(2),VFR(6),o[1],0,0,0), C1,4); \
    GAPB(o[0]=__builtin_amdgcn_mfma_f32_32x32x16_bf16(PAF(3),VFR(3),o[0],0,0,0), C1,8); \
    GAPB(o[1]=__builtin_amdgcn_mfma_f32_32x32x16_bf16(PAF(3),VFR(7),o[1],0,0,0), C1,12); \
    }while(0)
  int t=1;
  #undef CMASK
  #define CMASK(P0,P1,t) do{}while(0)
  for(;t+5<NT;t+=2){
    STEP(pB0,pB1,pA0,pA1,t,true,true,true);     WAIT_BAR(2); RESC(); ROT();
    STEP(pA0,pA1,pB0,pB1,t+1,true,true,true);   WAIT_BAR(2); RESC(); ROT();
  }
  #undef CMASK
  #define CMASK(P0,P1,t) do{int jb_=(t)-(NT-4); if(jb_>=0)cmask(P0,P1,jb_,qrel,hi);}while(0)
  #define ENDW(tt) do{ if((tt)+3<NT){WAIT_BAR(2);} else if((tt)+2<NT){WAIT_BAR(1);} else {WAIT_BAR(0);} }while(0)
  for(;t+1<NT;t+=2){
    STEP(pB0,pB1,pA0,pA1,t,(t+3<NT),(t+1<NT),(t+1<NT));       ENDW(t);   RESC(); ROT();
    STEP(pA0,pA1,pB0,pB1,t+1,(t+4<NT),(t+2<NT),(t+2<NT));     ENDW(t+1); RESC(); ROT();
  }
  STEP(pB0,pB1,pA0,pA1,NT-1,false,false,false); RESC();
  { float sacc=pB0[0]+pB0[1]; _Pragma("unroll") for(int r=2;r<16;++r)sacc+=pB0[r]; _Pragma("unroll") for(int r=0;r<16;++r)sacc+=pB1[r]; l_reg+=sacc;
    pw0=(u32x4){PKW(pB0,0),PKW(pB0,2),PKW(pB0,4),PKW(pB0,6)};pw1=(u32x4){PKW(pB0,8),PKW(pB0,10),PKW(pB0,12),PKW(pB0,14)};pw2=(u32x4){PKW(pB1,0),PKW(pB1,2),PKW(pB1,4),PKW(pB1,6)};pw3=(u32x4){PKW(pB1,8),PKW(pB1,10),PKW(pB1,12),PKW(pB1,14)};
    SBAR(); pv(o,vb0+sl_cur,PAF(0),PAF(1),PAF(2),PAF(3)); }
  #undef PKW
  #undef PAF
  #undef VFR
  #undef PIN
  #undef MX3
  #undef GAPA
  #undef GAPB
  #undef EX
  #undef VRD
  #undef KRD
  #undef STEP
  #undef ENDW
  {auto rr=__builtin_amdgcn_permlane32_swap(__float_as_uint(l_reg),__float_as_uint(l_reg),false,false);l_reg=__uint_as_float(rr[0])+__uint_as_float(rr[1]);}
  if(hi==0)wsf[32+r32]=l_reg;asm volatile("s_waitcnt lgkmcnt(0)":::"memory");
  float rli[16];
  #pragma unroll
  for(int r=0;r<16;++r)rli[r]=__builtin_amdgcn_rcpf(wsf[32+crow(r,hi)]);
  bf16*Ow=O+(rowbase+q0+wid*QBLK)*DMO;
  { bf16*stg=(bf16*)(shm+LDS_OST)+wid*2048;
    #pragma unroll
    for(int r=0;r<16;++r){const int orow=crow(r,hi);
      #pragma unroll
      for(int d0=0;d0<2;++d0)stg[orow*64+d0*32+r32]=__float2bfloat16(o[d0][r]*rli[r]);}
    asm volatile("s_waitcnt lgkmcnt(0)":::"memory");
    #pragma unroll
    for(int i=0;i<4;++i){const int row=i*8+(lane>>3),ch=lane&7; const u32x4 v=*(const u32x4*)(stg+row*64+ch*8); ATTN_STORE16(Ow+(long)row*DMO+ch*8,head_rms(v));} }
  asm volatile("s_waitcnt lgkmcnt(0)\n\ts_barrier":::"memory");
  #undef DMA_K
  #undef DMA_V
  #undef CMASK
  #undef CINIT
  #undef START
  #undef RESC
  #undef ROT
}
__device__ __forceinline__ float sp2f(float z){ const float e=__builtin_amdgcn_exp2f(-__builtin_fabsf(z)); return __builtin_fmaxf(z,0.f)+__builtin_amdgcn_logf(1.f+e); }
__device__ __forceinline__ void sb_unit(int b,int qb,const bf16*Q,const bf16*__restrict__ K,const bf16*__restrict__ V,bf16*O,char*shm){
  int tid_=threadIdx.x; asm volatile("":"+v"(tid_)); const int tid=tid_,lane=tid&63,r32=lane&31,hi=lane>>5; const int wid=__builtin_amdgcn_readfirstlane(tid>>6);
  const long rowbase=(long)b*SEQ; const int q0=qb*QB;
  const bf16*Qw=Q+(rowbase+q0+wid*QBLK)*DM;
  const bf16*Kh=K+rowbase*DM,*Vh=V+rowbase*DM;
  const unsigned lds0=(unsigned)(uintptr_t)shm; const lds_cptr shm3=(lds_cptr)shm;
  const bf16*ksrc=Kh+(long)lane*DM+wid*8;
  const bf16*vsrc=Vh+(long)(16*(wid&3)+(lane>>2))*DM+(wid>>2)*32+(lane&3)*8;
  const unsigned kdst=lds0+LDS_K+wid*1024, vdst=lds0+LDS_V+wid*1024;
  #define DMA_K(t,slot) glds16(ksrc+(long)(t)*KVBLK*DM,(unsigned)__builtin_amdgcn_readfirstlane(kdst+(slot)))
  #define DMA_V(t,slot) glds16(vsrc+(long)(t)*KVBLK*DM,(unsigned)__builtin_amdgcn_readfirstlane(vdst+(slot)))
  const int vb0=(int)(lds0+LDS_V)+((lane>>4)&1)*32+(lane&3)*8+(4*hi+((lane&15)>>2))*64;
  typedef __attribute__((address_space(3))) unsigned lds_u32;
  volatile lds_u32*flags=(volatile lds_u32*)(shm3+LDS_FLAGS);
  bf16x8 qr[4];
  #pragma unroll
  for(int d0=0;d0<4;++d0)qr[d0]=*reinterpret_cast<const bf16x8*>(&Qw[(long)r32*DM+d0*16+hi*8]);
  asm volatile("":::"memory");
  f32x16 o[2];o[0]=f32x16{};o[1]=f32x16{};
  float R=1.f; const int qabs=q0+wid*QBLK+r32; bool done=false;
  const int jtop=4*qb+3;
  DMA_K(jtop,0);DMA_V(jtop,0); DMA_K(jtop-1,SLOTB);DMA_V(jtop-1,SLOTB);
  int slot=0,slot2=2*SLOTB,bank=0;
  for(int j=jtop;j>=0;--j){
    if(j>0){ WAIT_BAR(2); } else { WAIT_BAR(0); }
    if(j<jtop){ unsigned alld=1u;
      #pragma unroll
      for(int w=0;w<NW;++w)alld&=flags[(bank^8)+w];
      if(alld)break; }
    if(j>=2){ DMA_K(j-2,slot2);DMA_V(j-2,slot2); }
    const bool active=(!done)&&(64*j<q0+wid*QBLK+31);
    if(active){
      f32x16 p0=f32x16{},p1=f32x16{};
      qkt(p0,p1,shm+LDS_K+slot,qr,r32,hi);
      const int kvb=64*j+4*hi; f32x16 s0,s1;
      if(64*j+63<q0+wid*QBLK){
        #pragma unroll
        for(int r=0;r<16;++r){
          const float e0=__builtin_amdgcn_exp2f(__builtin_fminf(p0[r],80.f)), e1=__builtin_amdgcn_exp2f(__builtin_fminf(p1[r],80.f));
          const float r0=__builtin_amdgcn_rcpf(1.f+e0), r1=__builtin_amdgcn_rcpf(1.f+e1);
          p0[r]=e0*r0; p1[r]=e1*r1; s0[r]=r0; s1[r]=r1; }
      } else {
        #pragma unroll
        for(int r=0;r<16;++r){ const int kv=kvb+(r&3)+8*(r>>2);
          const float e0=__builtin_amdgcn_exp2f(__builtin_fminf(p0[r],80.f)), e1=__builtin_amdgcn_exp2f(__builtin_fminf(p1[r],80.f));
          const float r0=__builtin_amdgcn_rcpf(1.f+e0), r1=__builtin_amdgcn_rcpf(1.f+e1);
          const bool v0=kv<qabs, v1=kv+32<qabs;
          p0[r]=v0?e0*r0:0.f; p1[r]=v1?e1*r1:0.f; s0[r]=v0?r0:1.f; s1[r]=v1?r1:1.f; }
      }
      float g0[4],g1[4],og0[4],og1[4],T0[4],T1[4];
      #pragma unroll
      for(int g=0;g<4;++g){ g0[g]=(s0[4*g]*s0[4*g+1])*(s0[4*g+2]*s0[4*g+3]); g1[g]=(s1[4*g]*s1[4*g+1])*(s1[4*g+2]*s1[4*g+3]); }
      #pragma unroll
      for(int g=0;g<4;++g){ og0[g]=__shfl_xor(g0[g],32); og1[g]=__shfl_xor(g1[g],32); }
      float run=R;
      #pragma unroll
      for(int g=3;g>=0;--g){ const float ah1=hi?g1[g]:og1[g], ah0=hi?og1[g]:g1[g]; const float t1=run; run*=ah1; const float t0=run; run*=ah0; T1[g]=hi?t1:t0; }
      #pragma unroll
      for(int g=3;g>=0;--g){ const float ah1=hi?g0[g]:og0[g], ah0=hi?og0[g]:g0[g]; const float t1=run; run*=ah1; const float t0=run; run*=ah0; T0[g]=hi?t1:t0; }
      R=run;
      #pragma unroll
      for(int g=0;g<4;++g){ float a0=T0[g],a1=T1[g];
        #pragma unroll
        for(int i=3;i>=0;--i){ const int r=4*g+i; p0[r]*=a0; p1[r]*=a1; a0*=s0[r]; a1*=s1[r]; } }
      u32x4 pw0,pw1,pw2,pw3;
      pw0=(u32x4){cvtpk_s(p0[0],p0[1]),cvtpk_s(p0[2],p0[3]),cvtpk_s(p0[4],p0[5]),cvtpk_s(p0[6],p0[7])};
      pw1=(u32x4){cvtpk_s(p0[8],p0[9]),cvtpk_s(p0[10],p0[11]),cvtpk_s(p0[12],p0[13]),cvtpk_s(p0[14],p0[15])};
      pw2=(u32x4){cvtpk_s(p1[0],p1[1]),cvtpk_s(p1[2],p1[3]),cvtpk_s(p1[4],p1[5]),cvtpk_s(p1[6],p1[7])};
      pw3=(u32x4){cvtpk_s(p1[8],p1[9]),cvtpk_s(p1[10],p1[11]),cvtpk_s(p1[12],p1[13]),cvtpk_s(p1[14],p1[15])};
      pv(o,vb0+slot,__builtin_bit_cast(bf16x8,pw0),__builtin_bit_cast(bf16x8,pw1),__builtin_bit_cast(bf16x8,pw2),__builtin_bit_cast(bf16x8,pw3));
      done=__all(R<1.0e-37f)!=0;
    }
    if(lane==0)flags[bank+wid]=done?1u:0u;
    bank^=8; slot=(slot==2*SLOTB)?0:slot+SLOTB; slot2=(slot2==2*SLOTB)?0:slot2+SLOTB;
  }
  asm volatile("s_waitcnt vmcnt(0)":::"memory");
  bf16*Ow=O+(rowbase+q0+wid*QBLK)*DMO;
  { bf16*stg=(bf16*)(shm+LDS_OST)+wid*2048;
    #pragma unroll
    for(int r=0;r<16;++r){const int orow=crow(r,hi);
      #pragma unroll
      for(int d0=0;d0<2;++d0)stg[orow*64+d0*32+r32]=__float2bfloat16(o[d0][r]);}
    asm volatile("s_waitcnt lgkmcnt(0)":::"memory");
    #pragma unroll
    for(int i=0;i<4;++i){const int row=i*8+(lane>>3),ch=lane&7; const u32x4 v=*(const u32x4*)(stg+row*64+ch*8); ATTN_STORE16(Ow+(long)row*DMO+ch*8,head_rms(v));} }
  asm volatile("s_waitcnt vmcnt(0) lgkmcnt(0)\n\ts_barrier":::"memory");
  #undef DMA_K
  #undef DMA_V
}
#undef SBAR
#undef WAIT_BAR
}
namespace cg = cooperative_groups;
constexpr int NWAVES = 8;
constexpr int DMODEL = 1024, NBATCH = 4, SEQ_IN = 8192, NMETA = 16, LREAL = NMETA + SEQ_IN, LP = 8448  ;
constexpr int MROWS = NBATCH * LP;
constexpr int MREAL = NBATCH * SEQ_IN;
constexpr int INW = 2566, NINP = 2560, NIN = 2816, DFF = 2816, NGU = 2 * DFF, DEPTH = 2, NFH = 6;
constexpr float C2F = 0.125f * 1.4426950408889634f;
constexpr int PC_U = 0, PC_FQ = 256, PC_FK = 640, PC_FV = 1024, PC_SQ = 1408, PC_SK = 1792, PC_SV = 2176;
constexpr size_t MiB = 1u << 20;
constexpr size_t WS_CTL = 0, CTL_ZERO_BYTES = 1 * MiB;
constexpr size_t WS_SS = 64 * 1024;
constexpr size_t WS_W = 1 * MiB, W_LAYER = 24 * MiB, W_IN = 0, W_OUT = (size_t)NIN * 1024 * 2, W_GU = W_OUT + 2 * MiB, W_D = W_GU + (size_t)NGU * 1024 * 2;
constexpr size_t WS_LF = 49 * MiB, WS_CS = 51 * MiB, WS_H = 52 * MiB, WS_HB = 184 * MiB, WS_Y = 250 * MiB, WS_P = 316 * MiB, WS_END = WS_P + (size_t)MROWS * DFF * 2;
static_assert(W_D + (size_t)1024 * DFF * 2 <= W_LAYER && WS_W + 2 * W_LAYER <= WS_LF && WS_SS + 5 * (size_t)MROWS * 4 <= CTL_ZERO_BYTES, "ws map");
static_assert(WS_H + (size_t)MROWS * 1024 * 4 <= WS_HB && WS_HB + (size_t)MROWS * 1024 * 2 <= WS_Y && WS_Y + (size_t)MROWS * 1024 * 2 <= WS_P && WS_END <= 512 * MiB, "ws map");
constexpr int LDS_BYTES = 147456;
constexpr int LDS_MISC = 131072;

#define LAS __attribute__((address_space(3)))
typedef unsigned short bf16u;
typedef unsigned v4u __attribute__((ext_vector_type(4)));
typedef float f32x4 __attribute__((ext_vector_type(4)));
#define LDS_WAIT() asm volatile("s_waitcnt lgkmcnt(0)" ::: "memory")
__device__ __forceinline__ unsigned f2bf(float f) { unsigned u = __builtin_bit_cast(unsigned, f); return (u + 0x7fffu + ((u >> 16) & 1u)) >> 16; }
__device__ __forceinline__ unsigned pk2(float lo, float hi) { return f2bf(lo) | (f2bf(hi) << 16); }
__device__ __forceinline__ float wave_sum(float v) {
#pragma unroll
    for (int o = 1; o < 64; o <<= 1) v += __shfl_xor(v, o);
    return v;
}

struct Args { const float* in[15]; float* out; unsigned char* ws; };

struct WinSrc { const float* w; const float* g;
    __device__ __forceinline__ float operator()(int k, int n) const { if (n >= INW) return 0.f; const int col = n < 1408 ? n : (n < 2560 ? n + 6 : n - 2560 + 1408);
        const float sc = ((n >= PC_FQ && n < PC_FK) || (n >= PC_SQ && n < PC_SK)) ? C2F : 1.0f; return w[(size_t)k * INW + col] * g[k] * sc; } };
struct WoutSrc { const float* w; const float* fg; const float* sg;
    __device__ __forceinline__ float operator()(int k, int n) const { const float gn = k < 640 ? fg[k - 256] : sg[k - 640]; return w[(size_t)k * 1024 + n] * gn; } };
struct WguSrc { const float* wg; const float* wu; const float* g;
    __device__ __forceinline__ float operator()(int k, int c) const { const int pn = c >> 8, w = c & 255, j = pn * 128 + (w & 127); const long dlt = (w >> 7) ? (long)(wu - wg) : 0L; return wg[(long)k * DFF + j + dlt] * g[k]; } };
struct WdSrc { const float* w;
    __device__ __forceinline__ float operator()(int k, int n) const { return w[(size_t)k * 1024 + n]; } };
template <class F> __device__ __forceinline__ void conv_item(const F src, bf16u* WT, int K, int k0, int n0, LAS float* scr, int lane) {
    float tv[32];
#pragma unroll
    for (int i = 0; i < 32; ++i) tv[i] = src(k0 + 2 * i + (lane >> 5), n0 + (lane & 31));
#pragma unroll
    for (int i = 0; i < 32; ++i) scr[(2 * i + (lane >> 5)) * 33 + (lane & 31)] = tv[i];
    LDS_WAIT(); asm volatile("" ::: "memory");
    const int c = lane & 7;
#pragma unroll
    for (int j = 0; j < 4; ++j) { const int n = (lane >> 3) + 8 * j; const LAS float* s = scr + (8 * c) * 33 + n;
        v4u o; o.x = pk2(s[0 * 33], s[1 * 33]); o.y = pk2(s[2 * 33], s[3 * 33]); o.z = pk2(s[4 * 33], s[5 * 33]); o.w = pk2(s[6 * 33], s[7 * 33]);
        *(v4u*)(WT + (size_t)(n0 + n) * K + k0 + 8 * c) = o; }
    LDS_WAIT(); asm volatile("" ::: "memory");
}
__device__ __forceinline__ void fold_item(const float* wout, const float* pw, const float* ps, bf16u* WT, int item, int lane) {
    const int g = item >> 4, n = (item & 15) * 64 + lane;
    float acc[64];
#pragma unroll
    for (int c = 0; c < 64; ++c) acc[c] = 0.f;
    for (int d = 0; d < 64; ++d) { const float wv = wout[(size_t)(g * 64 + d) * 1024 + n] * ps[g * 64 + d];
#pragma unroll
        for (int c = 0; c < 64; ++c) acc[c] += pw[(g * 64 + c) * 64 + d] * wv; }
    bf16u* o = WT + (size_t)n * 1024 + g * 64;
#pragma unroll
    for (int c = 0; c < 64; c += 8) { v4u w; w.x = pk2(acc[c], acc[c + 1]); w.y = pk2(acc[c + 2], acc[c + 3]); w.z = pk2(acc[c + 4], acc[c + 5]); w.w = pk2(acc[c + 6], acc[c + 7]); *(v4u*)(o + c) = w; }
}
__device__ __forceinline__ void p0_prologue(const Args& A, unsigned char* ws, LAS unsigned char* lds, int wave, int lane) {
    LAS float* scr = (LAS float*)(lds + wave * 16384);
    const int gw = blockIdx.x * NWAVES + wave, NGW = gridDim.x * NWAVES;
    constexpr int I_IN = 16 * (NIN / 32), I_OUT = 12 * 32, I_GU = 16 * (NGU / 32), I_D = (DFF / 64) * 32, I_F = 64, I_L = I_IN + I_OUT + I_GU + I_D + I_F;
    for (int it = gw; it < DEPTH * I_L; it += NGW) {
        const int L = it / I_L; int r = it % I_L;
        bf16u* wb = (bf16u*)(ws + WS_W + (size_t)L * W_LAYER);
        if (r < I_IN) { WinSrc s{A.in[3] + (size_t)L * 1024 * INW, A.in[2] + L * 1024}; conv_item(s, (bf16u*)((unsigned char*)wb + W_IN), 1024, (r / (NIN / 32)) * 64, (r % (NIN / 32)) * 32, scr, lane); continue; } r -= I_IN;
        if (r < I_OUT) { WoutSrc s{A.in[9] + (size_t)L * 1024 * 1024, A.in[7] + L * 384, A.in[8] + L * 384}; conv_item(s, (bf16u*)((unsigned char*)wb + W_OUT), 1024, 256 + (r / 32) * 64, (r % 32) * 32, scr, lane); continue; } r -= I_OUT;
        if (r < I_GU) { WguSrc s{A.in[11] + (size_t)L * 1024 * DFF, A.in[12] + (size_t)L * 1024 * DFF, A.in[10] + L * 1024}; conv_item(s, (bf16u*)((unsigned char*)wb + W_GU), 1024, (r / (NGU / 32)) * 64, (r % (NGU / 32)) * 32, scr, lane); continue; } r -= I_GU;
        if (r < I_D) { WdSrc s{A.in[13] + (size_t)L * DFF * 1024}; conv_item(s, (bf16u*)((unsigned char*)wb + W_D), DFF, (r / 32) * 64, (r % 32) * 32, scr, lane); continue; } r -= I_D;
        fold_item(A.in[9] + (size_t)L * 1024 * 1024, A.in[5] + (size_t)L * 4 * 64 * 64, A.in[6] + L * 256, (bf16u*)((unsigned char*)wb + W_OUT), r, lane);
    }
    bf16u* hb = (bf16u*)(ws + WS_HB); float* ss0 = (float*)(ws + WS_SS);
    for (int m = gw; m < MROWS; m += NGW) {
        const int b = m / LP, t = m % LP;
        f32x4 v[4]; float s = 0.f;
        if (t < LREAL) { const f32x4* src = (const f32x4*)(t < NMETA ? A.in[1] + (size_t)t * 1024 : A.in[0] + ((size_t)b * SEQ_IN + (t - NMETA)) * 1024) + lane;
#pragma unroll
            for (int j = 0; j < 4; ++j) { v[j] = src[64 * j]; s += (v[j].x * v[j].x + v[j].y * v[j].y) + (v[j].z * v[j].z + v[j].w * v[j].w); } }
        else {
#pragma unroll
            for (int j = 0; j < 4; ++j) v[j] = (f32x4){0.f, 0.f, 0.f, 0.f}; }
        s = wave_sum(s);
        unsigned long long* bo = (unsigned long long*)(hb + (size_t)m * 1024) + lane;
#pragma unroll
        for (int j = 0; j < 4; ++j) { bo[64 * j] = (unsigned long long)pk2(v[j].x, v[j].y) | ((unsigned long long)pk2(v[j].z, v[j].w) << 32); }
        if (lane == 0) ss0[m] = s;
    }
}
typedef short bf16x8m __attribute__((ext_vector_type(8)));
template <int NBK> __device__ __forceinline__ void mini_item(f32x4 (&acc)[NBK], const bf16u* A16, const bf16u* Bt0, const bf16u* Bt1, int K, LAS unsigned char* lds, int wave, int lane) {
    const int fr = lane & 15, fq = lane >> 4, kw = K >> 3; const size_t o = (size_t)fr * K + wave * kw + 8 * fq;
#pragma unroll
    for (int nb = 0; nb < NBK; ++nb) acc[nb] = (f32x4){0.f, 0.f, 0.f, 0.f};
    for (int k = 0; k < kw; k += 32) { const bf16x8m a = *(const bf16x8m*)(A16 + o + k); const bf16x8m b0 = *(const bf16x8m*)(Bt0 + o + k);
        acc[0] = __builtin_amdgcn_mfma_f32_16x16x32_bf16(b0, a, acc[0], 0, 0, 0);
        if (NBK == 2) { const bf16x8m b1 = *(const bf16x8m*)(Bt1 + o + k); acc[NBK - 1] = __builtin_amdgcn_mfma_f32_16x16x32_bf16(b1, a, acc[NBK - 1], 0, 0, 0); } }
    LAS f32x4* red = (LAS f32x4*)lds;
#pragma unroll
    for (int nb = 0; nb < NBK; ++nb) red[(nb * 8 + wave) * 64 + lane] = acc[nb];
    __syncthreads();
    if (wave == 0) {
#pragma unroll
        for (int nb = 0; nb < NBK; ++nb) { f32x4 s = red[(nb * 8) * 64 + lane];
#pragma unroll
            for (int w = 1; w < 8; ++w) s += red[(nb * 8 + w) * 64 + lane];
            acc[nb] = s; } }
    __syncthreads();
}
__device__ __forceinline__ void mini_in(unsigned char* ws, const bf16u* wt, const float* ss, const float* fb, LAS unsigned char* lds, int wave, int lane) {
    const bf16u* A16 = (const bf16u*)(ws + WS_HB); bf16u* P = (bf16u*)(ws + WS_P); float* LF = (float*)(ws + WS_LF);
    for (int it = blockIdx.x; it < 161; it += gridDim.x) { const int n0 = it * 16; f32x4 acc[1];
        mini_item<1>(acc, A16, wt + (size_t)n0 * 1024, nullptr, 1024, lds, wave, lane);
        if (wave == 0) { const int fr = lane & 15, fq = lane >> 4; const float rs = __builtin_amdgcn_rsqf(ss[fr] * (1.0f / 1024.0f) + 1e-6f); const f32x4 v = acc[0] * rs;
            if (n0 < NINP) { const unsigned long long w = (unsigned long long)pk2(v[0], v[1]) | ((unsigned long long)pk2(v[2], v[3]) << 32);
#pragma unroll
                for (int b = 0; b < NBATCH; ++b) *(unsigned long long*)(P + ((size_t)b * LP + fr) * NINP + n0 + 4 * fq) = w; }
            else if (fq < 2) { f32x4 l;
#pragma unroll
                for (int i = 0; i < 4; ++i) { const int c = 4 * fq + i; const float x = v[i] + fb[c < NFH ? c : 0]; l[i] = c < NFH ? -(fmaxf(-x, 0.f) + log1pf(expf(-fabsf(x)))) * 1.4426950408889634f : 0.f; }
#pragma unroll
                for (int b = 0; b < NBATCH; ++b) *(f32x4*)(LF + ((size_t)b * LP + fr) * 8 + 4 * fq) = l; } }
    }
}
__device__ __forceinline__ void mini_res(unsigned char* ws, const bf16u* A16, const bf16u* wt, int K, float* ssn, LAS unsigned char* lds, int wave, int lane) {
    bf16u* hb = (bf16u*)(ws + WS_HB);
    for (int it = blockIdx.x; it < 64; it += gridDim.x) { const int n0 = it * 16; f32x4 acc[1];
        mini_item<1>(acc, A16, wt + (size_t)n0 * K, nullptr, K, lds, wave, lane);
        if (wave == 0) { const int fr = lane & 15, fq = lane >> 4; unsigned long long* bp = (unsigned long long*)(hb + (size_t)fr * 1024 + n0 + 4 * fq); const unsigned long long r = *bp; const unsigned rl = (unsigned)r, rh = (unsigned)(r >> 32);
            const f32x4 a = (f32x4){__uint_as_float(rl << 16), __uint_as_float(rl & 0xffff0000u), __uint_as_float(rh << 16), __uint_as_float(rh & 0xffff0000u)} + acc[0];
            *bp = (unsigned long long)pk2(a[0], a[1]) | ((unsigned long long)pk2(a[2], a[3]) << 32);
            float s = (a[0] * a[0] + a[1] * a[1]) + (a[2] * a[2] + a[3] * a[3]); s += __shfl_xor(s, 16); s += __shfl_xor(s, 32);
            if (fq == 0) atomicAdd(ssn + fr, s); }
    }
}
__device__ __forceinline__ void mini_gu(unsigned char* ws, const bf16u* wt, const float* ss, LAS unsigned char* lds, int wave, int lane) {
    const bf16u* A16 = (const bf16u*)(ws + WS_HB); bf16u* H = (bf16u*)(ws + WS_P);
    for (int it = blockIdx.x; it < DFF / 16; it += gridDim.x) { const int j0 = it * 16, cg = (j0 >> 7) * 256 + (j0 & 127); f32x4 acc[2];
        mini_item<2>(acc, A16, wt + (size_t)cg * 1024, wt + (size_t)(cg + 128) * 1024, 1024, lds, wave, lane);
        if (wave == 0) { const int fr = lane & 15, fq = lane >> 4; const float rs = __builtin_amdgcn_rsqf(ss[fr] * (1.0f / 1024.0f) + 1e-6f); float o[4];
#pragma unroll
            for (int i = 0; i < 4; ++i) { const float g = acc[0][i] * rs, up = acc[1][i] * rs; o[i] = g * __builtin_amdgcn_rcpf(1.0f + __builtin_amdgcn_exp2f(-1.4426950408889634f * g)) * up; }
            *(unsigned long long*)(H + (size_t)fr * DFF + j0 + 4 * fq) = (unsigned long long)pk2(o[0], o[1]) | ((unsigned long long)pk2(o[2], o[3]) << 32); }
    }
}
__device__ __forceinline__ void fl_phase(unsigned char* ws, const bf16u* wt  , const float* ss, const float* fb, int wave, int lane) {
    const bf16u* HBp = (const bf16u*)(ws + WS_HB); float* LF = (float*)(ws + WS_LF);
    const int fr = lane & 15, fq = lane >> 4;
    for (int it = blockIdx.x * NWAVES + wave; it < MREAL / 16; it += gridDim.x * NWAVES) {
        const int m0 = it * 16, row0 = (m0 / SEQ_IN) * LP + NMETA + (m0 % SEQ_IN);
        const bf16u* ap = HBp + (size_t)(row0 + fr) * 1024 + 8 * fq; const bf16u* bp = wt + (size_t)fr * 1024 + 8 * fq;
        f32x4 acc = (f32x4){0.f, 0.f, 0.f, 0.f};
#pragma unroll 8
        for (int k = 0; k < 1024; k += 32) { const bf16x8m a = *(const bf16x8m*)(ap + k); const bf16x8m b = *(const bf16x8m*)(bp + k); acc = __builtin_amdgcn_mfma_f32_16x16x32_bf16(b, a, acc, 0, 0, 0); }
        if (fq < 2) { const int row = row0 + fr; const float rs = __builtin_amdgcn_rsqf(ss[row] * (1.0f / 1024.0f) + 1e-6f); f32x4 l;
#pragma unroll
            for (int i = 0; i < 4; ++i) { const int c = 4 * fq + i; const float x = acc[i] * rs + fb[c < NFH ? c : 0]; l[i] = c < NFH ? -(fmaxf(-x, 0.f) + log1pf(expf(-fabsf(x)))) * 1.4426950408889634f : 0.f; }
            *(f32x4*)(LF + (size_t)row * 8 + 4 * fq) = l; }
    }
}
__device__ __forceinline__ void pool_scan_phase(unsigned char* ws, LAS unsigned char* lds, unsigned* nrm, int tid, int wave, int lane) {
    const float* LF = (const float*)(ws + WS_LF); float* CS = (float*)(ws + WS_CS);
    if (blockIdx.x < NBATCH * NFH) {
        const int b = blockIdx.x / NFH, hf = blockIdx.x % NFH; constexpr int PER = 17;
        const float* lf = LF + (size_t)b * LP * 8 + hf; float* cs = CS + (size_t)(b * NFH + hf) * LP;
        float v[PER]; float s = 0.f; const int t0 = tid * PER;
#pragma unroll
        for (int i = 0; i < PER; ++i) { const int t = t0 + i; const float x = t < LREAL ? lf[(size_t)t * 8] : 0.f; s += x; v[i] = s; }
        float incl = s;
#pragma unroll
        for (int o = 1; o < 64; o <<= 1) { const float n = __shfl_up(incl, o); if (lane >= o) incl += n; }
        LAS float* wsum = (LAS float*)(lds + LDS_MISC + 256);
        if (lane == 63) wsum[wave] = incl;
        __syncthreads();
        float off = 0.f;
        for (int w = 0; w < wave; ++w) off += wsum[w];
        const float excl = off + incl - s;
#pragma unroll
        for (int i = 0; i < PER; ++i) { const int t = t0 + i; if (t < LREAL) cs[t] = excl + v[i]; }
        __syncthreads();
    }
    const bf16u* P = (const bf16u*)(ws + WS_P); bf16u* Y = (bf16u*)(ws + WS_Y);
    for (int sl = blockIdx.x; sl < 256; sl += gridDim.x) {
        if (tid < 480) { const int sub = tid / 96, task = tid % 96, which = task / 48, head = (task % 48) >> 3, chunk = task & 7; const int r0 = sl * (MROWS / 256), b = r0 / LP;
            const bf16u* src = P + (which ? PC_FK : PC_FQ) + head * 64 + chunk * 8; float mx = 0.f;
#pragma unroll 9
            for (int r = sub; r < MROWS / 256; r += 5) { const v4u w = ((r0 + r) % LP < LREAL) ? *(const v4u*)(src + (size_t)(r0 + r) * NINP) : (v4u){0u, 0u, 0u, 0u}; float s = 0.f;
#pragma unroll
                for (int e = 0; e < 4; ++e) { const float lo = __uint_as_float(w[e] << 16), hi = __uint_as_float(w[e] & 0xffff0000u); s += lo * lo + hi * hi; }
                s += __shfl_xor(s, 1); s += __shfl_xor(s, 2); s += __shfl_xor(s, 4); mx = fmaxf(mx, s); }
            if (chunk == 0) atomicMax(nrm + (b * NFH + head) * 2 + which, __float_as_uint(mx)); }
    }
}
__device__ __forceinline__ void pool_chunk(unsigned char* ws, int c, int tid) {
    const bf16u* P = (const bf16u*)(ws + WS_P); bf16u* Y = (bf16u*)(ws + WS_Y);
    const int rsub = tid >> 5, ch = (tid & 31) * 8, win = 2 << (ch >> 6);
    {
        const int rg = c * 64 + rsub * 4, t0 = rg % LP;
        v4u wv[19];
#pragma unroll
        for (int j = 0; j < 19; ++j) { const int back = 15 - j;
            wv[j] = (back < win && t0 - back >= 0) ? *(const v4u*)(P + (size_t)(rg - back) * NINP + PC_U + ch) : (v4u){0u, 0u, 0u, 0u}; }
#pragma unroll
        for (int i = 0; i < 4; ++i) { const int t = t0 + i, cnt = (t + 1 < win) ? t + 1 : win; float acc[8];
#pragma unroll
            for (int e = 0; e < 8; ++e) acc[e] = 0.f;
#pragma unroll
            for (int k = 0; k < 16; ++k) { if (k < cnt) {
#pragma unroll
                for (int e = 0; e < 4; ++e) { acc[2 * e] += __uint_as_float(wv[15 + i - k][e] << 16); acc[2 * e + 1] += __uint_as_float(wv[15 + i - k][e] & 0xffff0000u); } } }
            const float inv = 1.0f / (float)cnt; v4u o;
#pragma unroll
            for (int e = 0; e < 4; ++e) o[e] = pk2(acc[2 * e] * inv - __uint_as_float(wv[15 + i][e] << 16), acc[2 * e + 1] * inv - __uint_as_float(wv[15 + i][e] & 0xffff0000u));
            *(v4u*)(Y + (size_t)(rg + i) * 1024 + ch) = o; }
    }
}
__device__ __forceinline__ void attn_phase(unsigned char* ws, unsigned char* lds_g, unsigned* ctr, const unsigned* nrm, int tid) {
    const attn_body::bf16* P = (const attn_body::bf16*)(ws + WS_P); attn_body::bf16* Y = (attn_body::bf16*)(ws + WS_Y); const float* CS = (const float*)(ws + WS_CS);
    volatile LAS unsigned* bw = (volatile LAS unsigned*)((LAS unsigned char*)lds_g + LDS_MISC);
    constexpr int NU = NBATCH * NFH * (LP / 256);
    for (;;) {
        if (tid == 0) bw[0] = atomicAdd(ctr, 1u);
        __syncthreads();
        const int it = (int)bw[0];
        __syncthreads();
        if (it >= 2 * NU + MROWS / 64) break;
        if (it >= 2 * NU) { pool_chunk(ws, it - 2 * NU, tid); continue; }
#ifdef PROBE
        if (it == NU && tid == 0) ((volatile unsigned long long*)(ws + WS_CTL + 8192))[20 + (ctr != (unsigned*)(ws + WS_CTL))] = __builtin_amdgcn_s_memrealtime();
#endif
        const int r = it < NU ? it : it - NU; const int qb = (LP / 256 - 1) - r / (NBATCH * NFH), bh = r % (NBATCH * NFH), b = bh / NFH, h = bh % NFH;
#ifndef NO_FOX
        if (it < NU) attn_body::fox_unit<8>(b, qb, 154.0f + 2.0f * sqrtf(__uint_as_float(nrm[bh * 2]) * __uint_as_float(nrm[bh * 2 + 1])), P + PC_FQ + h * 64, P + PC_FK + h * 64, P + PC_FV + h * 64, Y + 256 + h * 64, CS + (size_t)bh * LP, (char*)lds_g);
#endif
#ifndef NO_SB
        if (it >= NU) attn_body::sb_unit(b, qb, P + PC_SQ + h * 64, P + PC_SK + h * 64, P + PC_SV + h * 64, Y + 640 + h * 64, (char*)lds_g);
#endif
    }
}
__device__ __forceinline__ void final_phase(const Args& A, unsigned char* ws, int wave, int lane) {
    const bf16u* hb = (const bf16u*)(ws + WS_HB); const float* ss = (const float*)(ws + WS_SS) + 4 * (size_t)MROWS; const f32x4* g = (const f32x4*)A.in[14] + lane;
    const int gw = blockIdx.x * NWAVES + wave, NGW = gridDim.x * NWAVES;
    f32x4 gv[4];
#pragma unroll
    for (int j = 0; j < 4; ++j) gv[j] = g[64 * j];
    for (int m = gw; m < NBATCH * SEQ_IN; m += NGW) {
        const int b = m / SEQ_IN, s = m % SEQ_IN; const size_t row = (size_t)b * LP + NMETA + s;
        const float rs = 1.0f / sqrtf(ss[row] * (1.0f / 1024.0f) + 1e-6f);
        const unsigned long long* src = (const unsigned long long*)(hb + row * 1024) + lane; f32x4* dst = (f32x4*)(A.out + (size_t)m * 1024) + lane;
#pragma unroll
        for (int j = 0; j < 4; ++j) { const unsigned long long r = src[64 * j]; const unsigned rl = (unsigned)r, rh = (unsigned)(r >> 32);
            dst[64 * j] = (f32x4){__uint_as_float(rl << 16), __uint_as_float(rl & 0xffff0000u), __uint_as_float(rh << 16), __uint_as_float(rh & 0xffff0000u)} * rs * gv[j]; }
    }
}

#define XB_TMO      128
#define XB_XCNT(j)  (256  + 64 * (j))
#define XB_XSUB(j)  (1280 + 64 * (j))
#define XB_XGEN(j)  (2304 + 64 * (j))
#define XB_TOP      3328
#define XB_TOPGEN   3392
#define XCD_BAR_WORDS 3456
#define XB_SPIN_CAP (1u << 18)

__device__ __forceinline__ unsigned xb_ld(unsigned* p)              { return __hip_atomic_load(p, __ATOMIC_RELAXED, __HIP_MEMORY_SCOPE_AGENT); }
__device__ __forceinline__ unsigned xb_add(unsigned* p, unsigned v) { return __hip_atomic_fetch_add(p, v, __ATOMIC_RELAXED, __HIP_MEMORY_SCOPE_AGENT); }
__device__ __forceinline__ unsigned xb_xcc_id() { return (unsigned)__builtin_amdgcn_s_getreg((3 << 11) | 20) & 0xFu; }
#define XB_SPIN(cond, bar) do { unsigned _sp = 0; while (cond) { __builtin_amdgcn_s_sleep(1); \
    if ((++_sp & 255u) == 0u) { if (xb_ld(&(bar)[XB_TMO])) break; if (_sp > XB_SPIN_CAP) { atomicAdd(&(bar)[XB_TMO], 1u); break; } } } } while (0)

struct XcdBarrier {
    unsigned* bar; unsigned x;
    volatile LAS unsigned* st;
};

__device__ __forceinline__ XcdBarrier xcd_barrier_post(unsigned* bar, volatile LAS unsigned* st) {
    XcdBarrier b; b.bar = bar; b.x = xb_xcc_id(); b.st = st;
    if (threadIdx.x == 0) (void)xb_add(&bar[XB_XCNT(b.x)], 1u);
    return b;
}
__device__ __forceinline__ void xcd_barrier_complete(unsigned* bar, unsigned x, unsigned& nloc, unsigned& nx) {
    const unsigned G = gridDim.x * gridDim.y * gridDim.z;
    unsigned sum, cnt, mine, sp = 0u;
    for (;;) {
        sum = 0u; cnt = 0u; mine = 0u;
#pragma unroll
        for (unsigned j = 0; j < 16; ++j) { const unsigned c = xb_ld(&bar[XB_XCNT(j)]); sum += c; cnt += (c > 0u) ? 1u : 0u; mine = (j == x) ? c : mine; }
        if (sum == G) break;
        __builtin_amdgcn_s_sleep(1);
        if ((++sp & 255u) == 0u) { if (xb_ld(&bar[XB_TMO])) break; if (sp > XB_SPIN_CAP) { atomicAdd(&bar[XB_TMO], 1u); break; } }
    }
    nloc = mine > 0u ? mine : 1u; nx = cnt > 0u ? cnt : 1u;
}

__device__ __forceinline__ void xcd_barrier(const XcdBarrier& b) {
    asm volatile("s_waitcnt vmcnt(0)" ::: "memory");
    __syncthreads();
    if (threadIdx.x == 0) {
        unsigned* bar = b.bar;
        __builtin_amdgcn_s_waitcnt(0);
        unsigned nloc = b.st[0], nx = b.st[1];
        if (nloc == 0u) { xcd_barrier_complete(bar, b.x, nloc, nx); b.st[0] = nloc; b.st[1] = nx; }
        const unsigned old = xb_add(&bar[XB_XSUB(b.x)], 1u);
        const unsigned gen = old / nloc;
        if (old + 1u == (gen + 1u) * nloc) {
            __builtin_amdgcn_fence(__ATOMIC_RELEASE, "agent");
            asm volatile("s_waitcnt vmcnt(0)" ::: "memory");
            const unsigned og = xb_add(&bar[XB_TOP], 1u);
            const unsigned tg = og / nx;
            if (og + 1u == (tg + 1u) * nx) xb_add(&bar[XB_TOPGEN], 1u);
            else XB_SPIN(xb_ld(&bar[XB_TOPGEN]) == tg, bar);
            __builtin_amdgcn_fence(__ATOMIC_ACQUIRE, "agent");
            xb_add(&bar[XB_XGEN(b.x)], 1u);
            asm volatile("s_waitcnt vmcnt(0)" ::: "memory");
        } else {
            XB_SPIN(xb_ld(&bar[XB_XGEN(b.x)]) == gen, bar);
            __builtin_amdgcn_fence(__ATOMIC_ACQUIRE, "agent");
            asm volatile("s_waitcnt vmcnt(0)" ::: "memory");
        }
    }
    __syncthreads();
}

#define FRESH() unsigned long zoff_ = 0; asm volatile("" : "+s"(zoff_)); unsigned char* ws = A.ws + zoff_; int tid = threadIdx.x; asm volatile("" : "+v"(tid)); const int lane = tid & 63, wave = __builtin_amdgcn_readfirstlane(tid >> 6); (void)lane; (void)wave
#ifdef PROBE
#define STAMP() do { if (blockIdx.x == 0 && threadIdx.x == 0) { ((volatile unsigned long long*)(A.ws + WS_CTL + 8192))[nst] = __builtin_amdgcn_s_memrealtime(); } ++nst; } while (0)
#else
#define STAMP() do {} while (0)
#endif
__global__ void __launch_bounds__(NWAVES * 64, 2) hymba_fwd(Args A) {
    extern __shared__ __attribute__((aligned(16))) unsigned char lds[];
    cg::grid_group grid = cg::this_grid();
    LAS unsigned char* L = (LAS unsigned char*)lds;
    if (threadIdx.x < 2) ((volatile LAS unsigned*)(L + LDS_MISC + 64))[threadIdx.x] = 0u;
    __syncthreads();
    const XcdBarrier xbar = xcd_barrier_post((unsigned*)(A.ws + WS_CTL) + 4096, (volatile LAS unsigned*)(L + LDS_MISC + 64));
#define GRID_BAR() xcd_barrier(xbar)
#ifdef PROBE
    int nst = 0; STAMP();
    for (int i = 0; i < 8; ++i) GRID_BAR();
    STAMP();
#endif
#ifndef NO_PRO
    { FRESH(); p0_prologue(A, ws, L, wave, lane); }
#endif
    if (A.ws == nullptr) grid.sync();
    GRID_BAR(); STAMP();
    for (int layer = 0; layer < DEPTH; ++layer) {
#ifndef NO_G1
        {
            FRESH(); const unsigned char* wb = ws + WS_W + (size_t)layer * W_LAYER;
            pg8::Gemm g{(const pg8::bf16_t*)(ws + WS_HB), (const pg8::bf16_t*)(wb + W_IN), MREAL, NINP, 1024}; pg8::StaticOrder S; S.init(MREAL, NINP, (int)gridDim.x, (int)blockIdx.x);
            pg8::EpiIn E{(pg8::bf16_t*)(ws + WS_P), (float*)(ws + WS_LF), (const float*)(ws + WS_SS) + (size_t)(2 * layer) * MROWS, A.in[4] + layer * NFH};
            fl_phase(ws, (const bf16u*)(wb + W_IN) + (size_t)NINP * 1024, (const float*)(ws + WS_SS) + (size_t)(2 * layer) * MROWS, A.in[4] + layer * NFH, wave, lane);
            mini_in(ws, (const bf16u*)(wb + W_IN), (const float*)(ws + WS_SS) + (size_t)(2 * layer) * MROWS, A.in[4] + layer * NFH, L, wave, lane);
            pg8::gemm_phase<pg8::EpiIn, pg8::StaticOrder, true, true>(L, g, S, E);
        }
#endif
        GRID_BAR(); STAMP();
#ifndef NO_POOL
        { FRESH(); pool_scan_phase(ws, L, (unsigned*)(ws + WS_CTL) + 128 + 64 * layer, tid, wave, lane); }
#endif
        GRID_BAR(); STAMP();
        { FRESH(); attn_phase(ws, lds, (unsigned*)(ws + WS_CTL) + 64 * layer, (const unsigned*)(ws + WS_CTL) + 128 + 64 * layer, tid); }
        GRID_BAR(); STAMP();
#ifndef NO_G3
        {
            FRESH(); const unsigned char* wb = ws + WS_W + (size_t)layer * W_LAYER;
            pg8::Gemm g{(const pg8::bf16_t*)(ws + WS_Y), (const pg8::bf16_t*)(wb + W_OUT), MREAL, 1024, 1024}; pg8::StaticOrder S; S.init(MREAL, 1024, (int)gridDim.x, (int)blockIdx.x);
            pg8::EpiRes E{(pg8::bf16_t*)(ws + WS_HB), nullptr, (float*)(ws + WS_SS) + (size_t)(2 * layer + 1) * MROWS};
            mini_res(ws, (const bf16u*)(ws + WS_Y), (const bf16u*)(wb + W_OUT), 1024, (float*)(ws + WS_SS) + (size_t)(2 * layer + 1) * MROWS, L, wave, lane);
            pg8::gemm_phase<pg8::EpiRes, pg8::StaticOrder, true, true>(L, g, S, E);
        }
#endif
        GRID_BAR(); STAMP();
#ifndef NO_G4
        {
            FRESH(); const unsigned char* wb = ws + WS_W + (size_t)layer * W_LAYER;
            pg8::Gemm g{(const pg8::bf16_t*)(ws + WS_HB), (const pg8::bf16_t*)(wb + W_GU), MREAL, NGU, 1024}; pg8::StaticOrder S; S.init(MREAL, NGU, (int)gridDim.x, (int)blockIdx.x);
            pg8::EpiGU E{(pg8::bf16_t*)(ws + WS_P), (const float*)(ws + WS_SS) + (size_t)(2 * layer + 1) * MROWS};
            mini_gu(ws, (const bf16u*)(wb + W_GU), (const float*)(ws + WS_SS) + (size_t)(2 * layer + 1) * MROWS, L, wave, lane);
            pg8::gemm_phase<pg8::EpiGU, pg8::StaticOrder, true, true>(L, g, S, E);
        }
#endif
        GRID_BAR(); STAMP();
#ifndef NO_G5
        {
            FRESH(); const unsigned char* wb = ws + WS_W + (size_t)layer * W_LAYER;
            pg8::Gemm g{(const pg8::bf16_t*)(ws + WS_P), (const pg8::bf16_t*)(wb + W_D), MREAL, 1024, DFF}; pg8::StaticOrder S; S.init(MREAL, 1024, (int)gridDim.x, (int)blockIdx.x);
            pg8::EpiRes E{(pg8::bf16_t*)(ws + WS_HB), nullptr, (float*)(ws + WS_SS) + (size_t)(2 * layer + 2) * MROWS};
            mini_res(ws, (const bf16u*)(ws + WS_P), (const bf16u*)(wb + W_D), DFF, (float*)(ws + WS_SS) + (size_t)(2 * layer + 2) * MROWS, L, wave, lane);
            pg8::gemm_phase<pg8::EpiRes, pg8::StaticOrder, true, true>(L, g, S, E);
        }
#endif
        GRID_BAR(); STAMP();
    }
    { FRESH(); final_phase(A, ws, wave, lane); }
#ifdef PROBE
    STAMP();
    grid.sync();
    {
        volatile unsigned long long* T = (volatile unsigned long long*)(A.ws + WS_CTL + 8192);
        if (blockIdx.x == 0) {
#ifndef PB_HI
#define PB_HI (PB + 1)
#endif
            const unsigned long long dA = T[PA + 1] - T[PA], dB = T[PB_HI] - T[PB];
            for (unsigned long long i = threadIdx.x; i < dB; i += NWAVES * 64) A.out[i] += 0.125f;
            if (threadIdx.x == 0) { const unsigned long long t0 = __builtin_amdgcn_s_memrealtime(); while (__builtin_amdgcn_s_memrealtime() - t0 < dA) __builtin_amdgcn_s_sleep(8); }
        }
    }
#endif
}

extern "C" void kernel_launch(void* const* d_in, const int* in_sizes, int n_in, void* d_out, int out_size, void* d_ws, size_t ws_size, hipStream_t stream) {
    static int grid = 0;
    if (grid == 0) {
        if (n_in != 15 || out_size != NBATCH * SEQ_IN * DMODEL || ws_size < WS_END) { fprintf(stderr, "kernel_launch: unexpected shapes (n_in %d out %d ws %zu, need %zu)\n", n_in, out_size, ws_size, (size_t)WS_END); grid = -1; return; }
        int dev = 0, cus = 0, per_cu = 0;
        if (hipGetDevice(&dev) != hipSuccess || hipDeviceGetAttribute(&cus, hipDeviceAttributeMultiprocessorCount, dev) != hipSuccess) { grid = -1; return; }
        if (hipFuncSetAttribute((const void*)hymba_fwd, hipFuncAttributeMaxDynamicSharedMemorySize, LDS_BYTES) != hipSuccess) { fprintf(stderr, "kernel_launch: hipFuncSetAttribute failed\n"); grid = -1; return; }
        if (hipOccupancyMaxActiveBlocksPerMultiprocessor(&per_cu, (const void*)hymba_fwd, NWAVES * 64, LDS_BYTES) != hipSuccess || per_cu < 1) { fprintf(stderr, "kernel_launch: occupancy query says %d\n", per_cu); per_cu = 1; }
        (void)hipGetLastError();
        grid = cus;
    }
    if (grid < 0) return;
    if (hipMemsetAsync((char*)d_ws + WS_CTL, 0, CTL_ZERO_BYTES, stream) != hipSuccess) { fprintf(stderr, "kernel_launch: memset failed\n"); return; }
    Args a{};
    for (int i = 0; i < 15; ++i) a.in[i] = (const float*)d_in[i];
    a.out = (float*)d_out; a.ws = (unsigned char*)d_ws;
    void* args[] = {&a};
    const hipError_t e = hipLaunchCooperativeKernel((const void*)hymba_fwd, dim3(grid), dim3(NWAVES * 64), args, LDS_BYTES, stream);
    if (e != hipSuccess) fprintf(stderr, "kernel_launch: cooperative launch failed: %s (grid %d)\n", hipGetErrorString(e), grid);
}
```

```cpp
#include <hip/hip_runtime.h>
#include <hip/hip_cooperative_groups.h>
#include <cstdio>
#include <cstdint>
namespace pg8 {
#define PG8_LAS __attribute__((address_space(3)))
typedef unsigned short bf16_t;
typedef short bf16x8 __attribute__((ext_vector_type(8)));
typedef float f32x4 __attribute__((ext_vector_type(4)));
typedef unsigned u32x4 __attribute__((ext_vector_type(4)));
constexpr int BM = 256, BK = 64, HALF = 128, HTB = HALF * BK * 2  , STAGE_BYTES = 8 * HTB, NXCD = 8, WGM = 8;

__host__ __device__ __forceinline__ int lds_byte(int r, int c) { const int st = (r >> 4) * 2 + (c >> 5), rr = r & 15, cc = c & 31, ob = rr * 64 + cc * 2; return st * 1024 + (ob ^ (((ob >> 9) & 1) << 5)); }
__host__ __device__ __forceinline__ void stage_rc(int b, int& R, int& C) { const int st = b / 1024, sb = b % 1024, swz = sb ^ (((sb >> 9) & 1) << 5); R = (st >> 1) * 16 + swz / 64; C = (st & 1) * 32 + (swz % 64) / 2; }
__host__ __device__ __forceinline__ int perm32(int rho) { const int n = rho >> 4, i = rho & 15; return 8 * (i >> 2) + 4 * n + (i & 3); }

struct Unit { int pm, pn; };
__host__ __device__ __forceinline__ int arow(int pm) { return 256 * (pm + (pm >> 5)) + 16; }
struct Gemm { const bf16_t* A; const bf16_t* Bt; int M, N, K; };

struct StaticOrder {
    int nM, nN, nwg, G, c;
    __host__ __device__ void init(int M, int N, int G_, int c_) { nM = M / BM; nN = N / BM; nwg = nM * nN; G = G_; c = c_; }
    __host__ __device__ bool next(int i, Unit& u) const {
        const long L = (long)i * G + c; if (L >= nwg) return false;
        int wgid = (int)L; { const int q = nwg / NXCD, r = nwg % NXCD, xcd = wgid % NXCD, off = wgid / NXCD; wgid = (xcd < r ? xcd * (q + 1) : r * (q + 1) + (xcd - r) * q) + off; }
        const int nig = WGM * nN, gid = wgid / nig, fm = gid * WGM, gsz = (nM - fm) < WGM ? (nM - fm) : WGM;
        u.pm = fm + ((wgid % nig) % gsz); u.pn = (wgid % nig) / gsz; return true;
    }
    __device__ __forceinline__ void a_ready(const Unit&) const {}
    __device__ __forceinline__ void done(const Unit&) const {}
};

__device__ __forceinline__ unsigned cvt_pk_bf16(float lo, float hi) { unsigned r; asm volatile("v_cvt_pk_bf16_f32 %0, %1, %2" : "=v"(r) : "v"(lo), "v"(hi)); return r; }
typedef unsigned u32x2 __attribute__((ext_vector_type(2)));
constexpr float RMS_EPS = 1e-6f;
struct EpiIn {
    static constexpr bool PERM = true, AFTER_DRAIN = false;
    bf16_t* P; float* LF; const float* ss; const float* fb;
    __device__ __forceinline__ void operator()(const f32x4 (&acc)[2][2][4][2], const Unit& u, int wr, int wc, int fr, int fq) const {
        const int row0 = arow(u.pm) + wr * 64 + fr;
        {
            const int col0 = u.pn * BM + wc * 32 + 8 * fq;
#pragma unroll
            for (int ai = 0; ai < 2; ++ai)
#pragma unroll
                for (int m = 0; m < 4; ++m) { const int row = row0 + ai * HALF + m * 16; const float rs = __builtin_amdgcn_rsqf(ss[row] * (1.0f / 1024.0f) + RMS_EPS);
                    bf16_t* rowp = P + (size_t)row * 2560 + col0;
#pragma unroll
                    for (int bj = 0; bj < 2; ++bj) { const f32x4 v0 = acc[ai][bj][m][0] * rs, v1 = acc[ai][bj][m][1] * rs;
                        u32x4 w; w.x = cvt_pk_bf16(v0[0], v0[1]); w.y = cvt_pk_bf16(v0[2], v0[3]); w.z = cvt_pk_bf16(v1[0], v1[1]); w.w = cvt_pk_bf16(v1[2], v1[3]);
                        *(u32x4*)(rowp + bj * HALF) = w; } }
        }
    }
};
struct EpiRes {
    static constexpr bool PERM = true, AFTER_DRAIN = false;
    bf16_t* hb; float* hf; float* ssn;
    __device__ __forceinline__ void operator()(const f32x4 (&acc)[2][2][4][2], const Unit& u, int wr, int wc, int fr, int fq) const {
        const int row0 = arow(u.pm) + wr * 64 + fr, col0 = u.pn * BM + wc * 32 + 8 * fq;
#pragma unroll
        for (int ai = 0; ai < 2; ++ai)
#pragma unroll
            for (int m = 0; m < 4; ++m) { const int row = row0 + ai * HALF + m * 16; bf16_t* bp = hb + (size_t)row * 1024 + col0; float s = 0.f;
#pragma unroll
                for (int bj = 0; bj < 2; ++bj) { const u32x4 r = *(const u32x4*)(bp + bj * HALF);
                    f32x4 a = (f32x4){__uint_as_float(r.x << 16), __uint_as_float(r.x & 0xffff0000u), __uint_as_float(r.y << 16), __uint_as_float(r.y & 0xffff0000u)};
                    f32x4 b = (f32x4){__uint_as_float(r.z << 16), __uint_as_float(r.z & 0xffff0000u), __uint_as_float(r.w << 16), __uint_as_float(r.w & 0xffff0000u)};
                    a = a + acc[ai][bj][m][0]; b = b + acc[ai][bj][m][1];
                    if (hf) { float* hp = hf + (size_t)row * 1024 + col0 + bj * HALF; *(f32x4*)hp = a; *(f32x4*)(hp + 4) = b; }
                    s += (a[0] * a[0] + a[1] * a[1]) + (a[2] * a[2] + a[3] * a[3]) + (b[0] * b[0] + b[1] * b[1]) + (b[2] * b[2] + b[3] * b[3]);
                    u32x4 w; w.x = cvt_pk_bf16(a[0], a[1]); w.y = cvt_pk_bf16(a[2], a[3]); w.z = cvt_pk_bf16(b[0], b[1]); w.w = cvt_pk_bf16(b[2], b[3]);
                    *(u32x4*)(bp + bj * HALF) = w; }
                s += __shfl_xor(s, 16); s += __shfl_xor(s, 32);
                if (fq == 0) atomicAdd(ssn + row, s);
                asm volatile("" ::: "memory"); }
    }
};
struct EpiGU {
    static constexpr bool PERM = true, AFTER_DRAIN = false;
    bf16_t* H; const float* ss;
    __device__ __forceinline__ void operator()(const f32x4 (&acc)[2][2][4][2], const Unit& u, int wr, int wc, int fr, int fq) const {
        const int row0 = arow(u.pm) + wr * 64 + fr, col0 = u.pn * HALF + wc * 32 + 8 * fq;
#pragma unroll
        for (int ai = 0; ai < 2; ++ai)
#pragma unroll
            for (int m = 0; m < 4; ++m) { const int row = row0 + ai * HALF + m * 16; const float rs = __builtin_amdgcn_rsqf(ss[row] * (1.0f / 1024.0f) + RMS_EPS);
                float o[8];
#pragma unroll
                for (int n = 0; n < 2; ++n)
#pragma unroll
                    for (int e = 0; e < 4; ++e) { const float g = acc[ai][0][m][n][e] * rs, up = acc[ai][1][m][n][e] * rs;
                        o[4 * n + e] = g * __builtin_amdgcn_rcpf(1.0f + __builtin_amdgcn_exp2f(-1.4426950408889634f * g)) * up; }
                u32x4 w; w.x = cvt_pk_bf16(o[0], o[1]); w.y = cvt_pk_bf16(o[2], o[3]); w.z = cvt_pk_bf16(o[4], o[5]); w.w = cvt_pk_bf16(o[6], o[7]);
                *(u32x4*)(H + (size_t)row * 2816 + col0) = w; }
    }
};
template <class Epi, class Sched, bool ALIGN_EPI = false, bool SP2 = false>
__device__ __forceinline__ void gemm_phase(PG8_LAS unsigned char* lds, const Gemm g, const Sched& S, const Epi& E) {
    int tid_ = threadIdx.x; asm volatile("" : "+v"(tid_));
    const int tid = tid_, wid = __builtin_amdgcn_readfirstlane(tid >> 6), lane = tid & 63, wr = wid >> 2, wc = wid & 3, fr = lane & 15, fq = lane >> 4;
    const int K = g.K, nt = K / BK;
    unsigned voffA[2], voffB[2];
#pragma unroll
    for (int i = 0; i < 2; ++i) { int R, C; stage_rc(tid * 16 + i * 8192, R, C); const int Rb = Epi::PERM ? ((R & ~31) + perm32(R & 31)) : R;
        voffA[i] = (unsigned)(R * K + C) * 2u; voffB[i] = (unsigned)(Rb * K + C) * 2u; }
    const size_t kstep = (size_t)(BK * 2);
    const size_t hstep = (size_t)HALF * K * 2;
    const size_t tstep = 2 * hstep;
    const unsigned ldsw = (unsigned)wid * 1024u;
    const int aoff = lds_byte(wr * 64 + fr, fq * 8), boff = lds_byte(wc * 32 + fr, fq * 8);
#define PG8_SA(b, h) (((b) * 2 + (h)) * HTB)
#define PG8_SB(b, h) ((4 + (b) * 2 + (h)) * HTB)
#define PG8_STAGE(bufoff, gbase, voff) do { _Pragma("unroll") for (int _i = 0; _i < 2; ++_i) \
        __builtin_amdgcn_global_load_lds((const unsigned*)((const char*)(gbase) + (voff)[_i]), (PG8_LAS unsigned*)(lds + (bufoff) + ldsw + _i * 8192), 16, 0, 0); } while (0)
#define PG8_LDA(dst, b, h) do { _Pragma("unroll") for (int m = 0; m < 4; ++m) _Pragma("unroll") for (int k = 0; k < 2; ++k) dst[m][k] = *(const PG8_LAS bf16x8*)(lds + PG8_SA(b, h) + aoff + m * 2048 + k * 1024); } while (0)
#define PG8_LDB(dst, b, h) do { _Pragma("unroll") for (int n = 0; n < 2; ++n) _Pragma("unroll") for (int k = 0; k < 2; ++k) dst[n][k] = *(const PG8_LAS bf16x8*)(lds + PG8_SB(b, h) + boff + n * 2048 + k * 1024); } while (0)
#define PG8_MMA(ai, bj, At, Bt) do { __builtin_amdgcn_s_setprio(1); _Pragma("unroll") for (int m = 0; m < 4; ++m) _Pragma("unroll") for (int n = 0; n < 2; ++n) _Pragma("unroll") for (int k = 0; k < 2; ++k) \
        acc[ai][bj][m][n] = __builtin_amdgcn_mfma_f32_16x16x32_bf16(Bt[n][k], At[m][k], acc[ai][bj][m][n], 0, 0, 0); __builtin_amdgcn_s_setprio(0); } while (0)
#define PG8_WAIT_V(n) asm volatile("s_waitcnt vmcnt(" #n ")" ::: "memory")
#define PG8_WAIT_L(n) asm volatile("s_waitcnt lgkmcnt(" #n ")" ::: "memory")
#define PG8_BAR __builtin_amdgcn_s_barrier()
#define PG8_SCHED __builtin_amdgcn_sched_barrier(0)
    Unit cur, nxt; int ui = 0;
    if (!S.next(0, cur)) return;
    f32x4 acc[2][2][4][2];
#pragma unroll
    for (int a = 0; a < 2; ++a)
#pragma unroll
        for (int b = 0; b < 2; ++b)
#pragma unroll
            for (int m = 0; m < 4; ++m)
#pragma unroll
                for (int n = 0; n < 2; ++n) acc[a][b][m][n] = (f32x4){0.f, 0.f, 0.f, 0.f};
    bf16x8 At[4][2], B0[2][2], B1[2][2];
    const char* cA = (const char*)g.A + (size_t)arow(cur.pm) * K * 2; const char* cB = (const char*)g.Bt + (size_t)cur.pn * tstep;
    S.a_ready(cur);
    if constexpr (SP2) {
        PG8_STAGE(PG8_SB(0, 0), cB, voffB); PG8_STAGE(PG8_SB(0, 1), cB + hstep, voffB); PG8_STAGE(PG8_SA(0, 0), cA, voffA); PG8_STAGE(PG8_SA(0, 1), cA + hstep, voffA);
        if (wr == 1) PG8_BAR;
        PG8_WAIT_V(2); PG8_BAR;
        PG8_STAGE(PG8_SB(1, 0), cB + kstep, voffB); PG8_STAGE(PG8_SA(1, 0), cA + kstep, voffA); PG8_STAGE(PG8_SB(1, 1), cB + hstep + kstep, voffB);
        PG8_WAIT_V(6); PG8_BAR;
    } else {
        PG8_STAGE(PG8_SB(0, 0), cB, voffB); PG8_STAGE(PG8_SA(0, 0), cA, voffA); PG8_STAGE(PG8_SB(0, 1), cB + hstep, voffB); PG8_STAGE(PG8_SA(0, 1), cA + hstep, voffA);
        if (wr == 1) PG8_BAR;
        PG8_WAIT_V(4); PG8_BAR;
        PG8_STAGE(PG8_SB(1, 0), cB + kstep, voffB); PG8_STAGE(PG8_SA(1, 0), cA + kstep, voffA); PG8_STAGE(PG8_SB(1, 1), cB + hstep + kstep, voffB);
        PG8_WAIT_V(6); PG8_BAR;
    }
    for (;;) {
        const bool has_next = S.next(ui + 1, nxt);
        const char* nA = has_next ? (const char*)g.A + (size_t)arow(nxt.pm) * K * 2 : cA; const char* nB = has_next ? (const char*)g.Bt + (size_t)nxt.pn * tstep : cB;
        for (int t = 0; t < nt; t += 2) {
            const bool last = (t == nt - 2);
            const char* a1 = cA + (size_t)(t + 1) * kstep;
            const char* a2 = last ? nA : cA + (size_t)(t + 2) * kstep; const char* b2 = last ? nB : cB + (size_t)(t + 2) * kstep;
            const char* a3 = a2 + kstep; const char* b3 = b2 + kstep;
            if (last && has_next) S.a_ready(nxt);
            if constexpr (SP2) {
            PG8_LDB(B0, 0, 0); PG8_LDB(B1, 0, 1); PG8_SCHED; PG8_LDA(At, 0, 0); PG8_STAGE(PG8_SA(1, 1), a1 + hstep, voffA);
            PG8_WAIT_V(8); PG8_WAIT_L(0); PG8_BAR; PG8_MMA(0, 0, At, B0); PG8_MMA(0, 1, At, B1); PG8_BAR; PG8_SCHED;
            PG8_LDA(At, 0, 1); PG8_STAGE(PG8_SB(0, 0), b2, voffB); PG8_STAGE(PG8_SB(0, 1), b2 + hstep, voffB); PG8_STAGE(PG8_SA(0, 0), a2, voffA);
            PG8_WAIT_V(8); PG8_WAIT_L(0); PG8_BAR; PG8_MMA(1, 0, At, B0); PG8_MMA(1, 1, At, B1); PG8_BAR; PG8_SCHED;
            PG8_LDB(B0, 1, 0); PG8_LDB(B1, 1, 1); PG8_SCHED; PG8_LDA(At, 1, 0); PG8_STAGE(PG8_SA(0, 1), a2 + hstep, voffA);
            PG8_WAIT_V(8); PG8_WAIT_L(0); PG8_BAR; PG8_MMA(0, 0, At, B0); PG8_MMA(0, 1, At, B1); PG8_BAR; PG8_SCHED;
            PG8_LDA(At, 1, 1); PG8_STAGE(PG8_SB(1, 0), b3, voffB); PG8_STAGE(PG8_SB(1, 1), b3 + hstep, voffB); PG8_STAGE(PG8_SA(1, 0), a3, voffA);
            PG8_WAIT_V(8); PG8_WAIT_L(0); PG8_BAR; PG8_MMA(1, 0, At, B0); PG8_MMA(1, 1, At, B1); PG8_BAR; PG8_SCHED;
            } else {
            PG8_LDB(B0, 0, 0); PG8_SCHED; PG8_LDA(At, 0, 0); PG8_STAGE(PG8_SA(1, 1), a1 + hstep, voffA);
            PG8_WAIT_L(8); PG8_BAR; PG8_WAIT_L(0); PG8_MMA(0, 0, At, B0); PG8_BAR; PG8_SCHED;
            PG8_LDB(B1, 0, 1); PG8_STAGE(PG8_SB(0, 0), b2, voffB);
            PG8_BAR; PG8_WAIT_L(0); PG8_MMA(0, 1, At, B1); PG8_BAR;
            PG8_LDA(At, 0, 1); PG8_STAGE(PG8_SA(0, 0), a2, voffA);
            PG8_BAR; PG8_WAIT_L(0); PG8_MMA(1, 0, At, B0); PG8_BAR; PG8_SCHED;
            PG8_STAGE(PG8_SB(0, 1), b2 + hstep, voffB);
            PG8_WAIT_V(6); PG8_BAR; PG8_MMA(1, 1, At, B1); PG8_BAR;
            PG8_LDB(B0, 1, 0); PG8_SCHED; PG8_LDA(At, 1, 0); PG8_STAGE(PG8_SA(0, 1), a2 + hstep, voffA);
            PG8_WAIT_L(8); PG8_BAR; PG8_WAIT_L(0); PG8_MMA(0, 0, At, B0); PG8_BAR; PG8_SCHED;
            PG8_LDB(B1, 1, 1); PG8_STAGE(PG8_SB(1, 0), b3, voffB);
            PG8_BAR; PG8_WAIT_L(0); PG8_MMA(0, 1, At, B1); PG8_BAR;
            PG8_LDA(At, 1, 1); PG8_STAGE(PG8_SA(1, 0), a3, voffA);
            PG8_BAR; PG8_WAIT_L(0); PG8_MMA(1, 0, At, B0); PG8_BAR; PG8_SCHED;
            PG8_STAGE(PG8_SB(1, 1), b3 + hstep, voffB);
            PG8_WAIT_V(6); PG8_BAR; PG8_MMA(1, 1, At, B1); PG8_BAR;
            }
        }
        if constexpr (ALIGN_EPI) { if (wr == 0) PG8_BAR; }
        if constexpr (!Epi::AFTER_DRAIN) { E(acc, cur, wr, wc, fr, fq); S.done(cur); }
        if (!has_next) break;
#pragma unroll
        for (int a = 0; a < 2; ++a)
#pragma unroll
            for (int b = 0; b < 2; ++b)
#pragma unroll
                for (int m = 0; m < 4; ++m)
#pragma unroll
                    for (int n = 0; n < 2; ++n) acc[a][b][m][n] = (f32x4){0.f, 0.f, 0.f, 0.f};
        cur = nxt; cA = nA; cB = nB; ++ui;
        if constexpr (ALIGN_EPI) { if (wr == 1) PG8_BAR; }
    }
    PG8_WAIT_V(0);
    if constexpr (!ALIGN_EPI) { if (wr == 0) PG8_BAR; }
    PG8_BAR;
    if constexpr (Epi::AFTER_DRAIN) { E.fused(acc, cur, wr, wc, fr, fq, lds, wid, lane); S.done(cur); }
#undef PG8_SA
#undef PG8_SB
#undef PG8_STAGE
#undef PG8_LDA
#undef PG8_LDB
#undef PG8_MMA
#undef PG8_WAIT_V
#undef PG8_WAIT_L
#undef PG8_BAR
#undef PG8_SCHED
}
}
#include <hip/hip_bf16.h>
#include <cmath>
namespace attn_body {
using bf16=__hip_bfloat16;
using bf16x8=__attribute__((ext_vector_type(8)))short;
using s16x4=__attribute__((ext_vector_type(4)))short;
using f32x16=__attribute__((ext_vector_type(16)))float;
using u32x4=__attribute__((ext_vector_type(4)))unsigned;
constexpr int SEQ=8448,D=64,DM=2560,DMO=1024;
using f32x4=__attribute__((ext_vector_type(4)))float;
constexpr int NW=8,QBLK=32,QB=QBLK*NW,KVBLK=64,NQB=SEQ/QB;
constexpr int ATTN_UNIT_ROWS=QB;
__device__ __forceinline__ int crow(int r,int hi){return (r&3)+8*(r>>2)+4*hi;}
#define SBAR() __builtin_amdgcn_sched_barrier(0)
__device__ __forceinline__ void cmask(f32x16&p0,f32x16&p1,int jb,int qrel,int hi){
  const float NEG=-INFINITY; int kb=64*jb+4*hi;
  #pragma unroll
  for(int r=0;r<16;++r){int kv=kb+(r&3)+8*(r>>2); if(kv>qrel)p0[r]=NEG; if(kv+32>qrel)p1[r]=NEG;}
}

constexpr int NSLOT=3, SLOTB=8192;
constexpr int LDS_K=0, LDS_V=NSLOT*SLOTB, LDS_WS=2*NSLOT*SLOTB, LDS_OST=LDS_WS+NW*64*4, LDS_BYTES=LDS_OST+NW*4096, LDS_CS=LDS_BYTES, LDS_FLAGS=LDS_CS+SEQ*4, LDS_END=LDS_FLAGS+256;
constexpr float C2=0.125f*1.4426950408889634f;
__device__ __forceinline__ void glds16(const void*gsrc,unsigned lds_dst){unsigned keep;
  asm volatile("s_mov_b32 %0, m0\n\ts_mov_b32 m0, %2\n\ts_nop 0\n\tglobal_load_lds_dwordx4 %1, off\n\ts_mov_b32 m0, %0":"=&s"(keep):"v"(gsrc),"s"(lds_dst):"memory");}
__device__ __forceinline__ float max3f(float a,float b,float c){float r;asm("v_max3_f32 %0, %1, %2, %3":"=v"(r):"v"(a),"v"(b),"v"(c));return r;}
__device__ __forceinline__ float max2f(float a,float b){float r;asm("v_max_f32_e32 %0, %1, %2":"=v"(r):"v"(a),"v"(b));return r;}
__device__ __forceinline__ float fadd_s(float a,float b){float r;asm("v_add_f32_e32 %0, %1, %2":"=v"(r):"v"(a),"v"(b));return r;}
__device__ __forceinline__ float fsub_s(float a,float b){float r;asm("v_sub_f32_e32 %0, %1, %2":"=v"(r):"v"(a),"v"(b));return r;}
typedef float f32x2_t __attribute__((ext_vector_type(2))); typedef __bf16 bf16x2_t __attribute__((ext_vector_type(2)));
__device__ __forceinline__ unsigned cvtpk_s(float lo,float hi){f32x2_t v={lo,hi};bf16x2_t b=__builtin_convertvector(v,bf16x2_t);return __builtin_bit_cast(unsigned,b);}
#define WAIT_BAR(N) asm volatile("s_waitcnt vmcnt(" #N ") lgkmcnt(0)\n\ts_barrier":::"memory")

__device__ __forceinline__ void qkt(f32x16&p0,f32x16&p1,const char*Kslot,const bf16x8*qr,int r32,int hi){
  const char*kb=Kslot+hi*1024+r32*16;
  #pragma unroll
  for(int d0=0;d0<4;++d0){
    const bf16x8 b0=*reinterpret_cast<const bf16x8*>(kb+d0*2048);
    const bf16x8 b1=*reinterpret_cast<const bf16x8*>(kb+d0*2048+512);
    {p0=__builtin_amdgcn_mfma_f32_32x32x16_bf16(b0,qr[d0],p0,0,0,0);p1=__builtin_amdgcn_mfma_f32_32x32x16_bf16(b1,qr[d0],p1,0,0,0);}}
}
typedef __attribute__((address_space(3))) const char* lds_cptr;
typedef short v4i16_t __attribute__((ext_vector_type(4)));
__device__ __forceinline__ void kload8(bf16x8*kf,lds_cptr kp){
  kf[0]=*(const __attribute__((address_space(3))) bf16x8*)(kp);      kf[1]=*(const __attribute__((address_space(3))) bf16x8*)(kp+512);
  kf[2]=*(const __attribute__((address_space(3))) bf16x8*)(kp+2048); kf[3]=*(const __attribute__((address_space(3))) bf16x8*)(kp+2560);
  kf[4]=*(const __attribute__((address_space(3))) bf16x8*)(kp+4096); kf[5]=*(const __attribute__((address_space(3))) bf16x8*)(kp+4608);
  kf[6]=*(const __attribute__((address_space(3))) bf16x8*)(kp+6144); kf[7]=*(const __attribute__((address_space(3))) bf16x8*)(kp+6656);
}
__device__ __forceinline__ void kload2(bf16x8*kf,lds_cptr kp,int j){ kf[2*j]=*(const __attribute__((address_space(3))) bf16x8*)(kp+j*2048); kf[2*j+1]=*(const __attribute__((address_space(3))) bf16x8*)(kp+j*2048+512); }
__device__ __forceinline__ s16x4 vtr(lds_cptr p){ return __builtin_bit_cast(s16x4,__builtin_amdgcn_ds_read_tr16_b64_v4i16((__attribute__((address_space(3))) v4i16_t*)p)); }
__device__ __forceinline__ float rowmax(const f32x16&p0,const f32x16&p1){
  float a=max3f(p0[0],p0[1],p1[0]),b=max3f(p0[2],p0[3],p1[1]);a=max3f(a,p1[2],p1[3]);
  #pragma unroll
  for(int r=4;r<16;r+=4){a=max3f(a,p0[r],p0[r+1]);b=max3f(b,p0[r+2],p0[r+3]);a=max3f(a,p1[r],p1[r+1]);b=max3f(b,p1[r+2],p1[r+3]);}
  const float m=max2f(a,b);
  auto rr=__builtin_amdgcn_permlane32_swap(__float_as_uint(m),__float_as_uint(m),false,false);
  return max2f(__uint_as_float(rr[0]),__uint_as_float(rr[1]));
}
__device__ __forceinline__ void pv(f32x16*o,int vb,bf16x8 pa0,bf16x8 pa1,bf16x8 pa2,bf16x8 pa3){
  #pragma unroll
  for(int d0=0;d0<2;++d0){s16x4 lo[4],hi[4];
    #pragma unroll
    for(int ks=0;ks<4;++ks){
      asm volatile("ds_read_b64_tr_b16 %0,%1 offset:%c2":"=&v"(lo[ks]):"v"(vb),"i"(d0*4096+ks*1024):"memory");
      asm volatile("ds_read_b64_tr_b16 %0,%1 offset:%c2":"=&v"(hi[ks]):"v"(vb),"i"(d0*4096+ks*1024+512):"memory");}
    asm volatile("s_waitcnt lgkmcnt(0)":::"memory");SBAR();
    #define PK(k) (bf16x8){lo[k][0],lo[k][1],lo[k][2],lo[k][3],hi[k][0],hi[k][1],hi[k][2],hi[k][3]}
    o[d0]=__builtin_amdgcn_mfma_f32_32x32x16_bf16(pa0,PK(0),o[d0],0,0,0);
    o[d0]=__builtin_amdgcn_mfma_f32_32x32x16_bf16(pa1,PK(1),o[d0],0,0,0);
    o[d0]=__builtin_amdgcn_mfma_f32_32x32x16_bf16(pa2,PK(2),o[d0],0,0,0);
    o[d0]=__builtin_amdgcn_mfma_f32_32x32x16_bf16(pa3,PK(3),o[d0],0,0,0);
    #undef PK
  }
}

__device__ __forceinline__ u32x4 head_rms(u32x4 v){ float x[8];
  #pragma unroll
  for(int i=0;i<4;++i){x[2*i]=__uint_as_float(v[i]<<16);x[2*i+1]=__uint_as_float(v[i]&0xffff0000u);}
  float s=0.f;
  #pragma unroll
  for(int i=0;i<8;++i)s+=x[i]*x[i];
  s+=__shfl_xor(s,1);s+=__shfl_xor(s,2);s+=__shfl_xor(s,4);
  const float rs=__builtin_amdgcn_rsqf(s*(1.0f/64.0f)+1e-6f); u32x4 w;
  #pragma unroll
  for(int i=0;i<4;++i)w[i]=cvtpk_s(x[2*i]*rs,x[2*i+1]*rs);
  return w; }
#ifndef ATTN_STORE16
#define ATTN_STORE16(p,v) (*(u32x4*)(p)=(v))
#endif
template<int THRL> __device__ __forceinline__ void fox_unit(int b,int qb,float dthr,const bf16*Q,const bf16*__restrict__ K,const bf16*__restrict__ V,bf16*O,const float*__restrict__ csg,char*shm){
  int tid_=threadIdx.x; asm volatile("":"+v"(tid_)); const int tid=tid_,lane=tid&63,r32=lane&31,hi=lane>>5; const int wid=__builtin_amdgcn_readfirstlane(tid>>6);
  const long rowbase=(long)b*SEQ; const int q0=qb*QB;
  const bf16*Qw=Q+(rowbase+q0+wid*QBLK)*DM;
  const unsigned lds0=(unsigned)(uintptr_t)shm; const lds_cptr shm3=(lds_cptr)shm;
  float*wsf=(float*)(shm+LDS_WS)+wid*64;
  const unsigned kdst=lds0+LDS_K+wid*1024, vdst=lds0+LDS_V+wid*1024;
  #define DMA_K(t,slot) glds16(ksrc+(long)(t)*KVBLK*DM,(unsigned)__builtin_amdgcn_readfirstlane(kdst+(slot)))
  #define DMA_V(t,slot) glds16(vsrc+(long)(t)*KVBLK*DM,(unsigned)__builtin_amdgcn_readfirstlane(vdst+(slot)))
  const int vb0=(int)(lds0+LDS_V)+((lane>>4)&1)*32+(lane&3)*8+(4*hi+((lane&15)>>2))*64;
  const char*Kbase=shm+LDS_K; bf16x8 kf[8];
  const lds_cptr kp0=shm3+LDS_K+hi*1024+r32*16; const lds_cptr vp0=shm3+LDS_V+((lane>>4)&1)*32+(lane&3)*8+(4*hi+((lane&15)>>2))*64;
  typedef __attribute__((address_space(3))) float lds_f32; typedef __attribute__((address_space(3))) f32x4 lds_f32x4;
  { lds_f32*cl=(lds_f32*)(shm3+LDS_CS); const int n_=q0+QB; for(int i_=tid*4;i_<n_;i_+=2048){ const f32x4 v_=*(const f32x4*)(csg+i_); *(lds_f32x4*)(cl+i_)=v_; } }
  asm volatile("s_waitcnt vmcnt(0) lgkmcnt(0)\n\ts_barrier":::"memory");
  int j0;
  { const lds_f32*cl=(const lds_f32*)(shm3+LDS_CS); const float cq0=cl[q0]; int lo_=0,hi_=4*qb;
    while(lo_<hi_){ const int mid_=(lo_+hi_)>>1; if(cl[64*mid_+63]-cq0>=dthr)lo_=mid_+1; else hi_=mid_; }
    j0=__builtin_amdgcn_readfirstlane(lo_)&~1; }
  const bf16*Kh=K+(rowbase+(long)j0*KVBLK)*DM,*Vh=V+(rowbase+(long)j0*KVBLK)*DM;
  const bf16*ksrc=Kh+(long)lane*DM+wid*8;
  const bf16*vsrc=Vh+(long)(16*(wid&3)+(lane>>2))*DM+(wid>>2)*32+(lane&3)*8;
  const int NT=(q0+QB)/KVBLK-j0;
  const lds_f32*cl3=(const lds_f32*)(shm3+LDS_CS)+64*j0;
  DMA_K(0,0);DMA_V(0,0);DMA_K(1,SLOTB);
  bf16x8 qr[4];
  #pragma unroll
  for(int d0=0;d0<4;++d0)qr[d0]=*reinterpret_cast<const bf16x8*>(&Qw[(long)r32*DM+d0*16+hi*8]);
  float base=0.f,l_reg=0.f;f32x16 o[2];o[0]=f32x16{};o[1]=f32x16{};
  #define CINIT(C0,C1,t) do{ const lds_f32*cp_=cl3+64*(t)+4*hi; \
    _Pragma("unroll") for(int g_=0;g_<4;++g_){ const f32x4 a_=*(const lds_f32x4*)(cp_+8*g_), b_=*(const lds_f32x4*)(cp_+32+8*g_); \
      C0[4*g_]=base-a_[0];C0[4*g_+1]=base-a_[1];C0[4*g_+2]=base-a_[2];C0[4*g_+3]=base-a_[3]; \
      C1[4*g_]=base-b_[0];C1[4*g_+1]=base-b_[1];C1[4*g_+2]=base-b_[2];C1[4*g_+3]=base-b_[3]; } }while(0)
  const int qrel=wid*QBLK+r32;
  #define CMASK(P0,P1,t) do{int jb_=(t)-(NT-4); if(jb_>=0)cmask(P0,P1,jb_,qrel,hi);}while(0)
  bool resc=false;
  #define START(P0,P1) do{ const float rm=rowmax(P0,P1); resc=false; \
    { const float dl=rm; base=fsub_s(base,dl); \
      _Pragma("unroll") for(int r=0;r<16;++r){P0[r]=fsub_s(P0[r],dl);P1[r]=fsub_s(P1[r],dl);} } \
    _Pragma("unroll") for(int r=0;r<16;++r)P0[r]=__builtin_amdgcn_exp2f(P0[r]); }while(0)
  #define RESC() do{ if(resc){ asm volatile("s_waitcnt lgkmcnt(0)":::"memory"); \
      _Pragma("unroll") for(int d_=0;d_<2;++d_) _Pragma("unroll") for(int r=0;r<16;++r)o[d_][r]*=wsf[crow(r,hi)]; } }while(0)
  f32x16 pA0,pA1,pB0,pB1;
  int sl_prev=0,sl_cur=0,sl_next=SLOTB;
  #define ROT() do{sl_prev=sl_cur;sl_cur=sl_next;sl_next=(sl_next==(NSLOT-1)*SLOTB)?0:sl_next+SLOTB;}while(0)
  DMA_K(2,2*SLOTB);
  WAIT_BAR(3);
  base=cl3[q0-64*j0+wid*QBLK+r32];
  CINIT(pA0,pA1,0); qkt(pA0,pA1,Kbase,qr,r32,hi);asm volatile("s_nop 15\n\ts_nop 7":"+v"(pA0),"+v"(pA1));CMASK(pA0,pA1,0);
  START(pA0,pA1);
  _Pragma("unroll") for(int r=0;r<16;++r)pA1[r]=__builtin_amdgcn_exp2f(pA1[r]);
  WAIT_BAR(0);
  DMA_K(3,0);DMA_V(1,SLOTB);
  ROT();
  kload8(kf,kp0+sl_cur);
  WAIT_BAR(2);
  s16x4 vlo[8],vhi[8]; u32x4 pw0,pw1,pw2,pw3;
  #define PKW(P,B) cvtpk_s(P[B],P[B+1])
  #define PAF(k) __builtin_bit_cast(bf16x8,pw##k)
  #define VFR(i) (bf16x8){vlo[i][0],vlo[i][1],vlo[i][2],vlo[i][3],vhi[i][0],vhi[i][1],vhi[i][2],vhi[i][3]}
  #define PIN(x) asm volatile("":"+v"(x))
  #define MX3(a,b,c) __builtin_fmaxf(__builtin_fmaxf((a),(b)),(c))
  #define GAPA(MF,A0,A1,A2,A3,W0,W1,PW) do{ MF; sacc+=A0; sacc+=A1; sacc+=A2; sacc+=A3; PIN(sacc); W0; W1; PIN(PW); SBAR(); }while(0)
  #define EX(v) __builtin_amdgcn_exp2f(v)
  #define GAPB(MF,X,B) do{ MF; X[B]=EX(X[B]); X[B+1]=EX(X[B+1]); X[B+2]=EX(X[B+2]); X[B+3]=EX(X[B+3]); PIN(X); SBAR(); }while(0)
  #define VRD(i) do{ vlo[i]=vtr(vp_+(((i)>>2)*4096+((i)&3)*1024)); vhi[i]=vtr(vp_+(((i)>>2)*4096+((i)&3)*1024+512)); }while(0)
  #define KRD(G,j) do{ if(G){ kload2(kf,kp0+sl_next,j); SBAR(); } }while(0)
  #define STEP(C0,C1,P0,P1,t,GK,GV,GL) do{ SBAR(); CINIT(C0,C1,t); SBAR(); \
    const lds_cptr vp_=vp0+sl_prev; \
    VRD(0); SBAR(); float sacc=(P0[0]+P0[1]); \
    GAPA(C0=__builtin_amdgcn_mfma_f32_32x32x16_bf16(kf[0],qr[0],C0,0,0,0), P0[2],P0[3],P0[4],P0[5],     pw0[0]=PKW(P0,0), pw0[1]=PKW(P0,2), pw0); \
    VRD(4); SBAR(); GAPA(C1=__builtin_amdgcn_mfma_f32_32x32x16_bf16(kf[1],qr[0],C1,0,0,0), P0[6],P0[7],P0[8],P0[9],     pw0[2]=PKW(P0,4), pw0[3]=PKW(P0,6), pw0); \
    VRD(1); SBAR(); GAPA(C0=__builtin_amdgcn_mfma_f32_32x32x16_bf16(kf[2],qr[1],C0,0,0,0),   P0[10],P0[11],P0[12],P0[13], pw1[0]=PKW(P0,8), pw1[1]=PKW(P0,10), pw1); \
    VRD(5); SBAR(); GAPA(C1=__builtin_amdgcn_mfma_f32_32x32x16_bf16(kf[3],qr[1],C1,0,0,0),   P0[14],P0[15],P1[0],P1[1],   pw1[2]=PKW(P0,12),pw1[3]=PKW(P0,14), pw1); \
    VRD(2); SBAR(); GAPA(C0=__builtin_amdgcn_mfma_f32_32x32x16_bf16(kf[4],qr[2],C0,0,0,0),   P1[2],P1[3],P1[4],P1[5],     pw2[0]=PKW(P1,0), pw2[1]=PKW(P1,2), pw2); \
    VRD(6); SBAR(); GAPA(C1=__builtin_amdgcn_mfma_f32_32x32x16_bf16(kf[5],qr[2],C1,0,0,0),   P1[6],P1[7],P1[8],P1[9],     pw2[2]=PKW(P1,4), pw2[3]=PKW(P1,6), pw2); \
    VRD(3); SBAR(); GAPA(C0=__builtin_amdgcn_mfma_f32_32x32x16_bf16(kf[6],qr[3],C0,0,0,0),   P1[10],P1[11],P1[12],P1[13], pw3[0]=PKW(P1,8), pw3[1]=PKW(P1,10), pw3); \
    VRD(7); SBAR(); GAPA(C1=__builtin_amdgcn_mfma_f32_32x32x16_bf16(kf[7],qr[3],C1,0,0,0),   P1[14],P1[15],0.f,0.f,       pw3[2]=PKW(P1,12),pw3[3]=PKW(P1,14), pw3); \
    l_reg+=sacc; \
    if(GK){DMA_K((t)+3,sl_cur);} if(GV){DMA_V((t)+1,sl_next);} \
    CMASK(C0,C1,t); \
    { float a=MX3(C0[0],C0[1],C1[0]),b=MX3(C0[2],C0[3],C1[1]); a=MX3(a,C1[2],C1[3]); \
      _Pragma("unroll") for(int r=4;r<16;r+=4){a=MX3(a,C0[r],C0[r+1]);b=MX3(b,C0[r+2],C0[r+3]);a=MX3(a,C1[r],C1[r+1]);b=MX3(b,C1[r+2],C1[r+3]);} \
      float rm=__builtin_fmaxf(a,b); { auto rr=__builtin_amdgcn_permlane32_swap(__float_as_uint(rm),__float_as_uint(rm),false,false); rm=__builtin_fmaxf(__uint_as_float(rr[0]),__uint_as_float(rr[1])); } \
      resc=false; \
      if(__builtin_expect(__any(rm>(float)THRL),0)){ const float dl=__builtin_fmaxf(rm,0.f); base-=dl; \
        _Pragma("unroll") for(int r=0;r<16;++r){C0[r]-=dl;C1[r]-=dl;} \
        const float f=__builtin_amdgcn_exp2f(-dl); l_reg*=f; if(hi==0)wsf[r32]=f; resc=true; } } \
    SBAR(); \
    GAPB(o[0]=__builtin_amdgcn_mfma_f32_32x32x16_bf16(PAF(0),VFR(0),o[0],0,0,0), C0,0); \
    GAPB(o[1]=__builtin_amdgcn_mfma_f32_32x32x16_bf16(PAF(0),VFR(4),o[1],0,0,0), C0,4); \
    KRD(GL,0); GAPB(o[0]=__builtin_amdgcn_mfma_f32_32x32x16_bf16(PAF(1),VFR(1),o[0],0,0,0), C0,8); \
    KRD(GL,1); GAPB(o[1]=__builtin_amdgcn_mfma_f32_32x32x16_bf16(PAF(1),VFR(5),o[1],0,0,0), C0,12); \
    KRD(GL,2); GAPB(o[0]=__builtin_amdgcn_mfma_f32_32x32x16_bf16(PAF(2),VFR(2),o[0],0,0,0), C1,0); \
    KRD(GL,3); GAPB(o[1]=__builtin_amdgcn_mfma_f32_32x32x16_bf16(PAF(2),VFR(6),o[1],0,0,0), C1,4); \
    GAPB(o[0]=__builtin_amdgcn_mfma_f32_32x32x16_bf16(PAF(3),VFR(3),o[0],0,0,0), C1,8); \
    GAPB(o[1]=__builtin_amdgcn_mfma_f32_32x32x16_bf16(PAF(3),VFR(7),o[1],0,0,0), C1,12); \
    }while(0)
  int t=1;
  #undef CMASK
  #define CMASK(P0,P1,t) do{}while(0)
  for(;t+5<NT;t+=2){
    STEP(pB0,pB1,pA0,pA1,t,true,true,true);     WAIT_BAR(2); RESC(); ROT();
    STEP(pA0,pA1,pB0,pB1,t+1,true,true,true);   WAIT_BAR(2); RESC(); ROT();
  }
  #undef CMASK
  #define CMASK(P0,P1,t) do{int jb_=(t)-(NT-4); if(jb_>=0)cmask(P0,P1,jb_,qrel,hi);}while(0)
  #define ENDW(tt) do{ if((tt)+3<NT){WAIT_BAR(2);} else if((tt)+2<NT){WAIT_BAR(1);} else {WAIT_BAR(0);} }while(0)
  for(;t+1<NT;t+=2){
    STEP(pB0,pB1,pA0,pA1,t,(t+3<NT),(t+1<NT),(t+1<NT));       ENDW(t);   RESC(); ROT();
    STEP(pA0,pA1,pB0,pB1,t+1,(t+4<NT),(t+2<NT),(t+2<NT));     ENDW(t+1); RESC(); ROT();
  }
  STEP(pB0,pB1,pA0,pA1,NT-1,false,false,false); RESC();
  { float sacc=pB0[0]+pB0[1]; _Pragma("unroll") for(int r=2;r<16;++r)sacc+=pB0[r]; _Pragma("unroll") for(int r=0;r<16;++r)sacc+=pB1[r]; l_reg+=sacc;
    pw0=(u32x4){PKW(pB0,0),PKW(pB0,2),PKW(pB0,4),PKW(pB0,6)};pw1=(u32x4){PKW(pB0,8),PKW(pB0,10),PKW(pB0,12),PKW(pB0,14)};pw2=(u32x4){PKW(pB1,0),PKW(pB1,2),PKW(pB1,4),PKW(pB1,6)};pw3=(u32x4){PKW(pB1,8),PKW(pB1,10),PKW(pB1,12),PKW(pB1,14)};
    SBAR(); pv(o,vb0+sl_cur,PAF(0),PAF(1),PAF(2),PAF(3)); }
  #undef PKW
  #undef PAF
  #undef VFR
  #undef PIN
  #undef MX3
  #undef GAPA
  #undef GAPB
  #undef EX
  #undef VRD
  #undef KRD
  #undef STEP
  #undef ENDW
  {auto rr=__builtin_amdgcn_permlane32_swap(__float_as_uint(l_reg),__float_as_uint(l_reg),false,false);l_reg=__uint_as_float(rr[0])+__uint_as_float(rr[1]);}
  if(hi==0)wsf[32+r32]=l_reg;asm volatile("s_waitcnt lgkmcnt(0)":::"memory");
  float rli[16];
  #pragma unroll
  for(int r=0;r<16;++r)rli[r]=__builtin_amdgcn_rcpf(wsf[32+crow(r,hi)]);
  bf16*Ow=O+(rowbase+q0+wid*QBLK)*DMO;
  { bf16*stg=(bf16*)(shm+LDS_OST)+wid*2048;
    #pragma unroll
    for(int r=0;r<16;++r){const int orow=crow(r,hi);
      #pragma unroll
      for(int d0=0;d0<2;++d0)stg[orow*64+d0*32+r32]=__float2bfloat16(o[d0][r]*rli[r]);}
    asm volatile("s_waitcnt lgkmcnt(0)":::"memory");
    #pragma unroll
    for(int i=0;i<4;++i){const int row=i*8+(lane>>3),ch=lane&7; const u32x4 v=*(const u32x4*)(stg+row*64+ch*8); ATTN_STORE16(Ow+(long)row*DMO+ch*8,head_rms(v));} }
  asm volatile("s_waitcnt lgkmcnt(0)\n\ts_barrier":::"memory");
  #undef DMA_K
  #undef DMA_V
  #undef CMASK
  #undef CINIT
  #undef START
  #undef RESC
  #undef ROT
}
__device__ __forceinline__ float sp2f(float z){ const float e=__builtin_amdgcn_exp2f(-__builtin_fabsf(z)); return __builtin_fmaxf(z,0.f)+__builtin_amdgcn_logf(1.f+e); }
__device__ __forceinline__ void sb_unit(int b,int qb,const bf16*Q,const bf16*__restrict__ K,const bf16*__restrict__ V,bf16*O,char*shm){
  int tid_=threadIdx.x; asm volatile("":"+v"(tid_)); const int tid=tid_,lane=tid&63,r32=lane&31,hi=lane>>5; const int wid=__builtin_amdgcn_readfirstlane(tid>>6);
  const long rowbase=(long)b*SEQ; const int q0=qb*QB;
  const bf16*Qw=Q+(rowbase+q0+wid*QBLK)*DM;
  const bf16*Kh=K+rowbase*DM,*Vh=V+rowbase*DM;
  const unsigned lds0=(unsigned)(uintptr_t)shm; const lds_cptr shm3=(lds_cptr)shm;
  const bf16*ksrc=Kh+(long)lane*DM+wid*8;
  const bf16*vsrc=Vh+(long)(16*(wid&3)+(lane>>2))*DM+(wid>>2)*32+(lane&3)*8;
  const unsigned kdst=lds0+LDS_K+wid*1024, vdst=lds0+LDS_V+wid*1024;
  #define DMA_K(t,slot) glds16(ksrc+(long)(t)*KVBLK*DM,(unsigned)__builtin_amdgcn_readfirstlane(kdst+(slot)))
  #define DMA_V(t,slot) glds16(vsrc+(long)(t)*KVBLK*DM,(unsigned)__builtin_amdgcn_readfirstlane(vdst+(slot)))
  const int vb0=(int)(lds0+LDS_V)+((lane>>4)&1)*32+(lane&3)*8+(4*hi+((lane&15)>>2))*64;
  typedef __attribute__((address_space(3))) unsigned lds_u32;
  volatile lds_u32*flags=(volatile lds_u32*)(shm3+LDS_FLAGS);
  bf16x8 qr[4];
  #pragma unroll
  for(int d0=0;d0<4;++d0)qr[d0]=*reinterpret_cast<const bf16x8*>(&Qw[(long)r32*DM+d0*16+hi*8]);
  asm volatile("":::"memory");
  f32x16 o[2];o[0]=f32x16{};o[1]=f32x16{};
  float R=1.f; const int qabs=q0+wid*QBLK+r32; bool done=false;
  const int jtop=4*qb+3;
  DMA_K(jtop,0);DMA_V(jtop,0); DMA_K(jtop-1,SLOTB);DMA_V(jtop-1,SLOTB);
  int slot=0,slot2=2*SLOTB,bank=0;
  for(int j=jtop;j>=0;--j){
    if(j>0){ WAIT_BAR(2); } else { WAIT_BAR(0); }
    if(j<jtop){ unsigned alld=1u;
      #pragma unroll
      for(int w=0;w<NW;++w)alld&=flags[(bank^8)+w];
      if(alld)break; }
    if(j>=2){ DMA_K(j-2,slot2);DMA_V(j-2,slot2); }
    const bool active=(!done)&&(64*j<q0+wid*QBLK+31);
    if(active){
      f32x16 p0=f32x16{},p1=f32x16{};
      qkt(p0,p1,shm+LDS_K+slot,qr,r32,hi);
      const int kvb=64*j+4*hi; f32x16 s0,s1;
      if(64*j+63<q0+wid*QBLK){
        #pragma unroll
        for(int r=0;r<16;++r){
          const float e0=__builtin_amdgcn_exp2f(__builtin_fminf(p0[r],80.f)), e1=__builtin_amdgcn_exp2f(__builtin_fminf(p1[r],80.f));
          const float r0=__builtin_amdgcn_rcpf(1.f+e0), r1=__builtin_amdgcn_rcpf(1.f+e1);
          p0[r]=e0*r0; p1[r]=e1*r1; s0[r]=r0; s1[r]=r1; }
      } else {
        #pragma unroll
        for(int r=0;r<16;++r){ const int kv=kvb+(r&3)+8*(r>>2);
          const float e0=__builtin_amdgcn_exp2f(__builtin_fminf(p0[r],80.f)), e1=__builtin_amdgcn_exp2f(__builtin_fminf(p1[r],80.f));
          const float r0=__builtin_amdgcn_rcpf(1.f+e0), r1=__builtin_amdgcn_rcpf(1.f+e1);
          const bool v0=kv<qabs, v1=kv+32<qabs;
          p0[r]=v0?e0*r0:0.f; p1[r]=v1?e1*r1:0.f; s0[r]=v0?r0:1.f; s1[r]=v1?r1:1.f; }
      }
      float g0[4],g1[4],og0[4],og1[4],T0[4],T1[4];
      #pragma unroll
      for(int g=0;g<4;++g){ g0[g]=(s0[4*g]*s0[4*g+1])*(s0[4*g+2]*s0[4*g+3]); g1[g]=(s1[4*g]*s1[4*g+1])*(s1[4*g+2]*s1[4*g+3]); }
      #pragma unroll
      for(int g=0;g<4;++g){ og0[g]=__shfl_xor(g0[g],32); og1[g]=__shfl_xor(g1[g],32); }
      float run=R;
      #pragma unroll
      for(int g=3;g>=0;--g){ const float ah1=hi?g1[g]:og1[g], ah0=hi?og1[g]:g1[g]; const float t1=run; run*=ah1; const float t0=run; run*=ah0; T1[g]=hi?t1:t0; }
      #pragma unroll
      for(int g=3;g>=0;--g){ const float ah1=hi?g0[g]:og0[g], ah0=hi?og0[g]:g0[g]; const float t1=run; run*=ah1; const float t0=run; run*=ah0; T0[g]=hi?t1:t0; }
      R=run;
      #pragma unroll
      for(int g=0;g<4;++g){ float a0=T0[g],a1=T1[g];
        #pragma unroll
        for(int i=3;i>=0;--i){ const int r=4*g+i; p0[r]*=a0; p1[r]*=a1; a0*=s0[r]; a1*=s1[r]; } }
      u32x4 pw0,pw1,pw2,pw3;
      pw0=(u32x4){cvtpk_s(p0[0],p0[1]),cvtpk_s(p0[2],p0[3]),cvtpk_s(p0[4],p0[5]),cvtpk_s(p0[6],p0[7])};
      pw1=(u32x4){cvtpk_s(p0[8],p0[9]),cvtpk_s(p0[10],p0[11]),cvtpk_s(p0[12],p0[13]),cvtpk_s(p0[14],p0[15])};
      pw2=(u32x4){cvtpk_s(p1[0],p1[1]),cvtpk_s(p1[2],p1[3]),cvtpk_s(p1[4],p1[5]),cvtpk_s(p1[6],p1[7])};
      pw3=(u32x4){cvtpk_s(p1[8],p1[9]),cvtpk_s(p1[10],p1[11]),cvtpk_s(p1[12],p1[13]),cvtpk_s(p1[14],p1[15])};
      pv(o,vb0+slot,__builtin_bit_cast(bf16x8,pw0),__builtin_bit_cast(bf16x8,pw1),__builtin_bit_cast(bf16x8,pw2),__builtin_bit_cast(bf16x8,pw3));
      done=__all(R<1.0e-37f)!=0;
    }
    if(lane==0)flags[bank+wid]=done?1u:0u;
    bank^=8; slot=(slot==2*SLOTB)?0:slot+SLOTB; slot2=(slot2==2*SLOTB)?0:slot2+SLOTB;
  }
  asm volatile("s_waitcnt vmcnt(0)":::"memory");
  bf16*Ow=O+(rowbase+q0+wid*QBLK)*DMO;
  { bf16*stg=(bf16*)(shm+LDS_OST)+wid*2048;
    #pragma unroll
    for(int r=0;r<16;++r){const int orow=crow(r,hi);
      #pragma unroll
      for(int d0=0;d0<2;++d0)stg[orow*64+d0*32+r32]=__float2bfloat16(o[d0][r]);}
    asm volatile("s_waitcnt lgkmcnt(0)":::"memory");
    #pragma unroll
    for(int i=0;i<4;++i){const int row=i*8+(lane>>3),ch=lane&7; const u32x4 v=*(const u32x4*)(stg+row*64+ch*8); ATTN_STORE16(Ow+(long)row*DMO+ch*8,head_rms(v));} }
  asm volatile("s_waitcnt vmcnt(0) lgkmcnt(0)\n\ts_barrier":::"memory");
  #undef DMA_K
  #undef DMA_V
}
#undef SBAR
#undef WAIT_BAR
}
namespace cg = cooperative_groups;
constexpr int NWAVES = 8;
constexpr int DMODEL = 1024, NBATCH = 4, SEQ_IN = 8192, NMETA = 16, LREAL = NMETA + SEQ_IN, LP = 8448  ;
constexpr int MROWS = NBATCH * LP;
constexpr int MREAL = NBATCH * SEQ_IN;
constexpr int INW = 2566, NINP = 2560, NIN = 2816, DFF = 2816, NGU = 2 * DFF, DEPTH = 2, NFH = 6;
constexpr float C2F = 0.125f * 1.4426950408889634f;
constexpr int PC_U = 0, PC_FQ = 256, PC_FK = 640, PC_FV = 1024, PC_SQ = 1408, PC_SK = 1792, PC_SV = 2176;
constexpr size_t MiB = 1u << 20;
constexpr size_t WS_CTL = 0, CTL_ZERO_BYTES = 1 * MiB;
constexpr size_t WS_SS = 64 * 1024;
constexpr size_t WS_W = 1 * MiB, W_LAYER = 24 * MiB, W_IN = 0, W_OUT = (size_t)NIN * 1024 * 2, W_GU = W_OUT + 2 * MiB, W_D = W_GU + (size_t)NGU * 1024 * 2;
constexpr size_t WS_LF = 49 * MiB, WS_CS = 51 * MiB, WS_H = 52 * MiB, WS_HB = 184 * MiB, WS_Y = 250 * MiB, WS_P = 316 * MiB, WS_END = WS_P + (size_t)MROWS * DFF * 2;
static_assert(W_D + (size_t)1024 * DFF * 2 <= W_LAYER && WS_W + 2 * W_LAYER <= WS_LF && WS_SS + 5 * (size_t)MROWS * 4 <= CTL_ZERO_BYTES, "ws map");
static_assert(WS_H + (size_t)MROWS * 1024 * 4 <= WS_HB && WS_HB + (size_t)MROWS * 1024 * 2 <= WS_Y && WS_Y + (size_t)MROWS * 1024 * 2 <= WS_P && WS_END <= 512 * MiB, "ws map");
constexpr int LDS_BYTES = 147456;
constexpr int LDS_MISC = 131072;

#define LAS __attribute__((address_space(3)))
typedef unsigned short bf16u;
typedef unsigned v4u __attribute__((ext_vector_type(4)));
typedef float f32x4 __attribute__((ext_vector_type(4)));
#define LDS_WAIT() asm volatile("s_waitcnt lgkmcnt(0)" ::: "memory")
__device__ __forceinline__ unsigned f2bf(float f) { unsigned u = __builtin_bit_cast(unsigned, f); return (u + 0x7fffu + ((u >> 16) & 1u)) >> 16; }
__device__ __forceinline__ unsigned pk2(float lo, float hi) { return f2bf(lo) | (f2bf(hi) << 16); }
__device__ __forceinline__ float wave_sum(float v) {
#pragma unroll
    for (int o = 1; o < 64; o <<= 1) v += __shfl_xor(v, o);
    return v;
}

struct Args { const float* in[15]; float* out; unsigned char* ws; };

struct WinSrc { const float* w; const float* g;
    __device__ __forceinline__ float operator()(int k, int n) const { if (n >= INW) return 0.f; const int col = n < 1408 ? n : (n < 2560 ? n + 6 : n - 2560 + 1408);
        const float sc = ((n >= PC_FQ && n < PC_FK) || (n >= PC_SQ && n < PC_SK)) ? C2F : 1.0f; return w[(size_t)k * INW + col] * g[k] * sc; } };
struct WoutSrc { const float* w; const float* fg; const float* sg;
    __device__ __forceinline__ float operator()(int k, int n) const { const float gn = k < 640 ? fg[k - 256] : sg[k - 640]; return w[(size_t)k * 1024 + n] * gn; } };
struct WguSrc { const float* wg; const float* wu; const float* g;
    __device__ __forceinline__ float operator()(int k, int c) const { const int pn = c >> 8, w = c & 255, j = pn * 128 + (w & 127); const long dlt = (w >> 7) ? (long)(wu - wg) : 0L; return wg[(long)k * DFF + j + dlt] * g[k]; } };
struct WdSrc { const float* w;
    __device__ __forceinline__ float operator()(int k, int n) const { return w[(size_t)k * 1024 + n]; } };
template <class F> __device__ __forceinline__ void conv_item(const F src, bf16u* WT, int K, int k0, int n0, LAS float* scr, int lane) {
    float tv[32];
#pragma unroll
    for (int i = 0; i < 32; ++i) tv[i] = src(k0 + 2 * i + (lane >> 5), n0 + (lane & 31));
#pragma unroll
    for (int i = 0; i < 32; ++i) scr[(2 * i + (lane >> 5)) * 33 + (lane & 31)] = tv[i];
    LDS_WAIT(); asm volatile("" ::: "memory");
    const int c = lane & 7;
#pragma unroll
    for (int j = 0; j < 4; ++j) { const int n = (lane >> 3) + 8 * j; const LAS float* s = scr + (8 * c) * 33 + n;
        v4u o; o.x = pk2(s[0 * 33], s[1 * 33]); o.y = pk2(s[2 * 33], s[3 * 33]); o.z = pk2(s[4 * 33], s[5 * 33]); o.w = pk2(s[6 * 33], s[7 * 33]);
        *(v4u*)(WT + (size_t)(n0 + n) * K + k0 + 8 * c) = o; }
    LDS_WAIT(); asm volatile("" ::: "memory");
}
__device__ __forceinline__ void fold_block_item(const float* wout, const float* pw, const float* ps, bf16u* WT, int item, LAS float* lds, int tid) {
    const int g = item >> 4, n0 = (item & 15) * 64;
    LAS float* At = lds; LAS float* Wt = lds + 4096;
    for (int i = tid; i < 4096; i += NWAVES * 64) { At[(i & 63) * 64 + (i >> 6)] = pw[(size_t)g * 4096 + i]; const int d = i >> 6; Wt[i] = wout[(size_t)(g * 64 + d) * 1024 + n0 + (i & 63)] * ps[g * 64 + d]; }
    __syncthreads();
    const int c0 = (tid >> 6) * 8, nn = tid & 63; f32x4 a0 = (f32x4){0.f, 0.f, 0.f, 0.f}, a1 = a0;
#pragma unroll 8
    for (int d = 0; d < 64; ++d) { const float w = Wt[d * 64 + nn]; a0 += *(const LAS f32x4*)(At + d * 64 + c0) * w; a1 += *(const LAS f32x4*)(At + d * 64 + c0 + 4) * w; }
    v4u o; o.x = pk2(a0[0], a0[1]); o.y = pk2(a0[2], a0[3]); o.z = pk2(a1[0], a1[1]); o.w = pk2(a1[2], a1[3]);
    *(v4u*)(WT + (size_t)(n0 + nn) * 1024 + g * 64 + c0) = o;
    __syncthreads();
}
__device__ __forceinline__ void p0_prologue(const Args& A, unsigned char* ws, LAS unsigned char* lds, int wave, int lane) {
    LAS float* scr = (LAS float*)(lds + wave * 16384);
    const int gw = blockIdx.x * NWAVES + wave, NGW = gridDim.x * NWAVES;
    constexpr int I_IN = 16 * (NIN / 32), I_OUT = 12 * 32, I_GU = 16 * (NGU / 32), I_D = (DFF / 64) * 32, I_L = I_IN + I_OUT + I_GU + I_D;
    for (int bi = blockIdx.x; bi < DEPTH * 64; bi += gridDim.x) { const int L = bi >> 6;
        fold_block_item(A.in[9] + (size_t)L * 1024 * 1024, A.in[5] + (size_t)L * 4 * 64 * 64, A.in[6] + L * 256, (bf16u*)(ws + WS_W + (size_t)L * W_LAYER + W_OUT), bi & 63, (LAS float*)lds, wave * 64 + lane); }
    for (int it = gw; it < DEPTH * I_L; it += NGW) {
        const int L = it / I_L; int r = it % I_L;
        bf16u* wb = (bf16u*)(ws + WS_W + (size_t)L * W_LAYER);
        if (r < I_IN) { WinSrc s{A.in[3] + (size_t)L * 1024 * INW, A.in[2] + L * 1024}; conv_item(s, (bf16u*)((unsigned char*)wb + W_IN), 1024, (r / (NIN / 32)) * 64, (r % (NIN / 32)) * 32, scr, lane); continue; } r -= I_IN;
        if (r < I_OUT) { WoutSrc s{A.in[9] + (size_t)L * 1024 * 1024, A.in[7] + L * 384, A.in[8] + L * 384}; conv_item(s, (bf16u*)((unsigned char*)wb + W_OUT), 1024, 256 + (r / 32) * 64, (r % 32) * 32, scr, lane); continue; } r -= I_OUT;
        if (r < I_GU) { WguSrc s{A.in[11] + (size_t)L * 1024 * DFF, A.in[12] + (size_t)L * 1024 * DFF, A.in[10] + L * 1024}; conv_item(s, (bf16u*)((unsigned char*)wb + W_GU), 1024, (r / (NGU / 32)) * 64, (r % (NGU / 32)) * 32, scr, lane); continue; } r -= I_GU;
        { WdSrc s{A.in[13] + (size_t)L * DFF * 1024}; conv_item(s, (bf16u*)((unsigned char*)wb + W_D), DFF, (r / 32) * 64, (r % 32) * 32, scr, lane); }
    }
    bf16u* hb = (bf16u*)(ws + WS_HB); float* ss0 = (float*)(ws + WS_SS);
    for (int m0 = gw * 4; m0 < MROWS; m0 += NGW * 4) {
        f32x4 v[4][4]; float s[4];
#pragma unroll
        for (int q = 0; q < 4; ++q) { const int m = m0 + q, b = m / LP, t = m % LP; s[q] = 0.f;
            if (t < LREAL) { const f32x4* src = (const f32x4*)(t < NMETA ? A.in[1] + (size_t)t * 1024 : A.in[0] + ((size_t)b * SEQ_IN + (t - NMETA)) * 1024) + lane;
#pragma unroll
                for (int j = 0; j < 4; ++j) v[q][j] = src[64 * j]; }
            else {
#pragma unroll
                for (int j = 0; j < 4; ++j) v[q][j] = (f32x4){0.f, 0.f, 0.f, 0.f}; } }
#pragma unroll
        for (int q = 0; q < 4; ++q) { const int m = m0 + q;
#pragma unroll
            for (int j = 0; j < 4; ++j) s[q] += (v[q][j].x * v[q][j].x + v[q][j].y * v[q][j].y) + (v[q][j].z * v[q][j].z + v[q][j].w * v[q][j].w);
            s[q] = wave_sum(s[q]);
            unsigned long long* bo = (unsigned long long*)(hb + (size_t)m * 1024) + lane;
#pragma unroll
            for (int j = 0; j < 4; ++j) bo[64 * j] = (unsigned long long)pk2(v[q][j].x, v[q][j].y) | ((unsigned long long)pk2(v[q][j].z, v[q][j].w) << 32);
            if (lane == 0) ss0[m] = s[q]; }
    }
}
typedef short bf16x8m __attribute__((ext_vector_type(8)));
template <int NBK> __device__ __forceinline__ void mini_item(f32x4 (&acc)[NBK], const bf16u* A16, const bf16u* Bt0, const bf16u* Bt1, int K, LAS unsigned char* lds, int wave, int lane) {
    const int fr = lane & 15, fq = lane >> 4, kw = K >> 3; const size_t o = (size_t)fr * K + wave * kw + 8 * fq;
#pragma unroll
    for (int nb = 0; nb < NBK; ++nb) acc[nb] = (f32x4){0.f, 0.f, 0.f, 0.f};
    for (int k = 0; k < kw; k += 32) { const bf16x8m a = *(const bf16x8m*)(A16 + o + k); const bf16x8m b0 = *(const bf16x8m*)(Bt0 + o + k);
        acc[0] = __builtin_amdgcn_mfma_f32_16x16x32_bf16(b0, a, acc[0], 0, 0, 0);
        if (NBK == 2) { const bf16x8m b1 = *(const bf16x8m*)(Bt1 + o + k); acc[NBK - 1] = __builtin_amdgcn_mfma_f32_16x16x32_bf16(b1, a, acc[NBK - 1], 0, 0, 0); } }
    LAS f32x4* red = (LAS f32x4*)lds;
#pragma unroll
    for (int nb = 0; nb < NBK; ++nb) red[(nb * 8 + wave) * 64 + lane] = acc[nb];
    __syncthreads();
    if (wave == 0) {
#pragma unroll
        for (int nb = 0; nb < NBK; ++nb) { f32x4 s = red[(nb * 8) * 64 + lane];
#pragma unroll
            for (int w = 1; w < 8; ++w) s += red[(nb * 8 + w) * 64 + lane];
            acc[nb] = s; } }
    __syncthreads();
}
__device__ __forceinline__ void mini_in(unsigned char* ws, const bf16u* wt, const float* ss, const float* fb, LAS unsigned char* lds, int wave, int lane) {
    const bf16u* A16 = (const bf16u*)(ws + WS_HB); bf16u* P = (bf16u*)(ws + WS_P); float* LF = (float*)(ws + WS_LF);
    for (int it = blockIdx.x; it < 161; it += gridDim.x) { const int n0 = it * 16; f32x4 acc[1];
        mini_item<1>(acc, A16, wt + (size_t)n0 * 1024, nullptr, 1024, lds, wave, lane);
        if (wave == 0) { const int fr = lane & 15, fq = lane >> 4; const float rs = __builtin_amdgcn_rsqf(ss[fr] * (1.0f / 1024.0f) + 1e-6f); const f32x4 v = acc[0] * rs;
            if (n0 < NINP) { const unsigned long long w = (unsigned long long)pk2(v[0], v[1]) | ((unsigned long long)pk2(v[2], v[3]) << 32);
#pragma unroll
                for (int b = 0; b < NBATCH; ++b) *(unsigned long long*)(P + ((size_t)b * LP + fr) * NINP + n0 + 4 * fq) = w; }
            else if (fq < 2) { f32x4 l;
#pragma unroll
                for (int i = 0; i < 4; ++i) { const int c = 4 * fq + i; const float x = v[i] + fb[c < NFH ? c : 0]; l[i] = c < NFH ? -(fmaxf(-x, 0.f) + log1pf(expf(-fabsf(x)))) * 1.4426950408889634f : 0.f; }
#pragma unroll
                for (int b = 0; b < NBATCH; ++b) *(f32x4*)(LF + ((size_t)b * LP + fr) * 8 + 4 * fq) = l; } }
    }
}
__device__ __forceinline__ void mini_res(unsigned char* ws, const bf16u* A16, const bf16u* wt, int K, float* ssn, LAS unsigned char* lds, int wave, int lane) {
    bf16u* hb = (bf16u*)(ws + WS_HB);
    for (int it = blockIdx.x; it < 64; it += gridDim.x) { const int n0 = it * 16; f32x4 acc[1];
        mini_item<1>(acc, A16, wt + (size_t)n0 * K, nullptr, K, lds, wave, lane);
        if (wave == 0) { const int fr = lane & 15, fq = lane >> 4; unsigned long long* bp = (unsigned long long*)(hb + (size_t)fr * 1024 + n0 + 4 * fq); const unsigned long long r = *bp; const unsigned rl = (unsigned)r, rh = (unsigned)(r >> 32);
            const f32x4 a = (f32x4){__uint_as_float(rl << 16), __uint_as_float(rl & 0xffff0000u), __uint_as_float(rh << 16), __uint_as_float(rh & 0xffff0000u)} + acc[0];
            *bp = (unsigned long long)pk2(a[0], a[1]) | ((unsigned long long)pk2(a[2], a[3]) << 32);
            float s = (a[0] * a[0] + a[1] * a[1]) + (a[2] * a[2] + a[3] * a[3]); s += __shfl_xor(s, 16); s += __shfl_xor(s, 32);
            if (fq == 0) atomicAdd(ssn + fr, s); }
    }
}
__device__ __forceinline__ void mini_gu(unsigned char* ws, const bf16u* wt, const float* ss, LAS unsigned char* lds, int wave, int lane) {
    const bf16u* A16 = (const bf16u*)(ws + WS_HB); bf16u* H = (bf16u*)(ws + WS_P);
    for (int it = blockIdx.x; it < DFF / 16; it += gridDim.x) { const int j0 = it * 16, cg = (j0 >> 7) * 256 + (j0 & 127); f32x4 acc[2];
        mini_item<2>(acc, A16, wt + (size_t)cg * 1024, wt + (size_t)(cg + 128) * 1024, 1024, lds, wave, lane);
        if (wave == 0) { const int fr = lane & 15, fq = lane >> 4; const float rs = __builtin_amdgcn_rsqf(ss[fr] * (1.0f / 1024.0f) + 1e-6f); float o[4];
#pragma unroll
            for (int i = 0; i < 4; ++i) { const float g = acc[0][i] * rs, up = acc[1][i] * rs; o[i] = g * __builtin_amdgcn_rcpf(1.0f + __builtin_amdgcn_exp2f(-1.4426950408889634f * g)) * up; }
            *(unsigned long long*)(H + (size_t)fr * DFF + j0 + 4 * fq) = (unsigned long long)pk2(o[0], o[1]) | ((unsigned long long)pk2(o[2], o[3]) << 32); }
    }
}
__device__ __forceinline__ void fl_phase(unsigned char* ws, const bf16u* wt  , const float* ss, const float* fb, int wave, int lane) {
    const bf16u* HBp = (const bf16u*)(ws + WS_HB); float* LF = (float*)(ws + WS_LF);
    const int fr = lane & 15, fq = lane >> 4;
    for (int it = blockIdx.x * NWAVES + wave; it < MREAL / 16; it += gridDim.x * NWAVES) {
        const int m0 = it * 16, row0 = (m0 / SEQ_IN) * LP + NMETA + (m0 % SEQ_IN);
        const bf16u* ap = HBp + (size_t)(row0 + fr) * 1024 + 8 * fq; const bf16u* bp = wt + (size_t)fr * 1024 + 8 * fq;
        f32x4 acc = (f32x4){0.f, 0.f, 0.f, 0.f};
#pragma unroll 8
        for (int k = 0; k < 1024; k += 32) { const bf16x8m a = *(const bf16x8m*)(ap + k); const bf16x8m b = *(const bf16x8m*)(bp + k); acc = __builtin_amdgcn_mfma_f32_16x16x32_bf16(b, a, acc, 0, 0, 0); }
        if (fq < 2) { const int row = row0 + fr; const float rs = __builtin_amdgcn_rsqf(ss[row] * (1.0f / 1024.0f) + 1e-6f); f32x4 l;
#pragma unroll
            for (int i = 0; i < 4; ++i) { const int c = 4 * fq + i; const float x = acc[i] * rs + fb[c < NFH ? c : 0]; l[i] = c < NFH ? -(fmaxf(-x, 0.f) + log1pf(expf(-fabsf(x)))) * 1.4426950408889634f : 0.f; }
            *(f32x4*)(LF + (size_t)row * 8 + 4 * fq) = l; }
    }
}
__device__ __forceinline__ void pool_scan_phase(unsigned char* ws, LAS unsigned char* lds, unsigned* nrm, int tid, int wave, int lane) {
    const float* LF = (const float*)(ws + WS_LF); float* CS = (float*)(ws + WS_CS);
    if (blockIdx.x < NBATCH * NFH) {
        const int b = blockIdx.x / NFH, hf = blockIdx.x % NFH; constexpr int PER = 17;
        const float* lf = LF + (size_t)b * LP * 8 + hf; float* cs = CS + (size_t)(b * NFH + hf) * LP;
        float v[PER]; float s = 0.f; const int t0 = tid * PER;
#pragma unroll
        for (int i = 0; i < PER; ++i) { const int t = t0 + i; const float x = t < LREAL ? lf[(size_t)t * 8] : 0.f; s += x; v[i] = s; }
        float incl = s;
#pragma unroll
        for (int o = 1; o < 64; o <<= 1) { const float n = __shfl_up(incl, o); if (lane >= o) incl += n; }
        LAS float* wsum = (LAS float*)(lds + LDS_MISC + 256);
        if (lane == 63) wsum[wave] = incl;
        __syncthreads();
        float off = 0.f;
        for (int w = 0; w < wave; ++w) off += wsum[w];
        const float excl = off + incl - s;
#pragma unroll
        for (int i = 0; i < PER; ++i) { const int t = t0 + i; if (t < LREAL) cs[t] = excl + v[i]; }
        __syncthreads();
    }
    const bf16u* P = (const bf16u*)(ws + WS_P); bf16u* Y = (bf16u*)(ws + WS_Y);
    for (int sl = blockIdx.x; sl < 256; sl += gridDim.x) {
        if (tid < 480) { const int sub = tid / 96, task = tid % 96, which = task / 48, head = (task % 48) >> 3, chunk = task & 7; const int r0 = sl * (MROWS / 256), b = r0 / LP;
            const bf16u* src = P + (which ? PC_FK : PC_FQ) + head * 64 + chunk * 8; float mx = 0.f;
#pragma unroll 9
            for (int r = sub; r < MROWS / 256; r += 5) { const v4u w = ((r0 + r) % LP < LREAL) ? *(const v4u*)(src + (size_t)(r0 + r) * NINP) : (v4u){0u, 0u, 0u, 0u}; float s = 0.f;
#pragma unroll
                for (int e = 0; e < 4; ++e) { const float lo = __uint_as_float(w[e] << 16), hi = __uint_as_float(w[e] & 0xffff0000u); s += lo * lo + hi * hi; }
                s += __shfl_xor(s, 1); s += __shfl_xor(s, 2); s += __shfl_xor(s, 4); mx = fmaxf(mx, s); }
            if (chunk == 0) atomicMax(nrm + (b * NFH + head) * 2 + which, __float_as_uint(mx)); }
    }
}
__device__ __forceinline__ void pool_chunk(unsigned char* ws, int c, int tid) {
    const bf16u* P = (const bf16u*)(ws + WS_P); bf16u* Y = (bf16u*)(ws + WS_Y);
    const int rsub = tid >> 5, ch = (tid & 31) * 8, win = 2 << (ch >> 6);
    {
        const int rg = c * 64 + rsub * 4, t0 = rg % LP;
        v4u wv[19];
#pragma unroll
        for (int j = 0; j < 19; ++j) { const int back = 15 - j;
            wv[j] = (back < win && t0 - back >= 0) ? *(const v4u*)(P + (size_t)(rg - back) * NINP + PC_U + ch) : (v4u){0u, 0u, 0u, 0u}; }
#pragma unroll
        for (int i = 0; i < 4; ++i) { const int t = t0 + i, cnt = (t + 1 < win) ? t + 1 : win; float acc[8];
#pragma unroll
            for (int e = 0; e < 8; ++e) acc[e] = 0.f;
#pragma unroll
            for (int k = 0; k < 16; ++k) { if (k < cnt) {
#pragma unroll
                for (int e = 0; e < 4; ++e) { acc[2 * e] += __uint_as_float(wv[15 + i - k][e] << 16); acc[2 * e + 1] += __uint_as_float(wv[15 + i - k][e] & 0xffff0000u); } } }
            const float inv = 1.0f / (float)cnt; v4u o;
#pragma unroll
            for (int e = 0; e < 4; ++e) o[e] = pk2(acc[2 * e] * inv - __uint_as_float(wv[15 + i][e] << 16), acc[2 * e + 1] * inv - __uint_as_float(wv[15 + i][e] & 0xffff0000u));
            *(v4u*)(Y + (size_t)(rg + i) * 1024 + ch) = o; }
    }
}
__device__ __forceinline__ void attn_phase(unsigned char* ws, unsigned char* lds_g, unsigned* ctr, const unsigned* nrm, int tid) {
    const attn_body::bf16* P = (const attn_body::bf16*)(ws + WS_P); attn_body::bf16* Y = (attn_body::bf16*)(ws + WS_Y); const float* CS = (const float*)(ws + WS_CS);
    volatile LAS unsigned* bw = (volatile LAS unsigned*)((LAS unsigned char*)lds_g + LDS_MISC);
    constexpr int NU = NBATCH * NFH * (LP / 256);
    for (;;) {
        if (tid == 0) bw[0] = atomicAdd(ctr, 1u);
        __syncthreads();
        const int it = (int)bw[0];
        __syncthreads();
        if (it >= 2 * NU + MROWS / 64) break;
        if (it >= 2 * NU) { pool_chunk(ws, it - 2 * NU, tid); continue; }
#ifdef PROBE
        if (it == NU && tid == 0) ((volatile unsigned long long*)(ws + WS_CTL + 8192))[20 + (ctr != (unsigned*)(ws + WS_CTL))] = __builtin_amdgcn_s_memrealtime();
#endif
        const int r = it < NU ? it : it - NU; const int qb = (LP / 256 - 1) - r / (NBATCH * NFH), bh = r % (NBATCH * NFH), b = bh / NFH, h = bh % NFH;
#ifndef NO_FOX
        if (it < NU) attn_body::fox_unit<8>(b, qb, 154.0f + 2.0f * sqrtf(__uint_as_float(nrm[bh * 2]) * __uint_as_float(nrm[bh * 2 + 1])), P + PC_FQ + h * 64, P + PC_FK + h * 64, P + PC_FV + h * 64, Y + 256 + h * 64, CS + (size_t)bh * LP, (char*)lds_g);
#endif
#ifndef NO_SB
        if (it >= NU) attn_body::sb_unit(b, qb, P + PC_SQ + h * 64, P + PC_SK + h * 64, P + PC_SV + h * 64, Y + 640 + h * 64, (char*)lds_g);
#endif
    }
}
__device__ __forceinline__ void final_phase(const Args& A, unsigned char* ws, int wave, int lane) {
    const bf16u* hb = (const bf16u*)(ws + WS_HB); const float* ss = (const float*)(ws + WS_SS) + 4 * (size_t)MROWS; const f32x4* g = (const f32x4*)A.in[14] + lane;
    const int gw = blockIdx.x * NWAVES + wave, NGW = gridDim.x * NWAVES;
    f32x4 gv[4];
#pragma unroll
    for (int j = 0; j < 4; ++j) gv[j] = g[64 * j];
    for (int m0 = gw * 2; m0 < NBATCH * SEQ_IN; m0 += NGW * 2) {
        unsigned long long r[2][4]; float rs[2];
#pragma unroll
        for (int q = 0; q < 2; ++q) { const int m = m0 + q, b = m / SEQ_IN, s = m % SEQ_IN; const size_t row = (size_t)b * LP + NMETA + s;
            rs[q] = 1.0f / sqrtf(ss[row] * (1.0f / 1024.0f) + 1e-6f);
            const unsigned long long* src = (const unsigned long long*)(hb + row * 1024) + lane;
#pragma unroll
            for (int j = 0; j < 4; ++j) r[q][j] = src[64 * j]; }
#pragma unroll
        for (int q = 0; q < 2; ++q) { f32x4* dst = (f32x4*)(A.out + (size_t)(m0 + q) * 1024) + lane;
#pragma unroll
            for (int j = 0; j < 4; ++j) { const unsigned rl = (unsigned)r[q][j], rh = (unsigned)(r[q][j] >> 32);
                dst[64 * j] = (f32x4){__uint_as_float(rl << 16), __uint_as_float(rl & 0xffff0000u), __uint_as_float(rh << 16), __uint_as_float(rh & 0xffff0000u)} * rs[q] * gv[j]; } }
    }
}

#define XB_TMO      128
#define XB_XCNT(j)  (256  + 64 * (j))
#define XB_XSUB(j)  (1280 + 64 * (j))
#define XB_XGEN(j)  (2304 + 64 * (j))
#define XB_TOP      3328
#define XB_TOPGEN   3392
#define XCD_BAR_WORDS 3456
#define XB_SPIN_CAP (1u << 18)

__device__ __forceinline__ unsigned xb_ld(unsigned* p)              { return __hip_atomic_load(p, __ATOMIC_RELAXED, __HIP_MEMORY_SCOPE_AGENT); }
__device__ __forceinline__ unsigned xb_add(unsigned* p, unsigned v) { return __hip_atomic_fetch_add(p, v, __ATOMIC_RELAXED, __HIP_MEMORY_SCOPE_AGENT); }
__device__ __forceinline__ unsigned xb_xcc_id() { return (unsigned)__builtin_amdgcn_s_getreg((3 << 11) | 20) & 0xFu; }
#define XB_SPIN(cond, bar) do { unsigned _sp = 0; while (cond) { __builtin_amdgcn_s_sleep(1); \
    if ((++_sp & 255u) == 0u) { if (xb_ld(&(bar)[XB_TMO])) break; if (_sp > XB_SPIN_CAP) { atomicAdd(&(bar)[XB_TMO], 1u); break; } } } } while (0)

struct XcdBarrier {
    unsigned* bar; unsigned x;
    volatile LAS unsigned* st;
};

__device__ __forceinline__ XcdBarrier xcd_barrier_post(unsigned* bar, volatile LAS unsigned* st) {
    XcdBarrier b; b.bar = bar; b.x = xb_xcc_id(); b.st = st;
    if (threadIdx.x == 0) (void)xb_add(&bar[XB_XCNT(b.x)], 1u);
    return b;
}
__device__ __forceinline__ void xcd_barrier_complete(unsigned* bar, unsigned x, unsigned& nloc, unsigned& nx) {
    const unsigned G = gridDim.x * gridDim.y * gridDim.z;
    unsigned sum, cnt, mine, sp = 0u;
    for (;;) {
        sum = 0u; cnt = 0u; mine = 0u;
#pragma unroll
        for (unsigned j = 0; j < 16; ++j) { const unsigned c = xb_ld(&bar[XB_XCNT(j)]); sum += c; cnt += (c > 0u) ? 1u : 0u; mine = (j == x) ? c : mine; }
        if (sum == G) break;
        __builtin_amdgcn_s_sleep(1);
        if ((++sp & 255u) == 0u) { if (xb_ld(&bar[XB_TMO])) break; if (sp > XB_SPIN_CAP) { atomicAdd(&bar[XB_TMO], 1u); break; } }
    }
    nloc = mine > 0u ? mine : 1u; nx = cnt > 0u ? cnt : 1u;
}

__device__ __forceinline__ void xcd_barrier(const XcdBarrier& b) {
    asm volatile("s_waitcnt vmcnt(0)" ::: "memory");
    __syncthreads();
    if (threadIdx.x == 0) {
        unsigned* bar = b.bar;
        __builtin_amdgcn_s_waitcnt(0);
        unsigned nloc = b.st[0], nx = b.st[1];
        if (nloc == 0u) { xcd_barrier_complete(bar, b.x, nloc, nx); b.st[0] = nloc; b.st[1] = nx; }
        const unsigned old = xb_add(&bar[XB_XSUB(b.x)], 1u);
        const unsigned gen = old / nloc;
        if (old + 1u == (gen + 1u) * nloc) {
            __builtin_amdgcn_fence(__ATOMIC_RELEASE, "agent");
            asm volatile("s_waitcnt vmcnt(0)" ::: "memory");
            const unsigned og = xb_add(&bar[XB_TOP], 1u);
            const unsigned tg = og / nx;
            if (og + 1u == (tg + 1u) * nx) xb_add(&bar[XB_TOPGEN], 1u);
            else XB_SPIN(xb_ld(&bar[XB_TOPGEN]) == tg, bar);
            __builtin_amdgcn_fence(__ATOMIC_ACQUIRE, "agent");
            xb_add(&bar[XB_XGEN(b.x)], 1u);
            asm volatile("s_waitcnt vmcnt(0)" ::: "memory");
        } else {
            XB_SPIN(xb_ld(&bar[XB_XGEN(b.x)]) == gen, bar);
            __builtin_amdgcn_fence(__ATOMIC_ACQUIRE, "agent");
            asm volatile("s_waitcnt vmcnt(0)" ::: "memory");
        }
    }
    __syncthreads();
}

#define FRESH() unsigned long zoff_ = 0; asm volatile("" : "+s"(zoff_)); unsigned char* ws = A.ws + zoff_; int tid = threadIdx.x; asm volatile("" : "+v"(tid)); const int lane = tid & 63, wave = __builtin_amdgcn_readfirstlane(tid >> 6); (void)lane; (void)wave
#ifdef PROBE
#define STAMP() do { if (blockIdx.x == 0 && threadIdx.x == 0) { ((volatile unsigned long long*)(A.ws + WS_CTL + 8192))[nst] = __builtin_amdgcn_s_memrealtime(); } ++nst; } while (0)
#else
#define STAMP() do {} while (0)
#endif
__global__ void __launch_bounds__(NWAVES * 64, 2) hymba_fwd(Args A) {
    extern __shared__ __attribute__((aligned(16))) unsigned char lds[];
    cg::grid_group grid = cg::this_grid();
    LAS unsigned char* L = (LAS unsigned char*)lds;
    if (threadIdx.x < 2) ((volatile LAS unsigned*)(L + LDS_MISC + 64))[threadIdx.x] = 0u;
    __syncthreads();
    const XcdBarrier xbar = xcd_barrier_post((unsigned*)(A.ws + WS_CTL) + 4096, (volatile LAS unsigned*)(L + LDS_MISC + 64));
#define GRID_BAR() xcd_barrier(xbar)
#ifdef PROBE
    int nst = 0; STAMP();
    for (int i = 0; i < 8; ++i) GRID_BAR();
    STAMP();
#endif
#ifndef NO_PRO
    { FRESH(); p0_prologue(A, ws, L, wave, lane); }
#endif
    if (A.ws == nullptr) grid.sync();
    GRID_BAR(); STAMP();
    for (int layer = 0; layer < DEPTH; ++layer) {
#ifndef NO_G1
        {
            FRESH(); const unsigned char* wb = ws + WS_W + (size_t)layer * W_LAYER;
            pg8::Gemm g{(const pg8::bf16_t*)(ws + WS_HB), (const pg8::bf16_t*)(wb + W_IN), MREAL, NINP, 1024}; pg8::StaticOrder S; S.init(MREAL, NINP, (int)gridDim.x, (int)blockIdx.x);
            pg8::EpiIn E{(pg8::bf16_t*)(ws + WS_P), (float*)(ws + WS_LF), (const float*)(ws + WS_SS) + (size_t)(2 * layer) * MROWS, A.in[4] + layer * NFH};
            fl_phase(ws, (const bf16u*)(wb + W_IN) + (size_t)NINP * 1024, (const float*)(ws + WS_SS) + (size_t)(2 * layer) * MROWS, A.in[4] + layer * NFH, wave, lane);
            mini_in(ws, (const bf16u*)(wb + W_IN), (const float*)(ws + WS_SS) + (size_t)(2 * layer) * MROWS, A.in[4] + layer * NFH, L, wave, lane);
            pg8::gemm_phase<pg8::EpiIn, pg8::StaticOrder, true, true>(L, g, S, E);
        }
#endif
        GRID_BAR(); STAMP();
#ifndef NO_POOL
        { FRESH(); pool_scan_phase(ws, L, (unsigned*)(ws + WS_CTL) + 128 + 64 * layer, tid, wave, lane); }
#endif
        GRID_BAR(); STAMP();
        { FRESH(); attn_phase(ws, lds, (unsigned*)(ws + WS_CTL) + 64 * layer, (const unsigned*)(ws + WS_CTL) + 128 + 64 * layer, tid); }
        GRID_BAR(); STAMP();
#ifndef NO_G3
        {
            FRESH(); const unsigned char* wb = ws + WS_W + (size_t)layer * W_LAYER;
            pg8::Gemm g{(const pg8::bf16_t*)(ws + WS_Y), (const pg8::bf16_t*)(wb + W_OUT), MREAL, 1024, 1024}; pg8::StaticOrder S; S.init(MREAL, 1024, (int)gridDim.x, (int)blockIdx.x);
            pg8::EpiRes E{(pg8::bf16_t*)(ws + WS_HB), nullptr, (float*)(ws + WS_SS) + (size_t)(2 * layer + 1) * MROWS};
            mini_res(ws, (const bf16u*)(ws + WS_Y), (const bf16u*)(wb + W_OUT), 1024, (float*)(ws + WS_SS) + (size_t)(2 * layer + 1) * MROWS, L, wave, lane);
            pg8::gemm_phase<pg8::EpiRes, pg8::StaticOrder, true, true>(L, g, S, E);
        }
#endif
        GRID_BAR(); STAMP();
#ifndef NO_G4
        {
            FRESH(); const unsigned char* wb = ws + WS_W + (size_t)layer * W_LAYER;
            pg8::Gemm g{(const pg8::bf16_t*)(ws + WS_HB), (const pg8::bf16_t*)(wb + W_GU), MREAL, NGU, 1024}; pg8::StaticOrder S; S.init(MREAL, NGU, (int)gridDim.x, (int)blockIdx.x);
            pg8::EpiGU E{(pg8::bf16_t*)(ws + WS_P), (const float*)(ws + WS_SS) + (size_t)(2 * layer + 1) * MROWS};
            mini_gu(ws, (const bf16u*)(wb + W_GU), (const float*)(ws + WS_SS) + (size_t)(2 * layer + 1) * MROWS, L, wave, lane);
            pg8::gemm_phase<pg8::EpiGU, pg8::StaticOrder, true, true>(L, g, S, E);
        }
#endif
        GRID_BAR(); STAMP();
#ifndef NO_G5
        {
            FRESH(); const unsigned char* wb = ws + WS_W + (size_t)layer * W_LAYER;
            pg8::Gemm g{(const pg8::bf16_t*)(ws + WS_P), (const pg8::bf16_t*)(wb + W_D), MREAL, 1024, DFF}; pg8::StaticOrder S; S.init(MREAL, 1024, (int)gridDim.x, (int)blockIdx.x);
            pg8::EpiRes E{(pg8::bf16_t*)(ws + WS_HB), nullptr, (float*)(ws + WS_SS) + (size_t)(2 * layer + 2) * MROWS};
            mini_res(ws, (const bf16u*)(ws + WS_P), (const bf16u*)(wb + W_D), DFF, (float*)(ws + WS_SS) + (size_t)(2 * layer + 2) * MROWS, L, wave, lane);
            pg8::gemm_phase<pg8::EpiRes, pg8::StaticOrder, true, true>(L, g, S, E);
        }
#endif
        GRID_BAR(); STAMP();
    }
    { FRESH(); final_phase(A, ws, wave, lane); }
#ifdef PROBE
    STAMP();
    grid.sync();
    {
        volatile unsigned long long* T = (volatile unsigned long long*)(A.ws + WS_CTL + 8192);
        if (blockIdx.x == 0) {
#ifndef PB_HI
#define PB_HI (PB + 1)
#endif
            const unsigned long long dA = T[PA + 1] - T[PA], dB = T[PB_HI < 0 ? 0 : PB_HI] - T[PB < 0 ? 0 : PB];
#if PB >= 0
            for (unsigned long long i = threadIdx.x; i < dB; i += NWAVES * 64) A.out[i] += 0.125f;
#else
            (void)dB;
#endif
            if (threadIdx.x == 0) { const unsigned long long t0 = __builtin_amdgcn_s_memrealtime(); while (__builtin_amdgcn_s_memrealtime() - t0 < dA) __builtin_amdgcn_s_sleep(8); }
        }
    }
#endif
}

extern "C" void kernel_launch(void* const* d_in, const int* in_sizes, int n_in, void* d_out, int out_size, void* d_ws, size_t ws_size, hipStream_t stream) {
    static int grid = 0;
    if (grid == 0) {
        if (n_in != 15 || out_size != NBATCH * SEQ_IN * DMODEL || ws_size < WS_END) { fprintf(stderr, "kernel_launch: unexpected shapes (n_in %d out %d ws %zu, need %zu)\n", n_in, out_size, ws_size, (size_t)WS_END); grid = -1; return; }
        int dev = 0, cus = 0, per_cu = 0;
        if (hipGetDevice(&dev) != hipSuccess || hipDeviceGetAttribute(&cus, hipDeviceAttributeMultiprocessorCount, dev) != hipSuccess) { grid = -1; return; }
        if (hipFuncSetAttribute((const void*)hymba_fwd, hipFuncAttributeMaxDynamicSharedMemorySize, LDS_BYTES) != hipSuccess) { fprintf(stderr, "kernel_launch: hipFuncSetAttribute failed\n"); grid = -1; return; }
        if (hipOccupancyMaxActiveBlocksPerMultiprocessor(&per_cu, (const void*)hymba_fwd, NWAVES * 64, LDS_BYTES) != hipSuccess || per_cu < 1) { fprintf(stderr, "kernel_launch: occupancy query says %d\n", per_cu); per_cu = 1; }
        (void)hipGetLastError();
        grid = cus;
    }
    if (grid < 0) return;
    if (hipMemsetAsync((char*)d_ws + WS_CTL, 0, CTL_ZERO_BYTES, stream) != hipSuccess) { fprintf(stderr, "kernel_launch: memset failed\n"); return; }
    Args a{};
    for (int i = 0; i < 15; ++i) a.in[i] = (const float*)d_in[i];
    a.out = (float*)d_out; a.ws = (unsigned char*)d_ws;
    void* args[] = {&a};
    const hipError_t e = hipLaunchCooperativeKernel((const void*)hymba_fwd, dim3(grid), dim3(NWAVES * 64), args, LDS_BYTES, stream);
    if (e != hipSuccess) fprintf(stderr, "kernel_launch: cooperative launch failed: %s (grid %d)\n", hipGetErrorString(e), grid);
}
```

```cpp
#include <hip/hip_runtime.h>
#include <hip/hip_cooperative_groups.h>
#include <cstdio>
#include <cstdint>
namespace pg8 {
#define PG8_LAS __attribute__((address_space(3)))
typedef unsigned short bf16_t;
typedef short bf16x8 __attribute__((ext_vector_type(8)));
typedef float f32x4 __attribute__((ext_vector_type(4)));
typedef unsigned u32x4 __attribute__((ext_vector_type(4)));
constexpr int BM = 256, BK = 64, HALF = 128, HTB = HALF * BK * 2  , STAGE_BYTES = 8 * HTB, NXCD = 8, WGM = 8;

__host__ __device__ __forceinline__ int lds_byte(int r, int c) { const int st = (r >> 4) * 2 + (c >> 5), rr = r & 15, cc = c & 31, ob = rr * 64 + cc * 2; return st * 1024 + (ob ^ (((ob >> 9) & 1) << 5)); }
__host__ __device__ __forceinline__ void stage_rc(int b, int& R, int& C) { const int st = b / 1024, sb = b % 1024, swz = sb ^ (((sb >> 9) & 1) << 5); R = (st >> 1) * 16 + swz / 64; C = (st & 1) * 32 + (swz % 64) / 2; }
__host__ __device__ __forceinline__ int perm32(int rho) { const int n = rho >> 4, i = rho & 15; return 8 * (i >> 2) + 4 * n + (i & 3); }

struct Unit { int pm, pn; };
__host__ __device__ __forceinline__ int arow(int pm) { return 256 * (pm + (pm >> 5)) + 16; }
struct Gemm { const bf16_t* A; const bf16_t* Bt; int M, N, K; };

struct StaticOrder {
    int nM, nN, nwg, G, c;
    __host__ __device__ void init(int M, int N, int G_, int c_) { nM = M / BM; nN = N / BM; nwg = nM * nN; G = G_; c = c_; }
    __host__ __device__ bool next(int i, Unit& u) const {
        const long L = (long)i * G + c; if (L >= nwg) return false;
        int wgid = (int)L; { const int q = nwg / NXCD, r = nwg % NXCD, xcd = wgid % NXCD, off = wgid / NXCD; wgid = (xcd < r ? xcd * (q + 1) : r * (q + 1) + (xcd - r) * q) + off; }
        const int nig = WGM * nN, gid = wgid / nig, fm = gid * WGM, gsz = (nM - fm) < WGM ? (nM - fm) : WGM;
        u.pm = fm + ((wgid % nig) % gsz); u.pn = (wgid % nig) / gsz; return true;
    }
    __device__ __forceinline__ void a_ready(const Unit&) const {}
    __device__ __forceinline__ void done(const Unit&) const {}
};

__device__ __forceinline__ unsigned cvt_pk_bf16(float lo, float hi) { unsigned r; asm volatile("v_cvt_pk_bf16_f32 %0, %1, %2" : "=v"(r) : "v"(lo), "v"(hi)); return r; }
typedef unsigned u32x2 __attribute__((ext_vector_type(2)));
constexpr float RMS_EPS = 1e-6f;
struct EpiIn {
    static constexpr bool PERM = true, AFTER_DRAIN = false;
    bf16_t* P; float* LF; const float* ss; const float* fb;
    __device__ __forceinline__ void operator()(const f32x4 (&acc)[2][2][4][2], const Unit& u, int wr, int wc, int fr, int fq) const {
        const int row0 = arow(u.pm) + wr * 64 + fr;
        {
            const int col0 = u.pn * BM + wc * 32 + 8 * fq;
#pragma unroll
            for (int ai = 0; ai < 2; ++ai)
#pragma unroll
                for (int m = 0; m < 4; ++m) { const int row = row0 + ai * HALF + m * 16; const float rs = __builtin_amdgcn_rsqf(ss[row] * (1.0f / 1024.0f) + RMS_EPS);
                    bf16_t* rowp = P + (size_t)row * 2560 + col0;
#pragma unroll
                    for (int bj = 0; bj < 2; ++bj) { const f32x4 v0 = acc[ai][bj][m][0] * rs, v1 = acc[ai][bj][m][1] * rs;
                        u32x4 w; w.x = cvt_pk_bf16(v0[0], v0[1]); w.y = cvt_pk_bf16(v0[2], v0[3]); w.z = cvt_pk_bf16(v1[0], v1[1]); w.w = cvt_pk_bf16(v1[2], v1[3]);
                        *(u32x4*)(rowp + bj * HALF) = w; } }
        }
    }
};
struct EpiRes {
    static constexpr bool PERM = true, AFTER_DRAIN = false;
    bf16_t* hb; float* hf; float* ssn;
    __device__ __forceinline__ void operator()(const f32x4 (&acc)[2][2][4][2], const Unit& u, int wr, int wc, int fr, int fq) const {
        const int row0 = arow(u.pm) + wr * 64 + fr, col0 = u.pn * BM + wc * 32 + 8 * fq;
#pragma unroll
        for (int ai = 0; ai < 2; ++ai)
#pragma unroll
            for (int m = 0; m < 4; ++m) { const int row = row0 + ai * HALF + m * 16; bf16_t* bp = hb + (size_t)row * 1024 + col0; float s = 0.f;
#pragma unroll
                for (int bj = 0; bj < 2; ++bj) { const u32x4 r = *(const u32x4*)(bp + bj * HALF);
                    f32x4 a = (f32x4){__uint_as_float(r.x << 16), __uint_as_float(r.x & 0xffff0000u), __uint_as_float(r.y << 16), __uint_as_float(r.y & 0xffff0000u)};
                    f32x4 b = (f32x4){__uint_as_float(r.z << 16), __uint_as_float(r.z & 0xffff0000u), __uint_as_float(r.w << 16), __uint_as_float(r.w & 0xffff0000u)};
                    a = a + acc[ai][bj][m][0]; b = b + acc[ai][bj][m][1];
                    if (hf) { float* hp = hf + (size_t)row * 1024 + col0 + bj * HALF; *(f32x4*)hp = a; *(f32x4*)(hp + 4) = b; }
                    s += (a[0] * a[0] + a[1] * a[1]) + (a[2] * a[2] + a[3] * a[3]) + (b[0] * b[0] + b[1] * b[1]) + (b[2] * b[2] + b[3] * b[3]);
                    u32x4 w; w.x = cvt_pk_bf16(a[0], a[1]); w.y = cvt_pk_bf16(a[2], a[3]); w.z = cvt_pk_bf16(b[0], b[1]); w.w = cvt_pk_bf16(b[2], b[3]);
                    *(u32x4*)(bp + bj * HALF) = w; }
                s += __shfl_xor(s, 16); s += __shfl_xor(s, 32);
                if (fq == 0) atomicAdd(ssn + row, s);
                asm volatile("" ::: "memory"); }
    }
};
struct EpiGU {
    static constexpr bool PERM = true, AFTER_DRAIN = false;
    bf16_t* H; const float* ss;
    __device__ __forceinline__ void operator()(const f32x4 (&acc)[2][2][4][2], const Unit& u, int wr, int wc, int fr, int fq) const {
        const int row0 = arow(u.pm) + wr * 64 + fr, col0 = u.pn * HALF + wc * 32 + 8 * fq;
#pragma unroll
        for (int ai = 0; ai < 2; ++ai)
#pragma unroll
            for (int m = 0; m < 4; ++m) { const int row = row0 + ai * HALF + m * 16; const float rs = __builtin_amdgcn_rsqf(ss[row] * (1.0f / 1024.0f) + RMS_EPS);
                float o[8];
#pragma unroll
                for (int n = 0; n < 2; ++n)
#pragma unroll
                    for (int e = 0; e < 4; ++e) { const float g = acc[ai][0][m][n][e] * rs, up = acc[ai][1][m][n][e] * rs;
                        o[4 * n + e] = g * __builtin_amdgcn_rcpf(1.0f + __builtin_amdgcn_exp2f(-1.4426950408889634f * g)) * up; }
                u32x4 w; w.x = cvt_pk_bf16(o[0], o[1]); w.y = cvt_pk_bf16(o[2], o[3]); w.z = cvt_pk_bf16(o[4], o[5]); w.w = cvt_pk_bf16(o[6], o[7]);
                *(u32x4*)(H + (size_t)row * 2816 + col0) = w; }
    }
};
template <class Epi, class Sched, bool ALIGN_EPI = false, bool SP2 = false>
__device__ __forceinline__ void gemm_phase(PG8_LAS unsigned char* lds, const Gemm g, const Sched& S, const Epi& E) {
    int tid_ = threadIdx.x; asm volatile("" : "+v"(tid_));
    const int tid = tid_, wid = __builtin_amdgcn_readfirstlane(tid >> 6), lane = tid & 63, wr = wid >> 2, wc = wid & 3, fr = lane & 15, fq = lane >> 4;
    const int K = g.K, nt = K / BK;
    unsigned voffA[2], voffB[2];
#pragma unroll
    for (int i = 0; i < 2; ++i) { int R, C; stage_rc(tid * 16 + i * 8192, R, C); const int Rb = Epi::PERM ? ((R & ~31) + perm32(R & 31)) : R;
        voffA[i] = (unsigned)(R * K + C) * 2u; voffB[i] = (unsigned)(Rb * K + C) * 2u; }
    const size_t kstep = (size_t)(BK * 2);
    const size_t hstep = (size_t)HALF * K * 2;
    const size_t tstep = 2 * hstep;
    const unsigned ldsw = (unsigned)wid * 1024u;
    const int aoff = lds_byte(wr * 64 + fr, fq * 8), boff = lds_byte(wc * 32 + fr, fq * 8);
#define PG8_SA(b, h) (((b) * 2 + (h)) * HTB)
#define PG8_SB(b, h) ((4 + (b) * 2 + (h)) * HTB)
#define PG8_STAGE(bufoff, gbase, voff) do { _Pragma("unroll") for (int _i = 0; _i < 2; ++_i) \
        __builtin_amdgcn_global_load_lds((const unsigned*)((const char*)(gbase) + (voff)[_i]), (PG8_LAS unsigned*)(lds + (bufoff) + ldsw + _i * 8192), 16, 0, 0); } while (0)
#define PG8_LDA(dst, b, h) do { _Pragma("unroll") for (int m = 0; m < 4; ++m) _Pragma("unroll") for (int k = 0; k < 2; ++k) dst[m][k] = *(const PG8_LAS bf16x8*)(lds + PG8_SA(b, h) + aoff + m * 2048 + k * 1024); } while (0)
#define PG8_LDB(dst, b, h) do { _Pragma("unroll") for (int n = 0; n < 2; ++n) _Pragma("unroll") for (int k = 0; k < 2; ++k) dst[n][k] = *(const PG8_LAS bf16x8*)(lds + PG8_SB(b, h) + boff + n * 2048 + k * 1024); } while (0)
#define PG8_MMA(ai, bj, At, Bt) do { __builtin_amdgcn_s_setprio(1); _Pragma("unroll") for (int m = 0; m < 4; ++m) _Pragma("unroll") for (int n = 0; n < 2; ++n) _Pragma("unroll") for (int k = 0; k < 2; ++k) \
        acc[ai][bj][m][n] = __builtin_amdgcn_mfma_f32_16x16x32_bf16(Bt[n][k], At[m][k], acc[ai][bj][m][n], 0, 0, 0); __builtin_amdgcn_s_setprio(0); } while (0)
#define PG8_WAIT_V(n) asm volatile("s_waitcnt vmcnt(" #n ")" ::: "memory")
#define PG8_WAIT_L(n) asm volatile("s_waitcnt lgkmcnt(" #n ")" ::: "memory")
#define PG8_BAR __builtin_amdgcn_s_barrier()
#define PG8_SCHED __builtin_amdgcn_sched_barrier(0)
    Unit cur, nxt; int ui = 0;
    if (!S.next(0, cur)) return;
    f32x4 acc[2][2][4][2];
#pragma unroll
    for (int a = 0; a < 2; ++a)
#pragma unroll
        for (int b = 0; b < 2; ++b)
#pragma unroll
            for (int m = 0; m < 4; ++m)
#pragma unroll
                for (int n = 0; n < 2; ++n) acc[a][b][m][n] = (f32x4){0.f, 0.f, 0.f, 0.f};
    bf16x8 At[4][2], B0[2][2], B1[2][2];
    const char* cA = (const char*)g.A + (size_t)arow(cur.pm) * K * 2; const char* cB = (const char*)g.Bt + (size_t)cur.pn * tstep;
    S.a_ready(cur);
    if constexpr (SP2) {
        PG8_STAGE(PG8_SB(0, 0), cB, voffB); PG8_STAGE(PG8_SB(0, 1), cB + hstep, voffB); PG8_STAGE(PG8_SA(0, 0), cA, voffA); PG8_STAGE(PG8_SA(0, 1), cA + hstep, voffA);
        if (wr == 1) PG8_BAR;
        PG8_WAIT_V(2); PG8_BAR;
        PG8_STAGE(PG8_SB(1, 0), cB + kstep, voffB); PG8_STAGE(PG8_SA(1, 0), cA + kstep, voffA); PG8_STAGE(PG8_SB(1, 1), cB + hstep + kstep, voffB);
        PG8_WAIT_V(6); PG8_BAR;
    } else {
        PG8_STAGE(PG8_SB(0, 0), cB, voffB); PG8_STAGE(PG8_SA(0, 0), cA, voffA); PG8_STAGE(PG8_SB(0, 1), cB + hstep, voffB); PG8_STAGE(PG8_SA(0, 1), cA + hstep, voffA);
        if (wr == 1) PG8_BAR;
        PG8_WAIT_V(4); PG8_BAR;
        PG8_STAGE(PG8_SB(1, 0), cB + kstep, voffB); PG8_STAGE(PG8_SA(1, 0), cA + kstep, voffA); PG8_STAGE(PG8_SB(1, 1), cB + hstep + kstep, voffB);
        PG8_WAIT_V(6); PG8_BAR;
    }
    for (;;) {
        const bool has_next = S.next(ui + 1, nxt);
        const char* nA = has_next ? (const char*)g.A + (size_t)arow(nxt.pm) * K * 2 : cA; const char* nB = has_next ? (const char*)g.Bt + (size_t)nxt.pn * tstep : cB;
        for (int t = 0; t < nt; t += 2) {
            const bool last = (t == nt - 2);
            const char* a1 = cA + (size_t)(t + 1) * kstep;
            const char* a2 = last ? nA : cA + (size_t)(t + 2) * kstep; const char* b2 = last ? nB : cB + (size_t)(t + 2) * kstep;
            const char* a3 = a2 + kstep; const char* b3 = b2 + kstep;
            if (last && has_next) S.a_ready(nxt);
            if constexpr (SP2) {
            PG8_LDB(B0, 0, 0); PG8_LDB(B1, 0, 1); PG8_SCHED; PG8_LDA(At, 0, 0); PG8_STAGE(PG8_SA(1, 1), a1 + hstep, voffA);
            PG8_WAIT_V(8); PG8_WAIT_L(0); PG8_BAR; PG8_MMA(0, 0, At, B0); PG8_MMA(0, 1, At, B1); PG8_BAR; PG8_SCHED;
            PG8_LDA(At, 0, 1); PG8_STAGE(PG8_SB(0, 0), b2, voffB); PG8_STAGE(PG8_SB(0, 1), b2 + hstep, voffB); PG8_STAGE(PG8_SA(0, 0), a2, voffA);
            PG8_WAIT_V(8); PG8_WAIT_L(0); PG8_BAR; PG8_MMA(1, 0, At, B0); PG8_MMA(1, 1, At, B1); PG8_BAR; PG8_SCHED;
            PG8_LDB(B0, 1, 0); PG8_LDB(B1, 1, 1); PG8_SCHED; PG8_LDA(At, 1, 0); PG8_STAGE(PG8_SA(0, 1), a2 + hstep, voffA);
            PG8_WAIT_V(8); PG8_WAIT_L(0); PG8_BAR; PG8_MMA(0, 0, At, B0); PG8_MMA(0, 1, At, B1); PG8_BAR; PG8_SCHED;
            PG8_LDA(At, 1, 1); PG8_STAGE(PG8_SB(1, 0), b3, voffB); PG8_STAGE(PG8_SB(1, 1), b3 + hstep, voffB); PG8_STAGE(PG8_SA(1, 0), a3, voffA);
            PG8_WAIT_V(8); PG8_WAIT_L(0); PG8_BAR; PG8_MMA(1, 0, At, B0); PG8_MMA(1, 1, At, B1); PG8_BAR; PG8_SCHED;
            } else {
            PG8_LDB(B0, 0, 0); PG8_SCHED; PG8_LDA(At, 0, 0); PG8_STAGE(PG8_SA(1, 1), a1 + hstep, voffA);
            PG8_WAIT_L(8); PG8_BAR; PG8_WAIT_L(0); PG8_MMA(0, 0, At, B0); PG8_BAR; PG8_SCHED;
            PG8_LDB(B1, 0, 1); PG8_STAGE(PG8_SB(0, 0), b2, voffB);
            PG8_BAR; PG8_WAIT_L(0); PG8_MMA(0, 1, At, B1); PG8_BAR;
            PG8_LDA(At, 0, 1); PG8_STAGE(PG8_SA(0, 0), a2, voffA);
            PG8_BAR; PG8_WAIT_L(0); PG8_MMA(1, 0, At, B0); PG8_BAR; PG8_SCHED;
            PG8_STAGE(PG8_SB(0, 1), b2 + hstep, voffB);
            PG8_WAIT_V(6); PG8_BAR; PG8_MMA(1, 1, At, B1); PG8_BAR;
            PG8_LDB(B0, 1, 0); PG8_SCHED; PG8_LDA(At, 1, 0); PG8_STAGE(PG8_SA(0, 1), a2 + hstep, voffA);
            PG8_WAIT_L(8); PG8_BAR; PG8_WAIT_L(0); PG8_MMA(0, 0, At, B0); PG8_BAR; PG8_SCHED;
            PG8_LDB(B1, 1, 1); PG8_STAGE(PG8_SB(1, 0), b3, voffB);
            PG8_BAR; PG8_WAIT_L(0); PG8_MMA(0, 1, At, B1); PG8_BAR;
            PG8_LDA(At, 1, 1); PG8_STAGE(PG8_SA(1, 0), a3, voffA);
            PG8_BAR; PG8_WAIT_L(0); PG8_MMA(1, 0, At, B0); PG8_BAR; PG8_SCHED;
            PG8_STAGE(PG8_SB(1, 1), b3 + hstep, voffB);
            PG8_WAIT_V(6); PG8_BAR; PG8_MMA(1, 1, At, B1); PG8_BAR;
            }
        }
        if constexpr (ALIGN_EPI) { if (wr == 0) PG8_BAR; }
        if constexpr (!Epi::AFTER_DRAIN) { E(acc, cur, wr, wc, fr, fq); S.done(cur); }
        if (!has_next) break;
#pragma unroll
        for (int a = 0; a < 2; ++a)
#pragma unroll
            for (int b = 0; b < 2; ++b)
#pragma unroll
                for (int m = 0; m < 4; ++m)
#pragma unroll
                    for (int n = 0; n < 2; ++n) acc[a][b][m][n] = (f32x4){0.f, 0.f, 0.f, 0.f};
        cur = nxt; cA = nA; cB = nB; ++ui;
        if constexpr (ALIGN_EPI) { if (wr == 1) PG8_BAR; }
    }
    PG8_WAIT_V(0);
    if constexpr (!ALIGN_EPI) { if (wr == 0) PG8_BAR; }
    PG8_BAR;
    if constexpr (Epi::AFTER_DRAIN) { E.fused(acc, cur, wr, wc, fr, fq, lds, wid, lane); S.done(cur); }
#undef PG8_SA
#undef PG8_SB
#undef PG8_STAGE
#undef PG8_LDA
#undef PG8_LDB
#undef PG8_MMA
#undef PG8_WAIT_V
#undef PG8_WAIT_L
#undef PG8_BAR
#undef PG8_SCHED
}
}
#include <hip/hip_bf16.h>
#include <cmath>
namespace attn_body {
using bf16=__hip_bfloat16;
using bf16x8=__attribute__((ext_vector_type(8)))short;
using s16x4=__attribute__((ext_vector_type(4)))short;
using f32x16=__attribute__((ext_vector_type(16)))float;
using u32x4=__attribute__((ext_vector_type(4)))unsigned;
constexpr int SEQ=8448,D=64,DM=2560,DMO=1024;
using f32x4=__attribute__((ext_vector_type(4)))float;
constexpr int NW=8,QBLK=32,QB=QBLK*NW,KVBLK=64,NQB=SEQ/QB;
constexpr int ATTN_UNIT_ROWS=QB;
__device__ __forceinline__ int crow(int r,int hi){return (r&3)+8*(r>>2)+4*hi;}
#define SBAR() __builtin_amdgcn_sched_barrier(0)
__device__ __forceinline__ void cmask(f32x16&p0,f32x16&p1,int jb,int qrel,int hi){
  const float NEG=-INFINITY; int kb=64*jb+4*hi;
  #pragma unroll
  for(int r=0;r<16;++r){int kv=kb+(r&3)+8*(r>>2); if(kv>qrel)p0[r]=NEG; if(kv+32>qrel)p1[r]=NEG;}
}

constexpr int NSLOT=3, SLOTB=8192;
constexpr int LDS_K=0, LDS_V=NSLOT*SLOTB, LDS_WS=2*NSLOT*SLOTB, LDS_OST=LDS_WS+NW*64*4, LDS_BYTES=LDS_OST+NW*4096, LDS_CS=LDS_BYTES, LDS_FLAGS=LDS_CS+SEQ*4, LDS_END=LDS_FLAGS+256;
constexpr float C2=0.125f*1.4426950408889634f;
__device__ __forceinline__ void glds16(const void*gsrc,unsigned lds_dst){unsigned keep;
  asm volatile("s_mov_b32 %0, m0\n\ts_mov_b32 m0, %2\n\ts_nop 0\n\tglobal_load_lds_dwordx4 %1, off\n\ts_mov_b32 m0, %0":"=&s"(keep):"v"(gsrc),"s"(lds_dst):"memory");}
__device__ __forceinline__ float max3f(float a,float b,float c){float r;asm("v_max3_f32 %0, %1, %2, %3":"=v"(r):"v"(a),"v"(b),"v"(c));return r;}
__device__ __forceinline__ float max2f(float a,float b){float r;asm("v_max_f32_e32 %0, %1, %2":"=v"(r):"v"(a),"v"(b));return r;}
__device__ __forceinline__ float fadd_s(float a,float b){float r;asm("v_add_f32_e32 %0, %1, %2":"=v"(r):"v"(a),"v"(b));return r;}
__device__ __forceinline__ float fsub_s(float a,float b){float r;asm("v_sub_f32_e32 %0, %1, %2":"=v"(r):"v"(a),"v"(b));return r;}
typedef float f32x2_t __attribute__((ext_vector_type(2))); typedef __bf16 bf16x2_t __attribute__((ext_vector_type(2)));
__device__ __forceinline__ unsigned cvtpk_s(float lo,float hi){f32x2_t v={lo,hi};bf16x2_t b=__builtin_convertvector(v,bf16x2_t);return __builtin_bit_cast(unsigned,b);}
#define WAIT_BAR(N) asm volatile("s_waitcnt vmcnt(" #N ") lgkmcnt(0)\n\ts_barrier":::"memory")

__device__ __forceinline__ void qkt(f32x16&p0,f32x16&p1,const char*Kslot,const bf16x8*qr,int r32,int hi){
  const char*kb=Kslot+hi*1024+r32*16;
  #pragma unroll
  for(int d0=0;d0<4;++d0){
    const bf16x8 b0=*reinterpret_cast<const bf16x8*>(kb+d0*2048);
    const bf16x8 b1=*reinterpret_cast<const bf16x8*>(kb+d0*2048+512);
    {p0=__builtin_amdgcn_mfma_f32_32x32x16_bf16(b0,qr[d0],p0,0,0,0);p1=__builtin_amdgcn_mfma_f32_32x32x16_bf16(b1,qr[d0],p1,0,0,0);}}
}
typedef __attribute__((address_space(3))) const char* lds_cptr;
typedef short v4i16_t __attribute__((ext_vector_type(4)));
__device__ __forceinline__ void kload8(bf16x8*kf,lds_cptr kp){
  kf[0]=*(const __attribute__((address_space(3))) bf16x8*)(kp);      kf[1]=*(const __attribute__((address_space(3))) bf16x8*)(kp+512);
  kf[2]=*(const __attribute__((address_space(3))) bf16x8*)(kp+2048); kf[3]=*(const __attribute__((address_space(3))) bf16x8*)(kp+2560);
  kf[4]=*(const __attribute__((address_space(3))) bf16x8*)(kp+4096); kf[5]=*(const __attribute__((address_space(3))) bf16x8*)(kp+4608);
  kf[6]=*(const __attribute__((address_space(3))) bf16x8*)(kp+6144); kf[7]=*(const __attribute__((address_space(3))) bf16x8*)(kp+6656);
}
__device__ __forceinline__ void kload2(bf16x8*kf,lds_cptr kp,int j){ kf[2*j]=*(const __attribute__((address_space(3))) bf16x8*)(kp+j*2048); kf[2*j+1]=*(const __attribute__((address_space(3))) bf16x8*)(kp+j*2048+512); }
__device__ __forceinline__ s16x4 vtr(lds_cptr p){ return __builtin_bit_cast(s16x4,__builtin_amdgcn_ds_read_tr16_b64_v4i16((__attribute__((address_space(3))) v4i16_t*)p)); }
__device__ __forceinline__ float rowmax(const f32x16&p0,const f32x16&p1){
  float a=max3f(p0[0],p0[1],p1[0]),b=max3f(p0[2],p0[3],p1[1]);a=max3f(a,p1[2],p1[3]);
  #pragma unroll
  for(int r=4;r<16;r+=4){a=max3f(a,p0[r],p0[r+1]);b=max3f(b,p0[r+2],p0[r+3]);a=max3f(a,p1[r],p1[r+1]);b=max3f(b,p1[r+2],p1[r+3]);}
  const float m=max2f(a,b);
  auto rr=__builtin_amdgcn_permlane32_swap(__float_as_uint(m),__float_as_uint(m),false,false);
  return max2f(__uint_as_float(rr[0]),__uint_as_float(rr[1]));
}
__device__ __forceinline__ void pv(f32x16*o,int vb,bf16x8 pa0,bf16x8 pa1,bf16x8 pa2,bf16x8 pa3){
  #pragma unroll
  for(int d0=0;d0<2;++d0){s16x4 lo[4],hi[4];
    #pragma unroll
    for(int ks=0;ks<4;++ks){
      asm volatile("ds_read_b64_tr_b16 %0,%1 offset:%c2":"=&v"(lo[ks]):"v"(vb),"i"(d0*4096+ks*1024):"memory");
      asm volatile("ds_read_b64_tr_b16 %0,%1 offset:%c2":"=&v"(hi[ks]):"v"(vb),"i"(d0*4096+ks*1024+512):"memory");}
    asm volatile("s_waitcnt lgkmcnt(0)":::"memory");SBAR();
    #define PK(k) (bf16x8){lo[k][0],lo[k][1],lo[k][2],lo[k][3],hi[k][0],hi[k][1],hi[k][2],hi[k][3]}
    o[d0]=__builtin_amdgcn_mfma_f32_32x32x16_bf16(pa0,PK(0),o[d0],0,0,0);
    o[d0]=__builtin_amdgcn_mfma_f32_32x32x16_bf16(pa1,PK(1),o[d0],0,0,0);
    o[d0]=__builtin_amdgcn_mfma_f32_32x32x16_bf16(pa2,PK(2),o[d0],0,0,0);
    o[d0]=__builtin_amdgcn_mfma_f32_32x32x16_bf16(pa3,PK(3),o[d0],0,0,0);
    #undef PK
  }
}

__device__ __forceinline__ u32x4 head_rms(u32x4 v){ float x[8];
  #pragma unroll
  for(int i=0;i<4;++i){x[2*i]=__uint_as_float(v[i]<<16);x[2*i+1]=__uint_as_float(v[i]&0xffff0000u);}
  float s=0.f;
  #pragma unroll
  for(int i=0;i<8;++i)s+=x[i]*x[i];
  s+=__shfl_xor(s,1);s+=__shfl_xor(s,2);s+=__shfl_xor(s,4);
  const float rs=__builtin_amdgcn_rsqf(s*(1.0f/64.0f)+1e-6f); u32x4 w;
  #pragma unroll
  for(int i=0;i<4;++i)w[i]=cvtpk_s(x[2*i]*rs,x[2*i+1]*rs);
  return w; }
#ifndef ATTN_STORE16
#define ATTN_STORE16(p,v) (*(u32x4*)(p)=(v))
#endif
template<int THRL> __device__ __forceinline__ void fox_unit(int b,int qb,float dthr,const bf16*Q,const bf16*__restrict__ K,const bf16*__restrict__ V,bf16*O,const float*__restrict__ csg,char*shm){
  int tid_=threadIdx.x; asm volatile("":"+v"(tid_)); const int tid=tid_,lane=tid&63,r32=lane&31,hi=lane>>5; const int wid=__builtin_amdgcn_readfirstlane(tid>>6);
  const long rowbase=(long)b*SEQ; const int q0=qb*QB;
  const bf16*Qw=Q+(rowbase+q0+wid*QBLK)*DM;
  const unsigned lds0=(unsigned)(uintptr_t)shm; const lds_cptr shm3=(lds_cptr)shm;
  float*wsf=(float*)(shm+LDS_WS)+wid*64;
  const unsigned kdst=lds0+LDS_K+wid*1024, vdst=lds0+LDS_V+wid*1024;
  #define DMA_K(t,slot) glds16(ksrc+(long)(t)*KVBLK*DM,(unsigned)__builtin_amdgcn_readfirstlane(kdst+(slot)))
  #define DMA_V(t,slot) glds16(vsrc+(long)(t)*KVBLK*DM,(unsigned)__builtin_amdgcn_readfirstlane(vdst+(slot)))
  const int vb0=(int)(lds0+LDS_V)+((lane>>4)&1)*32+(lane&3)*8+(4*hi+((lane&15)>>2))*64;
  const char*Kbase=shm+LDS_K; bf16x8 kf[8];
  const lds_cptr kp0=shm3+LDS_K+hi*1024+r32*16; const lds_cptr vp0=shm3+LDS_V+((lane>>4)&1)*32+(lane&3)*8+(4*hi+((lane&15)>>2))*64;
  typedef __attribute__((address_space(3))) float lds_f32; typedef __attribute__((address_space(3))) f32x4 lds_f32x4;
  { lds_f32*cl=(lds_f32*)(shm3+LDS_CS); const int n_=q0+QB; for(int i_=tid*4;i_<n_;i_+=2048){ const f32x4 v_=*(const f32x4*)(csg+i_); *(lds_f32x4*)(cl+i_)=v_; } }
  asm volatile("s_waitcnt vmcnt(0) lgkmcnt(0)\n\ts_barrier":::"memory");
  int j0;
  { const lds_f32*cl=(const lds_f32*)(shm3+LDS_CS); const float cq0=cl[q0]; int lo_=0,hi_=4*qb;
    while(lo_<hi_){ const int mid_=(lo_+hi_)>>1; if(cl[64*mid_+63]-cq0>=dthr)lo_=mid_+1; else hi_=mid_; }
    j0=__builtin_amdgcn_readfirstlane(lo_)&~1; }
  const bf16*Kh=K+(rowbase+(long)j0*KVBLK)*DM,*Vh=V+(rowbase+(long)j0*KVBLK)*DM;
  const bf16*ksrc=Kh+(long)lane*DM+wid*8;
  const bf16*vsrc=Vh+(long)(16*(wid&3)+(lane>>2))*DM+(wid>>2)*32+(lane&3)*8;
  const int NT=(q0+QB)/KVBLK-j0;
  const lds_f32*cl3=(const lds_f32*)(shm3+LDS_CS)+64*j0;
  DMA_K(0,0);DMA_V(0,0);DMA_K(1,SLOTB);
  bf16x8 qr[4];
  #pragma unroll
  for(int d0=0;d0<4;++d0)qr[d0]=*reinterpret_cast<const bf16x8*>(&Qw[(long)r32*DM+d0*16+hi*8]);
  float base=0.f,l_reg=0.f;f32x16 o[2];o[0]=f32x16{};o[1]=f32x16{};
  #define CINIT(C0,C1,t) do{ const lds_f32*cp_=cl3+64*(t)+4*hi; \
    _Pragma("unroll") for(int g_=0;g_<4;++g_){ const f32x4 a_=*(const lds_f32x4*)(cp_+8*g_), b_=*(const lds_f32x4*)(cp_+32+8*g_); \
      C0[4*g_]=base-a_[0];C0[4*g_+1]=base-a_[1];C0[4*g_+2]=base-a_[2];C0[4*g_+3]=base-a_[3]; \
      C1[4*g_]=base-b_[0];C1[4*g_+1]=base-b_[1];C1[4*g_+2]=base-b_[2];C1[4*g_+3]=base-b_[3]; } }while(0)
  const int qrel=wid*QBLK+r32;
  #define CMASK(P0,P1,t) do{int jb_=(t)-(NT-4); if(jb_>=0)cmask(P0,P1,jb_,qrel,hi);}while(0)
  bool resc=false;
  #define START(P0,P1) do{ const float rm=rowmax(P0,P1); resc=false; \
    { const float dl=rm; base=fsub_s(base,dl); \
      _Pragma("unroll") for(int r=0;r<16;++r){P0[r]=fsub_s(P0[r],dl);P1[r]=fsub_s(P1[r],dl);} } \
    _Pragma("unroll") for(int r=0;r<16;++r)P0[r]=__builtin_amdgcn_exp2f(P0[r]); }while(0)
  #define RESC() do{ if(resc){ asm volatile("s_waitcnt lgkmcnt(0)":::"memory"); \
      _Pragma("unroll") for(int d_=0;d_<2;++d_) _Pragma("unroll") for(int r=0;r<16;++r)o[d_][r]*=wsf[crow(r,hi)]; } }while(0)
  f32x16 pA0,pA1,pB0,pB1;
  int sl_prev=0,sl_cur=0,sl_next=SLOTB;
  #define ROT() do{sl_prev=sl_cur;sl_cur=sl_next;sl_next=(sl_next==(NSLOT-1)*SLOTB)?0:sl_next+SLOTB;}while(0)
  DMA_K(2,2*SLOTB);
  WAIT_BAR(3);
  base=cl3[q0-64*j0+wid*QBLK+r32];
  CINIT(pA0,pA1,0); qkt(pA0,pA1,Kbase,qr,r32,hi);asm volatile("s_nop 15\n\ts_nop 7":"+v"(pA0),"+v"(pA1));CMASK(pA0,pA1,0);
  START(pA0,pA1);
  _Pragma("unroll") for(int r=0;r<16;++r)pA1[r]=__builtin_amdgcn_exp2f(pA1[r]);
  WAIT_BAR(0);
  DMA_K(3,0);DMA_V(1,SLOTB);
  ROT();
  kload8(kf,kp0+sl_cur);
  WAIT_BAR(2);
  s16x4 vlo[8],vhi[8]; u32x4 pw0,pw1,pw2,pw3;
  #define PKW(P,B) cvtpk_s(P[B],P[B+1])
  #define PAF(k) __builtin_bit_cast(bf16x8,pw##k)
  #define VFR(i) (bf16x8){vlo[i][0],vlo[i][1],vlo[i][2],vlo[i][3],vhi[i][0],vhi[i][1],vhi[i][2],vhi[i][3]}
  #define PIN(x) asm volatile("":"+v"(x))
  #define MX3(a,b,c) __builtin_fmaxf(__builtin_fmaxf((a),(b)),(c))
  #define GAPA(MF,A0,A1,A2,A3,W0,W1,PW) do{ MF; sacc+=A0; sacc+=A1; sacc+=A2; sacc+=A3; PIN(sacc); W0; W1; PIN(PW); SBAR(); }while(0)
  #define EX(v) __builtin_amdgcn_exp2f(v)
  #define GAPB(MF,X,B) do{ MF; X[B]=EX(X[B]); X[B+1]=EX(X[B+1]); X[B+2]=EX(X[B+2]); X[B+3]=EX(X[B+3]); PIN(X); SBAR(); }while(0)
  #define VRD(i) do{ vlo[i]=vtr(vp_+(((i)>>2)*4096+((i)&3)*1024)); vhi[i]=vtr(vp_+(((i)>>2)*4096+((i)&3)*1024+512)); }while(0)
  #define KRD(G,j) do{ if(G){ kload2(kf,kp0+sl_next,j); SBAR(); } }while(0)
  #define STEP(C0,C1,P0,P1,t,GK,GV,GL) do{ SBAR(); CINIT(C0,C1,t); SBAR(); \
    const lds_cptr vp_=vp0+sl_prev; \
    VRD(0); SBAR(); float sacc=(P0[0]+P0[1]); \
    GAPA(C0=__builtin_amdgcn_mfma_f32_32x32x16_bf16(kf[0],qr[0],C0,0,0,0), P0[2],P0[3],P0[4],P0[5],     pw0[0]=PKW(P0,0), pw0[1]=PKW(P0,2), pw0); \
    VRD(4); SBAR(); GAPA(C1=__builtin_amdgcn_mfma_f32_32x32x16_bf16(kf[1],qr[0],C1,0,0,0), P0[6],P0[7],P0[8],P0[9],     pw0[2]=PKW(P0,4), pw0[3]=PKW(P0,6), pw0); \
    VRD(1); SBAR(); GAPA(C0=__builtin_amdgcn_mfma_f32_32x32x16_bf16(kf[2],qr[1],C0,0,0,0),   P0[10],P0[11],P0[12],P0[13], pw1[0]=PKW(P0,8), pw1[1]=PKW(P0,10), pw1); \
    VRD(5); SBAR(); GAPA(C1=__builtin_amdgcn_mfma_f32_32x32x16_bf16(kf[3],qr[1],C1,0,0,0),   P0[14],P0[15],P1[0],P1[1],   pw1[2]=PKW(P0,12),pw1[3]=PKW(P0,14), pw1); \
    VRD(2); SBAR(); GAPA(C0=__builtin_amdgcn_mfma_f32_32x32x16_bf16(kf[4],qr[2],C0,0,0,0),   P1[2],P1[3],P1[4],P1[5],     pw2[0]=PKW(P1,0), pw2[1]=PKW(P1,2), pw2); \
    VRD(6); SBAR(); GAPA(C1=__builtin_amdgcn_mfma_f32_32x32x16_bf16(kf[5],qr[2],C1,0,0,0),   P1[6],P1[7],P1[8],P1[9],     pw2[2]=PKW(P1,4), pw2[3]=PKW(P1,6), pw2); \
    VRD(3); SBAR(); GAPA(C0=__builtin_amdgcn_mfma_f32_32x32x16_bf16(kf[6],qr[3],C0,0,0,0),   P1[10],P1[11],P1[12],P1[13], pw3[0]=PKW(P1,8), pw3[1]=PKW(P1,10), pw3); \
    VRD(7); SBAR(); GAPA(C1=__builtin_amdgcn_mfma_f32_32x32x16_bf16(kf[7],qr[3],C1,0,0,0),   P1[14],P1[15],0.f,0.f,       pw3[2]=PKW(P1,12),pw3[3]=PKW(P1,14), pw3); \
    l_reg+=sacc; \
    if(GK){DMA_K((t)+3,sl_cur);} if(GV){DMA_V((t)+1,sl_next);} \
    CMASK(C0,C1,t); \
    { float a=MX3(C0[0],C0[1],C1[0]),b=MX3(C0[2],C0[3],C1[1]); a=MX3(a,C1[2],C1[3]); \
      _Pragma("unroll") for(int r=4;r<16;r+=4){a=MX3(a,C0[r],C0[r+1]);b=MX3(b,C0[r+2],C0[r+3]);a=MX3(a,C1[r],C1[r+1]);b=MX3(b,C1[r+2],C1[r+3]);} \
      float rm=__builtin_fmaxf(a,b); { auto rr=__builtin_amdgcn_permlane32_swap(__float_as_uint(rm),__float_as_uint(rm),false,false); rm=__builtin_fmaxf(__uint_as_float(rr[0]),__uint_as_float(rr[1])); } \
      resc=false; \
      if(__builtin_expect(__any(rm>(float)THRL),0)){ const float dl=__builtin_fmaxf(rm,0.f); base-=dl; \
        _Pragma("unroll") for(int r=0;r<16;++r){C0[r]-=dl;C1[r]-=dl;} \
        const float f=__builtin_amdgcn_exp2f(-dl); l_reg*=f; if(hi==0)wsf[r32]=f; resc=true; } } \
    SBAR(); \
    GAPB(o[0]=__builtin_amdgcn_mfma_f32_32x32x16_bf16(PAF(0),VFR(0),o[0],0,0,0), C0,0); \
    GAPB(o[1]=__builtin_amdgcn_mfma_f32_32x32x16_bf16(PAF(0),VFR(4),o[1],0,0,0), C0,4); \
    KRD(GL,0); GAPB(o[0]=__builtin_amdgcn_mfma_f32_32x32x16_bf16(PAF(1),VFR(1),o[0],0,0,0), C0,8); \
    KRD(GL,1); GAPB(o[1]=__builtin_amdgcn_mfma_f32_32x32x16_bf16(PAF(1),VFR(5),o[1],0,0,0), C0,12); \
    KRD(GL,2); GAPB(o[0]=__builtin_amdgcn_mfma_f32_32x32x16_bf16(PAF(2),VFR(2),o[0],0,0,0), C1,0); \
    KRD(GL,3); GAPB(o[1]=__builtin_amdgcn_mfma_f32_32x32x16_bf16(PAF(2),VFR(6),o[1],0,0,0), C1,4); \
    GAPB(o[0]=__builtin_amdgcn_mfma_f32_32x32x16_bf16(PAF(3),VFR(3),o[0],0,0,0), C1,8); \
    GAPB(o[1]=__builtin_amdgcn_mfma_f32_32x32x16_bf16(PAF(3),VFR(7),o[1],0,0,0), C1,12); \
    }while(0)
  int t=1;
  #undef CMASK
  #define CMASK(P0,P1,t) do{}while(0)
  for(;t+5<NT;t+=2){
    STEP(pB0,pB1,pA0,pA1,t,true,true,true);     WAIT_BAR(2); RESC(); ROT();
    STEP(pA0,pA1,pB0,pB1,t+1,true,true,true);   WAIT_BAR(2); RESC(); ROT();
  }
  #undef CMASK
  #define CMASK(P0,P1,t) do{int jb_=(t)-(NT-4); if(jb_>=0)cmask(P0,P1,jb_,qrel,hi);}while(0)
  #define ENDW(tt) do{ if((tt)+3<NT){WAIT_BAR(2);} else if((tt)+2<NT){WAIT_BAR(1);} else {WAIT_BAR(0);} }while(0)
  for(;t+1<NT;t+=2){
    STEP(pB0,pB1,pA0,pA1,t,(t+3<NT),(t+1<NT),(t+1<NT));       ENDW(t);   RESC(); ROT();
    STEP(pA0,pA1,pB0,pB1,t+1,(t+4<NT),(t+2<NT),(t+2<NT));     ENDW(t+1); RESC(); ROT();
  }
  STEP(pB0,pB1,pA0,pA1,NT-1,false,false,false); RESC();
  { float sacc=pB0[0]+pB0[1]; _Pragma("unroll") for(int r=2;r<16;++r)sacc+=pB0[r]; _Pragma("unroll") for(int r=0;r<16;++r)sacc+=pB1[r]; l_reg+=sacc;
    pw0=(u32x4){PKW(pB0,0),PKW(pB0,2),PKW(pB0,4),PKW(pB0,6)};pw1=(u32x4){PKW(pB0,8),PKW(pB0,10),PKW(pB0,12),PKW(pB0,14)};pw2=(u32x4){PKW(pB1,0),PKW(pB1,2),PKW(pB1,4),PKW(pB1,6)};pw3=(u32x4){PKW(pB1,8),PKW(pB1,10),PKW(pB1,12),PKW(pB1,14)};
    SBAR(); pv(o,vb0+sl_cur,PAF(0),PAF(1),PAF(2),PAF(3)); }
  #undef PKW
  #undef PAF
  #undef VFR
  #undef PIN
  #undef MX3
  #undef GAPA
  #undef GAPB
  #undef EX
  #undef VRD
  #undef KRD
  #undef STEP
  #undef ENDW
  {auto rr=__builtin_amdgcn_permlane32_swap(__float_as_uint(l_reg),__float_as_uint(l_reg),false,false);l_reg=__uint_as_float(rr[0])+__uint_as_float(rr[1]);}
  if(hi==0)wsf[32+r32]=l_reg;asm volatile("s_waitcnt lgkmcnt(0)":::"memory");
  float rli[16];
  #pragma unroll
  for(int r=0;r<16;++r)rli[r]=__builtin_amdgcn_rcpf(wsf[32+crow(r,hi)]);
  bf16*Ow=O+(rowbase+q0+wid*QBLK)*DMO;
  { bf16*stg=(bf16*)(shm+LDS_OST)+wid*2048;
    #pragma unroll
    for(int r=0;r<16;++r){const int orow=crow(r,hi);
      #pragma unroll
      for(int d0=0;d0<2;++d0)stg[orow*64+d0*32+r32]=__float2bfloat16(o[d0][r]*rli[r]);}
    asm volatile("s_waitcnt lgkmcnt(0)":::"memory");
    #pragma unroll
    for(int i=0;i<4;++i){const int row=i*8+(lane>>3),ch=lane&7; const u32x4 v=*(const u32x4*)(stg+row*64+ch*8); ATTN_STORE16(Ow+(long)row*DMO+ch*8,head_rms(v));} }
  asm volatile("s_waitcnt lgkmcnt(0)\n\ts_barrier":::"memory");
  #undef DMA_K
  #undef DMA_V
  #undef CMASK
  #undef CINIT
  #undef START
  #undef RESC
  #undef ROT
}
__device__ __forceinline__ float sp2f(float z){ const float e=__builtin_amdgcn_exp2f(-__builtin_fabsf(z)); return __builtin_fmaxf(z,0.f)+__builtin_amdgcn_logf(1.f+e); }
__device__ __forceinline__ void sb_unit(int b,int qb,const bf16*Q,const bf16*__restrict__ K,const bf16*__restrict__ V,bf16*O,char*shm){
  int tid_=threadIdx.x; asm volatile("":"+v"(tid_)); const int tid=tid_,lane=tid&63,r32=lane&31,hi=lane>>5; const int wid=__builtin_amdgcn_readfirstlane(tid>>6);
  const long rowbase=(long)b*SEQ; const int q0=qb*QB;
  const bf16*Qw=Q+(rowbase+q0+wid*QBLK)*DM;
  const bf16*Kh=K+rowbase*DM,*Vh=V+rowbase*DM;
  const unsigned lds0=(unsigned)(uintptr_t)shm; const lds_cptr shm3=(lds_cptr)shm;
  const bf16*ksrc=Kh+(long)lane*DM+wid*8;
  const bf16*vsrc=Vh+(long)(16*(wid&3)+(lane>>2))*DM+(wid>>2)*32+(lane&3)*8;
  const unsigned kdst=lds0+LDS_K+wid*1024, vdst=lds0+LDS_V+wid*1024;
  #define DMA_K(t,slot) glds16(ksrc+(long)(t)*KVBLK*DM,(unsigned)__builtin_amdgcn_readfirstlane(kdst+(slot)))
  #define DMA_V(t,slot) glds16(vsrc+(long)(t)*KVBLK*DM,(unsigned)__builtin_amdgcn_readfirstlane(vdst+(slot)))
  const int vb0=(int)(lds0+LDS_V)+((lane>>4)&1)*32+(lane&3)*8+(4*hi+((lane&15)>>2))*64;
  typedef __attribute__((address_space(3))) unsigned lds_u32;
  volatile lds_u32*flags=(volatile lds_u32*)(shm3+LDS_FLAGS);
  bf16x8 qr[4];
  #pragma unroll
  for(int d0=0;d0<4;++d0)qr[d0]=*reinterpret_cast<const bf16x8*>(&Qw[(long)r32*DM+d0*16+hi*8]);
  asm volatile("":::"memory");
  f32x16 o[2];o[0]=f32x16{};o[1]=f32x16{};
  float R=1.f; const int qabs=q0+wid*QBLK+r32; bool done=false;
  const int jtop=4*qb+3;
  DMA_K(jtop,0);DMA_V(jtop,0); DMA_K(jtop-1,SLOTB);DMA_V(jtop-1,SLOTB);
  int slot=0,slot2=2*SLOTB,bank=0;
  for(int j=jtop;j>=0;--j){
    if(j>0){ WAIT_BAR(2); } else { WAIT_BAR(0); }
    if(j<jtop){ unsigned alld=1u;
      #pragma unroll
      for(int w=0;w<NW;++w)alld&=flags[(bank^8)+w];
      if(alld)break; }
    if(j>=2){ DMA_K(j-2,slot2);DMA_V(j-2,slot2); }
    const bool active=(!done)&&(64*j<q0+wid*QBLK+31);
    if(active){
      f32x16 p0=f32x16{},p1=f32x16{};
      qkt(p0,p1,shm+LDS_K+slot,qr,r32,hi);
      const int kvb=64*j+4*hi; f32x16 s0,s1;
      if(64*j+63<q0+wid*QBLK){
        #pragma unroll
        for(int r=0;r<16;++r){
          const float e0=__builtin_amdgcn_exp2f(__builtin_fminf(p0[r],80.f)), e1=__builtin_amdgcn_exp2f(__builtin_fminf(p1[r],80.f));
          const float r0=__builtin_amdgcn_rcpf(1.f+e0), r1=__builtin_amdgcn_rcpf(1.f+e1);
          p0[r]=e0*r0; p1[r]=e1*r1; s0[r]=r0; s1[r]=r1; }
      } else {
        #pragma unroll
        for(int r=0;r<16;++r){ const int kv=kvb+(r&3)+8*(r>>2);
          const float e0=__builtin_amdgcn_exp2f(__builtin_fminf(p0[r],80.f)), e1=__builtin_amdgcn_exp2f(__builtin_fminf(p1[r],80.f));
          const float r0=__builtin_amdgcn_rcpf(1.f+e0), r1=__builtin_amdgcn_rcpf(1.f+e1);
          const bool v0=kv<qabs, v1=kv+32<qabs;
          p0[r]=v0?e0*r0:0.f; p1[r]=v1?e1*r1:0.f; s0[r]=v0?r0:1.f; s1[r]=v1?r1:1.f; }
      }
      float g0[4],g1[4],og0[4],og1[4],T0[4],T1[4];
      #pragma unroll
      for(int g=0;g<4;++g){ g0[g]=(s0[4*g]*s0[4*g+1])*(s0[4*g+2]*s0[4*g+3]); g1[g]=(s1[4*g]*s1[4*g+1])*(s1[4*g+2]*s1[4*g+3]); }
      #pragma unroll
      for(int g=0;g<4;++g){ og0[g]=__shfl_xor(g0[g],32); og1[g]=__shfl_xor(g1[g],32); }
      float run=R;
      #pragma unroll
      for(int g=3;g>=0;--g){ const float ah1=hi?g1[g]:og1[g], ah0=hi?og1[g]:g1[g]; const float t1=run; run*=ah1; const float t0=run; run*=ah0; T1[g]=hi?t1:t0; }
      #pragma unroll
      for(int g=3;g>=0;--g){ const float ah1=hi?g0[g]:og0[g], ah0=hi?og0[g]:g0[g]; const float t1=run; run*=ah1; const float t0=run; run*=ah0; T0[g]=hi?t1:t0; }
      R=run;
      #pragma unroll
      for(int g=0;g<4;++g){ float a0=T0[g],a1=T1[g];
        #pragma unroll
        for(int i=3;i>=0;--i){ const int r=4*g+i; p0[r]*=a0; p1[r]*=a1; a0*=s0[r]; a1*=s1[r]; } }
      u32x4 pw0,pw1,pw2,pw3;
      pw0=(u32x4){cvtpk_s(p0[0],p0[1]),cvtpk_s(p0[2],p0[3]),cvtpk_s(p0[4],p0[5]),cvtpk_s(p0[6],p0[7])};
      pw1=(u32x4){cvtpk_s(p0[8],p0[9]),cvtpk_s(p0[10],p0[11]),cvtpk_s(p0[12],p0[13]),cvtpk_s(p0[14],p0[15])};
      pw2=(u32x4){cvtpk_s(p1[0],p1[1]),cvtpk_s(p1[2],p1[3]),cvtpk_s(p1[4],p1[5]),cvtpk_s(p1[6],p1[7])};
      pw3=(u32x4){cvtpk_s(p1[8],p1[9]),cvtpk_s(p1[10],p1[11]),cvtpk_s(p1[12],p1[13]),cvtpk_s(p1[14],p1[15])};
      pv(o,vb0+slot,__builtin_bit_cast(bf16x8,pw0),__builtin_bit_cast(bf16x8,pw1),__builtin_bit_cast(bf16x8,pw2),__builtin_bit_cast(bf16x8,pw3));
      done=__all(R<1.0e-37f)!=0;
    }
    if(lane==0)flags[bank+wid]=done?1u:0u;
    bank^=8; slot=(slot==2*SLOTB)?0:slot+SLOTB; slot2=(slot2==2*SLOTB)?0:slot2+SLOTB;
  }
  asm volatile("s_waitcnt vmcnt(0)":::"memory");
  bf16*Ow=O+(rowbase+q0+wid*QBLK)*DMO;
  { bf16*stg=(bf16*)(shm+LDS_OST)+wid*2048;
    #pragma unroll
    for(int r=0;r<16;++r){const int orow=crow(r,hi);
      #pragma unroll
      for(int d0=0;d0<2;++d0)stg[orow*64+d0*32+r32]=__float2bfloat16(o[d0][r]);}
    asm volatile("s_waitcnt lgkmcnt(0)":::"memory");
    #pragma unroll
    for(int i=0;i<4;++i){const int row=i*8+(lane>>3),ch=lane&7; const u32x4 v=*(const u32x4*)(stg+row*64+ch*8); ATTN_STORE16(Ow+(long)row*DMO+ch*8,head_rms(v));} }
  asm volatile("s_waitcnt vmcnt(0) lgkmcnt(0)\n\ts_barrier":::"memory");
  #undef DMA_K
  #undef DMA_V
}
#undef SBAR
#undef WAIT_BAR
}
namespace cg = cooperative_groups;
constexpr int NWAVES = 8;
constexpr int DMODEL = 1024, NBATCH = 4, SEQ_IN = 8192, NMETA = 16, LREAL = NMETA + SEQ_IN, LP = 8448  ;
constexpr int MROWS = NBATCH * LP;
constexpr int MREAL = NBATCH * SEQ_IN;
constexpr int INW = 2566, NINP = 2560, NIN = 2816, DFF = 2816, NGU = 2 * DFF, DEPTH = 2, NFH = 6;
constexpr float C2F = 0.125f * 1.4426950408889634f;
constexpr int PC_U = 0, PC_FQ = 256, PC_FK = 640, PC_FV = 1024, PC_SQ = 1408, PC_SK = 1792, PC_SV = 2176;
constexpr size_t MiB = 1u << 20;
constexpr size_t WS_CTL = 0, CTL_ZERO_BYTES = 1 * MiB;
constexpr size_t WS_SS = 64 * 1024;
constexpr size_t WS_W = 1 * MiB, W_LAYER = 24 * MiB, W_IN = 0, W_OUT = (size_t)NIN * 1024 * 2, W_GU = W_OUT + 2 * MiB, W_D = W_GU + (size_t)NGU * 1024 * 2;
constexpr size_t WS_LF = 49 * MiB, WS_CS = 51 * MiB, WS_H = 52 * MiB, WS_HB = 184 * MiB, WS_Y = 250 * MiB, WS_P = 316 * MiB, WS_END = WS_P + (size_t)MROWS * DFF * 2;
static_assert(W_D + (size_t)1024 * DFF * 2 <= W_LAYER && WS_W + 2 * W_LAYER <= WS_LF && WS_SS + 5 * (size_t)MROWS * 4 <= CTL_ZERO_BYTES, "ws map");
static_assert(WS_H + (size_t)MROWS * 1024 * 4 <= WS_HB && WS_HB + (size_t)MROWS * 1024 * 2 <= WS_Y && WS_Y + (size_t)MROWS * 1024 * 2 <= WS_P && WS_END <= 512 * MiB, "ws map");
constexpr int LDS_BYTES = 147456;
constexpr int LDS_MISC = 131072;

#define LAS __attribute__((address_space(3)))
typedef unsigned short bf16u;
typedef unsigned v4u __attribute__((ext_vector_type(4)));
typedef float f32x4 __attribute__((ext_vector_type(4)));
#define LDS_WAIT() asm volatile("s_waitcnt lgkmcnt(0)" ::: "memory")
__device__ __forceinline__ unsigned f2bf(float f) { unsigned u = __builtin_bit_cast(unsigned, f); return (u + 0x7fffu + ((u >> 16) & 1u)) >> 16; }
__device__ __forceinline__ unsigned pk2(float lo, float hi) { return f2bf(lo) | (f2bf(hi) << 16); }
__device__ __forceinline__ float wave_sum(float v) {
#pragma unroll
    for (int o = 1; o < 64; o <<= 1) v += __shfl_xor(v, o);
    return v;
}

struct Args { const float* in[15]; float* out; unsigned char* ws; };

struct WinSrc { const float* w; const float* g;
    __device__ __forceinline__ float operator()(int k, int n) const { if (n >= INW) return 0.f; const int col = n < 1408 ? n : (n < 2560 ? n + 6 : n - 2560 + 1408);
        const float sc = ((n >= PC_FQ && n < PC_FK) || (n >= PC_SQ && n < PC_SK)) ? C2F : 1.0f; return w[(size_t)k * INW + col] * g[k] * sc; } };
struct WoutSrc { const float* w; const float* fg; const float* sg;
    __device__ __forceinline__ float operator()(int k, int n) const { const float gn = k < 640 ? fg[k - 256] : sg[k - 640]; return w[(size_t)k * 1024 + n] * gn; } };
struct WguSrc { const float* wg; const float* wu; const float* g;
    __device__ __forceinline__ float operator()(int k, int c) const { const int pn = c >> 8, w = c & 255, j = pn * 128 + (w & 127); const long dlt = (w >> 7) ? (long)(wu - wg) : 0L; return wg[(long)k * DFF + j + dlt] * g[k]; } };
struct WdSrc { const float* w;
    __device__ __forceinline__ float operator()(int k, int n) const { return w[(size_t)k * 1024 + n]; } };
template <class F> __device__ __forceinline__ void conv_item(const F src, bf16u* WT, int K, int k0, int n0, LAS float* scr, int lane) {
    float tv[32];
#pragma unroll
    for (int i = 0; i < 32; ++i) tv[i] = src(k0 + 2 * i + (lane >> 5), n0 + (lane & 31));
#pragma unroll
    for (int i = 0; i < 32; ++i) scr[(2 * i + (lane >> 5)) * 33 + (lane & 31)] = tv[i];
    LDS_WAIT(); asm volatile("" ::: "memory");
    const int c = lane & 7;
#pragma unroll
    for (int j = 0; j < 4; ++j) { const int n = (lane >> 3) + 8 * j; const LAS float* s = scr + (8 * c) * 33 + n;
        v4u o; o.x = pk2(s[0 * 33], s[1 * 33]); o.y = pk2(s[2 * 33], s[3 * 33]); o.z = pk2(s[4 * 33], s[5 * 33]); o.w = pk2(s[6 * 33], s[7 * 33]);
        *(v4u*)(WT + (size_t)(n0 + n) * K + k0 + 8 * c) = o; }
    LDS_WAIT(); asm volatile("" ::: "memory");
}
__device__ __forceinline__ void fold_block_item(const float* wout, const float* pw, const float* ps, bf16u* WT, int item, LAS float* lds, int tid) {
    const int g = item >> 4, n0 = (item & 15) * 64;
    LAS float* At = lds; LAS float* Wt = lds + 4096;
    for (int i = tid; i < 4096; i += NWAVES * 64) { At[(i & 63) * 64 + (i >> 6)] = pw[(size_t)g * 4096 + i]; const int d = i >> 6; Wt[i] = wout[(size_t)(g * 64 + d) * 1024 + n0 + (i & 63)] * ps[g * 64 + d]; }
    __syncthreads();
    const int c0 = (tid >> 6) * 8, nn = tid & 63; f32x4 a0 = (f32x4){0.f, 0.f, 0.f, 0.f}, a1 = a0;
#pragma unroll 8
    for (int d = 0; d < 64; ++d) { const float w = Wt[d * 64 + nn]; a0 += *(const LAS f32x4*)(At + d * 64 + c0) * w; a1 += *(const LAS f32x4*)(At + d * 64 + c0 + 4) * w; }
    v4u o; o.x = pk2(a0[0], a0[1]); o.y = pk2(a0[2], a0[3]); o.z = pk2(a1[0], a1[1]); o.w = pk2(a1[2], a1[3]);
    *(v4u*)(WT + (size_t)(n0 + nn) * 1024 + g * 64 + c0) = o;
    __syncthreads();
}
__device__ __forceinline__ void p0_prologue(const Args& A, unsigned char* ws, LAS unsigned char* lds, int wave, int lane) {
    LAS float* scr = (LAS float*)(lds + wave * 16384);
    const int gw = blockIdx.x * NWAVES + wave, NGW = gridDim.x * NWAVES;
    constexpr int I_IN = 16 * (NIN / 32), I_OUT = 12 * 32, I_GU = 16 * (NGU / 32), I_D = (DFF / 64) * 32, I_L = I_IN + I_OUT + I_GU + I_D;
    for (int bi = blockIdx.x; bi < DEPTH * 64; bi += gridDim.x) { const int L = bi >> 6;
        fold_block_item(A.in[9] + (size_t)L * 1024 * 1024, A.in[5] + (size_t)L * 4 * 64 * 64, A.in[6] + L * 256, (bf16u*)(ws + WS_W + (size_t)L * W_LAYER + W_OUT), bi & 63, (LAS float*)lds, wave * 64 + lane); }
    for (int it = gw; it < DEPTH * I_L; it += NGW) {
        const int L = it / I_L; int r = it % I_L;
        bf16u* wb = (bf16u*)(ws + WS_W + (size_t)L * W_LAYER);
        if (r < I_IN) { WinSrc s{A.in[3] + (size_t)L * 1024 * INW, A.in[2] + L * 1024}; conv_item(s, (bf16u*)((unsigned char*)wb + W_IN), 1024, (r / (NIN / 32)) * 64, (r % (NIN / 32)) * 32, scr, lane); continue; } r -= I_IN;
        if (r < I_OUT) { WoutSrc s{A.in[9] + (size_t)L * 1024 * 1024, A.in[7] + L * 384, A.in[8] + L * 384}; conv_item(s, (bf16u*)((unsigned char*)wb + W_OUT), 1024, 256 + (r / 32) * 64, (r % 32) * 32, scr, lane); continue; } r -= I_OUT;
        if (r < I_GU) { WguSrc s{A.in[11] + (size_t)L * 1024 * DFF, A.in[12] + (size_t)L * 1024 * DFF, A.in[10] + L * 1024}; conv_item(s, (bf16u*)((unsigned char*)wb + W_GU), 1024, (r / (NGU / 32)) * 64, (r % (NGU / 32)) * 32, scr, lane); continue; } r -= I_GU;
        { WdSrc s{A.in[13] + (size_t)L * DFF * 1024}; conv_item(s, (bf16u*)((unsigned char*)wb + W_D), DFF, (r / 32) * 64, (r % 32) * 32, scr, lane); }
    }
    bf16u* hb = (bf16u*)(ws + WS_HB); float* ss0 = (float*)(ws + WS_SS);
    for (int m0 = gw * 4; m0 < MROWS; m0 += NGW * 4) {
        f32x4 v[4][4]; float s[4];
#pragma unroll
        for (int q = 0; q < 4; ++q) { const int m = m0 + q, b = m / LP, t = m % LP; s[q] = 0.f;
            if (t < LREAL) { const f32x4* src = (const f32x4*)(t < NMETA ? A.in[1] + (size_t)t * 1024 : A.in[0] + ((size_t)b * SEQ_IN + (t - NMETA)) * 1024) + lane;
#pragma unroll
                for (int j = 0; j < 4; ++j) v[q][j] = src[64 * j]; }
            else {
#pragma unroll
                for (int j = 0; j < 4; ++j) v[q][j] = (f32x4){0.f, 0.f, 0.f, 0.f}; } }
#pragma unroll
        for (int q = 0; q < 4; ++q) { const int m = m0 + q;
#pragma unroll
            for (int j = 0; j < 4; ++j) s[q] += (v[q][j].x * v[q][j].x + v[q][j].y * v[q][j].y) + (v[q][j].z * v[q][j].z + v[q][j].w * v[q][j].w);
            s[q] = wave_sum(s[q]);
            unsigned long long* bo = (unsigned long long*)(hb + (size_t)m * 1024) + lane;
#pragma unroll
            for (int j = 0; j < 4; ++j) bo[64 * j] = (unsigned long long)pk2(v[q][j].x, v[q][j].y) | ((unsigned long long)pk2(v[q][j].z, v[q][j].w) << 32);
            if (lane == 0) ss0[m] = s[q]; }
    }
}
typedef short bf16x8m __attribute__((ext_vector_type(8)));
template <int NBK> __device__ __forceinline__ void mini_item(f32x4 (&acc)[NBK], const bf16u* A16, const bf16u* Bt0, const bf16u* Bt1, int K, LAS unsigned char* lds, int wave, int lane) {
    const int fr = lane & 15, fq = lane >> 4, kw = K >> 3; const size_t o = (size_t)fr * K + wave * kw + 8 * fq;
#pragma unroll
    for (int nb = 0; nb < NBK; ++nb) acc[nb] = (f32x4){0.f, 0.f, 0.f, 0.f};
    for (int k = 0; k < kw; k += 32) { const bf16x8m a = *(const bf16x8m*)(A16 + o + k); const bf16x8m b0 = *(const bf16x8m*)(Bt0 + o + k);
        acc[0] = __builtin_amdgcn_mfma_f32_16x16x32_bf16(b0, a, acc[0], 0, 0, 0);
        if (NBK == 2) { const bf16x8m b1 = *(const bf16x8m*)(Bt1 + o + k); acc[NBK - 1] = __builtin_amdgcn_mfma_f32_16x16x32_bf16(b1, a, acc[NBK - 1], 0, 0, 0); } }
    LAS f32x4* red = (LAS f32x4*)lds;
#pragma unroll
    for (int nb = 0; nb < NBK; ++nb) red[(nb * 8 + wave) * 64 + lane] = acc[nb];
    __syncthreads();
    if (wave == 0) {
#pragma unroll
        for (int nb = 0; nb < NBK; ++nb) { f32x4 s = red[(nb * 8) * 64 + lane];
#pragma unroll
            for (int w = 1; w < 8; ++w) s += red[(nb * 8 + w) * 64 + lane];
            acc[nb] = s; } }
    __syncthreads();
}
__device__ __forceinline__ void mini_in(unsigned char* ws, const bf16u* wt, const float* ss, const float* fb, LAS unsigned char* lds, int wave, int lane) {
    const bf16u* A16 = (const bf16u*)(ws + WS_HB); bf16u* P = (bf16u*)(ws + WS_P); float* LF = (float*)(ws + WS_LF);
    for (int it = blockIdx.x; it < 161; it += gridDim.x) { const int n0 = it * 16; f32x4 acc[1];
        mini_item<1>(acc, A16, wt + (size_t)n0 * 1024, nullptr, 1024, lds, wave, lane);
        if (wave == 0) { const int fr = lane & 15, fq = lane >> 4; const float rs = __builtin_amdgcn_rsqf(ss[fr] * (1.0f / 1024.0f) + 1e-6f); const f32x4 v = acc[0] * rs;
            if (n0 < NINP) { const unsigned long long w = (unsigned long long)pk2(v[0], v[1]) | ((unsigned long long)pk2(v[2], v[3]) << 32);
#pragma unroll
                for (int b = 0; b < NBATCH; ++b) *(unsigned long long*)(P + ((size_t)b * LP + fr) * NINP + n0 + 4 * fq) = w; }
            else if (fq < 2) { f32x4 l;
#pragma unroll
                for (int i = 0; i < 4; ++i) { const int c = 4 * fq + i; const float x = v[i] + fb[c < NFH ? c : 0]; l[i] = c < NFH ? -(fmaxf(-x, 0.f) + log1pf(expf(-fabsf(x)))) * 1.4426950408889634f : 0.f; }
#pragma unroll
                for (int b = 0; b < NBATCH; ++b) *(f32x4*)(LF + ((size_t)b * LP + fr) * 8 + 4 * fq) = l; } }
    }
}
__device__ __forceinline__ void mini_res(unsigned char* ws, const bf16u* A16, const bf16u* wt, int K, float* ssn, LAS unsigned char* lds, int wave, int lane) {
    bf16u* hb = (bf16u*)(ws + WS_HB);
    for (int it = blockIdx.x; it < 64; it += gridDim.x) { const int n0 = it * 16; f32x4 acc[1];
        mini_item<1>(acc, A16, wt + (size_t)n0 * K, nullptr, K, lds, wave, lane);
        if (wave == 0) { const int fr = lane & 15, fq = lane >> 4; unsigned long long* bp = (unsigned long long*)(hb + (size_t)fr * 1024 + n0 + 4 * fq); const unsigned long long r = *bp; const unsigned rl = (unsigned)r, rh = (unsigned)(r >> 32);
            const f32x4 a = (f32x4){__uint_as_float(rl << 16), __uint_as_float(rl & 0xffff0000u), __uint_as_float(rh << 16), __uint_as_float(rh & 0xffff0000u)} + acc[0];
            *bp = (unsigned long long)pk2(a[0], a[1]) | ((unsigned long long)pk2(a[2], a[3]) << 32);
            float s = (a[0] * a[0] + a[1] * a[1]) + (a[2] * a[2] + a[3] * a[3]); s += __shfl_xor(s, 16); s += __shfl_xor(s, 32);
            if (fq == 0) atomicAdd(ssn + fr, s); }
    }
}
__device__ __forceinline__ void mini_gu(unsigned char* ws, const bf16u* wt, const float* ss, LAS unsigned char* lds, int wave, int lane) {
    const bf16u* A16 = (const bf16u*)(ws + WS_HB); bf16u* H = (bf16u*)(ws + WS_P);
    for (int it = blockIdx.x; it < DFF / 16; it += gridDim.x) { const int j0 = it * 16, cg = (j0 >> 7) * 256 + (j0 & 127); f32x4 acc[2];
        mini_item<2>(acc, A16, wt + (size_t)cg * 1024, wt + (size_t)(cg + 128) * 1024, 1024, lds, wave, lane);
        if (wave == 0) { const int fr = lane & 15, fq = lane >> 4; const float rs = __builtin_amdgcn_rsqf(ss[fr] * (1.0f / 1024.0f) + 1e-6f); float o[4];
#pragma unroll
            for (int i = 0; i < 4; ++i) { const float g = acc[0][i] * rs, up = acc[1][i] * rs; o[i] = g * __builtin_amdgcn_rcpf(1.0f + __builtin_amdgcn_exp2f(-1.4426950408889634f * g)) * up; }
            *(unsigned long long*)(H + (size_t)fr * DFF + j0 + 4 * fq) = (unsigned long long)pk2(o[0], o[1]) | ((unsigned long long)pk2(o[2], o[3]) << 32); }
    }
}
__device__ __forceinline__ void fl_phase(unsigned char* ws, const bf16u* wt  , const float* ss, const float* fb, int wave, int lane) {
    const bf16u* HBp = (const bf16u*)(ws + WS_HB); float* LF = (float*)(ws + WS_LF);
    const int fr = lane & 15, fq = lane >> 4;
    for (int it = blockIdx.x * NWAVES + wave; it < MREAL / 16; it += gridDim.x * NWAVES) {
        const int m0 = it * 16, row0 = (m0 / SEQ_IN) * LP + NMETA + (m0 % SEQ_IN);
        const bf16u* ap = HBp + (size_t)(row0 + fr) * 1024 + 8 * fq; const bf16u* bp = wt + (size_t)fr * 1024 + 8 * fq;
        f32x4 acc = (f32x4){0.f, 0.f, 0.f, 0.f};
#pragma unroll 8
        for (int k = 0; k < 1024; k += 32) { const bf16x8m a = *(const bf16x8m*)(ap + k); const bf16x8m b = *(const bf16x8m*)(bp + k); acc = __builtin_amdgcn_mfma_f32_16x16x32_bf16(b, a, acc, 0, 0, 0); }
        if (fq < 2) { const int row = row0 + fr; const float rs = __builtin_amdgcn_rsqf(ss[row] * (1.0f / 1024.0f) + 1e-6f); f32x4 l;
#pragma unroll
            for (int i = 0; i < 4; ++i) { const int c = 4 * fq + i; const float x = acc[i] * rs + fb[c < NFH ? c : 0]; l[i] = c < NFH ? -(fmaxf(-x, 0.f) + log1pf(expf(-fabsf(x)))) * 1.4426950408889634f : 0.f; }
            *(f32x4*)(LF + (size_t)row * 8 + 4 * fq) = l; }
    }
}
__device__ __forceinline__ void pool_scan_phase(unsigned char* ws, LAS unsigned char* lds, unsigned* nrm, int tid, int wave, int lane) {
    const float* LF = (const float*)(ws + WS_LF); float* CS = (float*)(ws + WS_CS);
    if (blockIdx.x < NBATCH * NFH) {
        const int b = blockIdx.x / NFH, hf = blockIdx.x % NFH; constexpr int PER = 17;
        const float* lf = LF + (size_t)b * LP * 8 + hf; float* cs = CS + (size_t)(b * NFH + hf) * LP;
        float v[PER]; float s = 0.f; const int t0 = tid * PER;
#pragma unroll
        for (int i = 0; i < PER; ++i) { const int t = t0 + i; const float x = t < LREAL ? lf[(size_t)t * 8] : 0.f; s += x; v[i] = s; }
        float incl = s;
#pragma unroll
        for (int o = 1; o < 64; o <<= 1) { const float n = __shfl_up(incl, o); if (lane >= o) incl += n; }
        LAS float* wsum = (LAS float*)(lds + LDS_MISC + 256);
        if (lane == 63) wsum[wave] = incl;
        __syncthreads();
        float off = 0.f;
        for (int w = 0; w < wave; ++w) off += wsum[w];
        const float excl = off + incl - s;
#pragma unroll
        for (int i = 0; i < PER; ++i) { const int t = t0 + i; if (t < LREAL) cs[t] = excl + v[i]; }
        __syncthreads();
    }
    const bf16u* P = (const bf16u*)(ws + WS_P); bf16u* Y = (bf16u*)(ws + WS_Y);
    LAS float* nsc_ = (LAS float*)(lds + LDS_MISC + 512);
    for (int sl = blockIdx.x; sl < 256; sl += gridDim.x) {
        if (tid < 480) { const int sub = tid / 96, task = tid % 96, which = task / 48, head = (task % 48) >> 3, chunk = task & 7; const int r0 = sl * (MROWS / 256), b = r0 / LP;
            const bf16u* src = P + (which ? PC_FK : PC_FQ) + head * 64 + chunk * 8; float mx = 0.f;
#pragma unroll 9
            for (int r = sub; r < MROWS / 256; r += 5) { const v4u w = ((r0 + r) % LP < LREAL) ? *(const v4u*)(src + (size_t)(r0 + r) * NINP) : (v4u){0u, 0u, 0u, 0u}; float s = 0.f;
#pragma unroll
                for (int e = 0; e < 4; ++e) { const float lo = __uint_as_float(w[e] << 16), hi = __uint_as_float(w[e] & 0xffff0000u); s += lo * lo + hi * hi; }
                s += __shfl_xor(s, 1); s += __shfl_xor(s, 2); s += __shfl_xor(s, 4); mx = fmaxf(mx, s); }
            if (chunk == 0) nsc_[sub * 12 + head * 2 + which] = mx; }
        __syncthreads();
        if (tid < 12) { const int b = (sl * (MROWS / 256)) / LP; float mx = nsc_[tid];
#pragma unroll
            for (int s5 = 1; s5 < 5; ++s5) mx = fmaxf(mx, nsc_[s5 * 12 + tid]);
            atomicMax(nrm + b * NFH * 2 + tid, __float_as_uint(mx)); }
        __syncthreads();
    }
}
__device__ __forceinline__ void pool_chunk(unsigned char* ws, int c, int tid) {
    const bf16u* P = (const bf16u*)(ws + WS_P); bf16u* Y = (bf16u*)(ws + WS_Y);
    const int rsub = tid >> 5, ch = (tid & 31) * 8, win = 2 << (ch >> 6);
    {
        const int rg = c * 64 + rsub * 4, t0 = rg % LP;
        v4u wv[19];
#pragma unroll
        for (int j = 0; j < 19; ++j) { const int back = 15 - j;
            wv[j] = (back < win && t0 - back >= 0) ? *(const v4u*)(P + (size_t)(rg - back) * NINP + PC_U + ch) : (v4u){0u, 0u, 0u, 0u}; }
#pragma unroll
        for (int i = 0; i < 4; ++i) { const int t = t0 + i, cnt = (t + 1 < win) ? t + 1 : win; float acc[8];
#pragma unroll
            for (int e = 0; e < 8; ++e) acc[e] = 0.f;
#pragma unroll
            for (int k = 0; k < 16; ++k) { if (k < cnt) {
#pragma unroll
                for (int e = 0; e < 4; ++e) { acc[2 * e] += __uint_as_float(wv[15 + i - k][e] << 16); acc[2 * e + 1] += __uint_as_float(wv[15 + i - k][e] & 0xffff0000u); } } }
            const float inv = 1.0f / (float)cnt; v4u o;
#pragma unroll
            for (int e = 0; e < 4; ++e) o[e] = pk2(acc[2 * e] * inv - __uint_as_float(wv[15 + i][e] << 16), acc[2 * e + 1] * inv - __uint_as_float(wv[15 + i][e] & 0xffff0000u));
            *(v4u*)(Y + (size_t)(rg + i) * 1024 + ch) = o; }
    }
}
__device__ __forceinline__ void attn_phase(unsigned char* ws, unsigned char* lds_g, unsigned* ctr, const unsigned* nrm, int tid) {
    const attn_body::bf16* P = (const attn_body::bf16*)(ws + WS_P); attn_body::bf16* Y = (attn_body::bf16*)(ws + WS_Y); const float* CS = (const float*)(ws + WS_CS);
    volatile LAS unsigned* bw = (volatile LAS unsigned*)((LAS unsigned char*)lds_g + LDS_MISC);
    constexpr int NU = NBATCH * NFH * (LP / 256);
    for (;;) {
        if (tid == 0) bw[0] = atomicAdd(ctr, 1u);
        __syncthreads();
        const int it = (int)bw[0];
        __syncthreads();
        if (it >= 2 * NU + MROWS / 64) break;
#ifdef PROBE
        if (it == 2 * NU && tid == 0) ((volatile unsigned long long*)(ws + WS_CTL + 8192))[22 + (ctr != (unsigned*)(ws + WS_CTL))] = __builtin_amdgcn_s_memrealtime();
#endif
        if (it >= 2 * NU) { pool_chunk(ws, it - 2 * NU, tid); continue; }
#ifdef PROBE
        if (it == NU && tid == 0) ((volatile unsigned long long*)(ws + WS_CTL + 8192))[20 + (ctr != (unsigned*)(ws + WS_CTL))] = __builtin_amdgcn_s_memrealtime();
#endif
        constexpr int NF1 = 17 * NBATCH * NFH;
        const bool is_fox = it < NF1 || it >= NF1 + NU; const int r = it < NF1 ? it : (it < NF1 + NU ? it - NF1 : it - NU); const int qb = (LP / 256 - 1) - r / (NBATCH * NFH), bh = r % (NBATCH * NFH), b = bh / NFH, h = bh % NFH;
#ifndef NO_FOX
        if (is_fox) attn_body::fox_unit<8>(b, qb, 154.0f + 2.0f * sqrtf(__uint_as_float(nrm[bh * 2]) * __uint_as_float(nrm[bh * 2 + 1])), P + PC_FQ + h * 64, P + PC_FK + h * 64, P + PC_FV + h * 64, Y + 256 + h * 64, CS + (size_t)bh * LP, (char*)lds_g);
#endif
#ifndef NO_SB
        if (!is_fox) attn_body::sb_unit(b, qb, P + PC_SQ + h * 64, P + PC_SK + h * 64, P + PC_SV + h * 64, Y + 640 + h * 64, (char*)lds_g);
#endif
    }
}
__device__ __forceinline__ void final_phase(const Args& A, unsigned char* ws, int wave, int lane) {
    const bf16u* hb = (const bf16u*)(ws + WS_HB); const float* ss = (const float*)(ws + WS_SS) + 4 * (size_t)MROWS; const f32x4* g = (const f32x4*)A.in[14] + lane;
    const int gw = blockIdx.x * NWAVES + wave, NGW = gridDim.x * NWAVES;
    f32x4 gv[4];
#pragma unroll
    for (int j = 0; j < 4; ++j) gv[j] = g[64 * j];
    for (int m0 = gw * 2; m0 < NBATCH * SEQ_IN; m0 += NGW * 2) {
        unsigned long long r[2][4]; float rs[2];
#pragma unroll
        for (int q = 0; q < 2; ++q) { const int m = m0 + q, b = m / SEQ_IN, s = m % SEQ_IN; const size_t row = (size_t)b * LP + NMETA + s;
            rs[q] = 1.0f / sqrtf(ss[row] * (1.0f / 1024.0f) + 1e-6f);
            const unsigned long long* src = (const unsigned long long*)(hb + row * 1024) + lane;
#pragma unroll
            for (int j = 0; j < 4; ++j) r[q][j] = src[64 * j]; }
#pragma unroll
        for (int q = 0; q < 2; ++q) { f32x4* dst = (f32x4*)(A.out + (size_t)(m0 + q) * 1024) + lane;
#pragma unroll
            for (int j = 0; j < 4; ++j) { const unsigned rl = (unsigned)r[q][j], rh = (unsigned)(r[q][j] >> 32);
                dst[64 * j] = (f32x4){__uint_as_float(rl << 16), __uint_as_float(rl & 0xffff0000u), __uint_as_float(rh << 16), __uint_as_float(rh & 0xffff0000u)} * rs[q] * gv[j]; } }
    }
}

#define XB_TMO      128
#define XB_XCNT(j)  (256  + 64 * (j))
#define XB_XSUB(j)  (1280 + 64 * (j))
#define XB_XGEN(j)  (2304 + 64 * (j))
#define XB_TOP      3328
#define XB_TOPGEN   3392
#define XCD_BAR_WORDS 3456
#define XB_SPIN_CAP (1u << 18)

__device__ __forceinline__ unsigned xb_ld(unsigned* p)              { return __hip_atomic_load(p, __ATOMIC_RELAXED, __HIP_MEMORY_SCOPE_AGENT); }
__device__ __forceinline__ unsigned xb_add(unsigned* p, unsigned v) { return __hip_atomic_fetch_add(p, v, __ATOMIC_RELAXED, __HIP_MEMORY_SCOPE_AGENT); }
__device__ __forceinline__ unsigned xb_xcc_id() { return (unsigned)__builtin_amdgcn_s_getreg((3 << 11) | 20) & 0xFu; }
#define XB_SPIN(cond, bar) do { unsigned _sp = 0; while (cond) { __builtin_amdgcn_s_sleep(1); \
    if ((++_sp & 255u) == 0u) { if (xb_ld(&(bar)[XB_TMO])) break; if (_sp > XB_SPIN_CAP) { atomicAdd(&(bar)[XB_TMO], 1u); break; } } } } while (0)

struct XcdBarrier {
    unsigned* bar; unsigned x;
    volatile LAS unsigned* st;
};

__device__ __forceinline__ XcdBarrier xcd_barrier_post(unsigned* bar, volatile LAS unsigned* st) {
    XcdBarrier b; b.bar = bar; b.x = xb_xcc_id(); b.st = st;
    if (threadIdx.x == 0) (void)xb_add(&bar[XB_XCNT(b.x)], 1u);
    return b;
}
__device__ __forceinline__ void xcd_barrier_complete(unsigned* bar, unsigned x, unsigned& nloc, unsigned& nx) {
    const unsigned G = gridDim.x * gridDim.y * gridDim.z;
    unsigned sum, cnt, mine, sp = 0u;
    for (;;) {
        sum = 0u; cnt = 0u; mine = 0u;
#pragma unroll
        for (unsigned j = 0; j < 16; ++j) { const unsigned c = xb_ld(&bar[XB_XCNT(j)]); sum += c; cnt += (c > 0u) ? 1u : 0u; mine = (j == x) ? c : mine; }
        if (sum == G) break;
        __builtin_amdgcn_s_sleep(1);
        if ((++sp & 255u) == 0u) { if (xb_ld(&bar[XB_TMO])) break; if (sp > XB_SPIN_CAP) { atomicAdd(&bar[XB_TMO], 1u); break; } }
    }
    nloc = mine > 0u ? mine : 1u; nx = cnt > 0u ? cnt : 1u;
}

__device__ __forceinline__ void xcd_barrier(const XcdBarrier& b) {
    asm volatile("s_waitcnt vmcnt(0)" ::: "memory");
    __syncthreads();
    if (threadIdx.x == 0) {
        unsigned* bar = b.bar;
        __builtin_amdgcn_s_waitcnt(0);
        unsigned nloc = b.st[0], nx = b.st[1];
        if (nloc == 0u) { xcd_barrier_complete(bar, b.x, nloc, nx); b.st[0] = nloc; b.st[1] = nx; }
        const unsigned old = xb_add(&bar[XB_XSUB(b.x)], 1u);
        const unsigned gen = old / nloc;
        if (old + 1u == (gen + 1u) * nloc) {
            __builtin_amdgcn_fence(__ATOMIC_RELEASE, "agent");
            asm volatile("s_waitcnt vmcnt(0)" ::: "memory");
            const unsigned og = xb_add(&bar[XB_TOP], 1u);
            const unsigned tg = og / nx;
            if (og + 1u == (tg + 1u) * nx) xb_add(&bar[XB_TOPGEN], 1u);
            else XB_SPIN(xb_ld(&bar[XB_TOPGEN]) == tg, bar);
            __builtin_amdgcn_fence(__ATOMIC_ACQUIRE, "agent");
            xb_add(&bar[XB_XGEN(b.x)], 1u);
            asm volatile("s_waitcnt vmcnt(0)" ::: "memory");
        } else {
            XB_SPIN(xb_ld(&bar[XB_XGEN(b.x)]) == gen, bar);
            __builtin_amdgcn_fence(__ATOMIC_ACQUIRE, "agent");
            asm volatile("s_waitcnt vmcnt(0)" ::: "memory");
        }
    }
    __syncthreads();
}

#define FRESH() unsigned long zoff_ = 0; asm volatile("" : "+s"(zoff_)); unsigned char* ws = A.ws + zoff_; int tid = threadIdx.x; asm volatile("" : "+v"(tid)); const int lane = tid & 63, wave = __builtin_amdgcn_readfirstlane(tid >> 6); (void)lane; (void)wave
#ifdef PROBE
#define STAMP() do { if (blockIdx.x == 0 && threadIdx.x == 0) { ((volatile unsigned long long*)(A.ws + WS_CTL + 8192))[nst] = __builtin_amdgcn_s_memrealtime(); } ++nst; } while (0)
#else
#define STAMP() do {} while (0)
#endif
__global__ void __launch_bounds__(NWAVES * 64, 2) hymba_fwd(Args A) {
    extern __shared__ __attribute__((aligned(16))) unsigned char lds[];
    cg::grid_group grid = cg::this_grid();
    LAS unsigned char* L = (LAS unsigned char*)lds;
    if (threadIdx.x < 2) ((volatile LAS unsigned*)(L + LDS_MISC + 64))[threadIdx.x] = 0u;
    __syncthreads();
    const XcdBarrier xbar = xcd_barrier_post((unsigned*)(A.ws + WS_CTL) + 4096, (volatile LAS unsigned*)(L + LDS_MISC + 64));
#define GRID_BAR() xcd_barrier(xbar)
#ifdef PROBE
    int nst = 0; STAMP();
    for (int i = 0; i < 8; ++i) GRID_BAR();
    STAMP();
#endif
#ifndef NO_PRO
    { FRESH(); p0_prologue(A, ws, L, wave, lane); }
#endif
    if (A.ws == nullptr) grid.sync();
    GRID_BAR(); STAMP();
    for (int layer = 0; layer < DEPTH; ++layer) {
#ifndef NO_G1
        {
            FRESH(); const unsigned char* wb = ws + WS_W + (size_t)layer * W_LAYER;
            pg8::Gemm g{(const pg8::bf16_t*)(ws + WS_HB), (const pg8::bf16_t*)(wb + W_IN), MREAL, NINP, 1024}; pg8::StaticOrder S; S.init(MREAL, NINP, (int)gridDim.x, (int)blockIdx.x);
            pg8::EpiIn E{(pg8::bf16_t*)(ws + WS_P), (float*)(ws + WS_LF), (const float*)(ws + WS_SS) + (size_t)(2 * layer) * MROWS, A.in[4] + layer * NFH};
            fl_phase(ws, (const bf16u*)(wb + W_IN) + (size_t)NINP * 1024, (const float*)(ws + WS_SS) + (size_t)(2 * layer) * MROWS, A.in[4] + layer * NFH, wave, lane);
            mini_in(ws, (const bf16u*)(wb + W_IN), (const float*)(ws + WS_SS) + (size_t)(2 * layer) * MROWS, A.in[4] + layer * NFH, L, wave, lane);
            pg8::gemm_phase<pg8::EpiIn, pg8::StaticOrder, true, true>(L, g, S, E);
        }
#endif
        GRID_BAR(); STAMP();
#ifndef NO_POOL
        { FRESH(); pool_scan_phase(ws, L, (unsigned*)(ws + WS_CTL) + 128 + 64 * layer, tid, wave, lane); }
#endif
        GRID_BAR(); STAMP();
        { FRESH(); attn_phase(ws, lds, (unsigned*)(ws + WS_CTL) + 64 * layer, (const unsigned*)(ws + WS_CTL) + 128 + 64 * layer, tid); }
        GRID_BAR(); STAMP();
#ifndef NO_G3
        {
            FRESH(); const unsigned char* wb = ws + WS_W + (size_t)layer * W_LAYER;
            pg8::Gemm g{(const pg8::bf16_t*)(ws + WS_Y), (const pg8::bf16_t*)(wb + W_OUT), MREAL, 1024, 1024}; pg8::StaticOrder S; S.init(MREAL, 1024, (int)gridDim.x, (int)blockIdx.x);
            pg8::EpiRes E{(pg8::bf16_t*)(ws + WS_HB), nullptr, (float*)(ws + WS_SS) + (size_t)(2 * layer + 1) * MROWS};
            mini_res(ws, (const bf16u*)(ws + WS_Y), (const bf16u*)(wb + W_OUT), 1024, (float*)(ws + WS_SS) + (size_t)(2 * layer + 1) * MROWS, L, wave, lane);
            pg8::gemm_phase<pg8::EpiRes, pg8::StaticOrder, true, true>(L, g, S, E);
        }
#endif
        GRID_BAR(); STAMP();
#ifndef NO_G4
        {
            FRESH(); const unsigned char* wb = ws + WS_W + (size_t)layer * W_LAYER;
            pg8::Gemm g{(const pg8::bf16_t*)(ws + WS_HB), (const pg8::bf16_t*)(wb + W_GU), MREAL, NGU, 1024}; pg8::StaticOrder S; S.init(MREAL, NGU, (int)gridDim.x, (int)blockIdx.x);
            pg8::EpiGU E{(pg8::bf16_t*)(ws + WS_P), (const float*)(ws + WS_SS) + (size_t)(2 * layer + 1) * MROWS};
            mini_gu(ws, (const bf16u*)(wb + W_GU), (const float*)(ws + WS_SS) + (size_t)(2 * layer + 1) * MROWS, L, wave, lane);
            pg8::gemm_phase<pg8::EpiGU, pg8::StaticOrder, true, true>(L, g, S, E);
        }
#endif
        GRID_BAR(); STAMP();
#ifndef NO_G5
        {
            FRESH(); const unsigned char* wb = ws + WS_W + (size_t)layer * W_LAYER;
            pg8::Gemm g{(const pg8::bf16_t*)(ws + WS_P), (const pg8::bf16_t*)(wb + W_D), MREAL, 1024, DFF}; pg8::StaticOrder S; S.init(MREAL, 1024, (int)gridDim.x, (int)blockIdx.x);
            pg8::EpiRes E{(pg8::bf16_t*)(ws + WS_HB), nullptr, (float*)(ws + WS_SS) + (size_t)(2 * layer + 2) * MROWS};
            mini_res(ws, (const bf16u*)(ws + WS_P), (const bf16u*)(wb + W_D), DFF, (float*)(ws + WS_SS) + (size_t)(2 * layer + 2) * MROWS, L, wave, lane);
            pg8::gemm_phase<pg8::EpiRes, pg8::StaticOrder, true, true>(L, g, S, E);
        }
#endif
        GRID_BAR(); STAMP();
    }
    { FRESH(); final_phase(A, ws, wave, lane); }
#ifdef PROBE
    STAMP();
    grid.sync();
    {
        volatile unsigned long long* T = (volatile unsigned long long*)(A.ws + WS_CTL + 8192);
        if (blockIdx.x == 0) {
#ifndef PB_HI
#define PB_HI (PB + 1)
#endif

#ifndef PA_HI
#define PA_HI (PA + 1)
#endif
            const unsigned long long dA = T[PA_HI] - T[PA], dB = T[PB_HI < 0 ? 0 : PB_HI] - T[PB < 0 ? 0 : PB];
#if PB >= 0
            for (unsigned long long i = threadIdx.x; i < dB; i += NWAVES * 64) A.out[i] += 0.125f;
#else
            (void)dB;
#endif
            if (threadIdx.x == 0) { const unsigned long long t0 = __builtin_amdgcn_s_memrealtime(); while (__builtin_amdgcn_s_memrealtime() - t0 < dA) __builtin_amdgcn_s_sleep(8); }
        }
    }
#endif
}

extern "C" void kernel_launch(void* const* d_in, const int* in_sizes, int n_in, void* d_out, int out_size, void* d_ws, size_t ws_size, hipStream_t stream) {
    static int grid = 0;
    if (grid == 0) {
        if (n_in != 15 || out_size != NBATCH * SEQ_IN * DMODEL || ws_size < WS_END) { fprintf(stderr, "kernel_launch: unexpected shapes (n_in %d out %d ws %zu, need %zu)\n", n_in, out_size, ws_size, (size_t)WS_END); grid = -1; return; }
        int dev = 0, cus = 0, per_cu = 0;
        if (hipGetDevice(&dev) != hipSuccess || hipDeviceGetAttribute(&cus, hipDeviceAttributeMultiprocessorCount, dev) != hipSuccess) { grid = -1; return; }
        if (hipFuncSetAttribute((const void*)hymba_fwd, hipFuncAttributeMaxDynamicSharedMemorySize, LDS_BYTES) != hipSuccess) { fprintf(stderr, "kernel_launch: hipFuncSetAttribute failed\n"); grid = -1; return; }
        if (hipOccupancyMaxActiveBlocksPerMultiprocessor(&per_cu, (const void*)hymba_fwd, NWAVES * 64, LDS_BYTES) != hipSuccess || per_cu < 1) { fprintf(stderr, "kernel_launch: occupancy query says %d\n", per_cu); per_cu = 1; }
        (void)hipGetLastError();
        grid = cus;
    }
    if (grid < 0) return;
    if (hipMemsetAsync((char*)d_ws + WS_CTL, 0, CTL_ZERO_BYTES, stream) != hipSuccess) { fprintf(stderr, "kernel_launch: memset failed\n"); return; }
    Args a{};
    for (int i = 0; i < 15; ++i) a.in[i] = (const float*)d_in[i];
    a.out = (float*)d_out; a.ws = (unsigned char*)d_ws;
    void* args[] = {&a};
    const hipError_t e = hipLaunchCooperativeKernel((const void*)hymba_fwd, dim3(grid), dim3(NWAVES * 64), args, LDS_BYTES, stream);
    if (e != hipSuccess) fprintf(stderr, "kernel_launch: cooperative launch failed: %s (grid %d)\n", hipGetErrorString(e), grid);
}
```

```cpp
#include <hip/hip_runtime.h>
#include <hip/hip_cooperative_groups.h>
#include <cstdio>
#include <cstdint>
namespace pg8 {
#define PG8_LAS __attribute__((address_space(3)))
typedef unsigned short bf16_t;
typedef short bf16x8 __attribute__((ext_vector_type(8)));
typedef float f32x4 __attribute__((ext_vector_type(4)));
typedef unsigned u32x4 __attribute__((ext_vector_type(4)));
constexpr int BM = 256, BK = 64, HALF = 128, HTB = HALF * BK * 2  , STAGE_BYTES = 8 * HTB, NXCD = 8, WGM = 8;

__host__ __device__ __forceinline__ int lds_byte(int r, int c) { const int st = (r >> 4) * 2 + (c >> 5), rr = r & 15, cc = c & 31, ob = rr * 64 + cc * 2; return st * 1024 + (ob ^ (((ob >> 9) & 1) << 5)); }
__host__ __device__ __forceinline__ void stage_rc(int b, int& R, int& C) { const int st = b / 1024, sb = b % 1024, swz = sb ^ (((sb >> 9) & 1) << 5); R = (st >> 1) * 16 + swz / 64; C = (st & 1) * 32 + (swz % 64) / 2; }
__host__ __device__ __forceinline__ int perm32(int rho) { const int n = rho >> 4, i = rho & 15; return 8 * (i >> 2) + 4 * n + (i & 3); }

struct Unit { int pm, pn; };
__host__ __device__ __forceinline__ int arow(int pm) { return 256 * (pm + (pm >> 5)) + 16; }
struct Gemm { const bf16_t* A; const bf16_t* Bt; int M, N, K; };

struct StaticOrder {
    int nM, nN, nwg, G, c;
    __host__ __device__ void init(int M, int N, int G_, int c_) { nM = M / BM; nN = N / BM; nwg = nM * nN; G = G_; c = c_; }
    __host__ __device__ bool next(int i, Unit& u) const {
        const long L = (long)i * G + c; if (L >= nwg) return false;
        int wgid = (int)L; { const int q = nwg / NXCD, r = nwg % NXCD, xcd = wgid % NXCD, off = wgid / NXCD; wgid = (xcd < r ? xcd * (q + 1) : r * (q + 1) + (xcd - r) * q) + off; }
        const int nig = WGM * nN, gid = wgid / nig, fm = gid * WGM, gsz = (nM - fm) < WGM ? (nM - fm) : WGM;
        u.pm = fm + ((wgid % nig) % gsz); u.pn = (wgid % nig) / gsz; return true;
    }
    __device__ __forceinline__ void a_ready(const Unit&) const {}
    __device__ __forceinline__ void done(const Unit&) const {}
};

__device__ __forceinline__ unsigned cvt_pk_bf16(float lo, float hi) { unsigned r; asm volatile("v_cvt_pk_bf16_f32 %0, %1, %2" : "=v"(r) : "v"(lo), "v"(hi)); return r; }
typedef unsigned u32x2 __attribute__((ext_vector_type(2)));
constexpr float RMS_EPS = 1e-6f;
struct EpiIn {
    static constexpr bool PERM = true, AFTER_DRAIN = false;
    bf16_t* P; float* LF; const float* ss; const float* fb;
    __device__ __forceinline__ void operator()(const f32x4 (&acc)[2][2][4][2], const Unit& u, int wr, int wc, int fr, int fq) const {
        const int row0 = arow(u.pm) + wr * 64 + fr;
        {
            const int col0 = u.pn * BM + wc * 32 + 8 * fq;
#pragma unroll
            for (int ai = 0; ai < 2; ++ai)
#pragma unroll
                for (int m = 0; m < 4; ++m) { const int row = row0 + ai * HALF + m * 16; const float rs = __builtin_amdgcn_rsqf(ss[row] * (1.0f / 1024.0f) + RMS_EPS);
                    bf16_t* rowp = P + (size_t)row * 2560 + col0;
#pragma unroll
                    for (int bj = 0; bj < 2; ++bj) { const f32x4 v0 = acc[ai][bj][m][0] * rs, v1 = acc[ai][bj][m][1] * rs;
                        u32x4 w; w.x = cvt_pk_bf16(v0[0], v0[1]); w.y = cvt_pk_bf16(v0[2], v0[3]); w.z = cvt_pk_bf16(v1[0], v1[1]); w.w = cvt_pk_bf16(v1[2], v1[3]);
                        *(u32x4*)(rowp + bj * HALF) = w; } }
        }
    }
};
struct EpiRes {
    static constexpr bool PERM = true, AFTER_DRAIN = false;
    bf16_t* hb; float* hf; float* ssn;
    __device__ __forceinline__ void operator()(const f32x4 (&acc)[2][2][4][2], const Unit& u, int wr, int wc, int fr, int fq) const {
        const int row0 = arow(u.pm) + wr * 64 + fr, col0 = u.pn * BM + wc * 32 + 8 * fq;
#pragma unroll
        for (int ai = 0; ai < 2; ++ai)
#pragma unroll
            for (int m = 0; m < 4; ++m) { const int row = row0 + ai * HALF + m * 16; bf16_t* bp = hb + (size_t)row * 1024 + col0; float s = 0.f;
#pragma unroll
                for (int bj = 0; bj < 2; ++bj) { const u32x4 r = *(const u32x4*)(bp + bj * HALF);
                    f32x4 a = (f32x4){__uint_as_float(r.x << 16), __uint_as_float(r.x & 0xffff0000u), __uint_as_float(r.y << 16), __uint_as_float(r.y & 0xffff0000u)};
                    f32x4 b = (f32x4){__uint_as_float(r.z << 16), __uint_as_float(r.z & 0xffff0000u), __uint_as_float(r.w << 16), __uint_as_float(r.w & 0xffff0000u)};
                    a = a + acc[ai][bj][m][0]; b = b + acc[ai][bj][m][1];
                    if (hf) { float* hp = hf + (size_t)row * 1024 + col0 + bj * HALF; *(f32x4*)hp = a; *(f32x4*)(hp + 4) = b; }
                    s += (a[0] * a[0] + a[1] * a[1]) + (a[2] * a[2] + a[3] * a[3]) + (b[0] * b[0] + b[1] * b[1]) + (b[2] * b[2] + b[3] * b[3]);
                    u32x4 w; w.x = cvt_pk_bf16(a[0], a[1]); w.y = cvt_pk_bf16(a[2], a[3]); w.z = cvt_pk_bf16(b[0], b[1]); w.w = cvt_pk_bf16(b[2], b[3]);
                    *(u32x4*)(bp + bj * HALF) = w; }
                s += __shfl_xor(s, 16); s += __shfl_xor(s, 32);
                if (fq == 0) atomicAdd(ssn + row, s);
                asm volatile("" ::: "memory"); }
    }
};
struct EpiGU {
    static constexpr bool PERM = true, AFTER_DRAIN = false;
    bf16_t* H; const float* ss;
    __device__ __forceinline__ void operator()(const f32x4 (&acc)[2][2][4][2], const Unit& u, int wr, int wc, int fr, int fq) const {
        const int row0 = arow(u.pm) + wr * 64 + fr, col0 = u.pn * HALF + wc * 32 + 8 * fq;
#pragma unroll
        for (int ai = 0; ai < 2; ++ai)
#pragma unroll
            for (int m = 0; m < 4; ++m) { const int row = row0 + ai * HALF + m * 16; const float rs = __builtin_amdgcn_rsqf(ss[row] * (1.0f / 1024.0f) + RMS_EPS);
                float o[8];
#pragma unroll
                for (int n = 0; n < 2; ++n)
#pragma unroll
                    for (int e = 0; e < 4; ++e) { const float g = acc[ai][0][m][n][e] * rs, up = acc[ai][1][m][n][e] * rs;
                        o[4 * n + e] = g * __builtin_amdgcn_rcpf(1.0f + __builtin_amdgcn_exp2f(-1.4426950408889634f * g)) * up; }
                u32x4 w; w.x = cvt_pk_bf16(o[0], o[1]); w.y = cvt_pk_bf16(o[2], o[3]); w.z = cvt_pk_bf16(o[4], o[5]); w.w = cvt_pk_bf16(o[6], o[7]);
                *(u32x4*)(H + (size_t)row * 2816 + col0) = w; }
    }
};
template <class Epi, class Sched, bool ALIGN_EPI = false, bool SP2 = false>
__device__ __forceinline__ void gemm_phase(PG8_LAS unsigned char* lds, const Gemm g, const Sched& S, const Epi& E) {
    int tid_ = threadIdx.x; asm volatile("" : "+v"(tid_));
    const int tid = tid_, wid = __builtin_amdgcn_readfirstlane(tid >> 6), lane = tid & 63, wr = wid >> 2, wc = wid & 3, fr = lane & 15, fq = lane >> 4;
    const int K = g.K, nt = K / BK;
    unsigned voffA[2], voffB[2];
#pragma unroll
    for (int i = 0; i < 2; ++i) { int R, C; stage_rc(tid * 16 + i * 8192, R, C); const int Rb = Epi::PERM ? ((R & ~31) + perm32(R & 31)) : R;
        voffA[i] = (unsigned)(R * K + C) * 2u; voffB[i] = (unsigned)(Rb * K + C) * 2u; }
    const size_t kstep = (size_t)(BK * 2);
    const size_t hstep = (size_t)HALF * K * 2;
    const size_t tstep = 2 * hstep;
    const unsigned ldsw = (unsigned)wid * 1024u;
    const int aoff = lds_byte(wr * 64 + fr, fq * 8), boff = lds_byte(wc * 32 + fr, fq * 8);
#define PG8_SA(b, h) (((b) * 2 + (h)) * HTB)
#define PG8_SB(b, h) ((4 + (b) * 2 + (h)) * HTB)
#define PG8_STAGE(bufoff, gbase, voff) do { _Pragma("unroll") for (int _i = 0; _i < 2; ++_i) \
        __builtin_amdgcn_global_load_lds((const unsigned*)((const char*)(gbase) + (voff)[_i]), (PG8_LAS unsigned*)(lds + (bufoff) + ldsw + _i * 8192), 16, 0, 0); } while (0)
#define PG8_LDA(dst, b, h) do { _Pragma("unroll") for (int m = 0; m < 4; ++m) _Pragma("unroll") for (int k = 0; k < 2; ++k) dst[m][k] = *(const PG8_LAS bf16x8*)(lds + PG8_SA(b, h) + aoff + m * 2048 + k * 1024); } while (0)
#define PG8_LDB(dst, b, h) do { _Pragma("unroll") for (int n = 0; n < 2; ++n) _Pragma("unroll") for (int k = 0; k < 2; ++k) dst[n][k] = *(const PG8_LAS bf16x8*)(lds + PG8_SB(b, h) + boff + n * 2048 + k * 1024); } while (0)
#define PG8_MMA(ai, bj, At, Bt) do { __builtin_amdgcn_s_setprio(1); _Pragma("unroll") for (int m = 0; m < 4; ++m) _Pragma("unroll") for (int n = 0; n < 2; ++n) _Pragma("unroll") for (int k = 0; k < 2; ++k) \
        acc[ai][bj][m][n] = __builtin_amdgcn_mfma_f32_16x16x32_bf16(Bt[n][k], At[m][k], acc[ai][bj][m][n], 0, 0, 0); __builtin_amdgcn_s_setprio(0); } while (0)
#define PG8_WAIT_V(n) asm volatile("s_waitcnt vmcnt(" #n ")" ::: "memory")
#define PG8_WAIT_L(n) asm volatile("s_waitcnt lgkmcnt(" #n ")" ::: "memory")
#define PG8_BAR __builtin_amdgcn_s_barrier()
#define PG8_SCHED __builtin_amdgcn_sched_barrier(0)
    Unit cur, nxt; int ui = 0;
    if (!S.next(0, cur)) return;
    f32x4 acc[2][2][4][2];
#pragma unroll
    for (int a = 0; a < 2; ++a)
#pragma unroll
        for (int b = 0; b < 2; ++b)
#pragma unroll
            for (int m = 0; m < 4; ++m)
#pragma unroll
                for (int n = 0; n < 2; ++n) acc[a][b][m][n] = (f32x4){0.f, 0.f, 0.f, 0.f};
    bf16x8 At[4][2], B0[2][2], B1[2][2];
    const char* cA = (const char*)g.A + (size_t)arow(cur.pm) * K * 2; const char* cB = (const char*)g.Bt + (size_t)cur.pn * tstep;
    S.a_ready(cur);
    if constexpr (SP2) {
        PG8_STAGE(PG8_SB(0, 0), cB, voffB); PG8_STAGE(PG8_SB(0, 1), cB + hstep, voffB); PG8_STAGE(PG8_SA(0, 0), cA, voffA); PG8_STAGE(PG8_SA(0, 1), cA + hstep, voffA);
        if (wr == 1) PG8_BAR;
        PG8_WAIT_V(2); PG8_BAR;
        PG8_STAGE(PG8_SB(1, 0), cB + kstep, voffB); PG8_STAGE(PG8_SA(1, 0), cA + kstep, voffA); PG8_STAGE(PG8_SB(1, 1), cB + hstep + kstep, voffB);
        PG8_WAIT_V(6); PG8_BAR;
    } else {
        PG8_STAGE(PG8_SB(0, 0), cB, voffB); PG8_STAGE(PG8_SA(0, 0), cA, voffA); PG8_STAGE(PG8_SB(0, 1), cB + hstep, voffB); PG8_STAGE(PG8_SA(0, 1), cA + hstep, voffA);
        if (wr == 1) PG8_BAR;
        PG8_WAIT_V(4); PG8_BAR;
        PG8_STAGE(PG8_SB(1, 0), cB + kstep, voffB); PG8_STAGE(PG8_SA(1, 0), cA + kstep, voffA); PG8_STAGE(PG8_SB(1, 1), cB + hstep + kstep, voffB);
        PG8_WAIT_V(6); PG8_BAR;
    }
    for (;;) {
        const bool has_next = S.next(ui + 1, nxt);
        const char* nA = has_next ? (const char*)g.A + (size_t)arow(nxt.pm) * K * 2 : cA; const char* nB = has_next ? (const char*)g.Bt + (size_t)nxt.pn * tstep : cB;
        for (int t = 0; t < nt; t += 2) {
            const bool last = (t == nt - 2);
            const char* a1 = cA + (size_t)(t + 1) * kstep;
            const char* a2 = last ? nA : cA + (size_t)(t + 2) * kstep; const char* b2 = last ? nB : cB + (size_t)(t + 2) * kstep;
            const char* a3 = a2 + kstep; const char* b3 = b2 + kstep;
            if (last && has_next) S.a_ready(nxt);
            if constexpr (SP2) {
            PG8_LDB(B0, 0, 0); PG8_LDB(B1, 0, 1); PG8_SCHED; PG8_LDA(At, 0, 0); PG8_STAGE(PG8_SA(1, 1), a1 + hstep, voffA);
            PG8_WAIT_V(8); PG8_WAIT_L(0); PG8_BAR; PG8_MMA(0, 0, At, B0); PG8_MMA(0, 1, At, B1); PG8_BAR; PG8_SCHED;
            PG8_LDA(At, 0, 1); PG8_STAGE(PG8_SB(0, 0), b2, voffB); PG8_STAGE(PG8_SB(0, 1), b2 + hstep, voffB); PG8_STAGE(PG8_SA(0, 0), a2, voffA);
            PG8_WAIT_V(8); PG8_WAIT_L(0); PG8_BAR; PG8_MMA(1, 0, At, B0); PG8_MMA(1, 1, At, B1); PG8_BAR; PG8_SCHED;
            PG8_LDB(B0, 1, 0); PG8_LDB(B1, 1, 1); PG8_SCHED; PG8_LDA(At, 1, 0); PG8_STAGE(PG8_SA(0, 1), a2 + hstep, voffA);
            PG8_WAIT_V(8); PG8_WAIT_L(0); PG8_BAR; PG8_MMA(0, 0, At, B0); PG8_MMA(0, 1, At, B1); PG8_BAR; PG8_SCHED;
            PG8_LDA(At, 1, 1); PG8_STAGE(PG8_SB(1, 0), b3, voffB); PG8_STAGE(PG8_SB(1, 1), b3 + hstep, voffB); PG8_STAGE(PG8_SA(1, 0), a3, voffA);
            PG8_WAIT_V(8); PG8_WAIT_L(0); PG8_BAR; PG8_MMA(1, 0, At, B0); PG8_MMA(1, 1, At, B1); PG8_BAR; PG8_SCHED;
            } else {
            PG8_LDB(B0, 0, 0); PG8_SCHED; PG8_LDA(At, 0, 0); PG8_STAGE(PG8_SA(1, 1), a1 + hstep, voffA);
            PG8_WAIT_L(8); PG8_BAR; PG8_WAIT_L(0); PG8_MMA(0, 0, At, B0); PG8_BAR; PG8_SCHED;
            PG8_LDB(B1, 0, 1); PG8_STAGE(PG8_SB(0, 0), b2, voffB);
            PG8_BAR; PG8_WAIT_L(0); PG8_MMA(0, 1, At, B1); PG8_BAR;
            PG8_LDA(At, 0, 1); PG8_STAGE(PG8_SA(0, 0), a2, voffA);
            PG8_BAR; PG8_WAIT_L(0); PG8_MMA(1, 0, At, B0); PG8_BAR; PG8_SCHED;
            PG8_STAGE(PG8_SB(0, 1), b2 + hstep, voffB);
            PG8_WAIT_V(6); PG8_BAR; PG8_MMA(1, 1, At, B1); PG8_BAR;
            PG8_LDB(B0, 1, 0); PG8_SCHED; PG8_LDA(At, 1, 0); PG8_STAGE(PG8_SA(0, 1), a2 + hstep, voffA);
            PG8_WAIT_L(8); PG8_BAR; PG8_WAIT_L(0); PG8_MMA(0, 0, At, B0); PG8_BAR; PG8_SCHED;
            PG8_LDB(B1, 1, 1); PG8_STAGE(PG8_SB(1, 0), b3, voffB);
            PG8_BAR; PG8_WAIT_L(0); PG8_MMA(0, 1, At, B1); PG8_BAR;
            PG8_LDA(At, 1, 1); PG8_STAGE(PG8_SA(1, 0), a3, voffA);
            PG8_BAR; PG8_WAIT_L(0); PG8_MMA(1, 0, At, B0); PG8_BAR; PG8_SCHED;
            PG8_STAGE(PG8_SB(1, 1), b3 + hstep, voffB);
            PG8_WAIT_V(6); PG8_BAR; PG8_MMA(1, 1, At, B1); PG8_BAR;
            }
        }
        if constexpr (ALIGN_EPI) { if (wr == 0) PG8_BAR; }
        if constexpr (!Epi::AFTER_DRAIN) { E(acc, cur, wr, wc, fr, fq); S.done(cur); }
        if (!has_next) break;
#pragma unroll
        for (int a = 0; a < 2; ++a)
#pragma unroll
            for (int b = 0; b < 2; ++b)
#pragma unroll
                for (int m = 0; m < 4; ++m)
#pragma unroll
                    for (int n = 0; n < 2; ++n) acc[a][b][m][n] = (f32x4){0.f, 0.f, 0.f, 0.f};
        cur = nxt; cA = nA; cB = nB; ++ui;
        if constexpr (ALIGN_EPI) { if (wr == 1) PG8_BAR; }
    }
    PG8_WAIT_V(0);
    if constexpr (!ALIGN_EPI) { if (wr == 0) PG8_BAR; }
    PG8_BAR;
    if constexpr (Epi::AFTER_DRAIN) { E.fused(acc, cur, wr, wc, fr, fq, lds, wid, lane); S.done(cur); }
#undef PG8_SA
#undef PG8_SB
#undef PG8_STAGE
#undef PG8_LDA
#undef PG8_LDB
#undef PG8_MMA
#undef PG8_WAIT_V
#undef PG8_WAIT_L
#undef PG8_BAR
#undef PG8_SCHED
}
}
#include <hip/hip_bf16.h>
#include <cmath>
namespace attn_body {
using bf16=__hip_bfloat16;
using bf16x8=__attribute__((ext_vector_type(8)))short;
using s16x4=__attribute__((ext_vector_type(4)))short;
using f32x16=__attribute__((ext_vector_type(16)))float;
using u32x4=__attribute__((ext_vector_type(4)))unsigned;
constexpr int SEQ=8448,D=64,DM=2560,DMO=1024;
using f32x4=__attribute__((ext_vector_type(4)))float;
constexpr int NW=8,QBLK=32,QB=QBLK*NW,KVBLK=64,NQB=SEQ/QB;
constexpr int ATTN_UNIT_ROWS=QB;
__device__ __forceinline__ int crow(int r,int hi){return (r&3)+8*(r>>2)+4*hi;}
#define SBAR() __builtin_amdgcn_sched_barrier(0)
__device__ __forceinline__ void cmask(f32x16&p0,f32x16&p1,int jb,int qrel,int hi){
  const float NEG=-INFINITY; int kb=64*jb+4*hi;
  #pragma unroll
  for(int r=0;r<16;++r){int kv=kb+(r&3)+8*(r>>2); if(kv>qrel)p0[r]=NEG; if(kv+32>qrel)p1[r]=NEG;}
}

constexpr int NSLOT=3, SLOTB=8192;
constexpr int LDS_K=0, LDS_V=NSLOT*SLOTB, LDS_WS=2*NSLOT*SLOTB, LDS_OST=LDS_WS+NW*64*4, LDS_BYTES=LDS_OST+NW*4096, LDS_CS=LDS_BYTES, LDS_FLAGS=LDS_CS+SEQ*4, LDS_END=LDS_FLAGS+256;
constexpr float C2=0.125f*1.4426950408889634f;
__device__ __forceinline__ void glds16(const void*gsrc,unsigned lds_dst){unsigned keep;
  asm volatile("s_mov_b32 %0, m0\n\ts_mov_b32 m0, %2\n\ts_nop 0\n\tglobal_load_lds_dwordx4 %1, off\n\ts_mov_b32 m0, %0":"=&s"(keep):"v"(gsrc),"s"(lds_dst):"memory");}
__device__ __forceinline__ float max3f(float a,float b,float c){float r;asm("v_max3_f32 %0, %1, %2, %3":"=v"(r):"v"(a),"v"(b),"v"(c));return r;}
__device__ __forceinline__ float max2f(float a,float b){float r;asm("v_max_f32_e32 %0, %1, %2":"=v"(r):"v"(a),"v"(b));return r;}
__device__ __forceinline__ float fadd_s(float a,float b){float r;asm("v_add_f32_e32 %0, %1, %2":"=v"(r):"v"(a),"v"(b));return r;}
__device__ __forceinline__ float fsub_s(float a,float b){float r;asm("v_sub_f32_e32 %0, %1, %2":"=v"(r):"v"(a),"v"(b));return r;}
typedef float f32x2_t __attribute__((ext_vector_type(2))); typedef __bf16 bf16x2_t __attribute__((ext_vector_type(2)));
__device__ __forceinline__ unsigned cvtpk_s(float lo,float hi){f32x2_t v={lo,hi};bf16x2_t b=__builtin_convertvector(v,bf16x2_t);return __builtin_bit_cast(unsigned,b);}
#define WAIT_BAR(N) asm volatile("s_waitcnt vmcnt(" #N ") lgkmcnt(0)\n\ts_barrier":::"memory")

__device__ __forceinline__ void qkt(f32x16&p0,f32x16&p1,const char*Kslot,const bf16x8*qr,int r32,int hi){
  const char*kb=Kslot+hi*1024+r32*16;
  #pragma unroll
  for(int d0=0;d0<4;++d0){
    const bf16x8 b0=*reinterpret_cast<const bf16x8*>(kb+d0*2048);
    const bf16x8 b1=*reinterpret_cast<const bf16x8*>(kb+d0*2048+512);
    {p0=__builtin_amdgcn_mfma_f32_32x32x16_bf16(b0,qr[d0],p0,0,0,0);p1=__builtin_amdgcn_mfma_f32_32x32x16_bf16(b1,qr[d0],p1,0,0,0);}}
}
typedef __attribute__((address_space(3))) const char* lds_cptr;
typedef short v4i16_t __attribute__((ext_vector_type(4)));
__device__ __forceinline__ void kload8(bf16x8*kf,lds_cptr kp){
  kf[0]=*(const __attribute__((address_space(3))) bf16x8*)(kp);      kf[1]=*(const __attribute__((address_space(3))) bf16x8*)(kp+512);
  kf[2]=*(const __attribute__((address_space(3))) bf16x8*)(kp+2048); kf[3]=*(const __attribute__((address_space(3))) bf16x8*)(kp+2560);
  kf[4]=*(const __attribute__((address_space(3))) bf16x8*)(kp+4096); kf[5]=*(const __attribute__((address_space(3))) bf16x8*)(kp+4608);
  kf[6]=*(const __attribute__((address_space(3))) bf16x8*)(kp+6144); kf[7]=*(const __attribute__((address_space(3))) bf16x8*)(kp+6656);
}
__device__ __forceinline__ void kload2(bf16x8*kf,lds_cptr kp,int j){ kf[2*j]=*(const __attribute__((address_space(3))) bf16x8*)(kp+j*2048); kf[2*j+1]=*(const __attribute__((address_space(3))) bf16x8*)(kp+j*2048+512); }
__device__ __forceinline__ s16x4 vtr(lds_cptr p){ return __builtin_bit_cast(s16x4,__builtin_amdgcn_ds_read_tr16_b64_v4i16((__attribute__((address_space(3))) v4i16_t*)p)); }
__device__ __forceinline__ float rowmax(const f32x16&p0,const f32x16&p1){
  float a=max3f(p0[0],p0[1],p1[0]),b=max3f(p0[2],p0[3],p1[1]);a=max3f(a,p1[2],p1[3]);
  #pragma unroll
  for(int r=4;r<16;r+=4){a=max3f(a,p0[r],p0[r+1]);b=max3f(b,p0[r+2],p0[r+3]);a=max3f(a,p1[r],p1[r+1]);b=max3f(b,p1[r+2],p1[r+3]);}
  const float m=max2f(a,b);
  auto rr=__builtin_amdgcn_permlane32_swap(__float_as_uint(m),__float_as_uint(m),false,false);
  return max2f(__uint_as_float(rr[0]),__uint_as_float(rr[1]));
}
__device__ __forceinline__ void pv(f32x16*o,int vb,bf16x8 pa0,bf16x8 pa1,bf16x8 pa2,bf16x8 pa3){
  #pragma unroll
  for(int d0=0;d0<2;++d0){s16x4 lo[4],hi[4];
    #pragma unroll
    for(int ks=0;ks<4;++ks){
      asm volatile("ds_read_b64_tr_b16 %0,%1 offset:%c2":"=&v"(lo[ks]):"v"(vb),"i"(d0*4096+ks*1024):"memory");
      asm volatile("ds_read_b64_tr_b16 %0,%1 offset:%c2":"=&v"(hi[ks]):"v"(vb),"i"(d0*4096+ks*1024+512):"memory");}
    asm volatile("s_waitcnt lgkmcnt(0)":::"memory");SBAR();
    #define PK(k) (bf16x8){lo[k][0],lo[k][1],lo[k][2],lo[k][3],hi[k][0],hi[k][1],hi[k][2],hi[k][3]}
    o[d0]=__builtin_amdgcn_mfma_f32_32x32x16_bf16(pa0,PK(0),o[d0],0,0,0);
    o[d0]=__builtin_amdgcn_mfma_f32_32x32x16_bf16(pa1,PK(1),o[d0],0,0,0);
    o[d0]=__builtin_amdgcn_mfma_f32_32x32x16_bf16(pa2,PK(2),o[d0],0,0,0);
    o[d0]=__builtin_amdgcn_mfma_f32_32x32x16_bf16(pa3,PK(3),o[d0],0,0,0);
    #undef PK
  }
}

__device__ __forceinline__ u32x4 head_rms(u32x4 v){ float x[8];
  #pragma unroll
  for(int i=0;i<4;++i){x[2*i]=__uint_as_float(v[i]<<16);x[2*i+1]=__uint_as_float(v[i]&0xffff0000u);}
  float s=0.f;
  #pragma unroll
  for(int i=0;i<8;++i)s+=x[i]*x[i];
  s+=__shfl_xor(s,1);s+=__shfl_xor(s,2);s+=__shfl_xor(s,4);
  const float rs=__builtin_amdgcn_rsqf(s*(1.0f/64.0f)+1e-6f); u32x4 w;
  #pragma unroll
  for(int i=0;i<4;++i)w[i]=cvtpk_s(x[2*i]*rs,x[2*i+1]*rs);
  return w; }
#ifndef ATTN_STORE16
#define ATTN_STORE16(p,v) (*(u32x4*)(p)=(v))
#endif
template<int THRL> __device__ __forceinline__ void fox_unit(int b,int qb,float dthr,const bf16*Q,const bf16*__restrict__ K,const bf16*__restrict__ V,bf16*O,const float*__restrict__ csg,char*shm){
  int tid_=threadIdx.x; asm volatile("":"+v"(tid_)); const int tid=tid_,lane=tid&63,r32=lane&31,hi=lane>>5; const int wid=__builtin_amdgcn_readfirstlane(tid>>6);
  const long rowbase=(long)b*SEQ; const int q0=qb*QB;
  const bf16*Qw=Q+(rowbase+q0+wid*QBLK)*DM;
  const unsigned lds0=(unsigned)(uintptr_t)shm; const lds_cptr shm3=(lds_cptr)shm;
  float*wsf=(float*)(shm+LDS_WS)+wid*64;
  const unsigned kdst=lds0+LDS_K+wid*1024, vdst=lds0+LDS_V+wid*1024;
  #define DMA_K(t,slot) glds16(ksrc+(long)(t)*KVBLK*DM,(unsigned)__builtin_amdgcn_readfirstlane(kdst+(slot)))
  #define DMA_V(t,slot) glds16(vsrc+(long)(t)*KVBLK*DM,(unsigned)__builtin_amdgcn_readfirstlane(vdst+(slot)))
  const int vb0=(int)(lds0+LDS_V)+((lane>>4)&1)*32+(lane&3)*8+(4*hi+((lane&15)>>2))*64;
  const char*Kbase=shm+LDS_K; bf16x8 kf[8];
  const lds_cptr kp0=shm3+LDS_K+hi*1024+r32*16; const lds_cptr vp0=shm3+LDS_V+((lane>>4)&1)*32+(lane&3)*8+(4*hi+((lane&15)>>2))*64;
  typedef __attribute__((address_space(3))) float lds_f32; typedef __attribute__((address_space(3))) f32x4 lds_f32x4;
  { lds_f32*cl=(lds_f32*)(shm3+LDS_CS); const int n_=q0+QB; for(int i_=tid*4;i_<n_;i_+=2048){ const f32x4 v_=*(const f32x4*)(csg+i_); *(lds_f32x4*)(cl+i_)=v_; } }
  asm volatile("s_waitcnt vmcnt(0) lgkmcnt(0)\n\ts_barrier":::"memory");
  int j0;
  { const lds_f32*cl=(const lds_f32*)(shm3+LDS_CS); const float cq0=cl[q0]; int lo_=0,hi_=4*qb;
    while(lo_<hi_){ const int mid_=(lo_+hi_)>>1; if(cl[64*mid_+63]-cq0>=dthr)lo_=mid_+1; else hi_=mid_; }
    j0=__builtin_amdgcn_readfirstlane(lo_)&~1; }
  const bf16*Kh=K+(rowbase+(long)j0*KVBLK)*DM,*Vh=V+(rowbase+(long)j0*KVBLK)*DM;
  const bf16*ksrc=Kh+(long)lane*DM+wid*8;
  const bf16*vsrc=Vh+(long)(16*(wid&3)+(lane>>2))*DM+(wid>>2)*32+(lane&3)*8;
  const int NT=(q0+QB)/KVBLK-j0;
  const lds_f32*cl3=(const lds_f32*)(shm3+LDS_CS)+64*j0;
  DMA_K(0,0);DMA_V(0,0);DMA_K(1,SLOTB);
  bf16x8 qr[4];
  #pragma unroll
  for(int d0=0;d0<4;++d0)qr[d0]=*reinterpret_cast<const bf16x8*>(&Qw[(long)r32*DM+d0*16+hi*8]);
  float base=0.f,l_reg=0.f;f32x16 o[2];o[0]=f32x16{};o[1]=f32x16{};
  #define CINIT(C0,C1,t) do{ const lds_f32*cp_=cl3+64*(t)+4*hi; \
    _Pragma("unroll") for(int g_=0;g_<4;++g_){ const f32x4 a_=*(const lds_f32x4*)(cp_+8*g_), b_=*(const lds_f32x4*)(cp_+32+8*g_); \
      C0[4*g_]=base-a_[0];C0[4*g_+1]=base-a_[1];C0[4*g_+2]=base-a_[2];C0[4*g_+3]=base-a_[3]; \
      C1[4*g_]=base-b_[0];C1[4*g_+1]=base-b_[1];C1[4*g_+2]=base-b_[2];C1[4*g_+3]=base-b_[3]; } }while(0)
  const int qrel=wid*QBLK+r32;
  #define CMASK(P0,P1,t) do{int jb_=(t)-(NT-4); if(jb_>=0)cmask(P0,P1,jb_,qrel,hi);}while(0)
  bool resc=false;
  #define START(P0,P1) do{ const float rm=rowmax(P0,P1); resc=false; \
    { const float dl=rm; base=fsub_s(base,dl); \
      _Pragma("unroll") for(int r=0;r<16;++r){P0[r]=fsub_s(P0[r],dl);P1[r]=fsub_s(P1[r],dl);} } \
    _Pragma("unroll") for(int r=0;r<16;++r)P0[r]=__builtin_amdgcn_exp2f(P0[r]); }while(0)
  #define RESC() do{ if(resc){ asm volatile("s_waitcnt lgkmcnt(0)":::"memory"); \
      _Pragma("unroll") for(int d_=0;d_<2;++d_) _Pragma("unroll") for(int r=0;r<16;++r)o[d_][r]*=wsf[crow(r,hi)]; } }while(0)
  f32x16 pA0,pA1,pB0,pB1;
  int sl_prev=0,sl_cur=0,sl_next=SLOTB;
  #define ROT() do{sl_prev=sl_cur;sl_cur=sl_next;sl_next=(sl_next==(NSLOT-1)*SLOTB)?0:sl_next+SLOTB;}while(0)
  DMA_K(2,2*SLOTB);
  WAIT_BAR(3);
  base=cl3[q0-64*j0+wid*QBLK+r32];
  CINIT(pA0,pA1,0); qkt(pA0,pA1,Kbase,qr,r32,hi);asm volatile("s_nop 15\n\ts_nop 7":"+v"(pA0),"+v"(pA1));CMASK(pA0,pA1,0);
  START(pA0,pA1);
  _Pragma("unroll") for(int r=0;r<16;++r)pA1[r]=__builtin_amdgcn_exp2f(pA1[r]);
  WAIT_BAR(0);
  DMA_K(3,0);DMA_V(1,SLOTB);
  ROT();
  kload8(kf,kp0+sl_cur);
  WAIT_BAR(2);
  s16x4 vlo[8],vhi[8]; u32x4 pw0,pw1,pw2,pw3;
  #define PKW(P,B) cvtpk_s(P[B],P[B+1])
  #define PAF(k) __builtin_bit_cast(bf16x8,pw##k)
  #define VFR(i) (bf16x8){vlo[i][0],vlo[i][1],vlo[i][2],vlo[i][3],vhi[i][0],vhi[i][1],vhi[i][2],vhi[i][3]}
  #define PIN(x) asm volatile("":"+v"(x))
  #define MX3(a,b,c) __builtin_fmaxf(__builtin_fmaxf((a),(b)),(c))
  #define GAPA(MF,A0,A1,A2,A3,W0,W1,PW) do{ MF; sacc+=A0; sacc+=A1; sacc+=A2; sacc+=A3; PIN(sacc); W0; W1; PIN(PW); SBAR(); }while(0)
  #define EX(v) __builtin_amdgcn_exp2f(v)
  #define GAPB(MF,X,B) do{ MF; X[B]=EX(X[B]); X[B+1]=EX(X[B+1]); X[B+2]=EX(X[B+2]); X[B+3]=EX(X[B+3]); PIN(X); SBAR(); }while(0)
  #define VRD(i) do{ vlo[i]=vtr(vp_+(((i)>>2)*4096+((i)&3)*1024)); vhi[i]=vtr(vp_+(((i)>>2)*4096+((i)&3)*1024+512)); }while(0)
  #define KRD(G,j) do{ if(G){ kload2(kf,kp0+sl_next,j); SBAR(); } }while(0)
  #define STEP(C0,C1,P0,P1,t,GK,GV,GL) do{ SBAR(); CINIT(C0,C1,t); SBAR(); \
    const lds_cptr vp_=vp0+sl_prev; \
    VRD(0); SBAR(); float sacc=(P0[0]+P0[1]); \
    GAPA(C0=__builtin_amdgcn_mfma_f32_32x32x16_bf16(kf[0],qr[0],C0,0,0,0), P0[2],P0[3],P0[4],P0[5],     pw0[0]=PKW(P0,0), pw0[1]=PKW(P0,2), pw0); \
    VRD(4); SBAR(); GAPA(C1=__builtin_amdgcn_mfma_f32_32x32x16_bf16(kf[1],qr[0],C1,0,0,0), P0[6],P0[7],P0[8],P0[9],     pw0[2]=PKW(P0,4), pw0[3]=PKW(P0,6), pw0); \
    VRD(1); SBAR(); GAPA(C0=__builtin_amdgcn_mfma_f32_32x32x16_bf16(kf[2],qr[1],C0,0,0,0),   P0[10],P0[11],P0[12],P0[13], pw1[0]=PKW(P0,8), pw1[1]=PKW(P0,10), pw1); \
    VRD(5); SBAR(); GAPA(C1=__builtin_amdgcn_mfma_f32_32x32x16_bf16(kf[3],qr[1],C1,0,0,0),   P0[14],P0[15],P1[0],P1[1],   pw1[2]=PKW(P0,12),pw1[3]=PKW(P0,14), pw1); \
    VRD(2); SBAR(); GAPA(C0=__builtin_amdgcn_mfma_f32_32x32x16_bf16(kf[4],qr[2],C0,0,0,0),   P1[2],P1[3],P1[4],P1[5],     pw2[0]=PKW(P1,0), pw2[1]=PKW(P1,2), pw2); \
    VRD(6); SBAR(); GAPA(C1=__builtin_amdgcn_mfma_f32_32x32x16_bf16(kf[5],qr[2],C1,0,0,0),   P1[6],P1[7],P1[8],P1[9],     pw2[2]=PKW(P1,4), pw2[3]=PKW(P1,6), pw2); \
    VRD(3); SBAR(); GAPA(C0=__builtin_amdgcn_mfma_f32_32x32x16_bf16(kf[6],qr[3],C0,0,0,0),   P1[10],P1[11],P1[12],P1[13], pw3[0]=PKW(P1,8), pw3[1]=PKW(P1,10), pw3); \
    VRD(7); SBAR(); GAPA(C1=__builtin_amdgcn_mfma_f32_32x32x16_bf16(kf[7],qr[3],C1,0,0,0),   P1[14],P1[15],0.f,0.f,       pw3[2]=PKW(P1,12),pw3[3]=PKW(P1,14), pw3); \
    l_reg+=sacc; \
    if(GK){DMA_K((t)+3,sl_cur);} if(GV){DMA_V((t)+1,sl_next);} \
    CMASK(C0,C1,t); \
    { float a=MX3(C0[0],C0[1],C1[0]),b=MX3(C0[2],C0[3],C1[1]); a=MX3(a,C1[2],C1[3]); \
      _Pragma("unroll") for(int r=4;r<16;r+=4){a=MX3(a,C0[r],C0[r+1]);b=MX3(b,C0[r+2],C0[r+3]);a=MX3(a,C1[r],C1[r+1]);b=MX3(b,C1[r+2],C1[r+3]);} \
      float rm=__builtin_fmaxf(a,b); { auto rr=__builtin_amdgcn_permlane32_swap(__float_as_uint(rm),__float_as_uint(rm),false,false); rm=__builtin_fmaxf(__uint_as_float(rr[0]),__uint_as_float(rr[1])); } \
      resc=false; \
      if(__builtin_expect(__any(rm>(float)THRL),0)){ const float dl=__builtin_fmaxf(rm,0.f); base-=dl; \
        _Pragma("unroll") for(int r=0;r<16;++r){C0[r]-=dl;C1[r]-=dl;} \
        const float f=__builtin_amdgcn_exp2f(-dl); l_reg*=f; if(hi==0)wsf[r32]=f; resc=true; } } \
    SBAR(); \
    GAPB(o[0]=__builtin_amdgcn_mfma_f32_32x32x16_bf16(PAF(0),VFR(0),o[0],0,0,0), C0,0); \
    GAPB(o[1]=__builtin_amdgcn_mfma_f32_32x32x16_bf16(PAF(0),VFR(4),o[1],0,0,0), C0,4); \
    KRD(GL,0); GAPB(o[0]=__builtin_amdgcn_mfma_f32_32x32x16_bf16(PAF(1),VFR(1),o[0],0,0,0), C0,8); \
    KRD(GL,1); GAPB(o[1]=__builtin_amdgcn_mfma_f32_32x32x16_bf16(PAF(1),VFR(5),o[1],0,0,0), C0,12); \
    KRD(GL,2); GAPB(o[0]=__builtin_amdgcn_mfma_f32_32x32x16_bf16(PAF(2),VFR(2),o[0],0,0,0), C1,0); \
    KRD(GL,3); GAPB(o[1]=__builtin_amdgcn_mfma_f32_32x32x16_bf16(PAF(2),VFR(6),o[1],0,0,0), C1,4); \
    GAPB(o[0]=__builtin_amdgcn_mfma_f32_32x32x16_bf16(PAF(3),VFR(3),o[0],0,0,0), C1,8); \
    GAPB(o[1]=__builtin_amdgcn_mfma_f32_32x32x16_bf16(PAF(3),VFR(7),o[1],0,0,0), C1,12); \
    }while(0)
  int t=1;
  #undef CMASK
  #define CMASK(P0,P1,t) do{}while(0)
  for(;t+5<NT;t+=2){
    STEP(pB0,pB1,pA0,pA1,t,true,true,true);     WAIT_BAR(2); RESC(); ROT();
    STEP(pA0,pA1,pB0,pB1,t+1,true,true,true);   WAIT_BAR(2); RESC(); ROT();
  }
  #undef CMASK
  #define CMASK(P0,P1,t) do{int jb_=(t)-(NT-4); if(jb_>=0)cmask(P0,P1,jb_,qrel,hi);}while(0)
  #define ENDW(tt) do{ if((tt)+3<NT){WAIT_BAR(2);} else if((tt)+2<NT){WAIT_BAR(1);} else {WAIT_BAR(0);} }while(0)
  for(;t+1<NT;t+=2){
    STEP(pB0,pB1,pA0,pA1,t,(t+3<NT),(t+1<NT),(t+1<NT));       ENDW(t);   RESC(); ROT();
    STEP(pA0,pA1,pB0,pB1,t+1,(t+4<NT),(t+2<NT),(t+2<NT));     ENDW(t+1); RESC(); ROT();
  }
  STEP(pB0,pB1,pA0,pA1,NT-1,false,false,false); RESC();
  { float sacc=pB0[0]+pB0[1]; _Pragma("unroll") for(int r=2;r<16;++r)sacc+=pB0[r]; _Pragma("unroll") for(int r=0;r<16;++r)sacc+=pB1[r]; l_reg+=sacc;
    pw0=(u32x4){PKW(pB0,0),PKW(pB0,2),PKW(pB0,4),PKW(pB0,6)};pw1=(u32x4){PKW(pB0,8),PKW(pB0,10),PKW(pB0,12),PKW(pB0,14)};pw2=(u32x4){PKW(pB1,0),PKW(pB1,2),PKW(pB1,4),PKW(pB1,6)};pw3=(u32x4){PKW(pB1,8),PKW(pB1,10),PKW(pB1,12),PKW(pB1,14)};
    SBAR(); pv(o,vb0+sl_cur,PAF(0),PAF(1),PAF(2),PAF(3)); }
  #undef PKW
  #undef PAF
  #undef VFR
  #undef PIN
  #undef MX3
  #undef GAPA
  #undef GAPB
  #undef EX
  #undef VRD
  #undef KRD
  #undef STEP
  #undef ENDW
  {auto rr=__builtin_amdgcn_permlane32_swap(__float_as_uint(l_reg),__float_as_uint(l_reg),false,false);l_reg=__uint_as_float(rr[0])+__uint_as_float(rr[1]);}
  if(hi==0)wsf[32+r32]=l_reg;asm volatile("s_waitcnt lgkmcnt(0)":::"memory");
  float rli[16];
  #pragma unroll
  for(int r=0;r<16;++r)rli[r]=__builtin_amdgcn_rcpf(wsf[32+crow(r,hi)]);
  bf16*Ow=O+(rowbase+q0+wid*QBLK)*DMO;
  { bf16*stg=(bf16*)(shm+LDS_OST)+wid*2048;
    #pragma unroll
    for(int r=0;r<16;++r){const int orow=crow(r,hi);
      #pragma unroll
      for(int d0=0;d0<2;++d0)stg[orow*64+d0*32+r32]=__float2bfloat16(o[d0][r]*rli[r]);}
    asm volatile("s_waitcnt lgkmcnt(0)":::"memory");
    #pragma unroll
    for(int i=0;i<4;++i){const int row=i*8+(lane>>3),ch=lane&7; const u32x4 v=*(const u32x4*)(stg+row*64+ch*8); ATTN_STORE16(Ow+(long)row*DMO+ch*8,head_rms(v));} }
  asm volatile("s_waitcnt lgkmcnt(0)\n\ts_barrier":::"memory");
  #undef DMA_K
  #undef DMA_V
  #undef CMASK
  #undef CINIT
  #undef START
  #undef RESC
  #undef ROT
}
__device__ __forceinline__ float sp2f(float z){ const float e=__builtin_amdgcn_exp2f(-__builtin_fabsf(z)); return __builtin_fmaxf(z,0.f)+__builtin_amdgcn_logf(1.f+e); }
__device__ __forceinline__ void sb_tile(f32x16*o,float&R,const char*Kslot,int vb,const bf16x8*qr,int j,int qabs,bool unmasked,int r32,int hi){
  f32x16 p0=f32x16{},p1=f32x16{};
  qkt(p0,p1,Kslot,qr,r32,hi);
  const int kvb=64*j+4*hi; f32x16 s0,s1;
  if(unmasked){
    #pragma unroll
    for(int r=0;r<16;++r){
      const float e0=__builtin_amdgcn_exp2f(__builtin_fminf(p0[r],80.f)), e1=__builtin_amdgcn_exp2f(__builtin_fminf(p1[r],80.f));
      const float r0=__builtin_amdgcn_rcpf(1.f+e0), r1=__builtin_amdgcn_rcpf(1.f+e1);
      p0[r]=e0*r0; p1[r]=e1*r1; s0[r]=r0; s1[r]=r1; }
  } else {
    #pragma unroll
    for(int r=0;r<16;++r){ const int kv=kvb+(r&3)+8*(r>>2);
      const float e0=__builtin_amdgcn_exp2f(__builtin_fminf(p0[r],80.f)), e1=__builtin_amdgcn_exp2f(__builtin_fminf(p1[r],80.f));
      const float r0=__builtin_amdgcn_rcpf(1.f+e0), r1=__builtin_amdgcn_rcpf(1.f+e1);
      const bool v0=kv<qabs, v1=kv+32<qabs;
      p0[r]=v0?e0*r0:0.f; p1[r]=v1?e1*r1:0.f; s0[r]=v0?r0:1.f; s1[r]=v1?r1:1.f; }
  }
  float g0[4],g1[4],og0[4],og1[4],T0[4],T1[4];
  #pragma unroll
  for(int g=0;g<4;++g){ g0[g]=(s0[4*g]*s0[4*g+1])*(s0[4*g+2]*s0[4*g+3]); g1[g]=(s1[4*g]*s1[4*g+1])*(s1[4*g+2]*s1[4*g+3]); }
  #pragma unroll
  for(int g=0;g<4;++g){ og0[g]=__shfl_xor(g0[g],32); og1[g]=__shfl_xor(g1[g],32); }
  float run=R;
  #pragma unroll
  for(int g=3;g>=0;--g){ const float ah1=hi?g1[g]:og1[g], ah0=hi?og1[g]:g1[g]; const float t1=run; run*=ah1; const float t0=run; run*=ah0; T1[g]=hi?t1:t0; }
  #pragma unroll
  for(int g=3;g>=0;--g){ const float ah1=hi?g0[g]:og0[g], ah0=hi?og0[g]:g0[g]; const float t1=run; run*=ah1; const float t0=run; run*=ah0; T0[g]=hi?t1:t0; }
  R=run;
  #pragma unroll
  for(int g=0;g<4;++g){ float a0=T0[g],a1=T1[g];
    #pragma unroll
    for(int i=3;i>=0;--i){ const int r=4*g+i; p0[r]*=a0; p1[r]*=a1; a0*=s0[r]; a1*=s1[r]; } }
  u32x4 pw0,pw1,pw2,pw3;
  pw0=(u32x4){cvtpk_s(p0[0],p0[1]),cvtpk_s(p0[2],p0[3]),cvtpk_s(p0[4],p0[5]),cvtpk_s(p0[6],p0[7])};
  pw1=(u32x4){cvtpk_s(p0[8],p0[9]),cvtpk_s(p0[10],p0[11]),cvtpk_s(p0[12],p0[13]),cvtpk_s(p0[14],p0[15])};
  pw2=(u32x4){cvtpk_s(p1[0],p1[1]),cvtpk_s(p1[2],p1[3]),cvtpk_s(p1[4],p1[5]),cvtpk_s(p1[6],p1[7])};
  pw3=(u32x4){cvtpk_s(p1[8],p1[9]),cvtpk_s(p1[10],p1[11]),cvtpk_s(p1[12],p1[13]),cvtpk_s(p1[14],p1[15])};
  pv(o,vb,__builtin_bit_cast(bf16x8,pw0),__builtin_bit_cast(bf16x8,pw1),__builtin_bit_cast(bf16x8,pw2),__builtin_bit_cast(bf16x8,pw3));
}
__device__ __forceinline__ void sb_unit(int b,int qb,const bf16*Q,const bf16*__restrict__ K,const bf16*__restrict__ V,bf16*O,char*shm){
  int tid_=threadIdx.x; asm volatile("":"+v"(tid_)); const int tid=tid_,lane=tid&63,r32=lane&31,hi=lane>>5; const int wid=__builtin_amdgcn_readfirstlane(tid>>6);
  const long rowbase=(long)b*SEQ; const int q0=qb*QB;
  const bf16*Qw=Q+(rowbase+q0+wid*QBLK)*DM;
  const bf16*Kh=K+rowbase*DM,*Vh=V+rowbase*DM;
  const unsigned lds0=(unsigned)(uintptr_t)shm; const lds_cptr shm3=(lds_cptr)shm;
  const bf16*ksrc=Kh+(long)lane*DM+wid*8;
  const bf16*vsrc=Vh+(long)(16*(wid&3)+(lane>>2))*DM+(wid>>2)*32+(lane&3)*8;
  const unsigned kdst=lds0+LDS_K+wid*1024, vdst=lds0+LDS_V+wid*1024;
  constexpr int FASTV=65536;
  const unsigned kdstF=lds0+wid*1024, vdstF=lds0+FASTV+wid*1024;
  #define DMA_K(t,slot) glds16(ksrc+(long)(t)*KVBLK*DM,(unsigned)__builtin_amdgcn_readfirstlane(kdst+(slot)))
  #define DMA_V(t,slot) glds16(vsrc+(long)(t)*KVBLK*DM,(unsigned)__builtin_amdgcn_readfirstlane(vdst+(slot)))
  const int vlane=((lane>>4)&1)*32+(lane&3)*8+(4*hi+((lane&15)>>2))*64;
  const int vb0=(int)(lds0+LDS_V)+vlane, vbF=(int)(lds0+FASTV)+vlane;
  typedef __attribute__((address_space(3))) unsigned lds_u32;
  volatile lds_u32*flags=(volatile lds_u32*)(shm3+131072+1024)    ;
  bf16x8 qr[4];
  #pragma unroll
  for(int d0=0;d0<4;++d0)qr[d0]=*reinterpret_cast<const bf16x8*>(&Qw[(long)r32*DM+d0*16+hi*8]);
  asm volatile("":::"memory");
  f32x16 o[2];o[0]=f32x16{};o[1]=f32x16{};
  float R=1.f; const int qabs=q0+wid*QBLK+r32; bool done=false;
#ifndef SB_FAST_TILES
#define SB_FAST_TILES 8
#endif
  static_assert(SB_FAST_TILES>=4&&SB_FAST_TILES<=8,"the fallback assumes every tile it visits lies wholly below the unit's rows (>= 4 staged tiles); 8 tiles fill the 128 KiB");
  const int jtop=4*qb+3, jlow=(jtop-(SB_FAST_TILES-1)>0)?jtop-(SB_FAST_TILES-1):0;
  for(int i=0;i<=jtop-jlow;++i){ glds16(ksrc+(long)(jtop-i)*KVBLK*DM,(unsigned)__builtin_amdgcn_readfirstlane(kdstF+i*SLOTB)); glds16(vsrc+(long)(jtop-i)*KVBLK*DM,(unsigned)__builtin_amdgcn_readfirstlane(vdstF+i*SLOTB)); }
  WAIT_BAR(0);
  for(int j=(q0+wid*QBLK+30)>>6;j>=jlow&&!done;--j){ const int i=jtop-j;
    sb_tile(o,R,shm+i*SLOTB,vbF+i*SLOTB,qr,j,qabs,64*j+63<q0+wid*QBLK,r32,hi);
    done=__all(R<1.0e-37f)!=0; }
  if(lane==0)flags[16+wid]=(done||jlow==0)?1u:0u;
  asm volatile("s_waitcnt lgkmcnt(0)\n\ts_barrier":::"memory");
  unsigned fin=1u;
  #pragma unroll
  for(int w=0;w<NW;++w)fin&=flags[16+w];
  if(!fin){
    const int js=jlow-1;
    DMA_K(js,0);DMA_V(js,0); if(js>=1){ DMA_K(js-1,SLOTB);DMA_V(js-1,SLOTB); }
    int slot=0,slot2=2*SLOTB,bank=0;
    for(int j=js;j>=0;--j){
      if(j>0){ WAIT_BAR(2); } else { WAIT_BAR(0); }
      if(j<js){ unsigned alld=1u;
        #pragma unroll
        for(int w=0;w<NW;++w)alld&=flags[(bank^8)+w];
        if(alld)break; }
      if(j>=2){ DMA_K(j-2,slot2);DMA_V(j-2,slot2); }
      if(!done){ sb_tile(o,R,shm+LDS_K+slot,vb0+slot,qr,j,qabs,true,r32,hi); done=__all(R<1.0e-37f)!=0; }
      if(lane==0)flags[bank+wid]=done?1u:0u;
      bank^=8; slot=(slot==2*SLOTB)?0:slot+SLOTB; slot2=(slot2==2*SLOTB)?0:slot2+SLOTB;
    }
    asm volatile("s_waitcnt vmcnt(0)":::"memory");
  }
  bf16*Ow=O+(rowbase+q0+wid*QBLK)*DMO;
  { bf16*stg=(bf16*)(shm+LDS_OST)+wid*2048;
    #pragma unroll
    for(int r=0;r<16;++r){const int orow=crow(r,hi);
      #pragma unroll
      for(int d0=0;d0<2;++d0)stg[orow*64+d0*32+r32]=__float2bfloat16(o[d0][r]);}
    asm volatile("s_waitcnt lgkmcnt(0)":::"memory");
    #pragma unroll
    for(int i=0;i<4;++i){const int row=i*8+(lane>>3),ch=lane&7; const u32x4 v=*(const u32x4*)(stg+row*64+ch*8); ATTN_STORE16(Ow+(long)row*DMO+ch*8,head_rms(v));} }
  asm volatile("s_waitcnt vmcnt(0) lgkmcnt(0)\n\ts_barrier":::"memory");
  #undef DMA_K
  #undef DMA_V
}
#undef SBAR
#undef WAIT_BAR
}
namespace cg = cooperative_groups;
constexpr int NWAVES = 8;
constexpr int DMODEL = 1024, NBATCH = 4, SEQ_IN = 8192, NMETA = 16, LREAL = NMETA + SEQ_IN, LP = 8448  ;
constexpr int MROWS = NBATCH * LP;
constexpr int MREAL = NBATCH * SEQ_IN;
constexpr int INW = 2566, NINP = 2560, NIN = 2816, DFF = 2816, NGU = 2 * DFF, DEPTH = 2, NFH = 6;
constexpr float C2F = 0.125f * 1.4426950408889634f;
constexpr int PC_U = 0, PC_FQ = 256, PC_FK = 640, PC_FV = 1024, PC_SQ = 1408, PC_SK = 1792, PC_SV = 2176;
constexpr size_t MiB = 1u << 20;
constexpr size_t WS_CTL = 0, CTL_ZERO_BYTES = 1 * MiB;
constexpr size_t WS_SS = 64 * 1024;
constexpr size_t WS_W = 1 * MiB, W_LAYER = 24 * MiB, W_IN = 0, W_OUT = (size_t)NIN * 1024 * 2, W_GU = W_OUT + 2 * MiB, W_D = W_GU + (size_t)NGU * 1024 * 2;
constexpr size_t WS_LF = 49 * MiB, WS_CS = 51 * MiB, WS_H = 52 * MiB, WS_HB = 184 * MiB, WS_Y = 250 * MiB, WS_P = 316 * MiB, WS_END = WS_P + (size_t)MROWS * DFF * 2;
static_assert(W_D + (size_t)1024 * DFF * 2 <= W_LAYER && WS_W + 2 * W_LAYER <= WS_LF && WS_SS + 5 * (size_t)MROWS * 4 <= CTL_ZERO_BYTES, "ws map");
static_assert(WS_H + (size_t)MROWS * 1024 * 4 <= WS_HB && WS_HB + (size_t)MROWS * 1024 * 2 <= WS_Y && WS_Y + (size_t)MROWS * 1024 * 2 <= WS_P && WS_END <= 512 * MiB, "ws map");
constexpr int LDS_BYTES = 147456;
constexpr int LDS_MISC = 131072;

#define LAS __attribute__((address_space(3)))
typedef unsigned short bf16u;
typedef unsigned v4u __attribute__((ext_vector_type(4)));
typedef float f32x4 __attribute__((ext_vector_type(4)));
#define LDS_WAIT() asm volatile("s_waitcnt lgkmcnt(0)" ::: "memory")
__device__ __forceinline__ unsigned f2bf(float f) { unsigned u = __builtin_bit_cast(unsigned, f); return (u + 0x7fffu + ((u >> 16) & 1u)) >> 16; }
__device__ __forceinline__ unsigned pk2(float lo, float hi) { return f2bf(lo) | (f2bf(hi) << 16); }
__device__ __forceinline__ float wave_sum(float v) {
#pragma unroll
    for (int o = 1; o < 64; o <<= 1) v += __shfl_xor(v, o);
    return v;
}

struct Args { const float* in[15]; float* out; unsigned char* ws; };

struct WinSrc { const float* w; const float* g;
    __device__ __forceinline__ float operator()(int k, int n) const { if (n >= INW) return 0.f; const int col = n < 1408 ? n : (n < 2560 ? n + 6 : n - 2560 + 1408);
        const float sc = ((n >= PC_FQ && n < PC_FK) || (n >= PC_SQ && n < PC_SK)) ? C2F : 1.0f; return w[(size_t)k * INW + col] * g[k] * sc; } };
struct WoutSrc { const float* w; const float* fg; const float* sg;
    __device__ __forceinline__ float operator()(int k, int n) const { const float gn = k < 640 ? fg[k - 256] : sg[k - 640]; return w[(size_t)k * 1024 + n] * gn; } };
struct WguSrc { const float* wg; const float* wu; const float* g;
    __device__ __forceinline__ float operator()(int k, int c) const { const int pn = c >> 8, w = c & 255, j = pn * 128 + (w & 127); const long dlt = (w >> 7) ? (long)(wu - wg) : 0L; return wg[(long)k * DFF + j + dlt] * g[k]; } };
struct WdSrc { const float* w;
    __device__ __forceinline__ float operator()(int k, int n) const { return w[(size_t)k * 1024 + n]; } };
template <class F> __device__ __forceinline__ void conv_item(const F src, bf16u* WT, int K, int k0, int n0, LAS float* scr, int lane) {
    float tv[32];
#pragma unroll
    for (int i = 0; i < 32; ++i) tv[i] = src(k0 + 2 * i + (lane >> 5), n0 + (lane & 31));
#pragma unroll
    for (int i = 0; i < 32; ++i) scr[(2 * i + (lane >> 5)) * 33 + (lane & 31)] = tv[i];
    LDS_WAIT(); asm volatile("" ::: "memory");
    const int c = lane & 7;
#pragma unroll
    for (int j = 0; j < 4; ++j) { const int n = (lane >> 3) + 8 * j; const LAS float* s = scr + (8 * c) * 33 + n;
        v4u o; o.x = pk2(s[0 * 33], s[1 * 33]); o.y = pk2(s[2 * 33], s[3 * 33]); o.z = pk2(s[4 * 33], s[5 * 33]); o.w = pk2(s[6 * 33], s[7 * 33]);
        *(v4u*)(WT + (size_t)(n0 + n) * K + k0 + 8 * c) = o; }
    LDS_WAIT(); asm volatile("" ::: "memory");
}
__device__ __forceinline__ void fold_block_item(const float* wout, const float* pw, const float* ps, bf16u* WT, int item, LAS float* lds, int tid) {
    const int g = item >> 4, n0 = (item & 15) * 64;
    LAS float* At = lds; LAS float* Wt = lds + 4096;
    for (int i = tid; i < 4096; i += NWAVES * 64) { At[(i & 63) * 64 + (i >> 6)] = pw[(size_t)g * 4096 + i]; const int d = i >> 6; Wt[i] = wout[(size_t)(g * 64 + d) * 1024 + n0 + (i & 63)] * ps[g * 64 + d]; }
    __syncthreads();
    const int c0 = (tid >> 6) * 8, nn = tid & 63; f32x4 a0 = (f32x4){0.f, 0.f, 0.f, 0.f}, a1 = a0;
#pragma unroll 8
    for (int d = 0; d < 64; ++d) { const float w = Wt[d * 64 + nn]; a0 += *(const LAS f32x4*)(At + d * 64 + c0) * w; a1 += *(const LAS f32x4*)(At + d * 64 + c0 + 4) * w; }
    v4u o; o.x = pk2(a0[0], a0[1]); o.y = pk2(a0[2], a0[3]); o.z = pk2(a1[0], a1[1]); o.w = pk2(a1[2], a1[3]);
    *(v4u*)(WT + (size_t)(n0 + nn) * 1024 + g * 64 + c0) = o;
    __syncthreads();
}
__device__ __forceinline__ void p0_prologue(const Args& A, unsigned char* ws, LAS unsigned char* lds, int wave, int lane) {
    LAS float* scr = (LAS float*)(lds + wave * 16384);
    const int gw = blockIdx.x * NWAVES + wave, NGW = gridDim.x * NWAVES;
    constexpr int I_IN = 16 * (NIN / 32), I_OUT = 12 * 32, I_GU = 16 * (NGU / 32), I_D = (DFF / 64) * 32, I_L = I_IN + I_OUT + I_GU + I_D;
    for (int bi = blockIdx.x; bi < DEPTH * 64; bi += gridDim.x) { const int L = bi >> 6;
        fold_block_item(A.in[9] + (size_t)L * 1024 * 1024, A.in[5] + (size_t)L * 4 * 64 * 64, A.in[6] + L * 256, (bf16u*)(ws + WS_W + (size_t)L * W_LAYER + W_OUT), bi & 63, (LAS float*)lds, wave * 64 + lane); }
    for (int it = gw; it < DEPTH * I_L; it += NGW) {
        const int L = it / I_L; int r = it % I_L;
        bf16u* wb = (bf16u*)(ws + WS_W + (size_t)L * W_LAYER);
        if (r < I_IN) { WinSrc s{A.in[3] + (size_t)L * 1024 * INW, A.in[2] + L * 1024}; conv_item(s, (bf16u*)((unsigned char*)wb + W_IN), 1024, (r / (NIN / 32)) * 64, (r % (NIN / 32)) * 32, scr, lane); continue; } r -= I_IN;
        if (r < I_OUT) { WoutSrc s{A.in[9] + (size_t)L * 1024 * 1024, A.in[7] + L * 384, A.in[8] + L * 384}; conv_item(s, (bf16u*)((unsigned char*)wb + W_OUT), 1024, 256 + (r / 32) * 64, (r % 32) * 32, scr, lane); continue; } r -= I_OUT;
        if (r < I_GU) { WguSrc s{A.in[11] + (size_t)L * 1024 * DFF, A.in[12] + (size_t)L * 1024 * DFF, A.in[10] + L * 1024}; conv_item(s, (bf16u*)((unsigned char*)wb + W_GU), 1024, (r / (NGU / 32)) * 64, (r % (NGU / 32)) * 32, scr, lane); continue; } r -= I_GU;
        { WdSrc s{A.in[13] + (size_t)L * DFF * 1024}; conv_item(s, (bf16u*)((unsigned char*)wb + W_D), DFF, (r / 32) * 64, (r % 32) * 32, scr, lane); }
    }
    bf16u* hb = (bf16u*)(ws + WS_HB); float* ss0 = (float*)(ws + WS_SS);
    for (int m0 = gw * 4; m0 < MROWS; m0 += NGW * 4) {
        f32x4 v[4][4]; float s[4];
#pragma unroll
        for (int q = 0; q < 4; ++q) { const int m = m0 + q, b = m / LP, t = m % LP; s[q] = 0.f;
            if (t < LREAL) { const f32x4* src = (const f32x4*)(t < NMETA ? A.in[1] + (size_t)t * 1024 : A.in[0] + ((size_t)b * SEQ_IN + (t - NMETA)) * 1024) + lane;
#pragma unroll
                for (int j = 0; j < 4; ++j) v[q][j] = src[64 * j]; }
            else {
#pragma unroll
                for (int j = 0; j < 4; ++j) v[q][j] = (f32x4){0.f, 0.f, 0.f, 0.f}; } }
#pragma unroll
        for (int q = 0; q < 4; ++q) { const int m = m0 + q;
#pragma unroll
            for (int j = 0; j < 4; ++j) s[q] += (v[q][j].x * v[q][j].x + v[q][j].y * v[q][j].y) + (v[q][j].z * v[q][j].z + v[q][j].w * v[q][j].w);
            s[q] = wave_sum(s[q]);
            unsigned long long* bo = (unsigned long long*)(hb + (size_t)m * 1024) + lane;
#pragma unroll
            for (int j = 0; j < 4; ++j) bo[64 * j] = (unsigned long long)pk2(v[q][j].x, v[q][j].y) | ((unsigned long long)pk2(v[q][j].z, v[q][j].w) << 32);
            if (lane == 0) ss0[m] = s[q]; }
    }
}
typedef short bf16x8m __attribute__((ext_vector_type(8)));
template <int NBK> __device__ __forceinline__ void mini_item(f32x4 (&acc)[NBK], const bf16u* A16, const bf16u* Bt0, const bf16u* Bt1, int K, LAS unsigned char* lds, int wave, int lane) {
    const int fr = lane & 15, fq = lane >> 4, kw = K >> 3; const size_t o = (size_t)fr * K + wave * kw + 8 * fq;
#pragma unroll
    for (int nb = 0; nb < NBK; ++nb) acc[nb] = (f32x4){0.f, 0.f, 0.f, 0.f};
    for (int k = 0; k < kw; k += 32) { const bf16x8m a = *(const bf16x8m*)(A16 + o + k); const bf16x8m b0 = *(const bf16x8m*)(Bt0 + o + k);
        acc[0] = __builtin_amdgcn_mfma_f32_16x16x32_bf16(b0, a, acc[0], 0, 0, 0);
        if (NBK == 2) { const bf16x8m b1 = *(const bf16x8m*)(Bt1 + o + k); acc[NBK - 1] = __builtin_amdgcn_mfma_f32_16x16x32_bf16(b1, a, acc[NBK - 1], 0, 0, 0); } }
    LAS f32x4* red = (LAS f32x4*)lds;
#pragma unroll
    for (int nb = 0; nb < NBK; ++nb) red[(nb * 8 + wave) * 64 + lane] = acc[nb];
    __syncthreads();
    if (wave == 0) {
#pragma unroll
        for (int nb = 0; nb < NBK; ++nb) { f32x4 s = red[(nb * 8) * 64 + lane];
#pragma unroll
            for (int w = 1; w < 8; ++w) s += red[(nb * 8 + w) * 64 + lane];
            acc[nb] = s; } }
    __syncthreads();
}
__device__ __forceinline__ void mini_in(unsigned char* ws, const bf16u* wt, const float* ss, const float* fb, LAS unsigned char* lds, int wave, int lane) {
    const bf16u* A16 = (const bf16u*)(ws + WS_HB); bf16u* P = (bf16u*)(ws + WS_P); float* LF = (float*)(ws + WS_LF);
    for (int it = blockIdx.x; it < 161; it += gridDim.x) { const int n0 = it * 16; f32x4 acc[1];
        mini_item<1>(acc, A16, wt + (size_t)n0 * 1024, nullptr, 1024, lds, wave, lane);
        if (wave == 0) { const int fr = lane & 15, fq = lane >> 4; const float rs = __builtin_amdgcn_rsqf(ss[fr] * (1.0f / 1024.0f) + 1e-6f); const f32x4 v = acc[0] * rs;
            if (n0 < NINP) { const unsigned long long w = (unsigned long long)pk2(v[0], v[1]) | ((unsigned long long)pk2(v[2], v[3]) << 32);
#pragma unroll
                for (int b = 0; b < NBATCH; ++b) *(unsigned long long*)(P + ((size_t)b * LP + fr) * NINP + n0 + 4 * fq) = w; }
            else if (fq < 2) { f32x4 l;
#pragma unroll
                for (int i = 0; i < 4; ++i) { const int c = 4 * fq + i; const float x = v[i] + fb[c < NFH ? c : 0]; l[i] = c < NFH ? -(fmaxf(-x, 0.f) + log1pf(expf(-fabsf(x)))) * 1.4426950408889634f : 0.f; }
#pragma unroll
                for (int b = 0; b < NBATCH; ++b) *(f32x4*)(LF + ((size_t)b * LP + fr) * 8 + 4 * fq) = l; } }
    }
}
__device__ __forceinline__ void mini_res(unsigned char* ws, const bf16u* A16, const bf16u* wt, int K, float* ssn, LAS unsigned char* lds, int wave, int lane) {
    bf16u* hb = (bf16u*)(ws + WS_HB);
    for (int it = blockIdx.x; it < 64; it += gridDim.x) { const int n0 = it * 16; f32x4 acc[1];
        mini_item<1>(acc, A16, wt + (size_t)n0 * K, nullptr, K, lds, wave, lane);
        if (wave == 0) { const int fr = lane & 15, fq = lane >> 4; unsigned long long* bp = (unsigned long long*)(hb + (size_t)fr * 1024 + n0 + 4 * fq); const unsigned long long r = *bp; const unsigned rl = (unsigned)r, rh = (unsigned)(r >> 32);
            const f32x4 a = (f32x4){__uint_as_float(rl << 16), __uint_as_float(rl & 0xffff0000u), __uint_as_float(rh << 16), __uint_as_float(rh & 0xffff0000u)} + acc[0];
            *bp = (unsigned long long)pk2(a[0], a[1]) | ((unsigned long long)pk2(a[2], a[3]) << 32);
            float s = (a[0] * a[0] + a[1] * a[1]) + (a[2] * a[2] + a[3] * a[3]); s += __shfl_xor(s, 16); s += __shfl_xor(s, 32);
            if (fq == 0) atomicAdd(ssn + fr, s); }
    }
}
__device__ __forceinline__ void mini_gu(unsigned char* ws, const bf16u* wt, const float* ss, LAS unsigned char* lds, int wave, int lane) {
    const bf16u* A16 = (const bf16u*)(ws + WS_HB); bf16u* H = (bf16u*)(ws + WS_P);
    for (int it = blockIdx.x; it < DFF / 16; it += gridDim.x) { const int j0 = it * 16, cg = (j0 >> 7) * 256 + (j0 & 127); f32x4 acc[2];
        mini_item<2>(acc, A16, wt + (size_t)cg * 1024, wt + (size_t)(cg + 128) * 1024, 1024, lds, wave, lane);
        if (wave == 0) { const int fr = lane & 15, fq = lane >> 4; const float rs = __builtin_amdgcn_rsqf(ss[fr] * (1.0f / 1024.0f) + 1e-6f); float o[4];
#pragma unroll
            for (int i = 0; i < 4; ++i) { const float g = acc[0][i] * rs, up = acc[1][i] * rs; o[i] = g * __builtin_amdgcn_rcpf(1.0f + __builtin_amdgcn_exp2f(-1.4426950408889634f * g)) * up; }
            *(unsigned long long*)(H + (size_t)fr * DFF + j0 + 4 * fq) = (unsigned long long)pk2(o[0], o[1]) | ((unsigned long long)pk2(o[2], o[3]) << 32); }
    }
}
__device__ __forceinline__ void fl_phase(unsigned char* ws, const bf16u* wt  , const float* ss, const float* fb, int wave, int lane) {
    const bf16u* HBp = (const bf16u*)(ws + WS_HB); float* LF = (float*)(ws + WS_LF);
    const int fr = lane & 15, fq = lane >> 4;
    for (int it = blockIdx.x * NWAVES + wave; it < MREAL / 16; it += gridDim.x * NWAVES) {
        const int m0 = it * 16, row0 = (m0 / SEQ_IN) * LP + NMETA + (m0 % SEQ_IN);
        const bf16u* ap = HBp + (size_t)(row0 + fr) * 1024 + 8 * fq; const bf16u* bp = wt + (size_t)fr * 1024 + 8 * fq;
        f32x4 acc = (f32x4){0.f, 0.f, 0.f, 0.f};
#pragma unroll 8
        for (int k = 0; k < 1024; k += 32) { const bf16x8m a = *(const bf16x8m*)(ap + k); const bf16x8m b = *(const bf16x8m*)(bp + k); acc = __builtin_amdgcn_mfma_f32_16x16x32_bf16(b, a, acc, 0, 0, 0); }
        if (fq < 2) { const int row = row0 + fr; const float rs = __builtin_amdgcn_rsqf(ss[row] * (1.0f / 1024.0f) + 1e-6f); f32x4 l;
#pragma unroll
            for (int i = 0; i < 4; ++i) { const int c = 4 * fq + i; const float x = acc[i] * rs + fb[c < NFH ? c : 0]; l[i] = c < NFH ? -(fmaxf(-x, 0.f) + log1pf(expf(-fabsf(x)))) * 1.4426950408889634f : 0.f; }
            *(f32x4*)(LF + (size_t)row * 8 + 4 * fq) = l; }
    }
}
__device__ __forceinline__ void pool_scan_phase(unsigned char* ws, LAS unsigned char* lds, unsigned* nrm, int tid, int wave, int lane) {
    const float* LF = (const float*)(ws + WS_LF); float* CS = (float*)(ws + WS_CS);
    if (blockIdx.x < NBATCH * NFH) {
        const int b = blockIdx.x / NFH, hf = blockIdx.x % NFH; constexpr int PER = 17;
        const float* lf = LF + (size_t)b * LP * 8 + hf; float* cs = CS + (size_t)(b * NFH + hf) * LP;
        float v[PER]; float s = 0.f; const int t0 = tid * PER;
#pragma unroll
        for (int i = 0; i < PER; ++i) { const int t = t0 + i; const float x = t < LREAL ? lf[(size_t)t * 8] : 0.f; s += x; v[i] = s; }
        float incl = s;
#pragma unroll
        for (int o = 1; o < 64; o <<= 1) { const float n = __shfl_up(incl, o); if (lane >= o) incl += n; }
        LAS float* wsum = (LAS float*)(lds + LDS_MISC + 256);
        if (lane == 63) wsum[wave] = incl;
        __syncthreads();
        float off = 0.f;
        for (int w = 0; w < wave; ++w) off += wsum[w];
        const float excl = off + incl - s;
#pragma unroll
        for (int i = 0; i < PER; ++i) { const int t = t0 + i; if (t < LREAL) cs[t] = excl + v[i]; }
        __syncthreads();
    }
    const bf16u* P = (const bf16u*)(ws + WS_P); bf16u* Y = (bf16u*)(ws + WS_Y);
    LAS float* nsc_ = (LAS float*)(lds + LDS_MISC + 512);
    for (int sl = blockIdx.x; sl < 256; sl += gridDim.x) {
        if (tid < 480) { const int sub = tid / 96, task = tid % 96, which = task / 48, head = (task % 48) >> 3, chunk = task & 7; const int r0 = sl * (MROWS / 256), b = r0 / LP;
            const bf16u* src = P + (which ? PC_FK : PC_FQ) + head * 64 + chunk * 8; float mx = 0.f;
#pragma unroll 9
            for (int r = sub; r < MROWS / 256; r += 5) { const v4u w = ((r0 + r) % LP < LREAL) ? *(const v4u*)(src + (size_t)(r0 + r) * NINP) : (v4u){0u, 0u, 0u, 0u}; float s = 0.f;
#pragma unroll
                for (int e = 0; e < 4; ++e) { const float lo = __uint_as_float(w[e] << 16), hi = __uint_as_float(w[e] & 0xffff0000u); s += lo * lo + hi * hi; }
                s += __shfl_xor(s, 1); s += __shfl_xor(s, 2); s += __shfl_xor(s, 4); mx = fmaxf(mx, s); }
            if (chunk == 0) nsc_[sub * 12 + head * 2 + which] = mx; }
        __syncthreads();
        if (tid < 12) { const int b = (sl * (MROWS / 256)) / LP; float mx = nsc_[tid];
#pragma unroll
            for (int s5 = 1; s5 < 5; ++s5) mx = fmaxf(mx, nsc_[s5 * 12 + tid]);
            atomicMax(nrm + b * NFH * 2 + tid, __float_as_uint(mx)); }
        __syncthreads();
    }
}
__device__ __forceinline__ void pool_chunk(unsigned char* ws, int c, int tid) {
    const bf16u* P = (const bf16u*)(ws + WS_P); bf16u* Y = (bf16u*)(ws + WS_Y);
    const int rsub = tid >> 5, ch = (tid & 31) * 8, win = 2 << (ch >> 6);
    {
        const int rg = c * 64 + rsub * 4, t0 = rg % LP;
        v4u wv[19];
#pragma unroll
        for (int j = 0; j < 19; ++j) { const int back = 15 - j;
            wv[j] = (back < win && t0 - back >= 0) ? *(const v4u*)(P + (size_t)(rg - back) * NINP + PC_U + ch) : (v4u){0u, 0u, 0u, 0u}; }
#pragma unroll
        for (int i = 0; i < 4; ++i) { const int t = t0 + i, cnt = (t + 1 < win) ? t + 1 : win; float acc[8];
#pragma unroll
            for (int e = 0; e < 8; ++e) acc[e] = 0.f;
#pragma unroll
            for (int k = 0; k < 16; ++k) { if (k < cnt) {
#pragma unroll
                for (int e = 0; e < 4; ++e) { acc[2 * e] += __uint_as_float(wv[15 + i - k][e] << 16); acc[2 * e + 1] += __uint_as_float(wv[15 + i - k][e] & 0xffff0000u); } } }
            const float inv = 1.0f / (float)cnt; v4u o;
#pragma unroll
            for (int e = 0; e < 4; ++e) o[e] = pk2(acc[2 * e] * inv - __uint_as_float(wv[15 + i][e] << 16), acc[2 * e + 1] * inv - __uint_as_float(wv[15 + i][e] & 0xffff0000u));
            *(v4u*)(Y + (size_t)(rg + i) * 1024 + ch) = o; }
    }
}
__device__ __forceinline__ void attn_phase(unsigned char* ws, unsigned char* lds_g, unsigned* ctr, const unsigned* nrm, int tid) {
    const attn_body::bf16* P = (const attn_body::bf16*)(ws + WS_P); attn_body::bf16* Y = (attn_body::bf16*)(ws + WS_Y); const float* CS = (const float*)(ws + WS_CS);
    volatile LAS unsigned* bw = (volatile LAS unsigned*)((LAS unsigned char*)lds_g + LDS_MISC);
    constexpr int NU = NBATCH * NFH * (LP / 256);
    for (;;) {
        if (tid == 0) bw[0] = atomicAdd(ctr, 1u);
        __syncthreads();
        const int it = (int)bw[0];
        __syncthreads();
        if (it >= 2 * NU + MROWS / 64) break;
#ifdef PROBE
        if (it == 2 * NU && tid == 0) ((volatile unsigned long long*)(ws + WS_CTL + 8192))[22 + (ctr != (unsigned*)(ws + WS_CTL))] = __builtin_amdgcn_s_memrealtime();
#endif
        if (it >= 2 * NU) { pool_chunk(ws, it - 2 * NU, tid); continue; }
#ifdef PROBE
        if (it == NU && tid == 0) ((volatile unsigned long long*)(ws + WS_CTL + 8192))[20 + (ctr != (unsigned*)(ws + WS_CTL))] = __builtin_amdgcn_s_memrealtime();
#endif
        constexpr int NF1 = 17 * NBATCH * NFH;
        const bool is_fox = it < NF1 || it >= NF1 + NU; const int r = it < NF1 ? it : (it < NF1 + NU ? it - NF1 : it - NU); const int qb = (LP / 256 - 1) - r / (NBATCH * NFH), bh = r % (NBATCH * NFH), b = bh / NFH, h = bh % NFH;
#ifndef NO_FOX
        if (is_fox) attn_body::fox_unit<8>(b, qb, 154.0f + 2.0f * sqrtf(__uint_as_float(nrm[bh * 2]) * __uint_as_float(nrm[bh * 2 + 1])), P + PC_FQ + h * 64, P + PC_FK + h * 64, P + PC_FV + h * 64, Y + 256 + h * 64, CS + (size_t)bh * LP, (char*)lds_g);
#endif
#ifndef NO_SB
        if (!is_fox) attn_body::sb_unit(b, qb, P + PC_SQ + h * 64, P + PC_SK + h * 64, P + PC_SV + h * 64, Y + 640 + h * 64, (char*)lds_g);
#endif
    }
}
__device__ __forceinline__ void final_phase(const Args& A, unsigned char* ws, int wave, int lane) {
    const bf16u* hb = (const bf16u*)(ws + WS_HB); const float* ss = (const float*)(ws + WS_SS) + 4 * (size_t)MROWS; const f32x4* g = (const f32x4*)A.in[14] + lane;
    const int gw = blockIdx.x * NWAVES + wave, NGW = gridDim.x * NWAVES;
    f32x4 gv[4];
#pragma unroll
    for (int j = 0; j < 4; ++j) gv[j] = g[64 * j];
    for (int m0 = gw * 2; m0 < NBATCH * SEQ_IN; m0 += NGW * 2) {
        unsigned long long r[2][4]; float rs[2];
#pragma unroll
        for (int q = 0; q < 2; ++q) { const int m = m0 + q, b = m / SEQ_IN, s = m % SEQ_IN; const size_t row = (size_t)b * LP + NMETA + s;
            rs[q] = 1.0f / sqrtf(ss[row] * (1.0f / 1024.0f) + 1e-6f);
            const unsigned long long* src = (const unsigned long long*)(hb + row * 1024) + lane;
#pragma unroll
            for (int j = 0; j < 4; ++j) r[q][j] = src[64 * j]; }
#pragma unroll
        for (int q = 0; q < 2; ++q) { f32x4* dst = (f32x4*)(A.out + (size_t)(m0 + q) * 1024) + lane;
#pragma unroll
            for (int j = 0; j < 4; ++j) { const unsigned rl = (unsigned)r[q][j], rh = (unsigned)(r[q][j] >> 32);
                dst[64 * j] = (f32x4){__uint_as_float(rl << 16), __uint_as_float(rl & 0xffff0000u), __uint_as_float(rh << 16), __uint_as_float(rh & 0xffff0000u)} * rs[q] * gv[j]; } }
    }
}

#define XB_TMO      128
#define XB_XCNT(j)  (256  + 64 * (j))
#define XB_XSUB(j)  (1280 + 64 * (j))
#define XB_XGEN(j)  (2304 + 64 * (j))
#define XB_TOP      3328
#define XB_TOPGEN   3392
#define XCD_BAR_WORDS 3456
#define XB_SPIN_CAP (1u << 18)

__device__ __forceinline__ unsigned xb_ld(unsigned* p)              { return __hip_atomic_load(p, __ATOMIC_RELAXED, __HIP_MEMORY_SCOPE_AGENT); }
__device__ __forceinline__ unsigned xb_add(unsigned* p, unsigned v) { return __hip_atomic_fetch_add(p, v, __ATOMIC_RELAXED, __HIP_MEMORY_SCOPE_AGENT); }
__device__ __forceinline__ unsigned xb_xcc_id() { return (unsigned)__builtin_amdgcn_s_getreg((3 << 11) | 20) & 0xFu; }
#define XB_SPIN(cond, bar) do { unsigned _sp = 0; while (cond) { __builtin_amdgcn_s_sleep(1); \
    if ((++_sp & 255u) == 0u) { if (xb_ld(&(bar)[XB_TMO])) break; if (_sp > XB_SPIN_CAP) { atomicAdd(&(bar)[XB_TMO], 1u); break; } } } } while (0)

struct XcdBarrier {
    unsigned* bar; unsigned x;
    volatile LAS unsigned* st;
};

__device__ __forceinline__ XcdBarrier xcd_barrier_post(unsigned* bar, volatile LAS unsigned* st) {
    XcdBarrier b; b.bar = bar; b.x = xb_xcc_id(); b.st = st;
    if (threadIdx.x == 0) (void)xb_add(&bar[XB_XCNT(b.x)], 1u);
    return b;
}
__device__ __forceinline__ void xcd_barrier_complete(unsigned* bar, unsigned x, unsigned& nloc, unsigned& nx) {
    const unsigned G = gridDim.x * gridDim.y * gridDim.z;
    unsigned sum, cnt, mine, sp = 0u;
    for (;;) {
        sum = 0u; cnt = 0u; mine = 0u;
#pragma unroll
        for (unsigned j = 0; j < 16; ++j) { const unsigned c = xb_ld(&bar[XB_XCNT(j)]); sum += c; cnt += (c > 0u) ? 1u : 0u; mine = (j == x) ? c : mine; }
        if (sum == G) break;
        __builtin_amdgcn_s_sleep(1);
        if ((++sp & 255u) == 0u) { if (xb_ld(&bar[XB_TMO])) break; if (sp > XB_SPIN_CAP) { atomicAdd(&bar[XB_TMO], 1u); break; } }
    }
    nloc = mine > 0u ? mine : 1u; nx = cnt > 0u ? cnt : 1u;
}

__device__ __forceinline__ void xcd_barrier(const XcdBarrier& b) {
    asm volatile("s_waitcnt vmcnt(0)" ::: "memory");
    __syncthreads();
    if (threadIdx.x == 0) {
        unsigned* bar = b.bar;
        __builtin_amdgcn_s_waitcnt(0);
        unsigned nloc = b.st[0], nx = b.st[1];
        if (nloc == 0u) { xcd_barrier_complete(bar, b.x, nloc, nx); b.st[0] = nloc; b.st[1] = nx; }
        const unsigned old = xb_add(&bar[XB_XSUB(b.x)], 1u);
        const unsigned gen = old / nloc;
        if (old + 1u == (gen + 1u) * nloc) {
            __builtin_amdgcn_fence(__ATOMIC_RELEASE, "agent");
            asm volatile("s_waitcnt vmcnt(0)" ::: "memory");
            const unsigned og = xb_add(&bar[XB_TOP], 1u);
            const unsigned tg = og / nx;
            if (og + 1u == (tg + 1u) * nx) xb_add(&bar[XB_TOPGEN], 1u);
            else XB_SPIN(xb_ld(&bar[XB_TOPGEN]) == tg, bar);
            __builtin_amdgcn_fence(__ATOMIC_ACQUIRE, "agent");
            xb_add(&bar[XB_XGEN(b.x)], 1u);
            asm volatile("s_waitcnt vmcnt(0)" ::: "memory");
        } else {
            XB_SPIN(xb_ld(&bar[XB_XGEN(b.x)]) == gen, bar);
            __builtin_amdgcn_fence(__ATOMIC_ACQUIRE, "agent");
            asm volatile("s_waitcnt vmcnt(0)" ::: "memory");
        }
    }
    __syncthreads();
}

#define FRESH() unsigned long zoff_ = 0; asm volatile("" : "+s"(zoff_)); unsigned char* ws = A.ws + zoff_; int tid = threadIdx.x; asm volatile("" : "+v"(tid)); const int lane = tid & 63, wave = __builtin_amdgcn_readfirstlane(tid >> 6); (void)lane; (void)wave
#ifdef PROBE
#define STAMP() do { if (blockIdx.x == 0 && threadIdx.x == 0) { ((volatile unsigned long long*)(A.ws + WS_CTL + 8192))[nst] = __builtin_amdgcn_s_memrealtime(); } ++nst; } while (0)
#else
#define STAMP() do {} while (0)
#endif
__global__ void __launch_bounds__(NWAVES * 64, 2) hymba_fwd(Args A) {
    extern __shared__ __attribute__((aligned(16))) unsigned char lds[];
    cg::grid_group grid = cg::this_grid();
    LAS unsigned char* L = (LAS unsigned char*)lds;
    if (threadIdx.x < 2) ((volatile LAS unsigned*)(L + LDS_MISC + 64))[threadIdx.x] = 0u;
    __syncthreads();
    const XcdBarrier xbar = xcd_barrier_post((unsigned*)(A.ws + WS_CTL) + 4096, (volatile LAS unsigned*)(L + LDS_MISC + 64));
#define GRID_BAR() xcd_barrier(xbar)
#ifdef PROBE
    int nst = 0; STAMP();
    for (int i = 0; i < 8; ++i) GRID_BAR();
    STAMP();
#endif
#ifndef NO_PRO
    { FRESH(); p0_prologue(A, ws, L, wave, lane); }
#endif
    if (A.ws == nullptr) grid.sync();
    GRID_BAR(); STAMP();
    for (int layer = 0; layer < DEPTH; ++layer) {
#ifndef NO_G1
        {
            FRESH(); const unsigned char* wb = ws + WS_W + (size_t)layer * W_LAYER;
            pg8::Gemm g{(const pg8::bf16_t*)(ws + WS_HB), (const pg8::bf16_t*)(wb + W_IN), MREAL, NINP, 1024}; pg8::StaticOrder S; S.init(MREAL, NINP, (int)gridDim.x, (int)blockIdx.x);
            pg8::EpiIn E{(pg8::bf16_t*)(ws + WS_P), (float*)(ws + WS_LF), (const float*)(ws + WS_SS) + (size_t)(2 * layer) * MROWS, A.in[4] + layer * NFH};
            fl_phase(ws, (const bf16u*)(wb + W_IN) + (size_t)NINP * 1024, (const float*)(ws + WS_SS) + (size_t)(2 * layer) * MROWS, A.in[4] + layer * NFH, wave, lane);
            mini_in(ws, (const bf16u*)(wb + W_IN), (const float*)(ws + WS_SS) + (size_t)(2 * layer) * MROWS, A.in[4] + layer * NFH, L, wave, lane);
            pg8::gemm_phase<pg8::EpiIn, pg8::StaticOrder, true, true>(L, g, S, E);
        }
#endif
        GRID_BAR(); STAMP();
#ifndef NO_POOL
        { FRESH(); pool_scan_phase(ws, L, (unsigned*)(ws + WS_CTL) + 128 + 64 * layer, tid, wave, lane); }
#endif
        GRID_BAR(); STAMP();
        { FRESH(); attn_phase(ws, lds, (unsigned*)(ws + WS_CTL) + 64 * layer, (const unsigned*)(ws + WS_CTL) + 128 + 64 * layer, tid); }
        GRID_BAR(); STAMP();
#ifndef NO_G3
        {
            FRESH(); const unsigned char* wb = ws + WS_W + (size_t)layer * W_LAYER;
            pg8::Gemm g{(const pg8::bf16_t*)(ws + WS_Y), (const pg8::bf16_t*)(wb + W_OUT), MREAL, 1024, 1024}; pg8::StaticOrder S; S.init(MREAL, 1024, (int)gridDim.x, (int)blockIdx.x);
            pg8::EpiRes E{(pg8::bf16_t*)(ws + WS_HB), nullptr, (float*)(ws + WS_SS) + (size_t)(2 * layer + 1) * MROWS};
            mini_res(ws, (const bf16u*)(ws + WS_Y), (const bf16u*)(wb + W_OUT), 1024, (float*)(ws + WS_SS) + (size_t)(2 * layer + 1) * MROWS, L, wave, lane);
            pg8::gemm_phase<pg8::EpiRes, pg8::StaticOrder, true, true>(L, g, S, E);
        }
#endif
        GRID_BAR(); STAMP();
#ifndef NO_G4
        {
            FRESH(); const unsigned char* wb = ws + WS_W + (size_t)layer * W_LAYER;
            pg8::Gemm g{(const pg8::bf16_t*)(ws + WS_HB), (const pg8::bf16_t*)(wb + W_GU), MREAL, NGU, 1024}; pg8::StaticOrder S; S.init(MREAL, NGU, (int)gridDim.x, (int)blockIdx.x);
            pg8::EpiGU E{(pg8::bf16_t*)(ws + WS_P), (const float*)(ws + WS_SS) + (size_t)(2 * layer + 1) * MROWS};
            mini_gu(ws, (const bf16u*)(wb + W_GU), (const float*)(ws + WS_SS) + (size_t)(2 * layer + 1) * MROWS, L, wave, lane);
            pg8::gemm_phase<pg8::EpiGU, pg8::StaticOrder, true, true>(L, g, S, E);
        }
#endif
        GRID_BAR(); STAMP();
#ifndef NO_G5
        {
            FRESH(); const unsigned char* wb = ws + WS_W + (size_t)layer * W_LAYER;
            pg8::Gemm g{(const pg8::bf16_t*)(ws + WS_P), (const pg8::bf16_t*)(wb + W_D), MREAL, 1024, DFF}; pg8::StaticOrder S; S.init(MREAL, 1024, (int)gridDim.x, (int)blockIdx.x);
            pg8::EpiRes E{(pg8::bf16_t*)(ws + WS_HB), nullptr, (float*)(ws + WS_SS) + (size_t)(2 * layer + 2) * MROWS};
            mini_res(ws, (const bf16u*)(ws + WS_P), (const bf16u*)(wb + W_D), DFF, (float*)(ws + WS_SS) + (size_t)(2 * layer + 2) * MROWS, L, wave, lane);
            pg8::gemm_phase<pg8::EpiRes, pg8::StaticOrder, true, true>(L, g, S, E);
        }
#endif
        GRID_BAR(); STAMP();
    }
    { FRESH(); final_phase(A, ws, wave, lane); }
#ifdef PROBE
    STAMP();
    grid.sync();
    {
        volatile unsigned long long* T = (volatile unsigned long long*)(A.ws + WS_CTL + 8192);
        if (blockIdx.x == 0) {
#ifndef PB_HI
#define PB_HI (PB + 1)
#endif

#ifndef PA_HI
#define PA_HI (PA + 1)
#endif
            const unsigned long long dA = T[PA_HI] - T[PA], dB = T[PB_HI < 0 ? 0 : PB_HI] - T[PB < 0 ? 0 : PB];
#if PB >= 0
            for (unsigned long long i = threadIdx.x; i < dB; i += NWAVES * 64) A.out[i] += 0.125f;
#else
            (void)dB;
#endif
            if (threadIdx.x == 0) { const unsigned long long t0 = __builtin_amdgcn_s_memrealtime(); while (__builtin_amdgcn_s_memrealtime() - t0 < dA) __builtin_amdgcn_s_sleep(8); }
        }
    }
#endif
}

extern "C" void kernel_launch(void* const* d_in, const int* in_sizes, int n_in, void* d_out, int out_size, void* d_ws, size_t ws_size, hipStream_t stream) {
    static int grid = 0;
    if (grid == 0) {
        if (n_in != 15 || out_size != NBATCH * SEQ_IN * DMODEL || ws_size < WS_END) { fprintf(stderr, "kernel_launch: unexpected shapes (n_in %d out %d ws %zu, need %zu)\n", n_in, out_size, ws_size, (size_t)WS_END); grid = -1; return; }
        int dev = 0, cus = 0, per_cu = 0;
        if (hipGetDevice(&dev) != hipSuccess || hipDeviceGetAttribute(&cus, hipDeviceAttributeMultiprocessorCount, dev) != hipSuccess) { grid = -1; return; }
        if (hipFuncSetAttribute((const void*)hymba_fwd, hipFuncAttributeMaxDynamicSharedMemorySize, LDS_BYTES) != hipSuccess) { fprintf(stderr, "kernel_launch: hipFuncSetAttribute failed\n"); grid = -1; return; }
        if (hipOccupancyMaxActiveBlocksPerMultiprocessor(&per_cu, (const void*)hymba_fwd, NWAVES * 64, LDS_BYTES) != hipSuccess || per_cu < 1) { fprintf(stderr, "kernel_launch: occupancy query says %d\n", per_cu); per_cu = 1; }
        (void)hipGetLastError();
        grid = cus;
    }
    if (grid < 0) return;
    if (hipMemsetAsync((char*)d_ws + WS_CTL, 0, CTL_ZERO_BYTES, stream) != hipSuccess) { fprintf(stderr, "kernel_launch: memset failed\n"); return; }
    Args a{};
    for (int i = 0; i < 15; ++i) a.in[i] = (const float*)d_in[i];
    a.out = (float*)d_out; a.ws = (unsigned char*)d_ws;
    void* args[] = {&a};
    const hipError_t e = hipLaunchCooperativeKernel((const void*)hymba_fwd, dim3(grid), dim3(NWAVES * 64), args, LDS_BYTES, stream);
    if (e != hipSuccess) fprintf(stderr, "kernel_launch: cooperative launch failed: %s (grid %d)\n", hipGetErrorString(e), grid);
}
```

```cpp
#include <hip/hip_runtime.h>
#include <hip/hip_cooperative_groups.h>
#include <cstdio>
#include <cstdint>
namespace pg8 {
#define PG8_LAS __attribute__((address_space(3)))
typedef unsigned short bf16_t;
typedef short bf16x8 __attribute__((ext_vector_type(8)));
typedef float f32x4 __attribute__((ext_vector_type(4)));
typedef unsigned u32x4 __attribute__((ext_vector_type(4)));
constexpr int BM = 256, BK = 64, HALF = 128, HTB = HALF * BK * 2  , STAGE_BYTES = 8 * HTB, NXCD = 8, WGM = 8;

__host__ __device__ __forceinline__ int lds_byte(int r, int c) { const int st = (r >> 4) * 2 + (c >> 5), rr = r & 15, cc = c & 31, ob = rr * 64 + cc * 2; return st * 1024 + (ob ^ (((ob >> 9) & 1) << 5)); }
__host__ __device__ __forceinline__ void stage_rc(int b, int& R, int& C) { const int st = b / 1024, sb = b % 1024, swz = sb ^ (((sb >> 9) & 1) << 5); R = (st >> 1) * 16 + swz / 64; C = (st & 1) * 32 + (swz % 64) / 2; }
__host__ __device__ __forceinline__ int perm32(int rho) { const int n = rho >> 4, i = rho & 15; return 8 * (i >> 2) + 4 * n + (i & 3); }

struct Unit { int pm, pn; };
__host__ __device__ __forceinline__ int arow(int pm) { return 256 * (pm + (pm >> 5)) + 16; }
struct Gemm { const bf16_t* A; const bf16_t* Bt; int M, N, K; };

struct StaticOrder {
    int nM, nN, nwg, G, c;
    __host__ __device__ void init(int M, int N, int G_, int c_) { nM = M / BM; nN = N / BM; nwg = nM * nN; G = G_; c = c_; }
    __host__ __device__ bool next(int i, Unit& u) const {
        const long L = (long)i * G + c; if (L >= nwg) return false;
        int wgid = (int)L; { const int q = nwg / NXCD, r = nwg % NXCD, xcd = wgid % NXCD, off = wgid / NXCD; wgid = (xcd < r ? xcd * (q + 1) : r * (q + 1) + (xcd - r) * q) + off; }
        const int nig = WGM * nN, gid = wgid / nig, fm = gid * WGM, gsz = (nM - fm) < WGM ? (nM - fm) : WGM;
        u.pm = fm + ((wgid % nig) % gsz); u.pn = (wgid % nig) / gsz; return true;
    }
    __device__ __forceinline__ void a_ready(const Unit&) const {}
    __device__ __forceinline__ void done(const Unit&) const {}
};

__device__ __forceinline__ unsigned cvt_pk_bf16(float lo, float hi) { unsigned r; asm volatile("v_cvt_pk_bf16_f32 %0, %1, %2" : "=v"(r) : "v"(lo), "v"(hi)); return r; }
typedef unsigned u32x2 __attribute__((ext_vector_type(2)));
constexpr float RMS_EPS = 1e-6f;
struct EpiIn {
    static constexpr bool PERM = true, AFTER_DRAIN = false;
    bf16_t* P; float* LF; const float* ss; const float* fb;
    __device__ __forceinline__ void operator()(const f32x4 (&acc)[2][2][4][2], const Unit& u, int wr, int wc, int fr, int fq) const {
        const int row0 = arow(u.pm) + wr * 64 + fr;
        {
            const int col0 = u.pn * BM + wc * 32 + 8 * fq;
#pragma unroll
            for (int ai = 0; ai < 2; ++ai)
#pragma unroll
                for (int m = 0; m < 4; ++m) { const int row = row0 + ai * HALF + m * 16; const float rs = __builtin_amdgcn_rsqf(ss[row] * (1.0f / 1024.0f) + RMS_EPS);
                    bf16_t* rowp = P + (size_t)row * 2560 + col0;
#pragma unroll
                    for (int bj = 0; bj < 2; ++bj) { const f32x4 v0 = acc[ai][bj][m][0] * rs, v1 = acc[ai][bj][m][1] * rs;
                        u32x4 w; w.x = cvt_pk_bf16(v0[0], v0[1]); w.y = cvt_pk_bf16(v0[2], v0[3]); w.z = cvt_pk_bf16(v1[0], v1[1]); w.w = cvt_pk_bf16(v1[2], v1[3]);
                        *(u32x4*)(rowp + bj * HALF) = w; } }
        }
    }
};
struct EpiRes {
    static constexpr bool PERM = true, AFTER_DRAIN = false;
    bf16_t* hb; float* hf; float* ssn;
    __device__ __forceinline__ void operator()(const f32x4 (&acc)[2][2][4][2], const Unit& u, int wr, int wc, int fr, int fq) const {
        const int row0 = arow(u.pm) + wr * 64 + fr, col0 = u.pn * BM + wc * 32 + 8 * fq;
#pragma unroll
        for (int ai = 0; ai < 2; ++ai)
#pragma unroll
            for (int m = 0; m < 4; ++m) { const int row = row0 + ai * HALF + m * 16; bf16_t* bp = hb + (size_t)row * 1024 + col0; float s = 0.f;
#pragma unroll
                for (int bj = 0; bj < 2; ++bj) { const u32x4 r = *(const u32x4*)(bp + bj * HALF);
                    f32x4 a = (f32x4){__uint_as_float(r.x << 16), __uint_as_float(r.x & 0xffff0000u), __uint_as_float(r.y << 16), __uint_as_float(r.y & 0xffff0000u)};
                    f32x4 b = (f32x4){__uint_as_float(r.z << 16), __uint_as_float(r.z & 0xffff0000u), __uint_as_float(r.w << 16), __uint_as_float(r.w & 0xffff0000u)};
                    a = a + acc[ai][bj][m][0]; b = b + acc[ai][bj][m][1];
                    if (hf) { float* hp = hf + (size_t)row * 1024 + col0 + bj * HALF; *(f32x4*)hp = a; *(f32x4*)(hp + 4) = b; }
                    s += (a[0] * a[0] + a[1] * a[1]) + (a[2] * a[2] + a[3] * a[3]) + (b[0] * b[0] + b[1] * b[1]) + (b[2] * b[2] + b[3] * b[3]);
                    u32x4 w; w.x = cvt_pk_bf16(a[0], a[1]); w.y = cvt_pk_bf16(a[2], a[3]); w.z = cvt_pk_bf16(b[0], b[1]); w.w = cvt_pk_bf16(b[2], b[3]);
                    *(u32x4*)(bp + bj * HALF) = w; }
                s += __shfl_xor(s, 16); s += __shfl_xor(s, 32);
                if (fq == 0) atomicAdd(ssn + row, s);
                asm volatile("" ::: "memory"); }
    }
};
struct EpiGU {
    static constexpr bool PERM = true, AFTER_DRAIN = false;
    bf16_t* H; const float* ss;
    __device__ __forceinline__ void operator()(const f32x4 (&acc)[2][2][4][2], const Unit& u, int wr, int wc, int fr, int fq) const {
        const int row0 = arow(u.pm) + wr * 64 + fr, col0 = u.pn * HALF + wc * 32 + 8 * fq;
#pragma unroll
        for (int ai = 0; ai < 2; ++ai)
#pragma unroll
            for (int m = 0; m < 4; ++m) { const int row = row0 + ai * HALF + m * 16; const float rs = __builtin_amdgcn_rsqf(ss[row] * (1.0f / 1024.0f) + RMS_EPS);
                float o[8];
#pragma unroll
                for (int n = 0; n < 2; ++n)
#pragma unroll
                    for (int e = 0; e < 4; ++e) { const float g = acc[ai][0][m][n][e] * rs, up = acc[ai][1][m][n][e] * rs;
                        o[4 * n + e] = g * __builtin_amdgcn_rcpf(1.0f + __builtin_amdgcn_exp2f(-1.4426950408889634f * g)) * up; }
                u32x4 w; w.x = cvt_pk_bf16(o[0], o[1]); w.y = cvt_pk_bf16(o[2], o[3]); w.z = cvt_pk_bf16(o[4], o[5]); w.w = cvt_pk_bf16(o[6], o[7]);
                *(u32x4*)(H + (size_t)row * 2816 + col0) = w; }
    }
};
template <class Epi, class Sched, bool ALIGN_EPI = false, bool SP2 = false>
__device__ __forceinline__ void gemm_phase(PG8_LAS unsigned char* lds, const Gemm g, const Sched& S, const Epi& E) {
    int tid_ = threadIdx.x; asm volatile("" : "+v"(tid_));
    const int tid = tid_, wid = __builtin_amdgcn_readfirstlane(tid >> 6), lane = tid & 63, wr = wid >> 2, wc = wid & 3, fr = lane & 15, fq = lane >> 4;
    const int K = g.K, nt = K / BK;
    unsigned voffA[2], voffB[2];
#pragma unroll
    for (int i = 0; i < 2; ++i) { int R, C; stage_rc(tid * 16 + i * 8192, R, C); const int Rb = Epi::PERM ? ((R & ~31) + perm32(R & 31)) : R;
        voffA[i] = (unsigned)(R * K + C) * 2u; voffB[i] = (unsigned)(Rb * K + C) * 2u; }
    const size_t kstep = (size_t)(BK * 2);
    const size_t hstep = (size_t)HALF * K * 2;
    const size_t tstep = 2 * hstep;
    const unsigned ldsw = (unsigned)wid * 1024u;
    const int aoff = lds_byte(wr * 64 + fr, fq * 8), boff = lds_byte(wc * 32 + fr, fq * 8);
#define PG8_SA(b, h) (((b) * 2 + (h)) * HTB)
#define PG8_SB(b, h) ((4 + (b) * 2 + (h)) * HTB)
#define PG8_STAGE(bufoff, gbase, voff) do { _Pragma("unroll") for (int _i = 0; _i < 2; ++_i) \
        __builtin_amdgcn_global_load_lds((const unsigned*)((const char*)(gbase) + (voff)[_i]), (PG8_LAS unsigned*)(lds + (bufoff) + ldsw + _i * 8192), 16, 0, 0); } while (0)
#define PG8_LDA(dst, b, h) do { _Pragma("unroll") for (int m = 0; m < 4; ++m) _Pragma("unroll") for (int k = 0; k < 2; ++k) dst[m][k] = *(const PG8_LAS bf16x8*)(lds + PG8_SA(b, h) + aoff + m * 2048 + k * 1024); } while (0)
#define PG8_LDB(dst, b, h) do { _Pragma("unroll") for (int n = 0; n < 2; ++n) _Pragma("unroll") for (int k = 0; k < 2; ++k) dst[n][k] = *(const PG8_LAS bf16x8*)(lds + PG8_SB(b, h) + boff + n * 2048 + k * 1024); } while (0)
#define PG8_MMA(ai, bj, At, Bt) do { __builtin_amdgcn_s_setprio(1); _Pragma("unroll") for (int m = 0; m < 4; ++m) _Pragma("unroll") for (int n = 0; n < 2; ++n) _Pragma("unroll") for (int k = 0; k < 2; ++k) \
        acc[ai][bj][m][n] = __builtin_amdgcn_mfma_f32_16x16x32_bf16(Bt[n][k], At[m][k], acc[ai][bj][m][n], 0, 0, 0); __builtin_amdgcn_s_setprio(0); } while (0)
#define PG8_WAIT_V(n) asm volatile("s_waitcnt vmcnt(" #n ")" ::: "memory")
#define PG8_WAIT_L(n) asm volatile("s_waitcnt lgkmcnt(" #n ")" ::: "memory")
#define PG8_BAR __builtin_amdgcn_s_barrier()
#define PG8_SCHED __builtin_amdgcn_sched_barrier(0)
    Unit cur, nxt; int ui = 0;
    if (!S.next(0, cur)) return;
    f32x4 acc[2][2][4][2];
#pragma unroll
    for (int a = 0; a < 2; ++a)
#pragma unroll
        for (int b = 0; b < 2; ++b)
#pragma unroll
            for (int m = 0; m < 4; ++m)
#pragma unroll
                for (int n = 0; n < 2; ++n) acc[a][b][m][n] = (f32x4){0.f, 0.f, 0.f, 0.f};
    bf16x8 At[4][2], B0[2][2], B1[2][2];
    const char* cA = (const char*)g.A + (size_t)arow(cur.pm) * K * 2; const char* cB = (const char*)g.Bt + (size_t)cur.pn * tstep;
    S.a_ready(cur);
    if constexpr (SP2) {
        PG8_STAGE(PG8_SB(0, 0), cB, voffB); PG8_STAGE(PG8_SB(0, 1), cB + hstep, voffB); PG8_STAGE(PG8_SA(0, 0), cA, voffA); PG8_STAGE(PG8_SA(0, 1), cA + hstep, voffA);
        if (wr == 1) PG8_BAR;
        PG8_WAIT_V(2); PG8_BAR;
        PG8_STAGE(PG8_SB(1, 0), cB + kstep, voffB); PG8_STAGE(PG8_SA(1, 0), cA + kstep, voffA); PG8_STAGE(PG8_SB(1, 1), cB + hstep + kstep, voffB);
        PG8_WAIT_V(6); PG8_BAR;
    } else {
        PG8_STAGE(PG8_SB(0, 0), cB, voffB); PG8_STAGE(PG8_SA(0, 0), cA, voffA); PG8_STAGE(PG8_SB(0, 1), cB + hstep, voffB); PG8_STAGE(PG8_SA(0, 1), cA + hstep, voffA);
        if (wr == 1) PG8_BAR;
        PG8_WAIT_V(4); PG8_BAR;
        PG8_STAGE(PG8_SB(1, 0), cB + kstep, voffB); PG8_STAGE(PG8_SA(1, 0), cA + kstep, voffA); PG8_STAGE(PG8_SB(1, 1), cB + hstep + kstep, voffB);
        PG8_WAIT_V(6); PG8_BAR;
    }
    for (;;) {
        const bool has_next = S.next(ui + 1, nxt);
        const char* nA = has_next ? (const char*)g.A + (size_t)arow(nxt.pm) * K * 2 : cA; const char* nB = has_next ? (const char*)g.Bt + (size_t)nxt.pn * tstep : cB;
        for (int t = 0; t < nt; t += 2) {
            const bool last = (t == nt - 2);
            const char* a1 = cA + (size_t)(t + 1) * kstep;
            const char* a2 = last ? nA : cA + (size_t)(t + 2) * kstep; const char* b2 = last ? nB : cB + (size_t)(t + 2) * kstep;
            const char* a3 = a2 + kstep; const char* b3 = b2 + kstep;
            if (last && has_next) S.a_ready(nxt);
            if constexpr (SP2) {
            PG8_LDB(B0, 0, 0); PG8_LDB(B1, 0, 1); PG8_SCHED; PG8_LDA(At, 0, 0); PG8_STAGE(PG8_SA(1, 1), a1 + hstep, voffA);
            PG8_WAIT_V(8); PG8_WAIT_L(0); PG8_BAR; PG8_MMA(0, 0, At, B0); PG8_MMA(0, 1, At, B1); PG8_BAR; PG8_SCHED;
            PG8_LDA(At, 0, 1); PG8_STAGE(PG8_SB(0, 0), b2, voffB); PG8_STAGE(PG8_SB(0, 1), b2 + hstep, voffB); PG8_STAGE(PG8_SA(0, 0), a2, voffA);
            PG8_WAIT_V(8); PG8_WAIT_L(0); PG8_BAR; PG8_MMA(1, 0, At, B0); PG8_MMA(1, 1, At, B1); PG8_BAR; PG8_SCHED;
            PG8_LDB(B0, 1, 0); PG8_LDB(B1, 1, 1); PG8_SCHED; PG8_LDA(At, 1, 0); PG8_STAGE(PG8_SA(0, 1), a2 + hstep, voffA);
            PG8_WAIT_V(8); PG8_WAIT_L(0); PG8_BAR; PG8_MMA(0, 0, At, B0); PG8_MMA(0, 1, At, B1); PG8_BAR; PG8_SCHED;
            PG8_LDA(At, 1, 1); PG8_STAGE(PG8_SB(1, 0), b3, voffB); PG8_STAGE(PG8_SB(1, 1), b3 + hstep, voffB); PG8_STAGE(PG8_SA(1, 0), a3, voffA);
            PG8_WAIT_V(8); PG8_WAIT_L(0); PG8_BAR; PG8_MMA(1, 0, At, B0); PG8_MMA(1, 1, At, B1); PG8_BAR; PG8_SCHED;
            } else {
            PG8_LDB(B0, 0, 0); PG8_SCHED; PG8_LDA(At, 0, 0); PG8_STAGE(PG8_SA(1, 1), a1 + hstep, voffA);
            PG8_WAIT_L(8); PG8_BAR; PG8_WAIT_L(0); PG8_MMA(0, 0, At, B0); PG8_BAR; PG8_SCHED;
            PG8_LDB(B1, 0, 1); PG8_STAGE(PG8_SB(0, 0), b2, voffB);
            PG8_BAR; PG8_WAIT_L(0); PG8_MMA(0, 1, At, B1); PG8_BAR;
            PG8_LDA(At, 0, 1); PG8_STAGE(PG8_SA(0, 0), a2, voffA);
            PG8_BAR; PG8_WAIT_L(0); PG8_MMA(1, 0, At, B0); PG8_BAR; PG8_SCHED;
            PG8_STAGE(PG8_SB(0, 1), b2 + hstep, voffB);
            PG8_WAIT_V(6); PG8_BAR; PG8_MMA(1, 1, At, B1); PG8_BAR;
            PG8_LDB(B0, 1, 0); PG8_SCHED; PG8_LDA(At, 1, 0); PG8_STAGE(PG8_SA(0, 1), a2 + hstep, voffA);
            PG8_WAIT_L(8); PG8_BAR; PG8_WAIT_L(0); PG8_MMA(0, 0, At, B0); PG8_BAR; PG8_SCHED;
            PG8_LDB(B1, 1, 1); PG8_STAGE(PG8_SB(1, 0), b3, voffB);
            PG8_BAR; PG8_WAIT_L(0); PG8_MMA(0, 1, At, B1); PG8_BAR;
            PG8_LDA(At, 1, 1); PG8_STAGE(PG8_SA(1, 0), a3, voffA);
            PG8_BAR; PG8_WAIT_L(0); PG8_MMA(1, 0, At, B0); PG8_BAR; PG8_SCHED;
            PG8_STAGE(PG8_SB(1, 1), b3 + hstep, voffB);
            PG8_WAIT_V(6); PG8_BAR; PG8_MMA(1, 1, At, B1); PG8_BAR;
            }
        }
        if constexpr (ALIGN_EPI) { if (wr == 0) PG8_BAR; }
        if constexpr (!Epi::AFTER_DRAIN) { E(acc, cur, wr, wc, fr, fq); S.done(cur); }
        if (!has_next) break;
#pragma unroll
        for (int a = 0; a < 2; ++a)
#pragma unroll
            for (int b = 0; b < 2; ++b)
#pragma unroll
                for (int m = 0; m < 4; ++m)
#pragma unroll
                    for (int n = 0; n < 2; ++n) acc[a][b][m][n] = (f32x4){0.f, 0.f, 0.f, 0.f};
        cur = nxt; cA = nA; cB = nB; ++ui;
        if constexpr (ALIGN_EPI) { if (wr == 1) PG8_BAR; }
    }
    PG8_WAIT_V(0);
    if constexpr (!ALIGN_EPI) { if (wr == 0) PG8_BAR; }
    PG8_BAR;
    if constexpr (Epi::AFTER_DRAIN) { E.fused(acc, cur, wr, wc, fr, fq, lds, wid, lane); S.done(cur); }
#undef PG8_SA
#undef PG8_SB
#undef PG8_STAGE
#undef PG8_LDA
#undef PG8_LDB
#undef PG8_MMA
#undef PG8_WAIT_V
#undef PG8_WAIT_L
#undef PG8_BAR
#undef PG8_SCHED
}
}
#include <hip/hip_bf16.h>
#include <cmath>
namespace attn_body {
using bf16=__hip_bfloat16;
using bf16x8=__attribute__((ext_vector_type(8)))short;
using s16x4=__attribute__((ext_vector_type(4)))short;
using f32x16=__attribute__((ext_vector_type(16)))float;
using u32x4=__attribute__((ext_vector_type(4)))unsigned;
constexpr int SEQ=8448,D=64,DM=2560,DMO=1024;
using f32x4=__attribute__((ext_vector_type(4)))float;
constexpr int NW=8,QBLK=32,QB=QBLK*NW,KVBLK=64,NQB=SEQ/QB;
constexpr int ATTN_UNIT_ROWS=QB;
__device__ __forceinline__ int crow(int r,int hi){return (r&3)+8*(r>>2)+4*hi;}
#define SBAR() __builtin_amdgcn_sched_barrier(0)
__device__ __forceinline__ void cmask(f32x16&p0,f32x16&p1,int jb,int qrel,int hi){
  const float NEG=-INFINITY; int kb=64*jb+4*hi;
  #pragma unroll
  for(int r=0;r<16;++r){int kv=kb+(r&3)+8*(r>>2); if(kv>qrel)p0[r]=NEG; if(kv+32>qrel)p1[r]=NEG;}
}

constexpr int NSLOT=3, SLOTB=8192;
constexpr int LDS_K=0, LDS_V=NSLOT*SLOTB, LDS_WS=2*NSLOT*SLOTB, LDS_OST=LDS_WS+NW*64*4, LDS_BYTES=LDS_OST+NW*4096, LDS_CS=LDS_BYTES, LDS_FLAGS=LDS_CS+SEQ*4, LDS_END=LDS_FLAGS+256;
constexpr float C2=0.125f*1.4426950408889634f;
__device__ __forceinline__ void glds16(const void*gsrc,unsigned lds_dst){unsigned keep;
  asm volatile("s_mov_b32 %0, m0\n\ts_mov_b32 m0, %2\n\ts_nop 0\n\tglobal_load_lds_dwordx4 %1, off\n\ts_mov_b32 m0, %0":"=&s"(keep):"v"(gsrc),"s"(lds_dst):"memory");}
__device__ __forceinline__ float max3f(float a,float b,float c){float r;asm("v_max3_f32 %0, %1, %2, %3":"=v"(r):"v"(a),"v"(b),"v"(c));return r;}
__device__ __forceinline__ float max2f(float a,float b){float r;asm("v_max_f32_e32 %0, %1, %2":"=v"(r):"v"(a),"v"(b));return r;}
__device__ __forceinline__ float fadd_s(float a,float b){float r;asm("v_add_f32_e32 %0, %1, %2":"=v"(r):"v"(a),"v"(b));return r;}
__device__ __forceinline__ float fsub_s(float a,float b){float r;asm("v_sub_f32_e32 %0, %1, %2":"=v"(r):"v"(a),"v"(b));return r;}
typedef float f32x2_t __attribute__((ext_vector_type(2))); typedef __bf16 bf16x2_t __attribute__((ext_vector_type(2)));
__device__ __forceinline__ unsigned cvtpk_s(float lo,float hi){f32x2_t v={lo,hi};bf16x2_t b=__builtin_convertvector(v,bf16x2_t);return __builtin_bit_cast(unsigned,b);}
#define WAIT_BAR(N) asm volatile("s_waitcnt vmcnt(" #N ") lgkmcnt(0)\n\ts_barrier":::"memory")

__device__ __forceinline__ void qkt(f32x16&p0,f32x16&p1,const char*Kslot,const bf16x8*qr,int r32,int hi){
  const char*kb=Kslot+hi*1024+r32*16;
  #pragma unroll
  for(int d0=0;d0<4;++d0){
    const bf16x8 b0=*reinterpret_cast<const bf16x8*>(kb+d0*2048);
    const bf16x8 b1=*reinterpret_cast<const bf16x8*>(kb+d0*2048+512);
    {p0=__builtin_amdgcn_mfma_f32_32x32x16_bf16(b0,qr[d0],p0,0,0,0);p1=__builtin_amdgcn_mfma_f32_32x32x16_bf16(b1,qr[d0],p1,0,0,0);}}
}
typedef __attribute__((address_space(3))) const char* lds_cptr;
typedef short v4i16_t __attribute__((ext_vector_type(4)));
__device__ __forceinline__ void kload8(bf16x8*kf,lds_cptr kp){
  kf[0]=*(const __attribute__((address_space(3))) bf16x8*)(kp);      kf[1]=*(const __attribute__((address_space(3))) bf16x8*)(kp+512);
  kf[2]=*(const __attribute__((address_space(3))) bf16x8*)(kp+2048); kf[3]=*(const __attribute__((address_space(3))) bf16x8*)(kp+2560);
  kf[4]=*(const __attribute__((address_space(3))) bf16x8*)(kp+4096); kf[5]=*(const __attribute__((address_space(3))) bf16x8*)(kp+4608);
  kf[6]=*(const __attribute__((address_space(3))) bf16x8*)(kp+6144); kf[7]=*(const __attribute__((address_space(3))) bf16x8*)(kp+6656);
}
__device__ __forceinline__ void kload2(bf16x8*kf,lds_cptr kp,int j){ kf[2*j]=*(const __attribute__((address_space(3))) bf16x8*)(kp+j*2048); kf[2*j+1]=*(const __attribute__((address_space(3))) bf16x8*)(kp+j*2048+512); }
__device__ __forceinline__ s16x4 vtr(lds_cptr p){ return __builtin_bit_cast(s16x4,__builtin_amdgcn_ds_read_tr16_b64_v4i16((__attribute__((address_space(3))) v4i16_t*)p)); }
__device__ __forceinline__ float rowmax(const f32x16&p0,const f32x16&p1){
  float a=max3f(p0[0],p0[1],p1[0]),b=max3f(p0[2],p0[3],p1[1]);a=max3f(a,p1[2],p1[3]);
  #pragma unroll
  for(int r=4;r<16;r+=4){a=max3f(a,p0[r],p0[r+1]);b=max3f(b,p0[r+2],p0[r+3]);a=max3f(a,p1[r],p1[r+1]);b=max3f(b,p1[r+2],p1[r+3]);}
  const float m=max2f(a,b);
  auto rr=__builtin_amdgcn_permlane32_swap(__float_as_uint(m),__float_as_uint(m),false,false);
  return max2f(__uint_as_float(rr[0]),__uint_as_float(rr[1]));
}
__device__ __forceinline__ void pv(f32x16*o,int vb,bf16x8 pa0,bf16x8 pa1,bf16x8 pa2,bf16x8 pa3){
  #pragma unroll
  for(int d0=0;d0<2;++d0){s16x4 lo[4],hi[4];
    #pragma unroll
    for(int ks=0;ks<4;++ks){
      asm volatile("ds_read_b64_tr_b16 %0,%1 offset:%c2":"=&v"(lo[ks]):"v"(vb),"i"(d0*4096+ks*1024):"memory");
      asm volatile("ds_read_b64_tr_b16 %0,%1 offset:%c2":"=&v"(hi[ks]):"v"(vb),"i"(d0*4096+ks*1024+512):"memory");}
    asm volatile("s_waitcnt lgkmcnt(0)":::"memory");SBAR();
    #define PK(k) (bf16x8){lo[k][0],lo[k][1],lo[k][2],lo[k][3],hi[k][0],hi[k][1],hi[k][2],hi[k][3]}
    o[d0]=__builtin_amdgcn_mfma_f32_32x32x16_bf16(pa0,PK(0),o[d0],0,0,0);
    o[d0]=__builtin_amdgcn_mfma_f32_32x32x16_bf16(pa1,PK(1),o[d0],0,0,0);
    o[d0]=__builtin_amdgcn_mfma_f32_32x32x16_bf16(pa2,PK(2),o[d0],0,0,0);
    o[d0]=__builtin_amdgcn_mfma_f32_32x32x16_bf16(pa3,PK(3),o[d0],0,0,0);
    #undef PK
  }
}

__device__ __forceinline__ u32x4 head_rms(u32x4 v){ float x[8];
  #pragma unroll
  for(int i=0;i<4;++i){x[2*i]=__uint_as_float(v[i]<<16);x[2*i+1]=__uint_as_float(v[i]&0xffff0000u);}
  float s=0.f;
  #pragma unroll
  for(int i=0;i<8;++i)s+=x[i]*x[i];
  s+=__shfl_xor(s,1);s+=__shfl_xor(s,2);s+=__shfl_xor(s,4);
  const float rs=__builtin_amdgcn_rsqf(s*(1.0f/64.0f)+1e-6f); u32x4 w;
  #pragma unroll
  for(int i=0;i<4;++i)w[i]=cvtpk_s(x[2*i]*rs,x[2*i+1]*rs);
  return w; }
#ifndef ATTN_STORE16
#define ATTN_STORE16(p,v) (*(u32x4*)(p)=(v))
#endif
template<int THRL> __device__ __forceinline__ void fox_unit(int b,int qb,float dthr,const bf16*Q,const bf16*__restrict__ K,const bf16*__restrict__ V,bf16*O,const float*__restrict__ csg,char*shm){
  int tid_=threadIdx.x; asm volatile("":"+v"(tid_)); const int tid=tid_,lane=tid&63,r32=lane&31,hi=lane>>5; const int wid=__builtin_amdgcn_readfirstlane(tid>>6);
  const long rowbase=(long)b*SEQ; const int q0=qb*QB;
  const bf16*Qw=Q+(rowbase+q0+wid*QBLK)*DM;
  const unsigned lds0=(unsigned)(uintptr_t)shm; const lds_cptr shm3=(lds_cptr)shm;
  float*wsf=(float*)(shm+LDS_WS)+wid*64;
  const unsigned kdst=lds0+LDS_K+wid*1024, vdst=lds0+LDS_V+wid*1024;
  #define DMA_K(t,slot) glds16(ksrc+(long)(t)*KVBLK*DM,(unsigned)__builtin_amdgcn_readfirstlane(kdst+(slot)))
  #define DMA_V(t,slot) glds16(vsrc+(long)(t)*KVBLK*DM,(unsigned)__builtin_amdgcn_readfirstlane(vdst+(slot)))
  const int vb0=(int)(lds0+LDS_V)+((lane>>4)&1)*32+(lane&3)*8+(4*hi+((lane&15)>>2))*64;
  const char*Kbase=shm+LDS_K; bf16x8 kf[8];
  const lds_cptr kp0=shm3+LDS_K+hi*1024+r32*16; const lds_cptr vp0=shm3+LDS_V+((lane>>4)&1)*32+(lane&3)*8+(4*hi+((lane&15)>>2))*64;
  typedef __attribute__((address_space(3))) float lds_f32; typedef __attribute__((address_space(3))) f32x4 lds_f32x4;
  { lds_f32*cl=(lds_f32*)(shm3+LDS_CS); const int n_=q0+QB; for(int i_=tid*4;i_<n_;i_+=2048){ const f32x4 v_=*(const f32x4*)(csg+i_); *(lds_f32x4*)(cl+i_)=v_; } }
  asm volatile("s_waitcnt vmcnt(0) lgkmcnt(0)\n\ts_barrier":::"memory");
  int j0;
  { const lds_f32*cl=(const lds_f32*)(shm3+LDS_CS); const float cq0=cl[q0]; int lo_=0,hi_=4*qb;
    while(lo_<hi_){ const int mid_=(lo_+hi_)>>1; if(cl[64*mid_+63]-cq0>=dthr)lo_=mid_+1; else hi_=mid_; }
    j0=__builtin_amdgcn_readfirstlane(lo_)&~1; }
  const bf16*Kh=K+(rowbase+(long)j0*KVBLK)*DM,*Vh=V+(rowbase+(long)j0*KVBLK)*DM;
  const bf16*ksrc=Kh+(long)lane*DM+wid*8;
  const bf16*vsrc=Vh+(long)(16*(wid&3)+(lane>>2))*DM+(wid>>2)*32+(lane&3)*8;
  const int NT=(q0+QB)/KVBLK-j0;
  const lds_f32*cl3=(const lds_f32*)(shm3+LDS_CS)+64*j0;
  DMA_K(0,0);DMA_V(0,0);DMA_K(1,SLOTB);
  bf16x8 qr[4];
  #pragma unroll
  for(int d0=0;d0<4;++d0)qr[d0]=*reinterpret_cast<const bf16x8*>(&Qw[(long)r32*DM+d0*16+hi*8]);
  float base=0.f,l_reg=0.f;f32x16 o[2];o[0]=f32x16{};o[1]=f32x16{};
  #define CINIT(C0,C1,t) do{ const lds_f32*cp_=cl3+64*(t)+4*hi; \
    _Pragma("unroll") for(int g_=0;g_<4;++g_){ const f32x4 a_=*(const lds_f32x4*)(cp_+8*g_), b_=*(const lds_f32x4*)(cp_+32+8*g_); \
      C0[4*g_]=base-a_[0];C0[4*g_+1]=base-a_[1];C0[4*g_+2]=base-a_[2];C0[4*g_+3]=base-a_[3]; \
      C1[4*g_]=base-b_[0];C1[4*g_+1]=base-b_[1];C1[4*g_+2]=base-b_[2];C1[4*g_+3]=base-b_[3]; } }while(0)
  const int qrel=wid*QBLK+r32;
  #define CMASK(P0,P1,t) do{int jb_=(t)-(NT-4); if(jb_>=0)cmask(P0,P1,jb_,qrel,hi);}while(0)
  bool resc=false;
  #define START(P0,P1) do{ const float rm=rowmax(P0,P1); resc=false; \
    { const float dl=rm; base=fsub_s(base,dl); \
      _Pragma("unroll") for(int r=0;r<16;++r){P0[r]=fsub_s(P0[r],dl);P1[r]=fsub_s(P1[r],dl);} } \
    _Pragma("unroll") for(int r=0;r<16;++r)P0[r]=__builtin_amdgcn_exp2f(P0[r]); }while(0)
  #define RESC() do{ if(resc){ asm volatile("s_waitcnt lgkmcnt(0)":::"memory"); \
      _Pragma("unroll") for(int d_=0;d_<2;++d_) _Pragma("unroll") for(int r=0;r<16;++r)o[d_][r]*=wsf[crow(r,hi)]; } }while(0)
  f32x16 pA0,pA1,pB0,pB1;
  int sl_prev=0,sl_cur=0,sl_next=SLOTB;
  #define ROT() do{sl_prev=sl_cur;sl_cur=sl_next;sl_next=(sl_next==(NSLOT-1)*SLOTB)?0:sl_next+SLOTB;}while(0)
  DMA_K(2,2*SLOTB);
  WAIT_BAR(3);
  base=cl3[q0-64*j0+wid*QBLK+r32];
  CINIT(pA0,pA1,0); qkt(pA0,pA1,Kbase,qr,r32,hi);asm volatile("s_nop 15\n\ts_nop 7":"+v"(pA0),"+v"(pA1));CMASK(pA0,pA1,0);
  START(pA0,pA1);
  _Pragma("unroll") for(int r=0;r<16;++r)pA1[r]=__builtin_amdgcn_exp2f(pA1[r]);
  WAIT_BAR(0);
  DMA_K(3,0);DMA_V(1,SLOTB);
  ROT();
  kload8(kf,kp0+sl_cur);
  WAIT_BAR(2);
  s16x4 vlo[8],vhi[8]; u32x4 pw0,pw1,pw2,pw3;
  #define PKW(P,B) cvtpk_s(P[B],P[B+1])
  #define PAF(k) __builtin_bit_cast(bf16x8,pw##k)
  #define VFR(i) (bf16x8){vlo[i][0],vlo[i][1],vlo[i][2],vlo[i][3],vhi[i][0],vhi[i][1],vhi[i][2],vhi[i][3]}
  #define PIN(x) asm volatile("":"+v"(x))
  #define MX3(a,b,c) __builtin_fmaxf(__builtin_fmaxf((a),(b)),(c))
  #define GAPA(MF,A0,A1,A2,A3,W0,W1,PW) do{ MF; sacc+=A0; sacc+=A1; sacc+=A2; sacc+=A3; PIN(sacc); W0; W1; PIN(PW); SBAR(); }while(0)
  #define EX(v) __builtin_amdgcn_exp2f(v)
  #define GAPB(MF,X,B) do{ MF; X[B]=EX(X[B]); X[B+1]=EX(X[B+1]); X[B+2]=EX(X[B+2]); X[B+3]=EX(X[B+3]); PIN(X); SBAR(); }while(0)
  #define VRD(i) do{ vlo[i]=vtr(vp_+(((i)>>2)*4096+((i)&3)*1024)); vhi[i]=vtr(vp_+(((i)>>2)*4096+((i)&3)*1024+512)); }while(0)
  #define KRD(G,j) do{ if(G){ kload2(kf,kp0+sl_next,j); SBAR(); } }while(0)
  #define STEP(C0,C1,P0,P1,t,GK,GV,GL) do{ SBAR(); CINIT(C0,C1,t); SBAR(); \
    const lds_cptr vp_=vp0+sl_prev; \
    VRD(0); SBAR(); float sacc=(P0[0]+P0[1]); \
    GAPA(C0=__builtin_amdgcn_mfma_f32_32x32x16_bf16(kf[0],qr[0],C0,0,0,0), P0[2],P0[3],P0[4],P0[5],     pw0[0]=PKW(P0,0), pw0[1]=PKW(P0,2), pw0); \
    VRD(4); SBAR(); GAPA(C1=__builtin_amdgcn_mfma_f32_32x32x16_bf16(kf[1],qr[0],C1,0,0,0), P0[6],P0[7],P0[8],P0[9],     pw0[2]=PKW(P0,4), pw0[3]=PKW(P0,6), pw0); \
    VRD(1); SBAR(); GAPA(C0=__builtin_amdgcn_mfma_f32_32x32x16_bf16(kf[2],qr[1],C0,0,0,0),   P0[10],P0[11],P0[12],P0[13], pw1[0]=PKW(P0,8), pw1[1]=PKW(P0,10), pw1); \
    VRD(5); SBAR(); GAPA(C1=__builtin_amdgcn_mfma_f32_32x32x16_bf16(kf[3],qr[1],C1,0,0,0),   P0[14],P0[15],P1[0],P1[1],   pw1[2]=PKW(P0,12),pw1[3]=PKW(P0,14), pw1); \
    VRD(2); SBAR(); GAPA(C0=__builtin_amdgcn_mfma_f32_32x32x16_bf16(kf[4],qr[2],C0,0,0,0),   P1[2],P1[3],P1[4],P1[5],     pw2[0]=PKW(P1,0), pw2[1]=PKW(P1,2), pw2); \
    VRD(6); SBAR(); GAPA(C1=__builtin_amdgcn_mfma_f32_32x32x16_bf16(kf[5],qr[2],C1,0,0,0),   P1[6],P1[7],P1[8],P1[9],     pw2[2]=PKW(P1,4), pw2[3]=PKW(P1,6), pw2); \
    VRD(3); SBAR(); GAPA(C0=__builtin_amdgcn_mfma_f32_32x32x16_bf16(kf[6],qr[3],C0,0,0,0),   P1[10],P1[11],P1[12],P1[13], pw3[0]=PKW(P1,8), pw3[1]=PKW(P1,10), pw3); \
    VRD(7); SBAR(); GAPA(C1=__builtin_amdgcn_mfma_f32_32x32x16_bf16(kf[7],qr[3],C1,0,0,0),   P1[14],P1[15],0.f,0.f,       pw3[2]=PKW(P1,12),pw3[3]=PKW(P1,14), pw3); \
    l_reg+=sacc; \
    if(GK){DMA_K((t)+3,sl_cur);} if(GV){DMA_V((t)+1,sl_next);} \
    CMASK(C0,C1,t); \
    { float a=MX3(C0[0],C0[1],C1[0]),b=MX3(C0[2],C0[3],C1[1]); a=MX3(a,C1[2],C1[3]); \
      _Pragma("unroll") for(int r=4;r<16;r+=4){a=MX3(a,C0[r],C0[r+1]);b=MX3(b,C0[r+2],C0[r+3]);a=MX3(a,C1[r],C1[r+1]);b=MX3(b,C1[r+2],C1[r+3]);} \
      float rm=__builtin_fmaxf(a,b); { auto rr=__builtin_amdgcn_permlane32_swap(__float_as_uint(rm),__float_as_uint(rm),false,false); rm=__builtin_fmaxf(__uint_as_float(rr[0]),__uint_as_float(rr[1])); } \
      resc=false; \
      if(__builtin_expect(__any(rm>(float)THRL),0)){ const float dl=__builtin_fmaxf(rm,0.f); base-=dl; \
        _Pragma("unroll") for(int r=0;r<16;++r){C0[r]-=dl;C1[r]-=dl;} \
        const float f=__builtin_amdgcn_exp2f(-dl); l_reg*=f; if(hi==0)wsf[r32]=f; resc=true; } } \
    SBAR(); \
    GAPB(o[0]=__builtin_amdgcn_mfma_f32_32x32x16_bf16(PAF(0),VFR(0),o[0],0,0,0), C0,0); \
    GAPB(o[1]=__builtin_amdgcn_mfma_f32_32x32x16_bf16(PAF(0),VFR(4),o[1],0,0,0), C0,4); \
    KRD(GL,0); GAPB(o[0]=__builtin_amdgcn_mfma_f32_32x32x16_bf16(PAF(1),VFR(1),o[0],0,0,0), C0,8); \
    KRD(GL,1); GAPB(o[1]=__builtin_amdgcn_mfma_f32_32x32x16_bf16(PAF(1),VFR(5),o[1],0,0,0), C0,12); \
    KRD(GL,2); GAPB(o[0]=__builtin_amdgcn_mfma_f32_32x32x16_bf16(PAF(2),VFR(2),o[0],0,0,0), C1,0); \
    KRD(GL,3); GAPB(o[1]=__builtin_amdgcn_mfma_f32_32x32x16_bf16(PAF(2),VFR(6),o[1],0,0,0), C1,4); \
    GAPB(o[0]=__builtin_amdgcn_mfma_f32_32x32x16_bf16(PAF(3),VFR(3),o[0],0,0,0), C1,8); \
    GAPB(o[1]=__builtin_amdgcn_mfma_f32_32x32x16_bf16(PAF(3),VFR(7),o[1],0,0,0), C1,12); \
    }while(0)
  int t=1;
  #undef CMASK
  #define CMASK(P0,P1,t) do{}while(0)
  for(;t+5<NT;t+=2){
    STEP(pB0,pB1,pA0,pA1,t,true,true,true);     WAIT_BAR(2); RESC(); ROT();
    STEP(pA0,pA1,pB0,pB1,t+1,true,true,true);   WAIT_BAR(2); RESC(); ROT();
  }
  #undef CMASK
  #define CMASK(P0,P1,t) do{int jb_=(t)-(NT-4); if(jb_>=0)cmask(P0,P1,jb_,qrel,hi);}while(0)
  #define ENDW(tt) do{ if((tt)+3<NT){WAIT_BAR(2);} else if((tt)+2<NT){WAIT_BAR(1);} else {WAIT_BAR(0);} }while(0)
  for(;t+1<NT;t+=2){
    STEP(pB0,pB1,pA0,pA1,t,(t+3<NT),(t+1<NT),(t+1<NT));       ENDW(t);   RESC(); ROT();
    STEP(pA0,pA1,pB0,pB1,t+1,(t+4<NT),(t+2<NT),(t+2<NT));     ENDW(t+1); RESC(); ROT();
  }
  STEP(pB0,pB1,pA0,pA1,NT-1,false,false,false); RESC();
  { float sacc=pB0[0]+pB0[1]; _Pragma("unroll") for(int r=2;r<16;++r)sacc+=pB0[r]; _Pragma("unroll") for(int r=0;r<16;++r)sacc+=pB1[r]; l_reg+=sacc;
    pw0=(u32x4){PKW(pB0,0),PKW(pB0,2),PKW(pB0,4),PKW(pB0,6)};pw1=(u32x4){PKW(pB0,8),PKW(pB0,10),PKW(pB0,12),PKW(pB0,14)};pw2=(u32x4){PKW(pB1,0),PKW(pB1,2),PKW(pB1,4),PKW(pB1,6)};pw3=(u32x4){PKW(pB1,8),PKW(pB1,10),PKW(pB1,12),PKW(pB1,14)};
    SBAR(); pv(o,vb0+sl_cur,PAF(0),PAF(1),PAF(2),PAF(3)); }
  #undef PKW
  #undef PAF
  #undef VFR
  #undef PIN
  #undef MX3
  #undef GAPA
  #undef GAPB
  #undef EX
  #undef VRD
  #undef KRD
  #undef STEP
  #undef ENDW
  {auto rr=__builtin_amdgcn_permlane32_swap(__float_as_uint(l_reg),__float_as_uint(l_reg),false,false);l_reg=__uint_as_float(rr[0])+__uint_as_float(rr[1]);}
  if(hi==0)wsf[32+r32]=l_reg;asm volatile("s_waitcnt lgkmcnt(0)":::"memory");
  float rli[16];
  #pragma unroll
  for(int r=0;r<16;++r)rli[r]=__builtin_amdgcn_rcpf(wsf[32+crow(r,hi)]);
  bf16*Ow=O+(rowbase+q0+wid*QBLK)*DMO;
  { bf16*stg=(bf16*)(shm+LDS_OST)+wid*2048;
    #pragma unroll
    for(int r=0;r<16;++r){const int orow=crow(r,hi);
      #pragma unroll
      for(int d0=0;d0<2;++d0)stg[orow*64+d0*32+r32]=__float2bfloat16(o[d0][r]*rli[r]);}
    asm volatile("s_waitcnt lgkmcnt(0)":::"memory");
    #pragma unroll
    for(int i=0;i<4;++i){const int row=i*8+(lane>>3),ch=lane&7; const u32x4 v=*(const u32x4*)(stg+row*64+ch*8); ATTN_STORE16(Ow+(long)row*DMO+ch*8,head_rms(v));} }
  asm volatile("s_waitcnt lgkmcnt(0)\n\ts_barrier":::"memory");
  #undef DMA_K
  #undef DMA_V
  #undef CMASK
  #undef CINIT
  #undef START
  #undef RESC
  #undef ROT
}
__device__ __forceinline__ float sp2f(float z){ const float e=__builtin_amdgcn_exp2f(-__builtin_fabsf(z)); return __builtin_fmaxf(z,0.f)+__builtin_amdgcn_logf(1.f+e); }
__device__ __forceinline__ void sb_tile(f32x16*o,float&R,const char*Kslot,int vb,const bf16x8*qr,int j,int qabs,bool unmasked,int r32,int hi){
  f32x16 p0=f32x16{},p1=f32x16{};
  qkt(p0,p1,Kslot,qr,r32,hi);
  const int kvb=64*j+4*hi; f32x16 s0,s1;
  if(unmasked){
    #pragma unroll
    for(int r=0;r<16;++r){
      const float e0=__builtin_amdgcn_exp2f(__builtin_fminf(p0[r],80.f)), e1=__builtin_amdgcn_exp2f(__builtin_fminf(p1[r],80.f));
      const float r0=__builtin_amdgcn_rcpf(1.f+e0), r1=__builtin_amdgcn_rcpf(1.f+e1);
      p0[r]=e0*r0; p1[r]=e1*r1; s0[r]=r0; s1[r]=r1; }
  } else {
    #pragma unroll
    for(int r=0;r<16;++r){ const int kv=kvb+(r&3)+8*(r>>2);
      const float e0=__builtin_amdgcn_exp2f(__builtin_fminf(p0[r],80.f)), e1=__builtin_amdgcn_exp2f(__builtin_fminf(p1[r],80.f));
      const float r0=__builtin_amdgcn_rcpf(1.f+e0), r1=__builtin_amdgcn_rcpf(1.f+e1);
      const bool v0=kv<qabs, v1=kv+32<qabs;
      p0[r]=v0?e0*r0:0.f; p1[r]=v1?e1*r1:0.f; s0[r]=v0?r0:1.f; s1[r]=v1?r1:1.f; }
  }
  float g0[4],g1[4],og0[4],og1[4],T0[4],T1[4];
  #pragma unroll
  for(int g=0;g<4;++g){ g0[g]=(s0[4*g]*s0[4*g+1])*(s0[4*g+2]*s0[4*g+3]); g1[g]=(s1[4*g]*s1[4*g+1])*(s1[4*g+2]*s1[4*g+3]); }
  #pragma unroll
  for(int g=0;g<4;++g){ og0[g]=__shfl_xor(g0[g],32); og1[g]=__shfl_xor(g1[g],32); }
  float run=R;
  #pragma unroll
  for(int g=3;g>=0;--g){ const float ah1=hi?g1[g]:og1[g], ah0=hi?og1[g]:g1[g]; const float t1=run; run*=ah1; const float t0=run; run*=ah0; T1[g]=hi?t1:t0; }
  #pragma unroll
  for(int g=3;g>=0;--g){ const float ah1=hi?g0[g]:og0[g], ah0=hi?og0[g]:g0[g]; const float t1=run; run*=ah1; const float t0=run; run*=ah0; T0[g]=hi?t1:t0; }
  R=run;
  #pragma unroll
  for(int g=0;g<4;++g){ float a0=T0[g],a1=T1[g];
    #pragma unroll
    for(int i=3;i>=0;--i){ const int r=4*g+i; p0[r]*=a0; p1[r]*=a1; a0*=s0[r]; a1*=s1[r]; } }
  u32x4 pw0,pw1,pw2,pw3;
  pw0=(u32x4){cvtpk_s(p0[0],p0[1]),cvtpk_s(p0[2],p0[3]),cvtpk_s(p0[4],p0[5]),cvtpk_s(p0[6],p0[7])};
  pw1=(u32x4){cvtpk_s(p0[8],p0[9]),cvtpk_s(p0[10],p0[11]),cvtpk_s(p0[12],p0[13]),cvtpk_s(p0[14],p0[15])};
  pw2=(u32x4){cvtpk_s(p1[0],p1[1]),cvtpk_s(p1[2],p1[3]),cvtpk_s(p1[4],p1[5]),cvtpk_s(p1[6],p1[7])};
  pw3=(u32x4){cvtpk_s(p1[8],p1[9]),cvtpk_s(p1[10],p1[11]),cvtpk_s(p1[12],p1[13]),cvtpk_s(p1[14],p1[15])};
  pv(o,vb,__builtin_bit_cast(bf16x8,pw0),__builtin_bit_cast(bf16x8,pw1),__builtin_bit_cast(bf16x8,pw2),__builtin_bit_cast(bf16x8,pw3));
}
__device__ __forceinline__ void sb_unit(int b,int qb,const bf16*Q,const bf16*__restrict__ K,const bf16*__restrict__ V,bf16*O,char*shm){
  int tid_=threadIdx.x; asm volatile("":"+v"(tid_)); const int tid=tid_,lane=tid&63,r32=lane&31,hi=lane>>5; const int wid=__builtin_amdgcn_readfirstlane(tid>>6);
  const long rowbase=(long)b*SEQ; const int q0=qb*QB;
  const bf16*Qw=Q+(rowbase+q0+wid*QBLK)*DM;
  const bf16*Kh=K+rowbase*DM,*Vh=V+rowbase*DM;
  const unsigned lds0=(unsigned)(uintptr_t)shm; const lds_cptr shm3=(lds_cptr)shm;
  const bf16*ksrc=Kh+(long)lane*DM+wid*8;
  const bf16*vsrc=Vh+(long)(16*(wid&3)+(lane>>2))*DM+(wid>>2)*32+(lane&3)*8;
  const unsigned kdst=lds0+LDS_K+wid*1024, vdst=lds0+LDS_V+wid*1024;
  constexpr int FASTV=65536;
  const unsigned kdstF=lds0+wid*1024, vdstF=lds0+FASTV+wid*1024;
  #define DMA_K(t,slot) glds16(ksrc+(long)(t)*KVBLK*DM,(unsigned)__builtin_amdgcn_readfirstlane(kdst+(slot)))
  #define DMA_V(t,slot) glds16(vsrc+(long)(t)*KVBLK*DM,(unsigned)__builtin_amdgcn_readfirstlane(vdst+(slot)))
  const int vlane=((lane>>4)&1)*32+(lane&3)*8+(4*hi+((lane&15)>>2))*64;
  const int vb0=(int)(lds0+LDS_V)+vlane, vbF=(int)(lds0+FASTV)+vlane;
  typedef __attribute__((address_space(3))) unsigned lds_u32;
  volatile lds_u32*flags=(volatile lds_u32*)(shm3+131072+1024)    ;
  bf16x8 qr[4];
  #pragma unroll
  for(int d0=0;d0<4;++d0)qr[d0]=*reinterpret_cast<const bf16x8*>(&Qw[(long)r32*DM+d0*16+hi*8]);
  asm volatile("":::"memory");
  f32x16 o[2];o[0]=f32x16{};o[1]=f32x16{};
  float R=1.f; const int qabs=q0+wid*QBLK+r32; bool done=false;
#ifndef SB_FAST_TILES
#define SB_FAST_TILES 8
#endif
  static_assert(SB_FAST_TILES>=4&&SB_FAST_TILES<=8,"the fallback assumes every tile it visits lies wholly below the unit's rows (>= 4 staged tiles); 8 tiles fill the 128 KiB");
  const int jtop=4*qb+3, jlow=(jtop-(SB_FAST_TILES-1)>0)?jtop-(SB_FAST_TILES-1):0;
  for(int i=0;i<=jtop-jlow;++i){ glds16(ksrc+(long)(jtop-i)*KVBLK*DM,(unsigned)__builtin_amdgcn_readfirstlane(kdstF+i*SLOTB)); glds16(vsrc+(long)(jtop-i)*KVBLK*DM,(unsigned)__builtin_amdgcn_readfirstlane(vdstF+i*SLOTB)); }
  WAIT_BAR(0);
  for(int j=(q0+wid*QBLK+30)>>6;j>=jlow&&!done;--j){ const int i=jtop-j;
    sb_tile(o,R,shm+i*SLOTB,vbF+i*SLOTB,qr,j,qabs,64*j+63<q0+wid*QBLK,r32,hi);
    done=__all(R<1.0e-37f)!=0; }
  if(lane==0)flags[16+wid]=(done||jlow==0)?1u:0u;
  asm volatile("s_waitcnt lgkmcnt(0)\n\ts_barrier":::"memory");
  unsigned fin=1u;
  #pragma unroll
  for(int w=0;w<NW;++w)fin&=flags[16+w];
  if(!fin){
    const int js=jlow-1;
    DMA_K(js,0);DMA_V(js,0); if(js>=1){ DMA_K(js-1,SLOTB);DMA_V(js-1,SLOTB); }
    int slot=0,slot2=2*SLOTB,bank=0;
    for(int j=js;j>=0;--j){
      if(j>0){ WAIT_BAR(2); } else { WAIT_BAR(0); }
      if(j<js){ unsigned alld=1u;
        #pragma unroll
        for(int w=0;w<NW;++w)alld&=flags[(bank^8)+w];
        if(alld)break; }
      if(j>=2){ DMA_K(j-2,slot2);DMA_V(j-2,slot2); }
      if(!done){ sb_tile(o,R,shm+LDS_K+slot,vb0+slot,qr,j,qabs,true,r32,hi); done=__all(R<1.0e-37f)!=0; }
      if(lane==0)flags[bank+wid]=done?1u:0u;
      bank^=8; slot=(slot==2*SLOTB)?0:slot+SLOTB; slot2=(slot2==2*SLOTB)?0:slot2+SLOTB;
    }
    asm volatile("s_waitcnt vmcnt(0)":::"memory");
  }
  bf16*Ow=O+(rowbase+q0+wid*QBLK)*DMO;
  { bf16*stg=(bf16*)(shm+LDS_OST)+wid*2048;
    #pragma unroll
    for(int r=0;r<16;++r){const int orow=crow(r,hi);
      #pragma unroll
      for(int d0=0;d0<2;++d0)stg[orow*64+d0*32+r32]=__float2bfloat16(o[d0][r]);}
    asm volatile("s_waitcnt lgkmcnt(0)":::"memory");
    #pragma unroll
    for(int i=0;i<4;++i){const int row=i*8+(lane>>3),ch=lane&7; const u32x4 v=*(const u32x4*)(stg+row*64+ch*8); ATTN_STORE16(Ow+(long)row*DMO+ch*8,head_rms(v));} }
  asm volatile("s_waitcnt vmcnt(0) lgkmcnt(0)\n\ts_barrier":::"memory");
  #undef DMA_K
  #undef DMA_V
}
#undef SBAR
#undef WAIT_BAR
}
namespace cg = cooperative_groups;
constexpr int NWAVES = 8;
constexpr int DMODEL = 1024, NBATCH = 4, SEQ_IN = 8192, NMETA = 16, LREAL = NMETA + SEQ_IN, LP = 8448  ;
constexpr int MROWS = NBATCH * LP;
constexpr int MREAL = NBATCH * SEQ_IN;
constexpr int INW = 2566, NINP = 2560, NIN = 2816, DFF = 2816, NGU = 2 * DFF, DEPTH = 2, NFH = 6;
constexpr float C2F = 0.125f * 1.4426950408889634f;
constexpr int PC_U = 0, PC_FQ = 256, PC_FK = 640, PC_FV = 1024, PC_SQ = 1408, PC_SK = 1792, PC_SV = 2176;
constexpr size_t MiB = 1u << 20;
constexpr size_t WS_CTL = 0, CTL_ZERO_BYTES = 1 * MiB;
constexpr size_t WS_SS = 64 * 1024;
constexpr size_t WS_W = 1 * MiB, W_LAYER = 24 * MiB, W_IN = 0, W_OUT = (size_t)NIN * 1024 * 2, W_GU = W_OUT + 2 * MiB, W_D = W_GU + (size_t)NGU * 1024 * 2;
constexpr size_t WS_LF = 49 * MiB, WS_CS = 51 * MiB, WS_H = 52 * MiB, WS_HB = 184 * MiB, WS_Y = 250 * MiB, WS_P = 316 * MiB, WS_END = WS_P + (size_t)MROWS * DFF * 2;
static_assert(W_D + (size_t)1024 * DFF * 2 <= W_LAYER && WS_W + 2 * W_LAYER <= WS_LF && WS_SS + 5 * (size_t)MROWS * 4 <= CTL_ZERO_BYTES, "ws map");
static_assert(WS_H + (size_t)MROWS * 1024 * 4 <= WS_HB && WS_HB + (size_t)MROWS * 1024 * 2 <= WS_Y && WS_Y + (size_t)MROWS * 1024 * 2 <= WS_P && WS_END <= 512 * MiB, "ws map");
constexpr int LDS_BYTES = 147456;
constexpr int LDS_MISC = 131072;

#define LAS __attribute__((address_space(3)))
typedef unsigned short bf16u;
typedef unsigned v4u __attribute__((ext_vector_type(4)));
typedef float f32x4 __attribute__((ext_vector_type(4)));
#define LDS_WAIT() asm volatile("s_waitcnt lgkmcnt(0)" ::: "memory")
__device__ __forceinline__ unsigned f2bf(float f) { unsigned u = __builtin_bit_cast(unsigned, f); return (u + 0x7fffu + ((u >> 16) & 1u)) >> 16; }
__device__ __forceinline__ unsigned pk2(float lo, float hi) { return f2bf(lo) | (f2bf(hi) << 16); }
__device__ __forceinline__ float wave_sum(float v) {
#pragma unroll
    for (int o = 1; o < 64; o <<= 1) v += __shfl_xor(v, o);
    return v;
}

struct Args { const float* in[15]; float* out; unsigned char* ws; };

struct WinSrc { const float* w; const float* g;
    __device__ __forceinline__ float operator()(int k, int n) const { if (n >= INW) return 0.f; const int col = n < 1408 ? n : (n < 2560 ? n + 6 : n - 2560 + 1408);
        const float sc = ((n >= PC_FQ && n < PC_FK) || (n >= PC_SQ && n < PC_SK)) ? C2F : 1.0f; return w[(size_t)k * INW + col] * g[k] * sc; } };
struct WoutSrc { const float* w; const float* fg; const float* sg;
    __device__ __forceinline__ float operator()(int k, int n) const { const float gn = k < 640 ? fg[k - 256] : sg[k - 640]; return w[(size_t)k * 1024 + n] * gn; } };
struct WguSrc { const float* wg; const float* wu; const float* g;
    __device__ __forceinline__ float operator()(int k, int c) const { const int pn = c >> 8, w = c & 255, j = pn * 128 + (w & 127); const long dlt = (w >> 7) ? (long)(wu - wg) : 0L; return wg[(long)k * DFF + j + dlt] * g[k]; } };
struct WdSrc { const float* w;
    __device__ __forceinline__ float operator()(int k, int n) const { return w[(size_t)k * 1024 + n]; } };
template <class F> __device__ __forceinline__ void conv_item(const F src, bf16u* WT, int K, int k0, int n0, LAS float* scr, int lane) {
    float tv[32];
#pragma unroll
    for (int i = 0; i < 32; ++i) tv[i] = src(k0 + 2 * i + (lane >> 5), n0 + (lane & 31));
#pragma unroll
    for (int i = 0; i < 32; ++i) scr[(2 * i + (lane >> 5)) * 33 + (lane & 31)] = tv[i];
    LDS_WAIT(); asm volatile("" ::: "memory");
    const int c = lane & 7;
#pragma unroll
    for (int j = 0; j < 4; ++j) { const int n = (lane >> 3) + 8 * j; const LAS float* s = scr + (8 * c) * 33 + n;
        v4u o; o.x = pk2(s[0 * 33], s[1 * 33]); o.y = pk2(s[2 * 33], s[3 * 33]); o.z = pk2(s[4 * 33], s[5 * 33]); o.w = pk2(s[6 * 33], s[7 * 33]);
        *(v4u*)(WT + (size_t)(n0 + n) * K + k0 + 8 * c) = o; }
    LDS_WAIT(); asm volatile("" ::: "memory");
}
__device__ __forceinline__ void fold_block_item(const float* wout, const float* pw, const float* ps, bf16u* WT, int item, LAS float* lds, int tid) {
    const int g = item >> 4, n0 = (item & 15) * 64;
    LAS float* At = lds; LAS float* Wt = lds + 4096;
    for (int i = tid; i < 4096; i += NWAVES * 64) { At[(i & 63) * 64 + (i >> 6)] = pw[(size_t)g * 4096 + i]; const int d = i >> 6; Wt[i] = wout[(size_t)(g * 64 + d) * 1024 + n0 + (i & 63)] * ps[g * 64 + d]; }
    __syncthreads();
    const int c0 = (tid >> 6) * 8, nn = tid & 63; f32x4 a0 = (f32x4){0.f, 0.f, 0.f, 0.f}, a1 = a0;
#pragma unroll 8
    for (int d = 0; d < 64; ++d) { const float w = Wt[d * 64 + nn]; a0 += *(const LAS f32x4*)(At + d * 64 + c0) * w; a1 += *(const LAS f32x4*)(At + d * 64 + c0 + 4) * w; }
    v4u o; o.x = pk2(a0[0], a0[1]); o.y = pk2(a0[2], a0[3]); o.z = pk2(a1[0], a1[1]); o.w = pk2(a1[2], a1[3]);
    *(v4u*)(WT + (size_t)(n0 + nn) * 1024 + g * 64 + c0) = o;
    __syncthreads();
}
__device__ __forceinline__ void p0_prologue(const Args& A, unsigned char* ws, LAS unsigned char* lds, int wave, int lane) {
    LAS float* scr = (LAS float*)(lds + wave * 16384);
    const int gw = blockIdx.x * NWAVES + wave, NGW = gridDim.x * NWAVES;
    constexpr int I_IN = 16 * (NIN / 32), I_OUT = 12 * 32, I_GU = 16 * (NGU / 32), I_D = (DFF / 64) * 32, I_L = I_IN + I_OUT + I_GU + I_D;
    for (int bi = blockIdx.x; bi < DEPTH * 64; bi += gridDim.x) { const int L = bi >> 6;
        fold_block_item(A.in[9] + (size_t)L * 1024 * 1024, A.in[5] + (size_t)L * 4 * 64 * 64, A.in[6] + L * 256, (bf16u*)(ws + WS_W + (size_t)L * W_LAYER + W_OUT), bi & 63, (LAS float*)lds, wave * 64 + lane); }
    for (int it = gw; it < DEPTH * I_L; it += NGW) {
        const int L = it / I_L; int r = it % I_L;
        bf16u* wb = (bf16u*)(ws + WS_W + (size_t)L * W_LAYER);
        if (r < I_IN) { WinSrc s{A.in[3] + (size_t)L * 1024 * INW, A.in[2] + L * 1024}; conv_item(s, (bf16u*)((unsigned char*)wb + W_IN), 1024, (r / (NIN / 32)) * 64, (r % (NIN / 32)) * 32, scr, lane); continue; } r -= I_IN;
        if (r < I_OUT) { WoutSrc s{A.in[9] + (size_t)L * 1024 * 1024, A.in[7] + L * 384, A.in[8] + L * 384}; conv_item(s, (bf16u*)((unsigned char*)wb + W_OUT), 1024, 256 + (r / 32) * 64, (r % 32) * 32, scr, lane); continue; } r -= I_OUT;
        if (r < I_GU) { WguSrc s{A.in[11] + (size_t)L * 1024 * DFF, A.in[12] + (size_t)L * 1024 * DFF, A.in[10] + L * 1024}; conv_item(s, (bf16u*)((unsigned char*)wb + W_GU), 1024, (r / (NGU / 32)) * 64, (r % (NGU / 32)) * 32, scr, lane); continue; } r -= I_GU;
        { WdSrc s{A.in[13] + (size_t)L * DFF * 1024}; conv_item(s, (bf16u*)((unsigned char*)wb + W_D), DFF, (r / 32) * 64, (r % 32) * 32, scr, lane); }
    }
    bf16u* hb = (bf16u*)(ws + WS_HB); float* ss0 = (float*)(ws + WS_SS);
    for (int m0 = gw * 4; m0 < MROWS; m0 += NGW * 4) {
        f32x4 v[4][4]; float s[4];
#pragma unroll
        for (int q = 0; q < 4; ++q) { const int m = m0 + q, b = m / LP, t = m % LP; s[q] = 0.f;
            if (t < LREAL) { const f32x4* src = (const f32x4*)(t < NMETA ? A.in[1] + (size_t)t * 1024 : A.in[0] + ((size_t)b * SEQ_IN + (t - NMETA)) * 1024) + lane;
#pragma unroll
                for (int j = 0; j < 4; ++j) v[q][j] = src[64 * j]; }
            else {
#pragma unroll
                for (int j = 0; j < 4; ++j) v[q][j] = (f32x4){0.f, 0.f, 0.f, 0.f}; } }
#pragma unroll
        for (int q = 0; q < 4; ++q) { const int m = m0 + q;
#pragma unroll
            for (int j = 0; j < 4; ++j) s[q] += (v[q][j].x * v[q][j].x + v[q][j].y * v[q][j].y) + (v[q][j].z * v[q][j].z + v[q][j].w * v[q][j].w);
            s[q] = wave_sum(s[q]);
            unsigned long long* bo = (unsigned long long*)(hb + (size_t)m * 1024) + lane;
#pragma unroll
            for (int j = 0; j < 4; ++j) bo[64 * j] = (unsigned long long)pk2(v[q][j].x, v[q][j].y) | ((unsigned long long)pk2(v[q][j].z, v[q][j].w) << 32);
            if (lane == 0) ss0[m] = s[q]; }
    }
}
typedef short bf16x8m __attribute__((ext_vector_type(8)));
template <int NBK> __device__ __forceinline__ void mini_item(f32x4 (&acc)[NBK], const bf16u* A16, const bf16u* Bt0, const bf16u* Bt1, int K, LAS unsigned char* lds, int wave, int lane) {
    const int fr = lane & 15, fq = lane >> 4, kw = K >> 3; const size_t o = (size_t)fr * K + wave * kw + 8 * fq;
#pragma unroll
    for (int nb = 0; nb < NBK; ++nb) acc[nb] = (f32x4){0.f, 0.f, 0.f, 0.f};
    for (int k = 0; k < kw; k += 32) { const bf16x8m a = *(const bf16x8m*)(A16 + o + k); const bf16x8m b0 = *(const bf16x8m*)(Bt0 + o + k);
        acc[0] = __builtin_amdgcn_mfma_f32_16x16x32_bf16(b0, a, acc[0], 0, 0, 0);
        if (NBK == 2) { const bf16x8m b1 = *(const bf16x8m*)(Bt1 + o + k); acc[NBK - 1] = __builtin_amdgcn_mfma_f32_16x16x32_bf16(b1, a, acc[NBK - 1], 0, 0, 0); } }
    LAS f32x4* red = (LAS f32x4*)lds;
#pragma unroll
    for (int nb = 0; nb < NBK; ++nb) red[(nb * 8 + wave) * 64 + lane] = acc[nb];
    __syncthreads();
    if (wave == 0) {
#pragma unroll
        for (int nb = 0; nb < NBK; ++nb) { f32x4 s = red[(nb * 8) * 64 + lane];
#pragma unroll
            for (int w = 1; w < 8; ++w) s += red[(nb * 8 + w) * 64 + lane];
            acc[nb] = s; } }
    __syncthreads();
}
__device__ __forceinline__ void mini_in(unsigned char* ws, const bf16u* wt, const float* ss, const float* fb, LAS unsigned char* lds, int wave, int lane) {
    const bf16u* A16 = (const bf16u*)(ws + WS_HB); bf16u* P = (bf16u*)(ws + WS_P); float* LF = (float*)(ws + WS_LF);
    for (int it = blockIdx.x; it < 161; it += gridDim.x) { const int n0 = it * 16; f32x4 acc[1];
        mini_item<1>(acc, A16, wt + (size_t)n0 * 1024, nullptr, 1024, lds, wave, lane);
        if (wave == 0) { const int fr = lane & 15, fq = lane >> 4; const float rs = __builtin_amdgcn_rsqf(ss[fr] * (1.0f / 1024.0f) + 1e-6f); const f32x4 v = acc[0] * rs;
            if (n0 < NINP) { const unsigned long long w = (unsigned long long)pk2(v[0], v[1]) | ((unsigned long long)pk2(v[2], v[3]) << 32);
#pragma unroll
                for (int b = 0; b < NBATCH; ++b) *(unsigned long long*)(P + ((size_t)b * LP + fr) * NINP + n0 + 4 * fq) = w; }
            else if (fq < 2) { f32x4 l;
#pragma unroll
                for (int i = 0; i < 4; ++i) { const int c = 4 * fq + i; const float x = v[i] + fb[c < NFH ? c : 0]; l[i] = c < NFH ? -(fmaxf(-x, 0.f) + log1pf(expf(-fabsf(x)))) * 1.4426950408889634f : 0.f; }
#pragma unroll
                for (int b = 0; b < NBATCH; ++b) *(f32x4*)(LF + ((size_t)b * LP + fr) * 8 + 4 * fq) = l; } }
    }
}
__device__ __forceinline__ void mini_res(unsigned char* ws, const bf16u* A16, const bf16u* wt, int K, float* ssn, LAS unsigned char* lds, int wave, int lane) {
    bf16u* hb = (bf16u*)(ws + WS_HB);
    for (int it = blockIdx.x; it < 64; it += gridDim.x) { const int n0 = it * 16; f32x4 acc[1];
        mini_item<1>(acc, A16, wt + (size_t)n0 * K, nullptr, K, lds, wave, lane);
        if (wave == 0) { const int fr = lane & 15, fq = lane >> 4; unsigned long long* bp = (unsigned long long*)(hb + (size_t)fr * 1024 + n0 + 4 * fq); const unsigned long long r = *bp; const unsigned rl = (unsigned)r, rh = (unsigned)(r >> 32);
            const f32x4 a = (f32x4){__uint_as_float(rl << 16), __uint_as_float(rl & 0xffff0000u), __uint_as_float(rh << 16), __uint_as_float(rh & 0xffff0000u)} + acc[0];
            *bp = (unsigned long long)pk2(a[0], a[1]) | ((unsigned long long)pk2(a[2], a[3]) << 32);
            float s = (a[0] * a[0] + a[1] * a[1]) + (a[2] * a[2] + a[3] * a[3]); s += __shfl_xor(s, 16); s += __shfl_xor(s, 32);
            if (fq == 0) atomicAdd(ssn + fr, s); }
    }
}
__device__ __forceinline__ void mini_gu(unsigned char* ws, const bf16u* wt, const float* ss, LAS unsigned char* lds, int wave, int lane) {
    const bf16u* A16 = (const bf16u*)(ws + WS_HB); bf16u* H = (bf16u*)(ws + WS_P);
    for (int it = blockIdx.x; it < DFF / 16; it += gridDim.x) { const int j0 = it * 16, cg = (j0 >> 7) * 256 + (j0 & 127); f32x4 acc[2];
        mini_item<2>(acc, A16, wt + (size_t)cg * 1024, wt + (size_t)(cg + 128) * 1024, 1024, lds, wave, lane);
        if (wave == 0) { const int fr = lane & 15, fq = lane >> 4; const float rs = __builtin_amdgcn_rsqf(ss[fr] * (1.0f / 1024.0f) + 1e-6f); float o[4];
#pragma unroll
            for (int i = 0; i < 4; ++i) { const float g = acc[0][i] * rs, up = acc[1][i] * rs; o[i] = g * __builtin_amdgcn_rcpf(1.0f + __builtin_amdgcn_exp2f(-1.4426950408889634f * g)) * up; }
            *(unsigned long long*)(H + (size_t)fr * DFF + j0 + 4 * fq) = (unsigned long long)pk2(o[0], o[1]) | ((unsigned long long)pk2(o[2], o[3]) << 32); }
    }
}
__device__ __forceinline__ void fl_phase(unsigned char* ws, const bf16u* wt  , const float* ss, const float* fb, int wave, int lane) {
    const bf16u* HBp = (const bf16u*)(ws + WS_HB); float* LF = (float*)(ws + WS_LF);
    const int fr = lane & 15, fq = lane >> 4;
    for (int it = blockIdx.x * NWAVES + wave; it < MREAL / 16; it += gridDim.x * NWAVES) {
        const int m0 = it * 16, row0 = (m0 / SEQ_IN) * LP + NMETA + (m0 % SEQ_IN);
        const bf16u* ap = HBp + (size_t)(row0 + fr) * 1024 + 8 * fq; const bf16u* bp = wt + (size_t)fr * 1024 + 8 * fq;
        f32x4 acc = (f32x4){0.f, 0.f, 0.f, 0.f};
#pragma unroll 16
        for (int k = 0; k < 1024; k += 32) { const bf16x8m a = *(const bf16x8m*)(ap + k); const bf16x8m b = *(const bf16x8m*)(bp + k); acc = __builtin_amdgcn_mfma_f32_16x16x32_bf16(b, a, acc, 0, 0, 0); }
        if (fq < 2) { const int row = row0 + fr; const float rs = __builtin_amdgcn_rsqf(ss[row] * (1.0f / 1024.0f) + 1e-6f); f32x4 l;
#pragma unroll
            for (int i = 0; i < 4; ++i) { const int c = 4 * fq + i; const float x = acc[i] * rs + fb[c < NFH ? c : 0]; l[i] = c < NFH ? -(fmaxf(-x, 0.f) + log1pf(expf(-fabsf(x)))) * 1.4426950408889634f : 0.f; }
            *(f32x4*)(LF + (size_t)row * 8 + 4 * fq) = l; }
    }
}
__device__ __forceinline__ void pool_scan_phase(unsigned char* ws, LAS unsigned char* lds, unsigned* nrm, int tid, int wave, int lane) {
    const float* LF = (const float*)(ws + WS_LF); float* CS = (float*)(ws + WS_CS);
    if (blockIdx.x < NBATCH * NFH) {
        const int b = blockIdx.x / NFH, hf = blockIdx.x % NFH; constexpr int PER = 17;
        const float* lf = LF + (size_t)b * LP * 8 + hf; float* cs = CS + (size_t)(b * NFH + hf) * LP;
        float v[PER]; float s = 0.f; const int t0 = tid * PER;
#pragma unroll
        for (int i = 0; i < PER; ++i) { const int t = t0 + i; const float x = t < LREAL ? lf[(size_t)t * 8] : 0.f; s += x; v[i] = s; }
        float incl = s;
#pragma unroll
        for (int o = 1; o < 64; o <<= 1) { const float n = __shfl_up(incl, o); if (lane >= o) incl += n; }
        LAS float* wsum = (LAS float*)(lds + LDS_MISC + 256);
        if (lane == 63) wsum[wave] = incl;
        __syncthreads();
        float off = 0.f;
        for (int w = 0; w < wave; ++w) off += wsum[w];
        const float excl = off + incl - s;
#pragma unroll
        for (int i = 0; i < PER; ++i) { const int t = t0 + i; if (t < LREAL) cs[t] = excl + v[i]; }
        __syncthreads();
    }
    const bf16u* P = (const bf16u*)(ws + WS_P); bf16u* Y = (bf16u*)(ws + WS_Y);
    LAS float* nsc_ = (LAS float*)(lds + LDS_MISC + 512);
    for (int sl = blockIdx.x; sl < 256; sl += gridDim.x) {
        if (tid < 480) { const int sub = tid / 96, task = tid % 96, which = task / 48, head = (task % 48) >> 3, chunk = task & 7; const int r0 = sl * (MROWS / 256), b = r0 / LP;
            const bf16u* src = P + (which ? PC_FK : PC_FQ) + head * 64 + chunk * 8; float mx = 0.f;
#pragma unroll 9
            for (int r = sub; r < MROWS / 256; r += 5) { const v4u w = ((r0 + r) % LP < LREAL) ? *(const v4u*)(src + (size_t)(r0 + r) * NINP) : (v4u){0u, 0u, 0u, 0u}; float s = 0.f;
#pragma unroll
                for (int e = 0; e < 4; ++e) { const float lo = __uint_as_float(w[e] << 16), hi = __uint_as_float(w[e] & 0xffff0000u); s += lo * lo + hi * hi; }
                s += __shfl_xor(s, 1); s += __shfl_xor(s, 2); s += __shfl_xor(s, 4); mx = fmaxf(mx, s); }
            if (chunk == 0) nsc_[sub * 12 + head * 2 + which] = mx; }
        __syncthreads();
        if (tid < 12) { const int b = (sl * (MROWS / 256)) / LP; float mx = nsc_[tid];
#pragma unroll
            for (int s5 = 1; s5 < 5; ++s5) mx = fmaxf(mx, nsc_[s5 * 12 + tid]);
            atomicMax(nrm + b * NFH * 2 + tid, __float_as_uint(mx)); }
        __syncthreads();
    }
}
__device__ __forceinline__ void pool_chunk(unsigned char* ws, int c, int tid) {
    const bf16u* P = (const bf16u*)(ws + WS_P); bf16u* Y = (bf16u*)(ws + WS_Y);
    const int rsub = tid >> 5, ch = (tid & 31) * 8, win = 2 << (ch >> 6);
    {
        const int rg = c * 64 + rsub * 4, t0 = rg % LP;
        v4u wv[19];
#pragma unroll
        for (int j = 0; j < 19; ++j) { const int back = 15 - j;
            wv[j] = (back < win && t0 - back >= 0) ? *(const v4u*)(P + (size_t)(rg - back) * NINP + PC_U + ch) : (v4u){0u, 0u, 0u, 0u}; }
#pragma unroll
        for (int i = 0; i < 4; ++i) { const int t = t0 + i, cnt = (t + 1 < win) ? t + 1 : win; float acc[8];
#pragma unroll
            for (int e = 0; e < 8; ++e) acc[e] = 0.f;
#pragma unroll
            for (int k = 0; k < 16; ++k) { if (k < cnt) {
#pragma unroll
                for (int e = 0; e < 4; ++e) { acc[2 * e] += __uint_as_float(wv[15 + i - k][e] << 16); acc[2 * e + 1] += __uint_as_float(wv[15 + i - k][e] & 0xffff0000u); } } }
            const float inv = 1.0f / (float)cnt; v4u o;
#pragma unroll
            for (int e = 0; e < 4; ++e) o[e] = pk2(acc[2 * e] * inv - __uint_as_float(wv[15 + i][e] << 16), acc[2 * e + 1] * inv - __uint_as_float(wv[15 + i][e] & 0xffff0000u));
            *(v4u*)(Y + (size_t)(rg + i) * 1024 + ch) = o; }
    }
}
__device__ __forceinline__ void attn_phase(unsigned char* ws, unsigned char* lds_g, unsigned* ctr, const unsigned* nrm, int tid) {
    const attn_body::bf16* P = (const attn_body::bf16*)(ws + WS_P); attn_body::bf16* Y = (attn_body::bf16*)(ws + WS_Y); const float* CS = (const float*)(ws + WS_CS);
    volatile LAS unsigned* bw = (volatile LAS unsigned*)((LAS unsigned char*)lds_g + LDS_MISC);
    constexpr int NU = NBATCH * NFH * (LP / 256);
    for (;;) {
        if (tid == 0) bw[0] = atomicAdd(ctr, 1u);
        __syncthreads();
        const int it = (int)bw[0];
        __syncthreads();
        if (it >= 2 * NU + MROWS / 64) break;
#ifdef PROBE
        if (it == 2 * NU && tid == 0) ((volatile unsigned long long*)(ws + WS_CTL + 8192))[22 + (ctr != (unsigned*)(ws + WS_CTL))] = __builtin_amdgcn_s_memrealtime();
#endif
        if (it >= 2 * NU) { pool_chunk(ws, it - 2 * NU, tid); continue; }
#ifdef PROBE
        if (it == NU && tid == 0) ((volatile unsigned long long*)(ws + WS_CTL + 8192))[20 + (ctr != (unsigned*)(ws + WS_CTL))] = __builtin_amdgcn_s_memrealtime();
#endif
        constexpr int NF1 = 17 * NBATCH * NFH;
        const bool is_fox = it < NF1 || it >= NF1 + NU; const int r = it < NF1 ? it : (it < NF1 + NU ? it - NF1 : it - NU); const int qb = (LP / 256 - 1) - r / (NBATCH * NFH), bh = r % (NBATCH * NFH), b = bh / NFH, h = bh % NFH;
#ifndef NO_FOX
        if (is_fox) attn_body::fox_unit<16>(b, qb, 154.0f + 2.0f * sqrtf(__uint_as_float(nrm[bh * 2]) * __uint_as_float(nrm[bh * 2 + 1])), P + PC_FQ + h * 64, P + PC_FK + h * 64, P + PC_FV + h * 64, Y + 256 + h * 64, CS + (size_t)bh * LP, (char*)lds_g);
#endif
#ifndef NO_SB
        if (!is_fox) attn_body::sb_unit(b, qb, P + PC_SQ + h * 64, P + PC_SK + h * 64, P + PC_SV + h * 64, Y + 640 + h * 64, (char*)lds_g);
#endif
    }
}
__device__ __forceinline__ void final_phase(const Args& A, unsigned char* ws, int wave, int lane) {
    const bf16u* hb = (const bf16u*)(ws + WS_HB); const float* ss = (const float*)(ws + WS_SS) + 4 * (size_t)MROWS; const f32x4* g = (const f32x4*)A.in[14] + lane;
    const int gw = blockIdx.x * NWAVES + wave, NGW = gridDim.x * NWAVES;
    f32x4 gv[4];
#pragma unroll
    for (int j = 0; j < 4; ++j) gv[j] = g[64 * j];
    for (int m0 = gw * 2; m0 < NBATCH * SEQ_IN; m0 += NGW * 2) {
        unsigned long long r[2][4]; float rs[2];
#pragma unroll
        for (int q = 0; q < 2; ++q) { const int m = m0 + q, b = m / SEQ_IN, s = m % SEQ_IN; const size_t row = (size_t)b * LP + NMETA + s;
            rs[q] = 1.0f / sqrtf(ss[row] * (1.0f / 1024.0f) + 1e-6f);
            const unsigned long long* src = (const unsigned long long*)(hb + row * 1024) + lane;
#pragma unroll
            for (int j = 0; j < 4; ++j) r[q][j] = src[64 * j]; }
#pragma unroll
        for (int q = 0; q < 2; ++q) { f32x4* dst = (f32x4*)(A.out + (size_t)(m0 + q) * 1024) + lane;
#pragma unroll
            for (int j = 0; j < 4; ++j) { const unsigned rl = (unsigned)r[q][j], rh = (unsigned)(r[q][j] >> 32);
                dst[64 * j] = (f32x4){__uint_as_float(rl << 16), __uint_as_float(rl & 0xffff0000u), __uint_as_float(rh << 16), __uint_as_float(rh & 0xffff0000u)} * rs[q] * gv[j]; } }
    }
}

#define XB_TMO      128
#define XB_XCNT(j)  (256  + 64 * (j))
#define XB_XSUB(j)  (1280 + 64 * (j))
#define XB_XGEN(j)  (2304 + 64 * (j))
#define XB_TOP      3328
#define XB_TOPGEN   3392
#define XCD_BAR_WORDS 3456
#define XB_SPIN_CAP (1u << 18)

__device__ __forceinline__ unsigned xb_ld(unsigned* p)              { return __hip_atomic_load(p, __ATOMIC_RELAXED, __HIP_MEMORY_SCOPE_AGENT); }
__device__ __forceinline__ unsigned xb_add(unsigned* p, unsigned v) { return __hip_atomic_fetch_add(p, v, __ATOMIC_RELAXED, __HIP_MEMORY_SCOPE_AGENT); }
__device__ __forceinline__ unsigned xb_xcc_id() { return (unsigned)__builtin_amdgcn_s_getreg((3 << 11) | 20) & 0xFu; }
#define XB_SPIN(cond, bar) do { unsigned _sp = 0; while (cond) { __builtin_amdgcn_s_sleep(1); \
    if ((++_sp & 255u) == 0u) { if (xb_ld(&(bar)[XB_TMO])) break; if (_sp > XB_SPIN_CAP) { atomicAdd(&(bar)[XB_TMO], 1u); break; } } } } while (0)

struct XcdBarrier {
    unsigned* bar; unsigned x;
    volatile LAS unsigned* st;
};

__device__ __forceinline__ XcdBarrier xcd_barrier_post(unsigned* bar, volatile LAS unsigned* st) {
    XcdBarrier b; b.bar = bar; b.x = xb_xcc_id(); b.st = st;
    if (threadIdx.x == 0) (void)xb_add(&bar[XB_XCNT(b.x)], 1u);
    return b;
}
__device__ __forceinline__ void xcd_barrier_complete(unsigned* bar, unsigned x, unsigned& nloc, unsigned& nx) {
    const unsigned G = gridDim.x * gridDim.y * gridDim.z;
    unsigned sum, cnt, mine, sp = 0u;
    for (;;) {
        sum = 0u; cnt = 0u; mine = 0u;
#pragma unroll
        for (unsigned j = 0; j < 16; ++j) { const unsigned c = xb_ld(&bar[XB_XCNT(j)]); sum += c; cnt += (c > 0u) ? 1u : 0u; mine = (j == x) ? c : mine; }
        if (sum == G) break;
        __builtin_amdgcn_s_sleep(1);
        if ((++sp & 255u) == 0u) { if (xb_ld(&bar[XB_TMO])) break; if (sp > XB_SPIN_CAP) { atomicAdd(&bar[XB_TMO], 1u); break; } }
    }
    nloc = mine > 0u ? mine : 1u; nx = cnt > 0u ? cnt : 1u;
}

__device__ __forceinline__ void xcd_barrier(const XcdBarrier& b) {
    asm volatile("s_waitcnt vmcnt(0)" ::: "memory");
    __syncthreads();
    if (threadIdx.x == 0) {
        unsigned* bar = b.bar;
        __builtin_amdgcn_s_waitcnt(0);
        unsigned nloc = b.st[0], nx = b.st[1];
        if (nloc == 0u) { xcd_barrier_complete(bar, b.x, nloc, nx); b.st[0] = nloc; b.st[1] = nx; }
        const unsigned old = xb_add(&bar[XB_XSUB(b.x)], 1u);
        const unsigned gen = old / nloc;
        if (old + 1u == (gen + 1u) * nloc) {
            __builtin_amdgcn_fence(__ATOMIC_RELEASE, "agent");
            asm volatile("s_waitcnt vmcnt(0)" ::: "memory");
            const unsigned og = xb_add(&bar[XB_TOP], 1u);
            const unsigned tg = og / nx;
            if (og + 1u == (tg + 1u) * nx) xb_add(&bar[XB_TOPGEN], 1u);
            else XB_SPIN(xb_ld(&bar[XB_TOPGEN]) == tg, bar);
            __builtin_amdgcn_fence(__ATOMIC_ACQUIRE, "agent");
            xb_add(&bar[XB_XGEN(b.x)], 1u);
            asm volatile("s_waitcnt vmcnt(0)" ::: "memory");
        } else {
            XB_SPIN(xb_ld(&bar[XB_XGEN(b.x)]) == gen, bar);
            __builtin_amdgcn_fence(__ATOMIC_ACQUIRE, "agent");
            asm volatile("s_waitcnt vmcnt(0)" ::: "memory");
        }
    }
    __syncthreads();
}

#define FRESH() unsigned long zoff_ = 0; asm volatile("" : "+s"(zoff_)); unsigned char* ws = A.ws + zoff_; int tid = threadIdx.x; asm volatile("" : "+v"(tid)); const int lane = tid & 63, wave = __builtin_amdgcn_readfirstlane(tid >> 6); (void)lane; (void)wave
#ifdef PROBE
#define STAMP() do { if (blockIdx.x == 0 && threadIdx.x == 0) { ((volatile unsigned long long*)(A.ws + WS_CTL + 8192))[nst] = __builtin_amdgcn_s_memrealtime(); } ++nst; } while (0)
#else
#define STAMP() do {} while (0)
#endif
__global__ void __launch_bounds__(NWAVES * 64, 2) hymba_fwd(Args A) {
    extern __shared__ __attribute__((aligned(16))) unsigned char lds[];
    cg::grid_group grid = cg::this_grid();
    LAS unsigned char* L = (LAS unsigned char*)lds;
    if (threadIdx.x < 2) ((volatile LAS unsigned*)(L + LDS_MISC + 64))[threadIdx.x] = 0u;
    __syncthreads();
    const XcdBarrier xbar = xcd_barrier_post((unsigned*)(A.ws + WS_CTL) + 4096, (volatile LAS unsigned*)(L + LDS_MISC + 64));
#define GRID_BAR() xcd_barrier(xbar)
#ifdef PROBE
    int nst = 0; STAMP();
    for (int i = 0; i < 8; ++i) GRID_BAR();
    STAMP();
#endif
#ifndef NO_PRO
    { FRESH(); p0_prologue(A, ws, L, wave, lane); }
#endif
    if (A.ws == nullptr) grid.sync();
    GRID_BAR(); STAMP();
    for (int layer = 0; layer < DEPTH; ++layer) {
#ifndef NO_G1
        {
            FRESH(); const unsigned char* wb = ws + WS_W + (size_t)layer * W_LAYER;
            pg8::Gemm g{(const pg8::bf16_t*)(ws + WS_HB), (const pg8::bf16_t*)(wb + W_IN), MREAL, NINP, 1024}; pg8::StaticOrder S; S.init(MREAL, NINP, (int)gridDim.x, (int)blockIdx.x);
            pg8::EpiIn E{(pg8::bf16_t*)(ws + WS_P), (float*)(ws + WS_LF), (const float*)(ws + WS_SS) + (size_t)(2 * layer) * MROWS, A.in[4] + layer * NFH};
            fl_phase(ws, (const bf16u*)(wb + W_IN) + (size_t)NINP * 1024, (const float*)(ws + WS_SS) + (size_t)(2 * layer) * MROWS, A.in[4] + layer * NFH, wave, lane);
            mini_in(ws, (const bf16u*)(wb + W_IN), (const float*)(ws + WS_SS) + (size_t)(2 * layer) * MROWS, A.in[4] + layer * NFH, L, wave, lane);
            pg8::gemm_phase<pg8::EpiIn, pg8::StaticOrder, true, true>(L, g, S, E);
        }
#endif
        GRID_BAR(); STAMP();
#ifndef NO_POOL
        { FRESH(); pool_scan_phase(ws, L, (unsigned*)(ws + WS_CTL) + 128 + 64 * layer, tid, wave, lane); }
#endif
        GRID_BAR(); STAMP();
        { FRESH(); attn_phase(ws, lds, (unsigned*)(ws + WS_CTL) + 64 * layer, (const unsigned*)(ws + WS_CTL) + 128 + 64 * layer, tid); }
        GRID_BAR(); STAMP();
#ifndef NO_G3
        {
            FRESH(); const unsigned char* wb = ws + WS_W + (size_t)layer * W_LAYER;
            pg8::Gemm g{(const pg8::bf16_t*)(ws + WS_Y), (const pg8::bf16_t*)(wb + W_OUT), MREAL, 1024, 1024}; pg8::StaticOrder S; S.init(MREAL, 1024, (int)gridDim.x, (int)blockIdx.x);
            pg8::EpiRes E{(pg8::bf16_t*)(ws + WS_HB), nullptr, (float*)(ws + WS_SS) + (size_t)(2 * layer + 1) * MROWS};
            mini_res(ws, (const bf16u*)(ws + WS_Y), (const bf16u*)(wb + W_OUT), 1024, (float*)(ws + WS_SS) + (size_t)(2 * layer + 1) * MROWS, L, wave, lane);
            pg8::gemm_phase<pg8::EpiRes, pg8::StaticOrder, true, true>(L, g, S, E);
        }
#endif
        GRID_BAR(); STAMP();
#ifndef NO_G4
        {
            FRESH(); const unsigned char* wb = ws + WS_W + (size_t)layer * W_LAYER;
            pg8::Gemm g{(const pg8::bf16_t*)(ws + WS_HB), (const pg8::bf16_t*)(wb + W_GU), MREAL, NGU, 1024}; pg8::StaticOrder S; S.init(MREAL, NGU, (int)gridDim.x, (int)blockIdx.x);
            pg8::EpiGU E{(pg8::bf16_t*)(ws + WS_P), (const float*)(ws + WS_SS) + (size_t)(2 * layer + 1) * MROWS};
            mini_gu(ws, (const bf16u*)(wb + W_GU), (const float*)(ws + WS_SS) + (size_t)(2 * layer + 1) * MROWS, L, wave, lane);
            pg8::gemm_phase<pg8::EpiGU, pg8::StaticOrder, true, true>(L, g, S, E);
        }
#endif
        GRID_BAR(); STAMP();
#ifndef NO_G5
        {
            FRESH(); const unsigned char* wb = ws + WS_W + (size_t)layer * W_LAYER;
            pg8::Gemm g{(const pg8::bf16_t*)(ws + WS_P), (const pg8::bf16_t*)(wb + W_D), MREAL, 1024, DFF}; pg8::StaticOrder S; S.init(MREAL, 1024, (int)gridDim.x, (int)blockIdx.x);
            pg8::EpiRes E{(pg8::bf16_t*)(ws + WS_HB), nullptr, (float*)(ws + WS_SS) + (size_t)(2 * layer + 2) * MROWS};
            mini_res(ws, (const bf16u*)(ws + WS_P), (const bf16u*)(wb + W_D), DFF, (float*)(ws + WS_SS) + (size_t)(2 * layer + 2) * MROWS, L, wave, lane);
            pg8::gemm_phase<pg8::EpiRes, pg8::StaticOrder, true, true>(L, g, S, E);
        }
#endif
        GRID_BAR(); STAMP();
    }
    { FRESH(); final_phase(A, ws, wave, lane); }
#ifdef PROBE
    STAMP();
    grid.sync();
    {
        volatile unsigned long long* T = (volatile unsigned long long*)(A.ws + WS_CTL + 8192);
        if (blockIdx.x == 0) {
#ifndef PB_HI
#define PB_HI (PB + 1)
#endif

#ifndef PA_HI
#define PA_HI (PA + 1)
#endif
            const unsigned long long dA = T[PA_HI] - T[PA], dB = T[PB_HI < 0 ? 0 : PB_HI] - T[PB < 0 ? 0 : PB];
#if PB >= 0
            for (unsigned long long i = threadIdx.x; i < dB; i += NWAVES * 64) A.out[i] += 0.125f;
#else
            (void)dB;
#endif
            if (threadIdx.x == 0) { const unsigned long long t0 = __builtin_amdgcn_s_memrealtime(); while (__builtin_amdgcn_s_memrealtime() - t0 < dA) __builtin_amdgcn_s_sleep(8); }
        }
    }
#endif
}

extern "C" void kernel_launch(void* const* d_in, const int* in_sizes, int n_in, void* d_out, int out_size, void* d_ws, size_t ws_size, hipStream_t stream) {
    static int grid = 0;
    if (grid == 0) {
        if (n_in != 15 || out_size != NBATCH * SEQ_IN * DMODEL || ws_size < WS_END) { fprintf(stderr, "kernel_launch: unexpected shapes (n_in %d out %d ws %zu, need %zu)\n", n_in, out_size, ws_size, (size_t)WS_END); grid = -1; return; }
        int dev = 0, cus = 0, per_cu = 0;
        if (hipGetDevice(&dev) != hipSuccess || hipDeviceGetAttribute(&cus, hipDeviceAttributeMultiprocessorCount, dev) != hipSuccess) { grid = -1; return; }
        if (hipFuncSetAttribute((const void*)hymba_fwd, hipFuncAttributeMaxDynamicSharedMemorySize, LDS_BYTES) != hipSuccess) { fprintf(stderr, "kernel_launch: hipFuncSetAttribute failed\n"); grid = -1; return; }
        if (hipOccupancyMaxActiveBlocksPerMultiprocessor(&per_cu, (const void*)hymba_fwd, NWAVES * 64, LDS_BYTES) != hipSuccess || per_cu < 1) { fprintf(stderr, "kernel_launch: occupancy query says %d\n", per_cu); per_cu = 1; }
        (void)hipGetLastError();
        grid = cus;
    }
    if (grid < 0) return;
    if (hipMemsetAsync((char*)d_ws + WS_CTL, 0, CTL_ZERO_BYTES, stream) != hipSuccess) { fprintf(stderr, "kernel_launch: memset failed\n"); return; }
    Args a{};
    for (int i = 0; i < 15; ++i) a.in[i] = (const float*)d_in[i];
    a.out = (float*)d_out; a.ws = (unsigned char*)d_ws;
    void* args[] = {&a};
    const hipError_t e = hipLaunchCooperativeKernel((const void*)hymba_fwd, dim3(grid), dim3(NWAVES * 64), args, LDS_BYTES, stream);
    if (e != hipSuccess) fprintf(stderr, "kernel_launch: cooperative launch failed: %s (grid %d)\n", hipGetErrorString(e), grid);
}
```

```cpp
#include <hip/hip_runtime.h>
#include <hip/hip_cooperative_groups.h>
#include <cstdio>
#include <cstdint>
namespace pg8 {
#define PG8_LAS __attribute__((address_space(3)))
typedef unsigned short bf16_t;
typedef short bf16x8 __attribute__((ext_vector_type(8)));
typedef float f32x4 __attribute__((ext_vector_type(4)));
typedef unsigned u32x4 __attribute__((ext_vector_type(4)));
constexpr int BM = 256, BK = 64, HALF = 128, HTB = HALF * BK * 2  , STAGE_BYTES = 8 * HTB, NXCD = 8, WGM = 8;

__host__ __device__ __forceinline__ int lds_byte(int r, int c) { const int st = (r >> 4) * 2 + (c >> 5), rr = r & 15, cc = c & 31, ob = rr * 64 + cc * 2; return st * 1024 + (ob ^ (((ob >> 9) & 1) << 5)); }
__host__ __device__ __forceinline__ void stage_rc(int b, int& R, int& C) { const int st = b / 1024, sb = b % 1024, swz = sb ^ (((sb >> 9) & 1) << 5); R = (st >> 1) * 16 + swz / 64; C = (st & 1) * 32 + (swz % 64) / 2; }
__host__ __device__ __forceinline__ int perm32(int rho) { const int n = rho >> 4, i = rho & 15; return 8 * (i >> 2) + 4 * n + (i & 3); }

struct Unit { int pm, pn; };
__host__ __device__ __forceinline__ int arow(int pm) { return 256 * (pm + (pm >> 5)) + 16; }
struct Gemm { const bf16_t* A; const bf16_t* Bt; int M, N, K; };

struct StaticOrder {
    int nM, nN, nwg, G, c;
    __host__ __device__ void init(int M, int N, int G_, int c_) { nM = M / BM; nN = N / BM; nwg = nM * nN; G = G_; c = c_; }
    __host__ __device__ bool next(int i, Unit& u) const {
        const long L = (long)i * G + c; if (L >= nwg) return false;
        int wgid = (int)L; { const int q = nwg / NXCD, r = nwg % NXCD, xcd = wgid % NXCD, off = wgid / NXCD; wgid = (xcd < r ? xcd * (q + 1) : r * (q + 1) + (xcd - r) * q) + off; }
        const int nig = WGM * nN, gid = wgid / nig, fm = gid * WGM, gsz = (nM - fm) < WGM ? (nM - fm) : WGM;
        u.pm = fm + ((wgid % nig) % gsz); u.pn = (wgid % nig) / gsz; return true;
    }
    __device__ __forceinline__ void a_ready(const Unit&) const {}
    __device__ __forceinline__ void done(const Unit&) const {}
};

__device__ __forceinline__ unsigned cvt_pk_bf16(float lo, float hi) { unsigned r; asm volatile("v_cvt_pk_bf16_f32 %0, %1, %2" : "=v"(r) : "v"(lo), "v"(hi)); return r; }
typedef unsigned u32x2 __attribute__((ext_vector_type(2)));
constexpr float RMS_EPS = 1e-6f;
struct EpiIn {
    static constexpr bool PERM = true, AFTER_DRAIN = false;
    bf16_t* P; float* LF; const float* ss; const float* fb;
    __device__ __forceinline__ void operator()(const f32x4 (&acc)[2][2][4][2], const Unit& u, int wr, int wc, int fr, int fq) const {
        const int row0 = arow(u.pm) + wr * 64 + fr;
        {
            const int col0 = u.pn * BM + wc * 32 + 8 * fq;
#pragma unroll
            for (int ai = 0; ai < 2; ++ai)
#pragma unroll
                for (int m = 0; m < 4; ++m) { const int row = row0 + ai * HALF + m * 16; const float rs = __builtin_amdgcn_rsqf(ss[row] * (1.0f / 1024.0f) + RMS_EPS);
                    bf16_t* rowp = P + (size_t)row * 2560 + col0;
#pragma unroll
                    for (int bj = 0; bj < 2; ++bj) { const f32x4 v0 = acc[ai][bj][m][0] * rs, v1 = acc[ai][bj][m][1] * rs;
                        u32x4 w; w.x = cvt_pk_bf16(v0[0], v0[1]); w.y = cvt_pk_bf16(v0[2], v0[3]); w.z = cvt_pk_bf16(v1[0], v1[1]); w.w = cvt_pk_bf16(v1[2], v1[3]);
                        *(u32x4*)(rowp + bj * HALF) = w; } }
        }
    }
};
struct EpiRes {
    static constexpr bool PERM = true, AFTER_DRAIN = false;
    bf16_t* hb; float* hf; float* ssn;
    __device__ __forceinline__ void operator()(const f32x4 (&acc)[2][2][4][2], const Unit& u, int wr, int wc, int fr, int fq) const {
        const int row0 = arow(u.pm) + wr * 64 + fr, col0 = u.pn * BM + wc * 32 + 8 * fq;
#pragma unroll
        for (int ai = 0; ai < 2; ++ai)
#pragma unroll
            for (int m = 0; m < 4; ++m) { const int row = row0 + ai * HALF + m * 16; bf16_t* bp = hb + (size_t)row * 1024 + col0; float s = 0.f;
#pragma unroll
                for (int bj = 0; bj < 2; ++bj) { const u32x4 r = *(const u32x4*)(bp + bj * HALF);
                    f32x4 a = (f32x4){__uint_as_float(r.x << 16), __uint_as_float(r.x & 0xffff0000u), __uint_as_float(r.y << 16), __uint_as_float(r.y & 0xffff0000u)};
                    f32x4 b = (f32x4){__uint_as_float(r.z << 16), __uint_as_float(r.z & 0xffff0000u), __uint_as_float(r.w << 16), __uint_as_float(r.w & 0xffff0000u)};
                    a = a + acc[ai][bj][m][0]; b = b + acc[ai][bj][m][1];
                    if (hf) { float* hp = hf + (size_t)row * 1024 + col0 + bj * HALF; *(f32x4*)hp = a; *(f32x4*)(hp + 4) = b; }
                    s += (a[0] * a[0] + a[1] * a[1]) + (a[2] * a[2] + a[3] * a[3]) + (b[0] * b[0] + b[1] * b[1]) + (b[2] * b[2] + b[3] * b[3]);
                    u32x4 w; w.x = cvt_pk_bf16(a[0], a[1]); w.y = cvt_pk_bf16(a[2], a[3]); w.z = cvt_pk_bf16(b[0], b[1]); w.w = cvt_pk_bf16(b[2], b[3]);
                    *(u32x4*)(bp + bj * HALF) = w; }
                s += __shfl_xor(s, 16); s += __shfl_xor(s, 32);
                if (fq == 0) atomicAdd(ssn + row, s);
                asm volatile("" ::: "memory"); }
    }
};
struct EpiGU {
    static constexpr bool PERM = true, AFTER_DRAIN = false;
    bf16_t* H; const float* ss;
    __device__ __forceinline__ void operator()(const f32x4 (&acc)[2][2][4][2], const Unit& u, int wr, int wc, int fr, int fq) const {
        const int row0 = arow(u.pm) + wr * 64 + fr, col0 = u.pn * HALF + wc * 32 + 8 * fq;
#pragma unroll
        for (int ai = 0; ai < 2; ++ai)
#pragma unroll
            for (int m = 0; m < 4; ++m) { const int row = row0 + ai * HALF + m * 16; const float rs = __builtin_amdgcn_rsqf(ss[row] * (1.0f / 1024.0f) + RMS_EPS);
                float o[8];
#pragma unroll
                for (int n = 0; n < 2; ++n)
#pragma unroll
                    for (int e = 0; e < 4; ++e) { const float g = acc[ai][0][m][n][e] * rs, up = acc[ai][1][m][n][e] * rs;
                        o[4 * n + e] = g * __builtin_amdgcn_rcpf(1.0f + __builtin_amdgcn_exp2f(-1.4426950408889634f * g)) * up; }
                u32x4 w; w.x = cvt_pk_bf16(o[0], o[1]); w.y = cvt_pk_bf16(o[2], o[3]); w.z = cvt_pk_bf16(o[4], o[5]); w.w = cvt_pk_bf16(o[6], o[7]);
                *(u32x4*)(H + (size_t)row * 2816 + col0) = w; }
    }
};
template <class Epi, class Sched, bool ALIGN_EPI = false, bool SP2 = false>
__device__ __forceinline__ void gemm_phase(PG8_LAS unsigned char* lds, const Gemm g, const Sched& S, const Epi& E) {
    int tid_ = threadIdx.x; asm volatile("" : "+v"(tid_));
    const int tid = tid_, wid = __builtin_amdgcn_readfirstlane(tid >> 6), lane = tid & 63, wr = wid >> 2, wc = wid & 3, fr = lane & 15, fq = lane >> 4;
    const int K = g.K, nt = K / BK;
    unsigned voffA[2], voffB[2];
#pragma unroll
    for (int i = 0; i < 2; ++i) { int R, C; stage_rc(tid * 16 + i * 8192, R, C); const int Rb = Epi::PERM ? ((R & ~31) + perm32(R & 31)) : R;
        voffA[i] = (unsigned)(R * K + C) * 2u; voffB[i] = (unsigned)(Rb * K + C) * 2u; }
    const size_t kstep = (size_t)(BK * 2);
    const size_t hstep = (size_t)HALF * K * 2;
    const size_t tstep = 2 * hstep;
    const unsigned ldsw = (unsigned)wid * 1024u;
    const int aoff = lds_byte(wr * 64 + fr, fq * 8), boff = lds_byte(wc * 32 + fr, fq * 8);
#define PG8_SA(b, h) (((b) * 2 + (h)) * HTB)
#define PG8_SB(b, h) ((4 + (b) * 2 + (h)) * HTB)
#define PG8_STAGE(bufoff, gbase, voff) do { _Pragma("unroll") for (int _i = 0; _i < 2; ++_i) \
        __builtin_amdgcn_global_load_lds((const unsigned*)((const char*)(gbase) + (voff)[_i]), (PG8_LAS unsigned*)(lds + (bufoff) + ldsw + _i * 8192), 16, 0, 0); } while (0)
#define PG8_LDA(dst, b, h) do { _Pragma("unroll") for (int m = 0; m < 4; ++m) _Pragma("unroll") for (int k = 0; k < 2; ++k) dst[m][k] = *(const PG8_LAS bf16x8*)(lds + PG8_SA(b, h) + aoff + m * 2048 + k * 1024); } while (0)
#define PG8_LDB(dst, b, h) do { _Pragma("unroll") for (int n = 0; n < 2; ++n) _Pragma("unroll") for (int k = 0; k < 2; ++k) dst[n][k] = *(const PG8_LAS bf16x8*)(lds + PG8_SB(b, h) + boff + n * 2048 + k * 1024); } while (0)
#define PG8_MMA(ai, bj, At, Bt) do { __builtin_amdgcn_s_setprio(1); _Pragma("unroll") for (int m = 0; m < 4; ++m) _Pragma("unroll") for (int n = 0; n < 2; ++n) _Pragma("unroll") for (int k = 0; k < 2; ++k) \
        acc[ai][bj][m][n] = __builtin_amdgcn_mfma_f32_16x16x32_bf16(Bt[n][k], At[m][k], acc[ai][bj][m][n], 0, 0, 0); __builtin_amdgcn_s_setprio(0); } while (0)
#define PG8_WAIT_V(n) asm volatile("s_waitcnt vmcnt(" #n ")" ::: "memory")
#define PG8_WAIT_L(n) asm volatile("s_waitcnt lgkmcnt(" #n ")" ::: "memory")
#define PG8_BAR __builtin_amdgcn_s_barrier()
#define PG8_SCHED __builtin_amdgcn_sched_barrier(0)
    Unit cur, nxt; int ui = 0;
    if (!S.next(0, cur)) return;
    f32x4 acc[2][2][4][2];
#pragma unroll
    for (int a = 0; a < 2; ++a)
#pragma unroll
        for (int b = 0; b < 2; ++b)
#pragma unroll
            for (int m = 0; m < 4; ++m)
#pragma unroll
                for (int n = 0; n < 2; ++n) acc[a][b][m][n] = (f32x4){0.f, 0.f, 0.f, 0.f};
    bf16x8 At[4][2], B0[2][2], B1[2][2];
    const char* cA = (const char*)g.A + (size_t)arow(cur.pm) * K * 2; const char* cB = (const char*)g.Bt + (size_t)cur.pn * tstep;
    S.a_ready(cur);
    if constexpr (SP2) {
        PG8_STAGE(PG8_SB(0, 0), cB, voffB); PG8_STAGE(PG8_SB(0, 1), cB + hstep, voffB); PG8_STAGE(PG8_SA(0, 0), cA, voffA); PG8_STAGE(PG8_SA(0, 1), cA + hstep, voffA);
        if (wr == 1) PG8_BAR;
        PG8_WAIT_V(2); PG8_BAR;
        PG8_STAGE(PG8_SB(1, 0), cB + kstep, voffB); PG8_STAGE(PG8_SA(1, 0), cA + kstep, voffA); PG8_STAGE(PG8_SB(1, 1), cB + hstep + kstep, voffB);
        PG8_WAIT_V(6); PG8_BAR;
    } else {
        PG8_STAGE(PG8_SB(0, 0), cB, voffB); PG8_STAGE(PG8_SA(0, 0), cA, voffA); PG8_STAGE(PG8_SB(0, 1), cB + hstep, voffB); PG8_STAGE(PG8_SA(0, 1), cA + hstep, voffA);
        if (wr == 1) PG8_BAR;
        PG8_WAIT_V(4); PG8_BAR;
        PG8_STAGE(PG8_SB(1, 0), cB + kstep, voffB); PG8_STAGE(PG8_SA(1, 0), cA + kstep, voffA); PG8_STAGE(PG8_SB(1, 1), cB + hstep + kstep, voffB);
        PG8_WAIT_V(6); PG8_BAR;
    }
    for (;;) {
        const bool has_next = S.next(ui + 1, nxt);
        const char* nA = has_next ? (const char*)g.A + (size_t)arow(nxt.pm) * K * 2 : cA; const char* nB = has_next ? (const char*)g.Bt + (size_t)nxt.pn * tstep : cB;
        for (int t = 0; t < nt; t += 2) {
            const bool last = (t == nt - 2);
            const char* a1 = cA + (size_t)(t + 1) * kstep;
            const char* a2 = last ? nA : cA + (size_t)(t + 2) * kstep; const char* b2 = last ? nB : cB + (size_t)(t + 2) * kstep;
            const char* a3 = a2 + kstep; const char* b3 = b2 + kstep;
            if (last && has_next) S.a_ready(nxt);
            if constexpr (SP2) {
            PG8_LDB(B0, 0, 0); PG8_LDB(B1, 0, 1); PG8_SCHED; PG8_LDA(At, 0, 0); PG8_STAGE(PG8_SA(1, 1), a1 + hstep, voffA);
            PG8_WAIT_V(8); PG8_WAIT_L(0); PG8_BAR; PG8_MMA(0, 0, At, B0); PG8_MMA(0, 1, At, B1); PG8_BAR; PG8_SCHED;
            PG8_LDA(At, 0, 1); PG8_STAGE(PG8_SB(0, 0), b2, voffB); PG8_STAGE(PG8_SB(0, 1), b2 + hstep, voffB); PG8_STAGE(PG8_SA(0, 0), a2, voffA);
            PG8_WAIT_V(8); PG8_WAIT_L(0); PG8_BAR; PG8_MMA(1, 0, At, B0); PG8_MMA(1, 1, At, B1); PG8_BAR; PG8_SCHED;
            PG8_LDB(B0, 1, 0); PG8_LDB(B1, 1, 1); PG8_SCHED; PG8_LDA(At, 1, 0); PG8_STAGE(PG8_SA(0, 1), a2 + hstep, voffA);
            PG8_WAIT_V(8); PG8_WAIT_L(0); PG8_BAR; PG8_MMA(0, 0, At, B0); PG8_MMA(0, 1, At, B1); PG8_BAR; PG8_SCHED;
            PG8_LDA(At, 1, 1); PG8_STAGE(PG8_SB(1, 0), b3, voffB); PG8_STAGE(PG8_SB(1, 1), b3 + hstep, voffB); PG8_STAGE(PG8_SA(1, 0), a3, voffA);
            PG8_WAIT_V(8); PG8_WAIT_L(0); PG8_BAR; PG8_MMA(1, 0, At, B0); PG8_MMA(1, 1, At, B1); PG8_BAR; PG8_SCHED;
            } else {
            PG8_LDB(B0, 0, 0); PG8_SCHED; PG8_LDA(At, 0, 0); PG8_STAGE(PG8_SA(1, 1), a1 + hstep, voffA);
            PG8_WAIT_L(8); PG8_BAR; PG8_WAIT_L(0); PG8_MMA(0, 0, At, B0); PG8_BAR; PG8_SCHED;
            PG8_LDB(B1, 0, 1); PG8_STAGE(PG8_SB(0, 0), b2, voffB);
            PG8_BAR; PG8_WAIT_L(0); PG8_MMA(0, 1, At, B1); PG8_BAR;
            PG8_LDA(At, 0, 1); PG8_STAGE(PG8_SA(0, 0), a2, voffA);
            PG8_BAR; PG8_WAIT_L(0); PG8_MMA(1, 0, At, B0); PG8_BAR; PG8_SCHED;
            PG8_STAGE(PG8_SB(0, 1), b2 + hstep, voffB);
            PG8_WAIT_V(6); PG8_BAR; PG8_MMA(1, 1, At, B1); PG8_BAR;
            PG8_LDB(B0, 1, 0); PG8_SCHED; PG8_LDA(At, 1, 0); PG8_STAGE(PG8_SA(0, 1), a2 + hstep, voffA);
            PG8_WAIT_L(8); PG8_BAR; PG8_WAIT_L(0); PG8_MMA(0, 0, At, B0); PG8_BAR; PG8_SCHED;
            PG8_LDB(B1, 1, 1); PG8_STAGE(PG8_SB(1, 0), b3, voffB);
            PG8_BAR; PG8_WAIT_L(0); PG8_MMA(0, 1, At, B1); PG8_BAR;
            PG8_LDA(At, 1, 1); PG8_STAGE(PG8_SA(1, 0), a3, voffA);
            PG8_BAR; PG8_WAIT_L(0); PG8_MMA(1, 0, At, B0); PG8_BAR; PG8_SCHED;
            PG8_STAGE(PG8_SB(1, 1), b3 + hstep, voffB);
            PG8_WAIT_V(6); PG8_BAR; PG8_MMA(1, 1, At, B1); PG8_BAR;
            }
        }
        if constexpr (ALIGN_EPI) { if (wr == 0) PG8_BAR; }
        if constexpr (!Epi::AFTER_DRAIN) { E(acc, cur, wr, wc, fr, fq); S.done(cur); }
        if (!has_next) break;
#pragma unroll
        for (int a = 0; a < 2; ++a)
#pragma unroll
            for (int b = 0; b < 2; ++b)
#pragma unroll
                for (int m = 0; m < 4; ++m)
#pragma unroll
                    for (int n = 0; n < 2; ++n) acc[a][b][m][n] = (f32x4){0.f, 0.f, 0.f, 0.f};
        cur = nxt; cA = nA; cB = nB; ++ui;
        if constexpr (ALIGN_EPI) { if (wr == 1) PG8_BAR; }
    }
    PG8_WAIT_V(0);
    if constexpr (!ALIGN_EPI) { if (wr == 0) PG8_BAR; }
    PG8_BAR;
    if constexpr (Epi::AFTER_DRAIN) { E.fused(acc, cur, wr, wc, fr, fq, lds, wid, lane); S.done(cur); }
#undef PG8_SA
#undef PG8_SB
#undef PG8_STAGE
#undef PG8_LDA
#undef PG8_LDB
#undef PG8_MMA
#undef PG8_WAIT_V
#undef PG8_WAIT_L
#undef PG8_BAR
#undef PG8_SCHED
}
}
#include <hip/hip_bf16.h>
#include <cmath>
namespace attn_body {
using bf16=__hip_bfloat16;
using bf16x8=__attribute__((ext_vector_type(8)))short;
using s16x4=__attribute__((ext_vector_type(4)))short;
using f32x16=__attribute__((ext_vector_type(16)))float;
using u32x4=__attribute__((ext_vector_type(4)))unsigned;
constexpr int SEQ=8448,D=64,DM=2560,DMO=1024;
using f32x4=__attribute__((ext_vector_type(4)))float;
constexpr int NW=8,QBLK=32,QB=QBLK*NW,KVBLK=64,NQB=SEQ/QB;
constexpr int ATTN_UNIT_ROWS=QB;
__device__ __forceinline__ int crow(int r,int hi){return (r&3)+8*(r>>2)+4*hi;}
#define SBAR() __builtin_amdgcn_sched_barrier(0)
__device__ __forceinline__ void cmask(f32x16&p0,f32x16&p1,int jb,int qrel,int hi){
  const float NEG=-INFINITY; int kb=64*jb+4*hi;
  #pragma unroll
  for(int r=0;r<16;++r){int kv=kb+(r&3)+8*(r>>2); if(kv>qrel)p0[r]=NEG; if(kv+32>qrel)p1[r]=NEG;}
}

constexpr int NSLOT=3, SLOTB=8192;
constexpr int LDS_K=0, LDS_V=NSLOT*SLOTB, LDS_WS=2*NSLOT*SLOTB, LDS_OST=LDS_WS+NW*64*4, LDS_BYTES=LDS_OST+NW*4096, LDS_CS=LDS_BYTES, LDS_FLAGS=LDS_CS+SEQ*4, LDS_END=LDS_FLAGS+256;
constexpr float C2=0.125f*1.4426950408889634f;
__device__ __forceinline__ void glds16(const void*gsrc,unsigned lds_dst){unsigned keep;
  asm volatile("s_mov_b32 %0, m0\n\ts_mov_b32 m0, %2\n\ts_nop 0\n\tglobal_load_lds_dwordx4 %1, off\n\ts_mov_b32 m0, %0":"=&s"(keep):"v"(gsrc),"s"(lds_dst):"memory");}
__device__ __forceinline__ float max3f(float a,float b,float c){float r;asm("v_max3_f32 %0, %1, %2, %3":"=v"(r):"v"(a),"v"(b),"v"(c));return r;}
__device__ __forceinline__ float max2f(float a,float b){float r;asm("v_max_f32_e32 %0, %1, %2":"=v"(r):"v"(a),"v"(b));return r;}
__device__ __forceinline__ float fadd_s(float a,float b){float r;asm("v_add_f32_e32 %0, %1, %2":"=v"(r):"v"(a),"v"(b));return r;}
__device__ __forceinline__ float fsub_s(float a,float b){float r;asm("v_sub_f32_e32 %0, %1, %2":"=v"(r):"v"(a),"v"(b));return r;}
typedef float f32x2_t __attribute__((ext_vector_type(2))); typedef __bf16 bf16x2_t __attribute__((ext_vector_type(2)));
__device__ __forceinline__ unsigned cvtpk_s(float lo,float hi){f32x2_t v={lo,hi};bf16x2_t b=__builtin_convertvector(v,bf16x2_t);return __builtin_bit_cast(unsigned,b);}
#define WAIT_BAR(N) asm volatile("s_waitcnt vmcnt(" #N ") lgkmcnt(0)\n\ts_barrier":::"memory")

__device__ __forceinline__ void qkt(f32x16&p0,f32x16&p1,const char*Kslot,const bf16x8*qr,int r32,int hi){
  const char*kb=Kslot+hi*1024+r32*16;
  #pragma unroll
  for(int d0=0;d0<4;++d0){
    const bf16x8 b0=*reinterpret_cast<const bf16x8*>(kb+d0*2048);
    const bf16x8 b1=*reinterpret_cast<const bf16x8*>(kb+d0*2048+512);
    {p0=__builtin_amdgcn_mfma_f32_32x32x16_bf16(b0,qr[d0],p0,0,0,0);p1=__builtin_amdgcn_mfma_f32_32x32x16_bf16(b1,qr[d0],p1,0,0,0);}}
}
typedef __attribute__((address_space(3))) const char* lds_cptr;
typedef short v4i16_t __attribute__((ext_vector_type(4)));
__device__ __forceinline__ void kload8(bf16x8*kf,lds_cptr kp){
  kf[0]=*(const __attribute__((address_space(3))) bf16x8*)(kp);      kf[1]=*(const __attribute__((address_space(3))) bf16x8*)(kp+512);
  kf[2]=*(const __attribute__((address_space(3))) bf16x8*)(kp+2048); kf[3]=*(const __attribute__((address_space(3))) bf16x8*)(kp+2560);
  kf[4]=*(const __attribute__((address_space(3))) bf16x8*)(kp+4096); kf[5]=*(const __attribute__((address_space(3))) bf16x8*)(kp+4608);
  kf[6]=*(const __attribute__((address_space(3))) bf16x8*)(kp+6144); kf[7]=*(const __attribute__((address_space(3))) bf16x8*)(kp+6656);
}
__device__ __forceinline__ void kload2(bf16x8*kf,lds_cptr kp,int j){ kf[2*j]=*(const __attribute__((address_space(3))) bf16x8*)(kp+j*2048); kf[2*j+1]=*(const __attribute__((address_space(3))) bf16x8*)(kp+j*2048+512); }
__device__ __forceinline__ s16x4 vtr(lds_cptr p){ return __builtin_bit_cast(s16x4,__builtin_amdgcn_ds_read_tr16_b64_v4i16((__attribute__((address_space(3))) v4i16_t*)p)); }
__device__ __forceinline__ float rowmax(const f32x16&p0,const f32x16&p1){
  float a=max3f(p0[0],p0[1],p1[0]),b=max3f(p0[2],p0[3],p1[1]);a=max3f(a,p1[2],p1[3]);
  #pragma unroll
  for(int r=4;r<16;r+=4){a=max3f(a,p0[r],p0[r+1]);b=max3f(b,p0[r+2],p0[r+3]);a=max3f(a,p1[r],p1[r+1]);b=max3f(b,p1[r+2],p1[r+3]);}
  const float m=max2f(a,b);
  auto rr=__builtin_amdgcn_permlane32_swap(__float_as_uint(m),__float_as_uint(m),false,false);
  return max2f(__uint_as_float(rr[0]),__uint_as_float(rr[1]));
}
__device__ __forceinline__ void pv(f32x16*o,int vb,bf16x8 pa0,bf16x8 pa1,bf16x8 pa2,bf16x8 pa3){
  #pragma unroll
  for(int d0=0;d0<2;++d0){s16x4 lo[4],hi[4];
    #pragma unroll
    for(int ks=0;ks<4;++ks){
      asm volatile("ds_read_b64_tr_b16 %0,%1 offset:%c2":"=&v"(lo[ks]):"v"(vb),"i"(d0*4096+ks*1024):"memory");
      asm volatile("ds_read_b64_tr_b16 %0,%1 offset:%c2":"=&v"(hi[ks]):"v"(vb),"i"(d0*4096+ks*1024+512):"memory");}
    asm volatile("s_waitcnt lgkmcnt(0)":::"memory");SBAR();
    #define PK(k) (bf16x8){lo[k][0],lo[k][1],lo[k][2],lo[k][3],hi[k][0],hi[k][1],hi[k][2],hi[k][3]}
    o[d0]=__builtin_amdgcn_mfma_f32_32x32x16_bf16(pa0,PK(0),o[d0],0,0,0);
    o[d0]=__builtin_amdgcn_mfma_f32_32x32x16_bf16(pa1,PK(1),o[d0],0,0,0);
    o[d0]=__builtin_amdgcn_mfma_f32_32x32x16_bf16(pa2,PK(2),o[d0],0,0,0);
    o[d0]=__builtin_amdgcn_mfma_f32_32x32x16_bf16(pa3,PK(3),o[d0],0,0,0);
    #undef PK
  }
}

__device__ __forceinline__ u32x4 head_rms(u32x4 v){ float x[8];
  #pragma unroll
  for(int i=0;i<4;++i){x[2*i]=__uint_as_float(v[i]<<16);x[2*i+1]=__uint_as_float(v[i]&0xffff0000u);}
  float s=0.f;
  #pragma unroll
  for(int i=0;i<8;++i)s+=x[i]*x[i];
  s+=__shfl_xor(s,1);s+=__shfl_xor(s,2);s+=__shfl_xor(s,4);
  const float rs=__builtin_amdgcn_rsqf(s*(1.0f/64.0f)+1e-6f); u32x4 w;
  #pragma unroll
  for(int i=0;i<4;++i)w[i]=cvtpk_s(x[2*i]*rs,x[2*i+1]*rs);
  return w; }
#ifndef ATTN_STORE16
#define ATTN_STORE16(p,v) (*(u32x4*)(p)=(v))
#endif
template<int THRL> __device__ __forceinline__ void fox_unit(int b,int qb,float dthr,const bf16*Q,const bf16*__restrict__ K,const bf16*__restrict__ V,bf16*O,const float*__restrict__ csg,char*shm){
  int tid_=threadIdx.x; asm volatile("":"+v"(tid_)); const int tid=tid_,lane=tid&63,r32=lane&31,hi=lane>>5; const int wid=__builtin_amdgcn_readfirstlane(tid>>6);
  const long rowbase=(long)b*SEQ; const int q0=qb*QB;
  const bf16*Qw=Q+(rowbase+q0+wid*QBLK)*DM;
  const unsigned lds0=(unsigned)(uintptr_t)shm; const lds_cptr shm3=(lds_cptr)shm;
  float*wsf=(float*)(shm+LDS_WS)+wid*64;
  const unsigned kdst=lds0+LDS_K+wid*1024, vdst=lds0+LDS_V+wid*1024;
  #define DMA_K(t,slot) glds16(ksrc+(long)(t)*KVBLK*DM,(unsigned)__builtin_amdgcn_readfirstlane(kdst+(slot)))
  #define DMA_V(t,slot) glds16(vsrc+(long)(t)*KVBLK*DM,(unsigned)__builtin_amdgcn_readfirstlane(vdst+(slot)))
  const int vb0=(int)(lds0+LDS_V)+((lane>>4)&1)*32+(lane&3)*8+(4*hi+((lane&15)>>2))*64;
  const char*Kbase=shm+LDS_K; bf16x8 kf[8];
  const lds_cptr kp0=shm3+LDS_K+hi*1024+r32*16; const lds_cptr vp0=shm3+LDS_V+((lane>>4)&1)*32+(lane&3)*8+(4*hi+((lane&15)>>2))*64;
  typedef __attribute__((address_space(3))) float lds_f32; typedef __attribute__((address_space(3))) f32x4 lds_f32x4;
  { lds_f32*cl=(lds_f32*)(shm3+LDS_CS); const int n_=q0+QB; for(int i_=tid*4;i_<n_;i_+=2048){ const f32x4 v_=*(const f32x4*)(csg+i_); *(lds_f32x4*)(cl+i_)=v_; } }
  asm volatile("s_waitcnt vmcnt(0) lgkmcnt(0)\n\ts_barrier":::"memory");
  int j0;
  { const lds_f32*cl=(const lds_f32*)(shm3+LDS_CS); const float cq0=cl[q0]; int lo_=0,hi_=4*qb;
    while(lo_<hi_){ const int mid_=(lo_+hi_)>>1; if(cl[64*mid_+63]-cq0>=dthr)lo_=mid_+1; else hi_=mid_; }
    j0=__builtin_amdgcn_readfirstlane(lo_)&~1; }
  const bf16*Kh=K+(rowbase+(long)j0*KVBLK)*DM,*Vh=V+(rowbase+(long)j0*KVBLK)*DM;
  const bf16*ksrc=Kh+(long)lane*DM+wid*8;
  const bf16*vsrc=Vh+(long)(16*(wid&3)+(lane>>2))*DM+(wid>>2)*32+(lane&3)*8;
  const int NT=(q0+QB)/KVBLK-j0;
  const lds_f32*cl3=(const lds_f32*)(shm3+LDS_CS)+64*j0;
  DMA_K(0,0);DMA_V(0,0);DMA_K(1,SLOTB);
  bf16x8 qr[4];
  #pragma unroll
  for(int d0=0;d0<4;++d0)qr[d0]=*reinterpret_cast<const bf16x8*>(&Qw[(long)r32*DM+d0*16+hi*8]);
  float base=0.f,l_reg=0.f;f32x16 o[2];o[0]=f32x16{};o[1]=f32x16{};
  #define CINIT(C0,C1,t) do{ const lds_f32*cp_=cl3+64*(t)+4*hi; \
    _Pragma("unroll") for(int g_=0;g_<4;++g_){ const f32x4 a_=*(const lds_f32x4*)(cp_+8*g_), b_=*(const lds_f32x4*)(cp_+32+8*g_); \
      C0[4*g_]=base-a_[0];C0[4*g_+1]=base-a_[1];C0[4*g_+2]=base-a_[2];C0[4*g_+3]=base-a_[3]; \
      C1[4*g_]=base-b_[0];C1[4*g_+1]=base-b_[1];C1[4*g_+2]=base-b_[2];C1[4*g_+3]=base-b_[3]; } }while(0)
  const int qrel=wid*QBLK+r32;
  #define CMASK(P0,P1,t) do{int jb_=(t)-(NT-4); if(jb_>=0)cmask(P0,P1,jb_,qrel,hi);}while(0)
  bool resc=false;
  #define START(P0,P1) do{ const float rm=rowmax(P0,P1); resc=false; \
    { const float dl=rm; base=fsub_s(base,dl); \
      _Pragma("unroll") for(int r=0;r<16;++r){P0[r]=fsub_s(P0[r],dl);P1[r]=fsub_s(P1[r],dl);} } \
    _Pragma("unroll") for(int r=0;r<16;++r)P0[r]=__builtin_amdgcn_exp2f(P0[r]); }while(0)
  #define RESC() do{ if(resc){ asm volatile("s_waitcnt lgkmcnt(0)":::"memory"); \
      _Pragma("unroll") for(int d_=0;d_<2;++d_) _Pragma("unroll") for(int r=0;r<16;++r)o[d_][r]*=wsf[crow(r,hi)]; } }while(0)
  f32x16 pA0,pA1,pB0,pB1;
  int sl_prev=0,sl_cur=0,sl_next=SLOTB;
  #define ROT() do{sl_prev=sl_cur;sl_cur=sl_next;sl_next=(sl_next==(NSLOT-1)*SLOTB)?0:sl_next+SLOTB;}while(0)
  DMA_K(2,2*SLOTB);
  WAIT_BAR(3);
  base=cl3[q0-64*j0+wid*QBLK+r32];
  CINIT(pA0,pA1,0); qkt(pA0,pA1,Kbase,qr,r32,hi);asm volatile("s_nop 15\n\ts_nop 7":"+v"(pA0),"+v"(pA1));CMASK(pA0,pA1,0);
  START(pA0,pA1);
  _Pragma("unroll") for(int r=0;r<16;++r)pA1[r]=__builtin_amdgcn_exp2f(pA1[r]);
  WAIT_BAR(0);
  DMA_K(3,0);DMA_V(1,SLOTB);
  ROT();
  kload8(kf,kp0+sl_cur);
  WAIT_BAR(2);
  s16x4 vlo[8],vhi[8]; u32x4 pw0,pw1,pw2,pw3;
  #define PKW(P,B) cvtpk_s(P[B],P[B+1])
  #define PAF(k) __builtin_bit_cast(bf16x8,pw##k)
  #define VFR(i) (bf16x8){vlo[i][0],vlo[i][1],vlo[i][2],vlo[i][3],vhi[i][0],vhi[i][1],vhi[i][2],vhi[i][3]}
  #define PIN(x) asm volatile("":"+v"(x))
  #define MX3(a,b,c) __builtin_fmaxf(__builtin_fmaxf((a),(b)),(c))
  #define GAPA(MF,A0,A1,A2,A3,W0,W1,PW) do{ MF; sacc+=A0; sacc+=A1; sacc+=A2; sacc+=A3; PIN(sacc); W0; W1; PIN(PW); SBAR(); }while(0)
  #define EX(v) __builtin_amdgcn_exp2f(v)
  #define GAPB(MF,X,B) do{ MF; X[B]=EX(X[B]); X[B+1]=EX(X[B+1]); X[B+2]=EX(X[B+2]); X[B+3]=EX(X[B+3]); PIN(X); SBAR(); }while(0)
  #define VRD(i) do{ vlo[i]=vtr(vp_+(((i)>>2)*4096+((i)&3)*1024)); vhi[i]=vtr(vp_+(((i)>>2)*4096+((i)&3)*1024+512)); }while(0)
  #define KRD(G,j) do{ if(G){ kload2(kf,kp0+sl_next,j); SBAR(); } }while(0)
  #define STEP(C0,C1,P0,P1,t,GK,GV,GL) do{ SBAR(); CINIT(C0,C1,t); SBAR(); \
    const lds_cptr vp_=vp0+sl_prev; \
    VRD(0); SBAR(); float sacc=(P0[0]+P0[1]); \
    GAPA(C0=__builtin_amdgcn_mfma_f32_32x32x16_bf16(kf[0],qr[0],C0,0,0,0), P0[2],P0[3],P0[4],P0[5],     pw0[0]=PKW(P0,0), pw0[1]=PKW(P0,2), pw0); \
    VRD(4); SBAR(); GAPA(C1=__builtin_amdgcn_mfma_f32_32x32x16_bf16(kf[1],qr[0],C1,0,0,0), P0[6],P0[7],P0[8],P0[9],     pw0[2]=PKW(P0,4), pw0[3]=PKW(P0,6), pw0); \
    VRD(1); SBAR(); GAPA(C0=__builtin_amdgcn_mfma_f32_32x32x16_bf16(kf[2],qr[1],C0,0,0,0),   P0[10],P0[11],P0[12],P0[13], pw1[0]=PKW(P0,8), pw1[1]=PKW(P0,10), pw1); \
    VRD(5); SBAR(); GAPA(C1=__builtin_amdgcn_mfma_f32_32x32x16_bf16(kf[3],qr[1],C1,0,0,0),   P0[14],P0[15],P1[0],P1[1],   pw1[2]=PKW(P0,12),pw1[3]=PKW(P0,14), pw1); \
    VRD(2); SBAR(); GAPA(C0=__builtin_amdgcn_mfma_f32_32x32x16_bf16(kf[4],qr[2],C0,0,0,0),   P1[2],P1[3],P1[4],P1[5],     pw2[0]=PKW(P1,0), pw2[1]=PKW(P1,2), pw2); \
    VRD(6); SBAR(); GAPA(C1=__builtin_amdgcn_mfma_f32_32x32x16_bf16(kf[5],qr[2],C1,0,0,0),   P1[6],P1[7],P1[8],P1[9],     pw2[2]=PKW(P1,4), pw2[3]=PKW(P1,6), pw2); \
    VRD(3); SBAR(); GAPA(C0=__builtin_amdgcn_mfma_f32_32x32x16_bf16(kf[6],qr[3],C0,0,0,0),   P1[10],P1[11],P1[12],P1[13], pw3[0]=PKW(P1,8), pw3[1]=PKW(P1,10), pw3); \
    VRD(7); SBAR(); GAPA(C1=__builtin_amdgcn_mfma_f32_32x32x16_bf16(kf[7],qr[3],C1,0,0,0),   P1[14],P1[15],0.f,0.f,       pw3[2]=PKW(P1,12),pw3[3]=PKW(P1,14), pw3); \
    l_reg+=sacc; \
    if(GK){DMA_K((t)+3,sl_cur);} if(GV){DMA_V((t)+1,sl_next);} \
    CMASK(C0,C1,t); \
    { float a=MX3(C0[0],C0[1],C1[0]),b=MX3(C0[2],C0[3],C1[1]); a=MX3(a,C1[2],C1[3]); \
      _Pragma("unroll") for(int r=4;r<16;r+=4){a=MX3(a,C0[r],C0[r+1]);b=MX3(b,C0[r+2],C0[r+3]);a=MX3(a,C1[r],C1[r+1]);b=MX3(b,C1[r+2],C1[r+3]);} \
      float rm=__builtin_fmaxf(a,b); { auto rr=__builtin_amdgcn_permlane32_swap(__float_as_uint(rm),__float_as_uint(rm),false,false); rm=__builtin_fmaxf(__uint_as_float(rr[0]),__uint_as_float(rr[1])); } \
      resc=false; \
      if(__builtin_expect(__any(rm>(float)THRL),0)){ const float dl=__builtin_fmaxf(rm,0.f); base-=dl; \
        _Pragma("unroll") for(int r=0;r<16;++r){C0[r]-=dl;C1[r]-=dl;} \
        const float f=__builtin_amdgcn_exp2f(-dl); l_reg*=f; if(hi==0)wsf[r32]=f; resc=true; } } \
    SBAR(); \
    GAPB(o[0]=__builtin_amdgcn_mfma_f32_32x32x16_bf16(PAF(0),VFR(0),o[0],0,0,0), C0,0); \
    GAPB(o[1]=__builtin_amdgcn_mfma_f32_32x32x16_bf16(PAF(0),VFR(4),o[1],0,0,0), C0,4); \
    KRD(GL,0); GAPB(o[0]=__builtin_amdgcn_mfma_f32_32x32x16_bf16(PAF(1),VFR(1),o[0],0,0,0), C0,8); \
    KRD(GL,1); GAPB(o[1]=__builtin_amdgcn_mfma_f32_32x32x16_bf16(PAF(1),VFR(5),o[1],0,0,0), C0,12); \
    KRD(GL,2); GAPB(o[0]=__builtin_amdgcn_mfma_f32_32x32x16_bf16(PAF(2),VFR(2),o[0],0,0,0), C1,0); \
    KRD(GL,3); GAPB(o[1]=__builtin_amdgcn_mfma_f32_32x32x16_bf16(PAF(2),VFR(6),o[1],0,0,0), C1,4); \
    GAPB(o[0]=__builtin_amdgcn_mfma_f32_32x32x16_bf16(PAF(3),VFR(3),o[0],0,0,0), C1,8); \
    GAPB(o[1]=__builtin_amdgcn_mfma_f32_32x32x16_bf16(PAF(3),VFR(7),o[1],0,0,0), C1,12); \
    }while(0)
  int t=1;
  #undef CMASK
  #define CMASK(P0,P1,t) do{}while(0)
  for(;t+5<NT;t+=2){
    STEP(pB0,pB1,pA0,pA1,t,true,true,true);     WAIT_BAR(2); RESC(); ROT();
    STEP(pA0,pA1,pB0,pB1,t+1,true,true,true);   WAIT_BAR(2); RESC(); ROT();
  }
  #undef CMASK
  #define CMASK(P0,P1,t) do{int jb_=(t)-(NT-4); if(jb_>=0)cmask(P0,P1,jb_,qrel,hi);}while(0)
  #define ENDW(tt) do{ if((tt)+3<NT){WAIT_BAR(2);} else if((tt)+2<NT){WAIT_BAR(1);} else {WAIT_BAR(0);} }while(0)
  for(;t+1<NT;t+=2){
    STEP(pB0,pB1,pA0,pA1,t,(t+3<NT),(t+1<NT),(t+1<NT));       ENDW(t);   RESC(); ROT();
    STEP(pA0,pA1,pB0,pB1,t+1,(t+4<NT),(t+2<NT),(t+2<NT));     ENDW(t+1); RESC(); ROT();
  }
  STEP(pB0,pB1,pA0,pA1,NT-1,false,false,false); RESC();
  { float sacc=pB0[0]+pB0[1]; _Pragma("unroll") for(int r=2;r<16;++r)sacc+=pB0[r]; _Pragma("unroll") for(int r=0;r<16;++r)sacc+=pB1[r]; l_reg+=sacc;
    pw0=(u32x4){PKW(pB0,0),PKW(pB0,2),PKW(pB0,4),PKW(pB0,6)};pw1=(u32x4){PKW(pB0,8),PKW(pB0,10),PKW(pB0,12),PKW(pB0,14)};pw2=(u32x4){PKW(pB1,0),PKW(pB1,2),PKW(pB1,4),PKW(pB1,6)};pw3=(u32x4){PKW(pB1,8),PKW(pB1,10),PKW(pB1,12),PKW(pB1,14)};
    SBAR(); pv(o,vb0+sl_cur,PAF(0),PAF(1),PAF(2),PAF(3)); }
  #undef PKW
  #undef PAF
  #undef VFR
  #undef PIN
  #undef MX3
  #undef GAPA
  #undef GAPB
  #undef EX
  #undef VRD
  #undef KRD
  #undef STEP
  #undef ENDW
  {auto rr=__builtin_amdgcn_permlane32_swap(__float_as_uint(l_reg),__float_as_uint(l_reg),false,false);l_reg=__uint_as_float(rr[0])+__uint_as_float(rr[1]);}
  if(hi==0)wsf[32+r32]=l_reg;asm volatile("s_waitcnt lgkmcnt(0)":::"memory");
  float rli[16];
  #pragma unroll
  for(int r=0;r<16;++r)rli[r]=__builtin_amdgcn_rcpf(wsf[32+crow(r,hi)]);
  bf16*Ow=O+(rowbase+q0+wid*QBLK)*DMO;
  { bf16*stg=(bf16*)(shm+LDS_OST)+wid*2048;
    #pragma unroll
    for(int r=0;r<16;++r){const int orow=crow(r,hi);
      #pragma unroll
      for(int d0=0;d0<2;++d0)stg[orow*64+d0*32+r32]=__float2bfloat16(o[d0][r]*rli[r]);}
    asm volatile("s_waitcnt lgkmcnt(0)":::"memory");
    #pragma unroll
    for(int i=0;i<4;++i){const int row=i*8+(lane>>3),ch=lane&7; const u32x4 v=*(const u32x4*)(stg+row*64+ch*8); ATTN_STORE16(Ow+(long)row*DMO+ch*8,head_rms(v));} }
  asm volatile("s_waitcnt lgkmcnt(0)\n\ts_barrier":::"memory");
  #undef DMA_K
  #undef DMA_V
  #undef CMASK
  #undef CINIT
  #undef START
  #undef RESC
  #undef ROT
}
__device__ __forceinline__ float sp2f(float z){ const float e=__builtin_amdgcn_exp2f(-__builtin_fabsf(z)); return __builtin_fmaxf(z,0.f)+__builtin_amdgcn_logf(1.f+e); }
__device__ __forceinline__ void sb_tile(f32x16*o,float&R,const char*Kslot,int vb,const bf16x8*qr,int j,int qabs,bool unmasked,int r32,int hi){
  f32x16 p0=f32x16{},p1=f32x16{};
  qkt(p0,p1,Kslot,qr,r32,hi);
  const int kvb=64*j+4*hi; f32x16 s0,s1;
  if(unmasked){
    #pragma unroll
    for(int r=0;r<16;++r){
      const float e0=__builtin_amdgcn_exp2f(__builtin_fminf(p0[r],80.f)), e1=__builtin_amdgcn_exp2f(__builtin_fminf(p1[r],80.f));
      const float r0=__builtin_amdgcn_rcpf(1.f+e0), r1=__builtin_amdgcn_rcpf(1.f+e1);
      p0[r]=e0*r0; p1[r]=e1*r1; s0[r]=r0; s1[r]=r1; }
  } else {
    #pragma unroll
    for(int r=0;r<16;++r){ const int kv=kvb+(r&3)+8*(r>>2);
      const float e0=__builtin_amdgcn_exp2f(__builtin_fminf(p0[r],80.f)), e1=__builtin_amdgcn_exp2f(__builtin_fminf(p1[r],80.f));
      const float r0=__builtin_amdgcn_rcpf(1.f+e0), r1=__builtin_amdgcn_rcpf(1.f+e1);
      const bool v0=kv<qabs, v1=kv+32<qabs;
      p0[r]=v0?e0*r0:0.f; p1[r]=v1?e1*r1:0.f; s0[r]=v0?r0:1.f; s1[r]=v1?r1:1.f; }
  }
  float g0[4],g1[4],og0[4],og1[4],T0[4],T1[4];
  #pragma unroll
  for(int g=0;g<4;++g){ g0[g]=(s0[4*g]*s0[4*g+1])*(s0[4*g+2]*s0[4*g+3]); g1[g]=(s1[4*g]*s1[4*g+1])*(s1[4*g+2]*s1[4*g+3]); }
  #pragma unroll
  for(int g=0;g<4;++g){ og0[g]=__shfl_xor(g0[g],32); og1[g]=__shfl_xor(g1[g],32); }
  float run=R;
  #pragma unroll
  for(int g=3;g>=0;--g){ const float ah1=hi?g1[g]:og1[g], ah0=hi?og1[g]:g1[g]; const float t1=run; run*=ah1; const float t0=run; run*=ah0; T1[g]=hi?t1:t0; }
  #pragma unroll
  for(int g=3;g>=0;--g){ const float ah1=hi?g0[g]:og0[g], ah0=hi?og0[g]:g0[g]; const float t1=run; run*=ah1; const float t0=run; run*=ah0; T0[g]=hi?t1:t0; }
  R=run;
  #pragma unroll
  for(int g=0;g<4;++g){ float a0=T0[g],a1=T1[g];
    #pragma unroll
    for(int i=3;i>=0;--i){ const int r=4*g+i; p0[r]*=a0; p1[r]*=a1; a0*=s0[r]; a1*=s1[r]; } }
  u32x4 pw0,pw1,pw2,pw3;
  pw0=(u32x4){cvtpk_s(p0[0],p0[1]),cvtpk_s(p0[2],p0[3]),cvtpk_s(p0[4],p0[5]),cvtpk_s(p0[6],p0[7])};
  pw1=(u32x4){cvtpk_s(p0[8],p0[9]),cvtpk_s(p0[10],p0[11]),cvtpk_s(p0[12],p0[13]),cvtpk_s(p0[14],p0[15])};
  pw2=(u32x4){cvtpk_s(p1[0],p1[1]),cvtpk_s(p1[2],p1[3]),cvtpk_s(p1[4],p1[5]),cvtpk_s(p1[6],p1[7])};
  pw3=(u32x4){cvtpk_s(p1[8],p1[9]),cvtpk_s(p1[10],p1[11]),cvtpk_s(p1[12],p1[13]),cvtpk_s(p1[14],p1[15])};
  pv(o,vb,__builtin_bit_cast(bf16x8,pw0),__builtin_bit_cast(bf16x8,pw1),__builtin_bit_cast(bf16x8,pw2),__builtin_bit_cast(bf16x8,pw3));
}
__device__ __forceinline__ void sb_unit(int b,int qb,const bf16*Q,const bf16*__restrict__ K,const bf16*__restrict__ V,bf16*O,char*shm){
  int tid_=threadIdx.x; asm volatile("":"+v"(tid_)); const int tid=tid_,lane=tid&63,r32=lane&31,hi=lane>>5; const int wid=__builtin_amdgcn_readfirstlane(tid>>6);
  const long rowbase=(long)b*SEQ; const int q0=qb*QB;
  const bf16*Qw=Q+(rowbase+q0+wid*QBLK)*DM;
  const bf16*Kh=K+rowbase*DM,*Vh=V+rowbase*DM;
  const unsigned lds0=(unsigned)(uintptr_t)shm; const lds_cptr shm3=(lds_cptr)shm;
  const bf16*ksrc=Kh+(long)lane*DM+wid*8;
  const bf16*vsrc=Vh+(long)(16*(wid&3)+(lane>>2))*DM+(wid>>2)*32+(lane&3)*8;
  const unsigned kdst=lds0+LDS_K+wid*1024, vdst=lds0+LDS_V+wid*1024;
  constexpr int FASTV=65536;
  const unsigned kdstF=lds0+wid*1024, vdstF=lds0+FASTV+wid*1024;
  #define DMA_K(t,slot) glds16(ksrc+(long)(t)*KVBLK*DM,(unsigned)__builtin_amdgcn_readfirstlane(kdst+(slot)))
  #define DMA_V(t,slot) glds16(vsrc+(long)(t)*KVBLK*DM,(unsigned)__builtin_amdgcn_readfirstlane(vdst+(slot)))
  const int vlane=((lane>>4)&1)*32+(lane&3)*8+(4*hi+((lane&15)>>2))*64;
  const int vb0=(int)(lds0+LDS_V)+vlane, vbF=(int)(lds0+FASTV)+vlane;
  typedef __attribute__((address_space(3))) unsigned lds_u32;
  volatile lds_u32*flags=(volatile lds_u32*)(shm3+131072+1024)    ;
  bf16x8 qr[4];
  #pragma unroll
  for(int d0=0;d0<4;++d0)qr[d0]=*reinterpret_cast<const bf16x8*>(&Qw[(long)r32*DM+d0*16+hi*8]);
  asm volatile("":::"memory");
  f32x16 o[2];o[0]=f32x16{};o[1]=f32x16{};
  float R=1.f; const int qabs=q0+wid*QBLK+r32; bool done=false;
#ifndef SB_FAST_TILES
#define SB_FAST_TILES 8
#endif
  static_assert(SB_FAST_TILES>=4&&SB_FAST_TILES<=8,"the fallback assumes every tile it visits lies wholly below the unit's rows (>= 4 staged tiles); 8 tiles fill the 128 KiB");
  const int jtop=4*qb+3, jlow=(jtop-(SB_FAST_TILES-1)>0)?jtop-(SB_FAST_TILES-1):0;
  for(int i=0;i<=jtop-jlow;++i){ glds16(ksrc+(long)(jtop-i)*KVBLK*DM,(unsigned)__builtin_amdgcn_readfirstlane(kdstF+i*SLOTB)); glds16(vsrc+(long)(jtop-i)*KVBLK*DM,(unsigned)__builtin_amdgcn_readfirstlane(vdstF+i*SLOTB)); }
  WAIT_BAR(0);
  for(int j=(q0+wid*QBLK+30)>>6;j>=jlow&&!done;--j){ const int i=jtop-j;
    sb_tile(o,R,shm+i*SLOTB,vbF+i*SLOTB,qr,j,qabs,64*j+63<q0+wid*QBLK,r32,hi);
    done=__all(R<1.0e-37f)!=0; }
  if(lane==0)flags[16+wid]=(done||jlow==0)?1u:0u;
  asm volatile("s_waitcnt lgkmcnt(0)\n\ts_barrier":::"memory");
  unsigned fin=1u;
  #pragma unroll
  for(int w=0;w<NW;++w)fin&=flags[16+w];
  if(!fin){
    const int js=jlow-1;
    DMA_K(js,0);DMA_V(js,0); if(js>=1){ DMA_K(js-1,SLOTB);DMA_V(js-1,SLOTB); }
    int slot=0,slot2=2*SLOTB,bank=0;
    for(int j=js;j>=0;--j){
      if(j>0){ WAIT_BAR(2); } else { WAIT_BAR(0); }
      if(j<js){ unsigned alld=1u;
        #pragma unroll
        for(int w=0;w<NW;++w)alld&=flags[(bank^8)+w];
        if(alld)break; }
      if(j>=2){ DMA_K(j-2,slot2);DMA_V(j-2,slot2); }
      if(!done){ sb_tile(o,R,shm+LDS_K+slot,vb0+slot,qr,j,qabs,true,r32,hi); done=__all(R<1.0e-37f)!=0; }
      if(lane==0)flags[bank+wid]=done?1u:0u;
      bank^=8; slot=(slot==2*SLOTB)?0:slot+SLOTB; slot2=(slot2==2*SLOTB)?0:slot2+SLOTB;
    }
    asm volatile("s_waitcnt vmcnt(0)":::"memory");
  }
  bf16*Ow=O+(rowbase+q0+wid*QBLK)*DMO;
  { bf16*stg=(bf16*)(shm+LDS_OST)+wid*2048;
    #pragma unroll
    for(int r=0;r<16;++r){const int orow=crow(r,hi);
      #pragma unroll
      for(int d0=0;d0<2;++d0)stg[orow*64+d0*32+r32]=__float2bfloat16(o[d0][r]);}
    asm volatile("s_waitcnt lgkmcnt(0)":::"memory");
    #pragma unroll
    for(int i=0;i<4;++i){const int row=i*8+(lane>>3),ch=lane&7; const u32x4 v=*(const u32x4*)(stg+row*64+ch*8); ATTN_STORE16(Ow+(long)row*DMO+ch*8,head_rms(v));} }
  asm volatile("s_waitcnt vmcnt(0) lgkmcnt(0)\n\ts_barrier":::"memory");
  #undef DMA_K
  #undef DMA_V
}
#undef SBAR
#undef WAIT_BAR
}
namespace cg = cooperative_groups;
constexpr int NWAVES = 8;
constexpr int DMODEL = 1024, NBATCH = 4, SEQ_IN = 8192, NMETA = 16, LREAL = NMETA + SEQ_IN, LP = 8448  ;
constexpr int MROWS = NBATCH * LP;
constexpr int MREAL = NBATCH * SEQ_IN;
constexpr int INW = 2566, NINP = 2560, NIN = 2816, DFF = 2816, NGU = 2 * DFF, DEPTH = 2, NFH = 6;
constexpr float C2F = 0.125f * 1.4426950408889634f;
constexpr int PC_U = 0, PC_FQ = 256, PC_FK = 640, PC_FV = 1024, PC_SQ = 1408, PC_SK = 1792, PC_SV = 2176;
constexpr size_t MiB = 1u << 20;
constexpr size_t WS_CTL = 0, CTL_ZERO_BYTES = 1 * MiB;
constexpr size_t WS_SS = 64 * 1024;
constexpr size_t WS_W = 1 * MiB, W_LAYER = 24 * MiB, W_IN = 0, W_OUT = (size_t)NIN * 1024 * 2, W_GU = W_OUT + 2 * MiB, W_D = W_GU + (size_t)NGU * 1024 * 2;
constexpr size_t WS_LF = 49 * MiB, WS_CS = 51 * MiB, WS_H = 52 * MiB, WS_HB = 184 * MiB, WS_Y = 250 * MiB, WS_P = 316 * MiB, WS_END = WS_P + (size_t)MROWS * DFF * 2;
static_assert(W_D + (size_t)1024 * DFF * 2 <= W_LAYER && WS_W + 2 * W_LAYER <= WS_LF && WS_SS + 5 * (size_t)MROWS * 4 <= CTL_ZERO_BYTES, "ws map");
static_assert(WS_H + (size_t)MROWS * 1024 * 4 <= WS_HB && WS_HB + (size_t)MROWS * 1024 * 2 <= WS_Y && WS_Y + (size_t)MROWS * 1024 * 2 <= WS_P && WS_END <= 512 * MiB, "ws map");
constexpr int LDS_BYTES = 147456;
constexpr int LDS_MISC = 131072;

#define LAS __attribute__((address_space(3)))
typedef unsigned short bf16u;
typedef unsigned v4u __attribute__((ext_vector_type(4)));
typedef float f32x4 __attribute__((ext_vector_type(4)));
#define LDS_WAIT() asm volatile("s_waitcnt lgkmcnt(0)" ::: "memory")
__device__ __forceinline__ unsigned f2bf(float f) { unsigned u = __builtin_bit_cast(unsigned, f); return (u + 0x7fffu + ((u >> 16) & 1u)) >> 16; }
__device__ __forceinline__ unsigned pk2(float lo, float hi) { return f2bf(lo) | (f2bf(hi) << 16); }
__device__ __forceinline__ float wave_sum(float v) {
#pragma unroll
    for (int o = 1; o < 64; o <<= 1) v += __shfl_xor(v, o);
    return v;
}

struct Args { const float* in[15]; float* out; unsigned char* ws; };

struct WinSrc { const float* w; const float* g;
    __device__ __forceinline__ float operator()(int k, int n) const { if (n >= INW) return 0.f; const int col = n < 1408 ? n : (n < 2560 ? n + 6 : n - 2560 + 1408);
        const float sc = ((n >= PC_FQ && n < PC_FK) || (n >= PC_SQ && n < PC_SK)) ? C2F : 1.0f; return w[(size_t)k * INW + col] * g[k] * sc; } };
struct WoutSrc { const float* w; const float* fg; const float* sg;
    __device__ __forceinline__ float operator()(int k, int n) const { const float gn = k < 640 ? fg[k - 256] : sg[k - 640]; return w[(size_t)k * 1024 + n] * gn; } };
struct WguSrc { const float* wg; const float* wu; const float* g;
    __device__ __forceinline__ float operator()(int k, int c) const { const int pn = c >> 8, w = c & 255, j = pn * 128 + (w & 127); const long dlt = (w >> 7) ? (long)(wu - wg) : 0L; return wg[(long)k * DFF + j + dlt] * g[k]; } };
struct WdSrc { const float* w;
    __device__ __forceinline__ float operator()(int k, int n) const { return w[(size_t)k * 1024 + n]; } };
template <class F> __device__ __forceinline__ void conv_item(const F src, bf16u* WT, int K, int k0, int n0, LAS float* scr, int lane) {
    float tv[32];
#pragma unroll
    for (int i = 0; i < 32; ++i) tv[i] = src(k0 + 2 * i + (lane >> 5), n0 + (lane & 31));
#pragma unroll
    for (int i = 0; i < 32; ++i) scr[(2 * i + (lane >> 5)) * 33 + (lane & 31)] = tv[i];
    LDS_WAIT(); asm volatile("" ::: "memory");
    const int c = lane & 7;
#pragma unroll
    for (int j = 0; j < 4; ++j) { const int n = (lane >> 3) + 8 * j; const LAS float* s = scr + (8 * c) * 33 + n;
        v4u o; o.x = pk2(s[0 * 33], s[1 * 33]); o.y = pk2(s[2 * 33], s[3 * 33]); o.z = pk2(s[4 * 33], s[5 * 33]); o.w = pk2(s[6 * 33], s[7 * 33]);
        *(v4u*)(WT + (size_t)(n0 + n) * K + k0 + 8 * c) = o; }
    LDS_WAIT(); asm volatile("" ::: "memory");
}
__device__ __forceinline__ void fold_block_item(const float* wout, const float* pw, const float* ps, bf16u* WT, int item, LAS float* lds, int tid) {
    const int g = item >> 4, n0 = (item & 15) * 64;
    LAS float* At = lds; LAS float* Wt = lds + 4096;
    for (int i = tid; i < 4096; i += NWAVES * 64) { At[(i & 63) * 64 + (i >> 6)] = pw[(size_t)g * 4096 + i]; const int d = i >> 6; Wt[i] = wout[(size_t)(g * 64 + d) * 1024 + n0 + (i & 63)] * ps[g * 64 + d]; }
    __syncthreads();
    const int c0 = (tid >> 6) * 8, nn = tid & 63; f32x4 a0 = (f32x4){0.f, 0.f, 0.f, 0.f}, a1 = a0;
#pragma unroll 8
    for (int d = 0; d < 64; ++d) { const float w = Wt[d * 64 + nn]; a0 += *(const LAS f32x4*)(At + d * 64 + c0) * w; a1 += *(const LAS f32x4*)(At + d * 64 + c0 + 4) * w; }
    v4u o; o.x = pk2(a0[0], a0[1]); o.y = pk2(a0[2], a0[3]); o.z = pk2(a1[0], a1[1]); o.w = pk2(a1[2], a1[3]);
    *(v4u*)(WT + (size_t)(n0 + nn) * 1024 + g * 64 + c0) = o;
    __syncthreads();
}
__device__ __forceinline__ void p0_prologue(const Args& A, unsigned char* ws, LAS unsigned char* lds, int wave, int lane) {
    LAS float* scr = (LAS float*)(lds + wave * 16384);
    const int gw = blockIdx.x * NWAVES + wave, NGW = gridDim.x * NWAVES;
    constexpr int I_IN = 16 * (NIN / 32), I_OUT = 12 * 32, I_GU = 16 * (NGU / 32), I_D = (DFF / 64) * 32, I_L = I_IN + I_OUT + I_GU + I_D;
    for (int bi = blockIdx.x; bi < DEPTH * 64; bi += gridDim.x) { const int L = bi >> 6;
        fold_block_item(A.in[9] + (size_t)L * 1024 * 1024, A.in[5] + (size_t)L * 4 * 64 * 64, A.in[6] + L * 256, (bf16u*)(ws + WS_W + (size_t)L * W_LAYER + W_OUT), bi & 63, (LAS float*)lds, wave * 64 + lane); }
    for (int it = gw; it < DEPTH * I_L; it += NGW) {
        const int L = it / I_L; int r = it % I_L;
        bf16u* wb = (bf16u*)(ws + WS_W + (size_t)L * W_LAYER);
        if (r < I_IN) { WinSrc s{A.in[3] + (size_t)L * 1024 * INW, A.in[2] + L * 1024}; conv_item(s, (bf16u*)((unsigned char*)wb + W_IN), 1024, (r / (NIN / 32)) * 64, (r % (NIN / 32)) * 32, scr, lane); continue; } r -= I_IN;
        if (r < I_OUT) { WoutSrc s{A.in[9] + (size_t)L * 1024 * 1024, A.in[7] + L * 384, A.in[8] + L * 384}; conv_item(s, (bf16u*)((unsigned char*)wb + W_OUT), 1024, 256 + (r / 32) * 64, (r % 32) * 32, scr, lane); continue; } r -= I_OUT;
        if (r < I_GU) { WguSrc s{A.in[11] + (size_t)L * 1024 * DFF, A.in[12] + (size_t)L * 1024 * DFF, A.in[10] + L * 1024}; conv_item(s, (bf16u*)((unsigned char*)wb + W_GU), 1024, (r / (NGU / 32)) * 64, (r % (NGU / 32)) * 32, scr, lane); continue; } r -= I_GU;
        { WdSrc s{A.in[13] + (size_t)L * DFF * 1024}; conv_item(s, (bf16u*)((unsigned char*)wb + W_D), DFF, (r / 32) * 64, (r % 32) * 32, scr, lane); }
    }
    bf16u* hb = (bf16u*)(ws + WS_HB); float* ss0 = (float*)(ws + WS_SS);
    for (int m0 = gw * 4; m0 < MROWS; m0 += NGW * 4) {
        f32x4 v[4][4]; float s[4];
#pragma unroll
        for (int q = 0; q < 4; ++q) { const int m = m0 + q, b = m / LP, t = m % LP; s[q] = 0.f;
            if (t < LREAL) { const f32x4* src = (const f32x4*)(t < NMETA ? A.in[1] + (size_t)t * 1024 : A.in[0] + ((size_t)b * SEQ_IN + (t - NMETA)) * 1024) + lane;
#pragma unroll
                for (int j = 0; j < 4; ++j) v[q][j] = src[64 * j]; }
            else {
#pragma unroll
                for (int j = 0; j < 4; ++j) v[q][j] = (f32x4){0.f, 0.f, 0.f, 0.f}; } }
#pragma unroll
        for (int q = 0; q < 4; ++q) { const int m = m0 + q;
#pragma unroll
            for (int j = 0; j < 4; ++j) s[q] += (v[q][j].x * v[q][j].x + v[q][j].y * v[q][j].y) + (v[q][j].z * v[q][j].z + v[q][j].w * v[q][j].w);
            s[q] = wave_sum(s[q]);
            unsigned long long* bo = (unsigned long long*)(hb + (size_t)m * 1024) + lane;
#pragma unroll
            for (int j = 0; j < 4; ++j) bo[64 * j] = (unsigned long long)pk2(v[q][j].x, v[q][j].y) | ((unsigned long long)pk2(v[q][j].z, v[q][j].w) << 32);
            if (lane == 0) ss0[m] = s[q]; }
    }
}
typedef short bf16x8m __attribute__((ext_vector_type(8)));
template <int NBK> __device__ __forceinline__ void mini_item(f32x4 (&acc)[NBK], const bf16u* A16, const bf16u* Bt0, const bf16u* Bt1, int K, LAS unsigned char* lds, int wave, int lane) {
    const int fr = lane & 15, fq = lane >> 4, kw = K >> 3; const size_t o = (size_t)fr * K + wave * kw + 8 * fq;
#pragma unroll
    for (int nb = 0; nb < NBK; ++nb) acc[nb] = (f32x4){0.f, 0.f, 0.f, 0.f};
    for (int k = 0; k < kw; k += 32) { const bf16x8m a = *(const bf16x8m*)(A16 + o + k); const bf16x8m b0 = *(const bf16x8m*)(Bt0 + o + k);
        acc[0] = __builtin_amdgcn_mfma_f32_16x16x32_bf16(b0, a, acc[0], 0, 0, 0);
        if (NBK == 2) { const bf16x8m b1 = *(const bf16x8m*)(Bt1 + o + k); acc[NBK - 1] = __builtin_amdgcn_mfma_f32_16x16x32_bf16(b1, a, acc[NBK - 1], 0, 0, 0); } }
    LAS f32x4* red = (LAS f32x4*)lds;
#pragma unroll
    for (int nb = 0; nb < NBK; ++nb) red[(nb * 8 + wave) * 64 + lane] = acc[nb];
    __syncthreads();
    if (wave == 0) {
#pragma unroll
        for (int nb = 0; nb < NBK; ++nb) { f32x4 s = red[(nb * 8) * 64 + lane];
#pragma unroll
            for (int w = 1; w < 8; ++w) s += red[(nb * 8 + w) * 64 + lane];
            acc[nb] = s; } }
    __syncthreads();
}
__device__ __forceinline__ void mini_in(unsigned char* ws, const bf16u* wt, const float* ss, const float* fb, LAS unsigned char* lds, int wave, int lane) {
    const bf16u* A16 = (const bf16u*)(ws + WS_HB); bf16u* P = (bf16u*)(ws + WS_P); float* LF = (float*)(ws + WS_LF);
    for (int it = blockIdx.x; it < 161; it += gridDim.x) { const int n0 = it * 16; f32x4 acc[1];
        mini_item<1>(acc, A16, wt + (size_t)n0 * 1024, nullptr, 1024, lds, wave, lane);
        if (wave == 0) { const int fr = lane & 15, fq = lane >> 4; const float rs = __builtin_amdgcn_rsqf(ss[fr] * (1.0f / 1024.0f) + 1e-6f); const f32x4 v = acc[0] * rs;
            if (n0 < NINP) { const unsigned long long w = (unsigned long long)pk2(v[0], v[1]) | ((unsigned long long)pk2(v[2], v[3]) << 32);
#pragma unroll
                for (int b = 0; b < NBATCH; ++b) *(unsigned long long*)(P + ((size_t)b * LP + fr) * NINP + n0 + 4 * fq) = w; }
            else if (fq < 2) { f32x4 l;
#pragma unroll
                for (int i = 0; i < 4; ++i) { const int c = 4 * fq + i; const float x = v[i] + fb[c < NFH ? c : 0]; l[i] = c < NFH ? -(fmaxf(-x, 0.f) + log1pf(expf(-fabsf(x)))) * 1.4426950408889634f : 0.f; }
#pragma unroll
                for (int b = 0; b < NBATCH; ++b) *(f32x4*)(LF + ((size_t)b * LP + fr) * 8 + 4 * fq) = l; } }
    }
}
__device__ __forceinline__ void mini_res(unsigned char* ws, const bf16u* A16, const bf16u* wt, int K, float* ssn, LAS unsigned char* lds, int wave, int lane) {
    bf16u* hb = (bf16u*)(ws + WS_HB);
    for (int it = blockIdx.x; it < 64; it += gridDim.x) { const int n0 = it * 16; f32x4 acc[1];
        mini_item<1>(acc, A16, wt + (size_t)n0 * K, nullptr, K, lds, wave, lane);
        if (wave == 0) { const int fr = lane & 15, fq = lane >> 4; unsigned long long* bp = (unsigned long long*)(hb + (size_t)fr * 1024 + n0 + 4 * fq); const unsigned long long r = *bp; const unsigned rl = (unsigned)r, rh = (unsigned)(r >> 32);
            const f32x4 a = (f32x4){__uint_as_float(rl << 16), __uint_as_float(rl & 0xffff0000u), __uint_as_float(rh << 16), __uint_as_float(rh & 0xffff0000u)} + acc[0];
            *bp = (unsigned long long)pk2(a[0], a[1]) | ((unsigned long long)pk2(a[2], a[3]) << 32);
            float s = (a[0] * a[0] + a[1] * a[1]) + (a[2] * a[2] + a[3] * a[3]); s += __shfl_xor(s, 16); s += __shfl_xor(s, 32);
            if (fq == 0) atomicAdd(ssn + fr, s); }
    }
}
__device__ __forceinline__ void mini_gu(unsigned char* ws, const bf16u* wt, const float* ss, LAS unsigned char* lds, int wave, int lane) {
    const bf16u* A16 = (const bf16u*)(ws + WS_HB); bf16u* H = (bf16u*)(ws + WS_P);
    for (int it = blockIdx.x; it < DFF / 16; it += gridDim.x) { const int j0 = it * 16, cg = (j0 >> 7) * 256 + (j0 & 127); f32x4 acc[2];
        mini_item<2>(acc, A16, wt + (size_t)cg * 1024, wt + (size_t)(cg + 128) * 1024, 1024, lds, wave, lane);
        if (wave == 0) { const int fr = lane & 15, fq = lane >> 4; const float rs = __builtin_amdgcn_rsqf(ss[fr] * (1.0f / 1024.0f) + 1e-6f); float o[4];
#pragma unroll
            for (int i = 0; i < 4; ++i) { const float g = acc[0][i] * rs, up = acc[1][i] * rs; o[i] = g * __builtin_amdgcn_rcpf(1.0f + __builtin_amdgcn_exp2f(-1.4426950408889634f * g)) * up; }
            *(unsigned long long*)(H + (size_t)fr * DFF + j0 + 4 * fq) = (unsigned long long)pk2(o[0], o[1]) | ((unsigned long long)pk2(o[2], o[3]) << 32); }
    }
}
__device__ __forceinline__ void fl_phase(unsigned char* ws, const bf16u* wt  , const float* ss, const float* fb, int wave, int lane) {
    const bf16u* HBp = (const bf16u*)(ws + WS_HB); float* LF = (float*)(ws + WS_LF);
    const int fr = lane & 15, fq = lane >> 4;
    for (int it = blockIdx.x * NWAVES + wave; it < MREAL / 16; it += gridDim.x * NWAVES) {
        const int m0 = it * 16, row0 = (m0 / SEQ_IN) * LP + NMETA + (m0 % SEQ_IN);
        const bf16u* ap = HBp + (size_t)(row0 + fr) * 1024 + 8 * fq; const bf16u* bp = wt + (size_t)fr * 1024 + 8 * fq;
        f32x4 acc = (f32x4){0.f, 0.f, 0.f, 0.f};
#pragma unroll 16
        for (int k = 0; k < 1024; k += 32) { const bf16x8m a = *(const bf16x8m*)(ap + k); const bf16x8m b = *(const bf16x8m*)(bp + k); acc = __builtin_amdgcn_mfma_f32_16x16x32_bf16(b, a, acc, 0, 0, 0); }
        if (fq < 2) { const int row = row0 + fr; const float rs = __builtin_amdgcn_rsqf(ss[row] * (1.0f / 1024.0f) + 1e-6f); f32x4 l;
#pragma unroll
            for (int i = 0; i < 4; ++i) { const int c = 4 * fq + i; const float x = acc[i] * rs + fb[c < NFH ? c : 0]; l[i] = c < NFH ? -(fmaxf(-x, 0.f) + log1pf(expf(-fabsf(x)))) * 1.4426950408889634f : 0.f; }
            *(f32x4*)(LF + (size_t)row * 8 + 4 * fq) = l; }
    }
}
__device__ __forceinline__ void pool_scan_phase(unsigned char* ws, LAS unsigned char* lds, unsigned* nrm, int tid, int wave, int lane) {
    const float* LF = (const float*)(ws + WS_LF); float* CS = (float*)(ws + WS_CS);
    if (blockIdx.x < NBATCH * NFH) {
        const int b = blockIdx.x / NFH, hf = blockIdx.x % NFH; constexpr int PER = 17;
        const float* lf = LF + (size_t)b * LP * 8 + hf; float* cs = CS + (size_t)(b * NFH + hf) * LP;
        float v[PER]; float s = 0.f; const int t0 = tid * PER;
#pragma unroll
        for (int i = 0; i < PER; ++i) { const int t = t0 + i; const float x = t < LREAL ? lf[(size_t)t * 8] : 0.f; s += x; v[i] = s; }
        float incl = s;
#pragma unroll
        for (int o = 1; o < 64; o <<= 1) { const float n = __shfl_up(incl, o); if (lane >= o) incl += n; }
        LAS float* wsum = (LAS float*)(lds + LDS_MISC + 256);
        if (lane == 63) wsum[wave] = incl;
        __syncthreads();
        float off = 0.f;
        for (int w = 0; w < wave; ++w) off += wsum[w];
        const float excl = off + incl - s;
#pragma unroll
        for (int i = 0; i < PER; ++i) { const int t = t0 + i; if (t < LREAL) cs[t] = excl + v[i]; }
        __syncthreads();
    }
    const bf16u* P = (const bf16u*)(ws + WS_P); bf16u* Y = (bf16u*)(ws + WS_Y);
    LAS float* nsc_ = (LAS float*)(lds + LDS_MISC + 512);
#ifndef NO_NORMS
    for (int sl = blockIdx.x; sl < 256; sl += gridDim.x) {
        if (tid < 480) { const int sub = tid / 96, task = tid % 96, which = task / 48, head = (task % 48) >> 3, chunk = task & 7; const int r0 = sl * (MROWS / 256), b = r0 / LP;
            const bf16u* src = P + (which ? PC_FK : PC_FQ) + head * 64 + chunk * 8; float mx = 0.f;
            v4u wq[27];
#pragma unroll
            for (int i = 0; i < 27; ++i) { const int r = sub + 5 * i; wq[i] = (r < MROWS / 256 && (r0 + r) % LP < LREAL) ? *(const v4u*)(src + (size_t)(r0 + r) * NINP) : (v4u){0u, 0u, 0u, 0u}; }
#pragma unroll
            for (int i = 0; i < 27; ++i) { float s = 0.f;
#pragma unroll
                for (int e = 0; e < 4; ++e) { const float lo = __uint_as_float(wq[i][e] << 16), hi = __uint_as_float(wq[i][e] & 0xffff0000u); s += lo * lo + hi * hi; }
                s += __shfl_xor(s, 1); s += __shfl_xor(s, 2); s += __shfl_xor(s, 4); mx = fmaxf(mx, s); }
            if (chunk == 0) nsc_[sub * 12 + head * 2 + which] = mx; }
        __syncthreads();
        if (tid < 12) { const int b = (sl * (MROWS / 256)) / LP; float mx = nsc_[tid];
#pragma unroll
            for (int s5 = 1; s5 < 5; ++s5) mx = fmaxf(mx, nsc_[s5 * 12 + tid]);
            atomicMax(nrm + b * NFH * 2 + tid, __float_as_uint(mx)); }
        __syncthreads();
    }
#endif
}
__device__ __forceinline__ void pool_chunk(unsigned char* ws, int c, int tid) {
    const bf16u* P = (const bf16u*)(ws + WS_P); bf16u* Y = (bf16u*)(ws + WS_Y);
    const int rsub = tid >> 5, ch = (tid & 31) * 8, win = 2 << (ch >> 6);
    {
        const int rg = c * 64 + rsub * 4, t0 = rg % LP;
        v4u wv[19];
#pragma unroll
        for (int j = 0; j < 19; ++j) { const int back = 15 - j;
            wv[j] = (back < win && t0 - back >= 0) ? *(const v4u*)(P + (size_t)(rg - back) * NINP + PC_U + ch) : (v4u){0u, 0u, 0u, 0u}; }
#pragma unroll
        for (int i = 0; i < 4; ++i) { const int t = t0 + i, cnt = (t + 1 < win) ? t + 1 : win; float acc[8];
#pragma unroll
            for (int e = 0; e < 8; ++e) acc[e] = 0.f;
#pragma unroll
            for (int k = 0; k < 16; ++k) { if (k < cnt) {
#pragma unroll
                for (int e = 0; e < 4; ++e) { acc[2 * e] += __uint_as_float(wv[15 + i - k][e] << 16); acc[2 * e + 1] += __uint_as_float(wv[15 + i - k][e] & 0xffff0000u); } } }
            const float inv = 1.0f / (float)cnt; v4u o;
#pragma unroll
            for (int e = 0; e < 4; ++e) o[e] = pk2(acc[2 * e] * inv - __uint_as_float(wv[15 + i][e] << 16), acc[2 * e + 1] * inv - __uint_as_float(wv[15 + i][e] & 0xffff0000u));
            *(v4u*)(Y + (size_t)(rg + i) * 1024 + ch) = o; }
    }
}
__device__ __forceinline__ void attn_phase(unsigned char* ws, unsigned char* lds_g, unsigned* ctr, const unsigned* nrm, int tid) {
    const attn_body::bf16* P = (const attn_body::bf16*)(ws + WS_P); attn_body::bf16* Y = (attn_body::bf16*)(ws + WS_Y); const float* CS = (const float*)(ws + WS_CS);
    volatile LAS unsigned* bw = (volatile LAS unsigned*)((LAS unsigned char*)lds_g + LDS_MISC);
    constexpr int NU = NBATCH * NFH * (LP / 256);
    for (;;) {
        if (tid == 0) bw[0] = atomicAdd(ctr, 1u);
        __syncthreads();
        const int it = (int)bw[0];
        __syncthreads();
        if (it >= 2 * NU + MROWS / 64) break;
#ifdef PROBE
        if (it == 2 * NU && tid == 0) ((volatile unsigned long long*)(ws + WS_CTL + 8192))[22 + (ctr != (unsigned*)(ws + WS_CTL))] = __builtin_amdgcn_s_memrealtime();
#endif
        if (it >= 2 * NU) { pool_chunk(ws, it - 2 * NU, tid); continue; }
#ifdef PROBE
        if (it == NU && tid == 0) ((volatile unsigned long long*)(ws + WS_CTL + 8192))[20 + (ctr != (unsigned*)(ws + WS_CTL))] = __builtin_amdgcn_s_memrealtime();
#endif
        constexpr int NF1 = 17 * NBATCH * NFH;
        const bool is_fox = it < NF1 || it >= NF1 + NU; const int r = it < NF1 ? it : (it < NF1 + NU ? it - NF1 : it - NU); const int qb = (LP / 256 - 1) - r / (NBATCH * NFH), bh = r % (NBATCH * NFH), b = bh / NFH, h = bh % NFH;
#ifndef NO_FOX
        if (is_fox) attn_body::fox_unit<16>(b, qb, 154.0f + 2.0f * sqrtf(__uint_as_float(nrm[bh * 2]) * __uint_as_float(nrm[bh * 2 + 1])), P + PC_FQ + h * 64, P + PC_FK + h * 64, P + PC_FV + h * 64, Y + 256 + h * 64, CS + (size_t)bh * LP, (char*)lds_g);
#endif
#ifndef NO_SB
        if (!is_fox) attn_body::sb_unit(b, qb, P + PC_SQ + h * 64, P + PC_SK + h * 64, P + PC_SV + h * 64, Y + 640 + h * 64, (char*)lds_g);
#endif
    }
}
__device__ __forceinline__ void final_phase(const Args& A, unsigned char* ws, int wave, int lane) {
    const bf16u* hb = (const bf16u*)(ws + WS_HB); const float* ss = (const float*)(ws + WS_SS) + 4 * (size_t)MROWS; const f32x4* g = (const f32x4*)A.in[14] + lane;
    const int gw = blockIdx.x * NWAVES + wave, NGW = gridDim.x * NWAVES;
    f32x4 gv[4];
#pragma unroll
    for (int j = 0; j < 4; ++j) gv[j] = g[64 * j];
    for (int m0 = gw * 2; m0 < NBATCH * SEQ_IN; m0 += NGW * 2) {
        unsigned long long r[2][4]; float rs[2];
#pragma unroll
        for (int q = 0; q < 2; ++q) { const int m = m0 + q, b = m / SEQ_IN, s = m % SEQ_IN; const size_t row = (size_t)b * LP + NMETA + s;
            rs[q] = 1.0f / sqrtf(ss[row] * (1.0f / 1024.0f) + 1e-6f);
            const unsigned long long* src = (const unsigned long long*)(hb + row * 1024) + lane;
#pragma unroll
            for (int j = 0; j < 4; ++j) r[q][j] = src[64 * j]; }
#pragma unroll
        for (int q = 0; q < 2; ++q) { f32x4* dst = (f32x4*)(A.out + (size_t)(m0 + q) * 1024) + lane;
#pragma unroll
            for (int j = 0; j < 4; ++j) { const unsigned rl = (unsigned)r[q][j], rh = (unsigned)(r[q][j] >> 32);
                dst[64 * j] = (f32x4){__uint_as_float(rl << 16), __uint_as_float(rl & 0xffff0000u), __uint_as_float(rh << 16), __uint_as_float(rh & 0xffff0000u)} * rs[q] * gv[j]; } }
    }
}

#define XB_TMO      128
#define XB_XCNT(j)  (256  + 64 * (j))
#define XB_XSUB(j)  (1280 + 64 * (j))
#define XB_XGEN(j)  (2304 + 64 * (j))
#define XB_TOP      3328
#define XB_TOPGEN   3392
#define XCD_BAR_WORDS 3456
#define XB_SPIN_CAP (1u << 18)

__device__ __forceinline__ unsigned xb_ld(unsigned* p)              { return __hip_atomic_load(p, __ATOMIC_RELAXED, __HIP_MEMORY_SCOPE_AGENT); }
__device__ __forceinline__ unsigned xb_add(unsigned* p, unsigned v) { return __hip_atomic_fetch_add(p, v, __ATOMIC_RELAXED, __HIP_MEMORY_SCOPE_AGENT); }
__device__ __forceinline__ unsigned xb_xcc_id() { return (unsigned)__builtin_amdgcn_s_getreg((3 << 11) | 20) & 0xFu; }
#define XB_SPIN(cond, bar) do { unsigned _sp = 0; while (cond) { __builtin_amdgcn_s_sleep(1); \
    if ((++_sp & 255u) == 0u) { if (xb_ld(&(bar)[XB_TMO])) break; if (_sp > XB_SPIN_CAP) { atomicAdd(&(bar)[XB_TMO], 1u); break; } } } } while (0)

struct XcdBarrier {
    unsigned* bar; unsigned x;
    volatile LAS unsigned* st;
};

__device__ __forceinline__ XcdBarrier xcd_barrier_post(unsigned* bar, volatile LAS unsigned* st) {
    XcdBarrier b; b.bar = bar; b.x = xb_xcc_id(); b.st = st;
    if (threadIdx.x == 0) (void)xb_add(&bar[XB_XCNT(b.x)], 1u);
    return b;
}
__device__ __forceinline__ void xcd_barrier_complete(unsigned* bar, unsigned x, unsigned& nloc, unsigned& nx) {
    const unsigned G = gridDim.x * gridDim.y * gridDim.z;
    unsigned sum, cnt, mine, sp = 0u;
    for (;;) {
        sum = 0u; cnt = 0u; mine = 0u;
#pragma unroll
        for (unsigned j = 0; j < 16; ++j) { const unsigned c = xb_ld(&bar[XB_XCNT(j)]); sum += c; cnt += (c > 0u) ? 1u : 0u; mine = (j == x) ? c : mine; }
        if (sum == G) break;
        __builtin_amdgcn_s_sleep(1);
        if ((++sp & 255u) == 0u) { if (xb_ld(&bar[XB_TMO])) break; if (sp > XB_SPIN_CAP) { atomicAdd(&bar[XB_TMO], 1u); break; } }
    }
    nloc = mine > 0u ? mine : 1u; nx = cnt > 0u ? cnt : 1u;
}

__device__ __forceinline__ void xcd_barrier(const XcdBarrier& b) {
    asm volatile("s_waitcnt vmcnt(0)" ::: "memory");
    __syncthreads();
    if (threadIdx.x == 0) {
        unsigned* bar = b.bar;
        __builtin_amdgcn_s_waitcnt(0);
        unsigned nloc = b.st[0], nx = b.st[1];
        if (nloc == 0u) { xcd_barrier_complete(bar, b.x, nloc, nx); b.st[0] = nloc; b.st[1] = nx; }
        const unsigned old = xb_add(&bar[XB_XSUB(b.x)], 1u);
        const unsigned gen = old / nloc;
        if (old + 1u == (gen + 1u) * nloc) {
            __builtin_amdgcn_fence(__ATOMIC_RELEASE, "agent");
            asm volatile("s_waitcnt vmcnt(0)" ::: "memory");
            const unsigned og = xb_add(&bar[XB_TOP], 1u);
            const unsigned tg = og / nx;
            if (og + 1u == (tg + 1u) * nx) xb_add(&bar[XB_TOPGEN], 1u);
            else XB_SPIN(xb_ld(&bar[XB_TOPGEN]) == tg, bar);
            __builtin_amdgcn_fence(__ATOMIC_ACQUIRE, "agent");
            xb_add(&bar[XB_XGEN(b.x)], 1u);
            asm volatile("s_waitcnt vmcnt(0)" ::: "memory");
        } else {
            XB_SPIN(xb_ld(&bar[XB_XGEN(b.x)]) == gen, bar);
            __builtin_amdgcn_fence(__ATOMIC_ACQUIRE, "agent");
            asm volatile("s_waitcnt vmcnt(0)" ::: "memory");
        }
    }
    __syncthreads();
}

#define FRESH() unsigned long zoff_ = 0; asm volatile("" : "+s"(zoff_)); unsigned char* ws = A.ws + zoff_; int tid = threadIdx.x; asm volatile("" : "+v"(tid)); const int lane = tid & 63, wave = __builtin_amdgcn_readfirstlane(tid >> 6); (void)lane; (void)wave
#ifdef PROBE
#define STAMP() do { if (blockIdx.x == 0 && threadIdx.x == 0) { ((volatile unsigned long long*)(A.ws + WS_CTL + 8192))[nst] = __builtin_amdgcn_s_memrealtime(); } ++nst; } while (0)
#else
#define STAMP() do {} while (0)
#endif
__global__ void __launch_bounds__(NWAVES * 64, 2) hymba_fwd(Args A) {
    extern __shared__ __attribute__((aligned(16))) unsigned char lds[];
    cg::grid_group grid = cg::this_grid();
    LAS unsigned char* L = (LAS unsigned char*)lds;
    if (threadIdx.x < 2) ((volatile LAS unsigned*)(L + LDS_MISC + 64))[threadIdx.x] = 0u;
    __syncthreads();
    const XcdBarrier xbar = xcd_barrier_post((unsigned*)(A.ws + WS_CTL) + 4096, (volatile LAS unsigned*)(L + LDS_MISC + 64));
#define GRID_BAR() xcd_barrier(xbar)
#ifdef PROBE
    int nst = 0; STAMP();
    for (int i = 0; i < 8; ++i) GRID_BAR();
    STAMP();
#endif
#ifndef NO_PRO
    { FRESH(); p0_prologue(A, ws, L, wave, lane); }
#endif
    if (A.ws == nullptr) grid.sync();
    GRID_BAR(); STAMP();
    for (int layer = 0; layer < DEPTH; ++layer) {
#ifndef NO_G1
        {
            FRESH(); const unsigned char* wb = ws + WS_W + (size_t)layer * W_LAYER;
            pg8::Gemm g{(const pg8::bf16_t*)(ws + WS_HB), (const pg8::bf16_t*)(wb + W_IN), MREAL, NINP, 1024}; pg8::StaticOrder S; S.init(MREAL, NINP, (int)gridDim.x, (int)blockIdx.x);
            pg8::EpiIn E{(pg8::bf16_t*)(ws + WS_P), (float*)(ws + WS_LF), (const float*)(ws + WS_SS) + (size_t)(2 * layer) * MROWS, A.in[4] + layer * NFH};
            fl_phase(ws, (const bf16u*)(wb + W_IN) + (size_t)NINP * 1024, (const float*)(ws + WS_SS) + (size_t)(2 * layer) * MROWS, A.in[4] + layer * NFH, wave, lane);
            mini_in(ws, (const bf16u*)(wb + W_IN), (const float*)(ws + WS_SS) + (size_t)(2 * layer) * MROWS, A.in[4] + layer * NFH, L, wave, lane);
            pg8::gemm_phase<pg8::EpiIn, pg8::StaticOrder, true, true>(L, g, S, E);
        }
#endif
        GRID_BAR(); STAMP();
#ifndef NO_POOL
        { FRESH(); pool_scan_phase(ws, L, (unsigned*)(ws + WS_CTL) + 128 + 64 * layer, tid, wave, lane); }
#endif
        GRID_BAR(); STAMP();
        { FRESH(); attn_phase(ws, lds, (unsigned*)(ws + WS_CTL) + 64 * layer, (const unsigned*)(ws + WS_CTL) + 128 + 64 * layer, tid); }
        GRID_BAR(); STAMP();
#ifndef NO_G3
        {
            FRESH(); const unsigned char* wb = ws + WS_W + (size_t)layer * W_LAYER;
            pg8::Gemm g{(const pg8::bf16_t*)(ws + WS_Y), (const pg8::bf16_t*)(wb + W_OUT), MREAL, 1024, 1024}; pg8::StaticOrder S; S.init(MREAL, 1024, (int)gridDim.x, (int)blockIdx.x);
            pg8::EpiRes E{(pg8::bf16_t*)(ws + WS_HB), nullptr, (float*)(ws + WS_SS) + (size_t)(2 * layer + 1) * MROWS};
            mini_res(ws, (const bf16u*)(ws + WS_Y), (const bf16u*)(wb + W_OUT), 1024, (float*)(ws + WS_SS) + (size_t)(2 * layer + 1) * MROWS, L, wave, lane);
            pg8::gemm_phase<pg8::EpiRes, pg8::StaticOrder, true, true>(L, g, S, E);
        }
#endif
        GRID_BAR(); STAMP();
#ifndef NO_G4
        {
            FRESH(); const unsigned char* wb = ws + WS_W + (size_t)layer * W_LAYER;
            pg8::Gemm g{(const pg8::bf16_t*)(ws + WS_HB), (const pg8::bf16_t*)(wb + W_GU), MREAL, NGU, 1024}; pg8::StaticOrder S; S.init(MREAL, NGU, (int)gridDim.x, (int)blockIdx.x);
            pg8::EpiGU E{(pg8::bf16_t*)(ws + WS_P), (const float*)(ws + WS_SS) + (size_t)(2 * layer + 1) * MROWS};
            mini_gu(ws, (const bf16u*)(wb + W_GU), (const float*)(ws + WS_SS) + (size_t)(2 * layer + 1) * MROWS, L, wave, lane);
            pg8::gemm_phase<pg8::EpiGU, pg8::StaticOrder, true, true>(L, g, S, E);
        }
#endif
        GRID_BAR(); STAMP();
#ifndef NO_G5
        {
            FRESH(); const unsigned char* wb = ws + WS_W + (size_t)layer * W_LAYER;
            pg8::Gemm g{(const pg8::bf16_t*)(ws + WS_P), (const pg8::bf16_t*)(wb + W_D), MREAL, 1024, DFF}; pg8::StaticOrder S; S.init(MREAL, 1024, (int)gridDim.x, (int)blockIdx.x);
            pg8::EpiRes E{(pg8::bf16_t*)(ws + WS_HB), nullptr, (float*)(ws + WS_SS) + (size_t)(2 * layer + 2) * MROWS};
            mini_res(ws, (const bf16u*)(ws + WS_P), (const bf16u*)(wb + W_D), DFF, (float*)(ws + WS_SS) + (size_t)(2 * layer + 2) * MROWS, L, wave, lane);
            pg8::gemm_phase<pg8::EpiRes, pg8::StaticOrder, true, true>(L, g, S, E);
        }
#endif
        GRID_BAR(); STAMP();
    }
    { FRESH(); final_phase(A, ws, wave, lane); }
#ifdef PROBE
    STAMP();
    grid.sync();
    {
        volatile unsigned long long* T = (volatile unsigned long long*)(A.ws + WS_CTL + 8192);
        if (blockIdx.x == 0) {
#ifndef PB_HI
#define PB_HI (PB + 1)
#endif

#ifndef PA_HI
#define PA_HI (PA + 1)
#endif
            const unsigned long long dA = T[PA_HI] - T[PA], dB = T[PB_HI < 0 ? 0 : PB_HI] - T[PB < 0 ? 0 : PB];
#if PB >= 0
            for (unsigned long long i = threadIdx.x; i < dB; i += NWAVES * 64) A.out[i] += 0.125f;
#else
            (void)dB;
#endif
            if (threadIdx.x == 0) { const unsigned long long t0 = __builtin_amdgcn_s_memrealtime(); while (__builtin_amdgcn_s_memrealtime() - t0 < dA) __builtin_amdgcn_s_sleep(8); }
        }
    }
#endif
}

extern "C" void kernel_launch(void* const* d_in, const int* in_sizes, int n_in, void* d_out, int out_size, void* d_ws, size_t ws_size, hipStream_t stream) {
    static int grid = 0;
    if (grid == 0) {
        if (n_in != 15 || out_size != NBATCH * SEQ_IN * DMODEL || ws_size < WS_END) { fprintf(stderr, "kernel_launch: unexpected shapes (n_in %d out %d ws %zu, need %zu)\n", n_in, out_size, ws_size, (size_t)WS_END); grid = -1; return; }
        int dev = 0, cus = 0, per_cu = 0;
        if (hipGetDevice(&dev) != hipSuccess || hipDeviceGetAttribute(&cus, hipDeviceAttributeMultiprocessorCount, dev) != hipSuccess) { grid = -1; return; }
        if (hipFuncSetAttribute((const void*)hymba_fwd, hipFuncAttributeMaxDynamicSharedMemorySize, LDS_BYTES) != hipSuccess) { fprintf(stderr, "kernel_launch: hipFuncSetAttribute failed\n"); grid = -1; return; }
        if (hipOccupancyMaxActiveBlocksPerMultiprocessor(&per_cu, (const void*)hymba_fwd, NWAVES * 64, LDS_BYTES) != hipSuccess || per_cu < 1) { fprintf(stderr, "kernel_launch: occupancy query says %d\n", per_cu); per_cu = 1; }
        (void)hipGetLastError();
        grid = cus;
    }
    if (grid < 0) return;
    if (hipMemsetAsync((char*)d_ws + WS_CTL, 0, CTL_ZERO_BYTES, stream) != hipSuccess) { fprintf(stderr, "kernel_launch: memset failed\n"); return; }
    Args a{};
    for (int i = 0; i < 15; ++i) a.in[i] = (const float*)d_in[i];
    a.out = (float*)d_out; a.ws = (unsigned char*)d_ws;
    void* args[] = {&a};
    const hipError_t e = hipLaunchCooperativeKernel((const void*)hymba_fwd, dim3(grid), dim3(NWAVES * 64), args, LDS_BYTES, stream);
    if (e != hipSuccess) fprintf(stderr, "kernel_launch: cooperative launch failed: %s (grid %d)\n", hipGetErrorString(e), grid);
}
```
